# Optimizing an MI355X kernel written in HIP

```python
import jax, jax.numpy as jnp
from jax import lax
import numpy as np

D_MODEL = 1024
BATCH = 32
SEQ = 256
DEPTH = 4
DEC_BATCH = 4
DEC_SEQ = 4096
PAST_LEN = 256

GRID_W = 64
MIX_WIDTH = D_MODEL
GROUP_W = MIX_WIDTH // 4
A_GROUPS = 4
A_CH = GROUP_W // A_GROUPS
CHUNK = 128
B_WIDTH = GROUP_W
CONV_WIDTH = 3
C_GROUPS = 4
C_CH = GROUP_W // C_GROUPS
MLA_HEADS = 4
QK_NOPE = 64
QK_ROPE = 32
V_DIM = 64
Q_LORA = 192
KV_LORA = 128
ROPE_BASE = 10000.0
AXIS_ROPE = QK_ROPE // 2
Q_BLOCK = 128
FF_HIDDEN = ((8 * D_MODEL // 3 + 255) // 256) * 256
EPS = 1e-6
P_A = 2 * GROUP_W
P_B = 3 * B_WIDTH
P_C = GROUP_W
P_D = Q_LORA + KV_LORA + QK_ROPE
P_TOTAL = P_A + P_B + P_C + P_D
SPLITS = [GROUP_W, 2 * GROUP_W, 2 * GROUP_W + B_WIDTH, 2 * GROUP_W + 2 * B_WIDTH,
          2 * GROUP_W + 3 * B_WIDTH, 2 * GROUP_W + 3 * B_WIDTH + P_C]

kernel_name = 'hybrid_diffusion_prefix_trunk'


def rmsnorm(x, g):
    xf = x.astype(jnp.float32)
    y = xf * lax.rsqrt(jnp.mean(xf * xf, axis=-1, keepdims=True) + EPS)
    return (y * g.astype(jnp.float32)).astype(x.dtype)


def modulation(cond, w_ada, b_ada):
    m = jax.nn.silu(cond) @ w_ada + b_ada
    if cond.ndim == 2:
        m = m[:, None, :]
    return jnp.split(m, 6, axis=-1)


def rope_2d_tables(n):
    rows = n // GRID_W
    row = jnp.repeat(jnp.arange(rows, dtype=jnp.float32), GRID_W)
    col = jnp.tile(jnp.arange(GRID_W, dtype=jnp.float32), rows)
    inv = ROPE_BASE ** (-jnp.arange(0, AXIS_ROPE, 2, dtype=jnp.float32) / AXIS_ROPE)
    ang = jnp.stack([row[:, None] * inv, col[:, None] * inv], axis=1)
    return jnp.cos(ang), jnp.sin(ang)


def apply_rope_2d(x, cos, sin):
    xf = x.astype(jnp.float32)
    xr = xf.reshape(*x.shape[:-1], 2, 2, AXIS_ROPE // 2)
    x1, x2 = xr[..., 0, :], xr[..., 1, :]
    extra = x.ndim - 3
    c = cos.reshape(cos.shape[0], *([1] * extra), 2, AXIS_ROPE // 2)
    s = sin.reshape(sin.shape[0], *([1] * extra), 2, AXIS_ROPE // 2)
    out = jnp.stack([x1 * c - x2 * s, x2 * c + x1 * s], axis=-2)
    return out.reshape(x.shape).astype(x.dtype)


def chunk_mlp(u, v, spat_w, spat_b):
    b, n, _ = v.shape
    vr = v.reshape(b, n // CHUNK, CHUNK, A_GROUPS, A_CH)
    mixed = jnp.einsum('gpq,bnqgc->bnpgc', spat_w, vr) + spat_b.T[None, None, :, :, None]
    return u * mixed.reshape(b, n, GROUP_W)


def short_conv(h, gate_b, gate_c, conv_w, conv_b):
    z = gate_c * h
    zp = jnp.pad(z, ((0, 0), (1, 1), (0, 0)))
    y = zp[:, :-2] * conv_w[0] + zp[:, 1:-1] * conv_w[1] + zp[:, 2:] * conv_w[2] + conv_b
    return gate_b * y


def fourier_mix(x):
    b, n, _ = x.shape
    xg = x.astype(jnp.float32).reshape(b, n, C_GROUPS, C_CH)
    y = jnp.fft.fft2(xg, axes=(1, 3), norm='ortho').real
    return y.reshape(b, n, GROUP_W).astype(x.dtype)


def mla_project(pd, g_q_lora, w_uq, g_kv_lora):
    b, n, _ = pd.shape
    cq, ckv, k_rope = jnp.split(pd, [Q_LORA, Q_LORA + KV_LORA], axis=-1)
    q = (rmsnorm(cq, g_q_lora) @ w_uq).reshape(b, n, MLA_HEADS, QK_NOPE + QK_ROPE)
    q_nope, q_rope = q[..., :QK_NOPE], q[..., QK_NOPE:]
    return q_nope, q_rope, rmsnorm(ckv, g_kv_lora), k_rope


def mla_expand(ckv, w_ukv):
    b, n, _ = ckv.shape
    kv = (ckv @ w_ukv).reshape(b, n, MLA_HEADS, QK_NOPE + V_DIM)
    return kv[..., :QK_NOPE], kv[..., QK_NOPE:]


def mla_attend(q_nope, q_rope, k_nope, k_rope, v):
    b, n = q_nope.shape[:2]
    nb = n // Q_BLOCK
    qn_b = q_nope.reshape(b, nb, Q_BLOCK, MLA_HEADS, QK_NOPE).swapaxes(0, 1)
    qr_b = q_rope.reshape(b, nb, Q_BLOCK, MLA_HEADS, QK_ROPE).swapaxes(0, 1)
    scale = (QK_NOPE + QK_ROPE) ** -0.5

    def block(args):
        qn_i, qr_i = args
        s = (jnp.einsum('bqhd,bkhd->bhqk', qn_i, k_nope, preferred_element_type=jnp.float32)
             + jnp.einsum('bqhr,bkr->bhqk', qr_i, k_rope, preferred_element_type=jnp.float32))
        p = jax.nn.softmax(s * scale, axis=-1).astype(v.dtype)
        return jnp.einsum('bhqk,bkhd->bqhd', p, v)

    o = lax.map(block, (qn_b, qr_b))
    return o.swapaxes(0, 1).reshape(b, n, MLA_HEADS * V_DIM)


def swiglu(h, w_gate_up, w_down):
    g, u = jnp.split(h @ w_gate_up, 2, axis=-1)
    return (jax.nn.silu(g) * u) @ w_down


def trunk_layer(x, cond, ctx_ckv, ctx_krope, w_ada, b_ada, g_pre_mix, g_post_mix,
                g_pre_ffn, g_post_ffn, w_in, spat_w, spat_b, conv_w, conv_b,
                g_q_lora, w_uq, g_kv_lora, w_ukv, w_out, w_gate_up, w_down):
    shift1, scale1, gate1, shift2, scale2, gate2 = modulation(cond, w_ada, b_ada)
    h = rmsnorm(x, g_pre_mix) * (1.0 + scale1) + shift1
    pa_u, pa_v, pb_h, pb_b, pb_c, pc, pd = jnp.split(h @ w_in, SPLITS, axis=-1)
    y_a = chunk_mlp(pa_u, pa_v, spat_w, spat_b)
    y_b = short_conv(pb_h, pb_b, pb_c, conv_w, conv_b)
    y_c = fourier_mix(pc)
    q_nope, q_rope, ckv, k_rope = mla_project(pd, g_q_lora, w_uq, g_kv_lora)
    if ctx_ckv is None:
        k_nope, v = mla_expand(ckv, w_ukv)
        y_d = mla_attend(q_nope, q_rope, k_nope, k_rope, v)
    else:
        cos, sin = rope_2d_tables(x.shape[1])
        q_rope = apply_rope_2d(q_rope, cos, sin)
        k_rope = apply_rope_2d(k_rope, cos, sin)
        k_nope, v = mla_expand(jnp.concatenate([ckv, ctx_ckv], axis=1), w_ukv)
        k_rope_all = jnp.concatenate([k_rope, ctx_krope], axis=1)
        y_d = mla_attend(q_nope, q_rope, k_nope, k_rope_all, v)
    mix = jnp.concatenate([y_a, y_b, y_c, y_d], axis=-1) @ w_out
    x = x + gate1 * rmsnorm(mix, g_post_mix)
    h2 = rmsnorm(x, g_pre_ffn) * (1.0 + scale2) + shift2
    x = x + gate2 * rmsnorm(swiglu(h2, w_gate_up, w_down), g_post_ffn)
    return x, ckv, k_rope


def setup_inputs(seed: int = 0) -> dict:
    key = jax.random.key(seed)
    ks = jax.random.split(key, 24)

    def nrm(k, shape, s):
        return jax.random.normal(k, shape, jnp.float32) * s

    return {
        'x_prompt': nrm(ks[0], (BATCH, SEQ, D_MODEL), 1.0),
        'x_sample': nrm(ks[1], (DEC_BATCH, DEC_SEQ, D_MODEL), 1.0),
        'cache_ckv': nrm(ks[2], (DEC_BATCH, DEPTH, PAST_LEN, KV_LORA), 1.0),
        'cache_krope': nrm(ks[3], (DEC_BATCH, DEPTH, PAST_LEN, QK_ROPE), 1.0),
        'c': nrm(ks[4], (DEC_BATCH, D_MODEL), 1.0),
        'c_ctx': nrm(ks[5], (D_MODEL,), 1.0),
        'w_ada': nrm(ks[6], (DEPTH, D_MODEL, 6 * D_MODEL), 0.5 * D_MODEL ** -0.5),
        'b_ada': nrm(ks[7], (DEPTH, 6 * D_MODEL), 0.01),
        'g_pre_mix': 1.0 + nrm(ks[8], (DEPTH, D_MODEL), 0.01),
        'g_post_mix': 1.0 + nrm(ks[9], (DEPTH, D_MODEL), 0.01),
        'g_pre_ffn': 1.0 + nrm(ks[10], (DEPTH, D_MODEL), 0.01),
        'g_post_ffn': 1.0 + nrm(ks[11], (DEPTH, D_MODEL), 0.01),
        'w_in': nrm(ks[12], (DEPTH, D_MODEL, P_TOTAL), D_MODEL ** -0.5),
        'spat_w': nrm(ks[13], (DEPTH, A_GROUPS, CHUNK, CHUNK), CHUNK ** -0.5),
        'spat_b': 1.0 + nrm(ks[14], (DEPTH, A_GROUPS, CHUNK), 0.01),
        'conv_w': nrm(ks[15], (DEPTH, CONV_WIDTH, B_WIDTH), CONV_WIDTH ** -0.5),
        'conv_b': nrm(ks[16], (DEPTH, B_WIDTH), 0.01),
        'g_q_lora': 1.0 + nrm(ks[17], (DEPTH, Q_LORA), 0.01),
        'w_uq': nrm(ks[18], (DEPTH, Q_LORA, MLA_HEADS * (QK_NOPE + QK_ROPE)), Q_LORA ** -0.5),
        'g_kv_lora': 1.0 + nrm(ks[19], (DEPTH, KV_LORA), 0.01),
        'w_ukv': nrm(ks[20], (DEPTH, KV_LORA, MLA_HEADS * (QK_NOPE + V_DIM)), KV_LORA ** -0.5),
        'w_out': nrm(ks[21], (DEPTH, MIX_WIDTH, D_MODEL), MIX_WIDTH ** -0.5),
        'w_gate_up': nrm(ks[22], (DEPTH, D_MODEL, 2 * FF_HIDDEN), D_MODEL ** -0.5),
        'w_down': nrm(ks[23], (DEPTH, FF_HIDDEN, D_MODEL), FF_HIDDEN ** -0.5),
    }


def reference(x_prompt, x_sample, cache_ckv, cache_krope, c, c_ctx, w_ada, b_ada,
              g_pre_mix, g_post_mix, g_pre_ffn, g_post_ffn, w_in, spat_w, spat_b,
              conv_w, conv_b, g_q_lora, w_uq, g_kv_lora, w_ukv, w_out, w_gate_up, w_down):
    y_prompt = x_prompt
    y_sample = x_sample
    ckv_list = []
    krope_list = []
    for l in range(DEPTH):
        lp = (w_ada[l], b_ada[l], g_pre_mix[l], g_post_mix[l], g_pre_ffn[l], g_post_ffn[l],
              w_in[l], spat_w[l], spat_b[l], conv_w[l], conv_b[l], g_q_lora[l], w_uq[l],
              g_kv_lora[l], w_ukv[l], w_out[l], w_gate_up[l], w_down[l])
        y_prompt, ckv_l, krope_l = trunk_layer(y_prompt, c_ctx, None, None, *lp)
        ckv_list.append(ckv_l)
        krope_list.append(krope_l)
        y_sample, _, _ = trunk_layer(y_sample, c, cache_ckv[:, l], cache_krope[:, l], *lp)
    state_ckv = jnp.stack(ckv_list, axis=1)
    state_krope = jnp.stack(krope_list, axis=1)
    return (y_prompt, y_sample, state_ckv, state_krope)
```

```cpp
#include <hip/hip_runtime.h>
#include <hip/hip_cooperative_groups.h>
#include <cstdio>
#include <cstdint>
namespace cg = cooperative_groups;
namespace pg8 {
#define PG8_LAS __attribute__((address_space(3)))
typedef unsigned short bf16_t;
typedef short bf16x8 __attribute__((ext_vector_type(8)));
typedef float f32x4 __attribute__((ext_vector_type(4)));
typedef unsigned u32x4 __attribute__((ext_vector_type(4)));
constexpr int BM = 256, BK = 64, HALF = 128, HTB = HALF * BK * 2  , STAGE_BYTES = 8 * HTB, NXCD = 8, WGM = 8;

__host__ __device__ __forceinline__ int lds_byte(int r, int c) { const int st = (r >> 4) * 2 + (c >> 5), rr = r & 15, cc = c & 31, ob = rr * 64 + cc * 2; return st * 1024 + (ob ^ (((ob >> 9) & 1) << 5)); }
__host__ __device__ __forceinline__ void stage_rc(int b, int& R, int& C) { const int st = b / 1024, sb = b % 1024, swz = sb ^ (((sb >> 9) & 1) << 5); R = (st >> 1) * 16 + swz / 64; C = (st & 1) * 32 + (swz % 64) / 2; }
__host__ __device__ __forceinline__ int perm32(int rho) { const int n = rho >> 4, i = rho & 15; return 8 * (i >> 2) + 4 * n + (i & 3); }

struct Unit { int pm, pn; };
struct Gemm { const bf16_t* A; const bf16_t* Bt; int M, N, K; int wave_s; };

struct StaticOrder {
    int nM, nN, nwg, G, c;
    __host__ __device__ void init(int M, int N, int G_, int c_) { nM = M / BM; nN = N / BM; nwg = nM * nN; G = G_; c = c_; }
    __host__ __device__ bool next(int i, Unit& u) const {
        const long L = (long)i * G + c; if (L >= nwg) return false;
        int wgid = (int)L; { const int q = nwg / NXCD, r = nwg % NXCD, xcd = wgid % NXCD, off = wgid / NXCD; wgid = (xcd < r ? xcd * (q + 1) : r * (q + 1) + (xcd - r) * q) + off; }
        const int nig = WGM * nN, gid = wgid / nig, fm = gid * WGM, gsz = (nM - fm) < WGM ? (nM - fm) : WGM;
        u.pm = fm + ((wgid % nig) % gsz); u.pn = (wgid % nig) / gsz; return true;
    }
    __device__ __forceinline__ void a_ready(const Unit&) const {}
    __device__ __forceinline__ void done(const Unit&) const {}
};

__device__ __forceinline__ unsigned cvt_pk_bf16(float lo, float hi) { unsigned r; asm volatile("v_cvt_pk_bf16_f32 %0, %1, %2" : "=v"(r) : "v"(lo), "v"(hi)); return r; }
typedef float f32x2 __attribute__((ext_vector_type(2)));
struct EpiStore {
    static constexpr bool PERM = true, AFTER_DRAIN = false;
    bf16_t* O; int ldc; int ncols;
    __device__ __forceinline__ void operator()(const f32x4 (&acc)[2][2][4][2], const Unit& u, int wr, int wc, int fr, int fq) const {
        const int row0 = u.pm * BM + wr * 64 + fr; const int col0 = u.pn * BM + wc * 32 + 8 * fq;
#pragma unroll
        for (int ai = 0; ai < 2; ++ai)
#pragma unroll
            for (int m = 0; m < 4; ++m) { bf16_t* rowp = O + (size_t)(row0 + ai * HALF + m * 16) * ldc + col0;
#pragma unroll
                for (int bj = 0; bj < 2; ++bj) { const f32x4 v0 = acc[ai][bj][m][0], v1 = acc[ai][bj][m][1];
                    u32x4 w; w.x = cvt_pk_bf16(v0[0], v0[1]); w.y = cvt_pk_bf16(v0[2], v0[3]); w.z = cvt_pk_bf16(v1[0], v1[1]); w.w = cvt_pk_bf16(v1[2], v1[3]);
                    if (col0 + bj * HALF < ncols) *(u32x4*)(rowp + bj * HALF) = w; } }
    }
};
struct EpiStoreWT {
    static constexpr bool PERM = true, AFTER_DRAIN = false;
    bf16_t* O; int ldc; int ncols;
    __device__ __forceinline__ void operator()(const f32x4 (&acc)[2][2][4][2], const Unit& u, int wr, int wc, int fr, int fq) const {
        const int row0 = u.pm * BM + wr * 64 + fr; const int col0 = u.pn * BM + wc * 32 + 8 * fq;
#pragma unroll
        for (int ai = 0; ai < 2; ++ai)
#pragma unroll
            for (int m = 0; m < 4; ++m) { bf16_t* rowp = O + (size_t)(row0 + ai * HALF + m * 16) * ldc + col0;
#pragma unroll
                for (int bj = 0; bj < 2; ++bj) { const f32x4 v0 = acc[ai][bj][m][0], v1 = acc[ai][bj][m][1];
                    const unsigned long long lo = (unsigned long long)cvt_pk_bf16(v0[0], v0[1]) | ((unsigned long long)cvt_pk_bf16(v0[2], v0[3]) << 32);
                    const unsigned long long hi = (unsigned long long)cvt_pk_bf16(v1[0], v1[1]) | ((unsigned long long)cvt_pk_bf16(v1[2], v1[3]) << 32);
                    unsigned long long* q = (unsigned long long*)(rowp + bj * HALF);
                    __hip_atomic_store(q, lo, __ATOMIC_RELAXED, __HIP_MEMORY_SCOPE_AGENT); __hip_atomic_store(q + 1, hi, __ATOMIC_RELAXED, __HIP_MEMORY_SCOPE_AGENT); } }
    }
};
__device__ __forceinline__ float silu_mul(float g, float u) { return g * u * __builtin_amdgcn_rcpf(1.f + __expf(-g)); }
struct EpiSwiGLU {
    static constexpr bool PERM = true, AFTER_DRAIN = false;
    bf16_t* O; int ldc;
    __device__ __forceinline__ void operator()(const f32x4 (&acc)[2][2][4][2], const Unit& u, int wr, int wc, int fr, int fq) const {
        const int row0 = u.pm * BM + wr * 64 + fr; const int col0 = u.pn * HALF + wc * 32 + 8 * fq;
#pragma unroll
        for (int ai = 0; ai < 2; ++ai)
#pragma unroll
            for (int m = 0; m < 4; ++m) { bf16_t* rowp = O + (size_t)(row0 + ai * HALF + m * 16) * ldc + col0;
                const f32x4 g0 = acc[ai][0][m][0], g1 = acc[ai][0][m][1], u0 = acc[ai][1][m][0], u1 = acc[ai][1][m][1];
                u32x4 w; w.x = cvt_pk_bf16(silu_mul(g0[0], u0[0]), silu_mul(g0[1], u0[1])); w.y = cvt_pk_bf16(silu_mul(g0[2], u0[2]), silu_mul(g0[3], u0[3]));
                w.z = cvt_pk_bf16(silu_mul(g1[0], u1[0]), silu_mul(g1[1], u1[1])); w.w = cvt_pk_bf16(silu_mul(g1[2], u1[2]), silu_mul(g1[3], u1[3]));
                *(u32x4*)rowp = w; }
    }
};

struct PanelOrder {
    int nN, nwg, G, c; unsigned* cnt;
    __device__ void init(int M, int N, int G_, int c_, unsigned* cnt_) { nN = N / BM; nwg = (M / BM) * nN; G = G_; c = c_; cnt = cnt_; }
    __device__ bool next(int i, Unit& u) const { const long L = (long)i * G + c; if (L >= nwg) return false; u.pm = (int)L / nN; u.pn = (int)L % nN; return true; }
    __device__ __forceinline__ void a_ready(const Unit&) const {}
    __device__ __forceinline__ void done(const Unit& u) const {
        asm volatile("s_waitcnt vmcnt(0)" ::: "memory");
        if ((threadIdx.x & 63) == 0) __hip_atomic_fetch_add(cnt + u.pm, 1u, __ATOMIC_RELAXED, __HIP_MEMORY_SCOPE_AGENT);
    }
};
template <class Epi, class Sched, bool ALIGN_EPI = false, bool SP2 = false>
__device__ __forceinline__ void gemm_phase(PG8_LAS unsigned char* lds, const Gemm g, const Sched& S, const Epi& E) {
    int ws_ = g.wave_s; unsigned m1_ = ~0u; asm volatile("" : "+s"(ws_), "+s"(m1_)); int tid_ = ws_ * 64 + (int)__builtin_amdgcn_mbcnt_hi(m1_, __builtin_amdgcn_mbcnt_lo(m1_, 0u)); asm volatile("" : "+v"(tid_));
    const int tid = tid_, wid = __builtin_amdgcn_readfirstlane(tid >> 6), lane = tid & 63, wr = wid >> 2, wc = wid & 3, fr = lane & 15, fq = lane >> 4;
    const int K = g.K, nt = K / BK;
    unsigned voffA[2], voffB[2];
#pragma unroll
    for (int i = 0; i < 2; ++i) { int R, C; stage_rc(tid * 16 + i * 8192, R, C); const int Rb = Epi::PERM ? ((R & ~31) + perm32(R & 31)) : R;
        voffA[i] = (unsigned)(R * K + C) * 2u; voffB[i] = (unsigned)(Rb * K + C) * 2u; }
    const size_t kstep = (size_t)(BK * 2);
    const size_t hstep = (size_t)HALF * K * 2;
    const size_t tstep = 2 * hstep;
    const unsigned ldsw = (unsigned)wid * 1024u;
    const int aoff = lds_byte(wr * 64 + fr, fq * 8), boff = lds_byte(wc * 32 + fr, fq * 8);
#define PG8_SA(b, h) (((b) * 2 + (h)) * HTB)
#define PG8_SB(b, h) ((4 + (b) * 2 + (h)) * HTB)
#define PG8_STAGE(bufoff, gbase, voff) do { _Pragma("unroll") for (int _i = 0; _i < 2; ++_i) \
        __builtin_amdgcn_global_load_lds((const unsigned*)((const char*)(gbase) + (voff)[_i]), (PG8_LAS unsigned*)(lds + (bufoff) + ldsw + _i * 8192), 16, 0, 0); } while (0)
#define PG8_LDA(dst, b, h) do { _Pragma("unroll") for (int m = 0; m < 4; ++m) _Pragma("unroll") for (int k = 0; k < 2; ++k) dst[m][k] = *(const PG8_LAS bf16x8*)(lds + PG8_SA(b, h) + aoff + m * 2048 + k * 1024); } while (0)
#define PG8_LDB(dst, b, h) do { _Pragma("unroll") for (int n = 0; n < 2; ++n) _Pragma("unroll") for (int k = 0; k < 2; ++k) dst[n][k] = *(const PG8_LAS bf16x8*)(lds + PG8_SB(b, h) + boff + n * 2048 + k * 1024); } while (0)
#define PG8_MMA(ai, bj, At, Bt) do { __builtin_amdgcn_s_setprio(1); _Pragma("unroll") for (int m = 0; m < 4; ++m) _Pragma("unroll") for (int n = 0; n < 2; ++n) _Pragma("unroll") for (int k = 0; k < 2; ++k) \
        acc[ai][bj][m][n] = __builtin_amdgcn_mfma_f32_16x16x32_bf16(Bt[n][k], At[m][k], acc[ai][bj][m][n], 0, 0, 0); __builtin_amdgcn_s_setprio(0); } while (0)
#define PG8_WAIT_V(n) asm volatile("s_waitcnt vmcnt(" #n ")" ::: "memory")
#define PG8_WAIT_L(n) asm volatile("s_waitcnt lgkmcnt(" #n ")" ::: "memory")
#define PG8_BAR __builtin_amdgcn_s_barrier()
#define PG8_SCHED __builtin_amdgcn_sched_barrier(0)
    Unit cur, nxt; int ui = 0;
    if (!S.next(0, cur)) return;
    f32x4 acc[2][2][4][2];
#pragma unroll
    for (int a = 0; a < 2; ++a)
#pragma unroll
        for (int b = 0; b < 2; ++b)
#pragma unroll
            for (int m = 0; m < 4; ++m)
#pragma unroll
                for (int n = 0; n < 2; ++n) acc[a][b][m][n] = (f32x4){0.f, 0.f, 0.f, 0.f};
    bf16x8 At[4][2], B0[2][2], B1[2][2];
    const char* cA = (const char*)g.A + (size_t)cur.pm * tstep; const char* cB = (const char*)g.Bt + (size_t)cur.pn * tstep;
    S.a_ready(cur);
    if constexpr (SP2) {
        PG8_STAGE(PG8_SB(0, 0), cB, voffB); PG8_STAGE(PG8_SB(0, 1), cB + hstep, voffB); PG8_STAGE(PG8_SA(0, 0), cA, voffA); PG8_STAGE(PG8_SA(0, 1), cA + hstep, voffA);
        if (wr == 1) PG8_BAR;
        PG8_WAIT_V(2); PG8_BAR;
        PG8_STAGE(PG8_SB(1, 0), cB + kstep, voffB); PG8_STAGE(PG8_SA(1, 0), cA + kstep, voffA); PG8_STAGE(PG8_SB(1, 1), cB + hstep + kstep, voffB);
        PG8_WAIT_V(6); PG8_BAR;
    } else {
        PG8_STAGE(PG8_SB(0, 0), cB, voffB); PG8_STAGE(PG8_SA(0, 0), cA, voffA); PG8_STAGE(PG8_SB(0, 1), cB + hstep, voffB); PG8_STAGE(PG8_SA(0, 1), cA + hstep, voffA);
        if (wr == 1) PG8_BAR;
        PG8_WAIT_V(4); PG8_BAR;
        PG8_STAGE(PG8_SB(1, 0), cB + kstep, voffB); PG8_STAGE(PG8_SA(1, 0), cA + kstep, voffA); PG8_STAGE(PG8_SB(1, 1), cB + hstep + kstep, voffB);
        PG8_WAIT_V(6); PG8_BAR;
    }
    for (;;) {
        const bool has_next = S.next(ui + 1, nxt);
        const char* nA = has_next ? (const char*)g.A + (size_t)nxt.pm * tstep : cA; const char* nB = has_next ? (const char*)g.Bt + (size_t)nxt.pn * tstep : cB;
        for (int t = 0; t < nt; t += 2) {
            const bool last = (t == nt - 2);
            const char* a1 = cA + (size_t)(t + 1) * kstep;
            const char* a2 = last ? nA : cA + (size_t)(t + 2) * kstep; const char* b2 = last ? nB : cB + (size_t)(t + 2) * kstep;
            const char* a3 = a2 + kstep; const char* b3 = b2 + kstep;
            if (last && has_next) S.a_ready(nxt);
            if constexpr (SP2) {
            PG8_LDB(B0, 0, 0); PG8_LDB(B1, 0, 1); PG8_SCHED; PG8_LDA(At, 0, 0); PG8_STAGE(PG8_SA(1, 1), a1 + hstep, voffA);
            PG8_WAIT_V(8); PG8_WAIT_L(0); PG8_BAR; PG8_MMA(0, 0, At, B0); PG8_MMA(0, 1, At, B1); PG8_BAR; PG8_SCHED;
            PG8_LDA(At, 0, 1); PG8_STAGE(PG8_SB(0, 0), b2, voffB); PG8_STAGE(PG8_SB(0, 1), b2 + hstep, voffB); PG8_STAGE(PG8_SA(0, 0), a2, voffA);
            PG8_WAIT_V(8); PG8_WAIT_L(0); PG8_BAR; PG8_MMA(1, 0, At, B0); PG8_MMA(1, 1, At, B1); PG8_BAR; PG8_SCHED;
            PG8_LDB(B0, 1, 0); PG8_LDB(B1, 1, 1); PG8_SCHED; PG8_LDA(At, 1, 0); PG8_STAGE(PG8_SA(0, 1), a2 + hstep, voffA);
            PG8_WAIT_V(8); PG8_WAIT_L(0); PG8_BAR; PG8_MMA(0, 0, At, B0); PG8_MMA(0, 1, At, B1); PG8_BAR; PG8_SCHED;
            PG8_LDA(At, 1, 1); PG8_STAGE(PG8_SB(1, 0), b3, voffB); PG8_STAGE(PG8_SB(1, 1), b3 + hstep, voffB); PG8_STAGE(PG8_SA(1, 0), a3, voffA);
            PG8_WAIT_V(8); PG8_WAIT_L(0); PG8_BAR; PG8_MMA(1, 0, At, B0); PG8_MMA(1, 1, At, B1); PG8_BAR; PG8_SCHED;
            } else {
            PG8_LDB(B0, 0, 0); PG8_SCHED; PG8_LDA(At, 0, 0); PG8_STAGE(PG8_SA(1, 1), a1 + hstep, voffA);
            PG8_WAIT_L(8); PG8_BAR; PG8_WAIT_L(0); PG8_MMA(0, 0, At, B0); PG8_BAR; PG8_SCHED;
            PG8_LDB(B1, 0, 1); PG8_STAGE(PG8_SB(0, 0), b2, voffB);
            PG8_BAR; PG8_WAIT_L(0); PG8_MMA(0, 1, At, B1); PG8_BAR;
            PG8_LDA(At, 0, 1); PG8_STAGE(PG8_SA(0, 0), a2, voffA);
            PG8_BAR; PG8_WAIT_L(0); PG8_MMA(1, 0, At, B0); PG8_BAR; PG8_SCHED;
            PG8_STAGE(PG8_SB(0, 1), b2 + hstep, voffB);
            PG8_WAIT_V(6); PG8_BAR; PG8_MMA(1, 1, At, B1); PG8_BAR;
            PG8_LDB(B0, 1, 0); PG8_SCHED; PG8_LDA(At, 1, 0); PG8_STAGE(PG8_SA(0, 1), a2 + hstep, voffA);
            PG8_WAIT_L(8); PG8_BAR; PG8_WAIT_L(0); PG8_MMA(0, 0, At, B0); PG8_BAR; PG8_SCHED;
            PG8_LDB(B1, 1, 1); PG8_STAGE(PG8_SB(1, 0), b3, voffB);
            PG8_BAR; PG8_WAIT_L(0); PG8_MMA(0, 1, At, B1); PG8_BAR;
            PG8_LDA(At, 1, 1); PG8_STAGE(PG8_SA(1, 0), a3, voffA);
            PG8_BAR; PG8_WAIT_L(0); PG8_MMA(1, 0, At, B0); PG8_BAR; PG8_SCHED;
            PG8_STAGE(PG8_SB(1, 1), b3 + hstep, voffB);
            PG8_WAIT_V(6); PG8_BAR; PG8_MMA(1, 1, At, B1); PG8_BAR;
            }
        }
        if constexpr (ALIGN_EPI) { if (wr == 0) PG8_BAR; }
        if constexpr (!Epi::AFTER_DRAIN) { E(acc, cur, wr, wc, fr, fq); S.done(cur); }
        if (!has_next) break;
#pragma unroll
        for (int a = 0; a < 2; ++a)
#pragma unroll
            for (int b = 0; b < 2; ++b)
#pragma unroll
                for (int m = 0; m < 4; ++m)
#pragma unroll
                    for (int n = 0; n < 2; ++n) acc[a][b][m][n] = (f32x4){0.f, 0.f, 0.f, 0.f};
        cur = nxt; cA = nA; cB = nB; ++ui;
        if constexpr (ALIGN_EPI) { if (wr == 1) PG8_BAR; }
    }
    PG8_WAIT_V(0);
    if constexpr (!ALIGN_EPI) { if (wr == 0) PG8_BAR; }
    PG8_BAR;
    if constexpr (Epi::AFTER_DRAIN) { E.fused(acc, cur, wr, wc, fr, fq, lds, wid, lane); S.done(cur); }
#undef PG8_SA
#undef PG8_SB
#undef PG8_STAGE
#undef PG8_LDA
#undef PG8_LDB
#undef PG8_MMA
#undef PG8_WAIT_V
#undef PG8_WAIT_L
#undef PG8_BAR
#undef PG8_SCHED
}
}
#define LAS __attribute__((address_space(3)))
typedef unsigned short bf16_t;
typedef short bf16x8 __attribute__((ext_vector_type(8)));
typedef short bf16x4 __attribute__((ext_vector_type(4)));
typedef float f32x4 __attribute__((ext_vector_type(4)));
typedef float f32x2 __attribute__((ext_vector_type(2)));
typedef float f32x16 __attribute__((ext_vector_type(16)));
typedef unsigned u32x4 __attribute__((ext_vector_type(4)));
typedef unsigned u32x2 __attribute__((ext_vector_type(2)));

constexpr int D = 1024, M_CTX = 8192, M_LAT = 16384, M = M_CTX + M_LAT, NP = 1888, NPP = 2048, FF = 2816, DEPTH = 4;
constexpr int KEYROWS = 8192 + 4 * 4352;
constexpr float EPS = 1e-6f;
constexpr int NTHREADS = 512, NWAVES = 8;
constexpr int LDS_BYTES = 147456;

constexpr size_t OUT_X = 0, OUT_CKV = (size_t)M * D, OUT_KR = OUT_CKV + (size_t)32 * 4 * 256 * 128;
constexpr int PC_U = 0, PC_V = 256, PC_H = 512, PC_B = 768, PC_C = 1024, PC_F = 1280, PC_Q = 1536, PC_KV = 1728, PC_KR = 1856;

constexpr size_t al256(size_t x) { return (x + 255) & ~(size_t)255; }
constexpr size_t WS_BAR = 0, WS_BAR_BYTES = 16384;
constexpr size_t WS_MOD = WS_BAR_BYTES;
constexpr size_t WS_F64 = al256(WS_MOD + (size_t)4 * 5 * 6144 * 4);
constexpr size_t WS_T64R = WS_F64 + 128 * 64 * 2;
constexpr size_t WS_T64I = WS_T64R + 64 * 128 * 2;
constexpr size_t WS_T64B = WS_T64I + 64 * 128 * 2;
constexpr size_t WS_T256 = WS_T64B + 64 * 128 * 2;
constexpr size_t WS_TW = WS_T256 + 256 * 512 * 2;
constexpr size_t WS_ROPE = WS_TW + 4096 * 8;
constexpr size_t WS_W = al256(WS_ROPE + 64 * 8 * 8);
constexpr size_t WL_IN = 0, WL_OUT = WL_IN + (size_t)NPP * D * 2, WL_GU = WL_OUT + (size_t)D * D * 2, WL_DN = WL_GU + (size_t)2 * FF * D * 2,
                 WL_UQ = WL_DN + (size_t)D * FF * 2, WL_UKV = WL_UQ + (size_t)384 * 192 * 2, WL_SP = WL_UKV + (size_t)512 * 128 * 2, WL_SIZE = WL_SP + (size_t)4 * 128 * 128 * 2;
constexpr size_t WS_R1 = al256(WS_W + 4 * WL_SIZE);
constexpr size_t WS_R2 = WS_R1 + (size_t)M * D * 2;
constexpr size_t WS_MLA = WS_R2 + (size_t)M * FF * 2;
constexpr size_t WS_Q = WS_MLA, WS_KN = WS_Q + (size_t)M * 384 * 2, WS_VT = WS_KN + (size_t)KEYROWS * 256 * 2, WS_KR = WS_VT + (size_t)KEYROWS * 256 * 2,
                 WS_GB = WS_KR + (size_t)KEYROWS * 32 * 2, WS_END = WS_GB + (size_t)4 * 4 * 64 * 64 * 128 * 2;
static_assert(WS_END - WS_MLA >= (size_t)M * D * 2, "FFNOUT alias");
static_assert((size_t)M * NP * 2 <= (size_t)M * FF * 2, "PROJ fits R2");

struct Params { const float* in[24]; float* out; unsigned char* ws; };
enum { I_XP = 0, I_XS, I_CCKV, I_CKR, I_C, I_CCTX, I_WADA, I_BADA, I_GPM, I_GPOM, I_GPF, I_GPOF, I_WIN, I_SPW, I_SPB, I_CVW, I_CVB, I_GQ, I_WUQ, I_GKV, I_WUKV, I_WOUT, I_WGU, I_WDN };

__device__ __forceinline__ unsigned f2bf(float f) { unsigned u = __builtin_bit_cast(unsigned, f); return (u + 0x7fffu + ((u >> 16) & 1u)) >> 16; }
typedef __bf16 bf16x2v __attribute__((ext_vector_type(2)));
__device__ __forceinline__ unsigned pk2(float lo, float hi) { const bf16x2v r = __builtin_convertvector((f32x2){lo, hi}, bf16x2v); return __builtin_bit_cast(unsigned, r); }
__device__ __forceinline__ float bflo(unsigned w) { return __builtin_bit_cast(float, w << 16); }
__device__ __forceinline__ float bfhi(unsigned w) { return __builtin_bit_cast(float, w & 0xffff0000u); }
__device__ __forceinline__ float bf1(bf16_t v) { return __builtin_bit_cast(float, (unsigned)v << 16); }
__device__ __forceinline__ f32x4 mma16(bf16x8 a, bf16x8 b, f32x4 c) { return __builtin_amdgcn_mfma_f32_16x16x32_bf16(a, b, c, 0, 0, 0); }
__device__ __forceinline__ f32x16 mma32(bf16x8 a, bf16x8 b, f32x16 c) { return __builtin_amdgcn_mfma_f32_32x32x16_bf16(a, b, c, 0, 0, 0); }
template <int MSK> __device__ __forceinline__ int shx_i(int v, int lane) {
    if constexpr (MSK < 32) return __builtin_amdgcn_ds_swizzle(v, (MSK << 10) | 0x1F);
    else return __builtin_amdgcn_ds_bpermute((lane ^ 32) << 2, v);
}
template <int MSK> __device__ __forceinline__ float shx(float v, int lane) { return __builtin_bit_cast(float, shx_i<MSK>(__builtin_bit_cast(int, v), lane)); }
__device__ __forceinline__ float wave_sum(float v, int lane) {
    v += shx<1>(v, lane); v += shx<2>(v, lane); v += shx<4>(v, lane); v += shx<8>(v, lane); v += shx<16>(v, lane); v += shx<32>(v, lane);
    return v;
}
__device__ __forceinline__ u32x2 pk4(f32x4 v) { u32x2 w; w.x = pk2(v[0], v[1]); w.y = pk2(v[2], v[3]); return w; }
__device__ __forceinline__ int mod_of_row(int r) { return r < M_CTX ? 0 : 1 + ((r - M_CTX) >> 12); }

__device__ __forceinline__ int opaque_lane() { unsigned m1 = ~0u; asm volatile("" : "+s"(m1)); return (int)__builtin_amdgcn_mbcnt_hi(m1, __builtin_amdgcn_mbcnt_lo(m1, 0u)); }
struct Ctx {
    Params p; LAS unsigned char* lds; int tid, lane, wave, bid, G;
    unsigned char* ws;
    __device__ __forceinline__ const float* mod(int l, int mi, int chunk) const { return (const float*)(ws + WS_MOD) + ((size_t)(l * 5 + mi) * 6 + chunk) * 1024; }
    __device__ __forceinline__ unsigned char* wl(int l) const { return ws + WS_W + (size_t)l * WL_SIZE; }
    int wave_s;
    __device__ __forceinline__ void refresh() { int w = wave_s; asm volatile("" : "+s"(w)); int l = opaque_lane(); asm volatile("" : "+v"(l));
        wave = w; lane = l; tid = w * 64 + l;
        size_t z = 0; asm volatile("" : "+s"(z)); ws = p.ws + z;
        int b = blockIdx.x; asm volatile("" : "+s"(b)); bid = b; }
};

constexpr int TPS = 258;
struct TItem { const float* W; bf16_t* WT; int ldw, K, k0, n0, nvalid, gu; };
__device__ __forceinline__ void titem_load(const TItem& t, int wave, int lane, f32x4 (&v)[8]) {
    const int n = t.n0 + 4 * lane;
#pragma unroll
    for (int i = 0; i < 8; ++i) v[i] = n < t.nvalid ? *(const f32x4*)(t.W + (size_t)(t.k0 + 8 * wave + i) * t.ldw + n) : (f32x4){0.f, 0.f, 0.f, 0.f};
}
__device__ __forceinline__ void titem_stage(LAS unsigned char* lds, int wave, int lane, const f32x4 (&v)[8]) {
    LAS bf16_t* T = (LAS bf16_t*)lds;
#pragma unroll
    for (int i = 0; i < 8; ++i) { LAS unsigned* d = (LAS unsigned*)(T + (8 * wave + i) * TPS + 4 * lane); d[0] = pk2(v[i][0], v[i][1]); d[1] = pk2(v[i][2], v[i][3]); }
}
__device__ __forceinline__ void titem_store(const TItem& t, const LAS unsigned char* lds, int tid) {
    const LAS bf16_t* T = (const LAS bf16_t*)lds;
#pragma unroll
    for (int it = 0; it < 4; ++it) { const int q = tid + NTHREADS * it, n = q >> 3, c = q & 7;
        unsigned short e[8];
#pragma unroll
        for (int j = 0; j < 8; ++j) e[j] = T[(8 * c + j) * TPS + n];
        const int sn = t.n0 + n;
        if (sn < t.nvalid) { int dr = sn; if (t.gu) { const int isup = sn >= FF, jj = isup ? sn - FF : sn; dr = (jj >> 7) * 256 + isup * 128 + (jj & 127); }
            u32x4 o; o.x = e[0] | ((unsigned)e[1] << 16); o.y = e[2] | ((unsigned)e[3] << 16); o.z = e[4] | ((unsigned)e[5] << 16); o.w = e[6] | ((unsigned)e[7] << 16);
            *(u32x4*)(t.WT + (size_t)dr * t.K + t.k0 + 8 * c) = o; } }
}
constexpr int TI_IN = 16 * 8, TI_OUT = 16 * 4, TI_GU = 16 * 22, TI_DN = 44 * 4, TI_UQ = 3 * 2, TI_UKV = 2 * 2, TI_L = TI_IN + TI_OUT + TI_GU + TI_DN + TI_UQ + TI_UKV;
__device__ __forceinline__ TItem titem_make(const Ctx& C, int it) {
    const Params& p = C.p; const int l = it / TI_L; int r = it % TI_L; unsigned char* wl = C.wl(l); TItem t; t.gu = 0;
    if (r < TI_IN) { t.W = p.in[I_WIN] + (size_t)l * D * NP; t.WT = (bf16_t*)(wl + WL_IN); t.ldw = NP; t.K = D; t.k0 = (r >> 3) * 64; t.n0 = (r & 7) * 256; t.nvalid = NP; return t; } r -= TI_IN;
    if (r < TI_OUT) { t.W = p.in[I_WOUT] + (size_t)l * D * D; t.WT = (bf16_t*)(wl + WL_OUT); t.ldw = D; t.K = D; t.k0 = (r >> 2) * 64; t.n0 = (r & 3) * 256; t.nvalid = D; return t; } r -= TI_OUT;
    if (r < TI_GU) { t.W = p.in[I_WGU] + (size_t)l * D * 2 * FF; t.WT = (bf16_t*)(wl + WL_GU); t.ldw = 2 * FF; t.K = D; t.k0 = (r / 22) * 64; t.n0 = (r % 22) * 256; t.nvalid = 2 * FF; t.gu = 1; return t; } r -= TI_GU;
    if (r < TI_DN) { t.W = p.in[I_WDN] + (size_t)l * FF * D; t.WT = (bf16_t*)(wl + WL_DN); t.ldw = D; t.K = FF; t.k0 = (r >> 2) * 64; t.n0 = (r & 3) * 256; t.nvalid = D; return t; } r -= TI_DN;
    if (r < TI_UQ) { t.W = p.in[I_WUQ] + (size_t)l * 192 * 384; t.WT = (bf16_t*)(wl + WL_UQ); t.ldw = 384; t.K = 192; t.k0 = (r >> 1) * 64; t.n0 = (r & 1) * 256; t.nvalid = 384; return t; } r -= TI_UQ;
    t.W = p.in[I_WUKV] + (size_t)l * 128 * 512; t.WT = (bf16_t*)(wl + WL_UKV); t.ldw = 512; t.K = 128; t.k0 = (r >> 1) * 64; t.n0 = (r & 1) * 256; t.nvalid = 512; return t;
}

__device__ __forceinline__ void phase_prologue(const Ctx& C) {
    const Params& p = C.p;
    {
        const int NIT = 4 * TI_L;
        int it = C.bid; f32x4 v[8];
        TItem cur; if (it < NIT) { cur = titem_make(C, it); titem_load(cur, C.wave, C.lane, v); }
        while (it < NIT) {
            titem_stage(C.lds, C.wave, C.lane, v);
            const int nx = it + C.G; TItem nxt = cur; if (nx < NIT) { nxt = titem_make(C, nx); titem_load(nxt, C.wave, C.lane, v); }
            __syncthreads();
            titem_store(cur, C.lds, C.tid);
            __syncthreads();
            cur = nxt; it = nx;
        }
    }
    {
        LAS float* sc = (LAS float*)C.lds;
        LAS float* red = (LAS float*)(C.lds + 5 * 1024 * 4);
        const int ub = C.G - 1 - C.bid;
        if (ub < 96) {
            size_t za = 0, zb = 0; asm volatile("" : "+s"(za), "+s"(zb));
            const float* cctx = p.in[I_CCTX] + za; const float* cc_ = p.in[I_C] + zb;
            for (int i = C.tid; i < 5120; i += NTHREADS) { const int j = i >> 10, k = i & 1023; const float v = (j == 0) ? cctx[k] : cc_[(j - 1) * 1024 + k]; sc[i] = v / (1.f + __expf(-v)); }
            __syncthreads();
            for (int u = ub; u < 96; u += C.G) {
                const int l = u / 24, cb = u % 24;
                const float* w = p.in[I_WADA] + ((size_t)l * 1024 + C.wave * 128) * 6144 + cb * 256 + 4 * C.lane;
                f32x4 a0 = {0.f, 0.f, 0.f, 0.f}, a1 = a0, a2 = a0, a3 = a0, a4 = a0;
#pragma unroll 16
                for (int k = 0; k < 128; ++k) { const f32x4 wv = *(const f32x4*)(w + (size_t)k * 6144); const int kk = C.wave * 128 + k;
                    a0 += wv * sc[kk]; a1 += wv * sc[1024 + kk]; a2 += wv * sc[2048 + kk]; a3 += wv * sc[3072 + kk]; a4 += wv * sc[4096 + kk]; }
                LAS f32x4* rw = (LAS f32x4*)(red + C.wave * 1280) + C.lane;
                rw[0] = a0; rw[64] = a1; rw[128] = a2; rw[192] = a3; rw[256] = a4;
                __syncthreads();
                for (int i = C.tid; i < 1280; i += NTHREADS) { const int j = i >> 8, c2 = i & 255; float sum = p.in[I_BADA][l * 6144 + cb * 256 + c2];
#pragma unroll
                    for (int ww = 0; ww < 8; ++ww) sum += red[ww * 1280 + i];
                    ((float*)(C.ws + WS_MOD))[(size_t)(l * 5 + j) * 6144 + cb * 256 + c2] = sum; }
                __syncthreads();
            }
        }
        __syncthreads();
    }
    {
        const int gt = C.bid * NTHREADS + C.tid, GT = C.G * NTHREADS;
        for (int i = gt; i < 4 * 65536; i += GT) { const int l = i >> 16, e = i & 65535; ((bf16_t*)(C.wl(l) + WL_SP))[e] = (bf16_t)f2bf(p.in[I_SPW][i]); }
        for (int i = gt; i < 4 * 160 * 1024 / 2; i += GT) { const int l = i / (160 * 512), e = i % (160 * 512); ((unsigned*)(C.wl(l) + WL_IN + (size_t)NP * D * 2))[e] = 0u; }
        for (int i = gt; i < 128 * 64; i += GT) { const int m = i >> 6, c = i & 63; const int idx = ((m & 63) * c) & 63; const float a = (float)idx / 32.f;
            ((bf16_t*)(C.ws + WS_F64))[i] = (bf16_t)f2bf(m < 64 ? cospif(a) : sinpif(a)); }
        for (int i = gt; i < 64 * 128; i += GT) { const int k = i >> 7, K = i & 127; const int idx = (k * (K & 63)) & 63; const float a = (float)idx / 32.f; const float cv = cospif(a), sv = sinpif(a);
            ((bf16_t*)(C.ws + WS_T64R))[i] = (bf16_t)f2bf(K < 64 ? cv : -sv);
            ((bf16_t*)(C.ws + WS_T64I))[i] = (bf16_t)f2bf(K < 64 ? -sv : -cv);
            ((bf16_t*)(C.ws + WS_T64B))[i] = (bf16_t)f2bf(K < 64 ? cv : sv); }
        for (int i = gt; i < 256 * 512; i += GT) { const int k = i >> 9, K = i & 511; const int idx = (k * (K & 255)) & 255; const float a = (float)idx / 128.f;
            ((bf16_t*)(C.ws + WS_T256))[i] = (bf16_t)f2bf(K < 256 ? cospif(a) : -sinpif(a)); }
        for (int i = gt; i < 4096; i += GT) { const float a = (float)i / 2048.f; ((f32x2*)(C.ws + WS_TW))[i] = (f32x2){cospif(a), sinpif(a)}; }
        for (int i = gt; i < 512; i += GT) { const int pos = i >> 3, f = i & 7; const float inv = powf(10000.f, -(float)f / 8.f); const float ang = (float)pos * inv;
            ((f32x2*)(C.ws + WS_ROPE))[i] = (f32x2){cosf(ang), sinf(ang)}; }
    }
}

__device__ __forceinline__ void load_row_f32(const float* rowp, int lane, f32x4 (&v)[4]) {
#pragma unroll
    for (int j = 0; j < 4; ++j) v[j] = *(const f32x4*)(rowp + 4 * lane + 256 * j);
}
__device__ __forceinline__ void load_row_bf16(const bf16_t* rowp, int lane, f32x4 (&v)[4]) {
#pragma unroll
    for (int j = 0; j < 4; ++j) { const u32x2 w = *(const u32x2*)(rowp + 4 * lane + 256 * j); v[j] = (f32x4){bflo(w.x), bfhi(w.x), bflo(w.y), bfhi(w.y)}; }
}
__device__ __forceinline__ float row_rstd(const f32x4 (&v)[4], int lane) {
    float s = 0.f;
#pragma unroll
    for (int j = 0; j < 4; ++j) s += (v[j][0] * v[j][0] + v[j][1] * v[j][1]) + (v[j][2] * v[j][2] + v[j][3] * v[j][3]);
    return 1.f / sqrtf(wave_sum(s, lane) * (1.f / 1024.f) + EPS);
}
__device__ __forceinline__ void norm_mod_store(const f32x4 (&x)[4], const float* g, const float* scale, const float* shift, bf16_t* orow, int lane) {
    const float rs = row_rstd(x, lane);
#pragma unroll
    for (int j = 0; j < 4; ++j) { const int c = 4 * lane + 256 * j; const f32x4 gv = *(const f32x4*)(g + c), sv = *(const f32x4*)(scale + c), hv = *(const f32x4*)(shift + c);
        const f32x4 h = x[j] * rs * gv * (1.f + sv) + hv; *(u32x2*)(orow + c) = pk4(h); }
}
__device__ __forceinline__ const float* xin_row(const Ctx& C, int layer, int r) {
    if (layer > 0) return C.p.out + OUT_X + (size_t)r * D;
    size_t za = 0, zb = 0; asm volatile("" : "+s"(za), "+s"(zb));
    const float* a = C.p.in[I_XP] + za; const float* b = C.p.in[I_XS] + zb;
    return r < M_CTX ? a + (size_t)r * D : b + (size_t)(r - M_CTX) * D;
}
__device__ __forceinline__ void phase_norm0(const Ctx& C) {
    const int gw = C.bid * NWAVES + C.wave, NGW = C.G * NWAVES;
    bf16_t* H = (bf16_t*)(C.ws + WS_R1);
    f32x4 xn[4]; load_row_f32(xin_row(C, 0, gw), C.lane, xn);
    for (int r = gw; r < M; r += NGW) { f32x4 x[4];
#pragma unroll
        for (int j = 0; j < 4; ++j) x[j] = xn[j];
        if (r + NGW < M) load_row_f32(xin_row(C, 0, r + NGW), C.lane, xn);
        const int mi = mod_of_row(r);
        norm_mod_store(x, C.p.in[I_GPM], C.mod(0, mi, 1), C.mod(0, mi, 0), H + (size_t)r * D, C.lane); }
}
template <int which  > __device__ __forceinline__ void phase_post(const Ctx& C, int layer) {
    const int gw = C.bid * NWAVES + C.wave, NGW = C.G * NWAVES;
    const bf16_t* T = (const bf16_t*)(C.ws + (which == 0 ? WS_R2 : WS_MLA));
    bf16_t* H = (bf16_t*)(C.ws + WS_R1);
    const float* gpost = (which == 0 ? C.p.in[I_GPOM] : C.p.in[I_GPOF]) + layer * D;
    const bool do_next = (which == 0) || (layer + 1 < DEPTH);
    const int nl = which == 0 ? layer : layer + 1;
    const float* gnext = (which == 0 ? C.p.in[I_GPF] : C.p.in[I_GPM]) + (nl < DEPTH ? nl : 0) * D;
    f32x4 tn[4], xn[4];
    load_row_bf16(T + (size_t)gw * D, C.lane, tn); load_row_f32(which == 0 ? xin_row(C, layer, gw) : C.p.out + OUT_X + (size_t)gw * D, C.lane, xn);
    for (int r = gw; r < M; r += NGW) {
        const int mi = mod_of_row(r);
        f32x4 t[4], x[4];
#pragma unroll
        for (int j = 0; j < 4; ++j) { t[j] = tn[j]; x[j] = xn[j]; }
        if (r + NGW < M) { const int rn = r + NGW; load_row_bf16(T + (size_t)rn * D, C.lane, tn); load_row_f32(which == 0 ? xin_row(C, layer, rn) : C.p.out + OUT_X + (size_t)rn * D, C.lane, xn); }
        const float rs = row_rstd(t, C.lane); const float* gate = C.mod(layer, mi, which == 0 ? 2 : 5);
        float* xo = C.p.out + OUT_X + (size_t)r * D;
#pragma unroll
        for (int j = 0; j < 4; ++j) { const int c = 4 * C.lane + 256 * j; const f32x4 gv = *(const f32x4*)(gpost + c), ga = *(const f32x4*)(gate + c);
            x[j] = x[j] + ga * (t[j] * rs * gv); *(f32x4*)(xo + c) = x[j]; }
        if (do_next) norm_mod_store(x, gnext, C.mod(nl, mi, which == 0 ? 4 : 1), C.mod(nl, mi, which == 0 ? 3 : 0), H + (size_t)r * D, C.lane);
    }
}

__device__ __forceinline__ void unit_chunk_mlp(const Ctx& C, int layer, int u) {
    const int chunk = u >> 2, g = u & 3, r0 = chunk * 128;
    const bf16_t* PROJ = (const bf16_t*)(C.ws + WS_R2); bf16_t* MIX = (bf16_t*)(C.ws + WS_R1);
    constexpr int VS = 136;
    LAS bf16_t* Vt = (LAS bf16_t*)C.lds;
    { const int q = C.tid >> 2, c0 = (C.tid & 3) * 16; const bf16_t* src = PROJ + (size_t)(r0 + q) * NP + PC_V + g * 64 + c0;
      const bf16x8 v0 = *(const bf16x8*)src, v1 = *(const bf16x8*)(src + 8);
#pragma unroll
      for (int j = 0; j < 8; ++j) { Vt[(c0 + j) * VS + q] = (bf16_t)v0[j]; Vt[(c0 + 8 + j) * VS + q] = (bf16_t)v1[j]; } }
    __syncthreads();
    const int l15 = C.lane & 15, hq = C.lane >> 4, w = C.wave;
    const bf16_t* Wg = (const bf16_t*)(C.wl(layer) + WL_SP) + (size_t)g * 128 * 128;
    bf16x8 bw[4];
#pragma unroll
    for (int ks = 0; ks < 4; ++ks) bw[ks] = *(const bf16x8*)(Wg + (size_t)(w * 16 + l15) * 128 + ks * 32 + 8 * hq);
    const int p = w * 16 + l15; const float bias = C.p.in[I_SPB][(layer * 4 + g) * 128 + p];
#pragma unroll
    for (int ct = 0; ct < 4; ++ct) {
        f32x4 acc = {0.f, 0.f, 0.f, 0.f};
#pragma unroll
        for (int ks = 0; ks < 4; ++ks) { const bf16x8 a = *(const LAS bf16x8*)(Vt + (ct * 16 + l15) * VS + ks * 32 + 8 * hq); acc = mma16(a, bw[ks], acc); }
        const int cc = g * 64 + ct * 16 + 4 * hq; const u32x2 uw = *(const u32x2*)(PROJ + (size_t)(r0 + p) * NP + PC_U + cc);
        f32x4 o; o[0] = bflo(uw.x) * (acc[0] + bias); o[1] = bfhi(uw.x) * (acc[1] + bias); o[2] = bflo(uw.y) * (acc[2] + bias); o[3] = bfhi(uw.y) * (acc[3] + bias);
        *(u32x2*)(MIX + (size_t)(r0 + p) * D + cc) = pk4(o);
    }
    __syncthreads();
}
__device__ __forceinline__ void unit_conv(const Ctx& C, int layer, int u) {
    const bf16_t* PROJ = (const bf16_t*)(C.ws + WS_R2); bf16_t* MIX = (bf16_t*)(C.ws + WS_R1);
    const float* cw = C.p.in[I_CVW] + layer * 3 * 256; const float* cb = C.p.in[I_CVB] + layer * 256;
    for (int it = 0; it < 8; ++it) {
        const int item = it * NTHREADS + C.tid, t = item >> 5, ch = (item & 31) * 8, r = u * 128 + t;
        const int pos = r < M_CTX ? (r & 255) : ((r - M_CTX) & 4095), len = r < M_CTX ? 256 : 4096;
        const bf16_t* base = PROJ + (size_t)r * NP;
        const bf16x8 h1 = *(const bf16x8*)(base + PC_H + ch), c1 = *(const bf16x8*)(base + PC_C + ch), gb = *(const bf16x8*)(base + PC_B + ch);
        bf16x8 h0 = h1, c0 = c1, h2 = h1, c2 = c1; const bool hasp = pos > 0, hasn = pos < len - 1;
        if (hasp) { h0 = *(const bf16x8*)(base - NP + PC_H + ch); c0 = *(const bf16x8*)(base - NP + PC_C + ch); }
        if (hasn) { h2 = *(const bf16x8*)(base + NP + PC_H + ch); c2 = *(const bf16x8*)(base + NP + PC_C + ch); }
        float o[8];
#pragma unroll
        for (int j = 0; j < 8; ++j) {
            const float z0 = hasp ? bf1((bf16_t)h0[j]) * bf1((bf16_t)c0[j]) : 0.f, z1 = bf1((bf16_t)h1[j]) * bf1((bf16_t)c1[j]), z2 = hasn ? bf1((bf16_t)h2[j]) * bf1((bf16_t)c2[j]) : 0.f;
            const float y = z0 * cw[ch + j] + z1 * cw[256 + ch + j] + z2 * cw[512 + ch + j] + cb[ch + j];
            o[j] = bf1((bf16_t)gb[j]) * y; }
        u32x4 w; w.x = pk2(o[0], o[1]); w.y = pk2(o[2], o[3]); w.z = pk2(o[4], o[5]); w.w = pk2(o[6], o[7]);
        *(u32x4*)(MIX + (size_t)r * D + 256 + ch) = w;
    }
}
__device__ __forceinline__ void unit_fourier_ctx(const Ctx& C, int u) {
    const int s = u >> 2, g = u & 3, l15 = C.lane & 15, hq = C.lane >> 4, w = C.wave;
    const bf16_t* PROJ = (const bf16_t*)(C.ws + WS_R2); bf16_t* MIX = (bf16_t*)(C.ws + WS_R1);
    const bf16_t* F64 = (const bf16_t*)(C.ws + WS_F64); const bf16_t* T256 = (const bf16_t*)(C.ws + WS_T256);
    constexpr int ZS = 520; LAS bf16_t* Zt = (LAS bf16_t*)C.lds;
#pragma unroll
    for (int i = 0; i < 2; ++i) { const int nt = 2 * w + i;
        bf16x8 a[2];
#pragma unroll
        for (int ks = 0; ks < 2; ++ks) a[ks] = *(const bf16x8*)(PROJ + (size_t)(s * 256 + nt * 16 + l15) * NP + PC_F + g * 64 + ks * 32 + 8 * hq);
#pragma unroll
        for (int mt = 0; mt < 8; ++mt) { f32x4 acc = {0.f, 0.f, 0.f, 0.f};
#pragma unroll
            for (int ks = 0; ks < 2; ++ks) { const bf16x8 b = *(const bf16x8*)(F64 + (size_t)(mt * 16 + l15) * 64 + ks * 32 + 8 * hq); acc = mma16(a[ks], b, acc); }
            const int mp = mt * 16 + l15;
            *(LAS u32x2*)(Zt + (mp & 63) * ZS + (mp >> 6) * 256 + nt * 16 + 4 * hq) = pk4(acc); } }
    __syncthreads();
#pragma unroll 1
    for (int i = 0; i < 2; ++i) { const int kt = 2 * w + i;
        f32x4 acc[4];
#pragma unroll
        for (int mt = 0; mt < 4; ++mt) acc[mt] = (f32x4){0.f, 0.f, 0.f, 0.f};
#pragma unroll 8
        for (int ks = 0; ks < 16; ++ks) { const bf16x8 b = *(const bf16x8*)(T256 + (size_t)(kt * 16 + l15) * 512 + ks * 32 + 8 * hq);
#pragma unroll
            for (int mt = 0; mt < 4; ++mt) { const bf16x8 a = *(const LAS bf16x8*)(Zt + (mt * 16 + l15) * ZS + ks * 32 + 8 * hq); acc[mt] = mma16(a, b, acc[mt]); } }
#pragma unroll
        for (int mt = 0; mt < 4; ++mt) *(u32x2*)(MIX + (size_t)(s * 256 + kt * 16 + l15) * D + 512 + g * 64 + mt * 16 + 4 * hq) = pk4(acc[mt] * (1.f / 128.f)); }
    __syncthreads();
}
__device__ __forceinline__ void unit_fourier_lat1(const Ctx& C, int u) {
    const int b = u >> 5, g = (u >> 3) & 3, nb = u & 7, l15 = C.lane & 15, hq = C.lane >> 4, n2 = nb * 8 + C.wave;
    const bf16_t* PROJ = (const bf16_t*)(C.ws + WS_R2);
    const bf16_t* F64 = (const bf16_t*)(C.ws + WS_F64); const bf16_t* T64R = (const bf16_t*)(C.ws + WS_T64R); const bf16_t* T64I = (const bf16_t*)(C.ws + WS_T64I);
    const f32x2* TW = (const f32x2*)(C.ws + WS_TW);
    bf16_t* GB = (bf16_t*)(C.ws + WS_GB) + (size_t)((b * 4 + g) * 64 + n2) * 64 * 128;
    constexpr int ZS = 136; LAS bf16_t* Zt = (LAS bf16_t*)(C.lds + C.wave * (64 * ZS * 2));
#pragma unroll 2
    for (int nt = 0; nt < 4; ++nt) {
        bf16x8 a[2];
#pragma unroll
        for (int ks = 0; ks < 2; ++ks) a[ks] = *(const bf16x8*)(PROJ + (size_t)(M_CTX + b * 4096 + (nt * 16 + l15) * 64 + n2) * NP + PC_F + g * 64 + ks * 32 + 8 * hq);
#pragma unroll
        for (int mt = 0; mt < 8; ++mt) { f32x4 acc = {0.f, 0.f, 0.f, 0.f};
#pragma unroll
            for (int ks = 0; ks < 2; ++ks) { const bf16x8 bb = *(const bf16x8*)(F64 + (size_t)(mt * 16 + l15) * 64 + ks * 32 + 8 * hq); acc = mma16(a[ks], bb, acc); }
            const int mp = mt * 16 + l15;
            *(LAS u32x2*)(Zt + (mp & 63) * ZS + (mp >> 6) * 64 + nt * 16 + 4 * hq) = pk4(acc); } }
    asm volatile("s_waitcnt lgkmcnt(0)" ::: "memory");
#pragma unroll 2
    for (int kt = 0; kt < 4; ++kt) {
        bf16x8 br[4], bi[4];
#pragma unroll
        for (int ks = 0; ks < 4; ++ks) { br[ks] = *(const bf16x8*)(T64R + (size_t)(kt * 16 + l15) * 128 + ks * 32 + 8 * hq); bi[ks] = *(const bf16x8*)(T64I + (size_t)(kt * 16 + l15) * 128 + ks * 32 + 8 * hq); }
        const int k1 = kt * 16 + l15; const f32x2 tw = TW[k1 * n2];
#pragma unroll
        for (int mt = 0; mt < 4; ++mt) { f32x4 ar = {0.f, 0.f, 0.f, 0.f}, ai = {0.f, 0.f, 0.f, 0.f};
#pragma unroll
            for (int ks = 0; ks < 4; ++ks) { const bf16x8 a = *(const LAS bf16x8*)(Zt + (mt * 16 + l15) * ZS + ks * 32 + 8 * hq); ar = mma16(a, br[ks], ar); ai = mma16(a, bi[ks], ai); }
            const f32x4 gr = ar * tw[0] + ai * tw[1], gi = ai * tw[0] - ar * tw[1];
            bf16_t* dst = GB + (size_t)k1 * 128 + mt * 16 + 4 * hq;
            *(u32x2*)dst = pk4(gr); *(u32x2*)(dst + 64) = pk4(gi); } }
    __syncthreads();
}
__device__ __forceinline__ void unit_fourier_lat2(const Ctx& C, int u) {
    const int b = u >> 5, g = (u >> 3) & 3, kb = u & 7, l15 = C.lane & 15, hq = C.lane >> 4, k1 = kb * 8 + C.wave;
    const bf16_t* T64B = (const bf16_t*)(C.ws + WS_T64B); bf16_t* MIX = (bf16_t*)(C.ws + WS_R1);
    const bf16_t* GB = (const bf16_t*)(C.ws + WS_GB) + (size_t)((b * 4 + g) * 64) * 64 * 128 + (size_t)k1 * 128;
    constexpr int ZS = 136; LAS bf16_t* Tt = (LAS bf16_t*)(C.lds + C.wave * (64 * ZS * 2));
#pragma unroll 4
    for (int it = 0; it < 16; ++it) { const int q = it * 64 + C.lane, n2 = q >> 4, cc = q & 15, part = cc >> 3, m0 = (cc & 7) * 8;
        const bf16x8 v = *(const bf16x8*)(GB + (size_t)n2 * 64 * 128 + cc * 8);
#pragma unroll
        for (int j = 0; j < 8; ++j) Tt[(m0 + j) * ZS + part * 64 + n2] = (bf16_t)v[j]; }
    asm volatile("s_waitcnt lgkmcnt(0)" ::: "memory");
#pragma unroll 2
    for (int kt = 0; kt < 4; ++kt) {
        bf16x8 bb[4];
#pragma unroll
        for (int ks = 0; ks < 4; ++ks) bb[ks] = *(const bf16x8*)(T64B + (size_t)(kt * 16 + l15) * 128 + ks * 32 + 8 * hq);
        const int k2 = kt * 16 + l15; const int row = M_CTX + b * 4096 + k1 + 64 * k2;
#pragma unroll
        for (int mt = 0; mt < 4; ++mt) { f32x4 acc = {0.f, 0.f, 0.f, 0.f};
#pragma unroll
            for (int ks = 0; ks < 4; ++ks) { const bf16x8 a = *(const LAS bf16x8*)(Tt + (mt * 16 + l15) * ZS + ks * 32 + 8 * hq); acc = mma16(a, bb[ks], acc); }
            *(u32x2*)(MIX + (size_t)row * D + 512 + g * 64 + mt * 16 + 4 * hq) = pk4(acc * (1.f / 512.f)); } }
    __syncthreads();
}
constexpr float QSCALE = 0.10206207261596577f * 1.4426950408889634f;
__device__ __forceinline__ void unit_mla_prep(const Ctx& C, int layer, int u) {
    const Params& p = C.p;
    const bf16_t* PROJ = (const bf16_t*)(C.ws + WS_R2);
    bf16_t* Q = (bf16_t*)(C.ws + WS_Q); bf16_t* KN = (bf16_t*)(C.ws + WS_KN); bf16_t* VT = (bf16_t*)(C.ws + WS_VT); bf16_t* KR = (bf16_t*)(C.ws + WS_KR);
    const f32x2* ROPE = (const f32x2*)(C.ws + WS_ROPE);
    constexpr int QS = 200, KS = 136;
    LAS bf16_t* CQ = (LAS bf16_t*)C.lds;
    LAS bf16_t* CK = (LAS bf16_t*)(C.lds + 128 * QS * 2);
    const bool is_tok = u < 192;
    int r0 = 0, keyrow0, keypos0, nk; size_t vtbase; bool lat;
    if (is_tok) { r0 = u * 128; lat = r0 >= M_CTX;
        if (!lat) { keyrow0 = r0; keypos0 = r0 & 255; nk = 256; vtbase = (size_t)(r0 & ~255) * 256; }
        else { const int b = (r0 - M_CTX) >> 12, n = (r0 - M_CTX) & 4095; keyrow0 = M_CTX + b * 4352 + n; keypos0 = n; nk = 4352; vtbase = (size_t)(M_CTX + b * 4352) * 256; } }
    else { const int cu = u - 192, b = cu >> 1, half = cu & 1; lat = true; keyrow0 = M_CTX + b * 4352 + 4096 + half * 128; keypos0 = 4096 + half * 128; nk = 4352; vtbase = (size_t)(M_CTX + b * 4352) * 256; }
    { const int t = C.tid >> 2, sub = C.tid & 3;
      if (is_tok) {
        const int r = r0 + t; const bf16_t* base = PROJ + (size_t)r * NP;
        float q[48], k[32]; float sq = 0.f, sk = 0.f;
#pragma unroll
        for (int i = 0; i < 6; ++i) { const bf16x8 v = *(const bf16x8*)(base + PC_Q + sub * 48 + i * 8);
#pragma unroll
            for (int j = 0; j < 8; ++j) { q[i * 8 + j] = bf1((bf16_t)v[j]); sq += q[i * 8 + j] * q[i * 8 + j]; } }
#pragma unroll
        for (int i = 0; i < 4; ++i) { const bf16x8 v = *(const bf16x8*)(base + PC_KV + sub * 32 + i * 8);
#pragma unroll
            for (int j = 0; j < 8; ++j) { k[i * 8 + j] = bf1((bf16_t)v[j]); sk += k[i * 8 + j] * k[i * 8 + j]; } }
        sq += shx<1>(sq, C.lane); sq += shx<2>(sq, C.lane); sk += shx<1>(sk, C.lane); sk += shx<2>(sk, C.lane);
        const float rq = 1.f / sqrtf(sq * (1.f / 192.f) + EPS), rk = 1.f / sqrtf(sk * (1.f / 128.f) + EPS);
        const float* gq = p.in[I_GQ] + layer * 192 + sub * 48; const float* gk = p.in[I_GKV] + layer * 128 + sub * 32;
#pragma unroll
        for (int i = 0; i < 6; ++i) { u32x4 w; w.x = pk2(q[i * 8 + 0] * rq * gq[i * 8 + 0], q[i * 8 + 1] * rq * gq[i * 8 + 1]); w.y = pk2(q[i * 8 + 2] * rq * gq[i * 8 + 2], q[i * 8 + 3] * rq * gq[i * 8 + 3]);
            w.z = pk2(q[i * 8 + 4] * rq * gq[i * 8 + 4], q[i * 8 + 5] * rq * gq[i * 8 + 5]); w.w = pk2(q[i * 8 + 6] * rq * gq[i * 8 + 6], q[i * 8 + 7] * rq * gq[i * 8 + 7]);
            *(LAS u32x4*)(CQ + t * QS + sub * 48 + i * 8) = w; }
        float* sckv = nullptr;
        if (!lat) { const int s = r >> 8, pos = r & 255; sckv = p.out + OUT_CKV + ((size_t)(s * 4 + layer) * 256 + pos) * 128 + sub * 32; }
#pragma unroll
        for (int i = 0; i < 4; ++i) { float o[8];
#pragma unroll
            for (int j = 0; j < 8; ++j) o[j] = k[i * 8 + j] * rk * gk[i * 8 + j];
            u32x4 w; w.x = pk2(o[0], o[1]); w.y = pk2(o[2], o[3]); w.z = pk2(o[4], o[5]); w.w = pk2(o[6], o[7]);
            *(LAS u32x4*)(CK + t * KS + sub * 32 + i * 8) = w;
            if (!lat) { *(f32x4*)(sckv + i * 8) = (f32x4){o[0], o[1], o[2], o[3]}; *(f32x4*)(sckv + i * 8 + 4) = (f32x4){o[4], o[5], o[6], o[7]}; } }
        { const bf16x8 v = *(const bf16x8*)(base + PC_KR + sub * 8); float x[8], o[8];
#pragma unroll
          for (int j = 0; j < 8; ++j) x[j] = bf1((bf16_t)v[j]);
          if (lat) { const int n = (r - M_CTX) & 4095; const int pos = (sub >> 1) == 0 ? (n >> 6) : (n & 63);
#pragma unroll
              for (int j = 0; j < 8; ++j) { const float pr = shx<1>(x[j], C.lane); const f32x2 cs = ROPE[pos * 8 + j]; o[j] = (sub & 1) == 0 ? x[j] * cs[0] - pr * cs[1] : x[j] * cs[0] + pr * cs[1]; } }
          else {
#pragma unroll
              for (int j = 0; j < 8; ++j) o[j] = x[j];
              const int s = r >> 8, pos = r & 255; float* skr = p.out + OUT_KR + ((size_t)(s * 4 + layer) * 256 + pos) * 32 + sub * 8;
              *(f32x4*)skr = (f32x4){o[0], o[1], o[2], o[3]}; *(f32x4*)(skr + 4) = (f32x4){o[4], o[5], o[6], o[7]}; }
          u32x4 w; w.x = pk2(o[0], o[1]); w.y = pk2(o[2], o[3]); w.z = pk2(o[4], o[5]); w.w = pk2(o[6], o[7]);
          *(u32x4*)(KR + (size_t)(keyrow0 + t) * 32 + sub * 8) = w; }
      } else {
        const int cu = u - 192, b = cu >> 1, half = cu & 1, row = half * 128 + t;
        const float* src = p.in[I_CCKV] + ((size_t)(b * 4 + layer) * 256 + row) * 128 + sub * 32;
#pragma unroll
        for (int i = 0; i < 4; ++i) { const f32x4 v0 = *(const f32x4*)(src + i * 8), v1 = *(const f32x4*)(src + i * 8 + 4);
            u32x4 w; w.x = pk2(v0[0], v0[1]); w.y = pk2(v0[2], v0[3]); w.z = pk2(v1[0], v1[1]); w.w = pk2(v1[2], v1[3]);
            *(LAS u32x4*)(CK + t * KS + sub * 32 + i * 8) = w; }
        const float* ksrc = p.in[I_CKR] + ((size_t)(b * 4 + layer) * 256 + row) * 32 + sub * 8;
        const f32x4 v0 = *(const f32x4*)ksrc, v1 = *(const f32x4*)(ksrc + 4);
        u32x4 w; w.x = pk2(v0[0], v0[1]); w.y = pk2(v0[2], v0[3]); w.z = pk2(v1[0], v1[1]); w.w = pk2(v1[2], v1[3]);
        *(u32x4*)(KR + (size_t)(keyrow0 + t) * 32 + sub * 8) = w;
      } }
    __syncthreads();
    const int l15 = C.lane & 15, hq = C.lane >> 4, w = C.wave;
    if (is_tok) {
        const bf16_t* Wq = (const bf16_t*)(C.wl(layer) + WL_UQ);
        bf16x8 aq[3][6];
#pragma unroll
        for (int j = 0; j < 3; ++j)
#pragma unroll
            for (int ks = 0; ks < 6; ++ks) aq[j][ks] = *(const bf16x8*)(Wq + (size_t)((3 * w + j) * 16 + l15) * 192 + ks * 32 + 8 * hq);
#pragma unroll 2
        for (int tt = 0; tt < 8; ++tt) {
            bf16x8 bq[6];
#pragma unroll
            for (int ks = 0; ks < 6; ++ks) bq[ks] = *(const LAS bf16x8*)(CQ + (tt * 16 + l15) * QS + ks * 32 + 8 * hq);
            const int r = r0 + tt * 16 + l15; const int n = (r - M_CTX) & 4095;
#pragma unroll
            for (int j = 0; j < 3; ++j) { const int nt = 3 * w + j; f32x4 acc = {0.f, 0.f, 0.f, 0.f};
#pragma unroll
                for (int ks = 0; ks < 6; ++ks) acc = mma16(aq[j][ks], bq[ks], acc);
                const int sub6 = nt % 6;
                if (lat && sub6 >= 4) { const int pos = sub6 == 4 ? (n >> 6) : (n & 63);
#pragma unroll
                    for (int jj = 0; jj < 4; ++jj) { const float pr = shx<32>(acc[jj], C.lane); const f32x2 cs = ROPE[pos * 8 + ((4 * hq + jj) & 7)]; acc[jj] = hq < 2 ? acc[jj] * cs[0] - pr * cs[1] : acc[jj] * cs[0] + pr * cs[1]; } }
                *(u32x2*)(Q + (size_t)r * 384 + nt * 16 + 4 * hq) = pk4(acc * QSCALE); }
        }
    }
    { const bf16_t* Wkv = (const bf16_t*)(C.wl(layer) + WL_UKV);
      bf16x8 wf[4][4];
#pragma unroll
      for (int j = 0; j < 4; ++j)
#pragma unroll
          for (int ks = 0; ks < 4; ++ks) wf[j][ks] = *(const bf16x8*)(Wkv + (size_t)((4 * w + j) * 16 + l15) * 128 + ks * 32 + 8 * hq);
      const int h = w >> 1; const bool isv = (w & 1) != 0;
#pragma unroll 2
      for (int tt = 0; tt < 8; ++tt) {
          bf16x8 ck[4];
#pragma unroll
          for (int ks = 0; ks < 4; ++ks) ck[ks] = *(const LAS bf16x8*)(CK + (tt * 16 + l15) * KS + ks * 32 + 8 * hq);
#pragma unroll
          for (int j = 0; j < 4; ++j) { f32x4 acc = {0.f, 0.f, 0.f, 0.f};
              if (!isv) {
#pragma unroll
                  for (int ks = 0; ks < 4; ++ks) acc = mma16(wf[j][ks], ck[ks], acc);
                  *(u32x2*)(KN + (size_t)(keyrow0 + tt * 16 + l15) * 256 + h * 64 + j * 16 + 4 * hq) = pk4(acc);
              } else {
#pragma unroll
                  for (int ks = 0; ks < 4; ++ks) acc = mma16(ck[ks], wf[j][ks], acc);
                  *(u32x2*)(VT + vtbase + (size_t)(h * 64 + j * 16 + l15) * nk + keypos0 + tt * 16 + 4 * hq) = pk4(acc);
              } } } }
    __syncthreads();
}

constexpr int AKS = 104, AVS = 72;
constexpr int AKB = 64 * AKS * 2, AVB = 64 * AVS * 2;
constexpr float ATT_THR = 8.f;
__device__ __forceinline__ void attn_qk(const LAS unsigned char* Kb, const bf16x8 (&qf)[6], int l31, int hh, f32x16& s0, f32x16& s1) {
    const LAS bf16_t* Kl = (const LAS bf16_t*)Kb;
#pragma unroll
    for (int i = 0; i < 16; ++i) { s0[i] = 0.f; s1[i] = 0.f; }
#pragma unroll
    for (int third = 0; third < 3; ++third) {
        bf16x8 ka[2][2];
#pragma unroll
        for (int k2 = 0; k2 < 2; ++k2) { const int ks = 2 * third + k2; ka[0][k2] = *(const LAS bf16x8*)(Kl + l31 * AKS + ks * 16 + 8 * hh); ka[1][k2] = *(const LAS bf16x8*)(Kl + (32 + l31) * AKS + ks * 16 + 8 * hh); }
        __builtin_amdgcn_sched_barrier(0);
#pragma unroll
        for (int k2 = 0; k2 < 2; ++k2) { const int ks = 2 * third + k2; s0 = mma32(ka[0][k2], qf[ks], s0); s1 = mma32(ka[1][k2], qf[ks], s1); }
        __builtin_amdgcn_sched_barrier(0);
    }
}
__device__ __forceinline__ void attn_softmax_pv(const LAS unsigned char* Vb, f32x16& s0, f32x16& s1, f32x16& o0, f32x16& o1, float& mrun, float& lsum, int l31, int hh) {
    const LAS bf16_t* Vl = (const LAS bf16_t*)Vb;
    u32x2 vr[2][4];
#pragma unroll
    for (int ss = 0; ss < 2; ++ss) { const int ko = 16 * ss + 4 * hh;
        vr[ss][0] = *(const LAS u32x2*)(Vl + l31 * AVS + ko); vr[ss][1] = *(const LAS u32x2*)(Vl + l31 * AVS + ko + 8);
        vr[ss][2] = *(const LAS u32x2*)(Vl + (32 + l31) * AVS + ko); vr[ss][3] = *(const LAS u32x2*)(Vl + (32 + l31) * AVS + ko + 8); }
    __builtin_amdgcn_sched_barrier(0);
    float mx = fmaxf(s0[0], s1[0]);
#pragma unroll
    for (int i = 1; i < 16; ++i) mx = fmaxf(mx, fmaxf(s0[i], s1[i]));
    mx = fmaxf(mx, shx<32>(mx, l31 + 32 * hh));
    if (__builtin_amdgcn_ballot_w64(mx > mrun + ATT_THR) != 0ull) { const float mnew = fmaxf(mrun, mx); const float alpha = __builtin_amdgcn_exp2f(mrun - mnew); lsum *= alpha; o0 = o0 * alpha; o1 = o1 * alpha; mrun = mnew; }
    float ps = 0.f;
#pragma unroll
    for (int i = 0; i < 16; ++i) { s0[i] = __builtin_amdgcn_exp2f(s0[i] - mrun); s1[i] = __builtin_amdgcn_exp2f(s1[i] - mrun); ps += s0[i] + s1[i]; }
    lsum += ps;
#pragma unroll
    for (int t = 0; t < 2; ++t) {
        bf16x8 pf[2];
#pragma unroll
        for (int ss = 0; ss < 2; ++ss) { u32x4 w;
            if (t == 0) { w.x = pk2(s0[8 * ss + 0], s0[8 * ss + 1]); w.y = pk2(s0[8 * ss + 2], s0[8 * ss + 3]); w.z = pk2(s0[8 * ss + 4], s0[8 * ss + 5]); w.w = pk2(s0[8 * ss + 6], s0[8 * ss + 7]); }
            else { w.x = pk2(s1[8 * ss + 0], s1[8 * ss + 1]); w.y = pk2(s1[8 * ss + 2], s1[8 * ss + 3]); w.z = pk2(s1[8 * ss + 4], s1[8 * ss + 5]); w.w = pk2(s1[8 * ss + 6], s1[8 * ss + 7]); }
            pf[ss] = __builtin_bit_cast(bf16x8, w); }
#pragma unroll
        for (int ss = 0; ss < 2; ++ss) {
            const bf16x8 va = __builtin_bit_cast(bf16x8, (u32x4){vr[ss][0].x, vr[ss][0].y, vr[ss][1].x, vr[ss][1].y}), vb = __builtin_bit_cast(bf16x8, (u32x4){vr[ss][2].x, vr[ss][2].y, vr[ss][3].x, vr[ss][3].y});
            o0 = mma32(va, pf[ss], o0); o1 = mma32(vb, pf[ss], o1); }
        if (t == 0) {
#pragma unroll
            for (int ss = 0; ss < 2; ++ss) { const int ko = 32 + 16 * ss + 4 * hh;
                vr[ss][0] = *(const LAS u32x2*)(Vl + l31 * AVS + ko); vr[ss][1] = *(const LAS u32x2*)(Vl + l31 * AVS + ko + 8);
                vr[ss][2] = *(const LAS u32x2*)(Vl + (32 + l31) * AVS + ko); vr[ss][3] = *(const LAS u32x2*)(Vl + (32 + l31) * AVS + ko + 8); } }
    }
    __builtin_amdgcn_sched_barrier(0);
}
__device__ __forceinline__ void unit_attention(const Ctx& C, int u) {
    int rowbase, keyrow0, nk, h; size_t vtbase;
    if (u < 128) { const int s = u >> 2; h = u & 3; rowbase = s * 256; keyrow0 = s * 256; nk = 256; vtbase = (size_t)(s * 256) * 256; }
    else { const int v0 = u - 128; const int v = (C.G == 256) ? (((v0 & 7) * 2 + (v0 >> 7)) << 4) | ((v0 >> 3) & 15) : v0;
           const int b = v >> 6, qb = v & 15; h = (v >> 4) & 3; rowbase = M_CTX + b * 4096 + qb * 256; keyrow0 = M_CTX + b * 4352; nk = 4352; vtbase = (size_t)keyrow0 * 256; }
    const bf16_t* Q = (const bf16_t*)(C.ws + WS_Q); const bf16_t* KN = (const bf16_t*)(C.ws + WS_KN); const bf16_t* VT = (const bf16_t*)(C.ws + WS_VT); const bf16_t* KR = (const bf16_t*)(C.ws + WS_KR);
    bf16_t* MIX = (bf16_t*)(C.ws + WS_R1);
    const int l31 = C.lane & 31, hh = C.lane >> 5; const int qrow = rowbase + C.wave * 32 + l31;
    bf16x8 qf[6];
#pragma unroll
    for (int ks = 0; ks < 6; ++ks) qf[ks] = *(const bf16x8*)(Q + (size_t)qrow * 384 + h * 96 + ks * 16 + 8 * hh);
    f32x16 o0, o1;
#pragma unroll
    for (int i = 0; i < 16; ++i) { o0[i] = 0.f; o1[i] = 0.f; }
    float mrun = -1e30f, lsum = 0.f;
    const int skey = C.tid >> 3, sc8 = (C.tid & 7) * 8, rkey = (C.tid & 255) >> 2, rc8 = (C.tid & 3) * 8;
    const bf16_t* bkn = KN + (size_t)keyrow0 * 256 + h * 64; const bf16_t* bkr = KR + (size_t)keyrow0 * 32; const bf16_t* bvt = VT + vtbase + (size_t)(h * 64) * nk;
    const unsigned okn = skey * 256 + sc8, okr = rkey * 32 + rc8, ovt = skey * nk + sc8;
    const bool do_r = C.tid < 256;
    const int lkn = (skey * AKS + sc8) * 2, lkr = (rkey * AKS + 64 + rc8) * 2, lvt = (skey * AVS + sc8) * 2;
    LAS unsigned char* KB = C.lds; LAS unsigned char* VB = C.lds + 2 * AKB;
    const int ntile = nk >> 6;
    u32x4 rk, rr = {0u, 0u, 0u, 0u}, rv;
#define ATT_LDK(t) do { rk = *(const u32x4*)(bkn + (size_t)(t) * 64 * 256 + okn); if (do_r) rr = *(const u32x4*)(bkr + (size_t)(t) * 64 * 32 + okr); } while (0)
#define ATT_LDV(t) do { rv = *(const u32x4*)(bvt + (size_t)(t) * 64 + ovt); } while (0)
#define ATT_STK(t) do { LAS unsigned char* b_ = KB + ((t) & 1) * AKB; *(LAS u32x4*)(b_ + lkn) = rk; if (do_r) *(LAS u32x4*)(b_ + lkr) = rr; } while (0)
#define ATT_STV(t) do { *(LAS u32x4*)(VB + ((t) & 1) * AVB + lvt) = rv; } while (0)
    ATT_LDK(0); ATT_LDV(0); ATT_STK(0); ATT_STV(0); ATT_LDK(1); ATT_STK(1);
    __syncthreads();
    f32x16 sa0, sa1, sb0, sb1;
    const bool grpB = C.wave >= 4;
    attn_qk(KB, qf, l31, hh, sa0, sa1);
#define ATT_STEP(kt, SC0, SC1, SN0, SN1, ORDER_B) do { \
        const bool k2_ = (kt) + 2 < ntile, v1_ = (kt) + 1 < ntile; \
        if (k2_) ATT_LDK((kt) + 2); if (v1_) ATT_LDV((kt) + 1); \
        if (!(ORDER_B)) { if (v1_) attn_qk(KB + (((kt) + 1) & 1) * AKB, qf, l31, hh, SN0, SN1); \
                          attn_softmax_pv(VB + ((kt) & 1) * AVB, SC0, SC1, o0, o1, mrun, lsum, l31, hh); } \
        else            { attn_softmax_pv(VB + ((kt) & 1) * AVB, SC0, SC1, o0, o1, mrun, lsum, l31, hh); \
                          if (v1_) attn_qk(KB + (((kt) + 1) & 1) * AKB, qf, l31, hh, SN0, SN1); } \
        if (k2_) ATT_STK((kt) + 2); if (v1_) ATT_STV((kt) + 1); \
        __syncthreads(); } while (0)
    if (!grpB) {
#pragma unroll 1
        for (int kt = 0; kt < ntile; kt += 2) { ATT_STEP(kt, sa0, sa1, sb0, sb1, false); ATT_STEP(kt + 1, sb0, sb1, sa0, sa1, false); }
    } else {
#pragma unroll 1
        for (int kt = 0; kt < ntile; kt += 2) { ATT_STEP(kt, sa0, sa1, sb0, sb1, true); ATT_STEP(kt + 1, sb0, sb1, sa0, sa1, true); }
    }
#undef ATT_STEP
#undef ATT_LDK
#undef ATT_LDV
#undef ATT_STK
#undef ATT_STV
    lsum += shx<32>(lsum, C.lane);
    const float inv = 1.f / lsum;
    int w2 = C.wave_s; asm volatile("" : "+s"(w2)); int l2 = opaque_lane(); asm volatile("" : "+v"(l2));
    const int hh2 = l2 >> 5; size_t z2 = 0; asm volatile("" : "+s"(z2));
    bf16_t* orow = (bf16_t*)(C.p.ws + z2 + WS_R1) + (size_t)(rowbase + w2 * 32 + (l2 & 31)) * D + 768 + h * 64;
#pragma unroll
    for (int i = 0; i < 4; ++i) { const int dv = 8 * i + 4 * hh2;
        *(u32x2*)(orow + dv) = pk4((f32x4){o0[4 * i] * inv, o0[4 * i + 1] * inv, o0[4 * i + 2] * inv, o0[4 * i + 3] * inv});
        *(u32x2*)(orow + 32 + dv) = pk4((f32x4){o1[4 * i] * inv, o1[4 * i + 1] * inv, o1[4 * i + 2] * inv, o1[4 * i + 3] * inv}); }
}

#define XB_TMO      128
#define XB_XCNT(j)  (256  + 64 * (j))
#define XB_XSUB(j)  (1280 + 64 * (j))
#define XB_XGEN(j)  (2304 + 64 * (j))
#define XB_TOP      3328
#define XB_TOPGEN   3392
#define XCD_BAR_WORDS 3456
#define XB_SPIN_CAP (1u << 18)

__device__ __forceinline__ unsigned xb_ld(unsigned* p)              { return __hip_atomic_load(p, __ATOMIC_RELAXED, __HIP_MEMORY_SCOPE_AGENT); }
__device__ __forceinline__ unsigned xb_add(unsigned* p, unsigned v) { return __hip_atomic_fetch_add(p, v, __ATOMIC_RELAXED, __HIP_MEMORY_SCOPE_AGENT); }
__device__ __forceinline__ unsigned xb_xcc_id() { return (unsigned)__builtin_amdgcn_s_getreg((3 << 11) | 20) & 0xFu; }
#define XB_SPIN(cond, bar) do { unsigned _sp = 0; while (cond) { __builtin_amdgcn_s_sleep(1); \
    if ((++_sp & 255u) == 0u) { if (xb_ld(&(bar)[XB_TMO])) break; if (_sp > XB_SPIN_CAP) { atomicAdd(&(bar)[XB_TMO], 1u); break; } } } } while (0)

struct XcdBarrier {
    unsigned* bar; unsigned x; bool t0;
    volatile LAS unsigned* st;
};

__device__ __forceinline__ XcdBarrier xcd_barrier_post(unsigned* bar, volatile LAS unsigned* st) {
    XcdBarrier b; b.bar = bar; b.x = xb_xcc_id(); b.st = st;
    if (threadIdx.x == 0) (void)xb_add(&bar[XB_XCNT(b.x)], 1u);
    return b;
}
__device__ __forceinline__ void xcd_barrier_complete(unsigned* bar, unsigned x, unsigned& nloc, unsigned& nx) {
    const unsigned G = gridDim.x * gridDim.y * gridDim.z;
    unsigned sum, cnt, mine, sp = 0u;
    for (;;) {
        sum = 0u; cnt = 0u; mine = 0u;
#pragma unroll
        for (unsigned j = 0; j < 16; ++j) { const unsigned c = xb_ld(&bar[XB_XCNT(j)]); sum += c; cnt += (c > 0u) ? 1u : 0u; mine = (j == x) ? c : mine; }
        if (sum == G) break;
        __builtin_amdgcn_s_sleep(1);
        if ((++sp & 255u) == 0u) { if (xb_ld(&bar[XB_TMO])) break; if (sp > XB_SPIN_CAP) { atomicAdd(&bar[XB_TMO], 1u); break; } }
    }
    nloc = mine > 0u ? mine : 1u; nx = cnt > 0u ? cnt : 1u;
}

__device__ __forceinline__ void xcd_barrier(const XcdBarrier& b) {
    asm volatile("s_waitcnt vmcnt(0)" ::: "memory");
    __syncthreads();
    if (b.t0) {
        unsigned* bar = b.bar;
        __builtin_amdgcn_s_waitcnt(0);
        unsigned nloc = b.st[0], nx = b.st[1];
        if (nloc == 0u) { xcd_barrier_complete(bar, b.x, nloc, nx); b.st[0] = nloc; b.st[1] = nx; }
        const unsigned old = xb_add(&bar[XB_XSUB(b.x)], 1u);
        const unsigned gen = old / nloc;
        if (old + 1u == (gen + 1u) * nloc) {
            __builtin_amdgcn_fence(__ATOMIC_RELEASE, "agent");
            asm volatile("s_waitcnt vmcnt(0)" ::: "memory");
            const unsigned og = xb_add(&bar[XB_TOP], 1u);
            const unsigned tg = og / nx;
            if (og + 1u == (tg + 1u) * nx) xb_add(&bar[XB_TOPGEN], 1u);
            else XB_SPIN(xb_ld(&bar[XB_TOPGEN]) == tg, bar);
            __builtin_amdgcn_fence(__ATOMIC_ACQUIRE, "agent");
            xb_add(&bar[XB_XGEN(b.x)], 1u);
            asm volatile("s_waitcnt vmcnt(0)" ::: "memory");
        } else {
            XB_SPIN(xb_ld(&bar[XB_XGEN(b.x)]) == gen, bar);
            __builtin_amdgcn_fence(__ATOMIC_ACQUIRE, "agent");
            asm volatile("s_waitcnt vmcnt(0)" ::: "memory");
        }
    }
    __syncthreads();
}

__global__ void __launch_bounds__(NTHREADS, 2) mk_fwd(Params p) {
    extern __shared__ __attribute__((aligned(16))) unsigned char lds_raw[];
    cg::grid_group grid = cg::this_grid();
    Ctx C; C.p = p; C.lds = (LAS unsigned char*)lds_raw; C.tid = threadIdx.x; C.lane = C.tid & 63; C.wave = __builtin_amdgcn_readfirstlane(C.tid >> 6); C.wave_s = C.wave; C.bid = blockIdx.x; C.G = gridDim.x; C.ws = p.ws;

    volatile LAS unsigned* bst = (volatile LAS unsigned*)(C.lds + LDS_BYTES - 64);
    if (threadIdx.x < 2) bst[threadIdx.x] = 0u;
    __syncthreads();
    (void)xcd_barrier_post((unsigned*)(p.ws + WS_BAR), bst);
#define GRID_BAR() do { XcdBarrier b_; b_.bar = (unsigned*)(p.ws + WS_BAR); b_.x = xb_xcc_id(); C.refresh(); b_.t0 = (C.tid == 0); b_.st = (volatile LAS unsigned*)((LAS unsigned char*)lds_raw + LDS_BYTES - 64); xcd_barrier(b_); } while (0)
    C.refresh(); phase_prologue(C);
    grid.sync();
    C.refresh(); phase_norm0(C);
    GRID_BAR();
#pragma unroll 1
    for (int layer = 0; layer < DEPTH; ++layer) {
        { C.refresh(); bf16_t* R1 = (bf16_t*)(C.ws + WS_R1); bf16_t* R2 = (bf16_t*)(C.ws + WS_R2); unsigned char* wl = C.wl(layer); pg8::Gemm g{R1, (const bf16_t*)(wl + WL_IN), M, NPP, D, C.wave_s}; pg8::StaticOrder S; S.init(M, NPP, C.G, C.bid); pg8::EpiStore E{R2, NP, NP};
          pg8::gemm_phase<pg8::EpiStore, pg8::StaticOrder, true, true>(C.lds, g, S, E); }
        GRID_BAR();
        C.refresh();
        for (int u = C.bid; u < 768 + 192 + 128 + 128 + 200; u += C.G) {
            C.refresh();
            if (u < 768) unit_chunk_mlp(C, layer, u);
            else if (u < 960) unit_conv(C, layer, u - 768);
            else if (u < 1088) unit_fourier_ctx(C, u - 960);
            else if (u < 1216) unit_fourier_lat1(C, u - 1088);
            else unit_mla_prep(C, layer, u - 1216);
        }
        GRID_BAR();
        C.refresh();
        for (int u = C.bid; u < 512; u += C.G) {
            C.refresh();
            if (u < 256) unit_attention(C, 128 + u);
            else if (u < 384) unit_attention(C, u - 256);
            else unit_fourier_lat2(C, u - 384);
        }
        GRID_BAR();
        { C.refresh(); bf16_t* R1 = (bf16_t*)(C.ws + WS_R1); bf16_t* R2 = (bf16_t*)(C.ws + WS_R2); unsigned char* wl = C.wl(layer); pg8::Gemm g{R1, (const bf16_t*)(wl + WL_OUT), M, D, D, C.wave_s}; pg8::StaticOrder S; S.init(M, D, C.G, C.bid); pg8::EpiStore E{R2, D, D};
          pg8::gemm_phase<pg8::EpiStore, pg8::StaticOrder, true, true>(C.lds, g, S, E); }
        GRID_BAR();
        C.refresh(); phase_post<0>(C, layer);
        GRID_BAR();
        { C.refresh(); bf16_t* R1 = (bf16_t*)(C.ws + WS_R1); bf16_t* R2 = (bf16_t*)(C.ws + WS_R2); unsigned char* wl = C.wl(layer); pg8::Gemm g{R1, (const bf16_t*)(wl + WL_GU), M, 2 * FF, D, C.wave_s}; pg8::StaticOrder S; S.init(M, 2 * FF, C.G, C.bid); pg8::EpiSwiGLU E{R2, FF};
          pg8::gemm_phase<pg8::EpiSwiGLU, pg8::StaticOrder, true, true>(C.lds, g, S, E); }
        GRID_BAR();
        { C.refresh(); bf16_t* R2 = (bf16_t*)(C.ws + WS_R2); bf16_t* R3 = (bf16_t*)(C.ws + WS_MLA); unsigned char* wl = C.wl(layer); pg8::Gemm g{R2, (const bf16_t*)(wl + WL_DN), M, D, FF, C.wave_s}; pg8::StaticOrder S; S.init(M, D, C.G, C.bid); pg8::EpiStore E{R3, D, D};
          pg8::gemm_phase<pg8::EpiStore, pg8::StaticOrder, true, true>(C.lds, g, S, E); }
        GRID_BAR();
        C.refresh(); phase_post<1>(C, layer);
        if (layer + 1 < DEPTH) GRID_BAR();
    }
}

extern "C" void kernel_launch(void* const* d_in, const int* in_sizes, int n_in, void* d_out, int out_size, void* d_ws, size_t ws_size, hipStream_t stream) {
    static int grid = 0;
    if (grid == 0) {
        if (n_in != 24 || ws_size < WS_END) { fprintf(stderr, "kernel_launch: need 24 inputs and %zu bytes of workspace; got %d, %zu\n", (size_t)WS_END, n_in, ws_size); grid = -1; return; }
        int dev = 0, cus = 0, per_cu = 0;
        if (hipGetDevice(&dev) != hipSuccess || hipDeviceGetAttribute(&cus, hipDeviceAttributeMultiprocessorCount, dev) != hipSuccess) { grid = -1; return; }
        if (hipFuncSetAttribute((const void*)mk_fwd, hipFuncAttributeMaxDynamicSharedMemorySize, LDS_BYTES) != hipSuccess) { fprintf(stderr, "kernel_launch: hipFuncSetAttribute failed\n"); grid = -1; return; }
        if (hipOccupancyMaxActiveBlocksPerMultiprocessor(&per_cu, (const void*)mk_fwd, NTHREADS, LDS_BYTES) != hipSuccess || per_cu < 1) fprintf(stderr, "kernel_launch: occupancy query says %d blocks per CU\n", per_cu);
        (void)hipGetLastError();
        grid = cus;
    }
    if (grid < 0) return;
    Params p{};
    for (int i = 0; i < 24; ++i) p.in[i] = (const float*)d_in[i];
    p.out = (float*)d_out; p.ws = (unsigned char*)d_ws;
    if (hipMemsetAsync((char*)d_ws + WS_BAR, 0, WS_BAR_BYTES, stream) != hipSuccess) { fprintf(stderr, "kernel_launch: memset failed\n"); return; }
    void* args[] = {&p};
    hipError_t e = hipLaunchCooperativeKernel((const void*)mk_fwd, dim3(grid), dim3(NTHREADS), args, LDS_BYTES, stream);
    if (e != hipSuccess) fprintf(stderr, "kernel_launch: cooperative launch failed: %s (grid %d)\n", hipGetErrorString(e), grid);
}
```

```cpp
#include <hip/hip_runtime.h>
#include <hip/hip_cooperative_groups.h>
#include <cstdio>
#include <cstdint>
namespace cg = cooperative_groups;
namespace pg8 {
#define PG8_LAS __attribute__((address_space(3)))
typedef unsigned short bf16_t;
typedef short bf16x8 __attribute__((ext_vector_type(8)));
typedef float f32x4 __attribute__((ext_vector_type(4)));
typedef unsigned u32x4 __attribute__((ext_vector_type(4)));
constexpr int BM = 256, BK = 64, HALF = 128, HTB = HALF * BK * 2  , STAGE_BYTES = 8 * HTB, NXCD = 8, WGM = 8;

__host__ __device__ __forceinline__ int lds_byte(int r, int c) { const int st = (r >> 4) * 2 + (c >> 5), rr = r & 15, cc = c & 31, ob = rr * 64 + cc * 2; return st * 1024 + (ob ^ (((ob >> 9) & 1) << 5)); }
__host__ __device__ __forceinline__ void stage_rc(int b, int& R, int& C) { const int st = b / 1024, sb = b % 1024, swz = sb ^ (((sb >> 9) & 1) << 5); R = (st >> 1) * 16 + swz / 64; C = (st & 1) * 32 + (swz % 64) / 2; }
__host__ __device__ __forceinline__ int perm32(int rho) { const int n = rho >> 4, i = rho & 15; return 8 * (i >> 2) + 4 * n + (i & 3); }

struct Unit { int pm, pn; };
struct Gemm { const bf16_t* A; const bf16_t* Bt; int M, N, K; };

struct StaticOrder {
    int nM, nN, nwg, G, c;
    __host__ __device__ void init(int M, int N, int G_, int c_) { nM = M / BM; nN = N / BM; nwg = nM * nN; G = G_; c = c_; }
    __host__ __device__ bool next(int i, Unit& u) const {
        const long L = (long)i * G + c; if (L >= nwg) return false;
        int wgid = (int)L; { const int q = nwg / NXCD, r = nwg % NXCD, xcd = wgid % NXCD, off = wgid / NXCD; wgid = (xcd < r ? xcd * (q + 1) : r * (q + 1) + (xcd - r) * q) + off; }
        const int nig = WGM * nN, gid = wgid / nig, fm = gid * WGM, gsz = (nM - fm) < WGM ? (nM - fm) : WGM;
        u.pm = fm + ((wgid % nig) % gsz); u.pn = (wgid % nig) / gsz; return true;
    }
    __device__ __forceinline__ void a_ready(const Unit&) const {}
    __device__ __forceinline__ void done(const Unit&) const {}
};

__device__ __forceinline__ unsigned cvt_pk_bf16(float lo, float hi) { unsigned r; asm volatile("v_cvt_pk_bf16_f32 %0, %1, %2" : "=v"(r) : "v"(lo), "v"(hi)); return r; }
typedef float f32x2 __attribute__((ext_vector_type(2)));
struct EpiStore {
    static constexpr bool PERM = true, AFTER_DRAIN = false;
    bf16_t* O; int ldc; int ncols;
    __device__ __forceinline__ void operator()(const f32x4 (&acc)[2][2][4][2], const Unit& u, int wr, int wc, int fr, int fq) const {
        const int row0 = u.pm * BM + wr * 64 + fr; const int col0 = u.pn * BM + wc * 32 + 8 * fq;
#pragma unroll
        for (int ai = 0; ai < 2; ++ai)
#pragma unroll
            for (int m = 0; m < 4; ++m) { bf16_t* rowp = O + (size_t)(row0 + ai * HALF + m * 16) * ldc + col0;
#pragma unroll
                for (int bj = 0; bj < 2; ++bj) { const f32x4 v0 = acc[ai][bj][m][0], v1 = acc[ai][bj][m][1];
                    u32x4 w; w.x = cvt_pk_bf16(v0[0], v0[1]); w.y = cvt_pk_bf16(v0[2], v0[3]); w.z = cvt_pk_bf16(v1[0], v1[1]); w.w = cvt_pk_bf16(v1[2], v1[3]);
                    if (col0 + bj * HALF < ncols) *(u32x4*)(rowp + bj * HALF) = w; } }
    }
};
struct EpiStoreWT {
    static constexpr bool PERM = true, AFTER_DRAIN = false;
    bf16_t* O; int ldc; int ncols;
    __device__ __forceinline__ void operator()(const f32x4 (&acc)[2][2][4][2], const Unit& u, int wr, int wc, int fr, int fq) const {
        const int row0 = u.pm * BM + wr * 64 + fr; const int col0 = u.pn * BM + wc * 32 + 8 * fq;
#pragma unroll
        for (int ai = 0; ai < 2; ++ai)
#pragma unroll
            for (int m = 0; m < 4; ++m) { bf16_t* rowp = O + (size_t)(row0 + ai * HALF + m * 16) * ldc + col0;
#pragma unroll
                for (int bj = 0; bj < 2; ++bj) { const f32x4 v0 = acc[ai][bj][m][0], v1 = acc[ai][bj][m][1];
                    const unsigned long long lo = (unsigned long long)cvt_pk_bf16(v0[0], v0[1]) | ((unsigned long long)cvt_pk_bf16(v0[2], v0[3]) << 32);
                    const unsigned long long hi = (unsigned long long)cvt_pk_bf16(v1[0], v1[1]) | ((unsigned long long)cvt_pk_bf16(v1[2], v1[3]) << 32);
                    unsigned long long* q = (unsigned long long*)(rowp + bj * HALF);
                    __hip_atomic_store(q, lo, __ATOMIC_RELAXED, __HIP_MEMORY_SCOPE_AGENT); __hip_atomic_store(q + 1, hi, __ATOMIC_RELAXED, __HIP_MEMORY_SCOPE_AGENT); } }
    }
};
__device__ __forceinline__ float silu_mul(float g, float u) { return g * u * __builtin_amdgcn_rcpf(1.f + __expf(-g)); }
struct EpiSwiGLU {
    static constexpr bool PERM = true, AFTER_DRAIN = false;
    bf16_t* O; int ldc;
    __device__ __forceinline__ void operator()(const f32x4 (&acc)[2][2][4][2], const Unit& u, int wr, int wc, int fr, int fq) const {
        const int row0 = u.pm * BM + wr * 64 + fr; const int col0 = u.pn * HALF + wc * 32 + 8 * fq;
#pragma unroll
        for (int ai = 0; ai < 2; ++ai)
#pragma unroll
            for (int m = 0; m < 4; ++m) { bf16_t* rowp = O + (size_t)(row0 + ai * HALF + m * 16) * ldc + col0;
                const f32x4 g0 = acc[ai][0][m][0], g1 = acc[ai][0][m][1], u0 = acc[ai][1][m][0], u1 = acc[ai][1][m][1];
                u32x4 w; w.x = cvt_pk_bf16(silu_mul(g0[0], u0[0]), silu_mul(g0[1], u0[1])); w.y = cvt_pk_bf16(silu_mul(g0[2], u0[2]), silu_mul(g0[3], u0[3]));
                w.z = cvt_pk_bf16(silu_mul(g1[0], u1[0]), silu_mul(g1[1], u1[1])); w.w = cvt_pk_bf16(silu_mul(g1[2], u1[2]), silu_mul(g1[3], u1[3]));
                *(u32x4*)rowp = w; }
    }
};

struct PanelOrder {
    int nN, nwg, G, c; unsigned* cnt;
    __device__ void init(int M, int N, int G_, int c_, unsigned* cnt_) { nN = N / BM; nwg = (M / BM) * nN; G = G_; c = c_; cnt = cnt_; }
    __device__ bool next(int i, Unit& u) const { const long L = (long)i * G + c; if (L >= nwg) return false; u.pm = (int)L / nN; u.pn = (int)L % nN; return true; }
    __device__ __forceinline__ void a_ready(const Unit&) const {}
    __device__ __forceinline__ void done(const Unit& u) const {
        asm volatile("s_waitcnt vmcnt(0)" ::: "memory");
        if ((threadIdx.x & 63) == 0) __hip_atomic_fetch_add(cnt + u.pm, 1u, __ATOMIC_RELAXED, __HIP_MEMORY_SCOPE_AGENT);
    }
};
template <class Epi, class Sched, bool ALIGN_EPI = false, bool SP2 = false>
__device__ __forceinline__ void gemm_phase(PG8_LAS unsigned char* lds, const Gemm g, const Sched& S, const Epi& E) {
    int tid_ = threadIdx.x; asm volatile("" : "+v"(tid_));
    const int tid = tid_, wid = __builtin_amdgcn_readfirstlane(tid >> 6), lane = tid & 63, wr = wid >> 2, wc = wid & 3, fr = lane & 15, fq = lane >> 4;
    const int K = g.K, nt = K / BK;
    unsigned voffA[2], voffB[2];
#pragma unroll
    for (int i = 0; i < 2; ++i) { int R, C; stage_rc(tid * 16 + i * 8192, R, C); const int Rb = Epi::PERM ? ((R & ~31) + perm32(R & 31)) : R;
        voffA[i] = (unsigned)(R * K + C) * 2u; voffB[i] = (unsigned)(Rb * K + C) * 2u; }
    const size_t kstep = (size_t)(BK * 2);
    const size_t hstep = (size_t)HALF * K * 2;
    const size_t tstep = 2 * hstep;
    const unsigned ldsw = (unsigned)wid * 1024u;
    const int aoff = lds_byte(wr * 64 + fr, fq * 8), boff = lds_byte(wc * 32 + fr, fq * 8);
#define PG8_SA(b, h) (((b) * 2 + (h)) * HTB)
#define PG8_SB(b, h) ((4 + (b) * 2 + (h)) * HTB)
#define PG8_STAGE(bufoff, gbase, voff) do { _Pragma("unroll") for (int _i = 0; _i < 2; ++_i) \
        __builtin_amdgcn_global_load_lds((const unsigned*)((const char*)(gbase) + (voff)[_i]), (PG8_LAS unsigned*)(lds + (bufoff) + ldsw + _i * 8192), 16, 0, 0); } while (0)
#define PG8_LDA(dst, b, h) do { _Pragma("unroll") for (int m = 0; m < 4; ++m) _Pragma("unroll") for (int k = 0; k < 2; ++k) dst[m][k] = *(const PG8_LAS bf16x8*)(lds + PG8_SA(b, h) + aoff + m * 2048 + k * 1024); } while (0)
#define PG8_LDB(dst, b, h) do { _Pragma("unroll") for (int n = 0; n < 2; ++n) _Pragma("unroll") for (int k = 0; k < 2; ++k) dst[n][k] = *(const PG8_LAS bf16x8*)(lds + PG8_SB(b, h) + boff + n * 2048 + k * 1024); } while (0)
#define PG8_MMA(ai, bj, At, Bt) do { __builtin_amdgcn_s_setprio(1); _Pragma("unroll") for (int m = 0; m < 4; ++m) _Pragma("unroll") for (int n = 0; n < 2; ++n) _Pragma("unroll") for (int k = 0; k < 2; ++k) \
        acc[ai][bj][m][n] = __builtin_amdgcn_mfma_f32_16x16x32_bf16(Bt[n][k], At[m][k], acc[ai][bj][m][n], 0, 0, 0); __builtin_amdgcn_s_setprio(0); } while (0)
#define PG8_WAIT_V(n) asm volatile("s_waitcnt vmcnt(" #n ")" ::: "memory")
#define PG8_WAIT_L(n) asm volatile("s_waitcnt lgkmcnt(" #n ")" ::: "memory")
#define PG8_BAR __builtin_amdgcn_s_barrier()
#define PG8_SCHED __builtin_amdgcn_sched_barrier(0)
    Unit cur, nxt; int ui = 0;
    if (!S.next(0, cur)) return;
    f32x4 acc[2][2][4][2];
#pragma unroll
    for (int a = 0; a < 2; ++a)
#pragma unroll
        for (int b = 0; b < 2; ++b)
#pragma unroll
            for (int m = 0; m < 4; ++m)
#pragma unroll
                for (int n = 0; n < 2; ++n) acc[a][b][m][n] = (f32x4){0.f, 0.f, 0.f, 0.f};
    bf16x8 At[4][2], B0[2][2], B1[2][2];
    const char* cA = (const char*)g.A + (size_t)cur.pm * tstep; const char* cB = (const char*)g.Bt + (size_t)cur.pn * tstep;
    S.a_ready(cur);
    if constexpr (SP2) {
        PG8_STAGE(PG8_SB(0, 0), cB, voffB); PG8_STAGE(PG8_SB(0, 1), cB + hstep, voffB); PG8_STAGE(PG8_SA(0, 0), cA, voffA); PG8_STAGE(PG8_SA(0, 1), cA + hstep, voffA);
        if (wr == 1) PG8_BAR;
        PG8_WAIT_V(2); PG8_BAR;
        PG8_STAGE(PG8_SB(1, 0), cB + kstep, voffB); PG8_STAGE(PG8_SA(1, 0), cA + kstep, voffA); PG8_STAGE(PG8_SB(1, 1), cB + hstep + kstep, voffB);
        PG8_WAIT_V(6); PG8_BAR;
    } else {
        PG8_STAGE(PG8_SB(0, 0), cB, voffB); PG8_STAGE(PG8_SA(0, 0), cA, voffA); PG8_STAGE(PG8_SB(0, 1), cB + hstep, voffB); PG8_STAGE(PG8_SA(0, 1), cA + hstep, voffA);
        if (wr == 1) PG8_BAR;
        PG8_WAIT_V(4); PG8_BAR;
        PG8_STAGE(PG8_SB(1, 0), cB + kstep, voffB); PG8_STAGE(PG8_SA(1, 0), cA + kstep, voffA); PG8_STAGE(PG8_SB(1, 1), cB + hstep + kstep, voffB);
        PG8_WAIT_V(6); PG8_BAR;
    }
    for (;;) {
        const bool has_next = S.next(ui + 1, nxt);
        const char* nA = has_next ? (const char*)g.A + (size_t)nxt.pm * tstep : cA; const char* nB = has_next ? (const char*)g.Bt + (size_t)nxt.pn * tstep : cB;
        for (int t = 0; t < nt; t += 2) {
            const bool last = (t == nt - 2);
            const char* a1 = cA + (size_t)(t + 1) * kstep;
            const char* a2 = last ? nA : cA + (size_t)(t + 2) * kstep; const char* b2 = last ? nB : cB + (size_t)(t + 2) * kstep;
            const char* a3 = a2 + kstep; const char* b3 = b2 + kstep;
            if (last && has_next) S.a_ready(nxt);
            if constexpr (SP2) {
            PG8_LDB(B0, 0, 0); PG8_LDB(B1, 0, 1); PG8_SCHED; PG8_LDA(At, 0, 0); PG8_STAGE(PG8_SA(1, 1), a1 + hstep, voffA);
            PG8_WAIT_V(8); PG8_WAIT_L(0); PG8_BAR; PG8_MMA(0, 0, At, B0); PG8_MMA(0, 1, At, B1); PG8_BAR; PG8_SCHED;
            PG8_LDA(At, 0, 1); PG8_STAGE(PG8_SB(0, 0), b2, voffB); PG8_STAGE(PG8_SB(0, 1), b2 + hstep, voffB); PG8_STAGE(PG8_SA(0, 0), a2, voffA);
            PG8_WAIT_V(8); PG8_WAIT_L(0); PG8_BAR; PG8_MMA(1, 0, At, B0); PG8_MMA(1, 1, At, B1); PG8_BAR; PG8_SCHED;
            PG8_LDB(B0, 1, 0); PG8_LDB(B1, 1, 1); PG8_SCHED; PG8_LDA(At, 1, 0); PG8_STAGE(PG8_SA(0, 1), a2 + hstep, voffA);
            PG8_WAIT_V(8); PG8_WAIT_L(0); PG8_BAR; PG8_MMA(0, 0, At, B0); PG8_MMA(0, 1, At, B1); PG8_BAR; PG8_SCHED;
            PG8_LDA(At, 1, 1); PG8_STAGE(PG8_SB(1, 0), b3, voffB); PG8_STAGE(PG8_SB(1, 1), b3 + hstep, voffB); PG8_STAGE(PG8_SA(1, 0), a3, voffA);
            PG8_WAIT_V(8); PG8_WAIT_L(0); PG8_BAR; PG8_MMA(1, 0, At, B0); PG8_MMA(1, 1, At, B1); PG8_BAR; PG8_SCHED;
            } else {
            PG8_LDB(B0, 0, 0); PG8_SCHED; PG8_LDA(At, 0, 0); PG8_STAGE(PG8_SA(1, 1), a1 + hstep, voffA);
            PG8_WAIT_L(8); PG8_BAR; PG8_WAIT_L(0); PG8_MMA(0, 0, At, B0); PG8_BAR; PG8_SCHED;
            PG8_LDB(B1, 0, 1); PG8_STAGE(PG8_SB(0, 0), b2, voffB);
            PG8_BAR; PG8_WAIT_L(0); PG8_MMA(0, 1, At, B1); PG8_BAR;
            PG8_LDA(At, 0, 1); PG8_STAGE(PG8_SA(0, 0), a2, voffA);
            PG8_BAR; PG8_WAIT_L(0); PG8_MMA(1, 0, At, B0); PG8_BAR; PG8_SCHED;
            PG8_STAGE(PG8_SB(0, 1), b2 + hstep, voffB);
            PG8_WAIT_V(6); PG8_BAR; PG8_MMA(1, 1, At, B1); PG8_BAR;
            PG8_LDB(B0, 1, 0); PG8_SCHED; PG8_LDA(At, 1, 0); PG8_STAGE(PG8_SA(0, 1), a2 + hstep, voffA);
            PG8_WAIT_L(8); PG8_BAR; PG8_WAIT_L(0); PG8_MMA(0, 0, At, B0); PG8_BAR; PG8_SCHED;
            PG8_LDB(B1, 1, 1); PG8_STAGE(PG8_SB(1, 0), b3, voffB);
            PG8_BAR; PG8_WAIT_L(0); PG8_MMA(0, 1, At, B1); PG8_BAR;
            PG8_LDA(At, 1, 1); PG8_STAGE(PG8_SA(1, 0), a3, voffA);
            PG8_BAR; PG8_WAIT_L(0); PG8_MMA(1, 0, At, B0); PG8_BAR; PG8_SCHED;
            PG8_STAGE(PG8_SB(1, 1), b3 + hstep, voffB);
            PG8_WAIT_V(6); PG8_BAR; PG8_MMA(1, 1, At, B1); PG8_BAR;
            }
        }
        if constexpr (ALIGN_EPI) { if (wr == 0) PG8_BAR; }
        if constexpr (!Epi::AFTER_DRAIN) { E(acc, cur, wr, wc, fr, fq); S.done(cur); }
        if (!has_next) break;
#pragma unroll
        for (int a = 0; a < 2; ++a)
#pragma unroll
            for (int b = 0; b < 2; ++b)
#pragma unroll
                for (int m = 0; m < 4; ++m)
#pragma unroll
                    for (int n = 0; n < 2; ++n) acc[a][b][m][n] = (f32x4){0.f, 0.f, 0.f, 0.f};
        cur = nxt; cA = nA; cB = nB; ++ui;
        if constexpr (ALIGN_EPI) { if (wr == 1) PG8_BAR; }
    }
    PG8_WAIT_V(0);
    if constexpr (!ALIGN_EPI) { if (wr == 0) PG8_BAR; }
    PG8_BAR;
    if constexpr (Epi::AFTER_DRAIN) { E.fused(acc, cur, wr, wc, fr, fq, lds, wid, lane); S.done(cur); }
#undef PG8_SA
#undef PG8_SB
#undef PG8_STAGE
#undef PG8_LDA
#undef PG8_LDB
#undef PG8_MMA
#undef PG8_WAIT_V
#undef PG8_WAIT_L
#undef PG8_BAR
#undef PG8_SCHED
}
}
#define LAS __attribute__((address_space(3)))
typedef unsigned short bf16_t;
typedef short bf16x8 __attribute__((ext_vector_type(8)));
typedef short bf16x4 __attribute__((ext_vector_type(4)));
typedef float f32x4 __attribute__((ext_vector_type(4)));
typedef float f32x2 __attribute__((ext_vector_type(2)));
typedef float f32x16 __attribute__((ext_vector_type(16)));
typedef unsigned u32x4 __attribute__((ext_vector_type(4)));
typedef unsigned u32x2 __attribute__((ext_vector_type(2)));

constexpr int D = 1024, M_CTX = 8192, M_LAT = 16384, M = M_CTX + M_LAT, NP = 1888, NPP = 2048, FF = 2816, DEPTH = 4;
constexpr int KEYROWS = 8192 + 4 * 4352;
constexpr float EPS = 1e-6f;
constexpr int NTHREADS = 512, NWAVES = 8;
constexpr int LDS_BYTES = 147456;

constexpr size_t OUT_X = 0, OUT_CKV = (size_t)M * D, OUT_KR = OUT_CKV + (size_t)32 * 4 * 256 * 128;
constexpr int PC_U = 0, PC_V = 256, PC_H = 512, PC_B = 768, PC_C = 1024, PC_F = 1280, PC_Q = 1536, PC_KV = 1728, PC_KR = 1856;

constexpr size_t al256(size_t x) { return (x + 255) & ~(size_t)255; }
constexpr size_t WS_BAR = 0, WS_BAR_BYTES = 16384;
constexpr size_t WS_MOD = WS_BAR_BYTES;
constexpr size_t WS_F64 = al256(WS_MOD + (size_t)4 * 5 * 6144 * 4);
constexpr size_t WS_T64R = WS_F64 + 128 * 64 * 2;
constexpr size_t WS_T64I = WS_T64R + 64 * 128 * 2;
constexpr size_t WS_T64B = WS_T64I + 64 * 128 * 2;
constexpr size_t WS_T256 = WS_T64B + 64 * 128 * 2;
constexpr size_t WS_TW = WS_T256 + 256 * 512 * 2;
constexpr size_t WS_ROPE = WS_TW + 4096 * 8;
constexpr size_t WS_W = al256(WS_ROPE + 64 * 8 * 8);
constexpr size_t WL_IN = 0, WL_OUT = WL_IN + (size_t)NPP * D * 2, WL_GU = WL_OUT + (size_t)D * D * 2, WL_DN = WL_GU + (size_t)2 * FF * D * 2,
                 WL_UQ = WL_DN + (size_t)D * FF * 2, WL_UKV = WL_UQ + (size_t)384 * 192 * 2, WL_SP = WL_UKV + (size_t)512 * 128 * 2, WL_SIZE = WL_SP + (size_t)4 * 128 * 128 * 2;
constexpr size_t WS_R1 = al256(WS_W + 4 * WL_SIZE);
constexpr size_t WS_R2 = WS_R1 + (size_t)M * D * 2;
constexpr size_t WS_MLA = WS_R2 + (size_t)M * FF * 2;
constexpr size_t WS_Q = WS_MLA, WS_KN = WS_Q + (size_t)M * 384 * 2, WS_VT = WS_KN + (size_t)KEYROWS * 256 * 2, WS_KR = WS_VT + (size_t)KEYROWS * 256 * 2,
                 WS_GB = WS_KR + (size_t)KEYROWS * 32 * 2, WS_END = WS_GB + (size_t)4 * 4 * 64 * 64 * 128 * 2;
static_assert(WS_END - WS_MLA >= (size_t)M * D * 2, "FFNOUT alias");
static_assert((size_t)M * NP * 2 <= (size_t)M * FF * 2, "PROJ fits R2");

struct Params { const float* in[24]; float* out; unsigned char* ws; };
enum { I_XP = 0, I_XS, I_CCKV, I_CKR, I_C, I_CCTX, I_WADA, I_BADA, I_GPM, I_GPOM, I_GPF, I_GPOF, I_WIN, I_SPW, I_SPB, I_CVW, I_CVB, I_GQ, I_WUQ, I_GKV, I_WUKV, I_WOUT, I_WGU, I_WDN };

__device__ __forceinline__ unsigned f2bf(float f) { unsigned u = __builtin_bit_cast(unsigned, f); return (u + 0x7fffu + ((u >> 16) & 1u)) >> 16; }
typedef __bf16 bf16x2v __attribute__((ext_vector_type(2)));
__device__ __forceinline__ unsigned pk2(float lo, float hi) { const bf16x2v r = __builtin_convertvector((f32x2){lo, hi}, bf16x2v); return __builtin_bit_cast(unsigned, r); }
__device__ __forceinline__ float bflo(unsigned w) { return __builtin_bit_cast(float, w << 16); }
__device__ __forceinline__ float bfhi(unsigned w) { return __builtin_bit_cast(float, w & 0xffff0000u); }
__device__ __forceinline__ float bf1(bf16_t v) { return __builtin_bit_cast(float, (unsigned)v << 16); }
__device__ __forceinline__ f32x4 mma16(bf16x8 a, bf16x8 b, f32x4 c) { return __builtin_amdgcn_mfma_f32_16x16x32_bf16(a, b, c, 0, 0, 0); }
__device__ __forceinline__ f32x16 mma32(bf16x8 a, bf16x8 b, f32x16 c) { return __builtin_amdgcn_mfma_f32_32x32x16_bf16(a, b, c, 0, 0, 0); }
__device__ __forceinline__ float wave_sum(float v) {
#pragma unroll
    for (int o = 1; o < 64; o <<= 1) v += __shfl_xor(v, o);
    return v;
}
__device__ __forceinline__ u32x2 pk4(f32x4 v) { u32x2 w; w.x = pk2(v[0], v[1]); w.y = pk2(v[2], v[3]); return w; }
__device__ __forceinline__ int mod_of_row(int r) { return r < M_CTX ? 0 : 1 + ((r - M_CTX) >> 12); }

struct Ctx {
    Params p; LAS unsigned char* lds; int tid, lane, wave, bid, G;
    unsigned char* ws;
    __device__ __forceinline__ const float* mod(int l, int mi, int chunk) const { return (const float*)(ws + WS_MOD) + ((size_t)(l * 5 + mi) * 6 + chunk) * 1024; }
    __device__ __forceinline__ unsigned char* wl(int l) const { return ws + WS_W + (size_t)l * WL_SIZE; }
    __device__ __forceinline__ void refresh() { int t = threadIdx.x; asm volatile("" : "+v"(t)); tid = t; lane = t & 63; wave = __builtin_amdgcn_readfirstlane(t >> 6);
        size_t z = 0; asm volatile("" : "+s"(z)); ws = p.ws + z;
        int b = blockIdx.x; asm volatile("" : "+s"(b)); bid = b; }
};

constexpr int TPS = 258;
struct TItem { const float* W; bf16_t* WT; int ldw, K, k0, n0, nvalid, gu; };
__device__ __forceinline__ void titem_load(const TItem& t, int wave, int lane, f32x4 (&v)[8]) {
    const int n = t.n0 + 4 * lane;
#pragma unroll
    for (int i = 0; i < 8; ++i) v[i] = n < t.nvalid ? *(const f32x4*)(t.W + (size_t)(t.k0 + 8 * wave + i) * t.ldw + n) : (f32x4){0.f, 0.f, 0.f, 0.f};
}
__device__ __forceinline__ void titem_stage(LAS unsigned char* lds, int wave, int lane, const f32x4 (&v)[8]) {
    LAS bf16_t* T = (LAS bf16_t*)lds;
#pragma unroll
    for (int i = 0; i < 8; ++i) { LAS unsigned* d = (LAS unsigned*)(T + (8 * wave + i) * TPS + 4 * lane); d[0] = pk2(v[i][0], v[i][1]); d[1] = pk2(v[i][2], v[i][3]); }
}
__device__ __forceinline__ void titem_store(const TItem& t, const LAS unsigned char* lds, int tid) {
    const LAS bf16_t* T = (const LAS bf16_t*)lds;
#pragma unroll
    for (int it = 0; it < 4; ++it) { const int q = tid + NTHREADS * it, n = q >> 3, c = q & 7;
        unsigned short e[8];
#pragma unroll
        for (int j = 0; j < 8; ++j) e[j] = T[(8 * c + j) * TPS + n];
        const int sn = t.n0 + n;
        if (sn < t.nvalid) { int dr = sn; if (t.gu) { const int isup = sn >= FF, jj = isup ? sn - FF : sn; dr = (jj >> 7) * 256 + isup * 128 + (jj & 127); }
            u32x4 o; o.x = e[0] | ((unsigned)e[1] << 16); o.y = e[2] | ((unsigned)e[3] << 16); o.z = e[4] | ((unsigned)e[5] << 16); o.w = e[6] | ((unsigned)e[7] << 16);
            *(u32x4*)(t.WT + (size_t)dr * t.K + t.k0 + 8 * c) = o; } }
}
constexpr int TI_IN = 16 * 8, TI_OUT = 16 * 4, TI_GU = 16 * 22, TI_DN = 44 * 4, TI_UQ = 3 * 2, TI_UKV = 2 * 2, TI_L = TI_IN + TI_OUT + TI_GU + TI_DN + TI_UQ + TI_UKV;
__device__ __forceinline__ TItem titem_make(const Ctx& C, int it) {
    const Params& p = C.p; const int l = it / TI_L; int r = it % TI_L; unsigned char* wl = C.wl(l); TItem t; t.gu = 0;
    if (r < TI_IN) { t.W = p.in[I_WIN] + (size_t)l * D * NP; t.WT = (bf16_t*)(wl + WL_IN); t.ldw = NP; t.K = D; t.k0 = (r >> 3) * 64; t.n0 = (r & 7) * 256; t.nvalid = NP; return t; } r -= TI_IN;
    if (r < TI_OUT) { t.W = p.in[I_WOUT] + (size_t)l * D * D; t.WT = (bf16_t*)(wl + WL_OUT); t.ldw = D; t.K = D; t.k0 = (r >> 2) * 64; t.n0 = (r & 3) * 256; t.nvalid = D; return t; } r -= TI_OUT;
    if (r < TI_GU) { t.W = p.in[I_WGU] + (size_t)l * D * 2 * FF; t.WT = (bf16_t*)(wl + WL_GU); t.ldw = 2 * FF; t.K = D; t.k0 = (r / 22) * 64; t.n0 = (r % 22) * 256; t.nvalid = 2 * FF; t.gu = 1; return t; } r -= TI_GU;
    if (r < TI_DN) { t.W = p.in[I_WDN] + (size_t)l * FF * D; t.WT = (bf16_t*)(wl + WL_DN); t.ldw = D; t.K = FF; t.k0 = (r >> 2) * 64; t.n0 = (r & 3) * 256; t.nvalid = D; return t; } r -= TI_DN;
    if (r < TI_UQ) { t.W = p.in[I_WUQ] + (size_t)l * 192 * 384; t.WT = (bf16_t*)(wl + WL_UQ); t.ldw = 384; t.K = 192; t.k0 = (r >> 1) * 64; t.n0 = (r & 1) * 256; t.nvalid = 384; return t; } r -= TI_UQ;
    t.W = p.in[I_WUKV] + (size_t)l * 128 * 512; t.WT = (bf16_t*)(wl + WL_UKV); t.ldw = 512; t.K = 128; t.k0 = (r >> 1) * 64; t.n0 = (r & 1) * 256; t.nvalid = 512; return t;
}

__device__ __forceinline__ void phase_prologue(const Ctx& C) {
    const Params& p = C.p;
    {
        const int NIT = 4 * TI_L;
        int it = C.bid; f32x4 v[8];
        TItem cur; if (it < NIT) { cur = titem_make(C, it); titem_load(cur, C.wave, C.lane, v); }
        while (it < NIT) {
            titem_stage(C.lds, C.wave, C.lane, v);
            const int nx = it + C.G; TItem nxt = cur; if (nx < NIT) { nxt = titem_make(C, nx); titem_load(nxt, C.wave, C.lane, v); }
            __syncthreads();
            titem_store(cur, C.lds, C.tid);
            __syncthreads();
            cur = nxt; it = nx;
        }
    }
    {
        LAS float* sc = (LAS float*)C.lds;
        LAS float* red = (LAS float*)(C.lds + 5 * 1024 * 4);
        const int ub = C.G - 1 - C.bid;
        if (ub < 96) {
            size_t za = 0, zb = 0; asm volatile("" : "+s"(za), "+s"(zb));
            const float* cctx = p.in[I_CCTX] + za; const float* cc_ = p.in[I_C] + zb;
            for (int i = C.tid; i < 5120; i += NTHREADS) { const int j = i >> 10, k = i & 1023; const float v = (j == 0) ? cctx[k] : cc_[(j - 1) * 1024 + k]; sc[i] = v / (1.f + __expf(-v)); }
            __syncthreads();
            for (int u = ub; u < 96; u += C.G) {
                const int l = u / 24, cb = u % 24;
                const float* w = p.in[I_WADA] + ((size_t)l * 1024 + C.wave * 128) * 6144 + cb * 256 + 4 * C.lane;
                f32x4 a0 = {0.f, 0.f, 0.f, 0.f}, a1 = a0, a2 = a0, a3 = a0, a4 = a0;
#pragma unroll 16
                for (int k = 0; k < 128; ++k) { const f32x4 wv = *(const f32x4*)(w + (size_t)k * 6144); const int kk = C.wave * 128 + k;
                    a0 += wv * sc[kk]; a1 += wv * sc[1024 + kk]; a2 += wv * sc[2048 + kk]; a3 += wv * sc[3072 + kk]; a4 += wv * sc[4096 + kk]; }
                LAS f32x4* rw = (LAS f32x4*)(red + C.wave * 1280) + C.lane;
                rw[0] = a0; rw[64] = a1; rw[128] = a2; rw[192] = a3; rw[256] = a4;
                __syncthreads();
                for (int i = C.tid; i < 1280; i += NTHREADS) { const int j = i >> 8, c2 = i & 255; float sum = p.in[I_BADA][l * 6144 + cb * 256 + c2];
#pragma unroll
                    for (int ww = 0; ww < 8; ++ww) sum += red[ww * 1280 + i];
                    ((float*)(C.ws + WS_MOD))[(size_t)(l * 5 + j) * 6144 + cb * 256 + c2] = sum; }
                __syncthreads();
            }
        }
        __syncthreads();
    }
    {
        const int gt = C.bid * NTHREADS + C.tid, GT = C.G * NTHREADS;
        for (int i = gt; i < 4 * 65536; i += GT) { const int l = i >> 16, e = i & 65535; ((bf16_t*)(C.wl(l) + WL_SP))[e] = (bf16_t)f2bf(p.in[I_SPW][i]); }
        for (int i = gt; i < 4 * 160 * 1024 / 2; i += GT) { const int l = i / (160 * 512), e = i % (160 * 512); ((unsigned*)(C.wl(l) + WL_IN + (size_t)NP * D * 2))[e] = 0u; }
        for (int i = gt; i < 128 * 64; i += GT) { const int m = i >> 6, c = i & 63; const int idx = ((m & 63) * c) & 63; const float a = (float)idx / 32.f;
            ((bf16_t*)(C.ws + WS_F64))[i] = (bf16_t)f2bf(m < 64 ? cospif(a) : sinpif(a)); }
        for (int i = gt; i < 64 * 128; i += GT) { const int k = i >> 7, K = i & 127; const int idx = (k * (K & 63)) & 63; const float a = (float)idx / 32.f; const float cv = cospif(a), sv = sinpif(a);
            ((bf16_t*)(C.ws + WS_T64R))[i] = (bf16_t)f2bf(K < 64 ? cv : -sv);
            ((bf16_t*)(C.ws + WS_T64I))[i] = (bf16_t)f2bf(K < 64 ? -sv : -cv);
            ((bf16_t*)(C.ws + WS_T64B))[i] = (bf16_t)f2bf(K < 64 ? cv : sv); }
        for (int i = gt; i < 256 * 512; i += GT) { const int k = i >> 9, K = i & 511; const int idx = (k * (K & 255)) & 255; const float a = (float)idx / 128.f;
            ((bf16_t*)(C.ws + WS_T256))[i] = (bf16_t)f2bf(K < 256 ? cospif(a) : -sinpif(a)); }
        for (int i = gt; i < 4096; i += GT) { const float a = (float)i / 2048.f; ((f32x2*)(C.ws + WS_TW))[i] = (f32x2){cospif(a), sinpif(a)}; }
        for (int i = gt; i < 512; i += GT) { const int pos = i >> 3, f = i & 7; const float inv = powf(10000.f, -(float)f / 8.f); const float ang = (float)pos * inv;
            ((f32x2*)(C.ws + WS_ROPE))[i] = (f32x2){cosf(ang), sinf(ang)}; }
    }
}

__device__ __forceinline__ void load_row_f32(const float* rowp, int lane, f32x4 (&v)[4]) {
#pragma unroll
    for (int j = 0; j < 4; ++j) v[j] = *(const f32x4*)(rowp + 4 * lane + 256 * j);
}
__device__ __forceinline__ void load_row_bf16(const bf16_t* rowp, int lane, f32x4 (&v)[4]) {
#pragma unroll
    for (int j = 0; j < 4; ++j) { const u32x2 w = *(const u32x2*)(rowp + 4 * lane + 256 * j); v[j] = (f32x4){bflo(w.x), bfhi(w.x), bflo(w.y), bfhi(w.y)}; }
}
__device__ __forceinline__ float row_rstd(const f32x4 (&v)[4]) {
    float s = 0.f;
#pragma unroll
    for (int j = 0; j < 4; ++j) s += (v[j][0] * v[j][0] + v[j][1] * v[j][1]) + (v[j][2] * v[j][2] + v[j][3] * v[j][3]);
    return 1.f / sqrtf(wave_sum(s) * (1.f / 1024.f) + EPS);
}
__device__ __forceinline__ void norm_mod_store(const f32x4 (&x)[4], const float* g, const float* scale, const float* shift, bf16_t* orow, int lane) {
    const float rs = row_rstd(x);
#pragma unroll
    for (int j = 0; j < 4; ++j) { const int c = 4 * lane + 256 * j; const f32x4 gv = *(const f32x4*)(g + c), sv = *(const f32x4*)(scale + c), hv = *(const f32x4*)(shift + c);
        const f32x4 h = x[j] * rs * gv * (1.f + sv) + hv; *(u32x2*)(orow + c) = pk4(h); }
}
__device__ __forceinline__ const float* xin_row(const Ctx& C, int layer, int r) {
    if (layer > 0) return C.p.out + OUT_X + (size_t)r * D;
    size_t za = 0, zb = 0; asm volatile("" : "+s"(za), "+s"(zb));
    const float* a = C.p.in[I_XP] + za; const float* b = C.p.in[I_XS] + zb;
    return r < M_CTX ? a + (size_t)r * D : b + (size_t)(r - M_CTX) * D;
}
__device__ __forceinline__ void phase_norm0(const Ctx& C) {
    const int gw = C.bid * NWAVES + C.wave, NGW = C.G * NWAVES;
    bf16_t* H = (bf16_t*)(C.ws + WS_R1);
    f32x4 xn[4]; load_row_f32(xin_row(C, 0, gw), C.lane, xn);
    for (int r = gw; r < M; r += NGW) { f32x4 x[4];
#pragma unroll
        for (int j = 0; j < 4; ++j) x[j] = xn[j];
        if (r + NGW < M) load_row_f32(xin_row(C, 0, r + NGW), C.lane, xn);
        const int mi = mod_of_row(r);
        norm_mod_store(x, C.p.in[I_GPM], C.mod(0, mi, 1), C.mod(0, mi, 0), H + (size_t)r * D, C.lane); }
}
template <int which  > __device__ __forceinline__ void phase_post(const Ctx& C, int layer) {
    const int gw = C.bid * NWAVES + C.wave, NGW = C.G * NWAVES;
    const bf16_t* T = (const bf16_t*)(C.ws + (which == 0 ? WS_R2 : WS_MLA));
    bf16_t* H = (bf16_t*)(C.ws + WS_R1);
    const float* gpost = (which == 0 ? C.p.in[I_GPOM] : C.p.in[I_GPOF]) + layer * D;
    const bool do_next = (which == 0) || (layer + 1 < DEPTH);
    const int nl = which == 0 ? layer : layer + 1;
    const float* gnext = (which == 0 ? C.p.in[I_GPF] : C.p.in[I_GPM]) + (nl < DEPTH ? nl : 0) * D;
    f32x4 tn[4], xn[4];
    load_row_bf16(T + (size_t)gw * D, C.lane, tn); load_row_f32(which == 0 ? xin_row(C, layer, gw) : C.p.out + OUT_X + (size_t)gw * D, C.lane, xn);
    for (int r = gw; r < M; r += NGW) {
        const int mi = mod_of_row(r);
        f32x4 t[4], x[4];
#pragma unroll
        for (int j = 0; j < 4; ++j) { t[j] = tn[j]; x[j] = xn[j]; }
        if (r + NGW < M) { const int rn = r + NGW; load_row_bf16(T + (size_t)rn * D, C.lane, tn); load_row_f32(which == 0 ? xin_row(C, layer, rn) : C.p.out + OUT_X + (size_t)rn * D, C.lane, xn); }
        const float rs = row_rstd(t); const float* gate = C.mod(layer, mi, which == 0 ? 2 : 5);
        float* xo = C.p.out + OUT_X + (size_t)r * D;
#pragma unroll
        for (int j = 0; j < 4; ++j) { const int c = 4 * C.lane + 256 * j; const f32x4 gv = *(const f32x4*)(gpost + c), ga = *(const f32x4*)(gate + c);
            x[j] = x[j] + ga * (t[j] * rs * gv); *(f32x4*)(xo + c) = x[j]; }
        if (do_next) norm_mod_store(x, gnext, C.mod(nl, mi, which == 0 ? 4 : 1), C.mod(nl, mi, which == 0 ? 3 : 0), H + (size_t)r * D, C.lane);
    }
}

__device__ __forceinline__ void unit_chunk_mlp(const Ctx& C, int layer, int u) {
    const int chunk = u >> 2, g = u & 3, r0 = chunk * 128;
    const bf16_t* PROJ = (const bf16_t*)(C.ws + WS_R2); bf16_t* MIX = (bf16_t*)(C.ws + WS_R1);
    constexpr int VS = 136;
    LAS bf16_t* Vt = (LAS bf16_t*)C.lds;
    { const int q = C.tid >> 2, c0 = (C.tid & 3) * 16; const bf16_t* src = PROJ + (size_t)(r0 + q) * NP + PC_V + g * 64 + c0;
      const bf16x8 v0 = *(const bf16x8*)src, v1 = *(const bf16x8*)(src + 8);
#pragma unroll
      for (int j = 0; j < 8; ++j) { Vt[(c0 + j) * VS + q] = (bf16_t)v0[j]; Vt[(c0 + 8 + j) * VS + q] = (bf16_t)v1[j]; } }
    __syncthreads();
    const int l15 = C.lane & 15, hq = C.lane >> 4, w = C.wave;
    const bf16_t* Wg = (const bf16_t*)(C.wl(layer) + WL_SP) + (size_t)g * 128 * 128;
    bf16x8 bw[4];
#pragma unroll
    for (int ks = 0; ks < 4; ++ks) bw[ks] = *(const bf16x8*)(Wg + (size_t)(w * 16 + l15) * 128 + ks * 32 + 8 * hq);
    const int p = w * 16 + l15; const float bias = C.p.in[I_SPB][(layer * 4 + g) * 128 + p];
#pragma unroll
    for (int ct = 0; ct < 4; ++ct) {
        f32x4 acc = {0.f, 0.f, 0.f, 0.f};
#pragma unroll
        for (int ks = 0; ks < 4; ++ks) { const bf16x8 a = *(const LAS bf16x8*)(Vt + (ct * 16 + l15) * VS + ks * 32 + 8 * hq); acc = mma16(a, bw[ks], acc); }
        const int cc = g * 64 + ct * 16 + 4 * hq; const u32x2 uw = *(const u32x2*)(PROJ + (size_t)(r0 + p) * NP + PC_U + cc);
        f32x4 o; o[0] = bflo(uw.x) * (acc[0] + bias); o[1] = bfhi(uw.x) * (acc[1] + bias); o[2] = bflo(uw.y) * (acc[2] + bias); o[3] = bfhi(uw.y) * (acc[3] + bias);
        *(u32x2*)(MIX + (size_t)(r0 + p) * D + cc) = pk4(o);
    }
    __syncthreads();
}
__device__ __forceinline__ void unit_conv(const Ctx& C, int layer, int u) {
    const bf16_t* PROJ = (const bf16_t*)(C.ws + WS_R2); bf16_t* MIX = (bf16_t*)(C.ws + WS_R1);
    const float* cw = C.p.in[I_CVW] + layer * 3 * 256; const float* cb = C.p.in[I_CVB] + layer * 256;
    for (int it = 0; it < 8; ++it) {
        const int item = it * NTHREADS + C.tid, t = item >> 5, ch = (item & 31) * 8, r = u * 128 + t;
        const int pos = r < M_CTX ? (r & 255) : ((r - M_CTX) & 4095), len = r < M_CTX ? 256 : 4096;
        const bf16_t* base = PROJ + (size_t)r * NP;
        const bf16x8 h1 = *(const bf16x8*)(base + PC_H + ch), c1 = *(const bf16x8*)(base + PC_C + ch), gb = *(const bf16x8*)(base + PC_B + ch);
        bf16x8 h0 = h1, c0 = c1, h2 = h1, c2 = c1; const bool hasp = pos > 0, hasn = pos < len - 1;
        if (hasp) { h0 = *(const bf16x8*)(base - NP + PC_H + ch); c0 = *(const bf16x8*)(base - NP + PC_C + ch); }
        if (hasn) { h2 = *(const bf16x8*)(base + NP + PC_H + ch); c2 = *(const bf16x8*)(base + NP + PC_C + ch); }
        float o[8];
#pragma unroll
        for (int j = 0; j < 8; ++j) {
            const float z0 = hasp ? bf1((bf16_t)h0[j]) * bf1((bf16_t)c0[j]) : 0.f, z1 = bf1((bf16_t)h1[j]) * bf1((bf16_t)c1[j]), z2 = hasn ? bf1((bf16_t)h2[j]) * bf1((bf16_t)c2[j]) : 0.f;
            const float y = z0 * cw[ch + j] + z1 * cw[256 + ch + j] + z2 * cw[512 + ch + j] + cb[ch + j];
            o[j] = bf1((bf16_t)gb[j]) * y; }
        u32x4 w; w.x = pk2(o[0], o[1]); w.y = pk2(o[2], o[3]); w.z = pk2(o[4], o[5]); w.w = pk2(o[6], o[7]);
        *(u32x4*)(MIX + (size_t)r * D + 256 + ch) = w;
    }
}
__device__ __forceinline__ void unit_fourier_ctx(const Ctx& C, int u) {
    const int s = u >> 2, g = u & 3, l15 = C.lane & 15, hq = C.lane >> 4, w = C.wave;
    const bf16_t* PROJ = (const bf16_t*)(C.ws + WS_R2); bf16_t* MIX = (bf16_t*)(C.ws + WS_R1);
    const bf16_t* F64 = (const bf16_t*)(C.ws + WS_F64); const bf16_t* T256 = (const bf16_t*)(C.ws + WS_T256);
    constexpr int ZS = 520; LAS bf16_t* Zt = (LAS bf16_t*)C.lds;
#pragma unroll
    for (int i = 0; i < 2; ++i) { const int nt = 2 * w + i;
        bf16x8 a[2];
#pragma unroll
        for (int ks = 0; ks < 2; ++ks) a[ks] = *(const bf16x8*)(PROJ + (size_t)(s * 256 + nt * 16 + l15) * NP + PC_F + g * 64 + ks * 32 + 8 * hq);
#pragma unroll
        for (int mt = 0; mt < 8; ++mt) { f32x4 acc = {0.f, 0.f, 0.f, 0.f};
#pragma unroll
            for (int ks = 0; ks < 2; ++ks) { const bf16x8 b = *(const bf16x8*)(F64 + (size_t)(mt * 16 + l15) * 64 + ks * 32 + 8 * hq); acc = mma16(a[ks], b, acc); }
            const int mp = mt * 16 + l15;
            *(LAS u32x2*)(Zt + (mp & 63) * ZS + (mp >> 6) * 256 + nt * 16 + 4 * hq) = pk4(acc); } }
    __syncthreads();
#pragma unroll 1
    for (int i = 0; i < 2; ++i) { const int kt = 2 * w + i;
        f32x4 acc[4];
#pragma unroll
        for (int mt = 0; mt < 4; ++mt) acc[mt] = (f32x4){0.f, 0.f, 0.f, 0.f};
#pragma unroll 8
        for (int ks = 0; ks < 16; ++ks) { const bf16x8 b = *(const bf16x8*)(T256 + (size_t)(kt * 16 + l15) * 512 + ks * 32 + 8 * hq);
#pragma unroll
            for (int mt = 0; mt < 4; ++mt) { const bf16x8 a = *(const LAS bf16x8*)(Zt + (mt * 16 + l15) * ZS + ks * 32 + 8 * hq); acc[mt] = mma16(a, b, acc[mt]); } }
#pragma unroll
        for (int mt = 0; mt < 4; ++mt) *(u32x2*)(MIX + (size_t)(s * 256 + kt * 16 + l15) * D + 512 + g * 64 + mt * 16 + 4 * hq) = pk4(acc[mt] * (1.f / 128.f)); }
    __syncthreads();
}
__device__ __forceinline__ void unit_fourier_lat1(const Ctx& C, int u) {
    const int b = u >> 5, g = (u >> 3) & 3, nb = u & 7, l15 = C.lane & 15, hq = C.lane >> 4, n2 = nb * 8 + C.wave;
    const bf16_t* PROJ = (const bf16_t*)(C.ws + WS_R2);
    const bf16_t* F64 = (const bf16_t*)(C.ws + WS_F64); const bf16_t* T64R = (const bf16_t*)(C.ws + WS_T64R); const bf16_t* T64I = (const bf16_t*)(C.ws + WS_T64I);
    const f32x2* TW = (const f32x2*)(C.ws + WS_TW);
    bf16_t* GB = (bf16_t*)(C.ws + WS_GB) + (size_t)((b * 4 + g) * 64 + n2) * 64 * 128;
    constexpr int ZS = 136; LAS bf16_t* Zt = (LAS bf16_t*)(C.lds + C.wave * (64 * ZS * 2));
#pragma unroll 2
    for (int nt = 0; nt < 4; ++nt) {
        bf16x8 a[2];
#pragma unroll
        for (int ks = 0; ks < 2; ++ks) a[ks] = *(const bf16x8*)(PROJ + (size_t)(M_CTX + b * 4096 + (nt * 16 + l15) * 64 + n2) * NP + PC_F + g * 64 + ks * 32 + 8 * hq);
#pragma unroll
        for (int mt = 0; mt < 8; ++mt) { f32x4 acc = {0.f, 0.f, 0.f, 0.f};
#pragma unroll
            for (int ks = 0; ks < 2; ++ks) { const bf16x8 bb = *(const bf16x8*)(F64 + (size_t)(mt * 16 + l15) * 64 + ks * 32 + 8 * hq); acc = mma16(a[ks], bb, acc); }
            const int mp = mt * 16 + l15;
            *(LAS u32x2*)(Zt + (mp & 63) * ZS + (mp >> 6) * 64 + nt * 16 + 4 * hq) = pk4(acc); } }
    asm volatile("s_waitcnt lgkmcnt(0)" ::: "memory");
#pragma unroll 2
    for (int kt = 0; kt < 4; ++kt) {
        bf16x8 br[4], bi[4];
#pragma unroll
        for (int ks = 0; ks < 4; ++ks) { br[ks] = *(const bf16x8*)(T64R + (size_t)(kt * 16 + l15) * 128 + ks * 32 + 8 * hq); bi[ks] = *(const bf16x8*)(T64I + (size_t)(kt * 16 + l15) * 128 + ks * 32 + 8 * hq); }
        const int k1 = kt * 16 + l15; const f32x2 tw = TW[k1 * n2];
#pragma unroll
        for (int mt = 0; mt < 4; ++mt) { f32x4 ar = {0.f, 0.f, 0.f, 0.f}, ai = {0.f, 0.f, 0.f, 0.f};
#pragma unroll
            for (int ks = 0; ks < 4; ++ks) { const bf16x8 a = *(const LAS bf16x8*)(Zt + (mt * 16 + l15) * ZS + ks * 32 + 8 * hq); ar = mma16(a, br[ks], ar); ai = mma16(a, bi[ks], ai); }
            const f32x4 gr = ar * tw[0] + ai * tw[1], gi = ai * tw[0] - ar * tw[1];
            bf16_t* dst = GB + (size_t)k1 * 128 + mt * 16 + 4 * hq;
            *(u32x2*)dst = pk4(gr); *(u32x2*)(dst + 64) = pk4(gi); } }
    __syncthreads();
}
__device__ __forceinline__ void unit_fourier_lat2(const Ctx& C, int u) {
    const int b = u >> 5, g = (u >> 3) & 3, kb = u & 7, l15 = C.lane & 15, hq = C.lane >> 4, k1 = kb * 8 + C.wave;
    const bf16_t* T64B = (const bf16_t*)(C.ws + WS_T64B); bf16_t* MIX = (bf16_t*)(C.ws + WS_R1);
    const bf16_t* GB = (const bf16_t*)(C.ws + WS_GB) + (size_t)((b * 4 + g) * 64) * 64 * 128 + (size_t)k1 * 128;
    constexpr int ZS = 136; LAS bf16_t* Tt = (LAS bf16_t*)(C.lds + C.wave * (64 * ZS * 2));
#pragma unroll 4
    for (int it = 0; it < 16; ++it) { const int q = it * 64 + C.lane, n2 = q >> 4, cc = q & 15, part = cc >> 3, m0 = (cc & 7) * 8;
        const bf16x8 v = *(const bf16x8*)(GB + (size_t)n2 * 64 * 128 + cc * 8);
#pragma unroll
        for (int j = 0; j < 8; ++j) Tt[(m0 + j) * ZS + part * 64 + n2] = (bf16_t)v[j]; }
    asm volatile("s_waitcnt lgkmcnt(0)" ::: "memory");
#pragma unroll 2
    for (int kt = 0; kt < 4; ++kt) {
        bf16x8 bb[4];
#pragma unroll
        for (int ks = 0; ks < 4; ++ks) bb[ks] = *(const bf16x8*)(T64B + (size_t)(kt * 16 + l15) * 128 + ks * 32 + 8 * hq);
        const int k2 = kt * 16 + l15; const int row = M_CTX + b * 4096 + k1 + 64 * k2;
#pragma unroll
        for (int mt = 0; mt < 4; ++mt) { f32x4 acc = {0.f, 0.f, 0.f, 0.f};
#pragma unroll
            for (int ks = 0; ks < 4; ++ks) { const bf16x8 a = *(const LAS bf16x8*)(Tt + (mt * 16 + l15) * ZS + ks * 32 + 8 * hq); acc = mma16(a, bb[ks], acc); }
            *(u32x2*)(MIX + (size_t)row * D + 512 + g * 64 + mt * 16 + 4 * hq) = pk4(acc * (1.f / 512.f)); } }
    __syncthreads();
}
constexpr float QSCALE = 0.10206207261596577f * 1.4426950408889634f;
__device__ __forceinline__ void unit_mla_prep(const Ctx& C, int layer, int u) {
    const Params& p = C.p;
    const bf16_t* PROJ = (const bf16_t*)(C.ws + WS_R2);
    bf16_t* Q = (bf16_t*)(C.ws + WS_Q); bf16_t* KN = (bf16_t*)(C.ws + WS_KN); bf16_t* VT = (bf16_t*)(C.ws + WS_VT); bf16_t* KR = (bf16_t*)(C.ws + WS_KR);
    const f32x2* ROPE = (const f32x2*)(C.ws + WS_ROPE);
    constexpr int QS = 200, KS = 136;
    LAS bf16_t* CQ = (LAS bf16_t*)C.lds;
    LAS bf16_t* CK = (LAS bf16_t*)(C.lds + 128 * QS * 2);
    const bool is_tok = u < 192;
    int r0 = 0, keyrow0, keypos0, nk; size_t vtbase; bool lat;
    if (is_tok) { r0 = u * 128; lat = r0 >= M_CTX;
        if (!lat) { keyrow0 = r0; keypos0 = r0 & 255; nk = 256; vtbase = (size_t)(r0 & ~255) * 256; }
        else { const int b = (r0 - M_CTX) >> 12, n = (r0 - M_CTX) & 4095; keyrow0 = M_CTX + b * 4352 + n; keypos0 = n; nk = 4352; vtbase = (size_t)(M_CTX + b * 4352) * 256; } }
    else { const int cu = u - 192, b = cu >> 1, half = cu & 1; lat = true; keyrow0 = M_CTX + b * 4352 + 4096 + half * 128; keypos0 = 4096 + half * 128; nk = 4352; vtbase = (size_t)(M_CTX + b * 4352) * 256; }
    { const int t = C.tid >> 2, sub = C.tid & 3;
      if (is_tok) {
        const int r = r0 + t; const bf16_t* base = PROJ + (size_t)r * NP;
        float q[48], k[32]; float sq = 0.f, sk = 0.f;
#pragma unroll
        for (int i = 0; i < 6; ++i) { const bf16x8 v = *(const bf16x8*)(base + PC_Q + sub * 48 + i * 8);
#pragma unroll
            for (int j = 0; j < 8; ++j) { q[i * 8 + j] = bf1((bf16_t)v[j]); sq += q[i * 8 + j] * q[i * 8 + j]; } }
#pragma unroll
        for (int i = 0; i < 4; ++i) { const bf16x8 v = *(const bf16x8*)(base + PC_KV + sub * 32 + i * 8);
#pragma unroll
            for (int j = 0; j < 8; ++j) { k[i * 8 + j] = bf1((bf16_t)v[j]); sk += k[i * 8 + j] * k[i * 8 + j]; } }
        sq += __shfl_xor(sq, 1); sq += __shfl_xor(sq, 2); sk += __shfl_xor(sk, 1); sk += __shfl_xor(sk, 2);
        const float rq = 1.f / sqrtf(sq * (1.f / 192.f) + EPS), rk = 1.f / sqrtf(sk * (1.f / 128.f) + EPS);
        const float* gq = p.in[I_GQ] + layer * 192 + sub * 48; const float* gk = p.in[I_GKV] + layer * 128 + sub * 32;
#pragma unroll
        for (int i = 0; i < 6; ++i) { u32x4 w; w.x = pk2(q[i * 8 + 0] * rq * gq[i * 8 + 0], q[i * 8 + 1] * rq * gq[i * 8 + 1]); w.y = pk2(q[i * 8 + 2] * rq * gq[i * 8 + 2], q[i * 8 + 3] * rq * gq[i * 8 + 3]);
            w.z = pk2(q[i * 8 + 4] * rq * gq[i * 8 + 4], q[i * 8 + 5] * rq * gq[i * 8 + 5]); w.w = pk2(q[i * 8 + 6] * rq * gq[i * 8 + 6], q[i * 8 + 7] * rq * gq[i * 8 + 7]);
            *(LAS u32x4*)(CQ + t * QS + sub * 48 + i * 8) = w; }
        float* sckv = nullptr;
        if (!lat) { const int s = r >> 8, pos = r & 255; sckv = p.out + OUT_CKV + ((size_t)(s * 4 + layer) * 256 + pos) * 128 + sub * 32; }
#pragma unroll
        for (int i = 0; i < 4; ++i) { float o[8];
#pragma unroll
            for (int j = 0; j < 8; ++j) o[j] = k[i * 8 + j] * rk * gk[i * 8 + j];
            u32x4 w; w.x = pk2(o[0], o[1]); w.y = pk2(o[2], o[3]); w.z = pk2(o[4], o[5]); w.w = pk2(o[6], o[7]);
            *(LAS u32x4*)(CK + t * KS + sub * 32 + i * 8) = w;
            if (!lat) { *(f32x4*)(sckv + i * 8) = (f32x4){o[0], o[1], o[2], o[3]}; *(f32x4*)(sckv + i * 8 + 4) = (f32x4){o[4], o[5], o[6], o[7]}; } }
        { const bf16x8 v = *(const bf16x8*)(base + PC_KR + sub * 8); float x[8], o[8];
#pragma unroll
          for (int j = 0; j < 8; ++j) x[j] = bf1((bf16_t)v[j]);
          if (lat) { const int n = (r - M_CTX) & 4095; const int pos = (sub >> 1) == 0 ? (n >> 6) : (n & 63);
#pragma unroll
              for (int j = 0; j < 8; ++j) { const float pr = __shfl_xor(x[j], 1); const f32x2 cs = ROPE[pos * 8 + j]; o[j] = (sub & 1) == 0 ? x[j] * cs[0] - pr * cs[1] : x[j] * cs[0] + pr * cs[1]; } }
          else {
#pragma unroll
              for (int j = 0; j < 8; ++j) o[j] = x[j];
              const int s = r >> 8, pos = r & 255; float* skr = p.out + OUT_KR + ((size_t)(s * 4 + layer) * 256 + pos) * 32 + sub * 8;
              *(f32x4*)skr = (f32x4){o[0], o[1], o[2], o[3]}; *(f32x4*)(skr + 4) = (f32x4){o[4], o[5], o[6], o[7]}; }
          u32x4 w; w.x = pk2(o[0], o[1]); w.y = pk2(o[2], o[3]); w.z = pk2(o[4], o[5]); w.w = pk2(o[6], o[7]);
          *(u32x4*)(KR + (size_t)(keyrow0 + t) * 32 + sub * 8) = w; }
      } else {
        const int cu = u - 192, b = cu >> 1, half = cu & 1, row = half * 128 + t;
        const float* src = p.in[I_CCKV] + ((size_t)(b * 4 + layer) * 256 + row) * 128 + sub * 32;
#pragma unroll
        for (int i = 0; i < 4; ++i) { const f32x4 v0 = *(const f32x4*)(src + i * 8), v1 = *(const f32x4*)(src + i * 8 + 4);
            u32x4 w; w.x = pk2(v0[0], v0[1]); w.y = pk2(v0[2], v0[3]); w.z = pk2(v1[0], v1[1]); w.w = pk2(v1[2], v1[3]);
            *(LAS u32x4*)(CK + t * KS + sub * 32 + i * 8) = w; }
        const float* ksrc = p.in[I_CKR] + ((size_t)(b * 4 + layer) * 256 + row) * 32 + sub * 8;
        const f32x4 v0 = *(const f32x4*)ksrc, v1 = *(const f32x4*)(ksrc + 4);
        u32x4 w; w.x = pk2(v0[0], v0[1]); w.y = pk2(v0[2], v0[3]); w.z = pk2(v1[0], v1[1]); w.w = pk2(v1[2], v1[3]);
        *(u32x4*)(KR + (size_t)(keyrow0 + t) * 32 + sub * 8) = w;
      } }
    __syncthreads();
    const int l15 = C.lane & 15, hq = C.lane >> 4, w = C.wave;
    if (is_tok) {
        const bf16_t* Wq = (const bf16_t*)(C.wl(layer) + WL_UQ);
        bf16x8 aq[3][6];
#pragma unroll
        for (int j = 0; j < 3; ++j)
#pragma unroll
            for (int ks = 0; ks < 6; ++ks) aq[j][ks] = *(const bf16x8*)(Wq + (size_t)((3 * w + j) * 16 + l15) * 192 + ks * 32 + 8 * hq);
#pragma unroll 2
        for (int tt = 0; tt < 8; ++tt) {
            bf16x8 bq[6];
#pragma unroll
            for (int ks = 0; ks < 6; ++ks) bq[ks] = *(const LAS bf16x8*)(CQ + (tt * 16 + l15) * QS + ks * 32 + 8 * hq);
            const int r = r0 + tt * 16 + l15; const int n = (r - M_CTX) & 4095;
#pragma unroll
            for (int j = 0; j < 3; ++j) { const int nt = 3 * w + j; f32x4 acc = {0.f, 0.f, 0.f, 0.f};
#pragma unroll
                for (int ks = 0; ks < 6; ++ks) acc = mma16(aq[j][ks], bq[ks], acc);
                const int sub6 = nt % 6;
                if (lat && sub6 >= 4) { const int pos = sub6 == 4 ? (n >> 6) : (n & 63);
#pragma unroll
                    for (int jj = 0; jj < 4; ++jj) { const float pr = __shfl_xor(acc[jj], 32); const f32x2 cs = ROPE[pos * 8 + ((4 * hq + jj) & 7)]; acc[jj] = hq < 2 ? acc[jj] * cs[0] - pr * cs[1] : acc[jj] * cs[0] + pr * cs[1]; } }
                *(u32x2*)(Q + (size_t)r * 384 + nt * 16 + 4 * hq) = pk4(acc * QSCALE); }
        }
    }
    { const bf16_t* Wkv = (const bf16_t*)(C.wl(layer) + WL_UKV);
      bf16x8 wf[4][4];
#pragma unroll
      for (int j = 0; j < 4; ++j)
#pragma unroll
          for (int ks = 0; ks < 4; ++ks) wf[j][ks] = *(const bf16x8*)(Wkv + (size_t)((4 * w + j) * 16 + l15) * 128 + ks * 32 + 8 * hq);
      const int h = w >> 1; const bool isv = (w & 1) != 0;
#pragma unroll 2
      for (int tt = 0; tt < 8; ++tt) {
          bf16x8 ck[4];
#pragma unroll
          for (int ks = 0; ks < 4; ++ks) ck[ks] = *(const LAS bf16x8*)(CK + (tt * 16 + l15) * KS + ks * 32 + 8 * hq);
#pragma unroll
          for (int j = 0; j < 4; ++j) { f32x4 acc = {0.f, 0.f, 0.f, 0.f};
              if (!isv) {
#pragma unroll
                  for (int ks = 0; ks < 4; ++ks) acc = mma16(wf[j][ks], ck[ks], acc);
                  *(u32x2*)(KN + (size_t)(keyrow0 + tt * 16 + l15) * 256 + h * 64 + j * 16 + 4 * hq) = pk4(acc);
              } else {
#pragma unroll
                  for (int ks = 0; ks < 4; ++ks) acc = mma16(ck[ks], wf[j][ks], acc);
                  *(u32x2*)(VT + vtbase + (size_t)(h * 64 + j * 16 + l15) * nk + keypos0 + tt * 16 + 4 * hq) = pk4(acc);
              } } } }
    __syncthreads();
}

constexpr int AKS = 104, AVS = 72;
constexpr int ABUF = 64 * AKS * 2 + 64 * AVS * 2;
__device__ __forceinline__ void unit_attention(const Ctx& C, int u) {
    int rowbase, keyrow0, nk, h; size_t vtbase;
    if (u < 128) { const int s = u >> 2; h = u & 3; rowbase = s * 256; keyrow0 = s * 256; nk = 256; vtbase = (size_t)(s * 256) * 256; }
    else { const int v0 = u - 128; const int v = (C.G == 256) ? (((v0 & 7) * 2 + (v0 >> 7)) << 4) | ((v0 >> 3) & 15) : v0;
           const int b = v >> 6, qb = v & 15; h = (v >> 4) & 3; rowbase = M_CTX + b * 4096 + qb * 256; keyrow0 = M_CTX + b * 4352; nk = 4352; vtbase = (size_t)keyrow0 * 256; }
    const bf16_t* Q = (const bf16_t*)(C.ws + WS_Q); const bf16_t* KN = (const bf16_t*)(C.ws + WS_KN); const bf16_t* VT = (const bf16_t*)(C.ws + WS_VT); const bf16_t* KR = (const bf16_t*)(C.ws + WS_KR);
    bf16_t* MIX = (bf16_t*)(C.ws + WS_R1);
    const int l31 = C.lane & 31, hh = C.lane >> 5; const int qrow = rowbase + C.wave * 32 + l31;
    bf16x8 qf[6];
#pragma unroll
    for (int ks = 0; ks < 6; ++ks) qf[ks] = *(const bf16x8*)(Q + (size_t)qrow * 384 + h * 96 + ks * 16 + 8 * hh);
    f32x16 o0, o1;
#pragma unroll
    for (int i = 0; i < 16; ++i) { o0[i] = 0.f; o1[i] = 0.f; }
    float mrun = -1e30f, lsum = 0.f;
    const int skey = C.tid >> 3, sc8 = (C.tid & 7) * 8, rkey = (C.tid & 255) >> 2, rc8 = (C.tid & 3) * 8;
    const bf16_t* gkn = KN + (size_t)(keyrow0 + skey) * 256 + h * 64 + sc8;
    const bf16_t* gkr = KR + (size_t)(keyrow0 + rkey) * 32 + rc8;
    const bf16_t* gvt = VT + vtbase + (size_t)(h * 64 + skey) * nk + sc8;
    const bool do_r = C.tid < 256;
    const int lkn = (skey * AKS + sc8) * 2, lkr = (rkey * AKS + 64 + rc8) * 2, lvt = 64 * AKS * 2 + (skey * AVS + sc8) * 2;
    const int ntile = nk >> 6;
    u32x4 rk = *(const u32x4*)gkn, rr = do_r ? *(const u32x4*)gkr : (u32x4){0u, 0u, 0u, 0u}, rv = *(const u32x4*)gvt;
    *(LAS u32x4*)(C.lds + lkn) = rk; if (do_r) *(LAS u32x4*)(C.lds + lkr) = rr; *(LAS u32x4*)(C.lds + lvt) = rv;
    __syncthreads();
#pragma unroll 1
    for (int kt = 0; kt < ntile; ++kt) {
        const bool more = kt + 1 < ntile;
        if (more) { rk = *(const u32x4*)(gkn + (size_t)(kt + 1) * 64 * 256); if (do_r) rr = *(const u32x4*)(gkr + (size_t)(kt + 1) * 64 * 32); rv = *(const u32x4*)(gvt + (kt + 1) * 64); }
        LAS unsigned char* B = C.lds + (kt & 1) * ABUF;
        const LAS bf16_t* Kl = (const LAS bf16_t*)B; const LAS bf16_t* Vl = (const LAS bf16_t*)(B + 64 * AKS * 2);
        bf16x8 ka[2][6];
#pragma unroll
        for (int ks = 0; ks < 6; ++ks) { ka[0][ks] = *(const LAS bf16x8*)(Kl + l31 * AKS + ks * 16 + 8 * hh); ka[1][ks] = *(const LAS bf16x8*)(Kl + (32 + l31) * AKS + ks * 16 + 8 * hh); }
        __builtin_amdgcn_sched_barrier(0);
        f32x16 s0, s1;
#pragma unroll
        for (int i = 0; i < 16; ++i) { s0[i] = 0.f; s1[i] = 0.f; }
#pragma unroll
        for (int ks = 0; ks < 6; ++ks) { s0 = mma32(ka[0][ks], qf[ks], s0); s1 = mma32(ka[1][ks], qf[ks], s1); }
        __builtin_amdgcn_sched_barrier(0);
        u32x2 vr[2][2][4];
#pragma unroll
        for (int t = 0; t < 2; ++t)
#pragma unroll
            for (int ss = 0; ss < 2; ++ss) { const int ko = 32 * t + 16 * ss + 4 * hh;
                vr[t][ss][0] = *(const LAS u32x2*)(Vl + l31 * AVS + ko); vr[t][ss][1] = *(const LAS u32x2*)(Vl + l31 * AVS + ko + 8);
                vr[t][ss][2] = *(const LAS u32x2*)(Vl + (32 + l31) * AVS + ko); vr[t][ss][3] = *(const LAS u32x2*)(Vl + (32 + l31) * AVS + ko + 8); }
        __builtin_amdgcn_sched_barrier(0);
        float mx = fmaxf(s0[0], s1[0]);
#pragma unroll
        for (int i = 1; i < 16; ++i) mx = fmaxf(mx, fmaxf(s0[i], s1[i]));
        mx = fmaxf(mx, __shfl_xor(mx, 32));
        if (__builtin_amdgcn_ballot_w64(mx > mrun + 8.f) != 0ull) { const float mnew = fmaxf(mrun, mx); const float alpha = __builtin_amdgcn_exp2f(mrun - mnew); lsum *= alpha; o0 = o0 * alpha; o1 = o1 * alpha; mrun = mnew; }
        float ps = 0.f;
#pragma unroll
        for (int i = 0; i < 16; ++i) { s0[i] = __builtin_amdgcn_exp2f(s0[i] - mrun); s1[i] = __builtin_amdgcn_exp2f(s1[i] - mrun); ps += s0[i] + s1[i]; }
        lsum += ps;
#pragma unroll
        for (int t = 0; t < 2; ++t)
#pragma unroll
            for (int ss = 0; ss < 2; ++ss) {
                u32x4 w;
                if (t == 0) { w.x = pk2(s0[8 * ss + 0], s0[8 * ss + 1]); w.y = pk2(s0[8 * ss + 2], s0[8 * ss + 3]); w.z = pk2(s0[8 * ss + 4], s0[8 * ss + 5]); w.w = pk2(s0[8 * ss + 6], s0[8 * ss + 7]); }
                else { w.x = pk2(s1[8 * ss + 0], s1[8 * ss + 1]); w.y = pk2(s1[8 * ss + 2], s1[8 * ss + 3]); w.z = pk2(s1[8 * ss + 4], s1[8 * ss + 5]); w.w = pk2(s1[8 * ss + 6], s1[8 * ss + 7]); }
                const bf16x8 pf = __builtin_bit_cast(bf16x8, w);
                const bf16x8 va = __builtin_bit_cast(bf16x8, (u32x4){vr[t][ss][0].x, vr[t][ss][0].y, vr[t][ss][1].x, vr[t][ss][1].y}), vb = __builtin_bit_cast(bf16x8, (u32x4){vr[t][ss][2].x, vr[t][ss][2].y, vr[t][ss][3].x, vr[t][ss][3].y});
                o0 = mma32(va, pf, o0); o1 = mma32(vb, pf, o1);
            }
        if (more) { LAS unsigned char* Bn = C.lds + ((kt + 1) & 1) * ABUF; *(LAS u32x4*)(Bn + lkn) = rk; if (do_r) *(LAS u32x4*)(Bn + lkr) = rr; *(LAS u32x4*)(Bn + lvt) = rv; }
        __syncthreads();
    }
    lsum += __shfl_xor(lsum, 32);
    const float inv = 1.f / lsum;
    bf16_t* orow = MIX + (size_t)qrow * D + 768 + h * 64;
#pragma unroll
    for (int i = 0; i < 4; ++i) { const int dv = 8 * i + 4 * hh;
        *(u32x2*)(orow + dv) = pk4((f32x4){o0[4 * i] * inv, o0[4 * i + 1] * inv, o0[4 * i + 2] * inv, o0[4 * i + 3] * inv});
        *(u32x2*)(orow + 32 + dv) = pk4((f32x4){o1[4 * i] * inv, o1[4 * i + 1] * inv, o1[4 * i + 2] * inv, o1[4 * i + 3] * inv}); }
}

#define XB_TMO      128
#define XB_XCNT(j)  (256  + 64 * (j))
#define XB_XSUB(j)  (1280 + 64 * (j))
#define XB_XGEN(j)  (2304 + 64 * (j))
#define XB_TOP      3328
#define XB_TOPGEN   3392
#define XCD_BAR_WORDS 3456
#define XB_SPIN_CAP (1u << 18)

__device__ __forceinline__ unsigned xb_ld(unsigned* p)              { return __hip_atomic_load(p, __ATOMIC_RELAXED, __HIP_MEMORY_SCOPE_AGENT); }
__device__ __forceinline__ unsigned xb_add(unsigned* p, unsigned v) { return __hip_atomic_fetch_add(p, v, __ATOMIC_RELAXED, __HIP_MEMORY_SCOPE_AGENT); }
__device__ __forceinline__ unsigned xb_xcc_id() { return (unsigned)__builtin_amdgcn_s_getreg((3 << 11) | 20) & 0xFu; }
#define XB_SPIN(cond, bar) do { unsigned _sp = 0; while (cond) { __builtin_amdgcn_s_sleep(1); \
    if ((++_sp & 255u) == 0u) { if (xb_ld(&(bar)[XB_TMO])) break; if (_sp > XB_SPIN_CAP) { atomicAdd(&(bar)[XB_TMO], 1u); break; } } } } while (0)

struct XcdBarrier {
    unsigned* bar; unsigned x;
    volatile LAS unsigned* st;
};

__device__ __forceinline__ XcdBarrier xcd_barrier_post(unsigned* bar, volatile LAS unsigned* st) {
    XcdBarrier b; b.bar = bar; b.x = xb_xcc_id(); b.st = st;
    if (threadIdx.x == 0) (void)xb_add(&bar[XB_XCNT(b.x)], 1u);
    return b;
}
__device__ __forceinline__ void xcd_barrier_complete(unsigned* bar, unsigned x, unsigned& nloc, unsigned& nx) {
    const unsigned G = gridDim.x * gridDim.y * gridDim.z;
    unsigned sum, cnt, mine, sp = 0u;
    for (;;) {
        sum = 0u; cnt = 0u; mine = 0u;
#pragma unroll
        for (unsigned j = 0; j < 16; ++j) { const unsigned c = xb_ld(&bar[XB_XCNT(j)]); sum += c; cnt += (c > 0u) ? 1u : 0u; mine = (j == x) ? c : mine; }
        if (sum == G) break;
        __builtin_amdgcn_s_sleep(1);
        if ((++sp & 255u) == 0u) { if (xb_ld(&bar[XB_TMO])) break; if (sp > XB_SPIN_CAP) { atomicAdd(&bar[XB_TMO], 1u); break; } }
    }
    nloc = mine > 0u ? mine : 1u; nx = cnt > 0u ? cnt : 1u;
}

__device__ __forceinline__ void xcd_barrier(const XcdBarrier& b) {
    asm volatile("s_waitcnt vmcnt(0)" ::: "memory");
    __syncthreads();
    if (threadIdx.x == 0) {
        unsigned* bar = b.bar;
        __builtin_amdgcn_s_waitcnt(0);
        unsigned nloc = b.st[0], nx = b.st[1];
        if (nloc == 0u) { xcd_barrier_complete(bar, b.x, nloc, nx); b.st[0] = nloc; b.st[1] = nx; }
        const unsigned old = xb_add(&bar[XB_XSUB(b.x)], 1u);
        const unsigned gen = old / nloc;
        if (old + 1u == (gen + 1u) * nloc) {
            __builtin_amdgcn_fence(__ATOMIC_RELEASE, "agent");
            asm volatile("s_waitcnt vmcnt(0)" ::: "memory");
            const unsigned og = xb_add(&bar[XB_TOP], 1u);
            const unsigned tg = og / nx;
            if (og + 1u == (tg + 1u) * nx) xb_add(&bar[XB_TOPGEN], 1u);
            else XB_SPIN(xb_ld(&bar[XB_TOPGEN]) == tg, bar);
            __builtin_amdgcn_fence(__ATOMIC_ACQUIRE, "agent");
            xb_add(&bar[XB_XGEN(b.x)], 1u);
            asm volatile("s_waitcnt vmcnt(0)" ::: "memory");
        } else {
            XB_SPIN(xb_ld(&bar[XB_XGEN(b.x)]) == gen, bar);
            __builtin_amdgcn_fence(__ATOMIC_ACQUIRE, "agent");
            asm volatile("s_waitcnt vmcnt(0)" ::: "memory");
        }
    }
    __syncthreads();
}

__global__ void __launch_bounds__(NTHREADS, 2) mk_fwd(Params p) {
    extern __shared__ __attribute__((aligned(16))) unsigned char lds_raw[];
    cg::grid_group grid = cg::this_grid();
    Ctx C; C.p = p; C.lds = (LAS unsigned char*)lds_raw; C.tid = threadIdx.x; C.lane = C.tid & 63; C.wave = __builtin_amdgcn_readfirstlane(C.tid >> 6); C.bid = blockIdx.x; C.G = gridDim.x; C.ws = p.ws;

    volatile LAS unsigned* bst = (volatile LAS unsigned*)(C.lds + LDS_BYTES - 64);
    if (threadIdx.x < 2) bst[threadIdx.x] = 0u;
    __syncthreads();
    const XcdBarrier bar = xcd_barrier_post((unsigned*)(p.ws + WS_BAR), bst);
    C.refresh(); phase_prologue(C);
    grid.sync();
    C.refresh(); phase_norm0(C);
    xcd_barrier(bar);
#pragma unroll 1
    for (int layer = 0; layer < DEPTH; ++layer) {
        { C.refresh(); bf16_t* R1 = (bf16_t*)(C.ws + WS_R1); bf16_t* R2 = (bf16_t*)(C.ws + WS_R2); unsigned char* wl = C.wl(layer); pg8::Gemm g{R1, (const bf16_t*)(wl + WL_IN), M, NPP, D}; pg8::StaticOrder S; S.init(M, NPP, C.G, C.bid); pg8::EpiStore E{R2, NP, NP};
          pg8::gemm_phase<pg8::EpiStore, pg8::StaticOrder, true, true>(C.lds, g, S, E); }
        xcd_barrier(bar);
        C.refresh();
        for (int u = C.bid; u < 768 + 192 + 128 + 128 + 200; u += C.G) {
            C.refresh();
            if (u < 768) unit_chunk_mlp(C, layer, u);
            else if (u < 960) unit_conv(C, layer, u - 768);
            else if (u < 1088) unit_fourier_ctx(C, u - 960);
            else if (u < 1216) unit_fourier_lat1(C, u - 1088);
            else unit_mla_prep(C, layer, u - 1216);
        }
        xcd_barrier(bar);
        C.refresh();
        for (int u = C.bid; u < 512; u += C.G) {
            C.refresh();
            if (u < 256) unit_attention(C, 128 + u);
            else if (u < 384) unit_attention(C, u - 256);
            else unit_fourier_lat2(C, u - 384);
        }
        xcd_barrier(bar);
        { C.refresh(); bf16_t* R1 = (bf16_t*)(C.ws + WS_R1); bf16_t* R2 = (bf16_t*)(C.ws + WS_R2); unsigned char* wl = C.wl(layer); pg8::Gemm g{R1, (const bf16_t*)(wl + WL_OUT), M, D, D}; pg8::StaticOrder S; S.init(M, D, C.G, C.bid); pg8::EpiStore E{R2, D, D};
          pg8::gemm_phase<pg8::EpiStore, pg8::StaticOrder, true, true>(C.lds, g, S, E); }
        xcd_barrier(bar);
        C.refresh(); phase_post<0>(C, layer);
        xcd_barrier(bar);
        { C.refresh(); bf16_t* R1 = (bf16_t*)(C.ws + WS_R1); bf16_t* R2 = (bf16_t*)(C.ws + WS_R2); unsigned char* wl = C.wl(layer); pg8::Gemm g{R1, (const bf16_t*)(wl + WL_GU), M, 2 * FF, D}; pg8::StaticOrder S; S.init(M, 2 * FF, C.G, C.bid); pg8::EpiSwiGLU E{R2, FF};
          pg8::gemm_phase<pg8::EpiSwiGLU, pg8::StaticOrder, true, true>(C.lds, g, S, E); }
        xcd_barrier(bar);
        { C.refresh(); bf16_t* R2 = (bf16_t*)(C.ws + WS_R2); bf16_t* R3 = (bf16_t*)(C.ws + WS_MLA); unsigned char* wl = C.wl(layer); pg8::Gemm g{R2, (const bf16_t*)(wl + WL_DN), M, D, FF}; pg8::StaticOrder S; S.init(M, D, C.G, C.bid); pg8::EpiStore E{R3, D, D};
          pg8::gemm_phase<pg8::EpiStore, pg8::StaticOrder, true, true>(C.lds, g, S, E); }
        xcd_barrier(bar);
        C.refresh(); phase_post<1>(C, layer);
        if (layer + 1 < DEPTH) xcd_barrier(bar);
    }
}

extern "C" void kernel_launch(void* const* d_in, const int* in_sizes, int n_in, void* d_out, int out_size, void* d_ws, size_t ws_size, hipStream_t stream) {
    static int grid = 0;
    if (grid == 0) {
        if (n_in != 24 || ws_size < WS_END) { fprintf(stderr, "kernel_launch: need 24 inputs and %zu bytes of workspace; got %d, %zu\n", (size_t)WS_END, n_in, ws_size); grid = -1; return; }
        int dev = 0, cus = 0, per_cu = 0;
        if (hipGetDevice(&dev) != hipSuccess || hipDeviceGetAttribute(&cus, hipDeviceAttributeMultiprocessorCount, dev) != hipSuccess) { grid = -1; return; }
        if (hipFuncSetAttribute((const void*)mk_fwd, hipFuncAttributeMaxDynamicSharedMemorySize, LDS_BYTES) != hipSuccess) { fprintf(stderr, "kernel_launch: hipFuncSetAttribute failed\n"); grid = -1; return; }
        if (hipOccupancyMaxActiveBlocksPerMultiprocessor(&per_cu, (const void*)mk_fwd, NTHREADS, LDS_BYTES) != hipSuccess || per_cu < 1) fprintf(stderr, "kernel_launch: occupancy query says %d blocks per CU\n", per_cu);
        (void)hipGetLastError();
        grid = cus;
    }
    if (grid < 0) return;
    Params p{};
    for (int i = 0; i < 24; ++i) p.in[i] = (const float*)d_in[i];
    p.out = (float*)d_out; p.ws = (unsigned char*)d_ws;
    if (hipMemsetAsync((char*)d_ws + WS_BAR, 0, WS_BAR_BYTES, stream) != hipSuccess) { fprintf(stderr, "kernel_launch: memset failed\n"); return; }
    void* args[] = {&p};
    hipError_t e = hipLaunchCooperativeKernel((const void*)mk_fwd, dim3(grid), dim3(NTHREADS), args, LDS_BYTES, stream);
    if (e != hipSuccess) fprintf(stderr, "kernel_launch: cooperative launch failed: %s (grid %d)\n", hipGetErrorString(e), grid);
}
```

```cpp
#include <hip/hip_runtime.h>
#include <hip/hip_cooperative_groups.h>
#include <cstdio>
#include <cstdint>
namespace cg = cooperative_groups;
namespace pg8 {
#define PG8_LAS __attribute__((address_space(3)))
typedef unsigned short bf16_t;
typedef short bf16x8 __attribute__((ext_vector_type(8)));
typedef float f32x4 __attribute__((ext_vector_type(4)));
typedef unsigned u32x4 __attribute__((ext_vector_type(4)));
constexpr int BM = 256, BK = 64, HALF = 128, HTB = HALF * BK * 2  , STAGE_BYTES = 8 * HTB, NXCD = 8, WGM = 8;

__host__ __device__ __forceinline__ int lds_byte(int r, int c) { const int st = (r >> 4) * 2 + (c >> 5), rr = r & 15, cc = c & 31, ob = rr * 64 + cc * 2; return st * 1024 + (ob ^ (((ob >> 9) & 1) << 5)); }
__host__ __device__ __forceinline__ void stage_rc(int b, int& R, int& C) { const int st = b / 1024, sb = b % 1024, swz = sb ^ (((sb >> 9) & 1) << 5); R = (st >> 1) * 16 + swz / 64; C = (st & 1) * 32 + (swz % 64) / 2; }
__host__ __device__ __forceinline__ int perm32(int rho) { const int n = rho >> 4, i = rho & 15; return 8 * (i >> 2) + 4 * n + (i & 3); }

struct Unit { int pm, pn; };
struct Gemm { const bf16_t* A; const bf16_t* Bt; int M, N, K; };

struct StaticOrder {
    int nM, nN, nwg, G, c;
    __host__ __device__ void init(int M, int N, int G_, int c_) { nM = M / BM; nN = N / BM; nwg = nM * nN; G = G_; c = c_; }
    __host__ __device__ bool next(int i, Unit& u) const {
        const long L = (long)i * G + c; if (L >= nwg) return false;
        int wgid = (int)L; { const int q = nwg / NXCD, r = nwg % NXCD, xcd = wgid % NXCD, off = wgid / NXCD; wgid = (xcd < r ? xcd * (q + 1) : r * (q + 1) + (xcd - r) * q) + off; }
        const int nig = WGM * nN, gid = wgid / nig, fm = gid * WGM, gsz = (nM - fm) < WGM ? (nM - fm) : WGM;
        u.pm = fm + ((wgid % nig) % gsz); u.pn = (wgid % nig) / gsz; return true;
    }
    __device__ __forceinline__ void a_ready(const Unit&) const {}
    __device__ __forceinline__ void done(const Unit&) const {}
};

__device__ __forceinline__ unsigned cvt_pk_bf16(float lo, float hi) { unsigned r; asm volatile("v_cvt_pk_bf16_f32 %0, %1, %2" : "=v"(r) : "v"(lo), "v"(hi)); return r; }
typedef float f32x2 __attribute__((ext_vector_type(2)));
struct EpiStore {
    static constexpr bool PERM = true, AFTER_DRAIN = false;
    bf16_t* O; int ldc; int ncols;
    __device__ __forceinline__ void operator()(const f32x4 (&acc)[2][2][4][2], const Unit& u, int wr, int wc, int fr, int fq) const {
        const int row0 = u.pm * BM + wr * 64 + fr; const int col0 = u.pn * BM + wc * 32 + 8 * fq;
#pragma unroll
        for (int ai = 0; ai < 2; ++ai)
#pragma unroll
            for (int m = 0; m < 4; ++m) { bf16_t* rowp = O + (size_t)(row0 + ai * HALF + m * 16) * ldc + col0;
#pragma unroll
                for (int bj = 0; bj < 2; ++bj) { const f32x4 v0 = acc[ai][bj][m][0], v1 = acc[ai][bj][m][1];
                    u32x4 w; w.x = cvt_pk_bf16(v0[0], v0[1]); w.y = cvt_pk_bf16(v0[2], v0[3]); w.z = cvt_pk_bf16(v1[0], v1[1]); w.w = cvt_pk_bf16(v1[2], v1[3]);
                    if (col0 + bj * HALF < ncols) *(u32x4*)(rowp + bj * HALF) = w; } }
    }
};
struct EpiStoreWT {
    static constexpr bool PERM = true, AFTER_DRAIN = false;
    bf16_t* O; int ldc; int ncols;
    __device__ __forceinline__ void operator()(const f32x4 (&acc)[2][2][4][2], const Unit& u, int wr, int wc, int fr, int fq) const {
        const int row0 = u.pm * BM + wr * 64 + fr; const int col0 = u.pn * BM + wc * 32 + 8 * fq;
#pragma unroll
        for (int ai = 0; ai < 2; ++ai)
#pragma unroll
            for (int m = 0; m < 4; ++m) { bf16_t* rowp = O + (size_t)(row0 + ai * HALF + m * 16) * ldc + col0;
#pragma unroll
                for (int bj = 0; bj < 2; ++bj) { const f32x4 v0 = acc[ai][bj][m][0], v1 = acc[ai][bj][m][1];
                    const unsigned long long lo = (unsigned long long)cvt_pk_bf16(v0[0], v0[1]) | ((unsigned long long)cvt_pk_bf16(v0[2], v0[3]) << 32);
                    const unsigned long long hi = (unsigned long long)cvt_pk_bf16(v1[0], v1[1]) | ((unsigned long long)cvt_pk_bf16(v1[2], v1[3]) << 32);
                    unsigned long long* q = (unsigned long long*)(rowp + bj * HALF);
                    __hip_atomic_store(q, lo, __ATOMIC_RELAXED, __HIP_MEMORY_SCOPE_AGENT); __hip_atomic_store(q + 1, hi, __ATOMIC_RELAXED, __HIP_MEMORY_SCOPE_AGENT); } }
    }
};
__device__ __forceinline__ float silu_mul(float g, float u) { return g * u * __builtin_amdgcn_rcpf(1.f + __expf(-g)); }
struct EpiSwiGLU {
    static constexpr bool PERM = true, AFTER_DRAIN = false;
    bf16_t* O; int ldc;
    __device__ __forceinline__ void operator()(const f32x4 (&acc)[2][2][4][2], const Unit& u, int wr, int wc, int fr, int fq) const {
        const int row0 = u.pm * BM + wr * 64 + fr; const int col0 = u.pn * HALF + wc * 32 + 8 * fq;
#pragma unroll
        for (int ai = 0; ai < 2; ++ai)
#pragma unroll
            for (int m = 0; m < 4; ++m) { bf16_t* rowp = O + (size_t)(row0 + ai * HALF + m * 16) * ldc + col0;
                const f32x4 g0 = acc[ai][0][m][0], g1 = acc[ai][0][m][1], u0 = acc[ai][1][m][0], u1 = acc[ai][1][m][1];
                u32x4 w; w.x = cvt_pk_bf16(silu_mul(g0[0], u0[0]), silu_mul(g0[1], u0[1])); w.y = cvt_pk_bf16(silu_mul(g0[2], u0[2]), silu_mul(g0[3], u0[3]));
                w.z = cvt_pk_bf16(silu_mul(g1[0], u1[0]), silu_mul(g1[1], u1[1])); w.w = cvt_pk_bf16(silu_mul(g1[2], u1[2]), silu_mul(g1[3], u1[3]));
                *(u32x4*)rowp = w; }
    }
};

struct PanelOrder {
    int nN, nwg, G, c; unsigned* cnt;
    __device__ void init(int M, int N, int G_, int c_, unsigned* cnt_) { nN = N / BM; nwg = (M / BM) * nN; G = G_; c = c_; cnt = cnt_; }
    __device__ bool next(int i, Unit& u) const { const long L = (long)i * G + c; if (L >= nwg) return false; u.pm = (int)L / nN; u.pn = (int)L % nN; return true; }
    __device__ __forceinline__ void a_ready(const Unit&) const {}
    __device__ __forceinline__ void done(const Unit& u) const {
        asm volatile("s_waitcnt vmcnt(0)" ::: "memory");
        if ((threadIdx.x & 63) == 0) __hip_atomic_fetch_add(cnt + u.pm, 1u, __ATOMIC_RELAXED, __HIP_MEMORY_SCOPE_AGENT);
    }
};
template <class Epi, class Sched, bool ALIGN_EPI = false, bool SP2 = false>
__device__ __forceinline__ void gemm_phase(PG8_LAS unsigned char* lds, const Gemm g, const Sched& S, const Epi& E) {
    int tid_ = threadIdx.x; asm volatile("" : "+v"(tid_));
    const int tid = tid_, wid = __builtin_amdgcn_readfirstlane(tid >> 6), lane = tid & 63, wr = wid >> 2, wc = wid & 3, fr = lane & 15, fq = lane >> 4;
    const int K = g.K, nt = K / BK;
    unsigned voffA[2], voffB[2];
#pragma unroll
    for (int i = 0; i < 2; ++i) { int R, C; stage_rc(tid * 16 + i * 8192, R, C); const int Rb = Epi::PERM ? ((R & ~31) + perm32(R & 31)) : R;
        voffA[i] = (unsigned)(R * K + C) * 2u; voffB[i] = (unsigned)(Rb * K + C) * 2u; }
    const size_t kstep = (size_t)(BK * 2);
    const size_t hstep = (size_t)HALF * K * 2;
    const size_t tstep = 2 * hstep;
    const unsigned ldsw = (unsigned)wid * 1024u;
    const int aoff = lds_byte(wr * 64 + fr, fq * 8), boff = lds_byte(wc * 32 + fr, fq * 8);
#define PG8_SA(b, h) (((b) * 2 + (h)) * HTB)
#define PG8_SB(b, h) ((4 + (b) * 2 + (h)) * HTB)
#define PG8_STAGE(bufoff, gbase, voff) do { _Pragma("unroll") for (int _i = 0; _i < 2; ++_i) \
        __builtin_amdgcn_global_load_lds((const unsigned*)((const char*)(gbase) + (voff)[_i]), (PG8_LAS unsigned*)(lds + (bufoff) + ldsw + _i * 8192), 16, 0, 0); } while (0)
#define PG8_LDA(dst, b, h) do { _Pragma("unroll") for (int m = 0; m < 4; ++m) _Pragma("unroll") for (int k = 0; k < 2; ++k) dst[m][k] = *(const PG8_LAS bf16x8*)(lds + PG8_SA(b, h) + aoff + m * 2048 + k * 1024); } while (0)
#define PG8_LDB(dst, b, h) do { _Pragma("unroll") for (int n = 0; n < 2; ++n) _Pragma("unroll") for (int k = 0; k < 2; ++k) dst[n][k] = *(const PG8_LAS bf16x8*)(lds + PG8_SB(b, h) + boff + n * 2048 + k * 1024); } while (0)
#define PG8_MMA(ai, bj, At, Bt) do { __builtin_amdgcn_s_setprio(1); _Pragma("unroll") for (int m = 0; m < 4; ++m) _Pragma("unroll") for (int n = 0; n < 2; ++n) _Pragma("unroll") for (int k = 0; k < 2; ++k) \
        acc[ai][bj][m][n] = __builtin_amdgcn_mfma_f32_16x16x32_bf16(Bt[n][k], At[m][k], acc[ai][bj][m][n], 0, 0, 0); __builtin_amdgcn_s_setprio(0); } while (0)
#define PG8_WAIT_V(n) asm volatile("s_waitcnt vmcnt(" #n ")" ::: "memory")
#define PG8_WAIT_L(n) asm volatile("s_waitcnt lgkmcnt(" #n ")" ::: "memory")
#define PG8_BAR __builtin_amdgcn_s_barrier()
#define PG8_SCHED __builtin_amdgcn_sched_barrier(0)
    Unit cur, nxt; int ui = 0;
    if (!S.next(0, cur)) return;
    f32x4 acc[2][2][4][2];
#pragma unroll
    for (int a = 0; a < 2; ++a)
#pragma unroll
        for (int b = 0; b < 2; ++b)
#pragma unroll
            for (int m = 0; m < 4; ++m)
#pragma unroll
                for (int n = 0; n < 2; ++n) acc[a][b][m][n] = (f32x4){0.f, 0.f, 0.f, 0.f};
    bf16x8 At[4][2], B0[2][2], B1[2][2];
    const char* cA = (const char*)g.A + (size_t)cur.pm * tstep; const char* cB = (const char*)g.Bt + (size_t)cur.pn * tstep;
    S.a_ready(cur);
    if constexpr (SP2) {
        PG8_STAGE(PG8_SB(0, 0), cB, voffB); PG8_STAGE(PG8_SB(0, 1), cB + hstep, voffB); PG8_STAGE(PG8_SA(0, 0), cA, voffA); PG8_STAGE(PG8_SA(0, 1), cA + hstep, voffA);
        if (wr == 1) PG8_BAR;
        PG8_WAIT_V(2); PG8_BAR;
        PG8_STAGE(PG8_SB(1, 0), cB + kstep, voffB); PG8_STAGE(PG8_SA(1, 0), cA + kstep, voffA); PG8_STAGE(PG8_SB(1, 1), cB + hstep + kstep, voffB);
        PG8_WAIT_V(6); PG8_BAR;
    } else {
        PG8_STAGE(PG8_SB(0, 0), cB, voffB); PG8_STAGE(PG8_SA(0, 0), cA, voffA); PG8_STAGE(PG8_SB(0, 1), cB + hstep, voffB); PG8_STAGE(PG8_SA(0, 1), cA + hstep, voffA);
        if (wr == 1) PG8_BAR;
        PG8_WAIT_V(4); PG8_BAR;
        PG8_STAGE(PG8_SB(1, 0), cB + kstep, voffB); PG8_STAGE(PG8_SA(1, 0), cA + kstep, voffA); PG8_STAGE(PG8_SB(1, 1), cB + hstep + kstep, voffB);
        PG8_WAIT_V(6); PG8_BAR;
    }
    for (;;) {
        const bool has_next = S.next(ui + 1, nxt);
        const char* nA = has_next ? (const char*)g.A + (size_t)nxt.pm * tstep : cA; const char* nB = has_next ? (const char*)g.Bt + (size_t)nxt.pn * tstep : cB;
        for (int t = 0; t < nt; t += 2) {
            const bool last = (t == nt - 2);
            const char* a1 = cA + (size_t)(t + 1) * kstep;
            const char* a2 = last ? nA : cA + (size_t)(t + 2) * kstep; const char* b2 = last ? nB : cB + (size_t)(t + 2) * kstep;
            const char* a3 = a2 + kstep; const char* b3 = b2 + kstep;
            if (last && has_next) S.a_ready(nxt);
            if constexpr (SP2) {
            PG8_LDB(B0, 0, 0); PG8_LDB(B1, 0, 1); PG8_SCHED; PG8_LDA(At, 0, 0); PG8_STAGE(PG8_SA(1, 1), a1 + hstep, voffA);
            PG8_WAIT_V(8); PG8_WAIT_L(0); PG8_BAR; PG8_MMA(0, 0, At, B0); PG8_MMA(0, 1, At, B1); PG8_BAR; PG8_SCHED;
            PG8_LDA(At, 0, 1); PG8_STAGE(PG8_SB(0, 0), b2, voffB); PG8_STAGE(PG8_SB(0, 1), b2 + hstep, voffB); PG8_STAGE(PG8_SA(0, 0), a2, voffA);
            PG8_WAIT_V(8); PG8_WAIT_L(0); PG8_BAR; PG8_MMA(1, 0, At, B0); PG8_MMA(1, 1, At, B1); PG8_BAR; PG8_SCHED;
            PG8_LDB(B0, 1, 0); PG8_LDB(B1, 1, 1); PG8_SCHED; PG8_LDA(At, 1, 0); PG8_STAGE(PG8_SA(0, 1), a2 + hstep, voffA);
            PG8_WAIT_V(8); PG8_WAIT_L(0); PG8_BAR; PG8_MMA(0, 0, At, B0); PG8_MMA(0, 1, At, B1); PG8_BAR; PG8_SCHED;
            PG8_LDA(At, 1, 1); PG8_STAGE(PG8_SB(1, 0), b3, voffB); PG8_STAGE(PG8_SB(1, 1), b3 + hstep, voffB); PG8_STAGE(PG8_SA(1, 0), a3, voffA);
            PG8_WAIT_V(8); PG8_WAIT_L(0); PG8_BAR; PG8_MMA(1, 0, At, B0); PG8_MMA(1, 1, At, B1); PG8_BAR; PG8_SCHED;
            } else {
            PG8_LDB(B0, 0, 0); PG8_SCHED; PG8_LDA(At, 0, 0); PG8_STAGE(PG8_SA(1, 1), a1 + hstep, voffA);
            PG8_WAIT_L(8); PG8_BAR; PG8_WAIT_L(0); PG8_MMA(0, 0, At, B0); PG8_BAR; PG8_SCHED;
            PG8_LDB(B1, 0, 1); PG8_STAGE(PG8_SB(0, 0), b2, voffB);
            PG8_BAR; PG8_WAIT_L(0); PG8_MMA(0, 1, At, B1); PG8_BAR;
            PG8_LDA(At, 0, 1); PG8_STAGE(PG8_SA(0, 0), a2, voffA);
            PG8_BAR; PG8_WAIT_L(0); PG8_MMA(1, 0, At, B0); PG8_BAR; PG8_SCHED;
            PG8_STAGE(PG8_SB(0, 1), b2 + hstep, voffB);
            PG8_WAIT_V(6); PG8_BAR; PG8_MMA(1, 1, At, B1); PG8_BAR;
            PG8_LDB(B0, 1, 0); PG8_SCHED; PG8_LDA(At, 1, 0); PG8_STAGE(PG8_SA(0, 1), a2 + hstep, voffA);
            PG8_WAIT_L(8); PG8_BAR; PG8_WAIT_L(0); PG8_MMA(0, 0, At, B0); PG8_BAR; PG8_SCHED;
            PG8_LDB(B1, 1, 1); PG8_STAGE(PG8_SB(1, 0), b3, voffB);
            PG8_BAR; PG8_WAIT_L(0); PG8_MMA(0, 1, At, B1); PG8_BAR;
            PG8_LDA(At, 1, 1); PG8_STAGE(PG8_SA(1, 0), a3, voffA);
            PG8_BAR; PG8_WAIT_L(0); PG8_MMA(1, 0, At, B0); PG8_BAR; PG8_SCHED;
            PG8_STAGE(PG8_SB(1, 1), b3 + hstep, voffB);
            PG8_WAIT_V(6); PG8_BAR; PG8_MMA(1, 1, At, B1); PG8_BAR;
            }
        }
        if constexpr (ALIGN_EPI) { if (wr == 0) PG8_BAR; }
        if constexpr (!Epi::AFTER_DRAIN) { E(acc, cur, wr, wc, fr, fq); S.done(cur); }
        if (!has_next) break;
#pragma unroll
        for (int a = 0; a < 2; ++a)
#pragma unroll
            for (int b = 0; b < 2; ++b)
#pragma unroll
                for (int m = 0; m < 4; ++m)
#pragma unroll
                    for (int n = 0; n < 2; ++n) acc[a][b][m][n] = (f32x4){0.f, 0.f, 0.f, 0.f};
        cur = nxt; cA = nA; cB = nB; ++ui;
        if constexpr (ALIGN_EPI) { if (wr == 1) PG8_BAR; }
    }
    PG8_WAIT_V(0);
    if constexpr (!ALIGN_EPI) { if (wr == 0) PG8_BAR; }
    PG8_BAR;
    if constexpr (Epi::AFTER_DRAIN) { E.fused(acc, cur, wr, wc, fr, fq, lds, wid, lane); S.done(cur); }
#undef PG8_SA
#undef PG8_SB
#undef PG8_STAGE
#undef PG8_LDA
#undef PG8_LDB
#undef PG8_MMA
#undef PG8_WAIT_V
#undef PG8_WAIT_L
#undef PG8_BAR
#undef PG8_SCHED
}
}
#define LAS __attribute__((address_space(3)))
typedef unsigned short bf16_t;
typedef short bf16x8 __attribute__((ext_vector_type(8)));
typedef short bf16x4 __attribute__((ext_vector_type(4)));
typedef float f32x4 __attribute__((ext_vector_type(4)));
typedef float f32x2 __attribute__((ext_vector_type(2)));
typedef float f32x16 __attribute__((ext_vector_type(16)));
typedef unsigned u32x4 __attribute__((ext_vector_type(4)));
typedef unsigned u32x2 __attribute__((ext_vector_type(2)));

constexpr int D = 1024, M_CTX = 8192, M_LAT = 16384, M = M_CTX + M_LAT, NP = 1888, NPP = 2048, FF = 2816, DEPTH = 4;
constexpr int KEYROWS = 8192 + 4 * 4352;
constexpr float EPS = 1e-6f;
constexpr int NTHREADS = 512, NWAVES = 8;
constexpr int LDS_BYTES = 147456;

constexpr size_t OUT_X = 0, OUT_CKV = (size_t)M * D, OUT_KR = OUT_CKV + (size_t)32 * 4 * 256 * 128;
constexpr int PC_U = 0, PC_V = 256, PC_H = 512, PC_B = 768, PC_C = 1024, PC_F = 1280, PC_Q = 1536, PC_KV = 1728, PC_KR = 1856;

constexpr size_t al256(size_t x) { return (x + 255) & ~(size_t)255; }
constexpr size_t WS_BAR = 0, WS_BAR_BYTES = 16384;
constexpr size_t WS_MOD = WS_BAR_BYTES;
constexpr size_t WS_F64 = al256(WS_MOD + (size_t)4 * 5 * 6144 * 4);
constexpr size_t WS_T64R = WS_F64 + 128 * 64 * 2;
constexpr size_t WS_T64I = WS_T64R + 64 * 128 * 2;
constexpr size_t WS_T64B = WS_T64I + 64 * 128 * 2;
constexpr size_t WS_T256 = WS_T64B + 64 * 128 * 2;
constexpr size_t WS_TW = WS_T256 + 256 * 512 * 2;
constexpr size_t WS_ROPE = WS_TW + 4096 * 8;
constexpr size_t WS_W = al256(WS_ROPE + 64 * 8 * 8);
constexpr size_t WL_IN = 0, WL_OUT = WL_IN + (size_t)NPP * D * 2, WL_GU = WL_OUT + (size_t)D * D * 2, WL_DN = WL_GU + (size_t)2 * FF * D * 2,
                 WL_UQ = WL_DN + (size_t)D * FF * 2, WL_UKV = WL_UQ + (size_t)384 * 192 * 2, WL_SP = WL_UKV + (size_t)512 * 128 * 2, WL_SIZE = WL_SP + (size_t)4 * 128 * 128 * 2;
constexpr size_t WS_R1 = al256(WS_W + 4 * WL_SIZE);
constexpr size_t WS_R2 = WS_R1 + (size_t)M * D * 2;
constexpr size_t WS_MLA = WS_R2 + (size_t)M * FF * 2;
constexpr size_t WS_Q = WS_MLA, WS_KN = WS_Q + (size_t)M * 384 * 2, WS_VT = WS_KN + (size_t)KEYROWS * 256 * 2, WS_KR = WS_VT + (size_t)KEYROWS * 256 * 2,
                 WS_GB = WS_KR + (size_t)KEYROWS * 32 * 2, WS_END = WS_GB + (size_t)4 * 4 * 64 * 64 * 128 * 2;
static_assert(WS_END - WS_MLA >= (size_t)M * D * 2, "FFNOUT alias");
static_assert((size_t)M * NP * 2 <= (size_t)M * FF * 2, "PROJ fits R2");

struct Params { const float* in[24]; float* out; unsigned char* ws; };
enum { I_XP = 0, I_XS, I_CCKV, I_CKR, I_C, I_CCTX, I_WADA, I_BADA, I_GPM, I_GPOM, I_GPF, I_GPOF, I_WIN, I_SPW, I_SPB, I_CVW, I_CVB, I_GQ, I_WUQ, I_GKV, I_WUKV, I_WOUT, I_WGU, I_WDN };

__device__ __forceinline__ unsigned f2bf(float f) { unsigned u = __builtin_bit_cast(unsigned, f); return (u + 0x7fffu + ((u >> 16) & 1u)) >> 16; }
typedef __bf16 bf16x2v __attribute__((ext_vector_type(2)));
__device__ __forceinline__ unsigned pk2(float lo, float hi) { const bf16x2v r = __builtin_convertvector((f32x2){lo, hi}, bf16x2v); return __builtin_bit_cast(unsigned, r); }
__device__ __forceinline__ float bflo(unsigned w) { return __builtin_bit_cast(float, w << 16); }
__device__ __forceinline__ float bfhi(unsigned w) { return __builtin_bit_cast(float, w & 0xffff0000u); }
__device__ __forceinline__ float bf1(bf16_t v) { return __builtin_bit_cast(float, (unsigned)v << 16); }
__device__ __forceinline__ f32x4 mma16(bf16x8 a, bf16x8 b, f32x4 c) { return __builtin_amdgcn_mfma_f32_16x16x32_bf16(a, b, c, 0, 0, 0); }
__device__ __forceinline__ f32x16 mma32(bf16x8 a, bf16x8 b, f32x16 c) { return __builtin_amdgcn_mfma_f32_32x32x16_bf16(a, b, c, 0, 0, 0); }
__device__ __forceinline__ float wave_sum(float v) {
#pragma unroll
    for (int o = 1; o < 64; o <<= 1) v += __shfl_xor(v, o);
    return v;
}
__device__ __forceinline__ u32x2 pk4(f32x4 v) { u32x2 w; w.x = pk2(v[0], v[1]); w.y = pk2(v[2], v[3]); return w; }
__device__ __forceinline__ int mod_of_row(int r) { return r < M_CTX ? 0 : 1 + ((r - M_CTX) >> 12); }

struct Ctx {
    Params p; LAS unsigned char* lds; int tid, lane, wave, bid, G;
    unsigned char* ws;
    __device__ __forceinline__ const float* mod(int l, int mi, int chunk) const { return (const float*)(ws + WS_MOD) + ((size_t)(l * 5 + mi) * 6 + chunk) * 1024; }
    __device__ __forceinline__ unsigned char* wl(int l) const { return ws + WS_W + (size_t)l * WL_SIZE; }
    __device__ __forceinline__ void refresh() { int t = threadIdx.x; asm volatile("" : "+v"(t)); tid = t; lane = t & 63; wave = __builtin_amdgcn_readfirstlane(t >> 6);
        size_t z = 0; asm volatile("" : "+s"(z)); ws = p.ws + z;
        int b = blockIdx.x; asm volatile("" : "+s"(b)); bid = b; }
};

constexpr int TPS = 258;
struct TItem { const float* W; bf16_t* WT; int ldw, K, k0, n0, nvalid, gu; };
__device__ __forceinline__ void titem_load(const TItem& t, int wave, int lane, f32x4 (&v)[8]) {
    const int n = t.n0 + 4 * lane;
#pragma unroll
    for (int i = 0; i < 8; ++i) v[i] = n < t.nvalid ? *(const f32x4*)(t.W + (size_t)(t.k0 + 8 * wave + i) * t.ldw + n) : (f32x4){0.f, 0.f, 0.f, 0.f};
}
__device__ __forceinline__ void titem_stage(LAS unsigned char* lds, int wave, int lane, const f32x4 (&v)[8]) {
    LAS bf16_t* T = (LAS bf16_t*)lds;
#pragma unroll
    for (int i = 0; i < 8; ++i) { LAS unsigned* d = (LAS unsigned*)(T + (8 * wave + i) * TPS + 4 * lane); d[0] = pk2(v[i][0], v[i][1]); d[1] = pk2(v[i][2], v[i][3]); }
}
__device__ __forceinline__ void titem_store(const TItem& t, const LAS unsigned char* lds, int tid) {
    const LAS bf16_t* T = (const LAS bf16_t*)lds;
#pragma unroll
    for (int it = 0; it < 4; ++it) { const int q = tid + NTHREADS * it, n = q >> 3, c = q & 7;
        unsigned short e[8];
#pragma unroll
        for (int j = 0; j < 8; ++j) e[j] = T[(8 * c + j) * TPS + n];
        const int sn = t.n0 + n;
        if (sn < t.nvalid) { int dr = sn; if (t.gu) { const int isup = sn >= FF, jj = isup ? sn - FF : sn; dr = (jj >> 7) * 256 + isup * 128 + (jj & 127); }
            u32x4 o; o.x = e[0] | ((unsigned)e[1] << 16); o.y = e[2] | ((unsigned)e[3] << 16); o.z = e[4] | ((unsigned)e[5] << 16); o.w = e[6] | ((unsigned)e[7] << 16);
            *(u32x4*)(t.WT + (size_t)dr * t.K + t.k0 + 8 * c) = o; } }
}
constexpr int TI_IN = 16 * 8, TI_OUT = 16 * 4, TI_GU = 16 * 22, TI_DN = 44 * 4, TI_UQ = 3 * 2, TI_UKV = 2 * 2, TI_L = TI_IN + TI_OUT + TI_GU + TI_DN + TI_UQ + TI_UKV;
__device__ __forceinline__ TItem titem_make(const Ctx& C, int it) {
    const Params& p = C.p; const int l = it / TI_L; int r = it % TI_L; unsigned char* wl = C.wl(l); TItem t; t.gu = 0;
    if (r < TI_IN) { t.W = p.in[I_WIN] + (size_t)l * D * NP; t.WT = (bf16_t*)(wl + WL_IN); t.ldw = NP; t.K = D; t.k0 = (r >> 3) * 64; t.n0 = (r & 7) * 256; t.nvalid = NP; return t; } r -= TI_IN;
    if (r < TI_OUT) { t.W = p.in[I_WOUT] + (size_t)l * D * D; t.WT = (bf16_t*)(wl + WL_OUT); t.ldw = D; t.K = D; t.k0 = (r >> 2) * 64; t.n0 = (r & 3) * 256; t.nvalid = D; return t; } r -= TI_OUT;
    if (r < TI_GU) { t.W = p.in[I_WGU] + (size_t)l * D * 2 * FF; t.WT = (bf16_t*)(wl + WL_GU); t.ldw = 2 * FF; t.K = D; t.k0 = (r / 22) * 64; t.n0 = (r % 22) * 256; t.nvalid = 2 * FF; t.gu = 1; return t; } r -= TI_GU;
    if (r < TI_DN) { t.W = p.in[I_WDN] + (size_t)l * FF * D; t.WT = (bf16_t*)(wl + WL_DN); t.ldw = D; t.K = FF; t.k0 = (r >> 2) * 64; t.n0 = (r & 3) * 256; t.nvalid = D; return t; } r -= TI_DN;
    if (r < TI_UQ) { t.W = p.in[I_WUQ] + (size_t)l * 192 * 384; t.WT = (bf16_t*)(wl + WL_UQ); t.ldw = 384; t.K = 192; t.k0 = (r >> 1) * 64; t.n0 = (r & 1) * 256; t.nvalid = 384; return t; } r -= TI_UQ;
    t.W = p.in[I_WUKV] + (size_t)l * 128 * 512; t.WT = (bf16_t*)(wl + WL_UKV); t.ldw = 512; t.K = 128; t.k0 = (r >> 1) * 64; t.n0 = (r & 1) * 256; t.nvalid = 512; return t;
}

__device__ __forceinline__ void transpose_items(const Ctx& C, int it0, int stride, int end) {
    int it = it0; f32x4 v[8];
    TItem cur; if (it < end) { cur = titem_make(C, it); titem_load(cur, C.wave, C.lane, v); }
    while (it < end) {
        titem_stage(C.lds, C.wave, C.lane, v);
        const int nx = it + stride; TItem nxt = cur; if (nx < end) { nxt = titem_make(C, nx); titem_load(nxt, C.wave, C.lane, v); }
        __syncthreads();
        titem_store(cur, C.lds, C.tid);
        __syncthreads();
        cur = nxt; it = nx;
    }
}

__device__ __forceinline__ void phase_prologue(const Ctx& C) {
    const Params& p = C.p;
    transpose_items(C, C.bid, C.G, (C.G == 256) ? TI_L : 4 * TI_L);
    {
        LAS float* sc = (LAS float*)C.lds;
        LAS float* red = (LAS float*)(C.lds + 5 * 1024 * 4);
        const int ub = C.G - 1 - C.bid;
        if (ub < 96) {
            size_t za = 0, zb = 0; asm volatile("" : "+s"(za), "+s"(zb));
            const float* cctx = p.in[I_CCTX] + za; const float* cc_ = p.in[I_C] + zb;
            for (int i = C.tid; i < 5120; i += NTHREADS) { const int j = i >> 10, k = i & 1023; const float v = (j == 0) ? cctx[k] : cc_[(j - 1) * 1024 + k]; sc[i] = v / (1.f + __expf(-v)); }
            __syncthreads();
            for (int u = ub; u < 96; u += C.G) {
                const int l = u / 24, cb = u % 24;
                const float* w = p.in[I_WADA] + ((size_t)l * 1024 + C.wave * 128) * 6144 + cb * 256 + 4 * C.lane;
                f32x4 a0 = {0.f, 0.f, 0.f, 0.f}, a1 = a0, a2 = a0, a3 = a0, a4 = a0;
#pragma unroll 16
                for (int k = 0; k < 128; ++k) { const f32x4 wv = *(const f32x4*)(w + (size_t)k * 6144); const int kk = C.wave * 128 + k;
                    a0 += wv * sc[kk]; a1 += wv * sc[1024 + kk]; a2 += wv * sc[2048 + kk]; a3 += wv * sc[3072 + kk]; a4 += wv * sc[4096 + kk]; }
                LAS f32x4* rw = (LAS f32x4*)(red + C.wave * 1280) + C.lane;
                rw[0] = a0; rw[64] = a1; rw[128] = a2; rw[192] = a3; rw[256] = a4;
                __syncthreads();
                for (int i = C.tid; i < 1280; i += NTHREADS) { const int j = i >> 8, c2 = i & 255; float sum = p.in[I_BADA][l * 6144 + cb * 256 + c2];
#pragma unroll
                    for (int ww = 0; ww < 8; ++ww) sum += red[ww * 1280 + i];
                    ((float*)(C.ws + WS_MOD))[(size_t)(l * 5 + j) * 6144 + cb * 256 + c2] = sum; }
                __syncthreads();
            }
        }
        __syncthreads();
    }
    {
        const int gt = C.bid * NTHREADS + C.tid, GT = C.G * NTHREADS;
        for (int i = gt; i < 4 * 65536; i += GT) { const int l = i >> 16, e = i & 65535; ((bf16_t*)(C.wl(l) + WL_SP))[e] = (bf16_t)f2bf(p.in[I_SPW][i]); }
        for (int i = gt; i < 4 * 160 * 1024 / 2; i += GT) { const int l = i / (160 * 512), e = i % (160 * 512); ((unsigned*)(C.wl(l) + WL_IN + (size_t)NP * D * 2))[e] = 0u; }
        for (int i = gt; i < 128 * 64; i += GT) { const int m = i >> 6, c = i & 63; const int idx = ((m & 63) * c) & 63; const float a = (float)idx / 32.f;
            ((bf16_t*)(C.ws + WS_F64))[i] = (bf16_t)f2bf(m < 64 ? cospif(a) : sinpif(a)); }
        for (int i = gt; i < 64 * 128; i += GT) { const int k = i >> 7, K = i & 127; const int idx = (k * (K & 63)) & 63; const float a = (float)idx / 32.f; const float cv = cospif(a), sv = sinpif(a);
            ((bf16_t*)(C.ws + WS_T64R))[i] = (bf16_t)f2bf(K < 64 ? cv : -sv);
            ((bf16_t*)(C.ws + WS_T64I))[i] = (bf16_t)f2bf(K < 64 ? -sv : -cv);
            ((bf16_t*)(C.ws + WS_T64B))[i] = (bf16_t)f2bf(K < 64 ? cv : sv); }
        for (int i = gt; i < 256 * 512; i += GT) { const int k = i >> 9, K = i & 511; const int idx = (k * (K & 255)) & 255; const float a = (float)idx / 128.f;
            ((bf16_t*)(C.ws + WS_T256))[i] = (bf16_t)f2bf(K < 256 ? cospif(a) : -sinpif(a)); }
        for (int i = gt; i < 4096; i += GT) { const float a = (float)i / 2048.f; ((f32x2*)(C.ws + WS_TW))[i] = (f32x2){cospif(a), sinpif(a)}; }
        for (int i = gt; i < 512; i += GT) { const int pos = i >> 3, f = i & 7; const float inv = powf(10000.f, -(float)f / 8.f); const float ang = (float)pos * inv;
            ((f32x2*)(C.ws + WS_ROPE))[i] = (f32x2){cosf(ang), sinf(ang)}; }
    }
}

__device__ __forceinline__ void load_row_f32(const float* rowp, int lane, f32x4 (&v)[4]) {
#pragma unroll
    for (int j = 0; j < 4; ++j) v[j] = *(const f32x4*)(rowp + 4 * lane + 256 * j);
}
__device__ __forceinline__ void load_row_bf16(const bf16_t* rowp, int lane, f32x4 (&v)[4]) {
#pragma unroll
    for (int j = 0; j < 4; ++j) { const u32x2 w = *(const u32x2*)(rowp + 4 * lane + 256 * j); v[j] = (f32x4){bflo(w.x), bfhi(w.x), bflo(w.y), bfhi(w.y)}; }
}
__device__ __forceinline__ float row_rstd(const f32x4 (&v)[4]) {
    float s = 0.f;
#pragma unroll
    for (int j = 0; j < 4; ++j) s += (v[j][0] * v[j][0] + v[j][1] * v[j][1]) + (v[j][2] * v[j][2] + v[j][3] * v[j][3]);
    return 1.f / sqrtf(wave_sum(s) * (1.f / 1024.f) + EPS);
}
__device__ __forceinline__ void norm_mod_store(const f32x4 (&x)[4], const float* g, const float* scale, const float* shift, bf16_t* orow, int lane) {
    const float rs = row_rstd(x);
#pragma unroll
    for (int j = 0; j < 4; ++j) { const int c = 4 * lane + 256 * j; const f32x4 gv = *(const f32x4*)(g + c), sv = *(const f32x4*)(scale + c), hv = *(const f32x4*)(shift + c);
        const f32x4 h = x[j] * rs * gv * (1.f + sv) + hv; *(u32x2*)(orow + c) = pk4(h); }
}
__device__ __forceinline__ const float* xin_row(const Ctx& C, int layer, int r) {
    if (layer > 0) return C.p.out + OUT_X + (size_t)r * D;
    size_t za = 0, zb = 0; asm volatile("" : "+s"(za), "+s"(zb));
    const float* a = C.p.in[I_XP] + za; const float* b = C.p.in[I_XS] + zb;
    return r < M_CTX ? a + (size_t)r * D : b + (size_t)(r - M_CTX) * D;
}
__device__ __forceinline__ void phase_norm0(const Ctx& C) {
    const int gw = C.bid * NWAVES + C.wave, NGW = C.G * NWAVES;
    bf16_t* H = (bf16_t*)(C.ws + WS_R1);
    f32x4 xn[4]; load_row_f32(xin_row(C, 0, gw), C.lane, xn);
    for (int r = gw; r < M; r += NGW) { f32x4 x[4];
#pragma unroll
        for (int j = 0; j < 4; ++j) x[j] = xn[j];
        if (r + NGW < M) load_row_f32(xin_row(C, 0, r + NGW), C.lane, xn);
        const int mi = mod_of_row(r);
        norm_mod_store(x, C.p.in[I_GPM], C.mod(0, mi, 1), C.mod(0, mi, 0), H + (size_t)r * D, C.lane); }
}
template <int which  > __device__ __forceinline__ void phase_post(const Ctx& C, int layer) {
    const int gw = C.bid * NWAVES + C.wave, NGW = C.G * NWAVES;
    const bf16_t* T = (const bf16_t*)(C.ws + (which == 0 ? WS_R2 : WS_MLA));
    bf16_t* H = (bf16_t*)(C.ws + WS_R1);
    const float* gpost = (which == 0 ? C.p.in[I_GPOM] : C.p.in[I_GPOF]) + layer * D;
    const bool do_next = (which == 0) || (layer + 1 < DEPTH);
    const int nl = which == 0 ? layer : layer + 1;
    const float* gnext = (which == 0 ? C.p.in[I_GPF] : C.p.in[I_GPM]) + (nl < DEPTH ? nl : 0) * D;
    f32x4 tn[4], xn[4];
    load_row_bf16(T + (size_t)gw * D, C.lane, tn); load_row_f32(which == 0 ? xin_row(C, layer, gw) : C.p.out + OUT_X + (size_t)gw * D, C.lane, xn);
    for (int r = gw; r < M; r += NGW) {
        const int mi = mod_of_row(r);
        f32x4 t[4], x[4];
#pragma unroll
        for (int j = 0; j < 4; ++j) { t[j] = tn[j]; x[j] = xn[j]; }
        if (r + NGW < M) { const int rn = r + NGW; load_row_bf16(T + (size_t)rn * D, C.lane, tn); load_row_f32(which == 0 ? xin_row(C, layer, rn) : C.p.out + OUT_X + (size_t)rn * D, C.lane, xn); }
        const float rs = row_rstd(t); const float* gate = C.mod(layer, mi, which == 0 ? 2 : 5);
        float* xo = C.p.out + OUT_X + (size_t)r * D;
#pragma unroll
        for (int j = 0; j < 4; ++j) { const int c = 4 * C.lane + 256 * j; const f32x4 gv = *(const f32x4*)(gpost + c), ga = *(const f32x4*)(gate + c);
            x[j] = x[j] + ga * (t[j] * rs * gv); *(f32x4*)(xo + c) = x[j]; }
        if (do_next) norm_mod_store(x, gnext, C.mod(nl, mi, which == 0 ? 4 : 1), C.mod(nl, mi, which == 0 ? 3 : 0), H + (size_t)r * D, C.lane);
    }
}

__device__ __forceinline__ void unit_chunk_mlp(const Ctx& C, int layer, int u) {
    const int chunk = u >> 2, g = u & 3, r0 = chunk * 128;
    const bf16_t* PROJ = (const bf16_t*)(C.ws + WS_R2); bf16_t* MIX = (bf16_t*)(C.ws + WS_R1);
    constexpr int VS = 136;
    LAS bf16_t* Vt = (LAS bf16_t*)C.lds;
    { const int q = C.tid >> 2, c0 = (C.tid & 3) * 16; const bf16_t* src = PROJ + (size_t)(r0 + q) * NP + PC_V + g * 64 + c0;
      const bf16x8 v0 = *(const bf16x8*)src, v1 = *(const bf16x8*)(src + 8);
#pragma unroll
      for (int j = 0; j < 8; ++j) { Vt[(c0 + j) * VS + q] = (bf16_t)v0[j]; Vt[(c0 + 8 + j) * VS + q] = (bf16_t)v1[j]; } }
    __syncthreads();
    const int l15 = C.lane & 15, hq = C.lane >> 4, w = C.wave;
    const bf16_t* Wg = (const bf16_t*)(C.wl(layer) + WL_SP) + (size_t)g * 128 * 128;
    bf16x8 bw[4];
#pragma unroll
    for (int ks = 0; ks < 4; ++ks) bw[ks] = *(const bf16x8*)(Wg + (size_t)(w * 16 + l15) * 128 + ks * 32 + 8 * hq);
    const int p = w * 16 + l15; const float bias = C.p.in[I_SPB][(layer * 4 + g) * 128 + p];
#pragma unroll
    for (int ct = 0; ct < 4; ++ct) {
        f32x4 acc = {0.f, 0.f, 0.f, 0.f};
#pragma unroll
        for (int ks = 0; ks < 4; ++ks) { const bf16x8 a = *(const LAS bf16x8*)(Vt + (ct * 16 + l15) * VS + ks * 32 + 8 * hq); acc = mma16(a, bw[ks], acc); }
        const int cc = g * 64 + ct * 16 + 4 * hq; const u32x2 uw = *(const u32x2*)(PROJ + (size_t)(r0 + p) * NP + PC_U + cc);
        f32x4 o; o[0] = bflo(uw.x) * (acc[0] + bias); o[1] = bfhi(uw.x) * (acc[1] + bias); o[2] = bflo(uw.y) * (acc[2] + bias); o[3] = bfhi(uw.y) * (acc[3] + bias);
        *(u32x2*)(MIX + (size_t)(r0 + p) * D + cc) = pk4(o);
    }
    __syncthreads();
}
__device__ __forceinline__ void unit_conv(const Ctx& C, int layer, int u) {
    const bf16_t* PROJ = (const bf16_t*)(C.ws + WS_R2); bf16_t* MIX = (bf16_t*)(C.ws + WS_R1);
    const float* cw = C.p.in[I_CVW] + layer * 3 * 256; const float* cb = C.p.in[I_CVB] + layer * 256;
    for (int it = 0; it < 8; ++it) {
        const int item = it * NTHREADS + C.tid, t = item >> 5, ch = (item & 31) * 8, r = u * 128 + t;
        const int pos = r < M_CTX ? (r & 255) : ((r - M_CTX) & 4095), len = r < M_CTX ? 256 : 4096;
        const bf16_t* base = PROJ + (size_t)r * NP;
        const bf16x8 h1 = *(const bf16x8*)(base + PC_H + ch), c1 = *(const bf16x8*)(base + PC_C + ch), gb = *(const bf16x8*)(base + PC_B + ch);
        bf16x8 h0 = h1, c0 = c1, h2 = h1, c2 = c1; const bool hasp = pos > 0, hasn = pos < len - 1;
        if (hasp) { h0 = *(const bf16x8*)(base - NP + PC_H + ch); c0 = *(const bf16x8*)(base - NP + PC_C + ch); }
        if (hasn) { h2 = *(const bf16x8*)(base + NP + PC_H + ch); c2 = *(const bf16x8*)(base + NP + PC_C + ch); }
        float o[8];
#pragma unroll
        for (int j = 0; j < 8; ++j) {
            const float z0 = hasp ? bf1((bf16_t)h0[j]) * bf1((bf16_t)c0[j]) : 0.f, z1 = bf1((bf16_t)h1[j]) * bf1((bf16_t)c1[j]), z2 = hasn ? bf1((bf16_t)h2[j]) * bf1((bf16_t)c2[j]) : 0.f;
            const float y = z0 * cw[ch + j] + z1 * cw[256 + ch + j] + z2 * cw[512 + ch + j] + cb[ch + j];
            o[j] = bf1((bf16_t)gb[j]) * y; }
        u32x4 w; w.x = pk2(o[0], o[1]); w.y = pk2(o[2], o[3]); w.z = pk2(o[4], o[5]); w.w = pk2(o[6], o[7]);
        *(u32x4*)(MIX + (size_t)r * D + 256 + ch) = w;
    }
}
__device__ __forceinline__ void unit_fourier_ctx(const Ctx& C, int u) {
    const int s = u >> 2, g = u & 3, l15 = C.lane & 15, hq = C.lane >> 4, w = C.wave;
    const bf16_t* PROJ = (const bf16_t*)(C.ws + WS_R2); bf16_t* MIX = (bf16_t*)(C.ws + WS_R1);
    const bf16_t* F64 = (const bf16_t*)(C.ws + WS_F64); const bf16_t* T256 = (const bf16_t*)(C.ws + WS_T256);
    constexpr int ZS = 520; LAS bf16_t* Zt = (LAS bf16_t*)C.lds;
#pragma unroll
    for (int i = 0; i < 2; ++i) { const int nt = 2 * w + i;
        bf16x8 a[2];
#pragma unroll
        for (int ks = 0; ks < 2; ++ks) a[ks] = *(const bf16x8*)(PROJ + (size_t)(s * 256 + nt * 16 + l15) * NP + PC_F + g * 64 + ks * 32 + 8 * hq);
#pragma unroll
        for (int mt = 0; mt < 8; ++mt) { f32x4 acc = {0.f, 0.f, 0.f, 0.f};
#pragma unroll
            for (int ks = 0; ks < 2; ++ks) { const bf16x8 b = *(const bf16x8*)(F64 + (size_t)(mt * 16 + l15) * 64 + ks * 32 + 8 * hq); acc = mma16(a[ks], b, acc); }
            const int mp = mt * 16 + l15;
            *(LAS u32x2*)(Zt + (mp & 63) * ZS + (mp >> 6) * 256 + nt * 16 + 4 * hq) = pk4(acc); } }
    __syncthreads();
#pragma unroll 1
    for (int i = 0; i < 2; ++i) { const int kt = 2 * w + i;
        f32x4 acc[4];
#pragma unroll
        for (int mt = 0; mt < 4; ++mt) acc[mt] = (f32x4){0.f, 0.f, 0.f, 0.f};
#pragma unroll 8
        for (int ks = 0; ks < 16; ++ks) { const bf16x8 b = *(const bf16x8*)(T256 + (size_t)(kt * 16 + l15) * 512 + ks * 32 + 8 * hq);
#pragma unroll
            for (int mt = 0; mt < 4; ++mt) { const bf16x8 a = *(const LAS bf16x8*)(Zt + (mt * 16 + l15) * ZS + ks * 32 + 8 * hq); acc[mt] = mma16(a, b, acc[mt]); } }
#pragma unroll
        for (int mt = 0; mt < 4; ++mt) *(u32x2*)(MIX + (size_t)(s * 256 + kt * 16 + l15) * D + 512 + g * 64 + mt * 16 + 4 * hq) = pk4(acc[mt] * (1.f / 128.f)); }
    __syncthreads();
}
__device__ __forceinline__ void unit_fourier_lat1(const Ctx& C, int u) {
    const int b = u >> 5, g = (u >> 3) & 3, nb = u & 7, l15 = C.lane & 15, hq = C.lane >> 4, n2 = nb * 8 + C.wave;
    const bf16_t* PROJ = (const bf16_t*)(C.ws + WS_R2);
    const bf16_t* F64 = (const bf16_t*)(C.ws + WS_F64); const bf16_t* T64R = (const bf16_t*)(C.ws + WS_T64R); const bf16_t* T64I = (const bf16_t*)(C.ws + WS_T64I);
    const f32x2* TW = (const f32x2*)(C.ws + WS_TW);
    bf16_t* GB = (bf16_t*)(C.ws + WS_GB) + (size_t)((b * 4 + g) * 64 + n2) * 64 * 128;
    constexpr int ZS = 136; LAS bf16_t* Zt = (LAS bf16_t*)(C.lds + C.wave * (64 * ZS * 2));
#pragma unroll 2
    for (int nt = 0; nt < 4; ++nt) {
        bf16x8 a[2];
#pragma unroll
        for (int ks = 0; ks < 2; ++ks) a[ks] = *(const bf16x8*)(PROJ + (size_t)(M_CTX + b * 4096 + (nt * 16 + l15) * 64 + n2) * NP + PC_F + g * 64 + ks * 32 + 8 * hq);
#pragma unroll
        for (int mt = 0; mt < 8; ++mt) { f32x4 acc = {0.f, 0.f, 0.f, 0.f};
#pragma unroll
            for (int ks = 0; ks < 2; ++ks) { const bf16x8 bb = *(const bf16x8*)(F64 + (size_t)(mt * 16 + l15) * 64 + ks * 32 + 8 * hq); acc = mma16(a[ks], bb, acc); }
            const int mp = mt * 16 + l15;
            *(LAS u32x2*)(Zt + (mp & 63) * ZS + (mp >> 6) * 64 + nt * 16 + 4 * hq) = pk4(acc); } }
    asm volatile("s_waitcnt lgkmcnt(0)" ::: "memory");
#pragma unroll 2
    for (int kt = 0; kt < 4; ++kt) {
        bf16x8 br[4], bi[4];
#pragma unroll
        for (int ks = 0; ks < 4; ++ks) { br[ks] = *(const bf16x8*)(T64R + (size_t)(kt * 16 + l15) * 128 + ks * 32 + 8 * hq); bi[ks] = *(const bf16x8*)(T64I + (size_t)(kt * 16 + l15) * 128 + ks * 32 + 8 * hq); }
        const int k1 = kt * 16 + l15; const f32x2 tw = TW[k1 * n2];
#pragma unroll
        for (int mt = 0; mt < 4; ++mt) { f32x4 ar = {0.f, 0.f, 0.f, 0.f}, ai = {0.f, 0.f, 0.f, 0.f};
#pragma unroll
            for (int ks = 0; ks < 4; ++ks) { const bf16x8 a = *(const LAS bf16x8*)(Zt + (mt * 16 + l15) * ZS + ks * 32 + 8 * hq); ar = mma16(a, br[ks], ar); ai = mma16(a, bi[ks], ai); }
            const f32x4 gr = ar * tw[0] + ai * tw[1], gi = ai * tw[0] - ar * tw[1];
            bf16_t* dst = GB + (size_t)k1 * 128 + mt * 16 + 4 * hq;
            *(u32x2*)dst = pk4(gr); *(u32x2*)(dst + 64) = pk4(gi); } }
    __syncthreads();
}
__device__ __forceinline__ void unit_fourier_lat2(const Ctx& C, int u) {
    const int b = u >> 5, g = (u >> 3) & 3, kb = u & 7, l15 = C.lane & 15, hq = C.lane >> 4, k1 = kb * 8 + C.wave;
    const bf16_t* T64B = (const bf16_t*)(C.ws + WS_T64B); bf16_t* MIX = (bf16_t*)(C.ws + WS_R1);
    const bf16_t* GB = (const bf16_t*)(C.ws + WS_GB) + (size_t)((b * 4 + g) * 64) * 64 * 128 + (size_t)k1 * 128;
    constexpr int ZS = 136; LAS bf16_t* Tt = (LAS bf16_t*)(C.lds + C.wave * (64 * ZS * 2));
#pragma unroll 4
    for (int it = 0; it < 16; ++it) { const int q = it * 64 + C.lane, n2 = q >> 4, cc = q & 15, part = cc >> 3, m0 = (cc & 7) * 8;
        const bf16x8 v = *(const bf16x8*)(GB + (size_t)n2 * 64 * 128 + cc * 8);
#pragma unroll
        for (int j = 0; j < 8; ++j) Tt[(m0 + j) * ZS + part * 64 + n2] = (bf16_t)v[j]; }
    asm volatile("s_waitcnt lgkmcnt(0)" ::: "memory");
#pragma unroll 2
    for (int kt = 0; kt < 4; ++kt) {
        bf16x8 bb[4];
#pragma unroll
        for (int ks = 0; ks < 4; ++ks) bb[ks] = *(const bf16x8*)(T64B + (size_t)(kt * 16 + l15) * 128 + ks * 32 + 8 * hq);
        const int k2 = kt * 16 + l15; const int row = M_CTX + b * 4096 + k1 + 64 * k2;
#pragma unroll
        for (int mt = 0; mt < 4; ++mt) { f32x4 acc = {0.f, 0.f, 0.f, 0.f};
#pragma unroll
            for (int ks = 0; ks < 4; ++ks) { const bf16x8 a = *(const LAS bf16x8*)(Tt + (mt * 16 + l15) * ZS + ks * 32 + 8 * hq); acc = mma16(a, bb[ks], acc); }
            *(u32x2*)(MIX + (size_t)row * D + 512 + g * 64 + mt * 16 + 4 * hq) = pk4(acc * (1.f / 512.f)); } }
    __syncthreads();
}
constexpr float QSCALE = 0.10206207261596577f * 1.4426950408889634f;
__device__ __forceinline__ void unit_mla_prep(const Ctx& C, int layer, int u) {
    const Params& p = C.p;
    const bf16_t* PROJ = (const bf16_t*)(C.ws + WS_R2);
    bf16_t* Q = (bf16_t*)(C.ws + WS_Q); bf16_t* KN = (bf16_t*)(C.ws + WS_KN); bf16_t* VT = (bf16_t*)(C.ws + WS_VT); bf16_t* KR = (bf16_t*)(C.ws + WS_KR);
    const f32x2* ROPE = (const f32x2*)(C.ws + WS_ROPE);
    constexpr int QS = 200, KS = 136;
    LAS bf16_t* CQ = (LAS bf16_t*)C.lds;
    LAS bf16_t* CK = (LAS bf16_t*)(C.lds + 128 * QS * 2);
    const bool is_tok = u < 192;
    int r0 = 0, keyrow0, keypos0, nk; size_t vtbase; bool lat;
    if (is_tok) { r0 = u * 128; lat = r0 >= M_CTX;
        if (!lat) { keyrow0 = r0; keypos0 = r0 & 255; nk = 256; vtbase = (size_t)(r0 & ~255) * 256; }
        else { const int b = (r0 - M_CTX) >> 12, n = (r0 - M_CTX) & 4095; keyrow0 = M_CTX + b * 4352 + n; keypos0 = n; nk = 4352; vtbase = (size_t)(M_CTX + b * 4352) * 256; } }
    else { const int cu = u - 192, b = cu >> 1, half = cu & 1; lat = true; keyrow0 = M_CTX + b * 4352 + 4096 + half * 128; keypos0 = 4096 + half * 128; nk = 4352; vtbase = (size_t)(M_CTX + b * 4352) * 256; }
    { const int t = C.tid >> 2, sub = C.tid & 3;
      if (is_tok) {
        const int r = r0 + t; const bf16_t* base = PROJ + (size_t)r * NP;
        float q[48], k[32]; float sq = 0.f, sk = 0.f;
#pragma unroll
        for (int i = 0; i < 6; ++i) { const bf16x8 v = *(const bf16x8*)(base + PC_Q + sub * 48 + i * 8);
#pragma unroll
            for (int j = 0; j < 8; ++j) { q[i * 8 + j] = bf1((bf16_t)v[j]); sq += q[i * 8 + j] * q[i * 8 + j]; } }
#pragma unroll
        for (int i = 0; i < 4; ++i) { const bf16x8 v = *(const bf16x8*)(base + PC_KV + sub * 32 + i * 8);
#pragma unroll
            for (int j = 0; j < 8; ++j) { k[i * 8 + j] = bf1((bf16_t)v[j]); sk += k[i * 8 + j] * k[i * 8 + j]; } }
        sq += __shfl_xor(sq, 1); sq += __shfl_xor(sq, 2); sk += __shfl_xor(sk, 1); sk += __shfl_xor(sk, 2);
        const float rq = 1.f / sqrtf(sq * (1.f / 192.f) + EPS), rk = 1.f / sqrtf(sk * (1.f / 128.f) + EPS);
        const float* gq = p.in[I_GQ] + layer * 192 + sub * 48; const float* gk = p.in[I_GKV] + layer * 128 + sub * 32;
#pragma unroll
        for (int i = 0; i < 6; ++i) { u32x4 w; w.x = pk2(q[i * 8 + 0] * rq * gq[i * 8 + 0], q[i * 8 + 1] * rq * gq[i * 8 + 1]); w.y = pk2(q[i * 8 + 2] * rq * gq[i * 8 + 2], q[i * 8 + 3] * rq * gq[i * 8 + 3]);
            w.z = pk2(q[i * 8 + 4] * rq * gq[i * 8 + 4], q[i * 8 + 5] * rq * gq[i * 8 + 5]); w.w = pk2(q[i * 8 + 6] * rq * gq[i * 8 + 6], q[i * 8 + 7] * rq * gq[i * 8 + 7]);
            *(LAS u32x4*)(CQ + t * QS + sub * 48 + i * 8) = w; }
        float* sckv = nullptr;
        if (!lat) { const int s = r >> 8, pos = r & 255; sckv = p.out + OUT_CKV + ((size_t)(s * 4 + layer) * 256 + pos) * 128 + sub * 32; }
#pragma unroll
        for (int i = 0; i < 4; ++i) { float o[8];
#pragma unroll
            for (int j = 0; j < 8; ++j) o[j] = k[i * 8 + j] * rk * gk[i * 8 + j];
            u32x4 w; w.x = pk2(o[0], o[1]); w.y = pk2(o[2], o[3]); w.z = pk2(o[4], o[5]); w.w = pk2(o[6], o[7]);
            *(LAS u32x4*)(CK + t * KS + sub * 32 + i * 8) = w;
            if (!lat) { *(f32x4*)(sckv + i * 8) = (f32x4){o[0], o[1], o[2], o[3]}; *(f32x4*)(sckv + i * 8 + 4) = (f32x4){o[4], o[5], o[6], o[7]}; } }
        { const bf16x8 v = *(const bf16x8*)(base + PC_KR + sub * 8); float x[8], o[8];
#pragma unroll
          for (int j = 0; j < 8; ++j) x[j] = bf1((bf16_t)v[j]);
          if (lat) { const int n = (r - M_CTX) & 4095; const int pos = (sub >> 1) == 0 ? (n >> 6) : (n & 63);
#pragma unroll
              for (int j = 0; j < 8; ++j) { const float pr = __shfl_xor(x[j], 1); const f32x2 cs = ROPE[pos * 8 + j]; o[j] = (sub & 1) == 0 ? x[j] * cs[0] - pr * cs[1] : x[j] * cs[0] + pr * cs[1]; } }
          else {
#pragma unroll
              for (int j = 0; j < 8; ++j) o[j] = x[j];
              const int s = r >> 8, pos = r & 255; float* skr = p.out + OUT_KR + ((size_t)(s * 4 + layer) * 256 + pos) * 32 + sub * 8;
              *(f32x4*)skr = (f32x4){o[0], o[1], o[2], o[3]}; *(f32x4*)(skr + 4) = (f32x4){o[4], o[5], o[6], o[7]}; }
          u32x4 w; w.x = pk2(o[0], o[1]); w.y = pk2(o[2], o[3]); w.z = pk2(o[4], o[5]); w.w = pk2(o[6], o[7]);
          *(u32x4*)(KR + (size_t)(keyrow0 + t) * 32 + sub * 8) = w; }
      } else {
        const int cu = u - 192, b = cu >> 1, half = cu & 1, row = half * 128 + t;
        const float* src = p.in[I_CCKV] + ((size_t)(b * 4 + layer) * 256 + row) * 128 + sub * 32;
#pragma unroll
        for (int i = 0; i < 4; ++i) { const f32x4 v0 = *(const f32x4*)(src + i * 8), v1 = *(const f32x4*)(src + i * 8 + 4);
            u32x4 w; w.x = pk2(v0[0], v0[1]); w.y = pk2(v0[2], v0[3]); w.z = pk2(v1[0], v1[1]); w.w = pk2(v1[2], v1[3]);
            *(LAS u32x4*)(CK + t * KS + sub * 32 + i * 8) = w; }
        const float* ksrc = p.in[I_CKR] + ((size_t)(b * 4 + layer) * 256 + row) * 32 + sub * 8;
        const f32x4 v0 = *(const f32x4*)ksrc, v1 = *(const f32x4*)(ksrc + 4);
        u32x4 w; w.x = pk2(v0[0], v0[1]); w.y = pk2(v0[2], v0[3]); w.z = pk2(v1[0], v1[1]); w.w = pk2(v1[2], v1[3]);
        *(u32x4*)(KR + (size_t)(keyrow0 + t) * 32 + sub * 8) = w;
      } }
    __syncthreads();
    const int l15 = C.lane & 15, hq = C.lane >> 4, w = C.wave;
    if (is_tok) {
        const bf16_t* Wq = (const bf16_t*)(C.wl(layer) + WL_UQ);
        bf16x8 aq[3][6];
#pragma unroll
        for (int j = 0; j < 3; ++j)
#pragma unroll
            for (int ks = 0; ks < 6; ++ks) aq[j][ks] = *(const bf16x8*)(Wq + (size_t)((3 * w + j) * 16 + l15) * 192 + ks * 32 + 8 * hq);
#pragma unroll 2
        for (int tt = 0; tt < 8; ++tt) {
            bf16x8 bq[6];
#pragma unroll
            for (int ks = 0; ks < 6; ++ks) bq[ks] = *(const LAS bf16x8*)(CQ + (tt * 16 + l15) * QS + ks * 32 + 8 * hq);
            const int r = r0 + tt * 16 + l15; const int n = (r - M_CTX) & 4095;
#pragma unroll
            for (int j = 0; j < 3; ++j) { const int nt = 3 * w + j; f32x4 acc = {0.f, 0.f, 0.f, 0.f};
#pragma unroll
                for (int ks = 0; ks < 6; ++ks) acc = mma16(aq[j][ks], bq[ks], acc);
                const int sub6 = nt % 6;
                if (lat && sub6 >= 4) { const int pos = sub6 == 4 ? (n >> 6) : (n & 63);
#pragma unroll
                    for (int jj = 0; jj < 4; ++jj) { const float pr = __shfl_xor(acc[jj], 32); const f32x2 cs = ROPE[pos * 8 + ((4 * hq + jj) & 7)]; acc[jj] = hq < 2 ? acc[jj] * cs[0] - pr * cs[1] : acc[jj] * cs[0] + pr * cs[1]; } }
                *(u32x2*)(Q + (size_t)r * 384 + nt * 16 + 4 * hq) = pk4(acc * QSCALE); }
        }
    }
    { const bf16_t* Wkv = (const bf16_t*)(C.wl(layer) + WL_UKV);
      bf16x8 wf[4][4];
#pragma unroll
      for (int j = 0; j < 4; ++j)
#pragma unroll
          for (int ks = 0; ks < 4; ++ks) wf[j][ks] = *(const bf16x8*)(Wkv + (size_t)((4 * w + j) * 16 + l15) * 128 + ks * 32 + 8 * hq);
      const int h = w >> 1; const bool isv = (w & 1) != 0;
#pragma unroll 2
      for (int tt = 0; tt < 8; ++tt) {
          bf16x8 ck[4];
#pragma unroll
          for (int ks = 0; ks < 4; ++ks) ck[ks] = *(const LAS bf16x8*)(CK + (tt * 16 + l15) * KS + ks * 32 + 8 * hq);
#pragma unroll
          for (int j = 0; j < 4; ++j) { f32x4 acc = {0.f, 0.f, 0.f, 0.f};
              if (!isv) {
#pragma unroll
                  for (int ks = 0; ks < 4; ++ks) acc = mma16(wf[j][ks], ck[ks], acc);
                  *(u32x2*)(KN + (size_t)(keyrow0 + tt * 16 + l15) * 256 + h * 64 + j * 16 + 4 * hq) = pk4(acc);
              } else {
#pragma unroll
                  for (int ks = 0; ks < 4; ++ks) acc = mma16(ck[ks], wf[j][ks], acc);
                  *(u32x2*)(VT + vtbase + (size_t)(h * 64 + j * 16 + l15) * nk + keypos0 + tt * 16 + 4 * hq) = pk4(acc);
              } } } }
    __syncthreads();
}

constexpr int AKS = 104, AVS = 72;
constexpr int ABUF = 64 * AKS * 2 + 64 * AVS * 2;
__device__ __forceinline__ void unit_attention(const Ctx& C, int u) {
    int rowbase, keyrow0, nk, h; size_t vtbase;
    if (u < 128) { const int s = u >> 2; h = u & 3; rowbase = s * 256; keyrow0 = s * 256; nk = 256; vtbase = (size_t)(s * 256) * 256; }
    else { const int v0 = u - 128; const int v = (C.G == 256) ? (((v0 & 7) * 2 + (v0 >> 7)) << 4) | ((v0 >> 3) & 15) : v0;
           const int b = v >> 6, qb = v & 15; h = (v >> 4) & 3; rowbase = M_CTX + b * 4096 + qb * 256; keyrow0 = M_CTX + b * 4352; nk = 4352; vtbase = (size_t)keyrow0 * 256; }
    const bf16_t* Q = (const bf16_t*)(C.ws + WS_Q); const bf16_t* KN = (const bf16_t*)(C.ws + WS_KN); const bf16_t* VT = (const bf16_t*)(C.ws + WS_VT); const bf16_t* KR = (const bf16_t*)(C.ws + WS_KR);
    bf16_t* MIX = (bf16_t*)(C.ws + WS_R1);
    const int l31 = C.lane & 31, hh = C.lane >> 5; const int qrow = rowbase + C.wave * 32 + l31;
    bf16x8 qf[6];
#pragma unroll
    for (int ks = 0; ks < 6; ++ks) qf[ks] = *(const bf16x8*)(Q + (size_t)qrow * 384 + h * 96 + ks * 16 + 8 * hh);
    f32x16 o0, o1;
#pragma unroll
    for (int i = 0; i < 16; ++i) { o0[i] = 0.f; o1[i] = 0.f; }
    float mrun = -1e30f, lsum = 0.f;
    const int skey = C.tid >> 3, sc8 = (C.tid & 7) * 8, rkey = (C.tid & 255) >> 2, rc8 = (C.tid & 3) * 8;
    const bf16_t* gkn = KN + (size_t)(keyrow0 + skey) * 256 + h * 64 + sc8;
    const bf16_t* gkr = KR + (size_t)(keyrow0 + rkey) * 32 + rc8;
    const bf16_t* gvt = VT + vtbase + (size_t)(h * 64 + skey) * nk + sc8;
    const bool do_r = C.tid < 256;
    const int lkn = (skey * AKS + sc8) * 2, lkr = (rkey * AKS + 64 + rc8) * 2, lvt = 64 * AKS * 2 + (skey * AVS + sc8) * 2;
    const int ntile = nk >> 6;
    u32x4 rk = *(const u32x4*)gkn, rr = do_r ? *(const u32x4*)gkr : (u32x4){0u, 0u, 0u, 0u}, rv = *(const u32x4*)gvt;
    *(LAS u32x4*)(C.lds + lkn) = rk; if (do_r) *(LAS u32x4*)(C.lds + lkr) = rr; *(LAS u32x4*)(C.lds + lvt) = rv;
    __syncthreads();
#pragma unroll 1
    for (int kt = 0; kt < ntile; ++kt) {
        const bool more = kt + 1 < ntile;
        if (more) { rk = *(const u32x4*)(gkn + (size_t)(kt + 1) * 64 * 256); if (do_r) rr = *(const u32x4*)(gkr + (size_t)(kt + 1) * 64 * 32); rv = *(const u32x4*)(gvt + (kt + 1) * 64); }
        LAS unsigned char* B = C.lds + (kt & 1) * ABUF;
        const LAS bf16_t* Kl = (const LAS bf16_t*)B; const LAS bf16_t* Vl = (const LAS bf16_t*)(B + 64 * AKS * 2);
        bf16x8 ka[2][6];
#pragma unroll
        for (int ks = 0; ks < 6; ++ks) { ka[0][ks] = *(const LAS bf16x8*)(Kl + l31 * AKS + ks * 16 + 8 * hh); ka[1][ks] = *(const LAS bf16x8*)(Kl + (32 + l31) * AKS + ks * 16 + 8 * hh); }
        __builtin_amdgcn_sched_barrier(0);
        f32x16 s0, s1;
#pragma unroll
        for (int i = 0; i < 16; ++i) { s0[i] = 0.f; s1[i] = 0.f; }
#pragma unroll
        for (int ks = 0; ks < 6; ++ks) { s0 = mma32(ka[0][ks], qf[ks], s0); s1 = mma32(ka[1][ks], qf[ks], s1); }
        __builtin_amdgcn_sched_barrier(0);
        u32x2 vr[2][2][4];
#pragma unroll
        for (int t = 0; t < 2; ++t)
#pragma unroll
            for (int ss = 0; ss < 2; ++ss) { const int ko = 32 * t + 16 * ss + 4 * hh;
                vr[t][ss][0] = *(const LAS u32x2*)(Vl + l31 * AVS + ko); vr[t][ss][1] = *(const LAS u32x2*)(Vl + l31 * AVS + ko + 8);
                vr[t][ss][2] = *(const LAS u32x2*)(Vl + (32 + l31) * AVS + ko); vr[t][ss][3] = *(const LAS u32x2*)(Vl + (32 + l31) * AVS + ko + 8); }
        __builtin_amdgcn_sched_barrier(0);
        float mx = fmaxf(s0[0], s1[0]);
#pragma unroll
        for (int i = 1; i < 16; ++i) mx = fmaxf(mx, fmaxf(s0[i], s1[i]));
        mx = fmaxf(mx, __shfl_xor(mx, 32));
        if (__builtin_amdgcn_ballot_w64(mx > mrun + 8.f) != 0ull) { const float mnew = fmaxf(mrun, mx); const float alpha = __builtin_amdgcn_exp2f(mrun - mnew); lsum *= alpha; o0 = o0 * alpha; o1 = o1 * alpha; mrun = mnew; }
        float ps = 0.f;
#pragma unroll
        for (int i = 0; i < 16; ++i) { s0[i] = __builtin_amdgcn_exp2f(s0[i] - mrun); s1[i] = __builtin_amdgcn_exp2f(s1[i] - mrun); ps += s0[i] + s1[i]; }
        lsum += ps;
#pragma unroll
        for (int t = 0; t < 2; ++t)
#pragma unroll
            for (int ss = 0; ss < 2; ++ss) {
                u32x4 w;
                if (t == 0) { w.x = pk2(s0[8 * ss + 0], s0[8 * ss + 1]); w.y = pk2(s0[8 * ss + 2], s0[8 * ss + 3]); w.z = pk2(s0[8 * ss + 4], s0[8 * ss + 5]); w.w = pk2(s0[8 * ss + 6], s0[8 * ss + 7]); }
                else { w.x = pk2(s1[8 * ss + 0], s1[8 * ss + 1]); w.y = pk2(s1[8 * ss + 2], s1[8 * ss + 3]); w.z = pk2(s1[8 * ss + 4], s1[8 * ss + 5]); w.w = pk2(s1[8 * ss + 6], s1[8 * ss + 7]); }
                const bf16x8 pf = __builtin_bit_cast(bf16x8, w);
                const bf16x8 va = __builtin_bit_cast(bf16x8, (u32x4){vr[t][ss][0].x, vr[t][ss][0].y, vr[t][ss][1].x, vr[t][ss][1].y}), vb = __builtin_bit_cast(bf16x8, (u32x4){vr[t][ss][2].x, vr[t][ss][2].y, vr[t][ss][3].x, vr[t][ss][3].y});
                o0 = mma32(va, pf, o0); o1 = mma32(vb, pf, o1);
            }
        if (more) { LAS unsigned char* Bn = C.lds + ((kt + 1) & 1) * ABUF; *(LAS u32x4*)(Bn + lkn) = rk; if (do_r) *(LAS u32x4*)(Bn + lkr) = rr; *(LAS u32x4*)(Bn + lvt) = rv; }
        __syncthreads();
    }
    lsum += __shfl_xor(lsum, 32);
    const float inv = 1.f / lsum;
    bf16_t* orow = MIX + (size_t)qrow * D + 768 + h * 64;
#pragma unroll
    for (int i = 0; i < 4; ++i) { const int dv = 8 * i + 4 * hh;
        *(u32x2*)(orow + dv) = pk4((f32x4){o0[4 * i] * inv, o0[4 * i + 1] * inv, o0[4 * i + 2] * inv, o0[4 * i + 3] * inv});
        *(u32x2*)(orow + 32 + dv) = pk4((f32x4){o1[4 * i] * inv, o1[4 * i + 1] * inv, o1[4 * i + 2] * inv, o1[4 * i + 3] * inv}); }
}

#define XB_TMO      128
#define XB_XCNT(j)  (256  + 64 * (j))
#define XB_XSUB(j)  (1280 + 64 * (j))
#define XB_XGEN(j)  (2304 + 64 * (j))
#define XB_TOP      3328
#define XB_TOPGEN   3392
#define XCD_BAR_WORDS 3456
#define XB_SPIN_CAP (1u << 18)

__device__ __forceinline__ unsigned xb_ld(unsigned* p)              { return __hip_atomic_load(p, __ATOMIC_RELAXED, __HIP_MEMORY_SCOPE_AGENT); }
__device__ __forceinline__ unsigned xb_add(unsigned* p, unsigned v) { return __hip_atomic_fetch_add(p, v, __ATOMIC_RELAXED, __HIP_MEMORY_SCOPE_AGENT); }
__device__ __forceinline__ unsigned xb_xcc_id() { return (unsigned)__builtin_amdgcn_s_getreg((3 << 11) | 20) & 0xFu; }
#define XB_SPIN(cond, bar) do { unsigned _sp = 0; while (cond) { __builtin_amdgcn_s_sleep(1); \
    if ((++_sp & 255u) == 0u) { if (xb_ld(&(bar)[XB_TMO])) break; if (_sp > XB_SPIN_CAP) { atomicAdd(&(bar)[XB_TMO], 1u); break; } } } } while (0)

struct XcdBarrier {
    unsigned* bar; unsigned x;
    volatile LAS unsigned* st;
};

__device__ __forceinline__ XcdBarrier xcd_barrier_post(unsigned* bar, volatile LAS unsigned* st) {
    XcdBarrier b; b.bar = bar; b.x = xb_xcc_id(); b.st = st;
    if (threadIdx.x == 0) (void)xb_add(&bar[XB_XCNT(b.x)], 1u);
    return b;
}
__device__ __forceinline__ void xcd_barrier_complete(unsigned* bar, unsigned x, unsigned& nloc, unsigned& nx) {
    const unsigned G = gridDim.x * gridDim.y * gridDim.z;
    unsigned sum, cnt, mine, sp = 0u;
    for (;;) {
        sum = 0u; cnt = 0u; mine = 0u;
#pragma unroll
        for (unsigned j = 0; j < 16; ++j) { const unsigned c = xb_ld(&bar[XB_XCNT(j)]); sum += c; cnt += (c > 0u) ? 1u : 0u; mine = (j == x) ? c : mine; }
        if (sum == G) break;
        __builtin_amdgcn_s_sleep(1);
        if ((++sp & 255u) == 0u) { if (xb_ld(&bar[XB_TMO])) break; if (sp > XB_SPIN_CAP) { atomicAdd(&bar[XB_TMO], 1u); break; } }
    }
    nloc = mine > 0u ? mine : 1u; nx = cnt > 0u ? cnt : 1u;
}

__device__ __forceinline__ void xcd_barrier(const XcdBarrier& b) {
    asm volatile("s_waitcnt vmcnt(0)" ::: "memory");
    __syncthreads();
    if (threadIdx.x == 0) {
        unsigned* bar = b.bar;
        __builtin_amdgcn_s_waitcnt(0);
        unsigned nloc = b.st[0], nx = b.st[1];
        if (nloc == 0u) { xcd_barrier_complete(bar, b.x, nloc, nx); b.st[0] = nloc; b.st[1] = nx; }
        const unsigned old = xb_add(&bar[XB_XSUB(b.x)], 1u);
        const unsigned gen = old / nloc;
        if (old + 1u == (gen + 1u) * nloc) {
            __builtin_amdgcn_fence(__ATOMIC_RELEASE, "agent");
            asm volatile("s_waitcnt vmcnt(0)" ::: "memory");
            const unsigned og = xb_add(&bar[XB_TOP], 1u);
            const unsigned tg = og / nx;
            if (og + 1u == (tg + 1u) * nx) xb_add(&bar[XB_TOPGEN], 1u);
            else XB_SPIN(xb_ld(&bar[XB_TOPGEN]) == tg, bar);
            __builtin_amdgcn_fence(__ATOMIC_ACQUIRE, "agent");
            xb_add(&bar[XB_XGEN(b.x)], 1u);
            asm volatile("s_waitcnt vmcnt(0)" ::: "memory");
        } else {
            XB_SPIN(xb_ld(&bar[XB_XGEN(b.x)]) == gen, bar);
            __builtin_amdgcn_fence(__ATOMIC_ACQUIRE, "agent");
            asm volatile("s_waitcnt vmcnt(0)" ::: "memory");
        }
    }
    __syncthreads();
}

__global__ void __launch_bounds__(NTHREADS, 2) mk_fwd(Params p) {
    extern __shared__ __attribute__((aligned(16))) unsigned char lds_raw[];
    cg::grid_group grid = cg::this_grid();
    Ctx C; C.p = p; C.lds = (LAS unsigned char*)lds_raw; C.tid = threadIdx.x; C.lane = C.tid & 63; C.wave = __builtin_amdgcn_readfirstlane(C.tid >> 6); C.bid = blockIdx.x; C.G = gridDim.x; C.ws = p.ws;

    volatile LAS unsigned* bst = (volatile LAS unsigned*)(C.lds + LDS_BYTES - 64);
    if (threadIdx.x < 2) bst[threadIdx.x] = 0u;
    __syncthreads();
    const XcdBarrier bar = xcd_barrier_post((unsigned*)(p.ws + WS_BAR), bst);
    C.refresh(); phase_prologue(C);
    grid.sync();
    C.refresh(); phase_norm0(C);
    xcd_barrier(bar);
#pragma unroll 1
    for (int layer = 0; layer < DEPTH; ++layer) {
        { C.refresh(); bf16_t* R1 = (bf16_t*)(C.ws + WS_R1); bf16_t* R2 = (bf16_t*)(C.ws + WS_R2); unsigned char* wl = C.wl(layer); pg8::Gemm g{R1, (const bf16_t*)(wl + WL_IN), M, NPP, D}; pg8::StaticOrder S; S.init(M, NPP, C.G, C.bid); pg8::EpiStore E{R2, NP, NP};
          pg8::gemm_phase<pg8::EpiStore, pg8::StaticOrder, true, true>(C.lds, g, S, E); }
        xcd_barrier(bar);
        C.refresh();
        for (int u = C.bid; u < 768 + 192 + 128 + 128 + 200; u += C.G) {
            C.refresh();
            if (u < 768) unit_chunk_mlp(C, layer, u);
            else if (u < 960) unit_conv(C, layer, u - 768);
            else if (u < 1088) unit_fourier_ctx(C, u - 960);
            else if (u < 1216) unit_fourier_lat1(C, u - 1088);
            else unit_mla_prep(C, layer, u - 1216);
        }
        xcd_barrier(bar);
        C.refresh();
        for (int u = C.bid; u < 512; u += C.G) {
            C.refresh();
            if (u < 256) unit_attention(C, 128 + u);
            else if (u < 384) unit_attention(C, u - 256);
            else unit_fourier_lat2(C, u - 384);
        }
        xcd_barrier(bar);
        { C.refresh(); bf16_t* R1 = (bf16_t*)(C.ws + WS_R1); bf16_t* R2 = (bf16_t*)(C.ws + WS_R2); unsigned char* wl = C.wl(layer); pg8::Gemm g{R1, (const bf16_t*)(wl + WL_OUT), M, D, D}; pg8::StaticOrder S; S.init(M, D, C.G, C.bid); pg8::EpiStore E{R2, D, D};
          pg8::gemm_phase<pg8::EpiStore, pg8::StaticOrder, true, true>(C.lds, g, S, E); }
        xcd_barrier(bar);
        C.refresh(); phase_post<0>(C, layer);
        xcd_barrier(bar);
        { C.refresh(); bf16_t* R1 = (bf16_t*)(C.ws + WS_R1); bf16_t* R2 = (bf16_t*)(C.ws + WS_R2); unsigned char* wl = C.wl(layer); pg8::Gemm g{R1, (const bf16_t*)(wl + WL_GU), M, 2 * FF, D}; pg8::StaticOrder S; S.init(M, 2 * FF, C.G, C.bid); pg8::EpiSwiGLU E{R2, FF};
          pg8::gemm_phase<pg8::EpiSwiGLU, pg8::StaticOrder, true, true>(C.lds, g, S, E); }
        xcd_barrier(bar);
        { C.refresh(); bf16_t* R2 = (bf16_t*)(C.ws + WS_R2); bf16_t* R3 = (bf16_t*)(C.ws + WS_MLA); unsigned char* wl = C.wl(layer); pg8::Gemm g{R2, (const bf16_t*)(wl + WL_DN), M, D, FF}; pg8::StaticOrder S; S.init(M, D, C.G, C.bid); pg8::EpiStore E{R3, D, D};
          pg8::gemm_phase<pg8::EpiStore, pg8::StaticOrder, true, true>(C.lds, g, S, E);
          if (C.G == 256 && layer + 1 < DEPTH && C.bid >= 128) { C.refresh(); transpose_items(C, (layer + 1) * TI_L + (C.bid - 128), 128, (layer + 2) * TI_L); } }
        xcd_barrier(bar);
        C.refresh(); phase_post<1>(C, layer);
        if (layer + 1 < DEPTH) xcd_barrier(bar);
    }
}

extern "C" void kernel_launch(void* const* d_in, const int* in_sizes, int n_in, void* d_out, int out_size, void* d_ws, size_t ws_size, hipStream_t stream) {
    static int grid = 0;
    if (grid == 0) {
        if (n_in != 24 || ws_size < WS_END) { fprintf(stderr, "kernel_launch: need 24 inputs and %zu bytes of workspace; got %d, %zu\n", (size_t)WS_END, n_in, ws_size); grid = -1; return; }
        int dev = 0, cus = 0, per_cu = 0;
        if (hipGetDevice(&dev) != hipSuccess || hipDeviceGetAttribute(&cus, hipDeviceAttributeMultiprocessorCount, dev) != hipSuccess) { grid = -1; return; }
        if (hipFuncSetAttribute((const void*)mk_fwd, hipFuncAttributeMaxDynamicSharedMemorySize, LDS_BYTES) != hipSuccess) { fprintf(stderr, "kernel_launch: hipFuncSetAttribute failed\n"); grid = -1; return; }
        if (hipOccupancyMaxActiveBlocksPerMultiprocessor(&per_cu, (const void*)mk_fwd, NTHREADS, LDS_BYTES) != hipSuccess || per_cu < 1) fprintf(stderr, "kernel_launch: occupancy query says %d blocks per CU\n", per_cu);
        (void)hipGetLastError();
        grid = cus;
    }
    if (grid < 0) return;
    Params p{};
    for (int i = 0; i < 24; ++i) p.in[i] = (const float*)d_in[i];
    p.out = (float*)d_out; p.ws = (unsigned char*)d_ws;
    if (hipMemsetAsync((char*)d_ws + WS_BAR, 0, WS_BAR_BYTES, stream) != hipSuccess) { fprintf(stderr, "kernel_launch: memset failed\n"); return; }
    void* args[] = {&p};
    hipError_t e = hipLaunchCooperativeKernel((const void*)mk_fwd, dim3(grid), dim3(NTHREADS), args, LDS_BYTES, stream);
    if (e != hipSuccess) fprintf(stderr, "kernel_launch: cooperative launch failed: %s (grid %d)\n", hipGetErrorString(e), grid);
}
```

```cpp
#include <hip/hip_runtime.h>
#include <hip/hip_cooperative_groups.h>
#include <cstdio>
#include <cstdint>
namespace cg = cooperative_groups;
namespace pg8 {
#define PG8_LAS __attribute__((address_space(3)))
typedef unsigned short bf16_t;
typedef short bf16x8 __attribute__((ext_vector_type(8)));
typedef float f32x4 __attribute__((ext_vector_type(4)));
typedef unsigned u32x4 __attribute__((ext_vector_type(4)));
constexpr int BM = 256, BK = 64, HALF = 128, HTB = HALF * BK * 2  , STAGE_BYTES = 8 * HTB, NXCD = 8, WGM = 8;

__host__ __device__ __forceinline__ int lds_byte(int r, int c) { const int st = (r >> 4) * 2 + (c >> 5), rr = r & 15, cc = c & 31, ob = rr * 64 + cc * 2; return st * 1024 + (ob ^ (((ob >> 9) & 1) << 5)); }
__host__ __device__ __forceinline__ void stage_rc(int b, int& R, int& C) { const int st = b / 1024, sb = b % 1024, swz = sb ^ (((sb >> 9) & 1) << 5); R = (st >> 1) * 16 + swz / 64; C = (st & 1) * 32 + (swz % 64) / 2; }
__host__ __device__ __forceinline__ int perm32(int rho) { const int n = rho >> 4, i = rho & 15; return 8 * (i >> 2) + 4 * n + (i & 3); }

struct Unit { int pm, pn; int kh, nt, koff; };
struct Gemm { const bf16_t* A; const bf16_t* Bt; int M, N, K; };

struct StaticOrder {
    int nM, nN, nwg, G, c;
    __host__ __device__ void init(int M, int N, int G_, int c_) { nM = M / BM; nN = N / BM; nwg = nM * nN; G = G_; c = c_; }
    __host__ __device__ bool next(int i, Unit& u) const {
        const long L = (long)i * G + c; if (L >= nwg) return false;
        int wgid = (int)L; { const int q = nwg / NXCD, r = nwg % NXCD, xcd = wgid % NXCD, off = wgid / NXCD; wgid = (xcd < r ? xcd * (q + 1) : r * (q + 1) + (xcd - r) * q) + off; }
        const int nig = WGM * nN, gid = wgid / nig, fm = gid * WGM, gsz = (nM - fm) < WGM ? (nM - fm) : WGM;
        u.pm = fm + ((wgid % nig) % gsz); u.pn = (wgid % nig) / gsz; u.kh = 0; u.nt = 0; u.koff = 0; return true;
    }
    __device__ __forceinline__ void a_ready(const Unit&) const {}
    __device__ __forceinline__ void done(const Unit&) const {}
};

__device__ __forceinline__ unsigned cvt_pk_bf16(float lo, float hi) { unsigned r; asm volatile("v_cvt_pk_bf16_f32 %0, %1, %2" : "=v"(r) : "v"(lo), "v"(hi)); return r; }
typedef float f32x2 __attribute__((ext_vector_type(2)));
struct EpiStore {
    static constexpr bool PERM = true, AFTER_DRAIN = false;
    bf16_t* O; int ldc; int ncols;
    __device__ __forceinline__ void operator()(const f32x4 (&acc)[2][2][4][2], const Unit& u, int wr, int wc, int fr, int fq) const {
        const int row0 = u.pm * BM + wr * 64 + fr; const int col0 = u.pn * BM + wc * 32 + 8 * fq;
#pragma unroll
        for (int ai = 0; ai < 2; ++ai)
#pragma unroll
            for (int m = 0; m < 4; ++m) { bf16_t* rowp = O + (size_t)(row0 + ai * HALF + m * 16) * ldc + col0;
#pragma unroll
                for (int bj = 0; bj < 2; ++bj) { const f32x4 v0 = acc[ai][bj][m][0], v1 = acc[ai][bj][m][1];
                    u32x4 w; w.x = cvt_pk_bf16(v0[0], v0[1]); w.y = cvt_pk_bf16(v0[2], v0[3]); w.z = cvt_pk_bf16(v1[0], v1[1]); w.w = cvt_pk_bf16(v1[2], v1[3]);
                    if (col0 + bj * HALF < ncols) *(u32x4*)(rowp + bj * HALF) = w; } }
    }
};
struct EpiStoreWT {
    static constexpr bool PERM = true, AFTER_DRAIN = false;
    bf16_t* O; int ldc; int ncols;
    __device__ __forceinline__ void operator()(const f32x4 (&acc)[2][2][4][2], const Unit& u, int wr, int wc, int fr, int fq) const {
        const int row0 = u.pm * BM + wr * 64 + fr; const int col0 = u.pn * BM + wc * 32 + 8 * fq;
#pragma unroll
        for (int ai = 0; ai < 2; ++ai)
#pragma unroll
            for (int m = 0; m < 4; ++m) { bf16_t* rowp = O + (size_t)(row0 + ai * HALF + m * 16) * ldc + col0;
#pragma unroll
                for (int bj = 0; bj < 2; ++bj) { const f32x4 v0 = acc[ai][bj][m][0], v1 = acc[ai][bj][m][1];
                    const unsigned long long lo = (unsigned long long)cvt_pk_bf16(v0[0], v0[1]) | ((unsigned long long)cvt_pk_bf16(v0[2], v0[3]) << 32);
                    const unsigned long long hi = (unsigned long long)cvt_pk_bf16(v1[0], v1[1]) | ((unsigned long long)cvt_pk_bf16(v1[2], v1[3]) << 32);
                    unsigned long long* q = (unsigned long long*)(rowp + bj * HALF);
                    __hip_atomic_store(q, lo, __ATOMIC_RELAXED, __HIP_MEMORY_SCOPE_AGENT); __hip_atomic_store(q + 1, hi, __ATOMIC_RELAXED, __HIP_MEMORY_SCOPE_AGENT); } }
    }
};
__device__ __forceinline__ float silu_mul(float g, float u) { return g * u * __builtin_amdgcn_rcpf(1.f + __expf(-g)); }
struct EpiSwiGLU {
    static constexpr bool PERM = true, AFTER_DRAIN = false;
    bf16_t* O; int ldc;
    __device__ __forceinline__ void operator()(const f32x4 (&acc)[2][2][4][2], const Unit& u, int wr, int wc, int fr, int fq) const {
        const int row0 = u.pm * BM + wr * 64 + fr; const int col0 = u.pn * HALF + wc * 32 + 8 * fq;
#pragma unroll
        for (int ai = 0; ai < 2; ++ai)
#pragma unroll
            for (int m = 0; m < 4; ++m) { bf16_t* rowp = O + (size_t)(row0 + ai * HALF + m * 16) * ldc + col0;
                const f32x4 g0 = acc[ai][0][m][0], g1 = acc[ai][0][m][1], u0 = acc[ai][1][m][0], u1 = acc[ai][1][m][1];
                u32x4 w; w.x = cvt_pk_bf16(silu_mul(g0[0], u0[0]), silu_mul(g0[1], u0[1])); w.y = cvt_pk_bf16(silu_mul(g0[2], u0[2]), silu_mul(g0[3], u0[3]));
                w.z = cvt_pk_bf16(silu_mul(g1[0], u1[0]), silu_mul(g1[1], u1[1])); w.w = cvt_pk_bf16(silu_mul(g1[2], u1[2]), silu_mul(g1[3], u1[3]));
                *(u32x4*)rowp = w; }
    }
};

struct PanelOrder {
    int nN, nwg, G, c; unsigned* cnt;
    __device__ void init(int M, int N, int G_, int c_, unsigned* cnt_) { nN = N / BM; nwg = (M / BM) * nN; G = G_; c = c_; cnt = cnt_; }
    __device__ bool next(int i, Unit& u) const { const long L = (long)i * G + c; if (L >= nwg) return false; u.pm = (int)L / nN; u.pn = (int)L % nN; u.kh = 0; u.nt = 0; u.koff = 0; return true; }
    __device__ __forceinline__ void a_ready(const Unit&) const {}
    __device__ __forceinline__ void done(const Unit& u) const {
        asm volatile("s_waitcnt vmcnt(0)" ::: "memory");
        if ((threadIdx.x & 63) == 0) __hip_atomic_fetch_add(cnt + u.pm, 1u, __ATOMIC_RELAXED, __HIP_MEMORY_SCOPE_AGENT);
    }
};

struct SplitTailOrder {
    int G, c, ntf; bool split;
    __device__ void init(int K, int G_, int c_) { G = G_; c = c_; ntf = K / BK; split = (G_ == 256); }
    __device__ bool next(int i, Unit& u) const {
        if (!split) { const long L = (long)i * G + c; if (L >= 384) return false; u.pm = (int)L >> 2; u.pn = (int)L & 3; u.kh = 0; u.nt = 0; u.koff = 0; return true; }
        if (i == 0) { const int t = (c & 7) * 32 + (c >> 3); u.pm = t >> 2; u.pn = t & 3; u.kh = 0; u.nt = 0; u.koff = 0; return true; }
        if (i == 1) { const int t = 256 + (c & 7) * 16 + (c >> 4); u.pm = t >> 2; u.pn = t & 3; u.kh = (c >> 3) & 1; u.nt = ntf / 2; u.koff = u.kh * (ntf / 2) * BK * 2; return true; }
        return false;
    }
    __device__ __forceinline__ void a_ready(const Unit&) const {}
    __device__ __forceinline__ void done(const Unit&) const {}
};
struct EpiStoreSplit {
    static constexpr bool PERM = true, AFTER_DRAIN = false;
    bf16_t* O; bf16_t* O1; int ldc;
    __device__ __forceinline__ void operator()(const f32x4 (&acc)[2][2][4][2], const Unit& u, int wr, int wc, int fr, int fq) const {
        const int row0 = u.pm * BM + wr * 64 + fr; const int col0 = u.pn * BM + wc * 32 + 8 * fq; bf16_t* base = u.kh ? O1 : O;
#pragma unroll
        for (int ai = 0; ai < 2; ++ai)
#pragma unroll
            for (int m = 0; m < 4; ++m) { bf16_t* rowp = base + (size_t)(row0 + ai * HALF + m * 16) * ldc + col0;
#pragma unroll
                for (int bj = 0; bj < 2; ++bj) { const f32x4 v0 = acc[ai][bj][m][0], v1 = acc[ai][bj][m][1];
                    u32x4 w; w.x = cvt_pk_bf16(v0[0], v0[1]); w.y = cvt_pk_bf16(v0[2], v0[3]); w.z = cvt_pk_bf16(v1[0], v1[1]); w.w = cvt_pk_bf16(v1[2], v1[3]);
                    *(u32x4*)(rowp + bj * HALF) = w; } }
    }
};
template <class Epi, class Sched, bool ALIGN_EPI = false, bool SP2 = false>
__device__ __forceinline__ void gemm_phase(PG8_LAS unsigned char* lds, const Gemm g, const Sched& S, const Epi& E) {
    int tid_ = threadIdx.x; asm volatile("" : "+v"(tid_));
    const int tid = tid_, wid = __builtin_amdgcn_readfirstlane(tid >> 6), lane = tid & 63, wr = wid >> 2, wc = wid & 3, fr = lane & 15, fq = lane >> 4;
    const int K = g.K, nt = K / BK;
    unsigned voffA[2], voffB[2];
#pragma unroll
    for (int i = 0; i < 2; ++i) { int R, C; stage_rc(tid * 16 + i * 8192, R, C); const int Rb = Epi::PERM ? ((R & ~31) + perm32(R & 31)) : R;
        voffA[i] = (unsigned)(R * K + C) * 2u; voffB[i] = (unsigned)(Rb * K + C) * 2u; }
    const size_t kstep = (size_t)(BK * 2);
    const size_t hstep = (size_t)HALF * K * 2;
    const size_t tstep = 2 * hstep;
    const unsigned ldsw = (unsigned)wid * 1024u;
    const int aoff = lds_byte(wr * 64 + fr, fq * 8), boff = lds_byte(wc * 32 + fr, fq * 8);
#define PG8_SA(b, h) (((b) * 2 + (h)) * HTB)
#define PG8_SB(b, h) ((4 + (b) * 2 + (h)) * HTB)
#define PG8_STAGE(bufoff, gbase, voff) do { _Pragma("unroll") for (int _i = 0; _i < 2; ++_i) \
        __builtin_amdgcn_global_load_lds((const unsigned*)((const char*)(gbase) + (voff)[_i]), (PG8_LAS unsigned*)(lds + (bufoff) + ldsw + _i * 8192), 16, 0, 0); } while (0)
#define PG8_LDA(dst, b, h) do { _Pragma("unroll") for (int m = 0; m < 4; ++m) _Pragma("unroll") for (int k = 0; k < 2; ++k) dst[m][k] = *(const PG8_LAS bf16x8*)(lds + PG8_SA(b, h) + aoff + m * 2048 + k * 1024); } while (0)
#define PG8_LDB(dst, b, h) do { _Pragma("unroll") for (int n = 0; n < 2; ++n) _Pragma("unroll") for (int k = 0; k < 2; ++k) dst[n][k] = *(const PG8_LAS bf16x8*)(lds + PG8_SB(b, h) + boff + n * 2048 + k * 1024); } while (0)
#define PG8_MMA(ai, bj, At, Bt) do { __builtin_amdgcn_s_setprio(1); _Pragma("unroll") for (int m = 0; m < 4; ++m) _Pragma("unroll") for (int n = 0; n < 2; ++n) _Pragma("unroll") for (int k = 0; k < 2; ++k) \
        acc[ai][bj][m][n] = __builtin_amdgcn_mfma_f32_16x16x32_bf16(Bt[n][k], At[m][k], acc[ai][bj][m][n], 0, 0, 0); __builtin_amdgcn_s_setprio(0); } while (0)
#define PG8_WAIT_V(n) asm volatile("s_waitcnt vmcnt(" #n ")" ::: "memory")
#define PG8_WAIT_L(n) asm volatile("s_waitcnt lgkmcnt(" #n ")" ::: "memory")
#define PG8_BAR __builtin_amdgcn_s_barrier()
#define PG8_SCHED __builtin_amdgcn_sched_barrier(0)
    Unit cur, nxt; int ui = 0;
    if (!S.next(0, cur)) return;
    f32x4 acc[2][2][4][2];
#pragma unroll
    for (int a = 0; a < 2; ++a)
#pragma unroll
        for (int b = 0; b < 2; ++b)
#pragma unroll
            for (int m = 0; m < 4; ++m)
#pragma unroll
                for (int n = 0; n < 2; ++n) acc[a][b][m][n] = (f32x4){0.f, 0.f, 0.f, 0.f};
    bf16x8 At[4][2], B0[2][2], B1[2][2];
    const char* cA = (const char*)g.A + (size_t)cur.pm * tstep + cur.koff; const char* cB = (const char*)g.Bt + (size_t)cur.pn * tstep + cur.koff;
    S.a_ready(cur);
    if constexpr (SP2) {
        PG8_STAGE(PG8_SB(0, 0), cB, voffB); PG8_STAGE(PG8_SB(0, 1), cB + hstep, voffB); PG8_STAGE(PG8_SA(0, 0), cA, voffA); PG8_STAGE(PG8_SA(0, 1), cA + hstep, voffA);
        if (wr == 1) PG8_BAR;
        PG8_WAIT_V(2); PG8_BAR;
        PG8_STAGE(PG8_SB(1, 0), cB + kstep, voffB); PG8_STAGE(PG8_SA(1, 0), cA + kstep, voffA); PG8_STAGE(PG8_SB(1, 1), cB + hstep + kstep, voffB);
        PG8_WAIT_V(6); PG8_BAR;
    } else {
        PG8_STAGE(PG8_SB(0, 0), cB, voffB); PG8_STAGE(PG8_SA(0, 0), cA, voffA); PG8_STAGE(PG8_SB(0, 1), cB + hstep, voffB); PG8_STAGE(PG8_SA(0, 1), cA + hstep, voffA);
        if (wr == 1) PG8_BAR;
        PG8_WAIT_V(4); PG8_BAR;
        PG8_STAGE(PG8_SB(1, 0), cB + kstep, voffB); PG8_STAGE(PG8_SA(1, 0), cA + kstep, voffA); PG8_STAGE(PG8_SB(1, 1), cB + hstep + kstep, voffB);
        PG8_WAIT_V(6); PG8_BAR;
    }
    for (;;) {
        const bool has_next = S.next(ui + 1, nxt);
        const char* nA = has_next ? (const char*)g.A + (size_t)nxt.pm * tstep + nxt.koff : cA; const char* nB = has_next ? (const char*)g.Bt + (size_t)nxt.pn * tstep + nxt.koff : cB;
        const int ntc = cur.nt ? cur.nt : nt;
        for (int t = 0; t < ntc; t += 2) {
            const bool last = (t == ntc - 2);
            const char* a1 = cA + (size_t)(t + 1) * kstep;
            const char* a2 = last ? nA : cA + (size_t)(t + 2) * kstep; const char* b2 = last ? nB : cB + (size_t)(t + 2) * kstep;
            const char* a3 = a2 + kstep; const char* b3 = b2 + kstep;
            if (last && has_next) S.a_ready(nxt);
            if constexpr (SP2) {
            PG8_LDB(B0, 0, 0); PG8_LDB(B1, 0, 1); PG8_SCHED; PG8_LDA(At, 0, 0); PG8_STAGE(PG8_SA(1, 1), a1 + hstep, voffA);
            PG8_WAIT_V(8); PG8_WAIT_L(0); PG8_BAR; PG8_MMA(0, 0, At, B0); PG8_MMA(0, 1, At, B1); PG8_BAR; PG8_SCHED;
            PG8_LDA(At, 0, 1); PG8_STAGE(PG8_SB(0, 0), b2, voffB); PG8_STAGE(PG8_SB(0, 1), b2 + hstep, voffB); PG8_STAGE(PG8_SA(0, 0), a2, voffA);
            PG8_WAIT_V(8); PG8_WAIT_L(0); PG8_BAR; PG8_MMA(1, 0, At, B0); PG8_MMA(1, 1, At, B1); PG8_BAR; PG8_SCHED;
            PG8_LDB(B0, 1, 0); PG8_LDB(B1, 1, 1); PG8_SCHED; PG8_LDA(At, 1, 0); PG8_STAGE(PG8_SA(0, 1), a2 + hstep, voffA);
            PG8_WAIT_V(8); PG8_WAIT_L(0); PG8_BAR; PG8_MMA(0, 0, At, B0); PG8_MMA(0, 1, At, B1); PG8_BAR; PG8_SCHED;
            PG8_LDA(At, 1, 1); PG8_STAGE(PG8_SB(1, 0), b3, voffB); PG8_STAGE(PG8_SB(1, 1), b3 + hstep, voffB); PG8_STAGE(PG8_SA(1, 0), a3, voffA);
            PG8_WAIT_V(8); PG8_WAIT_L(0); PG8_BAR; PG8_MMA(1, 0, At, B0); PG8_MMA(1, 1, At, B1); PG8_BAR; PG8_SCHED;
            } else {
            PG8_LDB(B0, 0, 0); PG8_SCHED; PG8_LDA(At, 0, 0); PG8_STAGE(PG8_SA(1, 1), a1 + hstep, voffA);
            PG8_WAIT_L(8); PG8_BAR; PG8_WAIT_L(0); PG8_MMA(0, 0, At, B0); PG8_BAR; PG8_SCHED;
            PG8_LDB(B1, 0, 1); PG8_STAGE(PG8_SB(0, 0), b2, voffB);
            PG8_BAR; PG8_WAIT_L(0); PG8_MMA(0, 1, At, B1); PG8_BAR;
            PG8_LDA(At, 0, 1); PG8_STAGE(PG8_SA(0, 0), a2, voffA);
            PG8_BAR; PG8_WAIT_L(0); PG8_MMA(1, 0, At, B0); PG8_BAR; PG8_SCHED;
            PG8_STAGE(PG8_SB(0, 1), b2 + hstep, voffB);
            PG8_WAIT_V(6); PG8_BAR; PG8_MMA(1, 1, At, B1); PG8_BAR;
            PG8_LDB(B0, 1, 0); PG8_SCHED; PG8_LDA(At, 1, 0); PG8_STAGE(PG8_SA(0, 1), a2 + hstep, voffA);
            PG8_WAIT_L(8); PG8_BAR; PG8_WAIT_L(0); PG8_MMA(0, 0, At, B0); PG8_BAR; PG8_SCHED;
            PG8_LDB(B1, 1, 1); PG8_STAGE(PG8_SB(1, 0), b3, voffB);
            PG8_BAR; PG8_WAIT_L(0); PG8_MMA(0, 1, At, B1); PG8_BAR;
            PG8_LDA(At, 1, 1); PG8_STAGE(PG8_SA(1, 0), a3, voffA);
            PG8_BAR; PG8_WAIT_L(0); PG8_MMA(1, 0, At, B0); PG8_BAR; PG8_SCHED;
            PG8_STAGE(PG8_SB(1, 1), b3 + hstep, voffB);
            PG8_WAIT_V(6); PG8_BAR; PG8_MMA(1, 1, At, B1); PG8_BAR;
            }
        }
        if constexpr (ALIGN_EPI) { if (wr == 0) PG8_BAR; }
        if constexpr (!Epi::AFTER_DRAIN) { E(acc, cur, wr, wc, fr, fq); S.done(cur); }
        if (!has_next) break;
#pragma unroll
        for (int a = 0; a < 2; ++a)
#pragma unroll
            for (int b = 0; b < 2; ++b)
#pragma unroll
                for (int m = 0; m < 4; ++m)
#pragma unroll
                    for (int n = 0; n < 2; ++n) acc[a][b][m][n] = (f32x4){0.f, 0.f, 0.f, 0.f};
        cur = nxt; cA = nA; cB = nB; ++ui;
        if constexpr (ALIGN_EPI) { if (wr == 1) PG8_BAR; }
    }
    PG8_WAIT_V(0);
    if constexpr (!ALIGN_EPI) { if (wr == 0) PG8_BAR; }
    PG8_BAR;
    if constexpr (Epi::AFTER_DRAIN) { E.fused(acc, cur, wr, wc, fr, fq, lds, wid, lane); S.done(cur); }
#undef PG8_SA
#undef PG8_SB
#undef PG8_STAGE
#undef PG8_LDA
#undef PG8_LDB
#undef PG8_MMA
#undef PG8_WAIT_V
#undef PG8_WAIT_L
#undef PG8_BAR
#undef PG8_SCHED
}
}
#define LAS __attribute__((address_space(3)))
typedef unsigned short bf16_t;
typedef short bf16x8 __attribute__((ext_vector_type(8)));
typedef short bf16x4 __attribute__((ext_vector_type(4)));
typedef float f32x4 __attribute__((ext_vector_type(4)));
typedef float f32x2 __attribute__((ext_vector_type(2)));
typedef float f32x16 __attribute__((ext_vector_type(16)));
typedef unsigned u32x4 __attribute__((ext_vector_type(4)));
typedef unsigned u32x2 __attribute__((ext_vector_type(2)));

constexpr int D = 1024, M_CTX = 8192, M_LAT = 16384, M = M_CTX + M_LAT, NP = 1888, NPP = 2048, FF = 2816, DEPTH = 4;
constexpr int KEYROWS = 8192 + 4 * 4352;
constexpr float EPS = 1e-6f;
constexpr int NTHREADS = 512, NWAVES = 8;
constexpr int LDS_BYTES = 147456;

constexpr size_t OUT_X = 0, OUT_CKV = (size_t)M * D, OUT_KR = OUT_CKV + (size_t)32 * 4 * 256 * 128;
constexpr int PC_U = 0, PC_V = 256, PC_H = 512, PC_B = 768, PC_C = 1024, PC_F = 1280, PC_Q = 1536, PC_KV = 1728, PC_KR = 1856;

constexpr size_t al256(size_t x) { return (x + 255) & ~(size_t)255; }
constexpr size_t WS_BAR = 0, WS_BAR_BYTES = 16384;
constexpr size_t WS_MOD = WS_BAR_BYTES;
constexpr size_t WS_F64 = al256(WS_MOD + (size_t)4 * 5 * 6144 * 4);
constexpr size_t WS_T64R = WS_F64 + 128 * 64 * 2;
constexpr size_t WS_T64I = WS_T64R + 64 * 128 * 2;
constexpr size_t WS_T64B = WS_T64I + 64 * 128 * 2;
constexpr size_t WS_T256 = WS_T64B + 64 * 128 * 2;
constexpr size_t WS_TW = WS_T256 + 256 * 512 * 2;
constexpr size_t WS_ROPE = WS_TW + 4096 * 8;
constexpr size_t WS_W = al256(WS_ROPE + 64 * 8 * 8);
constexpr size_t WL_IN = 0, WL_OUT = WL_IN + (size_t)NPP * D * 2, WL_GU = WL_OUT + (size_t)D * D * 2, WL_DN = WL_GU + (size_t)2 * FF * D * 2,
                 WL_UQ = WL_DN + (size_t)D * FF * 2, WL_UKV = WL_UQ + (size_t)384 * 192 * 2, WL_SP = WL_UKV + (size_t)512 * 128 * 2, WL_SIZE = WL_SP + (size_t)4 * 128 * 128 * 2;
constexpr size_t WS_R1 = al256(WS_W + 4 * WL_SIZE);
constexpr size_t WS_R2 = WS_R1 + (size_t)M * D * 2;
constexpr size_t WS_MLA = WS_R2 + (size_t)M * FF * 2;
constexpr size_t WS_Q = WS_MLA, WS_KN = WS_Q + (size_t)M * 384 * 2, WS_VT = WS_KN + (size_t)KEYROWS * 256 * 2, WS_KR = WS_VT + (size_t)KEYROWS * 256 * 2,
                 WS_GB = WS_KR + (size_t)KEYROWS * 32 * 2, WS_END = WS_GB + (size_t)4 * 4 * 64 * 64 * 128 * 2;
static_assert(WS_END - WS_MLA >= (size_t)M * D * 2, "FFNOUT alias");
static_assert((size_t)M * NP * 2 <= (size_t)M * FF * 2, "PROJ fits R2");

struct Params { const float* in[24]; float* out; unsigned char* ws; };
enum { I_XP = 0, I_XS, I_CCKV, I_CKR, I_C, I_CCTX, I_WADA, I_BADA, I_GPM, I_GPOM, I_GPF, I_GPOF, I_WIN, I_SPW, I_SPB, I_CVW, I_CVB, I_GQ, I_WUQ, I_GKV, I_WUKV, I_WOUT, I_WGU, I_WDN };

__device__ __forceinline__ unsigned f2bf(float f) { unsigned u = __builtin_bit_cast(unsigned, f); return (u + 0x7fffu + ((u >> 16) & 1u)) >> 16; }
typedef __bf16 bf16x2v __attribute__((ext_vector_type(2)));
__device__ __forceinline__ unsigned pk2(float lo, float hi) { const bf16x2v r = __builtin_convertvector((f32x2){lo, hi}, bf16x2v); return __builtin_bit_cast(unsigned, r); }
__device__ __forceinline__ float bflo(unsigned w) { return __builtin_bit_cast(float, w << 16); }
__device__ __forceinline__ float bfhi(unsigned w) { return __builtin_bit_cast(float, w & 0xffff0000u); }
__device__ __forceinline__ float bf1(bf16_t v) { return __builtin_bit_cast(float, (unsigned)v << 16); }
__device__ __forceinline__ f32x4 mma16(bf16x8 a, bf16x8 b, f32x4 c) { return __builtin_amdgcn_mfma_f32_16x16x32_bf16(a, b, c, 0, 0, 0); }
__device__ __forceinline__ f32x16 mma32(bf16x8 a, bf16x8 b, f32x16 c) { return __builtin_amdgcn_mfma_f32_32x32x16_bf16(a, b, c, 0, 0, 0); }
__device__ __forceinline__ float wave_sum(float v) {
#pragma unroll
    for (int o = 1; o < 64; o <<= 1) v += __shfl_xor(v, o);
    return v;
}
__device__ __forceinline__ u32x2 pk4(f32x4 v) { u32x2 w; w.x = pk2(v[0], v[1]); w.y = pk2(v[2], v[3]); return w; }
__device__ __forceinline__ int mod_of_row(int r) { return r < M_CTX ? 0 : 1 + ((r - M_CTX) >> 12); }

struct Ctx {
    Params p; LAS unsigned char* lds; int tid, lane, wave, bid, G;
    unsigned char* ws;
    __device__ __forceinline__ const float* mod(int l, int mi, int chunk) const { return (const float*)(ws + WS_MOD) + ((size_t)(l * 5 + mi) * 6 + chunk) * 1024; }
    __device__ __forceinline__ unsigned char* wl(int l) const { return ws + WS_W + (size_t)l * WL_SIZE; }
    __device__ __forceinline__ void refresh() { int t = threadIdx.x; asm volatile("" : "+v"(t)); tid = t; lane = t & 63; wave = __builtin_amdgcn_readfirstlane(t >> 6);
        size_t z = 0; asm volatile("" : "+s"(z)); ws = p.ws + z;
        int b = blockIdx.x; asm volatile("" : "+s"(b)); bid = b; }
};

constexpr int TPS = 258;
struct TItem { const float* W; bf16_t* WT; int ldw, K, k0, n0, nvalid, gu; };
__device__ __forceinline__ void titem_load(const TItem& t, int wave, int lane, f32x4 (&v)[8]) {
    const int n = t.n0 + 4 * lane;
#pragma unroll
    for (int i = 0; i < 8; ++i) v[i] = n < t.nvalid ? *(const f32x4*)(t.W + (size_t)(t.k0 + 8 * wave + i) * t.ldw + n) : (f32x4){0.f, 0.f, 0.f, 0.f};
}
__device__ __forceinline__ void titem_stage(LAS unsigned char* lds, int wave, int lane, const f32x4 (&v)[8]) {
    LAS bf16_t* T = (LAS bf16_t*)lds;
#pragma unroll
    for (int i = 0; i < 8; ++i) { LAS unsigned* d = (LAS unsigned*)(T + (8 * wave + i) * TPS + 4 * lane); d[0] = pk2(v[i][0], v[i][1]); d[1] = pk2(v[i][2], v[i][3]); }
}
__device__ __forceinline__ void titem_store(const TItem& t, const LAS unsigned char* lds, int tid) {
    const LAS bf16_t* T = (const LAS bf16_t*)lds;
#pragma unroll
    for (int it = 0; it < 4; ++it) { const int q = tid + NTHREADS * it, n = q >> 3, c = q & 7;
        unsigned short e[8];
#pragma unroll
        for (int j = 0; j < 8; ++j) e[j] = T[(8 * c + j) * TPS + n];
        const int sn = t.n0 + n;
        if (sn < t.nvalid) { int dr = sn; if (t.gu) { const int isup = sn >= FF, jj = isup ? sn - FF : sn; dr = (jj >> 7) * 256 + isup * 128 + (jj & 127); }
            u32x4 o; o.x = e[0] | ((unsigned)e[1] << 16); o.y = e[2] | ((unsigned)e[3] << 16); o.z = e[4] | ((unsigned)e[5] << 16); o.w = e[6] | ((unsigned)e[7] << 16);
            *(u32x4*)(t.WT + (size_t)dr * t.K + t.k0 + 8 * c) = o; } }
}
constexpr int TI_IN = 16 * 8, TI_OUT = 16 * 4, TI_GU = 16 * 22, TI_DN = 44 * 4, TI_UQ = 3 * 2, TI_UKV = 2 * 2, TI_L = TI_IN + TI_OUT + TI_GU + TI_DN + TI_UQ + TI_UKV;
__device__ __forceinline__ TItem titem_make(const Ctx& C, int it) {
    const Params& p = C.p; const int l = it / TI_L; int r = it % TI_L; unsigned char* wl = C.wl(l); TItem t; t.gu = 0;
    if (r < TI_IN) { t.W = p.in[I_WIN] + (size_t)l * D * NP; t.WT = (bf16_t*)(wl + WL_IN); t.ldw = NP; t.K = D; t.k0 = (r >> 3) * 64; t.n0 = (r & 7) * 256; t.nvalid = NP; return t; } r -= TI_IN;
    if (r < TI_OUT) { t.W = p.in[I_WOUT] + (size_t)l * D * D; t.WT = (bf16_t*)(wl + WL_OUT); t.ldw = D; t.K = D; t.k0 = (r >> 2) * 64; t.n0 = (r & 3) * 256; t.nvalid = D; return t; } r -= TI_OUT;
    if (r < TI_GU) { t.W = p.in[I_WGU] + (size_t)l * D * 2 * FF; t.WT = (bf16_t*)(wl + WL_GU); t.ldw = 2 * FF; t.K = D; t.k0 = (r / 22) * 64; t.n0 = (r % 22) * 256; t.nvalid = 2 * FF; t.gu = 1; return t; } r -= TI_GU;
    if (r < TI_DN) { t.W = p.in[I_WDN] + (size_t)l * FF * D; t.WT = (bf16_t*)(wl + WL_DN); t.ldw = D; t.K = FF; t.k0 = (r >> 2) * 64; t.n0 = (r & 3) * 256; t.nvalid = D; return t; } r -= TI_DN;
    if (r < TI_UQ) { t.W = p.in[I_WUQ] + (size_t)l * 192 * 384; t.WT = (bf16_t*)(wl + WL_UQ); t.ldw = 384; t.K = 192; t.k0 = (r >> 1) * 64; t.n0 = (r & 1) * 256; t.nvalid = 384; return t; } r -= TI_UQ;
    t.W = p.in[I_WUKV] + (size_t)l * 128 * 512; t.WT = (bf16_t*)(wl + WL_UKV); t.ldw = 512; t.K = 128; t.k0 = (r >> 1) * 64; t.n0 = (r & 1) * 256; t.nvalid = 512; return t;
}

__device__ __forceinline__ void transpose_items(const Ctx& C, int it0, int stride, int end) {
    int it = it0; f32x4 v[8];
    TItem cur; if (it < end) { cur = titem_make(C, it); titem_load(cur, C.wave, C.lane, v); }
    while (it < end) {
        titem_stage(C.lds, C.wave, C.lane, v);
        const int nx = it + stride; TItem nxt = cur; if (nx < end) { nxt = titem_make(C, nx); titem_load(nxt, C.wave, C.lane, v); }
        __syncthreads();
        titem_store(cur, C.lds, C.tid);
        __syncthreads();
        cur = nxt; it = nx;
    }
}

__device__ __forceinline__ void phase_prologue(const Ctx& C) {
    const Params& p = C.p;
    transpose_items(C, C.bid, C.G, (C.G == 256) ? TI_L : 4 * TI_L);
    {
        LAS float* sc = (LAS float*)C.lds;
        LAS float* red = (LAS float*)(C.lds + 5 * 1024 * 4);
        const int ub = C.G - 1 - C.bid;
        if (ub < 96) {
            size_t za = 0, zb = 0; asm volatile("" : "+s"(za), "+s"(zb));
            const float* cctx = p.in[I_CCTX] + za; const float* cc_ = p.in[I_C] + zb;
            for (int i = C.tid; i < 5120; i += NTHREADS) { const int j = i >> 10, k = i & 1023; const float v = (j == 0) ? cctx[k] : cc_[(j - 1) * 1024 + k]; sc[i] = v / (1.f + __expf(-v)); }
            __syncthreads();
            for (int u = ub; u < 96; u += C.G) {
                const int l = u / 24, cb = u % 24;
                const float* w = p.in[I_WADA] + ((size_t)l * 1024 + C.wave * 128) * 6144 + cb * 256 + 4 * C.lane;
                f32x4 a0 = {0.f, 0.f, 0.f, 0.f}, a1 = a0, a2 = a0, a3 = a0, a4 = a0;
#pragma unroll 16
                for (int k = 0; k < 128; ++k) { const f32x4 wv = *(const f32x4*)(w + (size_t)k * 6144); const int kk = C.wave * 128 + k;
                    a0 += wv * sc[kk]; a1 += wv * sc[1024 + kk]; a2 += wv * sc[2048 + kk]; a3 += wv * sc[3072 + kk]; a4 += wv * sc[4096 + kk]; }
                LAS f32x4* rw = (LAS f32x4*)(red + C.wave * 1280) + C.lane;
                rw[0] = a0; rw[64] = a1; rw[128] = a2; rw[192] = a3; rw[256] = a4;
                __syncthreads();
                for (int i = C.tid; i < 1280; i += NTHREADS) { const int j = i >> 8, c2 = i & 255; float sum = p.in[I_BADA][l * 6144 + cb * 256 + c2];
#pragma unroll
                    for (int ww = 0; ww < 8; ++ww) sum += red[ww * 1280 + i];
                    ((float*)(C.ws + WS_MOD))[(size_t)(l * 5 + j) * 6144 + cb * 256 + c2] = sum; }
                __syncthreads();
            }
        }
        __syncthreads();
    }
    {
        const int gt = C.bid * NTHREADS + C.tid, GT = C.G * NTHREADS;
        for (int i = gt; i < 4 * 65536; i += GT) { const int l = i >> 16, e = i & 65535; ((bf16_t*)(C.wl(l) + WL_SP))[e] = (bf16_t)f2bf(p.in[I_SPW][i]); }
        for (int i = gt; i < 4 * 160 * 1024 / 2; i += GT) { const int l = i / (160 * 512), e = i % (160 * 512); ((unsigned*)(C.wl(l) + WL_IN + (size_t)NP * D * 2))[e] = 0u; }
        for (int i = gt; i < 128 * 64; i += GT) { const int m = i >> 6, c = i & 63; const int idx = ((m & 63) * c) & 63; const float a = (float)idx / 32.f;
            ((bf16_t*)(C.ws + WS_F64))[i] = (bf16_t)f2bf(m < 64 ? cospif(a) : sinpif(a)); }
        for (int i = gt; i < 64 * 128; i += GT) { const int k = i >> 7, K = i & 127; const int idx = (k * (K & 63)) & 63; const float a = (float)idx / 32.f; const float cv = cospif(a), sv = sinpif(a);
            ((bf16_t*)(C.ws + WS_T64R))[i] = (bf16_t)f2bf(K < 64 ? cv : -sv);
            ((bf16_t*)(C.ws + WS_T64I))[i] = (bf16_t)f2bf(K < 64 ? -sv : -cv);
            ((bf16_t*)(C.ws + WS_T64B))[i] = (bf16_t)f2bf(K < 64 ? cv : sv); }
        for (int i = gt; i < 256 * 512; i += GT) { const int k = i >> 9, K = i & 511; const int idx = (k * (K & 255)) & 255; const float a = (float)idx / 128.f;
            ((bf16_t*)(C.ws + WS_T256))[i] = (bf16_t)f2bf(K < 256 ? cospif(a) : -sinpif(a)); }
        for (int i = gt; i < 4096; i += GT) { const float a = (float)i / 2048.f; ((f32x2*)(C.ws + WS_TW))[i] = (f32x2){cospif(a), sinpif(a)}; }
        for (int i = gt; i < 512; i += GT) { const int pos = i >> 3, f = i & 7; const float inv = powf(10000.f, -(float)f / 8.f); const float ang = (float)pos * inv;
            ((f32x2*)(C.ws + WS_ROPE))[i] = (f32x2){cosf(ang), sinf(ang)}; }
    }
}

__device__ __forceinline__ void load_row_f32(const float* rowp, int lane, f32x4 (&v)[4]) {
#pragma unroll
    for (int j = 0; j < 4; ++j) v[j] = *(const f32x4*)(rowp + 4 * lane + 256 * j);
}
__device__ __forceinline__ void load_row_bf16(const bf16_t* rowp, int lane, f32x4 (&v)[4]) {
#pragma unroll
    for (int j = 0; j < 4; ++j) { const u32x2 w = *(const u32x2*)(rowp + 4 * lane + 256 * j); v[j] = (f32x4){bflo(w.x), bfhi(w.x), bflo(w.y), bfhi(w.y)}; }
}
__device__ __forceinline__ float row_rstd(const f32x4 (&v)[4]) {
    float s = 0.f;
#pragma unroll
    for (int j = 0; j < 4; ++j) s += (v[j][0] * v[j][0] + v[j][1] * v[j][1]) + (v[j][2] * v[j][2] + v[j][3] * v[j][3]);
    return 1.f / sqrtf(wave_sum(s) * (1.f / 1024.f) + EPS);
}
__device__ __forceinline__ void norm_mod_store(const f32x4 (&x)[4], const float* g, const float* scale, const float* shift, bf16_t* orow, int lane) {
    const float rs = row_rstd(x);
#pragma unroll
    for (int j = 0; j < 4; ++j) { const int c = 4 * lane + 256 * j; const f32x4 gv = *(const f32x4*)(g + c), sv = *(const f32x4*)(scale + c), hv = *(const f32x4*)(shift + c);
        const f32x4 h = x[j] * rs * gv * (1.f + sv) + hv; *(u32x2*)(orow + c) = pk4(h); }
}
__device__ __forceinline__ const float* xin_row(const Ctx& C, int layer, int r) {
    if (layer > 0) return C.p.out + OUT_X + (size_t)r * D;
    size_t za = 0, zb = 0; asm volatile("" : "+s"(za), "+s"(zb));
    const float* a = C.p.in[I_XP] + za; const float* b = C.p.in[I_XS] + zb;
    return r < M_CTX ? a + (size_t)r * D : b + (size_t)(r - M_CTX) * D;
}
constexpr int SPLIT_ROW0 = 16384;
__device__ __forceinline__ void load_T(const bf16_t* T, const bf16_t* T1, bool split, int r, int lane, f32x4 (&v)[4]) {
    load_row_bf16(T + (size_t)r * D, lane, v);
    if (split && r >= SPLIT_ROW0) { f32x4 w[4]; load_row_bf16(T1 + (size_t)r * D, lane, w);
#pragma unroll
        for (int j = 0; j < 4; ++j) v[j] = v[j] + w[j]; }
}
__device__ __forceinline__ void phase_norm0(const Ctx& C) {
    const int gw = C.bid * NWAVES + C.wave, NGW = C.G * NWAVES;
    bf16_t* H = (bf16_t*)(C.ws + WS_R1);
    f32x4 xn[4]; load_row_f32(xin_row(C, 0, gw), C.lane, xn);
    for (int r = gw; r < M; r += NGW) { f32x4 x[4];
#pragma unroll
        for (int j = 0; j < 4; ++j) x[j] = xn[j];
        if (r + NGW < M) load_row_f32(xin_row(C, 0, r + NGW), C.lane, xn);
        const int mi = mod_of_row(r);
        norm_mod_store(x, C.p.in[I_GPM], C.mod(0, mi, 1), C.mod(0, mi, 0), H + (size_t)r * D, C.lane); }
}
template <int which  > __device__ __forceinline__ void phase_post(const Ctx& C, int layer) {
    const int gw = C.bid * NWAVES + C.wave, NGW = C.G * NWAVES;
    const bf16_t* T = (const bf16_t*)(C.ws + (which == 0 ? WS_R2 : WS_MLA));
    const bf16_t* T1 = T + (size_t)M * D - (size_t)SPLIT_ROW0 * D;
    const bool split = (C.G == 256);
    bf16_t* H = (bf16_t*)(C.ws + WS_R1);
    const float* gpost = (which == 0 ? C.p.in[I_GPOM] : C.p.in[I_GPOF]) + layer * D;
    const bool do_next = (which == 0) || (layer + 1 < DEPTH);
    const int nl = which == 0 ? layer : layer + 1;
    const float* gnext = (which == 0 ? C.p.in[I_GPF] : C.p.in[I_GPM]) + (nl < DEPTH ? nl : 0) * D;
    f32x4 tn[4], xn[4];
    load_T(T, T1, split, gw, C.lane, tn); load_row_f32(which == 0 ? xin_row(C, layer, gw) : C.p.out + OUT_X + (size_t)gw * D, C.lane, xn);
    for (int r = gw; r < M; r += NGW) {
        const int mi = mod_of_row(r);
        f32x4 t[4], x[4];
#pragma unroll
        for (int j = 0; j < 4; ++j) { t[j] = tn[j]; x[j] = xn[j]; }
        if (r + NGW < M) { const int rn = r + NGW; load_T(T, T1, split, rn, C.lane, tn); load_row_f32(which == 0 ? xin_row(C, layer, rn) : C.p.out + OUT_X + (size_t)rn * D, C.lane, xn); }
        const float rs = row_rstd(t); const float* gate = C.mod(layer, mi, which == 0 ? 2 : 5);
        float* xo = C.p.out + OUT_X + (size_t)r * D;
#pragma unroll
        for (int j = 0; j < 4; ++j) { const int c = 4 * C.lane + 256 * j; const f32x4 gv = *(const f32x4*)(gpost + c), ga = *(const f32x4*)(gate + c);
            x[j] = x[j] + ga * (t[j] * rs * gv); *(f32x4*)(xo + c) = x[j]; }
        if (do_next) norm_mod_store(x, gnext, C.mod(nl, mi, which == 0 ? 4 : 1), C.mod(nl, mi, which == 0 ? 3 : 0), H + (size_t)r * D, C.lane);
    }
}

__device__ __forceinline__ void unit_chunk_mlp(const Ctx& C, int layer, int u) {
    const int chunk = u >> 2, g = u & 3, r0 = chunk * 128;
    const bf16_t* PROJ = (const bf16_t*)(C.ws + WS_R2); bf16_t* MIX = (bf16_t*)(C.ws + WS_R1);
    constexpr int VS = 136;
    LAS bf16_t* Vt = (LAS bf16_t*)C.lds;
    { const int q = C.tid >> 2, c0 = (C.tid & 3) * 16; const bf16_t* src = PROJ + (size_t)(r0 + q) * NP + PC_V + g * 64 + c0;
      const bf16x8 v0 = *(const bf16x8*)src, v1 = *(const bf16x8*)(src + 8);
#pragma unroll
      for (int j = 0; j < 8; ++j) { Vt[(c0 + j) * VS + q] = (bf16_t)v0[j]; Vt[(c0 + 8 + j) * VS + q] = (bf16_t)v1[j]; } }
    __syncthreads();
    const int l15 = C.lane & 15, hq = C.lane >> 4, w = C.wave;
    const bf16_t* Wg = (const bf16_t*)(C.wl(layer) + WL_SP) + (size_t)g * 128 * 128;
    bf16x8 bw[4];
#pragma unroll
    for (int ks = 0; ks < 4; ++ks) bw[ks] = *(const bf16x8*)(Wg + (size_t)(w * 16 + l15) * 128 + ks * 32 + 8 * hq);
    const int p = w * 16 + l15; const float bias = C.p.in[I_SPB][(layer * 4 + g) * 128 + p];
#pragma unroll
    for (int ct = 0; ct < 4; ++ct) {
        f32x4 acc = {0.f, 0.f, 0.f, 0.f};
#pragma unroll
        for (int ks = 0; ks < 4; ++ks) { const bf16x8 a = *(const LAS bf16x8*)(Vt + (ct * 16 + l15) * VS + ks * 32 + 8 * hq); acc = mma16(a, bw[ks], acc); }
        const int cc = g * 64 + ct * 16 + 4 * hq; const u32x2 uw = *(const u32x2*)(PROJ + (size_t)(r0 + p) * NP + PC_U + cc);
        f32x4 o; o[0] = bflo(uw.x) * (acc[0] + bias); o[1] = bfhi(uw.x) * (acc[1] + bias); o[2] = bflo(uw.y) * (acc[2] + bias); o[3] = bfhi(uw.y) * (acc[3] + bias);
        *(u32x2*)(MIX + (size_t)(r0 + p) * D + cc) = pk4(o);
    }
    __syncthreads();
}
__device__ __forceinline__ void unit_conv(const Ctx& C, int layer, int u) {
    const bf16_t* PROJ = (const bf16_t*)(C.ws + WS_R2); bf16_t* MIX = (bf16_t*)(C.ws + WS_R1);
    const float* cw = C.p.in[I_CVW] + layer * 3 * 256; const float* cb = C.p.in[I_CVB] + layer * 256;
    for (int it = 0; it < 8; ++it) {
        const int item = it * NTHREADS + C.tid, t = item >> 5, ch = (item & 31) * 8, r = u * 128 + t;
        const int pos = r < M_CTX ? (r & 255) : ((r - M_CTX) & 4095), len = r < M_CTX ? 256 : 4096;
        const bf16_t* base = PROJ + (size_t)r * NP;
        const bf16x8 h1 = *(const bf16x8*)(base + PC_H + ch), c1 = *(const bf16x8*)(base + PC_C + ch), gb = *(const bf16x8*)(base + PC_B + ch);
        bf16x8 h0 = h1, c0 = c1, h2 = h1, c2 = c1; const bool hasp = pos > 0, hasn = pos < len - 1;
        if (hasp) { h0 = *(const bf16x8*)(base - NP + PC_H + ch); c0 = *(const bf16x8*)(base - NP + PC_C + ch); }
        if (hasn) { h2 = *(const bf16x8*)(base + NP + PC_H + ch); c2 = *(const bf16x8*)(base + NP + PC_C + ch); }
        float o[8];
#pragma unroll
        for (int j = 0; j < 8; ++j) {
            const float z0 = hasp ? bf1((bf16_t)h0[j]) * bf1((bf16_t)c0[j]) : 0.f, z1 = bf1((bf16_t)h1[j]) * bf1((bf16_t)c1[j]), z2 = hasn ? bf1((bf16_t)h2[j]) * bf1((bf16_t)c2[j]) : 0.f;
            const float y = z0 * cw[ch + j] + z1 * cw[256 + ch + j] + z2 * cw[512 + ch + j] + cb[ch + j];
            o[j] = bf1((bf16_t)gb[j]) * y; }
        u32x4 w; w.x = pk2(o[0], o[1]); w.y = pk2(o[2], o[3]); w.z = pk2(o[4], o[5]); w.w = pk2(o[6], o[7]);
        *(u32x4*)(MIX + (size_t)r * D + 256 + ch) = w;
    }
}
__device__ __forceinline__ void unit_fourier_ctx(const Ctx& C, int u) {
    const int s = u >> 2, g = u & 3, l15 = C.lane & 15, hq = C.lane >> 4, w = C.wave;
    const bf16_t* PROJ = (const bf16_t*)(C.ws + WS_R2); bf16_t* MIX = (bf16_t*)(C.ws + WS_R1);
    const bf16_t* F64 = (const bf16_t*)(C.ws + WS_F64); const bf16_t* T256 = (const bf16_t*)(C.ws + WS_T256);
    constexpr int ZS = 520; LAS bf16_t* Zt = (LAS bf16_t*)C.lds;
#pragma unroll
    for (int i = 0; i < 2; ++i) { const int nt = 2 * w + i;
        bf16x8 a[2];
#pragma unroll
        for (int ks = 0; ks < 2; ++ks) a[ks] = *(const bf16x8*)(PROJ + (size_t)(s * 256 + nt * 16 + l15) * NP + PC_F + g * 64 + ks * 32 + 8 * hq);
#pragma unroll
        for (int mt = 0; mt < 8; ++mt) { f32x4 acc = {0.f, 0.f, 0.f, 0.f};
#pragma unroll
            for (int ks = 0; ks < 2; ++ks) { const bf16x8 b = *(const bf16x8*)(F64 + (size_t)(mt * 16 + l15) * 64 + ks * 32 + 8 * hq); acc = mma16(a[ks], b, acc); }
            const int mp = mt * 16 + l15;
            *(LAS u32x2*)(Zt + (mp & 63) * ZS + (mp >> 6) * 256 + nt * 16 + 4 * hq) = pk4(acc); } }
    __syncthreads();
#pragma unroll 1
    for (int i = 0; i < 2; ++i) { const int kt = 2 * w + i;
        f32x4 acc[4];
#pragma unroll
        for (int mt = 0; mt < 4; ++mt) acc[mt] = (f32x4){0.f, 0.f, 0.f, 0.f};
#pragma unroll 8
        for (int ks = 0; ks < 16; ++ks) { const bf16x8 b = *(const bf16x8*)(T256 + (size_t)(kt * 16 + l15) * 512 + ks * 32 + 8 * hq);
#pragma unroll
            for (int mt = 0; mt < 4; ++mt) { const bf16x8 a = *(const LAS bf16x8*)(Zt + (mt * 16 + l15) * ZS + ks * 32 + 8 * hq); acc[mt] = mma16(a, b, acc[mt]); } }
#pragma unroll
        for (int mt = 0; mt < 4; ++mt) *(u32x2*)(MIX + (size_t)(s * 256 + kt * 16 + l15) * D + 512 + g * 64 + mt * 16 + 4 * hq) = pk4(acc[mt] * (1.f / 128.f)); }
    __syncthreads();
}
__device__ __forceinline__ void unit_fourier_lat1(const Ctx& C, int u) {
    const int b = u >> 5, g = (u >> 3) & 3, nb = u & 7, l15 = C.lane & 15, hq = C.lane >> 4, n2 = nb * 8 + C.wave;
    const bf16_t* PROJ = (const bf16_t*)(C.ws + WS_R2);
    const bf16_t* F64 = (const bf16_t*)(C.ws + WS_F64); const bf16_t* T64R = (const bf16_t*)(C.ws + WS_T64R); const bf16_t* T64I = (const bf16_t*)(C.ws + WS_T64I);
    const f32x2* TW = (const f32x2*)(C.ws + WS_TW);
    bf16_t* GB = (bf16_t*)(C.ws + WS_GB) + (size_t)((b * 4 + g) * 64 + n2) * 64 * 128;
    constexpr int ZS = 136; LAS bf16_t* Zt = (LAS bf16_t*)(C.lds + C.wave * (64 * ZS * 2));
#pragma unroll 2
    for (int nt = 0; nt < 4; ++nt) {
        bf16x8 a[2];
#pragma unroll
        for (int ks = 0; ks < 2; ++ks) a[ks] = *(const bf16x8*)(PROJ + (size_t)(M_CTX + b * 4096 + (nt * 16 + l15) * 64 + n2) * NP + PC_F + g * 64 + ks * 32 + 8 * hq);
#pragma unroll
        for (int mt = 0; mt < 8; ++mt) { f32x4 acc = {0.f, 0.f, 0.f, 0.f};
#pragma unroll
            for (int ks = 0; ks < 2; ++ks) { const bf16x8 bb = *(const bf16x8*)(F64 + (size_t)(mt * 16 + l15) * 64 + ks * 32 + 8 * hq); acc = mma16(a[ks], bb, acc); }
            const int mp = mt * 16 + l15;
            *(LAS u32x2*)(Zt + (mp & 63) * ZS + (mp >> 6) * 64 + nt * 16 + 4 * hq) = pk4(acc); } }
    asm volatile("s_waitcnt lgkmcnt(0)" ::: "memory");
#pragma unroll 2
    for (int kt = 0; kt < 4; ++kt) {
        bf16x8 br[4], bi[4];
#pragma unroll
        for (int ks = 0; ks < 4; ++ks) { br[ks] = *(const bf16x8*)(T64R + (size_t)(kt * 16 + l15) * 128 + ks * 32 + 8 * hq); bi[ks] = *(const bf16x8*)(T64I + (size_t)(kt * 16 + l15) * 128 + ks * 32 + 8 * hq); }
        const int k1 = kt * 16 + l15; const f32x2 tw = TW[k1 * n2];
#pragma unroll
        for (int mt = 0; mt < 4; ++mt) { f32x4 ar = {0.f, 0.f, 0.f, 0.f}, ai = {0.f, 0.f, 0.f, 0.f};
#pragma unroll
            for (int ks = 0; ks < 4; ++ks) { const bf16x8 a = *(const LAS bf16x8*)(Zt + (mt * 16 + l15) * ZS + ks * 32 + 8 * hq); ar = mma16(a, br[ks], ar); ai = mma16(a, bi[ks], ai); }
            const f32x4 gr = ar * tw[0] + ai * tw[1], gi = ai * tw[0] - ar * tw[1];
            bf16_t* dst = GB + (size_t)k1 * 128 + mt * 16 + 4 * hq;
            *(u32x2*)dst = pk4(gr); *(u32x2*)(dst + 64) = pk4(gi); } }
    __syncthreads();
}
__device__ __forceinline__ void unit_fourier_lat2(const Ctx& C, int u) {
    const int b = u >> 5, g = (u >> 3) & 3, kb = u & 7, l15 = C.lane & 15, hq = C.lane >> 4, k1 = kb * 8 + C.wave;
    const bf16_t* T64B = (const bf16_t*)(C.ws + WS_T64B); bf16_t* MIX = (bf16_t*)(C.ws + WS_R1);
    const bf16_t* GB = (const bf16_t*)(C.ws + WS_GB) + (size_t)((b * 4 + g) * 64) * 64 * 128 + (size_t)k1 * 128;
    constexpr int ZS = 136; LAS bf16_t* Tt = (LAS bf16_t*)(C.lds + C.wave * (64 * ZS * 2));
#pragma unroll 4
    for (int it = 0; it < 16; ++it) { const int q = it * 64 + C.lane, n2 = q >> 4, cc = q & 15, part = cc >> 3, m0 = (cc & 7) * 8;
        const bf16x8 v = *(const bf16x8*)(GB + (size_t)n2 * 64 * 128 + cc * 8);
#pragma unroll
        for (int j = 0; j < 8; ++j) Tt[(m0 + j) * ZS + part * 64 + n2] = (bf16_t)v[j]; }
    asm volatile("s_waitcnt lgkmcnt(0)" ::: "memory");
#pragma unroll 2
    for (int kt = 0; kt < 4; ++kt) {
        bf16x8 bb[4];
#pragma unroll
        for (int ks = 0; ks < 4; ++ks) bb[ks] = *(const bf16x8*)(T64B + (size_t)(kt * 16 + l15) * 128 + ks * 32 + 8 * hq);
        const int k2 = kt * 16 + l15; const int row = M_CTX + b * 4096 + k1 + 64 * k2;
#pragma unroll
        for (int mt = 0; mt < 4; ++mt) { f32x4 acc = {0.f, 0.f, 0.f, 0.f};
#pragma unroll
            for (int ks = 0; ks < 4; ++ks) { const bf16x8 a = *(const LAS bf16x8*)(Tt + (mt * 16 + l15) * ZS + ks * 32 + 8 * hq); acc = mma16(a, bb[ks], acc); }
            *(u32x2*)(MIX + (size_t)row * D + 512 + g * 64 + mt * 16 + 4 * hq) = pk4(acc * (1.f / 512.f)); } }
    __syncthreads();
}
constexpr float QSCALE = 0.10206207261596577f * 1.4426950408889634f;
__device__ __forceinline__ void unit_mla_prep(const Ctx& C, int layer, int u) {
    const Params& p = C.p;
    const bf16_t* PROJ = (const bf16_t*)(C.ws + WS_R2);
    bf16_t* Q = (bf16_t*)(C.ws + WS_Q); bf16_t* KN = (bf16_t*)(C.ws + WS_KN); bf16_t* VT = (bf16_t*)(C.ws + WS_VT); bf16_t* KR = (bf16_t*)(C.ws + WS_KR);
    const f32x2* ROPE = (const f32x2*)(C.ws + WS_ROPE);
    constexpr int QS = 200, KS = 136;
    LAS bf16_t* CQ = (LAS bf16_t*)C.lds;
    LAS bf16_t* CK = (LAS bf16_t*)(C.lds + 128 * QS * 2);
    const bool is_tok = u < 192;
    int r0 = 0, keyrow0, keypos0, nk; size_t vtbase; bool lat;
    if (is_tok) { r0 = u * 128; lat = r0 >= M_CTX;
        if (!lat) { keyrow0 = r0; keypos0 = r0 & 255; nk = 256; vtbase = (size_t)(r0 & ~255) * 256; }
        else { const int b = (r0 - M_CTX) >> 12, n = (r0 - M_CTX) & 4095; keyrow0 = M_CTX + b * 4352 + n; keypos0 = n; nk = 4352; vtbase = (size_t)(M_CTX + b * 4352) * 256; } }
    else { const int cu = u - 192, b = cu >> 1, half = cu & 1; lat = true; keyrow0 = M_CTX + b * 4352 + 4096 + half * 128; keypos0 = 4096 + half * 128; nk = 4352; vtbase = (size_t)(M_CTX + b * 4352) * 256; }
    { const int t = C.tid >> 2, sub = C.tid & 3;
      if (is_tok) {
        const int r = r0 + t; const bf16_t* base = PROJ + (size_t)r * NP;
        float q[48], k[32]; float sq = 0.f, sk = 0.f;
#pragma unroll
        for (int i = 0; i < 6; ++i) { const bf16x8 v = *(const bf16x8*)(base + PC_Q + sub * 48 + i * 8);
#pragma unroll
            for (int j = 0; j < 8; ++j) { q[i * 8 + j] = bf1((bf16_t)v[j]); sq += q[i * 8 + j] * q[i * 8 + j]; } }
#pragma unroll
        for (int i = 0; i < 4; ++i) { const bf16x8 v = *(const bf16x8*)(base + PC_KV + sub * 32 + i * 8);
#pragma unroll
            for (int j = 0; j < 8; ++j) { k[i * 8 + j] = bf1((bf16_t)v[j]); sk += k[i * 8 + j] * k[i * 8 + j]; } }
        sq += __shfl_xor(sq, 1); sq += __shfl_xor(sq, 2); sk += __shfl_xor(sk, 1); sk += __shfl_xor(sk, 2);
        const float rq = 1.f / sqrtf(sq * (1.f / 192.f) + EPS), rk = 1.f / sqrtf(sk * (1.f / 128.f) + EPS);
        const float* gq = p.in[I_GQ] + layer * 192 + sub * 48; const float* gk = p.in[I_GKV] + layer * 128 + sub * 32;
#pragma unroll
        for (int i = 0; i < 6; ++i) { u32x4 w; w.x = pk2(q[i * 8 + 0] * rq * gq[i * 8 + 0], q[i * 8 + 1] * rq * gq[i * 8 + 1]); w.y = pk2(q[i * 8 + 2] * rq * gq[i * 8 + 2], q[i * 8 + 3] * rq * gq[i * 8 + 3]);
            w.z = pk2(q[i * 8 + 4] * rq * gq[i * 8 + 4], q[i * 8 + 5] * rq * gq[i * 8 + 5]); w.w = pk2(q[i * 8 + 6] * rq * gq[i * 8 + 6], q[i * 8 + 7] * rq * gq[i * 8 + 7]);
            *(LAS u32x4*)(CQ + t * QS + sub * 48 + i * 8) = w; }
        float* sckv = nullptr;
        if (!lat) { const int s = r >> 8, pos = r & 255; sckv = p.out + OUT_CKV + ((size_t)(s * 4 + layer) * 256 + pos) * 128 + sub * 32; }
#pragma unroll
        for (int i = 0; i < 4; ++i) { float o[8];
#pragma unroll
            for (int j = 0; j < 8; ++j) o[j] = k[i * 8 + j] * rk * gk[i * 8 + j];
            u32x4 w; w.x = pk2(o[0], o[1]); w.y = pk2(o[2], o[3]); w.z = pk2(o[4], o[5]); w.w = pk2(o[6], o[7]);
            *(LAS u32x4*)(CK + t * KS + sub * 32 + i * 8) = w;
            if (!lat) { *(f32x4*)(sckv + i * 8) = (f32x4){o[0], o[1], o[2], o[3]}; *(f32x4*)(sckv + i * 8 + 4) = (f32x4){o[4], o[5], o[6], o[7]}; } }
        { const bf16x8 v = *(const bf16x8*)(base + PC_KR + sub * 8); float x[8], o[8];
#pragma unroll
          for (int j = 0; j < 8; ++j) x[j] = bf1((bf16_t)v[j]);
          if (lat) { const int n = (r - M_CTX) & 4095; const int pos = (sub >> 1) == 0 ? (n >> 6) : (n & 63);
#pragma unroll
              for (int j = 0; j < 8; ++j) { const float pr = __shfl_xor(x[j], 1); const f32x2 cs = ROPE[pos * 8 + j]; o[j] = (sub & 1) == 0 ? x[j] * cs[0] - pr * cs[1] : x[j] * cs[0] + pr * cs[1]; } }
          else {
#pragma unroll
              for (int j = 0; j < 8; ++j) o[j] = x[j];
              const int s = r >> 8, pos = r & 255; float* skr = p.out + OUT_KR + ((size_t)(s * 4 + layer) * 256 + pos) * 32 + sub * 8;
              *(f32x4*)skr = (f32x4){o[0], o[1], o[2], o[3]}; *(f32x4*)(skr + 4) = (f32x4){o[4], o[5], o[6], o[7]}; }
          u32x4 w; w.x = pk2(o[0], o[1]); w.y = pk2(o[2], o[3]); w.z = pk2(o[4], o[5]); w.w = pk2(o[6], o[7]);
          *(u32x4*)(KR + (size_t)(keyrow0 + t) * 32 + sub * 8) = w; }
      } else {
        const int cu = u - 192, b = cu >> 1, half = cu & 1, row = half * 128 + t;
        const float* src = p.in[I_CCKV] + ((size_t)(b * 4 + layer) * 256 + row) * 128 + sub * 32;
#pragma unroll
        for (int i = 0; i < 4; ++i) { const f32x4 v0 = *(const f32x4*)(src + i * 8), v1 = *(const f32x4*)(src + i * 8 + 4);
            u32x4 w; w.x = pk2(v0[0], v0[1]); w.y = pk2(v0[2], v0[3]); w.z = pk2(v1[0], v1[1]); w.w = pk2(v1[2], v1[3]);
            *(LAS u32x4*)(CK + t * KS + sub * 32 + i * 8) = w; }
        const float* ksrc = p.in[I_CKR] + ((size_t)(b * 4 + layer) * 256 + row) * 32 + sub * 8;
        const f32x4 v0 = *(const f32x4*)ksrc, v1 = *(const f32x4*)(ksrc + 4);
        u32x4 w; w.x = pk2(v0[0], v0[1]); w.y = pk2(v0[2], v0[3]); w.z = pk2(v1[0], v1[1]); w.w = pk2(v1[2], v1[3]);
        *(u32x4*)(KR + (size_t)(keyrow0 + t) * 32 + sub * 8) = w;
      } }
    __syncthreads();
    const int l15 = C.lane & 15, hq = C.lane >> 4, w = C.wave;
    if (is_tok) {
        const bf16_t* Wq = (const bf16_t*)(C.wl(layer) + WL_UQ);
        bf16x8 aq[3][6];
#pragma unroll
        for (int j = 0; j < 3; ++j)
#pragma unroll
            for (int ks = 0; ks < 6; ++ks) aq[j][ks] = *(const bf16x8*)(Wq + (size_t)((3 * w + j) * 16 + l15) * 192 + ks * 32 + 8 * hq);
#pragma unroll 2
        for (int tt = 0; tt < 8; ++tt) {
            bf16x8 bq[6];
#pragma unroll
            for (int ks = 0; ks < 6; ++ks) bq[ks] = *(const LAS bf16x8*)(CQ + (tt * 16 + l15) * QS + ks * 32 + 8 * hq);
            const int r = r0 + tt * 16 + l15; const int n = (r - M_CTX) & 4095;
#pragma unroll
            for (int j = 0; j < 3; ++j) { const int nt = 3 * w + j; f32x4 acc = {0.f, 0.f, 0.f, 0.f};
#pragma unroll
                for (int ks = 0; ks < 6; ++ks) acc = mma16(aq[j][ks], bq[ks], acc);
                const int sub6 = nt % 6;
                if (lat && sub6 >= 4) { const int pos = sub6 == 4 ? (n >> 6) : (n & 63);
#pragma unroll
                    for (int jj = 0; jj < 4; ++jj) { const float pr = __shfl_xor(acc[jj], 32); const f32x2 cs = ROPE[pos * 8 + ((4 * hq + jj) & 7)]; acc[jj] = hq < 2 ? acc[jj] * cs[0] - pr * cs[1] : acc[jj] * cs[0] + pr * cs[1]; } }
                *(u32x2*)(Q + (size_t)r * 384 + nt * 16 + 4 * hq) = pk4(acc * QSCALE); }
        }
    }
    { const bf16_t* Wkv = (const bf16_t*)(C.wl(layer) + WL_UKV);
      bf16x8 wf[4][4];
#pragma unroll
      for (int j = 0; j < 4; ++j)
#pragma unroll
          for (int ks = 0; ks < 4; ++ks) wf[j][ks] = *(const bf16x8*)(Wkv + (size_t)((4 * w + j) * 16 + l15) * 128 + ks * 32 + 8 * hq);
      const int h = w >> 1; const bool isv = (w & 1) != 0;
#pragma unroll 2
      for (int tt = 0; tt < 8; ++tt) {
          bf16x8 ck[4];
#pragma unroll
          for (int ks = 0; ks < 4; ++ks) ck[ks] = *(const LAS bf16x8*)(CK + (tt * 16 + l15) * KS + ks * 32 + 8 * hq);
#pragma unroll
          for (int j = 0; j < 4; ++j) { f32x4 acc = {0.f, 0.f, 0.f, 0.f};
              if (!isv) {
#pragma unroll
                  for (int ks = 0; ks < 4; ++ks) acc = mma16(wf[j][ks], ck[ks], acc);
                  *(u32x2*)(KN + (size_t)(keyrow0 + tt * 16 + l15) * 256 + h * 64 + j * 16 + 4 * hq) = pk4(acc);
              } else {
#pragma unroll
                  for (int ks = 0; ks < 4; ++ks) acc = mma16(ck[ks], wf[j][ks], acc);
                  *(u32x2*)(VT + vtbase + (size_t)(h * 64 + j * 16 + l15) * nk + keypos0 + tt * 16 + 4 * hq) = pk4(acc);
              } } } }
    __syncthreads();
}

constexpr int AKS = 104, AVS = 72;
constexpr int ABUF = 64 * AKS * 2 + 64 * AVS * 2;
__device__ __forceinline__ void unit_attention(const Ctx& C, int u) {
    int rowbase, keyrow0, nk, h; size_t vtbase;
    if (u < 128) { const int s = u >> 2; h = u & 3; rowbase = s * 256; keyrow0 = s * 256; nk = 256; vtbase = (size_t)(s * 256) * 256; }
    else { const int v0 = u - 128; const int v = (C.G == 256) ? (((v0 & 7) * 2 + (v0 >> 7)) << 4) | ((v0 >> 3) & 15) : v0;
           const int b = v >> 6, qb = v & 15; h = (v >> 4) & 3; rowbase = M_CTX + b * 4096 + qb * 256; keyrow0 = M_CTX + b * 4352; nk = 4352; vtbase = (size_t)keyrow0 * 256; }
    const bf16_t* Q = (const bf16_t*)(C.ws + WS_Q); const bf16_t* KN = (const bf16_t*)(C.ws + WS_KN); const bf16_t* VT = (const bf16_t*)(C.ws + WS_VT); const bf16_t* KR = (const bf16_t*)(C.ws + WS_KR);
    bf16_t* MIX = (bf16_t*)(C.ws + WS_R1);
    const int l31 = C.lane & 31, hh = C.lane >> 5; const int qrow = rowbase + C.wave * 32 + l31;
    bf16x8 qf[6];
#pragma unroll
    for (int ks = 0; ks < 6; ++ks) qf[ks] = *(const bf16x8*)(Q + (size_t)qrow * 384 + h * 96 + ks * 16 + 8 * hh);
    f32x16 o0, o1;
#pragma unroll
    for (int i = 0; i < 16; ++i) { o0[i] = 0.f; o1[i] = 0.f; }
    float mrun = -1e30f, lsum = 0.f;
    const int skey = C.tid >> 3, sc8 = (C.tid & 7) * 8, rkey = (C.tid & 255) >> 2, rc8 = (C.tid & 3) * 8;
    const bf16_t* gkn = KN + (size_t)(keyrow0 + skey) * 256 + h * 64 + sc8;
    const bf16_t* gkr = KR + (size_t)(keyrow0 + rkey) * 32 + rc8;
    const bf16_t* gvt = VT + vtbase + (size_t)(h * 64 + skey) * nk + sc8;
    const bool do_r = C.tid < 256;
    const int lkn = (skey * AKS + sc8) * 2, lkr = (rkey * AKS + 64 + rc8) * 2, lvt = 64 * AKS * 2 + (skey * AVS + sc8) * 2;
    const int ntile = nk >> 6;
    u32x4 rk = *(const u32x4*)gkn, rr = do_r ? *(const u32x4*)gkr : (u32x4){0u, 0u, 0u, 0u}, rv = *(const u32x4*)gvt;
    *(LAS u32x4*)(C.lds + lkn) = rk; if (do_r) *(LAS u32x4*)(C.lds + lkr) = rr; *(LAS u32x4*)(C.lds + lvt) = rv;
    __syncthreads();
#pragma unroll 1
    for (int kt = 0; kt < ntile; ++kt) {
        const bool more = kt + 1 < ntile;
        if (more) { rk = *(const u32x4*)(gkn + (size_t)(kt + 1) * 64 * 256); if (do_r) rr = *(const u32x4*)(gkr + (size_t)(kt + 1) * 64 * 32); rv = *(const u32x4*)(gvt + (kt + 1) * 64); }
        LAS unsigned char* B = C.lds + (kt & 1) * ABUF;
        const LAS bf16_t* Kl = (const LAS bf16_t*)B; const LAS bf16_t* Vl = (const LAS bf16_t*)(B + 64 * AKS * 2);
        bf16x8 ka[2][6];
#pragma unroll
        for (int ks = 0; ks < 6; ++ks) { ka[0][ks] = *(const LAS bf16x8*)(Kl + l31 * AKS + ks * 16 + 8 * hh); ka[1][ks] = *(const LAS bf16x8*)(Kl + (32 + l31) * AKS + ks * 16 + 8 * hh); }
        __builtin_amdgcn_sched_barrier(0);
        f32x16 s0, s1;
#pragma unroll
        for (int i = 0; i < 16; ++i) { s0[i] = 0.f; s1[i] = 0.f; }
#pragma unroll
        for (int ks = 0; ks < 6; ++ks) { s0 = mma32(ka[0][ks], qf[ks], s0); s1 = mma32(ka[1][ks], qf[ks], s1); }
        __builtin_amdgcn_sched_barrier(0);
        u32x2 vr[2][2][4];
#pragma unroll
        for (int t = 0; t < 2; ++t)
#pragma unroll
            for (int ss = 0; ss < 2; ++ss) { const int ko = 32 * t + 16 * ss + 4 * hh;
                vr[t][ss][0] = *(const LAS u32x2*)(Vl + l31 * AVS + ko); vr[t][ss][1] = *(const LAS u32x2*)(Vl + l31 * AVS + ko + 8);
                vr[t][ss][2] = *(const LAS u32x2*)(Vl + (32 + l31) * AVS + ko); vr[t][ss][3] = *(const LAS u32x2*)(Vl + (32 + l31) * AVS + ko + 8); }
        __builtin_amdgcn_sched_barrier(0);
        float mx = fmaxf(s0[0], s1[0]);
#pragma unroll
        for (int i = 1; i < 16; ++i) mx = fmaxf(mx, fmaxf(s0[i], s1[i]));
        mx = fmaxf(mx, __shfl_xor(mx, 32));
        if (__builtin_amdgcn_ballot_w64(mx > mrun + 8.f) != 0ull) { const float mnew = fmaxf(mrun, mx); const float alpha = __builtin_amdgcn_exp2f(mrun - mnew); lsum *= alpha; o0 = o0 * alpha; o1 = o1 * alpha; mrun = mnew; }
        float ps = 0.f;
#pragma unroll
        for (int i = 0; i < 16; ++i) { s0[i] = __builtin_amdgcn_exp2f(s0[i] - mrun); s1[i] = __builtin_amdgcn_exp2f(s1[i] - mrun); ps += s0[i] + s1[i]; }
        lsum += ps;
#pragma unroll
        for (int t = 0; t < 2; ++t)
#pragma unroll
            for (int ss = 0; ss < 2; ++ss) {
                u32x4 w;
                if (t == 0) { w.x = pk2(s0[8 * ss + 0], s0[8 * ss + 1]); w.y = pk2(s0[8 * ss + 2], s0[8 * ss + 3]); w.z = pk2(s0[8 * ss + 4], s0[8 * ss + 5]); w.w = pk2(s0[8 * ss + 6], s0[8 * ss + 7]); }
                else { w.x = pk2(s1[8 * ss + 0], s1[8 * ss + 1]); w.y = pk2(s1[8 * ss + 2], s1[8 * ss + 3]); w.z = pk2(s1[8 * ss + 4], s1[8 * ss + 5]); w.w = pk2(s1[8 * ss + 6], s1[8 * ss + 7]); }
                const bf16x8 pf = __builtin_bit_cast(bf16x8, w);
                const bf16x8 va = __builtin_bit_cast(bf16x8, (u32x4){vr[t][ss][0].x, vr[t][ss][0].y, vr[t][ss][1].x, vr[t][ss][1].y}), vb = __builtin_bit_cast(bf16x8, (u32x4){vr[t][ss][2].x, vr[t][ss][2].y, vr[t][ss][3].x, vr[t][ss][3].y});
                o0 = mma32(va, pf, o0); o1 = mma32(vb, pf, o1);
            }
        if (more) { LAS unsigned char* Bn = C.lds + ((kt + 1) & 1) * ABUF; *(LAS u32x4*)(Bn + lkn) = rk; if (do_r) *(LAS u32x4*)(Bn + lkr) = rr; *(LAS u32x4*)(Bn + lvt) = rv; }
        __syncthreads();
    }
    lsum += __shfl_xor(lsum, 32);
    const float inv = 1.f / lsum;
    bf16_t* orow = MIX + (size_t)qrow * D + 768 + h * 64;
#pragma unroll
    for (int i = 0; i < 4; ++i) { const int dv = 8 * i + 4 * hh;
        *(u32x2*)(orow + dv) = pk4((f32x4){o0[4 * i] * inv, o0[4 * i + 1] * inv, o0[4 * i + 2] * inv, o0[4 * i + 3] * inv});
        *(u32x2*)(orow + 32 + dv) = pk4((f32x4){o1[4 * i] * inv, o1[4 * i + 1] * inv, o1[4 * i + 2] * inv, o1[4 * i + 3] * inv}); }
}

#define XB_TMO      128
#define XB_XCNT(j)  (256  + 64 * (j))
#define XB_XSUB(j)  (1280 + 64 * (j))
#define XB_XGEN(j)  (2304 + 64 * (j))
#define XB_TOP      3328
#define XB_TOPGEN   3392
#define XCD_BAR_WORDS 3456
#define XB_SPIN_CAP (1u << 18)

__device__ __forceinline__ unsigned xb_ld(unsigned* p)              { return __hip_atomic_load(p, __ATOMIC_RELAXED, __HIP_MEMORY_SCOPE_AGENT); }
__device__ __forceinline__ unsigned xb_add(unsigned* p, unsigned v) { return __hip_atomic_fetch_add(p, v, __ATOMIC_RELAXED, __HIP_MEMORY_SCOPE_AGENT); }
__device__ __forceinline__ unsigned xb_xcc_id() { return (unsigned)__builtin_amdgcn_s_getreg((3 << 11) | 20) & 0xFu; }
#define XB_SPIN(cond, bar) do { unsigned _sp = 0; while (cond) { __builtin_amdgcn_s_sleep(1); \
    if ((++_sp & 255u) == 0u) { if (xb_ld(&(bar)[XB_TMO])) break; if (_sp > XB_SPIN_CAP) { atomicAdd(&(bar)[XB_TMO], 1u); break; } } } } while (0)

struct XcdBarrier {
    unsigned* bar; unsigned x;
    volatile LAS unsigned* st;
};

__device__ __forceinline__ XcdBarrier xcd_barrier_post(unsigned* bar, volatile LAS unsigned* st) {
    XcdBarrier b; b.bar = bar; b.x = xb_xcc_id(); b.st = st;
    if (threadIdx.x == 0) (void)xb_add(&bar[XB_XCNT(b.x)], 1u);
    return b;
}
__device__ __forceinline__ void xcd_barrier_complete(unsigned* bar, unsigned x, unsigned& nloc, unsigned& nx) {
    const unsigned G = gridDim.x * gridDim.y * gridDim.z;
    unsigned sum, cnt, mine, sp = 0u;
    for (;;) {
        sum = 0u; cnt = 0u; mine = 0u;
#pragma unroll
        for (unsigned j = 0; j < 16; ++j) { const unsigned c = xb_ld(&bar[XB_XCNT(j)]); sum += c; cnt += (c > 0u) ? 1u : 0u; mine = (j == x) ? c : mine; }
        if (sum == G) break;
        __builtin_amdgcn_s_sleep(1);
        if ((++sp & 255u) == 0u) { if (xb_ld(&bar[XB_TMO])) break; if (sp > XB_SPIN_CAP) { atomicAdd(&bar[XB_TMO], 1u); break; } }
    }
    nloc = mine > 0u ? mine : 1u; nx = cnt > 0u ? cnt : 1u;
}

__device__ __forceinline__ void xcd_barrier(const XcdBarrier& b) {
    asm volatile("s_waitcnt vmcnt(0)" ::: "memory");
    __syncthreads();
    if (threadIdx.x == 0) {
        unsigned* bar = b.bar;
        __builtin_amdgcn_s_waitcnt(0);
        unsigned nloc = b.st[0], nx = b.st[1];
        if (nloc == 0u) { xcd_barrier_complete(bar, b.x, nloc, nx); b.st[0] = nloc; b.st[1] = nx; }
        const unsigned old = xb_add(&bar[XB_XSUB(b.x)], 1u);
        const unsigned gen = old / nloc;
        if (old + 1u == (gen + 1u) * nloc) {
            __builtin_amdgcn_fence(__ATOMIC_RELEASE, "agent");
            asm volatile("s_waitcnt vmcnt(0)" ::: "memory");
            const unsigned og = xb_add(&bar[XB_TOP], 1u);
            const unsigned tg = og / nx;
            if (og + 1u == (tg + 1u) * nx) xb_add(&bar[XB_TOPGEN], 1u);
            else XB_SPIN(xb_ld(&bar[XB_TOPGEN]) == tg, bar);
            __builtin_amdgcn_fence(__ATOMIC_ACQUIRE, "agent");
            xb_add(&bar[XB_XGEN(b.x)], 1u);
            asm volatile("s_waitcnt vmcnt(0)" ::: "memory");
        } else {
            XB_SPIN(xb_ld(&bar[XB_XGEN(b.x)]) == gen, bar);
            __builtin_amdgcn_fence(__ATOMIC_ACQUIRE, "agent");
            asm volatile("s_waitcnt vmcnt(0)" ::: "memory");
        }
    }
    __syncthreads();
}

__global__ void __launch_bounds__(NTHREADS, 2) mk_fwd(Params p) {
    extern __shared__ __attribute__((aligned(16))) unsigned char lds_raw[];
    cg::grid_group grid = cg::this_grid();
    Ctx C; C.p = p; C.lds = (LAS unsigned char*)lds_raw; C.tid = threadIdx.x; C.lane = C.tid & 63; C.wave = __builtin_amdgcn_readfirstlane(C.tid >> 6); C.bid = blockIdx.x; C.G = gridDim.x; C.ws = p.ws;

    volatile LAS unsigned* bst = (volatile LAS unsigned*)(C.lds + LDS_BYTES - 64);
    if (threadIdx.x < 2) bst[threadIdx.x] = 0u;
    __syncthreads();
    const XcdBarrier bar = xcd_barrier_post((unsigned*)(p.ws + WS_BAR), bst);
    C.refresh(); phase_prologue(C);
    grid.sync();
    C.refresh(); phase_norm0(C);
    xcd_barrier(bar);
#pragma unroll 1
    for (int layer = 0; layer < DEPTH; ++layer) {
        { C.refresh(); bf16_t* R1 = (bf16_t*)(C.ws + WS_R1); bf16_t* R2 = (bf16_t*)(C.ws + WS_R2); unsigned char* wl = C.wl(layer); pg8::Gemm g{R1, (const bf16_t*)(wl + WL_IN), M, NPP, D}; pg8::StaticOrder S; S.init(M, NPP, C.G, C.bid); pg8::EpiStore E{R2, NP, NP};
          pg8::gemm_phase<pg8::EpiStore, pg8::StaticOrder, true, true>(C.lds, g, S, E); }
        xcd_barrier(bar);
        C.refresh();
        for (int u = C.bid; u < 768 + 192 + 128 + 128 + 200; u += C.G) {
            C.refresh();
            if (u < 768) unit_chunk_mlp(C, layer, u);
            else if (u < 960) unit_conv(C, layer, u - 768);
            else if (u < 1088) unit_fourier_ctx(C, u - 960);
            else if (u < 1216) unit_fourier_lat1(C, u - 1088);
            else unit_mla_prep(C, layer, u - 1216);
        }
        xcd_barrier(bar);
        C.refresh();
        for (int u = C.bid; u < 512; u += C.G) {
            C.refresh();
            if (u < 256) unit_attention(C, 128 + u);
            else if (u < 384) unit_attention(C, u - 256);
            else unit_fourier_lat2(C, u - 384);
        }
        xcd_barrier(bar);
        { C.refresh(); bf16_t* R1 = (bf16_t*)(C.ws + WS_R1); bf16_t* R2 = (bf16_t*)(C.ws + WS_R2); unsigned char* wl = C.wl(layer); pg8::Gemm g{R1, (const bf16_t*)(wl + WL_OUT), M, D, D}; pg8::SplitTailOrder S; S.init(D, C.G, C.bid); pg8::EpiStoreSplit E{R2, R2 + (size_t)M * D - (size_t)SPLIT_ROW0 * D, D};
          pg8::gemm_phase<pg8::EpiStoreSplit, pg8::SplitTailOrder, true, true>(C.lds, g, S, E); }
        xcd_barrier(bar);
        C.refresh(); phase_post<0>(C, layer);
        xcd_barrier(bar);
        { C.refresh(); bf16_t* R1 = (bf16_t*)(C.ws + WS_R1); bf16_t* R2 = (bf16_t*)(C.ws + WS_R2); unsigned char* wl = C.wl(layer); pg8::Gemm g{R1, (const bf16_t*)(wl + WL_GU), M, 2 * FF, D}; pg8::StaticOrder S; S.init(M, 2 * FF, C.G, C.bid); pg8::EpiSwiGLU E{R2, FF};
          pg8::gemm_phase<pg8::EpiSwiGLU, pg8::StaticOrder, true, true>(C.lds, g, S, E);
          if (C.G == 256 && layer + 1 < DEPTH && C.bid >= 64) { C.refresh(); transpose_items(C, (layer + 1) * TI_L + (C.bid - 64), 192, (layer + 2) * TI_L); } }
        xcd_barrier(bar);
        { C.refresh(); bf16_t* R2 = (bf16_t*)(C.ws + WS_R2); bf16_t* R3 = (bf16_t*)(C.ws + WS_MLA); unsigned char* wl = C.wl(layer); pg8::Gemm g{R2, (const bf16_t*)(wl + WL_DN), M, D, FF}; pg8::SplitTailOrder S; S.init(FF, C.G, C.bid); pg8::EpiStoreSplit E{R3, R3 + (size_t)M * D - (size_t)SPLIT_ROW0 * D, D};
          pg8::gemm_phase<pg8::EpiStoreSplit, pg8::SplitTailOrder, true, true>(C.lds, g, S, E); }
        xcd_barrier(bar);
        C.refresh(); phase_post<1>(C, layer);
        if (layer + 1 < DEPTH) xcd_barrier(bar);
    }
}

extern "C" void kernel_launch(void* const* d_in, const int* in_sizes, int n_in, void* d_out, int out_size, void* d_ws, size_t ws_size, hipStream_t stream) {
    static int grid = 0;
    if (grid == 0) {
        if (n_in != 24 || ws_size < WS_END) { fprintf(stderr, "kernel_launch: need 24 inputs and %zu bytes of workspace; got %d, %zu\n", (size_t)WS_END, n_in, ws_size); grid = -1; return; }
        int dev = 0, cus = 0, per_cu = 0;
        if (hipGetDevice(&dev) != hipSuccess || hipDeviceGetAttribute(&cus, hipDeviceAttributeMultiprocessorCount, dev) != hipSuccess) { grid = -1; return; }
        if (hipFuncSetAttribute((const void*)mk_fwd, hipFuncAttributeMaxDynamicSharedMemorySize, LDS_BYTES) != hipSuccess) { fprintf(stderr, "kernel_launch: hipFuncSetAttribute failed\n"); grid = -1; return; }
        if (hipOccupancyMaxActiveBlocksPerMultiprocessor(&per_cu, (const void*)mk_fwd, NTHREADS, LDS_BYTES) != hipSuccess || per_cu < 1) fprintf(stderr, "kernel_launch: occupancy query says %d blocks per CU\n", per_cu);
        (void)hipGetLastError();
        grid = cus;
    }
    if (grid < 0) return;
    Params p{};
    for (int i = 0; i < 24; ++i) p.in[i] = (const float*)d_in[i];
    p.out = (float*)d_out; p.ws = (unsigned char*)d_ws;
    if (hipMemsetAsync((char*)d_ws + WS_BAR, 0, WS_BAR_BYTES, stream) != hipSuccess) { fprintf(stderr, "kernel_launch: memset failed\n"); return; }
    void* args[] = {&p};
    hipError_t e = hipLaunchCooperativeKernel((const void*)mk_fwd, dim3(grid), dim3(NTHREADS), args, LDS_BYTES, stream);
    if (e != hipSuccess) fprintf(stderr, "kernel_launch: cooperative launch failed: %s (grid %d)\n", hipGetErrorString(e), grid);
}
```

```cpp
#include <hip/hip_runtime.h>
#include <hip/hip_cooperative_groups.h>
#include <cstdio>
#include <cstdint>
namespace cg = cooperative_groups;
namespace pg8 {
#define PG8_LAS __attribute__((address_space(3)))
typedef unsigned short bf16_t;
typedef short bf16x8 __attribute__((ext_vector_type(8)));
typedef float f32x4 __attribute__((ext_vector_type(4)));
typedef unsigned u32x4 __attribute__((ext_vector_type(4)));
constexpr int BM = 256, BK = 64, HALF = 128, HTB = HALF * BK * 2  , STAGE_BYTES = 8 * HTB, NXCD = 8, WGM = 8;

__host__ __device__ __forceinline__ int lds_byte(int r, int c) { const int st = (r >> 4) * 2 + (c >> 5), rr = r & 15, cc = c & 31, ob = rr * 64 + cc * 2; return st * 1024 + (ob ^ (((ob >> 9) & 1) << 5)); }
__host__ __device__ __forceinline__ void stage_rc(int b, int& R, int& C) { const int st = b / 1024, sb = b % 1024, swz = sb ^ (((sb >> 9) & 1) << 5); R = (st >> 1) * 16 + swz / 64; C = (st & 1) * 32 + (swz % 64) / 2; }
__host__ __device__ __forceinline__ int perm32(int rho) { const int n = rho >> 4, i = rho & 15; return 8 * (i >> 2) + 4 * n + (i & 3); }

struct Unit { int pm, pn; int kh, nt, koff; };
struct Gemm { const bf16_t* A; const bf16_t* Bt; int M, N, K; };

struct StaticOrder {
    int nM, nN, nwg, G, c;
    __host__ __device__ void init(int M, int N, int G_, int c_) { nM = M / BM; nN = N / BM; nwg = nM * nN; G = G_; c = c_; }
    __host__ __device__ bool next(int i, Unit& u) const {
        const long L = (long)i * G + c; if (L >= nwg) return false;
        int wgid = (int)L; { const int q = nwg / NXCD, r = nwg % NXCD, xcd = wgid % NXCD, off = wgid / NXCD; wgid = (xcd < r ? xcd * (q + 1) : r * (q + 1) + (xcd - r) * q) + off; }
        const int nig = WGM * nN, gid = wgid / nig, fm = gid * WGM, gsz = (nM - fm) < WGM ? (nM - fm) : WGM;
        u.pm = fm + ((wgid % nig) % gsz); u.pn = (wgid % nig) / gsz; u.kh = 0; u.nt = 0; u.koff = 0; return true;
    }
    __device__ __forceinline__ void a_ready(const Unit&) const {}
    __device__ __forceinline__ void done(const Unit&) const {}
};

__device__ __forceinline__ unsigned cvt_pk_bf16(float lo, float hi) { unsigned r; asm volatile("v_cvt_pk_bf16_f32 %0, %1, %2" : "=v"(r) : "v"(lo), "v"(hi)); return r; }
typedef float f32x2 __attribute__((ext_vector_type(2)));
struct EpiStore {
    static constexpr bool PERM = true, AFTER_DRAIN = false;
    bf16_t* O; int ldc; int ncols;
    __device__ __forceinline__ void operator()(const f32x4 (&acc)[2][2][4][2], const Unit& u, int wr, int wc, int fr, int fq) const {
        const int row0 = u.pm * BM + wr * 64 + fr; const int col0 = u.pn * BM + wc * 32 + 8 * fq;
#pragma unroll
        for (int ai = 0; ai < 2; ++ai)
#pragma unroll
            for (int m = 0; m < 4; ++m) { bf16_t* rowp = O + (size_t)(row0 + ai * HALF + m * 16) * ldc + col0;
#pragma unroll
                for (int bj = 0; bj < 2; ++bj) { const f32x4 v0 = acc[ai][bj][m][0], v1 = acc[ai][bj][m][1];
                    u32x4 w; w.x = cvt_pk_bf16(v0[0], v0[1]); w.y = cvt_pk_bf16(v0[2], v0[3]); w.z = cvt_pk_bf16(v1[0], v1[1]); w.w = cvt_pk_bf16(v1[2], v1[3]);
                    if (col0 + bj * HALF < ncols) *(u32x4*)(rowp + bj * HALF) = w; } }
    }
};
struct EpiStoreWT {
    static constexpr bool PERM = true, AFTER_DRAIN = false;
    bf16_t* O; int ldc; int ncols;
    __device__ __forceinline__ void operator()(const f32x4 (&acc)[2][2][4][2], const Unit& u, int wr, int wc, int fr, int fq) const {
        const int row0 = u.pm * BM + wr * 64 + fr; const int col0 = u.pn * BM + wc * 32 + 8 * fq;
#pragma unroll
        for (int ai = 0; ai < 2; ++ai)
#pragma unroll
            for (int m = 0; m < 4; ++m) { bf16_t* rowp = O + (size_t)(row0 + ai * HALF + m * 16) * ldc + col0;
#pragma unroll
                for (int bj = 0; bj < 2; ++bj) { const f32x4 v0 = acc[ai][bj][m][0], v1 = acc[ai][bj][m][1];
                    const unsigned long long lo = (unsigned long long)cvt_pk_bf16(v0[0], v0[1]) | ((unsigned long long)cvt_pk_bf16(v0[2], v0[3]) << 32);
                    const unsigned long long hi = (unsigned long long)cvt_pk_bf16(v1[0], v1[1]) | ((unsigned long long)cvt_pk_bf16(v1[2], v1[3]) << 32);
                    unsigned long long* q = (unsigned long long*)(rowp + bj * HALF);
                    __hip_atomic_store(q, lo, __ATOMIC_RELAXED, __HIP_MEMORY_SCOPE_AGENT); __hip_atomic_store(q + 1, hi, __ATOMIC_RELAXED, __HIP_MEMORY_SCOPE_AGENT); } }
    }
};
__device__ __forceinline__ float silu_mul(float g, float u) { return g * u * __builtin_amdgcn_rcpf(1.f + __expf(-g)); }
struct EpiSwiGLU {
    static constexpr bool PERM = true, AFTER_DRAIN = false;
    bf16_t* O; int ldc;
    __device__ __forceinline__ void operator()(const f32x4 (&acc)[2][2][4][2], const Unit& u, int wr, int wc, int fr, int fq) const {
        const int row0 = u.pm * BM + wr * 64 + fr; const int col0 = u.pn * HALF + wc * 32 + 8 * fq;
#pragma unroll
        for (int ai = 0; ai < 2; ++ai)
#pragma unroll
            for (int m = 0; m < 4; ++m) { bf16_t* rowp = O + (size_t)(row0 + ai * HALF + m * 16) * ldc + col0;
                const f32x4 g0 = acc[ai][0][m][0], g1 = acc[ai][0][m][1], u0 = acc[ai][1][m][0], u1 = acc[ai][1][m][1];
                u32x4 w; w.x = cvt_pk_bf16(silu_mul(g0[0], u0[0]), silu_mul(g0[1], u0[1])); w.y = cvt_pk_bf16(silu_mul(g0[2], u0[2]), silu_mul(g0[3], u0[3]));
                w.z = cvt_pk_bf16(silu_mul(g1[0], u1[0]), silu_mul(g1[1], u1[1])); w.w = cvt_pk_bf16(silu_mul(g1[2], u1[2]), silu_mul(g1[3], u1[3]));
                *(u32x4*)rowp = w; }
    }
};

struct PanelOrder {
    int nN, nwg, G, c; unsigned* cnt;
    __device__ void init(int M, int N, int G_, int c_, unsigned* cnt_) { nN = N / BM; nwg = (M / BM) * nN; G = G_; c = c_; cnt = cnt_; }
    __device__ bool next(int i, Unit& u) const { const long L = (long)i * G + c; if (L >= nwg) return false; u.pm = (int)L / nN; u.pn = (int)L % nN; u.kh = 0; u.nt = 0; u.koff = 0; return true; }
    __device__ __forceinline__ void a_ready(const Unit&) const {}
    __device__ __forceinline__ void done(const Unit& u) const {
        asm volatile("s_waitcnt vmcnt(0)" ::: "memory");
        if ((threadIdx.x & 63) == 0) __hip_atomic_fetch_add(cnt + u.pm, 1u, __ATOMIC_RELAXED, __HIP_MEMORY_SCOPE_AGENT);
    }
};

struct SplitTailOrder {
    int G, c, ntf; bool split;
    __device__ void init(int K, int G_, int c_) { G = G_; c = c_; ntf = K / BK; split = (G_ == 256); }
    __device__ bool next(int i, Unit& u) const {
        if (!split) { const long L = (long)i * G + c; if (L >= 384) return false; u.pm = (int)L >> 2; u.pn = (int)L & 3; u.kh = 0; u.nt = 0; u.koff = 0; return true; }
        if (i == 0) { const int t = (c & 7) * 32 + (c >> 3); u.pm = t >> 2; u.pn = t & 3; u.kh = 0; u.nt = 0; u.koff = 0; return true; }
        if (i == 1) { const int t = 256 + (c & 7) * 16 + (c >> 4); u.pm = t >> 2; u.pn = t & 3; u.kh = (c >> 3) & 1; u.nt = ntf / 2; u.koff = u.kh * (ntf / 2) * BK * 2; return true; }
        return false;
    }
    __device__ __forceinline__ void a_ready(const Unit&) const {}
    __device__ __forceinline__ void done(const Unit&) const {}
};
struct EpiStoreSplit {
    static constexpr bool PERM = true, AFTER_DRAIN = false;
    bf16_t* O; bf16_t* O1; int ldc;
    __device__ __forceinline__ void operator()(const f32x4 (&acc)[2][2][4][2], const Unit& u, int wr, int wc, int fr, int fq) const {
        const int row0 = u.pm * BM + wr * 64 + fr; const int col0 = u.pn * BM + wc * 32 + 8 * fq; bf16_t* base = u.kh ? O1 : O;
#pragma unroll
        for (int ai = 0; ai < 2; ++ai)
#pragma unroll
            for (int m = 0; m < 4; ++m) { bf16_t* rowp = base + (size_t)(row0 + ai * HALF + m * 16) * ldc + col0;
#pragma unroll
                for (int bj = 0; bj < 2; ++bj) { const f32x4 v0 = acc[ai][bj][m][0], v1 = acc[ai][bj][m][1];
                    u32x4 w; w.x = cvt_pk_bf16(v0[0], v0[1]); w.y = cvt_pk_bf16(v0[2], v0[3]); w.z = cvt_pk_bf16(v1[0], v1[1]); w.w = cvt_pk_bf16(v1[2], v1[3]);
                    *(u32x4*)(rowp + bj * HALF) = w; } }
    }
};
template <class Epi, class Sched, bool ALIGN_EPI = false, bool SP2 = false>
__device__ __forceinline__ void gemm_phase(PG8_LAS unsigned char* lds, const Gemm g, const Sched& S, const Epi& E) {
    int tid_ = threadIdx.x; asm volatile("" : "+v"(tid_));
    const int tid = tid_, wid = __builtin_amdgcn_readfirstlane(tid >> 6), lane = tid & 63, wr = wid >> 2, wc = wid & 3, fr = lane & 15, fq = lane >> 4;
    const int K = g.K, nt = K / BK;
    unsigned voffA[2], voffB[2];
#pragma unroll
    for (int i = 0; i < 2; ++i) { int R, C; stage_rc(tid * 16 + i * 8192, R, C); const int Rb = Epi::PERM ? ((R & ~31) + perm32(R & 31)) : R;
        voffA[i] = (unsigned)(R * K + C) * 2u; voffB[i] = (unsigned)(Rb * K + C) * 2u; }
    const size_t kstep = (size_t)(BK * 2);
    const size_t hstep = (size_t)HALF * K * 2;
    const size_t tstep = 2 * hstep;
    const unsigned ldsw = (unsigned)wid * 1024u;
    const int aoff = lds_byte(wr * 64 + fr, fq * 8), boff = lds_byte(wc * 32 + fr, fq * 8);
#define PG8_SA(b, h) (((b) * 2 + (h)) * HTB)
#define PG8_SB(b, h) ((4 + (b) * 2 + (h)) * HTB)
#define PG8_STAGE(bufoff, gbase, voff) do { _Pragma("unroll") for (int _i = 0; _i < 2; ++_i) \
        __builtin_amdgcn_global_load_lds((const unsigned*)((const char*)(gbase) + (voff)[_i]), (PG8_LAS unsigned*)(lds + (bufoff) + ldsw + _i * 8192), 16, 0, 0); } while (0)
#define PG8_LDA(dst, b, h) do { _Pragma("unroll") for (int m = 0; m < 4; ++m) _Pragma("unroll") for (int k = 0; k < 2; ++k) dst[m][k] = *(const PG8_LAS bf16x8*)(lds + PG8_SA(b, h) + aoff + m * 2048 + k * 1024); } while (0)
#define PG8_LDB(dst, b, h) do { _Pragma("unroll") for (int n = 0; n < 2; ++n) _Pragma("unroll") for (int k = 0; k < 2; ++k) dst[n][k] = *(const PG8_LAS bf16x8*)(lds + PG8_SB(b, h) + boff + n * 2048 + k * 1024); } while (0)
#define PG8_MMA(ai, bj, At, Bt) do { __builtin_amdgcn_s_setprio(1); _Pragma("unroll") for (int m = 0; m < 4; ++m) _Pragma("unroll") for (int n = 0; n < 2; ++n) _Pragma("unroll") for (int k = 0; k < 2; ++k) \
        acc[ai][bj][m][n] = __builtin_amdgcn_mfma_f32_16x16x32_bf16(Bt[n][k], At[m][k], acc[ai][bj][m][n], 0, 0, 0); __builtin_amdgcn_s_setprio(0); } while (0)
#define PG8_WAIT_V(n) asm volatile("s_waitcnt vmcnt(" #n ")" ::: "memory")
#define PG8_WAIT_L(n) asm volatile("s_waitcnt lgkmcnt(" #n ")" ::: "memory")
#define PG8_BAR __builtin_amdgcn_s_barrier()
#define PG8_SCHED __builtin_amdgcn_sched_barrier(0)
    Unit cur, nxt; int ui = 0;
    if (!S.next(0, cur)) return;
    f32x4 acc[2][2][4][2];
#pragma unroll
    for (int a = 0; a < 2; ++a)
#pragma unroll
        for (int b = 0; b < 2; ++b)
#pragma unroll
            for (int m = 0; m < 4; ++m)
#pragma unroll
                for (int n = 0; n < 2; ++n) acc[a][b][m][n] = (f32x4){0.f, 0.f, 0.f, 0.f};
    bf16x8 At[4][2], B0[2][2], B1[2][2];
    const char* cA = (const char*)g.A + (size_t)cur.pm * tstep + cur.koff; const char* cB = (const char*)g.Bt + (size_t)cur.pn * tstep + cur.koff;
    S.a_ready(cur);
    if constexpr (SP2) {
        PG8_STAGE(PG8_SB(0, 0), cB, voffB); PG8_STAGE(PG8_SB(0, 1), cB + hstep, voffB); PG8_STAGE(PG8_SA(0, 0), cA, voffA); PG8_STAGE(PG8_SA(0, 1), cA + hstep, voffA);
        if (wr == 1) PG8_BAR;
        PG8_WAIT_V(2); PG8_BAR;
        PG8_STAGE(PG8_SB(1, 0), cB + kstep, voffB); PG8_STAGE(PG8_SA(1, 0), cA + kstep, voffA); PG8_STAGE(PG8_SB(1, 1), cB + hstep + kstep, voffB);
        PG8_WAIT_V(6); PG8_BAR;
    } else {
        PG8_STAGE(PG8_SB(0, 0), cB, voffB); PG8_STAGE(PG8_SA(0, 0), cA, voffA); PG8_STAGE(PG8_SB(0, 1), cB + hstep, voffB); PG8_STAGE(PG8_SA(0, 1), cA + hstep, voffA);
        if (wr == 1) PG8_BAR;
        PG8_WAIT_V(4); PG8_BAR;
        PG8_STAGE(PG8_SB(1, 0), cB + kstep, voffB); PG8_STAGE(PG8_SA(1, 0), cA + kstep, voffA); PG8_STAGE(PG8_SB(1, 1), cB + hstep + kstep, voffB);
        PG8_WAIT_V(6); PG8_BAR;
    }
    for (;;) {
        const bool has_next = S.next(ui + 1, nxt);
        const char* nA = has_next ? (const char*)g.A + (size_t)nxt.pm * tstep + nxt.koff : cA; const char* nB = has_next ? (const char*)g.Bt + (size_t)nxt.pn * tstep + nxt.koff : cB;
        const int ntc = cur.nt ? cur.nt : nt;
        for (int t = 0; t < ntc; t += 2) {
            const bool last = (t == ntc - 2);
            const char* a1 = cA + (size_t)(t + 1) * kstep;
            const char* a2 = last ? nA : cA + (size_t)(t + 2) * kstep; const char* b2 = last ? nB : cB + (size_t)(t + 2) * kstep;
            const char* a3 = a2 + kstep; const char* b3 = b2 + kstep;
            if (last && has_next) S.a_ready(nxt);
            if constexpr (SP2) {
            PG8_LDB(B0, 0, 0); PG8_LDB(B1, 0, 1); PG8_SCHED; PG8_LDA(At, 0, 0); PG8_STAGE(PG8_SA(1, 1), a1 + hstep, voffA);
            PG8_WAIT_V(8); PG8_WAIT_L(0); PG8_BAR; PG8_MMA(0, 0, At, B0); PG8_MMA(0, 1, At, B1); PG8_BAR; PG8_SCHED;
            PG8_LDA(At, 0, 1); PG8_STAGE(PG8_SB(0, 0), b2, voffB); PG8_STAGE(PG8_SB(0, 1), b2 + hstep, voffB); PG8_STAGE(PG8_SA(0, 0), a2, voffA);
            PG8_WAIT_V(8); PG8_WAIT_L(0); PG8_BAR; PG8_MMA(1, 0, At, B0); PG8_MMA(1, 1, At, B1); PG8_BAR; PG8_SCHED;
            PG8_LDB(B0, 1, 0); PG8_LDB(B1, 1, 1); PG8_SCHED; PG8_LDA(At, 1, 0); PG8_STAGE(PG8_SA(0, 1), a2 + hstep, voffA);
            PG8_WAIT_V(8); PG8_WAIT_L(0); PG8_BAR; PG8_MMA(0, 0, At, B0); PG8_MMA(0, 1, At, B1); PG8_BAR; PG8_SCHED;
            PG8_LDA(At, 1, 1); PG8_STAGE(PG8_SB(1, 0), b3, voffB); PG8_STAGE(PG8_SB(1, 1), b3 + hstep, voffB); PG8_STAGE(PG8_SA(1, 0), a3, voffA);
            PG8_WAIT_V(8); PG8_WAIT_L(0); PG8_BAR; PG8_MMA(1, 0, At, B0); PG8_MMA(1, 1, At, B1); PG8_BAR; PG8_SCHED;
            } else {
            PG8_LDB(B0, 0, 0); PG8_SCHED; PG8_LDA(At, 0, 0); PG8_STAGE(PG8_SA(1, 1), a1 + hstep, voffA);
            PG8_WAIT_L(8); PG8_BAR; PG8_WAIT_L(0); PG8_MMA(0, 0, At, B0); PG8_BAR; PG8_SCHED;
            PG8_LDB(B1, 0, 1); PG8_STAGE(PG8_SB(0, 0), b2, voffB);
            PG8_BAR; PG8_WAIT_L(0); PG8_MMA(0, 1, At, B1); PG8_BAR;
            PG8_LDA(At, 0, 1); PG8_STAGE(PG8_SA(0, 0), a2, voffA);
            PG8_BAR; PG8_WAIT_L(0); PG8_MMA(1, 0, At, B0); PG8_BAR; PG8_SCHED;
            PG8_STAGE(PG8_SB(0, 1), b2 + hstep, voffB);
            PG8_WAIT_V(6); PG8_BAR; PG8_MMA(1, 1, At, B1); PG8_BAR;
            PG8_LDB(B0, 1, 0); PG8_SCHED; PG8_LDA(At, 1, 0); PG8_STAGE(PG8_SA(0, 1), a2 + hstep, voffA);
            PG8_WAIT_L(8); PG8_BAR; PG8_WAIT_L(0); PG8_MMA(0, 0, At, B0); PG8_BAR; PG8_SCHED;
            PG8_LDB(B1, 1, 1); PG8_STAGE(PG8_SB(1, 0), b3, voffB);
            PG8_BAR; PG8_WAIT_L(0); PG8_MMA(0, 1, At, B1); PG8_BAR;
            PG8_LDA(At, 1, 1); PG8_STAGE(PG8_SA(1, 0), a3, voffA);
            PG8_BAR; PG8_WAIT_L(0); PG8_MMA(1, 0, At, B0); PG8_BAR; PG8_SCHED;
            PG8_STAGE(PG8_SB(1, 1), b3 + hstep, voffB);
            PG8_WAIT_V(6); PG8_BAR; PG8_MMA(1, 1, At, B1); PG8_BAR;
            }
        }
        if constexpr (ALIGN_EPI) { if (wr == 0) PG8_BAR; }
        if constexpr (!Epi::AFTER_DRAIN) { E(acc, cur, wr, wc, fr, fq); S.done(cur); }
        if (!has_next) break;
#pragma unroll
        for (int a = 0; a < 2; ++a)
#pragma unroll
            for (int b = 0; b < 2; ++b)
#pragma unroll
                for (int m = 0; m < 4; ++m)
#pragma unroll
                    for (int n = 0; n < 2; ++n) acc[a][b][m][n] = (f32x4){0.f, 0.f, 0.f, 0.f};
        cur = nxt; cA = nA; cB = nB; ++ui;
        if constexpr (ALIGN_EPI) { if (wr == 1) PG8_BAR; }
    }
    PG8_WAIT_V(0);
    if constexpr (!ALIGN_EPI) { if (wr == 0) PG8_BAR; }
    PG8_BAR;
    if constexpr (Epi::AFTER_DRAIN) { E.fused(acc, cur, wr, wc, fr, fq, lds, wid, lane); S.done(cur); }
#undef PG8_SA
#undef PG8_SB
#undef PG8_STAGE
#undef PG8_LDA
#undef PG8_LDB
#undef PG8_MMA
#undef PG8_WAIT_V
#undef PG8_WAIT_L
#undef PG8_BAR
#undef PG8_SCHED
}
}
#define LAS __attribute__((address_space(3)))
typedef unsigned short bf16_t;
typedef short bf16x8 __attribute__((ext_vector_type(8)));
typedef short bf16x4 __attribute__((ext_vector_type(4)));
typedef float f32x4 __attribute__((ext_vector_type(4)));
typedef float f32x2 __attribute__((ext_vector_type(2)));
typedef float f32x16 __attribute__((ext_vector_type(16)));
typedef unsigned u32x4 __attribute__((ext_vector_type(4)));
typedef unsigned u32x2 __attribute__((ext_vector_type(2)));

constexpr int D = 1024, M_CTX = 8192, M_LAT = 16384, M = M_CTX + M_LAT, NP = 1888, NPP = 2048, FF = 2816, DEPTH = 4;
constexpr int KEYROWS = 8192 + 4 * 4352;
constexpr float EPS = 1e-6f;
constexpr int NTHREADS = 512, NWAVES = 8;
constexpr int LDS_BYTES = 147456;

constexpr size_t OUT_X = 0, OUT_CKV = (size_t)M * D, OUT_KR = OUT_CKV + (size_t)32 * 4 * 256 * 128;
constexpr int PC_U = 0, PC_V = 256, PC_H = 512, PC_B = 768, PC_C = 1024, PC_F = 1280, PC_Q = 1536, PC_KV = 1728, PC_KR = 1856;

constexpr size_t al256(size_t x) { return (x + 255) & ~(size_t)255; }
constexpr size_t WS_BAR = 0, WS_BAR_BYTES = 16384;
constexpr size_t WS_MOD = WS_BAR_BYTES;
constexpr size_t WS_F64 = al256(WS_MOD + (size_t)4 * 5 * 6144 * 4);
constexpr size_t WS_T64R = WS_F64 + 128 * 64 * 2;
constexpr size_t WS_T64I = WS_T64R + 64 * 128 * 2;
constexpr size_t WS_T64B = WS_T64I + 64 * 128 * 2;
constexpr size_t WS_T256 = WS_T64B + 64 * 128 * 2;
constexpr size_t WS_TW = WS_T256 + 256 * 512 * 2;
constexpr size_t WS_ROPE = WS_TW + 4096 * 8;
constexpr size_t WS_W = al256(WS_ROPE + 64 * 8 * 8);
constexpr size_t WL_IN = 0, WL_OUT = WL_IN + (size_t)NPP * D * 2, WL_GU = WL_OUT + (size_t)D * D * 2, WL_DN = WL_GU + (size_t)2 * FF * D * 2,
                 WL_UQ = WL_DN + (size_t)D * FF * 2, WL_UKV = WL_UQ + (size_t)384 * 192 * 2, WL_SP = WL_UKV + (size_t)512 * 128 * 2, WL_SIZE = WL_SP + (size_t)4 * 128 * 128 * 2;
constexpr size_t WS_R1 = al256(WS_W + 4 * WL_SIZE);
constexpr size_t WS_R2 = WS_R1 + (size_t)M * D * 2;
constexpr size_t WS_MLA = WS_R2 + (size_t)M * FF * 2;
constexpr size_t WS_Q = WS_MLA, WS_KN = WS_Q + (size_t)M * 384 * 2, WS_VT = WS_KN + (size_t)KEYROWS * 256 * 2, WS_KR = WS_VT + (size_t)KEYROWS * 256 * 2,
                 WS_GB = WS_KR + (size_t)KEYROWS * 32 * 2, WS_END = WS_GB + (size_t)4 * 4 * 64 * 64 * 128 * 2;
static_assert(WS_END - WS_MLA >= (size_t)M * D * 2, "FFNOUT alias");
static_assert((size_t)M * NP * 2 <= (size_t)M * FF * 2, "PROJ fits R2");

struct Params { const float* in[24]; float* out; unsigned char* ws; };
enum { I_XP = 0, I_XS, I_CCKV, I_CKR, I_C, I_CCTX, I_WADA, I_BADA, I_GPM, I_GPOM, I_GPF, I_GPOF, I_WIN, I_SPW, I_SPB, I_CVW, I_CVB, I_GQ, I_WUQ, I_GKV, I_WUKV, I_WOUT, I_WGU, I_WDN };

__device__ __forceinline__ unsigned f2bf(float f) { unsigned u = __builtin_bit_cast(unsigned, f); return (u + 0x7fffu + ((u >> 16) & 1u)) >> 16; }
typedef __bf16 bf16x2v __attribute__((ext_vector_type(2)));
__device__ __forceinline__ unsigned pk2(float lo, float hi) { const bf16x2v r = __builtin_convertvector((f32x2){lo, hi}, bf16x2v); return __builtin_bit_cast(unsigned, r); }
__device__ __forceinline__ float bflo(unsigned w) { return __builtin_bit_cast(float, w << 16); }
__device__ __forceinline__ float bfhi(unsigned w) { return __builtin_bit_cast(float, w & 0xffff0000u); }
__device__ __forceinline__ float bf1(bf16_t v) { return __builtin_bit_cast(float, (unsigned)v << 16); }
__device__ __forceinline__ f32x4 mma16(bf16x8 a, bf16x8 b, f32x4 c) { return __builtin_amdgcn_mfma_f32_16x16x32_bf16(a, b, c, 0, 0, 0); }
__device__ __forceinline__ f32x16 mma32(bf16x8 a, bf16x8 b, f32x16 c) { return __builtin_amdgcn_mfma_f32_32x32x16_bf16(a, b, c, 0, 0, 0); }
__device__ __forceinline__ float wave_sum(float v) {
#pragma unroll
    for (int o = 1; o < 64; o <<= 1) v += __shfl_xor(v, o);
    return v;
}
__device__ __forceinline__ u32x2 pk4(f32x4 v) { u32x2 w; w.x = pk2(v[0], v[1]); w.y = pk2(v[2], v[3]); return w; }
__device__ __forceinline__ int mod_of_row(int r) { return r < M_CTX ? 0 : 1 + ((r - M_CTX) >> 12); }

struct Ctx {
    Params p; LAS unsigned char* lds; int tid, lane, wave, bid, G;
    unsigned char* ws;
    __device__ __forceinline__ const float* mod(int l, int mi, int chunk) const { return (const float*)(ws + WS_MOD) + ((size_t)(l * 5 + mi) * 6 + chunk) * 1024; }
    __device__ __forceinline__ unsigned char* wl(int l) const { return ws + WS_W + (size_t)l * WL_SIZE; }
    __device__ __forceinline__ void refresh() { int t = threadIdx.x; asm volatile("" : "+v"(t)); tid = t; lane = t & 63; wave = __builtin_amdgcn_readfirstlane(t >> 6);
        size_t z = 0; asm volatile("" : "+s"(z)); ws = p.ws + z;
        int b = blockIdx.x; asm volatile("" : "+s"(b)); bid = b; }
};

constexpr int TPS = 258;
struct TItem { const float* W; bf16_t* WT; int ldw, K, k0, n0, nvalid, gu; };
__device__ __forceinline__ void titem_load(const TItem& t, int wave, int lane, f32x4 (&v)[8]) {
    const int n = t.n0 + 4 * lane;
#pragma unroll
    for (int i = 0; i < 8; ++i) v[i] = n < t.nvalid ? *(const f32x4*)(t.W + (size_t)(t.k0 + 8 * wave + i) * t.ldw + n) : (f32x4){0.f, 0.f, 0.f, 0.f};
}
__device__ __forceinline__ void titem_stage(LAS unsigned char* lds, int wave, int lane, const f32x4 (&v)[8]) {
    LAS bf16_t* T = (LAS bf16_t*)lds;
#pragma unroll
    for (int i = 0; i < 8; ++i) { LAS unsigned* d = (LAS unsigned*)(T + (8 * wave + i) * TPS + 4 * lane); d[0] = pk2(v[i][0], v[i][1]); d[1] = pk2(v[i][2], v[i][3]); }
}
__device__ __forceinline__ void titem_store(const TItem& t, const LAS unsigned char* lds, int tid) {
    const LAS bf16_t* T = (const LAS bf16_t*)lds;
#pragma unroll
    for (int it = 0; it < 4; ++it) { const int q = tid + NTHREADS * it, n = q >> 3, c = q & 7;
        unsigned short e[8];
#pragma unroll
        for (int j = 0; j < 8; ++j) e[j] = T[(8 * c + j) * TPS + n];
        const int sn = t.n0 + n;
        if (sn < t.nvalid) { int dr = sn; if (t.gu) { const int isup = sn >= FF, jj = isup ? sn - FF : sn; dr = (jj >> 7) * 256 + isup * 128 + (jj & 127); }
            u32x4 o; o.x = e[0] | ((unsigned)e[1] << 16); o.y = e[2] | ((unsigned)e[3] << 16); o.z = e[4] | ((unsigned)e[5] << 16); o.w = e[6] | ((unsigned)e[7] << 16);
            *(u32x4*)(t.WT + (size_t)dr * t.K + t.k0 + 8 * c) = o; } }
}
constexpr int TI_IN = 16 * 8, TI_OUT = 16 * 4, TI_GU = 16 * 22, TI_DN = 44 * 4, TI_UQ = 3 * 2, TI_UKV = 2 * 2, TI_L = TI_IN + TI_OUT + TI_GU + TI_DN + TI_UQ + TI_UKV;
__device__ __forceinline__ TItem titem_make(const Ctx& C, int it) {
    const Params& p = C.p; const int l = it / TI_L; int r = it % TI_L; unsigned char* wl = C.wl(l); TItem t; t.gu = 0;
    if (r < TI_IN) { t.W = p.in[I_WIN] + (size_t)l * D * NP; t.WT = (bf16_t*)(wl + WL_IN); t.ldw = NP; t.K = D; t.k0 = (r >> 3) * 64; t.n0 = (r & 7) * 256; t.nvalid = NP; return t; } r -= TI_IN;
    if (r < TI_OUT) { t.W = p.in[I_WOUT] + (size_t)l * D * D; t.WT = (bf16_t*)(wl + WL_OUT); t.ldw = D; t.K = D; t.k0 = (r >> 2) * 64; t.n0 = (r & 3) * 256; t.nvalid = D; return t; } r -= TI_OUT;
    if (r < TI_GU) { t.W = p.in[I_WGU] + (size_t)l * D * 2 * FF; t.WT = (bf16_t*)(wl + WL_GU); t.ldw = 2 * FF; t.K = D; t.k0 = (r / 22) * 64; t.n0 = (r % 22) * 256; t.nvalid = 2 * FF; t.gu = 1; return t; } r -= TI_GU;
    if (r < TI_DN) { t.W = p.in[I_WDN] + (size_t)l * FF * D; t.WT = (bf16_t*)(wl + WL_DN); t.ldw = D; t.K = FF; t.k0 = (r >> 2) * 64; t.n0 = (r & 3) * 256; t.nvalid = D; return t; } r -= TI_DN;
    if (r < TI_UQ) { t.W = p.in[I_WUQ] + (size_t)l * 192 * 384; t.WT = (bf16_t*)(wl + WL_UQ); t.ldw = 384; t.K = 192; t.k0 = (r >> 1) * 64; t.n0 = (r & 1) * 256; t.nvalid = 384; return t; } r -= TI_UQ;
    t.W = p.in[I_WUKV] + (size_t)l * 128 * 512; t.WT = (bf16_t*)(wl + WL_UKV); t.ldw = 512; t.K = 128; t.k0 = (r >> 1) * 64; t.n0 = (r & 1) * 256; t.nvalid = 512; return t;
}

__device__ __forceinline__ void transpose_items(const Ctx& C, int it0, int stride, int end) {
    int it = it0; f32x4 v[8];
    TItem cur; if (it < end) { cur = titem_make(C, it); titem_load(cur, C.wave, C.lane, v); }
    while (it < end) {
        titem_stage(C.lds, C.wave, C.lane, v);
        const int nx = it + stride; TItem nxt = cur; if (nx < end) { nxt = titem_make(C, nx); titem_load(nxt, C.wave, C.lane, v); }
        __syncthreads();
        titem_store(cur, C.lds, C.tid);
        __syncthreads();
        cur = nxt; it = nx;
    }
}

__device__ __forceinline__ void phase_prologue(const Ctx& C) {
    const Params& p = C.p;
    transpose_items(C, C.bid, C.G, (C.G == 256) ? TI_L : 4 * TI_L);
    {
        LAS float* sc = (LAS float*)C.lds;
        LAS float* red = (LAS float*)(C.lds + 5 * 1024 * 4);
        const int ub = C.G - 1 - C.bid;
        if (ub < 96) {
            size_t za = 0, zb = 0; asm volatile("" : "+s"(za), "+s"(zb));
            const float* cctx = p.in[I_CCTX] + za; const float* cc_ = p.in[I_C] + zb;
            for (int i = C.tid; i < 5120; i += NTHREADS) { const int j = i >> 10, k = i & 1023; const float v = (j == 0) ? cctx[k] : cc_[(j - 1) * 1024 + k]; sc[i] = v / (1.f + __expf(-v)); }
            __syncthreads();
            for (int u = ub; u < 96; u += C.G) {
                const int l = u / 24, cb = u % 24;
                const float* w = p.in[I_WADA] + ((size_t)l * 1024 + C.wave * 128) * 6144 + cb * 256 + 4 * C.lane;
                f32x4 a0 = {0.f, 0.f, 0.f, 0.f}, a1 = a0, a2 = a0, a3 = a0, a4 = a0;
#pragma unroll 16
                for (int k = 0; k < 128; ++k) { const f32x4 wv = *(const f32x4*)(w + (size_t)k * 6144); const int kk = C.wave * 128 + k;
                    a0 += wv * sc[kk]; a1 += wv * sc[1024 + kk]; a2 += wv * sc[2048 + kk]; a3 += wv * sc[3072 + kk]; a4 += wv * sc[4096 + kk]; }
                LAS f32x4* rw = (LAS f32x4*)(red + C.wave * 1280) + C.lane;
                rw[0] = a0; rw[64] = a1; rw[128] = a2; rw[192] = a3; rw[256] = a4;
                __syncthreads();
                for (int i = C.tid; i < 1280; i += NTHREADS) { const int j = i >> 8, c2 = i & 255; float sum = p.in[I_BADA][l * 6144 + cb * 256 + c2];
#pragma unroll
                    for (int ww = 0; ww < 8; ++ww) sum += red[ww * 1280 + i];
                    ((float*)(C.ws + WS_MOD))[(size_t)(l * 5 + j) * 6144 + cb * 256 + c2] = sum; }
                __syncthreads();
            }
        }
        __syncthreads();
    }
    {
        const int gt = C.bid * NTHREADS + C.tid, GT = C.G * NTHREADS;
        for (int i = gt; i < 4 * 65536; i += GT) { const int l = i >> 16, e = i & 65535; ((bf16_t*)(C.wl(l) + WL_SP))[e] = (bf16_t)f2bf(p.in[I_SPW][i]); }
        for (int i = gt; i < 4 * 160 * 1024 / 2; i += GT) { const int l = i / (160 * 512), e = i % (160 * 512); ((unsigned*)(C.wl(l) + WL_IN + (size_t)NP * D * 2))[e] = 0u; }
        for (int i = gt; i < 128 * 64; i += GT) { const int m = i >> 6, c = i & 63; const int idx = ((m & 63) * c) & 63; const float a = (float)idx / 32.f;
            ((bf16_t*)(C.ws + WS_F64))[i] = (bf16_t)f2bf(m < 64 ? cospif(a) : sinpif(a)); }
        for (int i = gt; i < 64 * 128; i += GT) { const int k = i >> 7, K = i & 127; const int idx = (k * (K & 63)) & 63; const float a = (float)idx / 32.f; const float cv = cospif(a), sv = sinpif(a);
            ((bf16_t*)(C.ws + WS_T64R))[i] = (bf16_t)f2bf(K < 64 ? cv : -sv);
            ((bf16_t*)(C.ws + WS_T64I))[i] = (bf16_t)f2bf(K < 64 ? -sv : -cv);
            ((bf16_t*)(C.ws + WS_T64B))[i] = (bf16_t)f2bf(K < 64 ? cv : sv); }
        for (int i = gt; i < 256 * 512; i += GT) { const int k = i >> 9, K = i & 511; const int idx = (k * (K & 255)) & 255; const float a = (float)idx / 128.f;
            ((bf16_t*)(C.ws + WS_T256))[i] = (bf16_t)f2bf(K < 256 ? cospif(a) : -sinpif(a)); }
        for (int i = gt; i < 4096; i += GT) { const float a = (float)i / 2048.f; ((f32x2*)(C.ws + WS_TW))[i] = (f32x2){cospif(a), sinpif(a)}; }
        for (int i = gt; i < 512; i += GT) { const int pos = i >> 3, f = i & 7; const float inv = powf(10000.f, -(float)f / 8.f); const float ang = (float)pos * inv;
            ((f32x2*)(C.ws + WS_ROPE))[i] = (f32x2){cosf(ang), sinf(ang)}; }
    }
}

__device__ __forceinline__ void load_row_f32(const float* rowp, int lane, f32x4 (&v)[4]) {
#pragma unroll
    for (int j = 0; j < 4; ++j) v[j] = *(const f32x4*)(rowp + 4 * lane + 256 * j);
}
__device__ __forceinline__ void load_row_bf16(const bf16_t* rowp, int lane, f32x4 (&v)[4]) {
#pragma unroll
    for (int j = 0; j < 4; ++j) { const u32x2 w = *(const u32x2*)(rowp + 4 * lane + 256 * j); v[j] = (f32x4){bflo(w.x), bfhi(w.x), bflo(w.y), bfhi(w.y)}; }
}
__device__ __forceinline__ float row_rstd(const f32x4 (&v)[4]) {
    float s = 0.f;
#pragma unroll
    for (int j = 0; j < 4; ++j) s += (v[j][0] * v[j][0] + v[j][1] * v[j][1]) + (v[j][2] * v[j][2] + v[j][3] * v[j][3]);
    return 1.f / sqrtf(wave_sum(s) * (1.f / 1024.f) + EPS);
}
__device__ __forceinline__ void norm_mod_store(const f32x4 (&x)[4], const float* g, const float* scale, const float* shift, bf16_t* orow, int lane) {
    const float rs = row_rstd(x);
#pragma unroll
    for (int j = 0; j < 4; ++j) { const int c = 4 * lane + 256 * j; const f32x4 gv = *(const f32x4*)(g + c), sv = *(const f32x4*)(scale + c), hv = *(const f32x4*)(shift + c);
        const f32x4 h = x[j] * rs * gv * (1.f + sv) + hv; *(u32x2*)(orow + c) = pk4(h); }
}
__device__ __forceinline__ const float* xin_row(const Ctx& C, int layer, int r) {
    if (layer > 0) return C.p.out + OUT_X + (size_t)r * D;
    size_t za = 0, zb = 0; asm volatile("" : "+s"(za), "+s"(zb));
    const float* a = C.p.in[I_XP] + za; const float* b = C.p.in[I_XS] + zb;
    return r < M_CTX ? a + (size_t)r * D : b + (size_t)(r - M_CTX) * D;
}
constexpr int SPLIT_ROW0 = 16384;
__device__ __forceinline__ void load_T(const bf16_t* T, const bf16_t* T1, bool split, int r, int lane, f32x4 (&v)[4]) {
    load_row_bf16(T + (size_t)r * D, lane, v);
    if (split && r >= SPLIT_ROW0) { f32x4 w[4]; load_row_bf16(T1 + (size_t)r * D, lane, w);
#pragma unroll
        for (int j = 0; j < 4; ++j) v[j] = v[j] + w[j]; }
}
__device__ __forceinline__ void phase_norm0(const Ctx& C) {
    const int gw = C.bid * NWAVES + C.wave, NGW = C.G * NWAVES;
    bf16_t* H = (bf16_t*)(C.ws + WS_R1);
    f32x4 xn[4]; load_row_f32(xin_row(C, 0, gw), C.lane, xn);
    for (int r = gw; r < M; r += NGW) { f32x4 x[4];
#pragma unroll
        for (int j = 0; j < 4; ++j) x[j] = xn[j];
        if (r + NGW < M) load_row_f32(xin_row(C, 0, r + NGW), C.lane, xn);
        const int mi = mod_of_row(r);
        norm_mod_store(x, C.p.in[I_GPM], C.mod(0, mi, 1), C.mod(0, mi, 0), H + (size_t)r * D, C.lane); }
}
template <int which  > __device__ __forceinline__ void phase_post(const Ctx& C, int layer) {
    const int gw = C.bid * NWAVES + C.wave, NGW = C.G * NWAVES;
    const bf16_t* T = (const bf16_t*)(C.ws + (which == 0 ? WS_R2 : WS_MLA));
    const bf16_t* T1 = T + (size_t)M * D - (size_t)SPLIT_ROW0 * D;
    const bool split = (C.G == 256);
    bf16_t* H = (bf16_t*)(C.ws + WS_R1);
    const float* gpost = (which == 0 ? C.p.in[I_GPOM] : C.p.in[I_GPOF]) + layer * D;
    const bool do_next = (which == 0) || (layer + 1 < DEPTH);
    const int nl = which == 0 ? layer : layer + 1;
    const float* gnext = (which == 0 ? C.p.in[I_GPF] : C.p.in[I_GPM]) + (nl < DEPTH ? nl : 0) * D;
    f32x4 tn[4], xn[4];
    load_T(T, T1, split, gw, C.lane, tn); load_row_f32(which == 0 ? xin_row(C, layer, gw) : C.p.out + OUT_X + (size_t)gw * D, C.lane, xn);
    for (int r = gw; r < M; r += NGW) {
        const int mi = mod_of_row(r);
        f32x4 t[4], x[4];
#pragma unroll
        for (int j = 0; j < 4; ++j) { t[j] = tn[j]; x[j] = xn[j]; }
        if (r + NGW < M) { const int rn = r + NGW; load_T(T, T1, split, rn, C.lane, tn); load_row_f32(which == 0 ? xin_row(C, layer, rn) : C.p.out + OUT_X + (size_t)rn * D, C.lane, xn); }
        const float rs = row_rstd(t); const float* gate = C.mod(layer, mi, which == 0 ? 2 : 5);
        float* xo = C.p.out + OUT_X + (size_t)r * D;
#pragma unroll
        for (int j = 0; j < 4; ++j) { const int c = 4 * C.lane + 256 * j; const f32x4 gv = *(const f32x4*)(gpost + c), ga = *(const f32x4*)(gate + c);
            x[j] = x[j] + ga * (t[j] * rs * gv); *(f32x4*)(xo + c) = x[j]; }
        if (do_next) norm_mod_store(x, gnext, C.mod(nl, mi, which == 0 ? 4 : 1), C.mod(nl, mi, which == 0 ? 3 : 0), H + (size_t)r * D, C.lane);
    }
}

__device__ __forceinline__ void unit_chunk_mlp(const Ctx& C, int layer, int u) {
    const int chunk = u >> 2, g = u & 3, r0 = chunk * 128;
    const bf16_t* PROJ = (const bf16_t*)(C.ws + WS_R2); bf16_t* MIX = (bf16_t*)(C.ws + WS_R1);
    constexpr int VS = 136;
    LAS bf16_t* Vt = (LAS bf16_t*)C.lds;
    { const int q = C.tid >> 2, c0 = (C.tid & 3) * 16; const bf16_t* src = PROJ + (size_t)(r0 + q) * NP + PC_V + g * 64 + c0;
      const bf16x8 v0 = *(const bf16x8*)src, v1 = *(const bf16x8*)(src + 8);
#pragma unroll
      for (int j = 0; j < 8; ++j) { Vt[(c0 + j) * VS + q] = (bf16_t)v0[j]; Vt[(c0 + 8 + j) * VS + q] = (bf16_t)v1[j]; } }
    __syncthreads();
    const int l15 = C.lane & 15, hq = C.lane >> 4, w = C.wave;
    const bf16_t* Wg = (const bf16_t*)(C.wl(layer) + WL_SP) + (size_t)g * 128 * 128;
    bf16x8 bw[4];
#pragma unroll
    for (int ks = 0; ks < 4; ++ks) bw[ks] = *(const bf16x8*)(Wg + (size_t)(w * 16 + l15) * 128 + ks * 32 + 8 * hq);
    const int p = w * 16 + l15; const float bias = C.p.in[I_SPB][(layer * 4 + g) * 128 + p];
#pragma unroll
    for (int ct = 0; ct < 4; ++ct) {
        f32x4 acc = {0.f, 0.f, 0.f, 0.f};
#pragma unroll
        for (int ks = 0; ks < 4; ++ks) { const bf16x8 a = *(const LAS bf16x8*)(Vt + (ct * 16 + l15) * VS + ks * 32 + 8 * hq); acc = mma16(a, bw[ks], acc); }
        const int cc = g * 64 + ct * 16 + 4 * hq; const u32x2 uw = *(const u32x2*)(PROJ + (size_t)(r0 + p) * NP + PC_U + cc);
        f32x4 o; o[0] = bflo(uw.x) * (acc[0] + bias); o[1] = bfhi(uw.x) * (acc[1] + bias); o[2] = bflo(uw.y) * (acc[2] + bias); o[3] = bfhi(uw.y) * (acc[3] + bias);
        *(u32x2*)(MIX + (size_t)(r0 + p) * D + cc) = pk4(o);
    }
    __syncthreads();
}
__device__ __forceinline__ void unit_conv(const Ctx& C, int layer, int u) {
    const bf16_t* PROJ = (const bf16_t*)(C.ws + WS_R2); bf16_t* MIX = (bf16_t*)(C.ws + WS_R1);
    const float* cw = C.p.in[I_CVW] + layer * 3 * 256; const float* cb = C.p.in[I_CVB] + layer * 256;
    for (int it = 0; it < 8; ++it) {
        const int item = it * NTHREADS + C.tid, t = item >> 5, ch = (item & 31) * 8, r = u * 128 + t;
        const int pos = r < M_CTX ? (r & 255) : ((r - M_CTX) & 4095), len = r < M_CTX ? 256 : 4096;
        const bf16_t* base = PROJ + (size_t)r * NP;
        const bf16x8 h1 = *(const bf16x8*)(base + PC_H + ch), c1 = *(const bf16x8*)(base + PC_C + ch), gb = *(const bf16x8*)(base + PC_B + ch);
        bf16x8 h0 = h1, c0 = c1, h2 = h1, c2 = c1; const bool hasp = pos > 0, hasn = pos < len - 1;
        if (hasp) { h0 = *(const bf16x8*)(base - NP + PC_H + ch); c0 = *(const bf16x8*)(base - NP + PC_C + ch); }
        if (hasn) { h2 = *(const bf16x8*)(base + NP + PC_H + ch); c2 = *(const bf16x8*)(base + NP + PC_C + ch); }
        float o[8];
#pragma unroll
        for (int j = 0; j < 8; ++j) {
            const float z0 = hasp ? bf1((bf16_t)h0[j]) * bf1((bf16_t)c0[j]) : 0.f, z1 = bf1((bf16_t)h1[j]) * bf1((bf16_t)c1[j]), z2 = hasn ? bf1((bf16_t)h2[j]) * bf1((bf16_t)c2[j]) : 0.f;
            const float y = z0 * cw[ch + j] + z1 * cw[256 + ch + j] + z2 * cw[512 + ch + j] + cb[ch + j];
            o[j] = bf1((bf16_t)gb[j]) * y; }
        u32x4 w; w.x = pk2(o[0], o[1]); w.y = pk2(o[2], o[3]); w.z = pk2(o[4], o[5]); w.w = pk2(o[6], o[7]);
        *(u32x4*)(MIX + (size_t)r * D + 256 + ch) = w;
    }
}
__device__ __forceinline__ void unit_fourier_ctx(const Ctx& C, int u) {
    const int s = u >> 2, g = u & 3, l15 = C.lane & 15, hq = C.lane >> 4, w = C.wave;
    const bf16_t* PROJ = (const bf16_t*)(C.ws + WS_R2); bf16_t* MIX = (bf16_t*)(C.ws + WS_R1);
    const bf16_t* F64 = (const bf16_t*)(C.ws + WS_F64); const bf16_t* T256 = (const bf16_t*)(C.ws + WS_T256);
    constexpr int ZS = 520; LAS bf16_t* Zt = (LAS bf16_t*)C.lds;
#pragma unroll
    for (int i = 0; i < 2; ++i) { const int nt = 2 * w + i;
        bf16x8 a[2];
#pragma unroll
        for (int ks = 0; ks < 2; ++ks) a[ks] = *(const bf16x8*)(PROJ + (size_t)(s * 256 + nt * 16 + l15) * NP + PC_F + g * 64 + ks * 32 + 8 * hq);
#pragma unroll
        for (int mt = 0; mt < 8; ++mt) { f32x4 acc = {0.f, 0.f, 0.f, 0.f};
#pragma unroll
            for (int ks = 0; ks < 2; ++ks) { const bf16x8 b = *(const bf16x8*)(F64 + (size_t)(mt * 16 + l15) * 64 + ks * 32 + 8 * hq); acc = mma16(a[ks], b, acc); }
            const int mp = mt * 16 + l15;
            *(LAS u32x2*)(Zt + (mp & 63) * ZS + (mp >> 6) * 256 + nt * 16 + 4 * hq) = pk4(acc); } }
    __syncthreads();
#pragma unroll 1
    for (int i = 0; i < 2; ++i) { const int kt = 2 * w + i;
        f32x4 acc[4];
#pragma unroll
        for (int mt = 0; mt < 4; ++mt) acc[mt] = (f32x4){0.f, 0.f, 0.f, 0.f};
#pragma unroll 8
        for (int ks = 0; ks < 16; ++ks) { const bf16x8 b = *(const bf16x8*)(T256 + (size_t)(kt * 16 + l15) * 512 + ks * 32 + 8 * hq);
#pragma unroll
            for (int mt = 0; mt < 4; ++mt) { const bf16x8 a = *(const LAS bf16x8*)(Zt + (mt * 16 + l15) * ZS + ks * 32 + 8 * hq); acc[mt] = mma16(a, b, acc[mt]); } }
#pragma unroll
        for (int mt = 0; mt < 4; ++mt) *(u32x2*)(MIX + (size_t)(s * 256 + kt * 16 + l15) * D + 512 + g * 64 + mt * 16 + 4 * hq) = pk4(acc[mt] * (1.f / 128.f)); }
    __syncthreads();
}
__device__ __forceinline__ void unit_fourier_lat1(const Ctx& C, int u) {
    const int b = u >> 5, g = (u >> 3) & 3, nb = u & 7, l15 = C.lane & 15, hq = C.lane >> 4, n2 = nb * 8 + C.wave;
    const bf16_t* PROJ = (const bf16_t*)(C.ws + WS_R2);
    const bf16_t* F64 = (const bf16_t*)(C.ws + WS_F64); const bf16_t* T64R = (const bf16_t*)(C.ws + WS_T64R); const bf16_t* T64I = (const bf16_t*)(C.ws + WS_T64I);
    const f32x2* TW = (const f32x2*)(C.ws + WS_TW);
    bf16_t* GB = (bf16_t*)(C.ws + WS_GB) + (size_t)((b * 4 + g) * 64 + n2) * 64 * 128;
    constexpr int ZS = 136; LAS bf16_t* Zt = (LAS bf16_t*)(C.lds + C.wave * (64 * ZS * 2));
#pragma unroll 2
    for (int nt = 0; nt < 4; ++nt) {
        bf16x8 a[2];
#pragma unroll
        for (int ks = 0; ks < 2; ++ks) a[ks] = *(const bf16x8*)(PROJ + (size_t)(M_CTX + b * 4096 + (nt * 16 + l15) * 64 + n2) * NP + PC_F + g * 64 + ks * 32 + 8 * hq);
#pragma unroll
        for (int mt = 0; mt < 8; ++mt) { f32x4 acc = {0.f, 0.f, 0.f, 0.f};
#pragma unroll
            for (int ks = 0; ks < 2; ++ks) { const bf16x8 bb = *(const bf16x8*)(F64 + (size_t)(mt * 16 + l15) * 64 + ks * 32 + 8 * hq); acc = mma16(a[ks], bb, acc); }
            const int mp = mt * 16 + l15;
            *(LAS u32x2*)(Zt + (mp & 63) * ZS + (mp >> 6) * 64 + nt * 16 + 4 * hq) = pk4(acc); } }
    asm volatile("s_waitcnt lgkmcnt(0)" ::: "memory");
#pragma unroll 2
    for (int kt = 0; kt < 4; ++kt) {
        bf16x8 br[4], bi[4];
#pragma unroll
        for (int ks = 0; ks < 4; ++ks) { br[ks] = *(const bf16x8*)(T64R + (size_t)(kt * 16 + l15) * 128 + ks * 32 + 8 * hq); bi[ks] = *(const bf16x8*)(T64I + (size_t)(kt * 16 + l15) * 128 + ks * 32 + 8 * hq); }
        const int k1 = kt * 16 + l15; const f32x2 tw = TW[k1 * n2];
#pragma unroll
        for (int mt = 0; mt < 4; ++mt) { f32x4 ar = {0.f, 0.f, 0.f, 0.f}, ai = {0.f, 0.f, 0.f, 0.f};
#pragma unroll
            for (int ks = 0; ks < 4; ++ks) { const bf16x8 a = *(const LAS bf16x8*)(Zt + (mt * 16 + l15) * ZS + ks * 32 + 8 * hq); ar = mma16(a, br[ks], ar); ai = mma16(a, bi[ks], ai); }
            const f32x4 gr = ar * tw[0] + ai * tw[1], gi = ai * tw[0] - ar * tw[1];
            bf16_t* dst = GB + (size_t)k1 * 128 + mt * 16 + 4 * hq;
            *(u32x2*)dst = pk4(gr); *(u32x2*)(dst + 64) = pk4(gi); } }
    __syncthreads();
}
__device__ __forceinline__ void unit_fourier_lat2(const Ctx& C, int u) {
    const int b = u >> 5, g = (u >> 3) & 3, kb = u & 7, l15 = C.lane & 15, hq = C.lane >> 4, k1 = kb * 8 + C.wave;
    const bf16_t* T64B = (const bf16_t*)(C.ws + WS_T64B); bf16_t* MIX = (bf16_t*)(C.ws + WS_R1);
    const bf16_t* GB = (const bf16_t*)(C.ws + WS_GB) + (size_t)((b * 4 + g) * 64) * 64 * 128 + (size_t)k1 * 128;
    constexpr int ZS = 136; LAS bf16_t* Tt = (LAS bf16_t*)(C.lds + C.wave * (64 * ZS * 2));
#pragma unroll 4
    for (int it = 0; it < 16; ++it) { const int q = it * 64 + C.lane, n2 = q >> 4, cc = q & 15, part = cc >> 3, m0 = (cc & 7) * 8;
        const bf16x8 v = *(const bf16x8*)(GB + (size_t)n2 * 64 * 128 + cc * 8);
#pragma unroll
        for (int j = 0; j < 8; ++j) Tt[(m0 + j) * ZS + part * 64 + n2] = (bf16_t)v[j]; }
    asm volatile("s_waitcnt lgkmcnt(0)" ::: "memory");
#pragma unroll 2
    for (int kt = 0; kt < 4; ++kt) {
        bf16x8 bb[4];
#pragma unroll
        for (int ks = 0; ks < 4; ++ks) bb[ks] = *(const bf16x8*)(T64B + (size_t)(kt * 16 + l15) * 128 + ks * 32 + 8 * hq);
        const int k2 = kt * 16 + l15; const int row = M_CTX + b * 4096 + k1 + 64 * k2;
#pragma unroll
        for (int mt = 0; mt < 4; ++mt) { f32x4 acc = {0.f, 0.f, 0.f, 0.f};
#pragma unroll
            for (int ks = 0; ks < 4; ++ks) { const bf16x8 a = *(const LAS bf16x8*)(Tt + (mt * 16 + l15) * ZS + ks * 32 + 8 * hq); acc = mma16(a, bb[ks], acc); }
            *(u32x2*)(MIX + (size_t)row * D + 512 + g * 64 + mt * 16 + 4 * hq) = pk4(acc * (1.f / 512.f)); } }
    __syncthreads();
}
constexpr float QSCALE = 0.10206207261596577f * 1.4426950408889634f;
__device__ __forceinline__ void unit_mla_prep(const Ctx& C, int layer, int u) {
    const Params& p = C.p;
    const bf16_t* PROJ = (const bf16_t*)(C.ws + WS_R2);
    bf16_t* Q = (bf16_t*)(C.ws + WS_Q); bf16_t* KN = (bf16_t*)(C.ws + WS_KN); bf16_t* VT = (bf16_t*)(C.ws + WS_VT); bf16_t* KR = (bf16_t*)(C.ws + WS_KR);
    const f32x2* ROPE = (const f32x2*)(C.ws + WS_ROPE);
    constexpr int QS = 200, KS = 136;
    LAS bf16_t* CQ = (LAS bf16_t*)C.lds;
    LAS bf16_t* CK = (LAS bf16_t*)(C.lds + 128 * QS * 2);
    const bool is_tok = u < 192;
    int r0 = 0, keyrow0, keypos0, nk; size_t vtbase; bool lat;
    if (is_tok) { r0 = u * 128; lat = r0 >= M_CTX;
        if (!lat) { keyrow0 = r0; keypos0 = r0 & 255; nk = 256; vtbase = (size_t)(r0 & ~255) * 256; }
        else { const int b = (r0 - M_CTX) >> 12, n = (r0 - M_CTX) & 4095; keyrow0 = M_CTX + b * 4352 + n; keypos0 = n; nk = 4352; vtbase = (size_t)(M_CTX + b * 4352) * 256; } }
    else { const int cu = u - 192, b = cu >> 1, half = cu & 1; lat = true; keyrow0 = M_CTX + b * 4352 + 4096 + half * 128; keypos0 = 4096 + half * 128; nk = 4352; vtbase = (size_t)(M_CTX + b * 4352) * 256; }
    { const int t = C.tid >> 2, sub = C.tid & 3;
      if (is_tok) {
        const int r = r0 + t; const bf16_t* base = PROJ + (size_t)r * NP;
        float q[48], k[32]; float sq = 0.f, sk = 0.f;
#pragma unroll
        for (int i = 0; i < 6; ++i) { const bf16x8 v = *(const bf16x8*)(base + PC_Q + sub * 48 + i * 8);
#pragma unroll
            for (int j = 0; j < 8; ++j) { q[i * 8 + j] = bf1((bf16_t)v[j]); sq += q[i * 8 + j] * q[i * 8 + j]; } }
#pragma unroll
        for (int i = 0; i < 4; ++i) { const bf16x8 v = *(const bf16x8*)(base + PC_KV + sub * 32 + i * 8);
#pragma unroll
            for (int j = 0; j < 8; ++j) { k[i * 8 + j] = bf1((bf16_t)v[j]); sk += k[i * 8 + j] * k[i * 8 + j]; } }
        sq += __shfl_xor(sq, 1); sq += __shfl_xor(sq, 2); sk += __shfl_xor(sk, 1); sk += __shfl_xor(sk, 2);
        const float rq = 1.f / sqrtf(sq * (1.f / 192.f) + EPS), rk = 1.f / sqrtf(sk * (1.f / 128.f) + EPS);
        const float* gq = p.in[I_GQ] + layer * 192 + sub * 48; const float* gk = p.in[I_GKV] + layer * 128 + sub * 32;
#pragma unroll
        for (int i = 0; i < 6; ++i) { u32x4 w; w.x = pk2(q[i * 8 + 0] * rq * gq[i * 8 + 0], q[i * 8 + 1] * rq * gq[i * 8 + 1]); w.y = pk2(q[i * 8 + 2] * rq * gq[i * 8 + 2], q[i * 8 + 3] * rq * gq[i * 8 + 3]);
            w.z = pk2(q[i * 8 + 4] * rq * gq[i * 8 + 4], q[i * 8 + 5] * rq * gq[i * 8 + 5]); w.w = pk2(q[i * 8 + 6] * rq * gq[i * 8 + 6], q[i * 8 + 7] * rq * gq[i * 8 + 7]);
            *(LAS u32x4*)(CQ + t * QS + sub * 48 + i * 8) = w; }
        float* sckv = nullptr;
        if (!lat) { const int s = r >> 8, pos = r & 255; sckv = p.out + OUT_CKV + ((size_t)(s * 4 + layer) * 256 + pos) * 128 + sub * 32; }
#pragma unroll
        for (int i = 0; i < 4; ++i) { float o[8];
#pragma unroll
            for (int j = 0; j < 8; ++j) o[j] = k[i * 8 + j] * rk * gk[i * 8 + j];
            u32x4 w; w.x = pk2(o[0], o[1]); w.y = pk2(o[2], o[3]); w.z = pk2(o[4], o[5]); w.w = pk2(o[6], o[7]);
            *(LAS u32x4*)(CK + t * KS + sub * 32 + i * 8) = w;
            if (!lat) { *(f32x4*)(sckv + i * 8) = (f32x4){o[0], o[1], o[2], o[3]}; *(f32x4*)(sckv + i * 8 + 4) = (f32x4){o[4], o[5], o[6], o[7]}; } }
        { const bf16x8 v = *(const bf16x8*)(base + PC_KR + sub * 8); float x[8], o[8];
#pragma unroll
          for (int j = 0; j < 8; ++j) x[j] = bf1((bf16_t)v[j]);
          if (lat) { const int n = (r - M_CTX) & 4095; const int pos = (sub >> 1) == 0 ? (n >> 6) : (n & 63);
#pragma unroll
              for (int j = 0; j < 8; ++j) { const float pr = __shfl_xor(x[j], 1); const f32x2 cs = ROPE[pos * 8 + j]; o[j] = (sub & 1) == 0 ? x[j] * cs[0] - pr * cs[1] : x[j] * cs[0] + pr * cs[1]; } }
          else {
#pragma unroll
              for (int j = 0; j < 8; ++j) o[j] = x[j];
              const int s = r >> 8, pos = r & 255; float* skr = p.out + OUT_KR + ((size_t)(s * 4 + layer) * 256 + pos) * 32 + sub * 8;
              *(f32x4*)skr = (f32x4){o[0], o[1], o[2], o[3]}; *(f32x4*)(skr + 4) = (f32x4){o[4], o[5], o[6], o[7]}; }
          u32x4 w; w.x = pk2(o[0], o[1]); w.y = pk2(o[2], o[3]); w.z = pk2(o[4], o[5]); w.w = pk2(o[6], o[7]);
          *(u32x4*)(KR + (size_t)(keyrow0 + t) * 32 + sub * 8) = w; }
      } else {
        const int cu = u - 192, b = cu >> 1, half = cu & 1, row = half * 128 + t;
        const float* src = p.in[I_CCKV] + ((size_t)(b * 4 + layer) * 256 + row) * 128 + sub * 32;
#pragma unroll
        for (int i = 0; i < 4; ++i) { const f32x4 v0 = *(const f32x4*)(src + i * 8), v1 = *(const f32x4*)(src + i * 8 + 4);
            u32x4 w; w.x = pk2(v0[0], v0[1]); w.y = pk2(v0[2], v0[3]); w.z = pk2(v1[0], v1[1]); w.w = pk2(v1[2], v1[3]);
            *(LAS u32x4*)(CK + t * KS + sub * 32 + i * 8) = w; }
        const float* ksrc = p.in[I_CKR] + ((size_t)(b * 4 + layer) * 256 + row) * 32 + sub * 8;
        const f32x4 v0 = *(const f32x4*)ksrc, v1 = *(const f32x4*)(ksrc + 4);
        u32x4 w; w.x = pk2(v0[0], v0[1]); w.y = pk2(v0[2], v0[3]); w.z = pk2(v1[0], v1[1]); w.w = pk2(v1[2], v1[3]);
        *(u32x4*)(KR + (size_t)(keyrow0 + t) * 32 + sub * 8) = w;
      } }
    __syncthreads();
    const int l15 = C.lane & 15, hq = C.lane >> 4, w = C.wave;
    if (is_tok) {
        const bf16_t* Wq = (const bf16_t*)(C.wl(layer) + WL_UQ);
        bf16x8 aq[3][6];
#pragma unroll
        for (int j = 0; j < 3; ++j)
#pragma unroll
            for (int ks = 0; ks < 6; ++ks) aq[j][ks] = *(const bf16x8*)(Wq + (size_t)((3 * w + j) * 16 + l15) * 192 + ks * 32 + 8 * hq);
#pragma unroll 2
        for (int tt = 0; tt < 8; ++tt) {
            bf16x8 bq[6];
#pragma unroll
            for (int ks = 0; ks < 6; ++ks) bq[ks] = *(const LAS bf16x8*)(CQ + (tt * 16 + l15) * QS + ks * 32 + 8 * hq);
            const int r = r0 + tt * 16 + l15; const int n = (r - M_CTX) & 4095;
#pragma unroll
            for (int j = 0; j < 3; ++j) { const int nt = 3 * w + j; f32x4 acc = {0.f, 0.f, 0.f, 0.f};
#pragma unroll
                for (int ks = 0; ks < 6; ++ks) acc = mma16(aq[j][ks], bq[ks], acc);
                const int sub6 = nt % 6;
                if (lat && sub6 >= 4) { const int pos = sub6 == 4 ? (n >> 6) : (n & 63);
#pragma unroll
                    for (int jj = 0; jj < 4; ++jj) { const float pr = __shfl_xor(acc[jj], 32); const f32x2 cs = ROPE[pos * 8 + ((4 * hq + jj) & 7)]; acc[jj] = hq < 2 ? acc[jj] * cs[0] - pr * cs[1] : acc[jj] * cs[0] + pr * cs[1]; } }
                *(u32x2*)(Q + (size_t)r * 384 + nt * 16 + 4 * hq) = pk4(acc * QSCALE); }
        }
    }
    { const bf16_t* Wkv = (const bf16_t*)(C.wl(layer) + WL_UKV);
      bf16x8 wf[4][4];
#pragma unroll
      for (int j = 0; j < 4; ++j)
#pragma unroll
          for (int ks = 0; ks < 4; ++ks) wf[j][ks] = *(const bf16x8*)(Wkv + (size_t)((4 * w + j) * 16 + l15) * 128 + ks * 32 + 8 * hq);
      const int h = w >> 1; const bool isv = (w & 1) != 0;
#pragma unroll 2
      for (int tt = 0; tt < 8; ++tt) {
          bf16x8 ck[4];
#pragma unroll
          for (int ks = 0; ks < 4; ++ks) ck[ks] = *(const LAS bf16x8*)(CK + (tt * 16 + l15) * KS + ks * 32 + 8 * hq);
#pragma unroll
          for (int j = 0; j < 4; ++j) { f32x4 acc = {0.f, 0.f, 0.f, 0.f};
              if (!isv) {
#pragma unroll
                  for (int ks = 0; ks < 4; ++ks) acc = mma16(wf[j][ks], ck[ks], acc);
                  *(u32x2*)(KN + (size_t)(keyrow0 + tt * 16 + l15) * 256 + h * 64 + j * 16 + 4 * hq) = pk4(acc);
              } else {
#pragma unroll
                  for (int ks = 0; ks < 4; ++ks) acc = mma16(ck[ks], wf[j][ks], acc);
                  *(u32x2*)(VT + vtbase + (size_t)(h * 64 + j * 16 + l15) * nk + keypos0 + tt * 16 + 4 * hq) = pk4(acc);
              } } } }
    __syncthreads();
}

constexpr int AKS = 104, AVS = 72;
constexpr int ABUF = 64 * AKS * 2 + 64 * AVS * 2;
__device__ __forceinline__ int imax3(int a, int b, int c) { return max(a, max(b, c)); }
__device__ __forceinline__ void unit_attention(const Ctx& C, int u) {
    int rowbase, keyrow0, nk, h; size_t vtbase;
    if (u < 128) { const int s = u >> 2; h = u & 3; rowbase = s * 256; keyrow0 = s * 256; nk = 256; vtbase = (size_t)(s * 256) * 256; }
    else { const int v0 = u - 128; const int v = (C.G == 256) ? (((v0 & 7) * 2 + (v0 >> 7)) << 4) | ((v0 >> 3) & 15) : v0;
           const int b = v >> 6, qb = v & 15; h = (v >> 4) & 3; rowbase = M_CTX + b * 4096 + qb * 256; keyrow0 = M_CTX + b * 4352; nk = 4352; vtbase = (size_t)keyrow0 * 256; }
    const bf16_t* Q = (const bf16_t*)(C.ws + WS_Q); const bf16_t* KN = (const bf16_t*)(C.ws + WS_KN); const bf16_t* VT = (const bf16_t*)(C.ws + WS_VT); const bf16_t* KR = (const bf16_t*)(C.ws + WS_KR);
    bf16_t* MIX = (bf16_t*)(C.ws + WS_R1);
    const int l31 = C.lane & 31, hh = C.lane >> 5; const int qrow = rowbase + C.wave * 32 + l31;
    bf16x8 qf[6];
#pragma unroll
    for (int ks = 0; ks < 6; ++ks) qf[ks] = *(const bf16x8*)(Q + (size_t)qrow * 384 + h * 96 + ks * 16 + 8 * hh);
    f32x16 o0, o1, o2, negm;
#pragma unroll
    for (int i = 0; i < 16; ++i) { o0[i] = 0.f; o1[i] = 0.f; o2[i] = 0.f; negm[i] = 0.f; }
    const unsigned onew = (l31 == 0) ? 0x3F803F80u : 0u;
    const bf16x8 onesf = __builtin_bit_cast(bf16x8, (u32x4){onew, onew, onew, onew});
    const int skey = C.tid >> 3, sc8 = (C.tid & 7) * 8, rkey = (C.tid & 255) >> 2, rc8 = (C.tid & 3) * 8;
    const bf16_t* gkn = KN + (size_t)(keyrow0 + skey) * 256 + h * 64 + sc8;
    const bf16_t* gkr = KR + (size_t)(keyrow0 + rkey) * 32 + rc8;
    const bf16_t* gvt = VT + vtbase + (size_t)(h * 64 + skey) * nk + sc8;
    const bool do_r = C.tid < 256;
    const int lkn = (skey * AKS + sc8) * 2, lkr = (rkey * AKS + 64 + rc8) * 2, lvt = 64 * AKS * 2 + (skey * AVS + sc8) * 2;
    const int ntile = nk >> 6;
    u32x4 rk = *(const u32x4*)gkn, rr = do_r ? *(const u32x4*)gkr : (u32x4){0u, 0u, 0u, 0u}, rv = *(const u32x4*)gvt;
    *(LAS u32x4*)(C.lds + lkn) = rk; if (do_r) *(LAS u32x4*)(C.lds + lkr) = rr; *(LAS u32x4*)(C.lds + lvt) = rv;
    __syncthreads();
#pragma unroll 1
    for (int kt = 0; kt < ntile; ++kt) {
        const bool more = kt + 1 < ntile;
        if (more) { rk = *(const u32x4*)(gkn + (size_t)(kt + 1) * 64 * 256); if (do_r) rr = *(const u32x4*)(gkr + (size_t)(kt + 1) * 64 * 32); rv = *(const u32x4*)(gvt + (kt + 1) * 64); }
        LAS unsigned char* B = C.lds + (kt & 1) * ABUF;
        const LAS bf16_t* Kl = (const LAS bf16_t*)B; const LAS bf16_t* Vl = (const LAS bf16_t*)(B + 64 * AKS * 2);
        bf16x8 ka[2][6];
#pragma unroll
        for (int ks = 0; ks < 6; ++ks) { ka[0][ks] = *(const LAS bf16x8*)(Kl + l31 * AKS + ks * 16 + 8 * hh); ka[1][ks] = *(const LAS bf16x8*)(Kl + (32 + l31) * AKS + ks * 16 + 8 * hh); }
        __builtin_amdgcn_sched_barrier(0);
        f32x16 s0 = mma32(ka[0][0], qf[0], negm), s1 = mma32(ka[1][0], qf[0], negm);
#pragma unroll
        for (int ks = 1; ks < 6; ++ks) { s0 = mma32(ka[0][ks], qf[ks], s0); s1 = mma32(ka[1][ks], qf[ks], s1); }
        __builtin_amdgcn_sched_barrier(0);
        u32x2 vr[2][2][4];
#pragma unroll
        for (int t = 0; t < 2; ++t)
#pragma unroll
            for (int ss = 0; ss < 2; ++ss) { const int ko = 32 * t + 16 * ss + 4 * hh;
                vr[t][ss][0] = *(const LAS u32x2*)(Vl + l31 * AVS + ko); vr[t][ss][1] = *(const LAS u32x2*)(Vl + l31 * AVS + ko + 8);
                vr[t][ss][2] = *(const LAS u32x2*)(Vl + (32 + l31) * AVS + ko); vr[t][ss][3] = *(const LAS u32x2*)(Vl + (32 + l31) * AVS + ko + 8); }
        __builtin_amdgcn_sched_barrier(0);
        float d; bool resc;
        if (kt == 0) {
            float mx = fmaxf(s0[0], s1[0]);
#pragma unroll
            for (int i = 1; i < 16; ++i) mx = fmaxf(mx, fmaxf(s0[i], s1[i]));
            d = fmaxf(mx, __shfl_xor(mx, 32)); resc = true;
        } else {
            int im = imax3(__builtin_bit_cast(int, s0[0]), __builtin_bit_cast(int, s1[0]), __builtin_bit_cast(int, s0[1]));
            im = imax3(im, __builtin_bit_cast(int, s1[1]), __builtin_bit_cast(int, s0[2])); im = imax3(im, __builtin_bit_cast(int, s1[2]), __builtin_bit_cast(int, s0[3]));
            im = imax3(im, __builtin_bit_cast(int, s1[3]), __builtin_bit_cast(int, s0[4])); im = imax3(im, __builtin_bit_cast(int, s1[4]), __builtin_bit_cast(int, s0[5]));
            im = imax3(im, __builtin_bit_cast(int, s1[5]), __builtin_bit_cast(int, s0[6])); im = imax3(im, __builtin_bit_cast(int, s1[6]), __builtin_bit_cast(int, s0[7]));
            im = imax3(im, __builtin_bit_cast(int, s1[7]), __builtin_bit_cast(int, s0[8])); im = imax3(im, __builtin_bit_cast(int, s1[8]), __builtin_bit_cast(int, s0[9]));
            im = imax3(im, __builtin_bit_cast(int, s1[9]), __builtin_bit_cast(int, s0[10])); im = imax3(im, __builtin_bit_cast(int, s1[10]), __builtin_bit_cast(int, s0[11]));
            im = imax3(im, __builtin_bit_cast(int, s1[11]), __builtin_bit_cast(int, s0[12])); im = imax3(im, __builtin_bit_cast(int, s1[12]), __builtin_bit_cast(int, s0[13]));
            im = imax3(im, __builtin_bit_cast(int, s1[13]), __builtin_bit_cast(int, s0[14])); im = imax3(im, __builtin_bit_cast(int, s1[14]), __builtin_bit_cast(int, s0[15]));
            im = max(im, __builtin_bit_cast(int, s1[15]));
            im = max(im, __shfl_xor(im, 32));
            resc = __builtin_amdgcn_ballot_w64(im > 0x41000000) != 0ull; d = im > 0x41000000 ? __builtin_bit_cast(float, im) : 0.f;
        }
        if (resc) {
            if (kt != 0) { const float alpha = __builtin_amdgcn_exp2f(-d); o0 = o0 * alpha; o1 = o1 * alpha; o2 = o2 * alpha; }
            negm = negm - d; s0 = s0 - d; s1 = s1 - d;
        }
#pragma unroll
        for (int i = 0; i < 16; ++i) { s0[i] = __builtin_amdgcn_exp2f(s0[i]); s1[i] = __builtin_amdgcn_exp2f(s1[i]); }
#pragma unroll
        for (int t = 0; t < 2; ++t)
#pragma unroll
            for (int ss = 0; ss < 2; ++ss) {
                u32x4 w;
                if (t == 0) { w.x = pk2(s0[8 * ss + 0], s0[8 * ss + 1]); w.y = pk2(s0[8 * ss + 2], s0[8 * ss + 3]); w.z = pk2(s0[8 * ss + 4], s0[8 * ss + 5]); w.w = pk2(s0[8 * ss + 6], s0[8 * ss + 7]); }
                else { w.x = pk2(s1[8 * ss + 0], s1[8 * ss + 1]); w.y = pk2(s1[8 * ss + 2], s1[8 * ss + 3]); w.z = pk2(s1[8 * ss + 4], s1[8 * ss + 5]); w.w = pk2(s1[8 * ss + 6], s1[8 * ss + 7]); }
                const bf16x8 pf = __builtin_bit_cast(bf16x8, w);
                const bf16x8 va = __builtin_bit_cast(bf16x8, (u32x4){vr[t][ss][0].x, vr[t][ss][0].y, vr[t][ss][1].x, vr[t][ss][1].y}), vb = __builtin_bit_cast(bf16x8, (u32x4){vr[t][ss][2].x, vr[t][ss][2].y, vr[t][ss][3].x, vr[t][ss][3].y});
                o0 = mma32(va, pf, o0); o1 = mma32(vb, pf, o1); o2 = mma32(onesf, pf, o2);
            }
        if (more) { LAS unsigned char* Bn = C.lds + ((kt + 1) & 1) * ABUF; *(LAS u32x4*)(Bn + lkn) = rk; if (do_r) *(LAS u32x4*)(Bn + lkr) = rr; *(LAS u32x4*)(Bn + lvt) = rv; }
        __syncthreads();
    }
    const float lsum = o2[0] + __shfl_xor(o2[0], 32);
    const float inv = 1.f / lsum;
    bf16_t* orow = MIX + (size_t)qrow * D + 768 + h * 64;
#pragma unroll
    for (int i = 0; i < 4; ++i) { const int dv = 8 * i + 4 * hh;
        *(u32x2*)(orow + dv) = pk4((f32x4){o0[4 * i] * inv, o0[4 * i + 1] * inv, o0[4 * i + 2] * inv, o0[4 * i + 3] * inv});
        *(u32x2*)(orow + 32 + dv) = pk4((f32x4){o1[4 * i] * inv, o1[4 * i + 1] * inv, o1[4 * i + 2] * inv, o1[4 * i + 3] * inv}); }
}

#define XB_TMO      128
#define XB_XCNT(j)  (256  + 64 * (j))
#define XB_XSUB(j)  (1280 + 64 * (j))
#define XB_XGEN(j)  (2304 + 64 * (j))
#define XB_TOP      3328
#define XB_TOPGEN   3392
#define XCD_BAR_WORDS 3456
#define XB_SPIN_CAP (1u << 18)

__device__ __forceinline__ unsigned xb_ld(unsigned* p)              { return __hip_atomic_load(p, __ATOMIC_RELAXED, __HIP_MEMORY_SCOPE_AGENT); }
__device__ __forceinline__ unsigned xb_add(unsigned* p, unsigned v) { return __hip_atomic_fetch_add(p, v, __ATOMIC_RELAXED, __HIP_MEMORY_SCOPE_AGENT); }
__device__ __forceinline__ unsigned xb_xcc_id() { return (unsigned)__builtin_amdgcn_s_getreg((3 << 11) | 20) & 0xFu; }
#define XB_SPIN(cond, bar) do { unsigned _sp = 0; while (cond) { __builtin_amdgcn_s_sleep(1); \
    if ((++_sp & 255u) == 0u) { if (xb_ld(&(bar)[XB_TMO])) break; if (_sp > XB_SPIN_CAP) { atomicAdd(&(bar)[XB_TMO], 1u); break; } } } } while (0)

struct XcdBarrier {
    unsigned* bar; unsigned x;
    volatile LAS unsigned* st;
};

__device__ __forceinline__ XcdBarrier xcd_barrier_post(unsigned* bar, volatile LAS unsigned* st) {
    XcdBarrier b; b.bar = bar; b.x = xb_xcc_id(); b.st = st;
    if (threadIdx.x == 0) (void)xb_add(&bar[XB_XCNT(b.x)], 1u);
    return b;
}
__device__ __forceinline__ void xcd_barrier_complete(unsigned* bar, unsigned x, unsigned& nloc, unsigned& nx) {
    const unsigned G = gridDim.x * gridDim.y * gridDim.z;
    unsigned sum, cnt, mine, sp = 0u;
    for (;;) {
        sum = 0u; cnt = 0u; mine = 0u;
#pragma unroll
        for (unsigned j = 0; j < 16; ++j) { const unsigned c = xb_ld(&bar[XB_XCNT(j)]); sum += c; cnt += (c > 0u) ? 1u : 0u; mine = (j == x) ? c : mine; }
        if (sum == G) break;
        __builtin_amdgcn_s_sleep(1);
        if ((++sp & 255u) == 0u) { if (xb_ld(&bar[XB_TMO])) break; if (sp > XB_SPIN_CAP) { atomicAdd(&bar[XB_TMO], 1u); break; } }
    }
    nloc = mine > 0u ? mine : 1u; nx = cnt > 0u ? cnt : 1u;
}

__device__ __forceinline__ void xcd_barrier(const XcdBarrier& b) {
    asm volatile("s_waitcnt vmcnt(0)" ::: "memory");
    __syncthreads();
    if (threadIdx.x == 0) {
        unsigned* bar = b.bar;
        __builtin_amdgcn_s_waitcnt(0);
        unsigned nloc = b.st[0], nx = b.st[1];
        if (nloc == 0u) { xcd_barrier_complete(bar, b.x, nloc, nx); b.st[0] = nloc; b.st[1] = nx; }
        const unsigned old = xb_add(&bar[XB_XSUB(b.x)], 1u);
        const unsigned gen = old / nloc;
        if (old + 1u == (gen + 1u) * nloc) {
            __builtin_amdgcn_fence(__ATOMIC_RELEASE, "agent");
            asm volatile("s_waitcnt vmcnt(0)" ::: "memory");
            const unsigned og = xb_add(&bar[XB_TOP], 1u);
            const unsigned tg = og / nx;
            if (og + 1u == (tg + 1u) * nx) xb_add(&bar[XB_TOPGEN], 1u);
            else XB_SPIN(xb_ld(&bar[XB_TOPGEN]) == tg, bar);
            __builtin_amdgcn_fence(__ATOMIC_ACQUIRE, "agent");
            xb_add(&bar[XB_XGEN(b.x)], 1u);
            asm volatile("s_waitcnt vmcnt(0)" ::: "memory");
        } else {
            XB_SPIN(xb_ld(&bar[XB_XGEN(b.x)]) == gen, bar);
            __builtin_amdgcn_fence(__ATOMIC_ACQUIRE, "agent");
            asm volatile("s_waitcnt vmcnt(0)" ::: "memory");
        }
    }
    __syncthreads();
}

__global__ void __launch_bounds__(NTHREADS, 2) mk_fwd(Params p) {
    extern __shared__ __attribute__((aligned(16))) unsigned char lds_raw[];
    cg::grid_group grid = cg::this_grid();
    Ctx C; C.p = p; C.lds = (LAS unsigned char*)lds_raw; C.tid = threadIdx.x; C.lane = C.tid & 63; C.wave = __builtin_amdgcn_readfirstlane(C.tid >> 6); C.bid = blockIdx.x; C.G = gridDim.x; C.ws = p.ws;

    volatile LAS unsigned* bst = (volatile LAS unsigned*)(C.lds + LDS_BYTES - 64);
    if (threadIdx.x < 2) bst[threadIdx.x] = 0u;
    __syncthreads();
    const XcdBarrier bar = xcd_barrier_post((unsigned*)(p.ws + WS_BAR), bst);
    C.refresh(); phase_prologue(C);
    grid.sync();
    C.refresh(); phase_norm0(C);
    xcd_barrier(bar);
#pragma unroll 1
    for (int layer = 0; layer < DEPTH; ++layer) {
        { C.refresh(); bf16_t* R1 = (bf16_t*)(C.ws + WS_R1); bf16_t* R2 = (bf16_t*)(C.ws + WS_R2); unsigned char* wl = C.wl(layer); pg8::Gemm g{R1, (const bf16_t*)(wl + WL_IN), M, NPP, D}; pg8::StaticOrder S; S.init(M, NPP, C.G, C.bid); pg8::EpiStore E{R2, NP, NP};
          pg8::gemm_phase<pg8::EpiStore, pg8::StaticOrder, true, true>(C.lds, g, S, E); }
        xcd_barrier(bar);
        C.refresh();
        for (int u = C.bid; u < 768 + 192 + 128 + 128 + 200; u += C.G) {
            C.refresh();
            if (u < 768) unit_chunk_mlp(C, layer, u);
            else if (u < 960) unit_conv(C, layer, u - 768);
            else if (u < 1088) unit_fourier_ctx(C, u - 960);
            else if (u < 1216) unit_fourier_lat1(C, u - 1088);
            else unit_mla_prep(C, layer, u - 1216);
        }
        xcd_barrier(bar);
        C.refresh();
        for (int u = C.bid; u < 512; u += C.G) {
            C.refresh();
            if (u < 256) unit_attention(C, 128 + u);
            else if (u < 384) unit_attention(C, u - 256);
            else unit_fourier_lat2(C, u - 384);
        }
        xcd_barrier(bar);
        { C.refresh(); bf16_t* R1 = (bf16_t*)(C.ws + WS_R1); bf16_t* R2 = (bf16_t*)(C.ws + WS_R2); unsigned char* wl = C.wl(layer); pg8::Gemm g{R1, (const bf16_t*)(wl + WL_OUT), M, D, D}; pg8::SplitTailOrder S; S.init(D, C.G, C.bid); pg8::EpiStoreSplit E{R2, R2 + (size_t)M * D - (size_t)SPLIT_ROW0 * D, D};
          pg8::gemm_phase<pg8::EpiStoreSplit, pg8::SplitTailOrder, true, true>(C.lds, g, S, E); }
        xcd_barrier(bar);
        C.refresh(); phase_post<0>(C, layer);
        xcd_barrier(bar);
        { C.refresh(); bf16_t* R1 = (bf16_t*)(C.ws + WS_R1); bf16_t* R2 = (bf16_t*)(C.ws + WS_R2); unsigned char* wl = C.wl(layer); pg8::Gemm g{R1, (const bf16_t*)(wl + WL_GU), M, 2 * FF, D}; pg8::StaticOrder S; S.init(M, 2 * FF, C.G, C.bid); pg8::EpiSwiGLU E{R2, FF};
          pg8::gemm_phase<pg8::EpiSwiGLU, pg8::StaticOrder, true, true>(C.lds, g, S, E);
          if (C.G == 256 && layer + 1 < DEPTH && C.bid >= 64) { C.refresh(); transpose_items(C, (layer + 1) * TI_L + (C.bid - 64), 192, (layer + 2) * TI_L); } }
        xcd_barrier(bar);
        { C.refresh(); bf16_t* R2 = (bf16_t*)(C.ws + WS_R2); bf16_t* R3 = (bf16_t*)(C.ws + WS_MLA); unsigned char* wl = C.wl(layer); pg8::Gemm g{R2, (const bf16_t*)(wl + WL_DN), M, D, FF}; pg8::SplitTailOrder S; S.init(FF, C.G, C.bid); pg8::EpiStoreSplit E{R3, R3 + (size_t)M * D - (size_t)SPLIT_ROW0 * D, D};
          pg8::gemm_phase<pg8::EpiStoreSplit, pg8::SplitTailOrder, true, true>(C.lds, g, S, E); }
        xcd_barrier(bar);
        C.refresh(); phase_post<1>(C, layer);
        if (layer + 1 < DEPTH) xcd_barrier(bar);
    }
}

extern "C" void kernel_launch(void* const* d_in, const int* in_sizes, int n_in, void* d_out, int out_size, void* d_ws, size_t ws_size, hipStream_t stream) {
    static int grid = 0;
    if (grid == 0) {
        if (n_in != 24 || ws_size < WS_END) { fprintf(stderr, "kernel_launch: need 24 inputs and %zu bytes of workspace; got %d, %zu\n", (size_t)WS_END, n_in, ws_size); grid = -1; return; }
        int dev = 0, cus = 0, per_cu = 0;
        if (hipGetDevice(&dev) != hipSuccess || hipDeviceGetAttribute(&cus, hipDeviceAttributeMultiprocessorCount, dev) != hipSuccess) { grid = -1; return; }
        if (hipFuncSetAttribute((const void*)mk_fwd, hipFuncAttributeMaxDynamicSharedMemorySize, LDS_BYTES) != hipSuccess) { fprintf(stderr, "kernel_launch: hipFuncSetAttribute failed\n"); grid = -1; return; }
        if (hipOccupancyMaxActiveBlocksPerMultiprocessor(&per_cu, (const void*)mk_fwd, NTHREADS, LDS_BYTES) != hipSuccess || per_cu < 1) fprintf(stderr, "kernel_launch: occupancy query says %d blocks per CU\n", per_cu);
        (void)hipGetLastError();
        grid = cus;
    }
    if (grid < 0) return;
    Params p{};
    for (int i = 0; i < 24; ++i) p.in[i] = (const float*)d_in[i];
    p.out = (float*)d_out; p.ws = (unsigned char*)d_ws;
    if (hipMemsetAsync((char*)d_ws + WS_BAR, 0, WS_BAR_BYTES, stream) != hipSuccess) { fprintf(stderr, "kernel_launch: memset failed\n"); return; }
    void* args[] = {&p};
    hipError_t e = hipLaunchCooperativeKernel((const void*)mk_fwd, dim3(grid), dim3(NTHREADS), args, LDS_BYTES, stream);
    if (e != hipSuccess) fprintf(stderr, "kernel_launch: cooperative launch failed: %s (grid %d)\n", hipGetErrorString(e), grid);
}
```

```cpp
#include <hip/hip_runtime.h>
#include <hip/hip_cooperative_groups.h>
#include <cstdio>
#include <cstdint>
namespace cg = cooperative_groups;
namespace pg8 {
#define PG8_LAS __attribute__((address_space(3)))
typedef unsigned short bf16_t;
typedef short bf16x8 __attribute__((ext_vector_type(8)));
typedef float f32x4 __attribute__((ext_vector_type(4)));
typedef unsigned u32x4 __attribute__((ext_vector_type(4)));
constexpr int BM = 256, BK = 64, HALF = 128, HTB = HALF * BK * 2  , STAGE_BYTES = 8 * HTB, NXCD = 8, WGM = 8;

__host__ __device__ __forceinline__ int lds_byte(int r, int c) { const int st = (r >> 4) * 2 + (c >> 5), rr = r & 15, cc = c & 31, ob = rr * 64 + cc * 2; return st * 1024 + (ob ^ (((ob >> 9) & 1) << 5)); }
__host__ __device__ __forceinline__ void stage_rc(int b, int& R, int& C) { const int st = b / 1024, sb = b % 1024, swz = sb ^ (((sb >> 9) & 1) << 5); R = (st >> 1) * 16 + swz / 64; C = (st & 1) * 32 + (swz % 64) / 2; }
__host__ __device__ __forceinline__ int perm32(int rho) { const int n = rho >> 4, i = rho & 15; return 8 * (i >> 2) + 4 * n + (i & 3); }

struct Unit { int pm, pn; int kh, nt, koff; };
struct Gemm { const bf16_t* A; const bf16_t* Bt; int M, N, K; };

struct StaticOrder {
    int nM, nN, nwg, G, c;
    __host__ __device__ void init(int M, int N, int G_, int c_) { nM = M / BM; nN = N / BM; nwg = nM * nN; G = G_; c = c_; }
    __host__ __device__ bool next(int i, Unit& u) const {
        const long L = (long)i * G + c; if (L >= nwg) return false;
        int wgid = (int)L; { const int q = nwg / NXCD, r = nwg % NXCD, xcd = wgid % NXCD, off = wgid / NXCD; wgid = (xcd < r ? xcd * (q + 1) : r * (q + 1) + (xcd - r) * q) + off; }
        const int nig = WGM * nN, gid = wgid / nig, fm = gid * WGM, gsz = (nM - fm) < WGM ? (nM - fm) : WGM;
        u.pm = fm + ((wgid % nig) % gsz); u.pn = (wgid % nig) / gsz; u.kh = 0; u.nt = 0; u.koff = 0; return true;
    }
    __device__ __forceinline__ void a_ready(const Unit&) const {}
    __device__ __forceinline__ void done(const Unit&) const {}
};

__device__ __forceinline__ unsigned cvt_pk_bf16(float lo, float hi) { unsigned r; asm volatile("v_cvt_pk_bf16_f32 %0, %1, %2" : "=v"(r) : "v"(lo), "v"(hi)); return r; }
typedef float f32x2 __attribute__((ext_vector_type(2)));
struct EpiStore {
    static constexpr bool PERM = true, AFTER_DRAIN = false;
    bf16_t* O; int ldc; int ncols;
    __device__ __forceinline__ void operator()(const f32x4 (&acc)[2][2][4][2], const Unit& u, int wr, int wc, int fr, int fq) const {
        const int row0 = u.pm * BM + wr * 64 + fr; const int col0 = u.pn * BM + wc * 32 + 8 * fq;
#pragma unroll
        for (int ai = 0; ai < 2; ++ai)
#pragma unroll
            for (int m = 0; m < 4; ++m) { bf16_t* rowp = O + (size_t)(row0 + ai * HALF + m * 16) * ldc + col0;
#pragma unroll
                for (int bj = 0; bj < 2; ++bj) { const f32x4 v0 = acc[ai][bj][m][0], v1 = acc[ai][bj][m][1];
                    u32x4 w; w.x = cvt_pk_bf16(v0[0], v0[1]); w.y = cvt_pk_bf16(v0[2], v0[3]); w.z = cvt_pk_bf16(v1[0], v1[1]); w.w = cvt_pk_bf16(v1[2], v1[3]);
                    if (col0 + bj * HALF < ncols) *(u32x4*)(rowp + bj * HALF) = w; } }
    }
};
struct EpiStoreWT {
    static constexpr bool PERM = true, AFTER_DRAIN = false;
    bf16_t* O; int ldc; int ncols;
    __device__ __forceinline__ void operator()(const f32x4 (&acc)[2][2][4][2], const Unit& u, int wr, int wc, int fr, int fq) const {
        const int row0 = u.pm * BM + wr * 64 + fr; const int col0 = u.pn * BM + wc * 32 + 8 * fq;
#pragma unroll
        for (int ai = 0; ai < 2; ++ai)
#pragma unroll
            for (int m = 0; m < 4; ++m) { bf16_t* rowp = O + (size_t)(row0 + ai * HALF + m * 16) * ldc + col0;
#pragma unroll
                for (int bj = 0; bj < 2; ++bj) { const f32x4 v0 = acc[ai][bj][m][0], v1 = acc[ai][bj][m][1];
                    const unsigned long long lo = (unsigned long long)cvt_pk_bf16(v0[0], v0[1]) | ((unsigned long long)cvt_pk_bf16(v0[2], v0[3]) << 32);
                    const unsigned long long hi = (unsigned long long)cvt_pk_bf16(v1[0], v1[1]) | ((unsigned long long)cvt_pk_bf16(v1[2], v1[3]) << 32);
                    unsigned long long* q = (unsigned long long*)(rowp + bj * HALF);
                    __hip_atomic_store(q, lo, __ATOMIC_RELAXED, __HIP_MEMORY_SCOPE_AGENT); __hip_atomic_store(q + 1, hi, __ATOMIC_RELAXED, __HIP_MEMORY_SCOPE_AGENT); } }
    }
};
__device__ __forceinline__ float silu_mul(float g, float u) { return g * u * __builtin_amdgcn_rcpf(1.f + __expf(-g)); }
struct EpiSwiGLU {
    static constexpr bool PERM = true, AFTER_DRAIN = false;
    bf16_t* O; int ldc;
    __device__ __forceinline__ void operator()(const f32x4 (&acc)[2][2][4][2], const Unit& u, int wr, int wc, int fr, int fq) const {
        const int row0 = u.pm * BM + wr * 64 + fr; const int col0 = u.pn * HALF + wc * 32 + 8 * fq;
#pragma unroll
        for (int ai = 0; ai < 2; ++ai)
#pragma unroll
            for (int m = 0; m < 4; ++m) { bf16_t* rowp = O + (size_t)(row0 + ai * HALF + m * 16) * ldc + col0;
                const f32x4 g0 = acc[ai][0][m][0], g1 = acc[ai][0][m][1], u0 = acc[ai][1][m][0], u1 = acc[ai][1][m][1];
                u32x4 w; w.x = cvt_pk_bf16(silu_mul(g0[0], u0[0]), silu_mul(g0[1], u0[1])); w.y = cvt_pk_bf16(silu_mul(g0[2], u0[2]), silu_mul(g0[3], u0[3]));
                w.z = cvt_pk_bf16(silu_mul(g1[0], u1[0]), silu_mul(g1[1], u1[1])); w.w = cvt_pk_bf16(silu_mul(g1[2], u1[2]), silu_mul(g1[3], u1[3]));
                *(u32x4*)rowp = w; }
    }
};

struct PanelOrder {
    int nN, nwg, G, c; unsigned* cnt;
    __device__ void init(int M, int N, int G_, int c_, unsigned* cnt_) { nN = N / BM; nwg = (M / BM) * nN; G = G_; c = c_; cnt = cnt_; }
    __device__ bool next(int i, Unit& u) const { const long L = (long)i * G + c; if (L >= nwg) return false; u.pm = (int)L / nN; u.pn = (int)L % nN; u.kh = 0; u.nt = 0; u.koff = 0; return true; }
    __device__ __forceinline__ void a_ready(const Unit&) const {}
    __device__ __forceinline__ void done(const Unit& u) const {
        asm volatile("s_waitcnt vmcnt(0)" ::: "memory");
        if ((threadIdx.x & 63) == 0) __hip_atomic_fetch_add(cnt + u.pm, 1u, __ATOMIC_RELAXED, __HIP_MEMORY_SCOPE_AGENT);
    }
};

struct SplitTailOrder {
    int G, c, ntf; bool split;
    __device__ void init(int K, int G_, int c_) { G = G_; c = c_; ntf = K / BK; split = (G_ == 256); }
    __device__ bool next(int i, Unit& u) const {
        if (!split) { const long L = (long)i * G + c; if (L >= 384) return false; u.pm = (int)L >> 2; u.pn = (int)L & 3; u.kh = 0; u.nt = 0; u.koff = 0; return true; }
        if (i == 0) { const int t = (c & 7) * 32 + (c >> 3); u.pm = t >> 2; u.pn = t & 3; u.kh = 0; u.nt = 0; u.koff = 0; return true; }
        if (i == 1) { const int t = 256 + (c & 7) * 16 + (c >> 4); u.pm = t >> 2; u.pn = t & 3; u.kh = (c >> 3) & 1; u.nt = ntf / 2; u.koff = u.kh * (ntf / 2) * BK * 2; return true; }
        return false;
    }
    __device__ __forceinline__ void a_ready(const Unit&) const {}
    __device__ __forceinline__ void done(const Unit&) const {}
};
struct EpiStoreSplit {
    static constexpr bool PERM = true, AFTER_DRAIN = false;
    bf16_t* O; bf16_t* O1; int ldc;
    __device__ __forceinline__ void operator()(const f32x4 (&acc)[2][2][4][2], const Unit& u, int wr, int wc, int fr, int fq) const {
        const int row0 = u.pm * BM + wr * 64 + fr; const int col0 = u.pn * BM + wc * 32 + 8 * fq; bf16_t* base = u.kh ? O1 : O;
#pragma unroll
        for (int ai = 0; ai < 2; ++ai)
#pragma unroll
            for (int m = 0; m < 4; ++m) { bf16_t* rowp = base + (size_t)(row0 + ai * HALF + m * 16) * ldc + col0;
#pragma unroll
                for (int bj = 0; bj < 2; ++bj) { const f32x4 v0 = acc[ai][bj][m][0], v1 = acc[ai][bj][m][1];
                    u32x4 w; w.x = cvt_pk_bf16(v0[0], v0[1]); w.y = cvt_pk_bf16(v0[2], v0[3]); w.z = cvt_pk_bf16(v1[0], v1[1]); w.w = cvt_pk_bf16(v1[2], v1[3]);
                    *(u32x4*)(rowp + bj * HALF) = w; } }
    }
};
template <class Epi, class Sched, bool ALIGN_EPI = false, bool SP2 = false>
__device__ __forceinline__ void gemm_phase(PG8_LAS unsigned char* lds, const Gemm g, const Sched& S, const Epi& E) {
    int tid_ = threadIdx.x; asm volatile("" : "+v"(tid_));
    const int tid = tid_, wid = __builtin_amdgcn_readfirstlane(tid >> 6), lane = tid & 63, wr = wid >> 2, wc = wid & 3, fr = lane & 15, fq = lane >> 4;
    const int K = g.K, nt = K / BK;
    unsigned voffA[2], voffB[2];
#pragma unroll
    for (int i = 0; i < 2; ++i) { int R, C; stage_rc(tid * 16 + i * 8192, R, C); const int Rb = Epi::PERM ? ((R & ~31) + perm32(R & 31)) : R;
        voffA[i] = (unsigned)(R * K + C) * 2u; voffB[i] = (unsigned)(Rb * K + C) * 2u; }
    const size_t kstep = (size_t)(BK * 2);
    const size_t hstep = (size_t)HALF * K * 2;
    const size_t tstep = 2 * hstep;
    const unsigned ldsw = (unsigned)wid * 1024u;
    const int aoff = lds_byte(wr * 64 + fr, fq * 8), boff = lds_byte(wc * 32 + fr, fq * 8);
#define PG8_SA(b, h) (((b) * 2 + (h)) * HTB)
#define PG8_SB(b, h) ((4 + (b) * 2 + (h)) * HTB)
#define PG8_STAGE(bufoff, gbase, voff) do { _Pragma("unroll") for (int _i = 0; _i < 2; ++_i) \
        __builtin_amdgcn_global_load_lds((const unsigned*)((const char*)(gbase) + (voff)[_i]), (PG8_LAS unsigned*)(lds + (bufoff) + ldsw + _i * 8192), 16, 0, 0); } while (0)
#define PG8_LDA(dst, b, h) do { _Pragma("unroll") for (int m = 0; m < 4; ++m) _Pragma("unroll") for (int k = 0; k < 2; ++k) dst[m][k] = *(const PG8_LAS bf16x8*)(lds + PG8_SA(b, h) + aoff + m * 2048 + k * 1024); } while (0)
#define PG8_LDB(dst, b, h) do { _Pragma("unroll") for (int n = 0; n < 2; ++n) _Pragma("unroll") for (int k = 0; k < 2; ++k) dst[n][k] = *(const PG8_LAS bf16x8*)(lds + PG8_SB(b, h) + boff + n * 2048 + k * 1024); } while (0)
#define PG8_MMA(ai, bj, At, Bt) do { __builtin_amdgcn_s_setprio(1); _Pragma("unroll") for (int m = 0; m < 4; ++m) _Pragma("unroll") for (int n = 0; n < 2; ++n) _Pragma("unroll") for (int k = 0; k < 2; ++k) \
        acc[ai][bj][m][n] = __builtin_amdgcn_mfma_f32_16x16x32_bf16(Bt[n][k], At[m][k], acc[ai][bj][m][n], 0, 0, 0); __builtin_amdgcn_s_setprio(0); } while (0)
#define PG8_WAIT_V(n) asm volatile("s_waitcnt vmcnt(" #n ")" ::: "memory")
#define PG8_WAIT_L(n) asm volatile("s_waitcnt lgkmcnt(" #n ")" ::: "memory")
#define PG8_BAR __builtin_amdgcn_s_barrier()
#define PG8_SCHED __builtin_amdgcn_sched_barrier(0)
    Unit cur, nxt; int ui = 0;
    if (!S.next(0, cur)) return;
    f32x4 acc[2][2][4][2];
#pragma unroll
    for (int a = 0; a < 2; ++a)
#pragma unroll
        for (int b = 0; b < 2; ++b)
#pragma unroll
            for (int m = 0; m < 4; ++m)
#pragma unroll
                for (int n = 0; n < 2; ++n) acc[a][b][m][n] = (f32x4){0.f, 0.f, 0.f, 0.f};
    bf16x8 At[4][2], B0[2][2], B1[2][2];
    const char* cA = (const char*)g.A + (size_t)cur.pm * tstep + cur.koff; const char* cB = (const char*)g.Bt + (size_t)cur.pn * tstep + cur.koff;
    S.a_ready(cur);
    if constexpr (SP2) {
        PG8_STAGE(PG8_SB(0, 0), cB, voffB); PG8_STAGE(PG8_SB(0, 1), cB + hstep, voffB); PG8_STAGE(PG8_SA(0, 0), cA, voffA); PG8_STAGE(PG8_SA(0, 1), cA + hstep, voffA);
        if (wr == 1) PG8_BAR;
        PG8_WAIT_V(2); PG8_BAR;
        PG8_STAGE(PG8_SB(1, 0), cB + kstep, voffB); PG8_STAGE(PG8_SA(1, 0), cA + kstep, voffA); PG8_STAGE(PG8_SB(1, 1), cB + hstep + kstep, voffB);
        PG8_WAIT_V(6); PG8_BAR;
    } else {
        PG8_STAGE(PG8_SB(0, 0), cB, voffB); PG8_STAGE(PG8_SA(0, 0), cA, voffA); PG8_STAGE(PG8_SB(0, 1), cB + hstep, voffB); PG8_STAGE(PG8_SA(0, 1), cA + hstep, voffA);
        if (wr == 1) PG8_BAR;
        PG8_WAIT_V(4); PG8_BAR;
        PG8_STAGE(PG8_SB(1, 0), cB + kstep, voffB); PG8_STAGE(PG8_SA(1, 0), cA + kstep, voffA); PG8_STAGE(PG8_SB(1, 1), cB + hstep + kstep, voffB);
        PG8_WAIT_V(6); PG8_BAR;
    }
    for (;;) {
        const bool has_next = S.next(ui + 1, nxt);
        const char* nA = has_next ? (const char*)g.A + (size_t)nxt.pm * tstep + nxt.koff : cA; const char* nB = has_next ? (const char*)g.Bt + (size_t)nxt.pn * tstep + nxt.koff : cB;
        const int ntc = cur.nt ? cur.nt : nt;
        for (int t = 0; t < ntc; t += 2) {
            const bool last = (t == ntc - 2);
            const char* a1 = cA + (size_t)(t + 1) * kstep;
            const char* a2 = last ? nA : cA + (size_t)(t + 2) * kstep; const char* b2 = last ? nB : cB + (size_t)(t + 2) * kstep;
            const char* a3 = a2 + kstep; const char* b3 = b2 + kstep;
            if (last && has_next) S.a_ready(nxt);
            if constexpr (SP2) {
            PG8_LDB(B0, 0, 0); PG8_LDB(B1, 0, 1); PG8_SCHED; PG8_LDA(At, 0, 0); PG8_STAGE(PG8_SA(1, 1), a1 + hstep, voffA);
            PG8_WAIT_V(8); PG8_WAIT_L(0); PG8_BAR; PG8_MMA(0, 0, At, B0); PG8_MMA(0, 1, At, B1); PG8_BAR; PG8_SCHED;
            PG8_LDA(At, 0, 1); PG8_STAGE(PG8_SB(0, 0), b2, voffB); PG8_STAGE(PG8_SB(0, 1), b2 + hstep, voffB); PG8_STAGE(PG8_SA(0, 0), a2, voffA);
            PG8_WAIT_V(8); PG8_WAIT_L(0); PG8_BAR; PG8_MMA(1, 0, At, B0); PG8_MMA(1, 1, At, B1); PG8_BAR; PG8_SCHED;
            PG8_LDB(B0, 1, 0); PG8_LDB(B1, 1, 1); PG8_SCHED; PG8_LDA(At, 1, 0); PG8_STAGE(PG8_SA(0, 1), a2 + hstep, voffA);
            PG8_WAIT_V(8); PG8_WAIT_L(0); PG8_BAR; PG8_MMA(0, 0, At, B0); PG8_MMA(0, 1, At, B1); PG8_BAR; PG8_SCHED;
            PG8_LDA(At, 1, 1); PG8_STAGE(PG8_SB(1, 0), b3, voffB); PG8_STAGE(PG8_SB(1, 1), b3 + hstep, voffB); PG8_STAGE(PG8_SA(1, 0), a3, voffA);
            PG8_WAIT_V(8); PG8_WAIT_L(0); PG8_BAR; PG8_MMA(1, 0, At, B0); PG8_MMA(1, 1, At, B1); PG8_BAR; PG8_SCHED;
            } else {
            PG8_LDB(B0, 0, 0); PG8_SCHED; PG8_LDA(At, 0, 0); PG8_STAGE(PG8_SA(1, 1), a1 + hstep, voffA);
            PG8_WAIT_L(8); PG8_BAR; PG8_WAIT_L(0); PG8_MMA(0, 0, At, B0); PG8_BAR; PG8_SCHED;
            PG8_LDB(B1, 0, 1); PG8_STAGE(PG8_SB(0, 0), b2, voffB);
            PG8_BAR; PG8_WAIT_L(0); PG8_MMA(0, 1, At, B1); PG8_BAR;
            PG8_LDA(At, 0, 1); PG8_STAGE(PG8_SA(0, 0), a2, voffA);
            PG8_BAR; PG8_WAIT_L(0); PG8_MMA(1, 0, At, B0); PG8_BAR; PG8_SCHED;
            PG8_STAGE(PG8_SB(0, 1), b2 + hstep, voffB);
            PG8_WAIT_V(6); PG8_BAR; PG8_MMA(1, 1, At, B1); PG8_BAR;
            PG8_LDB(B0, 1, 0); PG8_SCHED; PG8_LDA(At, 1, 0); PG8_STAGE(PG8_SA(0, 1), a2 + hstep, voffA);
            PG8_WAIT_L(8); PG8_BAR; PG8_WAIT_L(0); PG8_MMA(0, 0, At, B0); PG8_BAR; PG8_SCHED;
            PG8_LDB(B1, 1, 1); PG8_STAGE(PG8_SB(1, 0), b3, voffB);
            PG8_BAR; PG8_WAIT_L(0); PG8_MMA(0, 1, At, B1); PG8_BAR;
            PG8_LDA(At, 1, 1); PG8_STAGE(PG8_SA(1, 0), a3, voffA);
            PG8_BAR; PG8_WAIT_L(0); PG8_MMA(1, 0, At, B0); PG8_BAR; PG8_SCHED;
            PG8_STAGE(PG8_SB(1, 1), b3 + hstep, voffB);
            PG8_WAIT_V(6); PG8_BAR; PG8_MMA(1, 1, At, B1); PG8_BAR;
            }
        }
        if constexpr (ALIGN_EPI) { if (wr == 0) PG8_BAR; }
        if constexpr (!Epi::AFTER_DRAIN) { E(acc, cur, wr, wc, fr, fq); S.done(cur); }
        if (!has_next) break;
#pragma unroll
        for (int a = 0; a < 2; ++a)
#pragma unroll
            for (int b = 0; b < 2; ++b)
#pragma unroll
                for (int m = 0; m < 4; ++m)
#pragma unroll
                    for (int n = 0; n < 2; ++n) acc[a][b][m][n] = (f32x4){0.f, 0.f, 0.f, 0.f};
        cur = nxt; cA = nA; cB = nB; ++ui;
        if constexpr (ALIGN_EPI) { if (wr == 1) PG8_BAR; }
    }
    PG8_WAIT_V(0);
    if constexpr (!ALIGN_EPI) { if (wr == 0) PG8_BAR; }
    PG8_BAR;
    if constexpr (Epi::AFTER_DRAIN) { E.fused(acc, cur, wr, wc, fr, fq, lds, wid, lane); S.done(cur); }
#undef PG8_SA
#undef PG8_SB
#undef PG8_STAGE
#undef PG8_LDA
#undef PG8_LDB
#undef PG8_MMA
#undef PG8_WAIT_V
#undef PG8_WAIT_L
#undef PG8_BAR
#undef PG8_SCHED
}
}
#define LAS __attribute__((address_space(3)))
typedef unsigned short bf16_t;
typedef short bf16x8 __attribute__((ext_vector_type(8)));
typedef short bf16x4 __attribute__((ext_vector_type(4)));
typedef float f32x4 __attribute__((ext_vector_type(4)));
typedef float f32x2 __attribute__((ext_vector_type(2)));
typedef float f32x16 __attribute__((ext_vector_type(16)));
typedef unsigned u32x4 __attribute__((ext_vector_type(4)));
typedef unsigned u32x2 __attribute__((ext_vector_type(2)));

constexpr int D = 1024, M_CTX = 8192, M_LAT = 16384, M = M_CTX + M_LAT, NP = 1888, NPP = 2048, FF = 2816, DEPTH = 4;
constexpr int KEYROWS = 8192 + 4 * 4352;
constexpr float EPS = 1e-6f;
constexpr int NTHREADS = 512, NWAVES = 8;
constexpr int LDS_BYTES = 147456;

constexpr size_t OUT_X = 0, OUT_CKV = (size_t)M * D, OUT_KR = OUT_CKV + (size_t)32 * 4 * 256 * 128;
constexpr int PC_U = 0, PC_V = 256, PC_H = 512, PC_B = 768, PC_C = 1024, PC_F = 1280, PC_Q = 1536, PC_KV = 1728, PC_KR = 1856;

constexpr size_t al256(size_t x) { return (x + 255) & ~(size_t)255; }
constexpr size_t WS_BAR = 0, WS_BAR_BYTES = 16384;
constexpr size_t WS_MOD = WS_BAR_BYTES;
constexpr size_t WS_F64 = al256(WS_MOD + (size_t)4 * 5 * 6144 * 4);
constexpr size_t WS_T64R = WS_F64 + 128 * 64 * 2;
constexpr size_t WS_T64I = WS_T64R + 64 * 128 * 2;
constexpr size_t WS_T64B = WS_T64I + 64 * 128 * 2;
constexpr size_t WS_T256 = WS_T64B + 64 * 128 * 2;
constexpr size_t WS_TW = WS_T256 + 256 * 512 * 2;
constexpr size_t WS_ROPE = WS_TW + 4096 * 8;
constexpr size_t WS_W = al256(WS_ROPE + 64 * 8 * 8);
constexpr size_t WL_IN = 0, WL_OUT = WL_IN + (size_t)NPP * D * 2, WL_GU = WL_OUT + (size_t)D * D * 2, WL_DN = WL_GU + (size_t)2 * FF * D * 2,
                 WL_UQ = WL_DN + (size_t)D * FF * 2, WL_UKV = WL_UQ + (size_t)384 * 192 * 2, WL_SP = WL_UKV + (size_t)512 * 128 * 2, WL_SIZE = WL_SP + (size_t)4 * 128 * 128 * 2;
constexpr size_t WS_R1 = al256(WS_W + 4 * WL_SIZE);
constexpr size_t WS_R2 = WS_R1 + (size_t)M * D * 2;
constexpr size_t WS_MLA = WS_R2 + (size_t)M * FF * 2;
constexpr size_t WS_Q = WS_MLA, WS_KN = WS_Q + (size_t)M * 384 * 2, WS_VT = WS_KN + (size_t)KEYROWS * 256 * 2, WS_KR = WS_VT + (size_t)KEYROWS * 256 * 2,
                 WS_GB = WS_KR + (size_t)KEYROWS * 32 * 2, WS_END = WS_GB + (size_t)4 * 4 * 64 * 64 * 128 * 2;
static_assert(WS_END - WS_MLA >= (size_t)M * D * 2, "FFNOUT alias");
static_assert((size_t)M * NP * 2 <= (size_t)M * FF * 2, "PROJ fits R2");

struct Params { const float* in[24]; float* out; unsigned char* ws; };
enum { I_XP = 0, I_XS, I_CCKV, I_CKR, I_C, I_CCTX, I_WADA, I_BADA, I_GPM, I_GPOM, I_GPF, I_GPOF, I_WIN, I_SPW, I_SPB, I_CVW, I_CVB, I_GQ, I_WUQ, I_GKV, I_WUKV, I_WOUT, I_WGU, I_WDN };

__device__ __forceinline__ unsigned f2bf(float f) { unsigned u = __builtin_bit_cast(unsigned, f); return (u + 0x7fffu + ((u >> 16) & 1u)) >> 16; }
typedef __bf16 bf16x2v __attribute__((ext_vector_type(2)));
__device__ __forceinline__ unsigned pk2(float lo, float hi) { const bf16x2v r = __builtin_convertvector((f32x2){lo, hi}, bf16x2v); return __builtin_bit_cast(unsigned, r); }
__device__ __forceinline__ float bflo(unsigned w) { return __builtin_bit_cast(float, w << 16); }
__device__ __forceinline__ float bfhi(unsigned w) { return __builtin_bit_cast(float, w & 0xffff0000u); }
__device__ __forceinline__ float bf1(bf16_t v) { return __builtin_bit_cast(float, (unsigned)v << 16); }
__device__ __forceinline__ f32x4 mma16(bf16x8 a, bf16x8 b, f32x4 c) { return __builtin_amdgcn_mfma_f32_16x16x32_bf16(a, b, c, 0, 0, 0); }
__device__ __forceinline__ f32x16 mma32(bf16x8 a, bf16x8 b, f32x16 c) { return __builtin_amdgcn_mfma_f32_32x32x16_bf16(a, b, c, 0, 0, 0); }
__device__ __forceinline__ float wave_sum(float v) {
#pragma unroll
    for (int o = 1; o < 64; o <<= 1) v += __shfl_xor(v, o);
    return v;
}
__device__ __forceinline__ u32x2 pk4(f32x4 v) { u32x2 w; w.x = pk2(v[0], v[1]); w.y = pk2(v[2], v[3]); return w; }
__device__ __forceinline__ int mod_of_row(int r) { return r < M_CTX ? 0 : 1 + ((r - M_CTX) >> 12); }

struct Ctx {
    Params p; LAS unsigned char* lds; int tid, lane, wave, bid, G;
    unsigned char* ws;
    __device__ __forceinline__ const float* mod(int l, int mi, int chunk) const { return (const float*)(ws + WS_MOD) + ((size_t)(l * 5 + mi) * 6 + chunk) * 1024; }
    __device__ __forceinline__ unsigned char* wl(int l) const { return ws + WS_W + (size_t)l * WL_SIZE; }
    __device__ __forceinline__ void refresh() { int t = threadIdx.x; asm volatile("" : "+v"(t)); tid = t; lane = t & 63; wave = __builtin_amdgcn_readfirstlane(t >> 6);
        size_t z = 0; asm volatile("" : "+s"(z)); ws = p.ws + z;
        int b = blockIdx.x; asm volatile("" : "+s"(b)); bid = b; }
};

constexpr int TPS = 258;
struct TItem { const float* W; bf16_t* WT; int ldw, K, k0, n0, nvalid, gu; };
__device__ __forceinline__ void titem_load(const TItem& t, int wave, int lane, f32x4 (&v)[8]) {
    const int n = t.n0 + 4 * lane;
#pragma unroll
    for (int i = 0; i < 8; ++i) v[i] = n < t.nvalid ? *(const f32x4*)(t.W + (size_t)(t.k0 + 8 * wave + i) * t.ldw + n) : (f32x4){0.f, 0.f, 0.f, 0.f};
}
__device__ __forceinline__ void titem_stage(LAS unsigned char* lds, int wave, int lane, const f32x4 (&v)[8]) {
    LAS bf16_t* T = (LAS bf16_t*)lds;
#pragma unroll
    for (int i = 0; i < 8; ++i) { LAS unsigned* d = (LAS unsigned*)(T + (8 * wave + i) * TPS + 4 * lane); d[0] = pk2(v[i][0], v[i][1]); d[1] = pk2(v[i][2], v[i][3]); }
}
__device__ __forceinline__ void titem_store(const TItem& t, const LAS unsigned char* lds, int tid) {
    const LAS bf16_t* T = (const LAS bf16_t*)lds;
#pragma unroll
    for (int it = 0; it < 4; ++it) { const int q = tid + NTHREADS * it, n = q >> 3, c = q & 7;
        unsigned short e[8];
#pragma unroll
        for (int j = 0; j < 8; ++j) e[j] = T[(8 * c + j) * TPS + n];
        const int sn = t.n0 + n;
        if (sn < t.nvalid) { int dr = sn; if (t.gu) { const int isup = sn >= FF, jj = isup ? sn - FF : sn; dr = (jj >> 7) * 256 + isup * 128 + (jj & 127); }
            u32x4 o; o.x = e[0] | ((unsigned)e[1] << 16); o.y = e[2] | ((unsigned)e[3] << 16); o.z = e[4] | ((unsigned)e[5] << 16); o.w = e[6] | ((unsigned)e[7] << 16);
            *(u32x4*)(t.WT + (size_t)dr * t.K + t.k0 + 8 * c) = o; } }
}
constexpr int TI_IN = 16 * 8, TI_OUT = 16 * 4, TI_GU = 16 * 22, TI_DN = 44 * 4, TI_UQ = 3 * 2, TI_UKV = 2 * 2, TI_L = TI_IN + TI_OUT + TI_GU + TI_DN + TI_UQ + TI_UKV;
__device__ __forceinline__ TItem titem_make(const Ctx& C, int it) {
    const Params& p = C.p; const int l = it / TI_L; int r = it % TI_L; unsigned char* wl = C.wl(l); TItem t; t.gu = 0;
    if (r < TI_IN) { t.W = p.in[I_WIN] + (size_t)l * D * NP; t.WT = (bf16_t*)(wl + WL_IN); t.ldw = NP; t.K = D; t.k0 = (r >> 3) * 64; t.n0 = (r & 7) * 256; t.nvalid = NP; return t; } r -= TI_IN;
    if (r < TI_OUT) { t.W = p.in[I_WOUT] + (size_t)l * D * D; t.WT = (bf16_t*)(wl + WL_OUT); t.ldw = D; t.K = D; t.k0 = (r >> 2) * 64; t.n0 = (r & 3) * 256; t.nvalid = D; return t; } r -= TI_OUT;
    if (r < TI_GU) { t.W = p.in[I_WGU] + (size_t)l * D * 2 * FF; t.WT = (bf16_t*)(wl + WL_GU); t.ldw = 2 * FF; t.K = D; t.k0 = (r / 22) * 64; t.n0 = (r % 22) * 256; t.nvalid = 2 * FF; t.gu = 1; return t; } r -= TI_GU;
    if (r < TI_DN) { t.W = p.in[I_WDN] + (size_t)l * FF * D; t.WT = (bf16_t*)(wl + WL_DN); t.ldw = D; t.K = FF; t.k0 = (r >> 2) * 64; t.n0 = (r & 3) * 256; t.nvalid = D; return t; } r -= TI_DN;
    if (r < TI_UQ) { t.W = p.in[I_WUQ] + (size_t)l * 192 * 384; t.WT = (bf16_t*)(wl + WL_UQ); t.ldw = 384; t.K = 192; t.k0 = (r >> 1) * 64; t.n0 = (r & 1) * 256; t.nvalid = 384; return t; } r -= TI_UQ;
    t.W = p.in[I_WUKV] + (size_t)l * 128 * 512; t.WT = (bf16_t*)(wl + WL_UKV); t.ldw = 512; t.K = 128; t.k0 = (r >> 1) * 64; t.n0 = (r & 1) * 256; t.nvalid = 512; return t;
}

__device__ __forceinline__ void transpose_items(const Ctx& C, int it0, int stride, int end) {
    int it = it0; f32x4 v[8];
    TItem cur; if (it < end) { cur = titem_make(C, it); titem_load(cur, C.wave, C.lane, v); }
    while (it < end) {
        titem_stage(C.lds, C.wave, C.lane, v);
        const int nx = it + stride; TItem nxt = cur; if (nx < end) { nxt = titem_make(C, nx); titem_load(nxt, C.wave, C.lane, v); }
        __syncthreads();
        titem_store(cur, C.lds, C.tid);
        __syncthreads();
        cur = nxt; it = nx;
    }
}

__device__ __forceinline__ void phase_prologue(const Ctx& C) {
    const Params& p = C.p;
    transpose_items(C, C.bid, C.G, (C.G == 256) ? TI_L : 4 * TI_L);
    {
        LAS float* sc = (LAS float*)C.lds;
        LAS float* red = (LAS float*)(C.lds + 5 * 1024 * 4);
        const int ub = C.G - 1 - C.bid;
        if (ub < 96) {
            size_t za = 0, zb = 0; asm volatile("" : "+s"(za), "+s"(zb));
            const float* cctx = p.in[I_CCTX] + za; const float* cc_ = p.in[I_C] + zb;
            for (int i = C.tid; i < 5120; i += NTHREADS) { const int j = i >> 10, k = i & 1023; const float v = (j == 0) ? cctx[k] : cc_[(j - 1) * 1024 + k]; sc[i] = v / (1.f + __expf(-v)); }
            __syncthreads();
            for (int u = ub; u < 96; u += C.G) {
                const int l = u / 24, cb = u % 24;
                const float* w = p.in[I_WADA] + ((size_t)l * 1024 + C.wave * 128) * 6144 + cb * 256 + 4 * C.lane;
                f32x4 a0 = {0.f, 0.f, 0.f, 0.f}, a1 = a0, a2 = a0, a3 = a0, a4 = a0;
#pragma unroll 16
                for (int k = 0; k < 128; ++k) { const f32x4 wv = *(const f32x4*)(w + (size_t)k * 6144); const int kk = C.wave * 128 + k;
                    a0 += wv * sc[kk]; a1 += wv * sc[1024 + kk]; a2 += wv * sc[2048 + kk]; a3 += wv * sc[3072 + kk]; a4 += wv * sc[4096 + kk]; }
                LAS f32x4* rw = (LAS f32x4*)(red + C.wave * 1280) + C.lane;
                rw[0] = a0; rw[64] = a1; rw[128] = a2; rw[192] = a3; rw[256] = a4;
                __syncthreads();
                for (int i = C.tid; i < 1280; i += NTHREADS) { const int j = i >> 8, c2 = i & 255; float sum = p.in[I_BADA][l * 6144 + cb * 256 + c2];
#pragma unroll
                    for (int ww = 0; ww < 8; ++ww) sum += red[ww * 1280 + i];
                    ((float*)(C.ws + WS_MOD))[(size_t)(l * 5 + j) * 6144 + cb * 256 + c2] = sum; }
                __syncthreads();
            }
        }
        __syncthreads();
    }
    {
        const int gt = C.bid * NTHREADS + C.tid, GT = C.G * NTHREADS;
        for (int i = gt; i < 4 * 65536; i += GT) { const int l = i >> 16, e = i & 65535; ((bf16_t*)(C.wl(l) + WL_SP))[e] = (bf16_t)f2bf(p.in[I_SPW][i]); }
        for (int i = gt; i < 4 * 160 * 1024 / 2; i += GT) { const int l = i / (160 * 512), e = i % (160 * 512); ((unsigned*)(C.wl(l) + WL_IN + (size_t)NP * D * 2))[e] = 0u; }
        for (int i = gt; i < 128 * 64; i += GT) { const int m = i >> 6, c = i & 63; const int idx = ((m & 63) * c) & 63; const float a = (float)idx / 32.f;
            ((bf16_t*)(C.ws + WS_F64))[i] = (bf16_t)f2bf(m < 64 ? cospif(a) : sinpif(a)); }
        for (int i = gt; i < 64 * 128; i += GT) { const int k = i >> 7, K = i & 127; const int idx = (k * (K & 63)) & 63; const float a = (float)idx / 32.f; const float cv = cospif(a), sv = sinpif(a);
            ((bf16_t*)(C.ws + WS_T64R))[i] = (bf16_t)f2bf(K < 64 ? cv : -sv);
            ((bf16_t*)(C.ws + WS_T64I))[i] = (bf16_t)f2bf(K < 64 ? -sv : -cv);
            ((bf16_t*)(C.ws + WS_T64B))[i] = (bf16_t)f2bf(K < 64 ? cv : sv); }
        for (int i = gt; i < 256 * 512; i += GT) { const int k = i >> 9, K = i & 511; const int idx = (k * (K & 255)) & 255; const float a = (float)idx / 128.f;
            ((bf16_t*)(C.ws + WS_T256))[i] = (bf16_t)f2bf(K < 256 ? cospif(a) : -sinpif(a)); }
        for (int i = gt; i < 4096; i += GT) { const float a = (float)i / 2048.f; ((f32x2*)(C.ws + WS_TW))[i] = (f32x2){cospif(a), sinpif(a)}; }
        for (int i = gt; i < 512; i += GT) { const int pos = i >> 3, f = i & 7; const float inv = powf(10000.f, -(float)f / 8.f); const float ang = (float)pos * inv;
            ((f32x2*)(C.ws + WS_ROPE))[i] = (f32x2){cosf(ang), sinf(ang)}; }
    }
}

__device__ __forceinline__ void load_row_f32(const float* rowp, int lane, f32x4 (&v)[4]) {
#pragma unroll
    for (int j = 0; j < 4; ++j) v[j] = *(const f32x4*)(rowp + 4 * lane + 256 * j);
}
__device__ __forceinline__ void load_row_bf16(const bf16_t* rowp, int lane, f32x4 (&v)[4]) {
#pragma unroll
    for (int j = 0; j < 4; ++j) { const u32x2 w = *(const u32x2*)(rowp + 4 * lane + 256 * j); v[j] = (f32x4){bflo(w.x), bfhi(w.x), bflo(w.y), bfhi(w.y)}; }
}
__device__ __forceinline__ float row_rstd(const f32x4 (&v)[4]) {
    float s = 0.f;
#pragma unroll
    for (int j = 0; j < 4; ++j) s += (v[j][0] * v[j][0] + v[j][1] * v[j][1]) + (v[j][2] * v[j][2] + v[j][3] * v[j][3]);
    return 1.f / sqrtf(wave_sum(s) * (1.f / 1024.f) + EPS);
}
__device__ __forceinline__ void norm_mod_store(const f32x4 (&x)[4], const float* g, const float* scale, const float* shift, bf16_t* orow, int lane) {
    const float rs = row_rstd(x);
#pragma unroll
    for (int j = 0; j < 4; ++j) { const int c = 4 * lane + 256 * j; const f32x4 gv = *(const f32x4*)(g + c), sv = *(const f32x4*)(scale + c), hv = *(const f32x4*)(shift + c);
        const f32x4 h = x[j] * rs * gv * (1.f + sv) + hv; *(u32x2*)(orow + c) = pk4(h); }
}
__device__ __forceinline__ const float* xin_row(const Ctx& C, int layer, int r) {
    if (layer > 0) return C.p.out + OUT_X + (size_t)r * D;
    size_t za = 0, zb = 0; asm volatile("" : "+s"(za), "+s"(zb));
    const float* a = C.p.in[I_XP] + za; const float* b = C.p.in[I_XS] + zb;
    return r < M_CTX ? a + (size_t)r * D : b + (size_t)(r - M_CTX) * D;
}
constexpr int SPLIT_ROW0 = 16384;
__device__ __forceinline__ void load_T(const bf16_t* T, const bf16_t* T1, bool split, int r, int lane, f32x4 (&v)[4]) {
    load_row_bf16(T + (size_t)r * D, lane, v);
    if (split && r >= SPLIT_ROW0) { f32x4 w[4]; load_row_bf16(T1 + (size_t)r * D, lane, w);
#pragma unroll
        for (int j = 0; j < 4; ++j) v[j] = v[j] + w[j]; }
}
__device__ __forceinline__ void phase_norm0(const Ctx& C) {
    const int gw = C.bid * NWAVES + C.wave, NGW = C.G * NWAVES;
    bf16_t* H = (bf16_t*)(C.ws + WS_R1);
    f32x4 xn[4]; load_row_f32(xin_row(C, 0, gw), C.lane, xn);
    for (int r = gw; r < M; r += NGW) { f32x4 x[4];
#pragma unroll
        for (int j = 0; j < 4; ++j) x[j] = xn[j];
        if (r + NGW < M) load_row_f32(xin_row(C, 0, r + NGW), C.lane, xn);
        const int mi = mod_of_row(r);
        norm_mod_store(x, C.p.in[I_GPM], C.mod(0, mi, 1), C.mod(0, mi, 0), H + (size_t)r * D, C.lane); }
}
template <int which  > __device__ __forceinline__ void phase_post(const Ctx& C, int layer) {
    const int gw = C.bid * NWAVES + C.wave, NGW = C.G * NWAVES;
    const bf16_t* T = (const bf16_t*)(C.ws + (which == 0 ? WS_R2 : WS_MLA));
    const bf16_t* T1 = T + (size_t)M * D - (size_t)SPLIT_ROW0 * D;
    const bool split = (C.G == 256);
    bf16_t* H = (bf16_t*)(C.ws + WS_R1);
    const float* gpost = (which == 0 ? C.p.in[I_GPOM] : C.p.in[I_GPOF]) + layer * D;
    const bool do_next = (which == 0) || (layer + 1 < DEPTH);
    const int nl = which == 0 ? layer : layer + 1;
    const float* gnext = (which == 0 ? C.p.in[I_GPF] : C.p.in[I_GPM]) + (nl < DEPTH ? nl : 0) * D;
    f32x4 tn[4], xn[4];
    load_T(T, T1, split, gw, C.lane, tn); load_row_f32(which == 0 ? xin_row(C, layer, gw) : C.p.out + OUT_X + (size_t)gw * D, C.lane, xn);
    for (int r = gw; r < M; r += NGW) {
        const int mi = mod_of_row(r);
        f32x4 t[4], x[4];
#pragma unroll
        for (int j = 0; j < 4; ++j) { t[j] = tn[j]; x[j] = xn[j]; }
        if (r + NGW < M) { const int rn = r + NGW; load_T(T, T1, split, rn, C.lane, tn); load_row_f32(which == 0 ? xin_row(C, layer, rn) : C.p.out + OUT_X + (size_t)rn * D, C.lane, xn); }
        const float rs = row_rstd(t); const float* gate = C.mod(layer, mi, which == 0 ? 2 : 5);
        float* xo = C.p.out + OUT_X + (size_t)r * D;
#pragma unroll
        for (int j = 0; j < 4; ++j) { const int c = 4 * C.lane + 256 * j; const f32x4 gv = *(const f32x4*)(gpost + c), ga = *(const f32x4*)(gate + c);
            x[j] = x[j] + ga * (t[j] * rs * gv); *(f32x4*)(xo + c) = x[j]; }
        if (do_next) norm_mod_store(x, gnext, C.mod(nl, mi, which == 0 ? 4 : 1), C.mod(nl, mi, which == 0 ? 3 : 0), H + (size_t)r * D, C.lane);
    }
}

__device__ __forceinline__ void unit_chunk_mlp(const Ctx& C, int layer, int u) {
    const int chunk = u >> 2, g = u & 3, r0 = chunk * 128;
    const bf16_t* PROJ = (const bf16_t*)(C.ws + WS_R2); bf16_t* MIX = (bf16_t*)(C.ws + WS_R1);
    constexpr int VS = 136;
    LAS bf16_t* Vt = (LAS bf16_t*)C.lds;
    { const int q = C.tid >> 2, c0 = (C.tid & 3) * 16; const bf16_t* src = PROJ + (size_t)(r0 + q) * NP + PC_V + g * 64 + c0;
      const bf16x8 v0 = *(const bf16x8*)src, v1 = *(const bf16x8*)(src + 8);
#pragma unroll
      for (int j = 0; j < 8; ++j) { Vt[(c0 + j) * VS + q] = (bf16_t)v0[j]; Vt[(c0 + 8 + j) * VS + q] = (bf16_t)v1[j]; } }
    __syncthreads();
    const int l15 = C.lane & 15, hq = C.lane >> 4, w = C.wave;
    const bf16_t* Wg = (const bf16_t*)(C.wl(layer) + WL_SP) + (size_t)g * 128 * 128;
    bf16x8 bw[4];
#pragma unroll
    for (int ks = 0; ks < 4; ++ks) bw[ks] = *(const bf16x8*)(Wg + (size_t)(w * 16 + l15) * 128 + ks * 32 + 8 * hq);
    const int p = w * 16 + l15; const float bias = C.p.in[I_SPB][(layer * 4 + g) * 128 + p];
#pragma unroll
    for (int ct = 0; ct < 4; ++ct) {
        f32x4 acc = {0.f, 0.f, 0.f, 0.f};
#pragma unroll
        for (int ks = 0; ks < 4; ++ks) { const bf16x8 a = *(const LAS bf16x8*)(Vt + (ct * 16 + l15) * VS + ks * 32 + 8 * hq); acc = mma16(a, bw[ks], acc); }
        const int cc = g * 64 + ct * 16 + 4 * hq; const u32x2 uw = *(const u32x2*)(PROJ + (size_t)(r0 + p) * NP + PC_U + cc);
        f32x4 o; o[0] = bflo(uw.x) * (acc[0] + bias); o[1] = bfhi(uw.x) * (acc[1] + bias); o[2] = bflo(uw.y) * (acc[2] + bias); o[3] = bfhi(uw.y) * (acc[3] + bias);
        *(u32x2*)(MIX + (size_t)(r0 + p) * D + cc) = pk4(o);
    }
    __syncthreads();
}
__device__ __forceinline__ void unit_conv(const Ctx& C, int layer, int u) {
    const bf16_t* PROJ = (const bf16_t*)(C.ws + WS_R2); bf16_t* MIX = (bf16_t*)(C.ws + WS_R1);
    const float* cw = C.p.in[I_CVW] + layer * 3 * 256; const float* cb = C.p.in[I_CVB] + layer * 256;
    for (int it = 0; it < 8; ++it) {
        const int item = it * NTHREADS + C.tid, t = item >> 5, ch = (item & 31) * 8, r = u * 128 + t;
        const int pos = r < M_CTX ? (r & 255) : ((r - M_CTX) & 4095), len = r < M_CTX ? 256 : 4096;
        const bf16_t* base = PROJ + (size_t)r * NP;
        const bf16x8 h1 = *(const bf16x8*)(base + PC_H + ch), c1 = *(const bf16x8*)(base + PC_C + ch), gb = *(const bf16x8*)(base + PC_B + ch);
        bf16x8 h0 = h1, c0 = c1, h2 = h1, c2 = c1; const bool hasp = pos > 0, hasn = pos < len - 1;
        if (hasp) { h0 = *(const bf16x8*)(base - NP + PC_H + ch); c0 = *(const bf16x8*)(base - NP + PC_C + ch); }
        if (hasn) { h2 = *(const bf16x8*)(base + NP + PC_H + ch); c2 = *(const bf16x8*)(base + NP + PC_C + ch); }
        float o[8];
#pragma unroll
        for (int j = 0; j < 8; ++j) {
            const float z0 = hasp ? bf1((bf16_t)h0[j]) * bf1((bf16_t)c0[j]) : 0.f, z1 = bf1((bf16_t)h1[j]) * bf1((bf16_t)c1[j]), z2 = hasn ? bf1((bf16_t)h2[j]) * bf1((bf16_t)c2[j]) : 0.f;
            const float y = z0 * cw[ch + j] + z1 * cw[256 + ch + j] + z2 * cw[512 + ch + j] + cb[ch + j];
            o[j] = bf1((bf16_t)gb[j]) * y; }
        u32x4 w; w.x = pk2(o[0], o[1]); w.y = pk2(o[2], o[3]); w.z = pk2(o[4], o[5]); w.w = pk2(o[6], o[7]);
        *(u32x4*)(MIX + (size_t)r * D + 256 + ch) = w;
    }
}
__device__ __forceinline__ void unit_fourier_ctx(const Ctx& C, int u) {
    const int s = u >> 2, g = u & 3, l15 = C.lane & 15, hq = C.lane >> 4, w = C.wave;
    const bf16_t* PROJ = (const bf16_t*)(C.ws + WS_R2); bf16_t* MIX = (bf16_t*)(C.ws + WS_R1);
    const bf16_t* F64 = (const bf16_t*)(C.ws + WS_F64); const bf16_t* T256 = (const bf16_t*)(C.ws + WS_T256);
    constexpr int ZS = 520; LAS bf16_t* Zt = (LAS bf16_t*)C.lds;
#pragma unroll
    for (int i = 0; i < 2; ++i) { const int nt = 2 * w + i;
        bf16x8 a[2];
#pragma unroll
        for (int ks = 0; ks < 2; ++ks) a[ks] = *(const bf16x8*)(PROJ + (size_t)(s * 256 + nt * 16 + l15) * NP + PC_F + g * 64 + ks * 32 + 8 * hq);
#pragma unroll
        for (int mt = 0; mt < 8; ++mt) { f32x4 acc = {0.f, 0.f, 0.f, 0.f};
#pragma unroll
            for (int ks = 0; ks < 2; ++ks) { const bf16x8 b = *(const bf16x8*)(F64 + (size_t)(mt * 16 + l15) * 64 + ks * 32 + 8 * hq); acc = mma16(a[ks], b, acc); }
            const int mp = mt * 16 + l15;
            *(LAS u32x2*)(Zt + (mp & 63) * ZS + (mp >> 6) * 256 + nt * 16 + 4 * hq) = pk4(acc); } }
    __syncthreads();
#pragma unroll 1
    for (int i = 0; i < 2; ++i) { const int kt = 2 * w + i;
        f32x4 acc[4];
#pragma unroll
        for (int mt = 0; mt < 4; ++mt) acc[mt] = (f32x4){0.f, 0.f, 0.f, 0.f};
#pragma unroll 8
        for (int ks = 0; ks < 16; ++ks) { const bf16x8 b = *(const bf16x8*)(T256 + (size_t)(kt * 16 + l15) * 512 + ks * 32 + 8 * hq);
#pragma unroll
            for (int mt = 0; mt < 4; ++mt) { const bf16x8 a = *(const LAS bf16x8*)(Zt + (mt * 16 + l15) * ZS + ks * 32 + 8 * hq); acc[mt] = mma16(a, b, acc[mt]); } }
#pragma unroll
        for (int mt = 0; mt < 4; ++mt) *(u32x2*)(MIX + (size_t)(s * 256 + kt * 16 + l15) * D + 512 + g * 64 + mt * 16 + 4 * hq) = pk4(acc[mt] * (1.f / 128.f)); }
    __syncthreads();
}
__device__ __forceinline__ void unit_fourier_lat1(const Ctx& C, int u) {
    const int b = u >> 5, g = (u >> 3) & 3, nb = u & 7, l15 = C.lane & 15, hq = C.lane >> 4, n2 = nb * 8 + C.wave;
    const bf16_t* PROJ = (const bf16_t*)(C.ws + WS_R2);
    const bf16_t* F64 = (const bf16_t*)(C.ws + WS_F64); const bf16_t* T64R = (const bf16_t*)(C.ws + WS_T64R); const bf16_t* T64I = (const bf16_t*)(C.ws + WS_T64I);
    const f32x2* TW = (const f32x2*)(C.ws + WS_TW);
    bf16_t* GB = (bf16_t*)(C.ws + WS_GB) + (size_t)((b * 4 + g) * 64 + n2) * 64 * 128;
    constexpr int ZS = 136; LAS bf16_t* Zt = (LAS bf16_t*)(C.lds + C.wave * (64 * ZS * 2));
#pragma unroll 2
    for (int nt = 0; nt < 4; ++nt) {
        bf16x8 a[2];
#pragma unroll
        for (int ks = 0; ks < 2; ++ks) a[ks] = *(const bf16x8*)(PROJ + (size_t)(M_CTX + b * 4096 + (nt * 16 + l15) * 64 + n2) * NP + PC_F + g * 64 + ks * 32 + 8 * hq);
#pragma unroll
        for (int mt = 0; mt < 8; ++mt) { f32x4 acc = {0.f, 0.f, 0.f, 0.f};
#pragma unroll
            for (int ks = 0; ks < 2; ++ks) { const bf16x8 bb = *(const bf16x8*)(F64 + (size_t)(mt * 16 + l15) * 64 + ks * 32 + 8 * hq); acc = mma16(a[ks], bb, acc); }
            const int mp = mt * 16 + l15;
            *(LAS u32x2*)(Zt + (mp & 63) * ZS + (mp >> 6) * 64 + nt * 16 + 4 * hq) = pk4(acc); } }
    asm volatile("s_waitcnt lgkmcnt(0)" ::: "memory");
#pragma unroll 2
    for (int kt = 0; kt < 4; ++kt) {
        bf16x8 br[4], bi[4];
#pragma unroll
        for (int ks = 0; ks < 4; ++ks) { br[ks] = *(const bf16x8*)(T64R + (size_t)(kt * 16 + l15) * 128 + ks * 32 + 8 * hq); bi[ks] = *(const bf16x8*)(T64I + (size_t)(kt * 16 + l15) * 128 + ks * 32 + 8 * hq); }
        const int k1 = kt * 16 + l15; const f32x2 tw = TW[k1 * n2];
#pragma unroll
        for (int mt = 0; mt < 4; ++mt) { f32x4 ar = {0.f, 0.f, 0.f, 0.f}, ai = {0.f, 0.f, 0.f, 0.f};
#pragma unroll
            for (int ks = 0; ks < 4; ++ks) { const bf16x8 a = *(const LAS bf16x8*)(Zt + (mt * 16 + l15) * ZS + ks * 32 + 8 * hq); ar = mma16(a, br[ks], ar); ai = mma16(a, bi[ks], ai); }
            const f32x4 gr = ar * tw[0] + ai * tw[1], gi = ai * tw[0] - ar * tw[1];
            bf16_t* dst = GB + (size_t)k1 * 128 + mt * 16 + 4 * hq;
            *(u32x2*)dst = pk4(gr); *(u32x2*)(dst + 64) = pk4(gi); } }
    __syncthreads();
}
__device__ __forceinline__ void unit_fourier_lat2(const Ctx& C, int u) {
    const int b = u >> 5, g = (u >> 3) & 3, kb = u & 7, l15 = C.lane & 15, hq = C.lane >> 4, k1 = kb * 8 + C.wave;
    const bf16_t* T64B = (const bf16_t*)(C.ws + WS_T64B); bf16_t* MIX = (bf16_t*)(C.ws + WS_R1);
    const bf16_t* GB = (const bf16_t*)(C.ws + WS_GB) + (size_t)((b * 4 + g) * 64) * 64 * 128 + (size_t)k1 * 128;
    constexpr int ZS = 136; LAS bf16_t* Tt = (LAS bf16_t*)(C.lds + C.wave * (64 * ZS * 2));
#pragma unroll 4
    for (int it = 0; it < 16; ++it) { const int q = it * 64 + C.lane, n2 = q >> 4, cc = q & 15, part = cc >> 3, m0 = (cc & 7) * 8;
        const bf16x8 v = *(const bf16x8*)(GB + (size_t)n2 * 64 * 128 + cc * 8);
#pragma unroll
        for (int j = 0; j < 8; ++j) Tt[(m0 + j) * ZS + part * 64 + n2] = (bf16_t)v[j]; }
    asm volatile("s_waitcnt lgkmcnt(0)" ::: "memory");
#pragma unroll 2
    for (int kt = 0; kt < 4; ++kt) {
        bf16x8 bb[4];
#pragma unroll
        for (int ks = 0; ks < 4; ++ks) bb[ks] = *(const bf16x8*)(T64B + (size_t)(kt * 16 + l15) * 128 + ks * 32 + 8 * hq);
        const int k2 = kt * 16 + l15; const int row = M_CTX + b * 4096 + k1 + 64 * k2;
#pragma unroll
        for (int mt = 0; mt < 4; ++mt) { f32x4 acc = {0.f, 0.f, 0.f, 0.f};
#pragma unroll
            for (int ks = 0; ks < 4; ++ks) { const bf16x8 a = *(const LAS bf16x8*)(Tt + (mt * 16 + l15) * ZS + ks * 32 + 8 * hq); acc = mma16(a, bb[ks], acc); }
            *(u32x2*)(MIX + (size_t)row * D + 512 + g * 64 + mt * 16 + 4 * hq) = pk4(acc * (1.f / 512.f)); } }
    __syncthreads();
}
constexpr float QSCALE = 0.10206207261596577f * 1.4426950408889634f;
__device__ __forceinline__ void unit_mla_prep(const Ctx& C, int layer, int u) {
    const Params& p = C.p;
    const bf16_t* PROJ = (const bf16_t*)(C.ws + WS_R2);
    bf16_t* Q = (bf16_t*)(C.ws + WS_Q); bf16_t* KN = (bf16_t*)(C.ws + WS_KN); bf16_t* VT = (bf16_t*)(C.ws + WS_VT); bf16_t* KR = (bf16_t*)(C.ws + WS_KR);
    const f32x2* ROPE = (const f32x2*)(C.ws + WS_ROPE);
    constexpr int QS = 200, KS = 136;
    LAS bf16_t* CQ = (LAS bf16_t*)C.lds;
    LAS bf16_t* CK = (LAS bf16_t*)(C.lds + 128 * QS * 2);
    const bool is_tok = u < 192;
    int r0 = 0, keyrow0, keypos0, nk; size_t vtbase; bool lat;
    if (is_tok) { r0 = u * 128; lat = r0 >= M_CTX;
        if (!lat) { keyrow0 = r0; keypos0 = r0 & 255; nk = 256; vtbase = (size_t)(r0 & ~255) * 256; }
        else { const int b = (r0 - M_CTX) >> 12, n = (r0 - M_CTX) & 4095; keyrow0 = M_CTX + b * 4352 + n; keypos0 = n; nk = 4352; vtbase = (size_t)(M_CTX + b * 4352) * 256; } }
    else { const int cu = u - 192, b = cu >> 1, half = cu & 1; lat = true; keyrow0 = M_CTX + b * 4352 + 4096 + half * 128; keypos0 = 4096 + half * 128; nk = 4352; vtbase = (size_t)(M_CTX + b * 4352) * 256; }
    { const int t = C.tid >> 2, sub = C.tid & 3;
      if (is_tok) {
        const int r = r0 + t; const bf16_t* base = PROJ + (size_t)r * NP;
        float q[48], k[32]; float sq = 0.f, sk = 0.f;
#pragma unroll
        for (int i = 0; i < 6; ++i) { const bf16x8 v = *(const bf16x8*)(base + PC_Q + sub * 48 + i * 8);
#pragma unroll
            for (int j = 0; j < 8; ++j) { q[i * 8 + j] = bf1((bf16_t)v[j]); sq += q[i * 8 + j] * q[i * 8 + j]; } }
#pragma unroll
        for (int i = 0; i < 4; ++i) { const bf16x8 v = *(const bf16x8*)(base + PC_KV + sub * 32 + i * 8);
#pragma unroll
            for (int j = 0; j < 8; ++j) { k[i * 8 + j] = bf1((bf16_t)v[j]); sk += k[i * 8 + j] * k[i * 8 + j]; } }
        sq += __shfl_xor(sq, 1); sq += __shfl_xor(sq, 2); sk += __shfl_xor(sk, 1); sk += __shfl_xor(sk, 2);
        const float rq = 1.f / sqrtf(sq * (1.f / 192.f) + EPS), rk = 1.f / sqrtf(sk * (1.f / 128.f) + EPS);
        const float* gq = p.in[I_GQ] + layer * 192 + sub * 48; const float* gk = p.in[I_GKV] + layer * 128 + sub * 32;
#pragma unroll
        for (int i = 0; i < 6; ++i) { u32x4 w; w.x = pk2(q[i * 8 + 0] * rq * gq[i * 8 + 0], q[i * 8 + 1] * rq * gq[i * 8 + 1]); w.y = pk2(q[i * 8 + 2] * rq * gq[i * 8 + 2], q[i * 8 + 3] * rq * gq[i * 8 + 3]);
            w.z = pk2(q[i * 8 + 4] * rq * gq[i * 8 + 4], q[i * 8 + 5] * rq * gq[i * 8 + 5]); w.w = pk2(q[i * 8 + 6] * rq * gq[i * 8 + 6], q[i * 8 + 7] * rq * gq[i * 8 + 7]);
            *(LAS u32x4*)(CQ + t * QS + sub * 48 + i * 8) = w; }
        float* sckv = nullptr;
        if (!lat) { const int s = r >> 8, pos = r & 255; sckv = p.out + OUT_CKV + ((size_t)(s * 4 + layer) * 256 + pos) * 128 + sub * 32; }
#pragma unroll
        for (int i = 0; i < 4; ++i) { float o[8];
#pragma unroll
            for (int j = 0; j < 8; ++j) o[j] = k[i * 8 + j] * rk * gk[i * 8 + j];
            u32x4 w; w.x = pk2(o[0], o[1]); w.y = pk2(o[2], o[3]); w.z = pk2(o[4], o[5]); w.w = pk2(o[6], o[7]);
            *(LAS u32x4*)(CK + t * KS + sub * 32 + i * 8) = w;
            if (!lat) { *(f32x4*)(sckv + i * 8) = (f32x4){o[0], o[1], o[2], o[3]}; *(f32x4*)(sckv + i * 8 + 4) = (f32x4){o[4], o[5], o[6], o[7]}; } }
        { const bf16x8 v = *(const bf16x8*)(base + PC_KR + sub * 8); float x[8], o[8];
#pragma unroll
          for (int j = 0; j < 8; ++j) x[j] = bf1((bf16_t)v[j]);
          if (lat) { const int n = (r - M_CTX) & 4095; const int pos = (sub >> 1) == 0 ? (n >> 6) : (n & 63);
#pragma unroll
              for (int j = 0; j < 8; ++j) { const float pr = __shfl_xor(x[j], 1); const f32x2 cs = ROPE[pos * 8 + j]; o[j] = (sub & 1) == 0 ? x[j] * cs[0] - pr * cs[1] : x[j] * cs[0] + pr * cs[1]; } }
          else {
#pragma unroll
              for (int j = 0; j < 8; ++j) o[j] = x[j];
              const int s = r >> 8, pos = r & 255; float* skr = p.out + OUT_KR + ((size_t)(s * 4 + layer) * 256 + pos) * 32 + sub * 8;
              *(f32x4*)skr = (f32x4){o[0], o[1], o[2], o[3]}; *(f32x4*)(skr + 4) = (f32x4){o[4], o[5], o[6], o[7]}; }
          u32x4 w; w.x = pk2(o[0], o[1]); w.y = pk2(o[2], o[3]); w.z = pk2(o[4], o[5]); w.w = pk2(o[6], o[7]);
          *(u32x4*)(KR + (size_t)(keyrow0 + t) * 32 + sub * 8) = w; }
      } else {
        const int cu = u - 192, b = cu >> 1, half = cu & 1, row = half * 128 + t;
        const float* src = p.in[I_CCKV] + ((size_t)(b * 4 + layer) * 256 + row) * 128 + sub * 32;
#pragma unroll
        for (int i = 0; i < 4; ++i) { const f32x4 v0 = *(const f32x4*)(src + i * 8), v1 = *(const f32x4*)(src + i * 8 + 4);
            u32x4 w; w.x = pk2(v0[0], v0[1]); w.y = pk2(v0[2], v0[3]); w.z = pk2(v1[0], v1[1]); w.w = pk2(v1[2], v1[3]);
            *(LAS u32x4*)(CK + t * KS + sub * 32 + i * 8) = w; }
        const float* ksrc = p.in[I_CKR] + ((size_t)(b * 4 + layer) * 256 + row) * 32 + sub * 8;
        const f32x4 v0 = *(const f32x4*)ksrc, v1 = *(const f32x4*)(ksrc + 4);
        u32x4 w; w.x = pk2(v0[0], v0[1]); w.y = pk2(v0[2], v0[3]); w.z = pk2(v1[0], v1[1]); w.w = pk2(v1[2], v1[3]);
        *(u32x4*)(KR + (size_t)(keyrow0 + t) * 32 + sub * 8) = w;
      } }
    __syncthreads();
    const int l15 = C.lane & 15, hq = C.lane >> 4, w = C.wave;
    if (is_tok) {
        const bf16_t* Wq = (const bf16_t*)(C.wl(layer) + WL_UQ);
        bf16x8 aq[3][6];
#pragma unroll
        for (int j = 0; j < 3; ++j)
#pragma unroll
            for (int ks = 0; ks < 6; ++ks) aq[j][ks] = *(const bf16x8*)(Wq + (size_t)((3 * w + j) * 16 + l15) * 192 + ks * 32 + 8 * hq);
#pragma unroll 2
        for (int tt = 0; tt < 8; ++tt) {
            bf16x8 bq[6];
#pragma unroll
            for (int ks = 0; ks < 6; ++ks) bq[ks] = *(const LAS bf16x8*)(CQ + (tt * 16 + l15) * QS + ks * 32 + 8 * hq);
            const int r = r0 + tt * 16 + l15; const int n = (r - M_CTX) & 4095;
#pragma unroll
            for (int j = 0; j < 3; ++j) { const int nt = 3 * w + j; f32x4 acc = {0.f, 0.f, 0.f, 0.f};
#pragma unroll
                for (int ks = 0; ks < 6; ++ks) acc = mma16(aq[j][ks], bq[ks], acc);
                const int sub6 = nt % 6;
                if (lat && sub6 >= 4) { const int pos = sub6 == 4 ? (n >> 6) : (n & 63);
#pragma unroll
                    for (int jj = 0; jj < 4; ++jj) { const float pr = __shfl_xor(acc[jj], 32); const f32x2 cs = ROPE[pos * 8 + ((4 * hq + jj) & 7)]; acc[jj] = hq < 2 ? acc[jj] * cs[0] - pr * cs[1] : acc[jj] * cs[0] + pr * cs[1]; } }
                *(u32x2*)(Q + (size_t)r * 384 + nt * 16 + 4 * hq) = pk4(acc * QSCALE); }
        }
    }
    { const bf16_t* Wkv = (const bf16_t*)(C.wl(layer) + WL_UKV);
      bf16x8 wf[4][4];
#pragma unroll
      for (int j = 0; j < 4; ++j)
#pragma unroll
          for (int ks = 0; ks < 4; ++ks) wf[j][ks] = *(const bf16x8*)(Wkv + (size_t)((4 * w + j) * 16 + l15) * 128 + ks * 32 + 8 * hq);
      const int h = w >> 1; const bool isv = (w & 1) != 0;
#pragma unroll 2
      for (int tt = 0; tt < 8; ++tt) {
          bf16x8 ck[4];
#pragma unroll
          for (int ks = 0; ks < 4; ++ks) ck[ks] = *(const LAS bf16x8*)(CK + (tt * 16 + l15) * KS + ks * 32 + 8 * hq);
#pragma unroll
          for (int j = 0; j < 4; ++j) { f32x4 acc = {0.f, 0.f, 0.f, 0.f};
              if (!isv) {
#pragma unroll
                  for (int ks = 0; ks < 4; ++ks) acc = mma16(wf[j][ks], ck[ks], acc);
                  *(u32x2*)(KN + (size_t)(keyrow0 + tt * 16 + l15) * 256 + h * 64 + j * 16 + 4 * hq) = pk4(acc);
              } else {
#pragma unroll
                  for (int ks = 0; ks < 4; ++ks) acc = mma16(ck[ks], wf[j][ks], acc);
                  *(u32x2*)(VT + vtbase + (size_t)(h * 64 + j * 16 + l15) * nk + keypos0 + tt * 16 + 4 * hq) = pk4(acc);
              } } } }
    __syncthreads();
}

constexpr int AKS = 104, AVS = 72;
constexpr int ABUF = 64 * AKS * 2 + 64 * AVS * 2;
__device__ __forceinline__ int imax3(int a, int b, int c) { return max(a, max(b, c)); }
constexpr int AVS2 = 136; constexpr int ABUF2 = 128 * AKS * 2 + 64 * AVS2 * 2;
__device__ __forceinline__ void unit_attention(const Ctx& C, int u) {
    int rowbase, keyrow0, nk, h; size_t vtbase;
    if (u < 128) { const int s = u >> 2; h = u & 3; rowbase = s * 256; keyrow0 = s * 256; nk = 256; vtbase = (size_t)(s * 256) * 256; }
    else { const int v0 = u - 128; const int v = (C.G == 256) ? (((v0 & 7) * 2 + (v0 >> 7)) << 4) | ((v0 >> 3) & 15) : v0;
           const int b = v >> 6, qb = v & 15; h = (v >> 4) & 3; rowbase = M_CTX + b * 4096 + qb * 256; keyrow0 = M_CTX + b * 4352; nk = 4352; vtbase = (size_t)keyrow0 * 256; }
    const bf16_t* Q = (const bf16_t*)(C.ws + WS_Q); const bf16_t* KN = (const bf16_t*)(C.ws + WS_KN); const bf16_t* VT = (const bf16_t*)(C.ws + WS_VT); const bf16_t* KR = (const bf16_t*)(C.ws + WS_KR);
    bf16_t* MIX = (bf16_t*)(C.ws + WS_R1);
    const int l31 = C.lane & 31, hh = C.lane >> 5; const int qrow = rowbase + C.wave * 32 + l31;
    bf16x8 qf[6];
#pragma unroll
    for (int ks = 0; ks < 6; ++ks) qf[ks] = *(const bf16x8*)(Q + (size_t)qrow * 384 + h * 96 + ks * 16 + 8 * hh);
    f32x16 o0, o1, o2, negm;
#pragma unroll
    for (int i = 0; i < 16; ++i) { o0[i] = 0.f; o1[i] = 0.f; o2[i] = 0.f; negm[i] = 0.f; }
    const unsigned onew = (l31 == 0) ? 0x3F803F80u : 0u;
    const bf16x8 onesf = __builtin_bit_cast(bf16x8, (u32x4){onew, onew, onew, onew});
    const int skey = C.tid >> 3, sc8 = (C.tid & 7) * 8, rkey = (C.tid & 255) >> 2, rc8 = (C.tid & 3) * 8;
    const bf16_t* gkn = KN + (size_t)(keyrow0 + skey) * 256 + h * 64 + sc8;
    const bf16_t* gkr = KR + (size_t)(keyrow0 + rkey) * 32 + rc8;
    const bf16_t* gvt = VT + vtbase + (size_t)(h * 64 + skey) * nk + sc8;
    const bool do_r = C.tid < 256;
    const int lkn = (skey * AKS + sc8) * 2, lkr = (rkey * AKS + 64 + rc8) * 2, lvt = 128 * AKS * 2 + (skey * AVS2 + sc8) * 2;
    const int ntile = nk >> 7;
    u32x4 rk[2], rr[2] = {{0u, 0u, 0u, 0u}, {0u, 0u, 0u, 0u}}, rv[2];
#define ATT_LD(t) do { _Pragma("unroll") for (int s_ = 0; s_ < 2; ++s_) { rk[s_] = *(const u32x4*)(gkn + (size_t)(2 * (t) + s_) * 64 * 256); if (do_r) rr[s_] = *(const u32x4*)(gkr + (size_t)(2 * (t) + s_) * 64 * 32); rv[s_] = *(const u32x4*)(gvt + (2 * (t) + s_) * 64); } } while (0)
#define ATT_ST(buf) do { LAS unsigned char* b_ = C.lds + (buf) * ABUF2; _Pragma("unroll") for (int s_ = 0; s_ < 2; ++s_) { *(LAS u32x4*)(b_ + lkn + s_ * 64 * AKS * 2) = rk[s_]; if (do_r) *(LAS u32x4*)(b_ + lkr + s_ * 64 * AKS * 2) = rr[s_]; *(LAS u32x4*)(b_ + lvt + s_ * 128) = rv[s_]; } } while (0)
    ATT_LD(0); ATT_ST(0);
    __syncthreads();
#pragma unroll 1
    for (int kt = 0; kt < ntile; ++kt) {
        const bool more = kt + 1 < ntile;
        if (more) ATT_LD(kt + 1);
        LAS unsigned char* B = C.lds + (kt & 1) * ABUF2;
#pragma unroll 1
        for (int sub = 0; sub < 2; ++sub) {
        const LAS bf16_t* Kl = (const LAS bf16_t*)B + sub * 64 * AKS; const LAS bf16_t* Vl = (const LAS bf16_t*)(B + 128 * AKS * 2) + sub * 64;
        bf16x8 ka[2][6];
#pragma unroll
        for (int ks = 0; ks < 6; ++ks) { ka[0][ks] = *(const LAS bf16x8*)(Kl + l31 * AKS + ks * 16 + 8 * hh); ka[1][ks] = *(const LAS bf16x8*)(Kl + (32 + l31) * AKS + ks * 16 + 8 * hh); }
        __builtin_amdgcn_sched_barrier(0);
        f32x16 s0 = mma32(ka[0][0], qf[0], negm), s1 = mma32(ka[1][0], qf[0], negm);
#pragma unroll
        for (int ks = 1; ks < 6; ++ks) { s0 = mma32(ka[0][ks], qf[ks], s0); s1 = mma32(ka[1][ks], qf[ks], s1); }
        __builtin_amdgcn_sched_barrier(0);
        u32x2 vr[2][2][4];
#pragma unroll
        for (int t = 0; t < 2; ++t)
#pragma unroll
            for (int ss = 0; ss < 2; ++ss) { const int ko = 32 * t + 16 * ss + 4 * hh;
                vr[t][ss][0] = *(const LAS u32x2*)(Vl + l31 * AVS2 + ko); vr[t][ss][1] = *(const LAS u32x2*)(Vl + l31 * AVS2 + ko + 8);
                vr[t][ss][2] = *(const LAS u32x2*)(Vl + (32 + l31) * AVS2 + ko); vr[t][ss][3] = *(const LAS u32x2*)(Vl + (32 + l31) * AVS2 + ko + 8); }
        __builtin_amdgcn_sched_barrier(0);
        float d; bool resc;
        if (kt == 0 && sub == 0) {
            float mx = fmaxf(s0[0], s1[0]);
#pragma unroll
            for (int i = 1; i < 16; ++i) mx = fmaxf(mx, fmaxf(s0[i], s1[i]));
            d = fmaxf(mx, __shfl_xor(mx, 32)); resc = true;
        } else {
            int im = imax3(__builtin_bit_cast(int, s0[0]), __builtin_bit_cast(int, s1[0]), __builtin_bit_cast(int, s0[1]));
            im = imax3(im, __builtin_bit_cast(int, s1[1]), __builtin_bit_cast(int, s0[2])); im = imax3(im, __builtin_bit_cast(int, s1[2]), __builtin_bit_cast(int, s0[3]));
            im = imax3(im, __builtin_bit_cast(int, s1[3]), __builtin_bit_cast(int, s0[4])); im = imax3(im, __builtin_bit_cast(int, s1[4]), __builtin_bit_cast(int, s0[5]));
            im = imax3(im, __builtin_bit_cast(int, s1[5]), __builtin_bit_cast(int, s0[6])); im = imax3(im, __builtin_bit_cast(int, s1[6]), __builtin_bit_cast(int, s0[7]));
            im = imax3(im, __builtin_bit_cast(int, s1[7]), __builtin_bit_cast(int, s0[8])); im = imax3(im, __builtin_bit_cast(int, s1[8]), __builtin_bit_cast(int, s0[9]));
            im = imax3(im, __builtin_bit_cast(int, s1[9]), __builtin_bit_cast(int, s0[10])); im = imax3(im, __builtin_bit_cast(int, s1[10]), __builtin_bit_cast(int, s0[11]));
            im = imax3(im, __builtin_bit_cast(int, s1[11]), __builtin_bit_cast(int, s0[12])); im = imax3(im, __builtin_bit_cast(int, s1[12]), __builtin_bit_cast(int, s0[13]));
            im = imax3(im, __builtin_bit_cast(int, s1[13]), __builtin_bit_cast(int, s0[14])); im = imax3(im, __builtin_bit_cast(int, s1[14]), __builtin_bit_cast(int, s0[15]));
            im = max(im, __builtin_bit_cast(int, s1[15]));
            im = max(im, __shfl_xor(im, 32));
            resc = __builtin_amdgcn_ballot_w64(im > 0x41000000) != 0ull; d = im > 0x41000000 ? __builtin_bit_cast(float, im) : 0.f;
        }
        if (resc) {
            if (kt != 0 || sub != 0) { const float alpha = __builtin_amdgcn_exp2f(-d); o0 = o0 * alpha; o1 = o1 * alpha; o2 = o2 * alpha; }
            negm = negm - d; s0 = s0 - d; s1 = s1 - d;
        }
#pragma unroll
        for (int i = 0; i < 16; ++i) { s0[i] = __builtin_amdgcn_exp2f(s0[i]); s1[i] = __builtin_amdgcn_exp2f(s1[i]); }
#pragma unroll
        for (int t = 0; t < 2; ++t)
#pragma unroll
            for (int ss = 0; ss < 2; ++ss) {
                u32x4 w;
                if (t == 0) { w.x = pk2(s0[8 * ss + 0], s0[8 * ss + 1]); w.y = pk2(s0[8 * ss + 2], s0[8 * ss + 3]); w.z = pk2(s0[8 * ss + 4], s0[8 * ss + 5]); w.w = pk2(s0[8 * ss + 6], s0[8 * ss + 7]); }
                else { w.x = pk2(s1[8 * ss + 0], s1[8 * ss + 1]); w.y = pk2(s1[8 * ss + 2], s1[8 * ss + 3]); w.z = pk2(s1[8 * ss + 4], s1[8 * ss + 5]); w.w = pk2(s1[8 * ss + 6], s1[8 * ss + 7]); }
                const bf16x8 pf = __builtin_bit_cast(bf16x8, w);
                const bf16x8 va = __builtin_bit_cast(bf16x8, (u32x4){vr[t][ss][0].x, vr[t][ss][0].y, vr[t][ss][1].x, vr[t][ss][1].y}), vb = __builtin_bit_cast(bf16x8, (u32x4){vr[t][ss][2].x, vr[t][ss][2].y, vr[t][ss][3].x, vr[t][ss][3].y});
                o0 = mma32(va, pf, o0); o1 = mma32(vb, pf, o1); o2 = mma32(onesf, pf, o2);
            }
        }
        if (more) ATT_ST((kt + 1) & 1);
        __syncthreads();
    }
#undef ATT_LD
#undef ATT_ST
    const float lsum = o2[0] + __shfl_xor(o2[0], 32);
    const float inv = 1.f / lsum;
    bf16_t* orow = MIX + (size_t)qrow * D + 768 + h * 64;
#pragma unroll
    for (int i = 0; i < 4; ++i) { const int dv = 8 * i + 4 * hh;
        *(u32x2*)(orow + dv) = pk4((f32x4){o0[4 * i] * inv, o0[4 * i + 1] * inv, o0[4 * i + 2] * inv, o0[4 * i + 3] * inv});
        *(u32x2*)(orow + 32 + dv) = pk4((f32x4){o1[4 * i] * inv, o1[4 * i + 1] * inv, o1[4 * i + 2] * inv, o1[4 * i + 3] * inv}); }
}

#define XB_TMO      128
#define XB_XCNT(j)  (256  + 64 * (j))
#define XB_XSUB(j)  (1280 + 64 * (j))
#define XB_XGEN(j)  (2304 + 64 * (j))
#define XB_TOP      3328
#define XB_TOPGEN   3392
#define XCD_BAR_WORDS 3456
#define XB_SPIN_CAP (1u << 18)

__device__ __forceinline__ unsigned xb_ld(unsigned* p)              { return __hip_atomic_load(p, __ATOMIC_RELAXED, __HIP_MEMORY_SCOPE_AGENT); }
__device__ __forceinline__ unsigned xb_add(unsigned* p, unsigned v) { return __hip_atomic_fetch_add(p, v, __ATOMIC_RELAXED, __HIP_MEMORY_SCOPE_AGENT); }
__device__ __forceinline__ unsigned xb_xcc_id() { return (unsigned)__builtin_amdgcn_s_getreg((3 << 11) | 20) & 0xFu; }
#define XB_SPIN(cond, bar) do { unsigned _sp = 0; while (cond) { __builtin_amdgcn_s_sleep(1); \
    if ((++_sp & 255u) == 0u) { if (xb_ld(&(bar)[XB_TMO])) break; if (_sp > XB_SPIN_CAP) { atomicAdd(&(bar)[XB_TMO], 1u); break; } } } } while (0)

struct XcdBarrier {
    unsigned* bar; unsigned x;
    volatile LAS unsigned* st;
};

__device__ __forceinline__ XcdBarrier xcd_barrier_post(unsigned* bar, volatile LAS unsigned* st) {
    XcdBarrier b; b.bar = bar; b.x = xb_xcc_id(); b.st = st;
    if (threadIdx.x == 0) (void)xb_add(&bar[XB_XCNT(b.x)], 1u);
    return b;
}
__device__ __forceinline__ void xcd_barrier_complete(unsigned* bar, unsigned x, unsigned& nloc, unsigned& nx) {
    const unsigned G = gridDim.x * gridDim.y * gridDim.z;
    unsigned sum, cnt, mine, sp = 0u;
    for (;;) {
        sum = 0u; cnt = 0u; mine = 0u;
#pragma unroll
        for (unsigned j = 0; j < 16; ++j) { const unsigned c = xb_ld(&bar[XB_XCNT(j)]); sum += c; cnt += (c > 0u) ? 1u : 0u; mine = (j == x) ? c : mine; }
        if (sum == G) break;
        __builtin_amdgcn_s_sleep(1);
        if ((++sp & 255u) == 0u) { if (xb_ld(&bar[XB_TMO])) break; if (sp > XB_SPIN_CAP) { atomicAdd(&bar[XB_TMO], 1u); break; } }
    }
    nloc = mine > 0u ? mine : 1u; nx = cnt > 0u ? cnt : 1u;
}

__device__ __forceinline__ void xcd_barrier(const XcdBarrier& b) {
    asm volatile("s_waitcnt vmcnt(0)" ::: "memory");
    __syncthreads();
    if (threadIdx.x == 0) {
        unsigned* bar = b.bar;
        __builtin_amdgcn_s_waitcnt(0);
        unsigned nloc = b.st[0], nx = b.st[1];
        if (nloc == 0u) { xcd_barrier_complete(bar, b.x, nloc, nx); b.st[0] = nloc; b.st[1] = nx; }
        const unsigned old = xb_add(&bar[XB_XSUB(b.x)], 1u);
        const unsigned gen = old / nloc;
        if (old + 1u == (gen + 1u) * nloc) {
            __builtin_amdgcn_fence(__ATOMIC_RELEASE, "agent");
            asm volatile("s_waitcnt vmcnt(0)" ::: "memory");
            const unsigned og = xb_add(&bar[XB_TOP], 1u);
            const unsigned tg = og / nx;
            if (og + 1u == (tg + 1u) * nx) xb_add(&bar[XB_TOPGEN], 1u);
            else XB_SPIN(xb_ld(&bar[XB_TOPGEN]) == tg, bar);
            __builtin_amdgcn_fence(__ATOMIC_ACQUIRE, "agent");
            xb_add(&bar[XB_XGEN(b.x)], 1u);
            asm volatile("s_waitcnt vmcnt(0)" ::: "memory");
        } else {
            XB_SPIN(xb_ld(&bar[XB_XGEN(b.x)]) == gen, bar);
            __builtin_amdgcn_fence(__ATOMIC_ACQUIRE, "agent");
            asm volatile("s_waitcnt vmcnt(0)" ::: "memory");
        }
    }
    __syncthreads();
}

__global__ void __launch_bounds__(NTHREADS, 2) mk_fwd(Params p) {
    extern __shared__ __attribute__((aligned(16))) unsigned char lds_raw[];
    cg::grid_group grid = cg::this_grid();
    Ctx C; C.p = p; C.lds = (LAS unsigned char*)lds_raw; C.tid = threadIdx.x; C.lane = C.tid & 63; C.wave = __builtin_amdgcn_readfirstlane(C.tid >> 6); C.bid = blockIdx.x; C.G = gridDim.x; C.ws = p.ws;

    volatile LAS unsigned* bst = (volatile LAS unsigned*)(C.lds + LDS_BYTES - 64);
    if (threadIdx.x < 2) bst[threadIdx.x] = 0u;
    __syncthreads();
    const XcdBarrier bar = xcd_barrier_post((unsigned*)(p.ws + WS_BAR), bst);
    C.refresh(); phase_prologue(C);
    grid.sync();
    C.refresh(); phase_norm0(C);
    xcd_barrier(bar);
#pragma unroll 1
    for (int layer = 0; layer < DEPTH; ++layer) {
        { C.refresh(); bf16_t* R1 = (bf16_t*)(C.ws + WS_R1); bf16_t* R2 = (bf16_t*)(C.ws + WS_R2); unsigned char* wl = C.wl(layer); pg8::Gemm g{R1, (const bf16_t*)(wl + WL_IN), M, NPP, D}; pg8::StaticOrder S; S.init(M, NPP, C.G, C.bid); pg8::EpiStore E{R2, NP, NP};
          pg8::gemm_phase<pg8::EpiStore, pg8::StaticOrder, true, true>(C.lds, g, S, E); }
        xcd_barrier(bar);
        C.refresh();
        for (int u = C.bid; u < 768 + 192 + 128 + 128 + 200; u += C.G) {
            C.refresh();
            if (u < 768) unit_chunk_mlp(C, layer, u);
            else if (u < 960) unit_conv(C, layer, u - 768);
            else if (u < 1088) unit_fourier_ctx(C, u - 960);
            else if (u < 1216) unit_fourier_lat1(C, u - 1088);
            else unit_mla_prep(C, layer, u - 1216);
        }
        xcd_barrier(bar);
        C.refresh();
        for (int u = C.bid; u < 512; u += C.G) {
            C.refresh();
            if (u < 256) unit_attention(C, 128 + u);
            else if (u < 384) unit_attention(C, u - 256);
            else unit_fourier_lat2(C, u - 384);
        }
        xcd_barrier(bar);
        { C.refresh(); bf16_t* R1 = (bf16_t*)(C.ws + WS_R1); bf16_t* R2 = (bf16_t*)(C.ws + WS_R2); unsigned char* wl = C.wl(layer); pg8::Gemm g{R1, (const bf16_t*)(wl + WL_OUT), M, D, D}; pg8::SplitTailOrder S; S.init(D, C.G, C.bid); pg8::EpiStoreSplit E{R2, R2 + (size_t)M * D - (size_t)SPLIT_ROW0 * D, D};
          pg8::gemm_phase<pg8::EpiStoreSplit, pg8::SplitTailOrder, true, true>(C.lds, g, S, E); }
        xcd_barrier(bar);
        C.refresh(); phase_post<0>(C, layer);
        xcd_barrier(bar);
        { C.refresh(); bf16_t* R1 = (bf16_t*)(C.ws + WS_R1); bf16_t* R2 = (bf16_t*)(C.ws + WS_R2); unsigned char* wl = C.wl(layer); pg8::Gemm g{R1, (const bf16_t*)(wl + WL_GU), M, 2 * FF, D}; pg8::StaticOrder S; S.init(M, 2 * FF, C.G, C.bid); pg8::EpiSwiGLU E{R2, FF};
          pg8::gemm_phase<pg8::EpiSwiGLU, pg8::StaticOrder, true, true>(C.lds, g, S, E);
          if (C.G == 256 && layer + 1 < DEPTH && C.bid >= 64) { C.refresh(); transpose_items(C, (layer + 1) * TI_L + (C.bid - 64), 192, (layer + 2) * TI_L); } }
        xcd_barrier(bar);
        { C.refresh(); bf16_t* R2 = (bf16_t*)(C.ws + WS_R2); bf16_t* R3 = (bf16_t*)(C.ws + WS_MLA); unsigned char* wl = C.wl(layer); pg8::Gemm g{R2, (const bf16_t*)(wl + WL_DN), M, D, FF}; pg8::SplitTailOrder S; S.init(FF, C.G, C.bid); pg8::EpiStoreSplit E{R3, R3 + (size_t)M * D - (size_t)SPLIT_ROW0 * D, D};
          pg8::gemm_phase<pg8::EpiStoreSplit, pg8::SplitTailOrder, true, true>(C.lds, g, S, E); }
        xcd_barrier(bar);
        C.refresh(); phase_post<1>(C, layer);
        if (layer + 1 < DEPTH) xcd_barrier(bar);
    }
}

extern "C" void kernel_launch(void* const* d_in, const int* in_sizes, int n_in, void* d_out, int out_size, void* d_ws, size_t ws_size, hipStream_t stream) {
    static int grid = 0;
    if (grid == 0) {
        if (n_in != 24 || ws_size < WS_END) { fprintf(stderr, "kernel_launch: need 24 inputs and %zu bytes of workspace; got %d, %zu\n", (size_t)WS_END, n_in, ws_size); grid = -1; return; }
        int dev = 0, cus = 0, per_cu = 0;
        if (hipGetDevice(&dev) != hipSuccess || hipDeviceGetAttribute(&cus, hipDeviceAttributeMultiprocessorCount, dev) != hipSuccess) { grid = -1; return; }
        if (hipFuncSetAttribute((const void*)mk_fwd, hipFuncAttributeMaxDynamicSharedMemorySize, LDS_BYTES) != hipSuccess) { fprintf(stderr, "kernel_launch: hipFuncSetAttribute failed\n"); grid = -1; return; }
        if (hipOccupancyMaxActiveBlocksPerMultiprocessor(&per_cu, (const void*)mk_fwd, NTHREADS, LDS_BYTES) != hipSuccess || per_cu < 1) fprintf(stderr, "kernel_launch: occupancy query says %d blocks per CU\n", per_cu);
        (void)hipGetLastError();
        grid = cus;
    }
    if (grid < 0) return;
    Params p{};
    for (int i = 0; i < 24; ++i) p.in[i] = (const float*)d_in[i];
    p.out = (float*)d_out; p.ws = (unsigned char*)d_ws;
    if (hipMemsetAsync((char*)d_ws + WS_BAR, 0, WS_BAR_BYTES, stream) != hipSuccess) { fprintf(stderr, "kernel_launch: memset failed\n"); return; }
    void* args[] = {&p};
    hipError_t e = hipLaunchCooperativeKernel((const void*)mk_fwd, dim3(grid), dim3(NTHREADS), args, LDS_BYTES, stream);
    if (e != hipSuccess) fprintf(stderr, "kernel_launch: cooperative launch failed: %s (grid %d)\n", hipGetErrorString(e), grid);
}
```

```cpp
#include <hip/hip_runtime.h>
#include <hip/hip_cooperative_groups.h>
#include <cstdio>
#include <cstdint>
namespace cg = cooperative_groups;
namespace pg8 {
#define PG8_LAS __attribute__((address_space(3)))
typedef unsigned short bf16_t;
typedef short bf16x8 __attribute__((ext_vector_type(8)));
typedef float f32x4 __attribute__((ext_vector_type(4)));
typedef unsigned u32x4 __attribute__((ext_vector_type(4)));
constexpr int BM = 256, BK = 64, HALF = 128, HTB = HALF * BK * 2  , STAGE_BYTES = 8 * HTB, NXCD = 8, WGM = 8;

__host__ __device__ __forceinline__ int lds_byte(int r, int c) { const int st = (r >> 4) * 2 + (c >> 5), rr = r & 15, cc = c & 31, ob = rr * 64 + cc * 2; return st * 1024 + (ob ^ (((ob >> 9) & 1) << 5)); }
__host__ __device__ __forceinline__ void stage_rc(int b, int& R, int& C) { const int st = b / 1024, sb = b % 1024, swz = sb ^ (((sb >> 9) & 1) << 5); R = (st >> 1) * 16 + swz / 64; C = (st & 1) * 32 + (swz % 64) / 2; }
__host__ __device__ __forceinline__ int perm32(int rho) { const int n = rho >> 4, i = rho & 15; return 8 * (i >> 2) + 4 * n + (i & 3); }

struct Unit { int pm, pn; int kh, nt, koff; };
struct Gemm { const bf16_t* A; const bf16_t* Bt; int M, N, K; };

struct StaticOrder {
    int nM, nN, nwg, G, c;
    __host__ __device__ void init(int M, int N, int G_, int c_) { nM = M / BM; nN = N / BM; nwg = nM * nN; G = G_; c = c_; }
    __host__ __device__ bool next(int i, Unit& u) const {
        const long L = (long)i * G + c; if (L >= nwg) return false;
        int wgid = (int)L; { const int q = nwg / NXCD, r = nwg % NXCD, xcd = wgid % NXCD, off = wgid / NXCD; wgid = (xcd < r ? xcd * (q + 1) : r * (q + 1) + (xcd - r) * q) + off; }
        const int nig = WGM * nN, gid = wgid / nig, fm = gid * WGM, gsz = (nM - fm) < WGM ? (nM - fm) : WGM;
        u.pm = fm + ((wgid % nig) % gsz); u.pn = (wgid % nig) / gsz; u.kh = 0; u.nt = 0; u.koff = 0; return true;
    }
    __device__ __forceinline__ void a_ready(const Unit&) const {}
    __device__ __forceinline__ void done(const Unit&) const {}
};

__device__ __forceinline__ unsigned cvt_pk_bf16(float lo, float hi) { unsigned r; asm volatile("v_cvt_pk_bf16_f32 %0, %1, %2" : "=v"(r) : "v"(lo), "v"(hi)); return r; }
typedef float f32x2 __attribute__((ext_vector_type(2)));
struct EpiStore {
    static constexpr bool PERM = true, AFTER_DRAIN = false;
    bf16_t* O; int ldc; int ncols;
    __device__ __forceinline__ void operator()(const f32x4 (&acc)[2][2][4][2], const Unit& u, int wr, int wc, int fr, int fq) const {
        const int row0 = u.pm * BM + wr * 64 + fr; const int col0 = u.pn * BM + wc * 32 + 8 * fq;
#pragma unroll
        for (int ai = 0; ai < 2; ++ai)
#pragma unroll
            for (int m = 0; m < 4; ++m) { bf16_t* rowp = O + (size_t)(row0 + ai * HALF + m * 16) * ldc + col0;
#pragma unroll
                for (int bj = 0; bj < 2; ++bj) { const f32x4 v0 = acc[ai][bj][m][0], v1 = acc[ai][bj][m][1];
                    u32x4 w; w.x = cvt_pk_bf16(v0[0], v0[1]); w.y = cvt_pk_bf16(v0[2], v0[3]); w.z = cvt_pk_bf16(v1[0], v1[1]); w.w = cvt_pk_bf16(v1[2], v1[3]);
                    if (col0 + bj * HALF < ncols) *(u32x4*)(rowp + bj * HALF) = w; } }
    }
};
struct EpiStoreWT {
    static constexpr bool PERM = true, AFTER_DRAIN = false;
    bf16_t* O; int ldc; int ncols;
    __device__ __forceinline__ void operator()(const f32x4 (&acc)[2][2][4][2], const Unit& u, int wr, int wc, int fr, int fq) const {
        const int row0 = u.pm * BM + wr * 64 + fr; const int col0 = u.pn * BM + wc * 32 + 8 * fq;
#pragma unroll
        for (int ai = 0; ai < 2; ++ai)
#pragma unroll
            for (int m = 0; m < 4; ++m) { bf16_t* rowp = O + (size_t)(row0 + ai * HALF + m * 16) * ldc + col0;
#pragma unroll
                for (int bj = 0; bj < 2; ++bj) { const f32x4 v0 = acc[ai][bj][m][0], v1 = acc[ai][bj][m][1];
                    const unsigned long long lo = (unsigned long long)cvt_pk_bf16(v0[0], v0[1]) | ((unsigned long long)cvt_pk_bf16(v0[2], v0[3]) << 32);
                    const unsigned long long hi = (unsigned long long)cvt_pk_bf16(v1[0], v1[1]) | ((unsigned long long)cvt_pk_bf16(v1[2], v1[3]) << 32);
                    unsigned long long* q = (unsigned long long*)(rowp + bj * HALF);
                    __hip_atomic_store(q, lo, __ATOMIC_RELAXED, __HIP_MEMORY_SCOPE_AGENT); __hip_atomic_store(q + 1, hi, __ATOMIC_RELAXED, __HIP_MEMORY_SCOPE_AGENT); } }
    }
};
__device__ __forceinline__ float silu_mul(float g, float u) { return g * u * __builtin_amdgcn_rcpf(1.f + __expf(-g)); }
struct EpiSwiGLU {
    static constexpr bool PERM = true, AFTER_DRAIN = false;
    bf16_t* O; int ldc;
    __device__ __forceinline__ void operator()(const f32x4 (&acc)[2][2][4][2], const Unit& u, int wr, int wc, int fr, int fq) const {
        const int row0 = u.pm * BM + wr * 64 + fr; const int col0 = u.pn * HALF + wc * 32 + 8 * fq;
#pragma unroll
        for (int ai = 0; ai < 2; ++ai)
#pragma unroll
            for (int m = 0; m < 4; ++m) { bf16_t* rowp = O + (size_t)(row0 + ai * HALF + m * 16) * ldc + col0;
                const f32x4 g0 = acc[ai][0][m][0], g1 = acc[ai][0][m][1], u0 = acc[ai][1][m][0], u1 = acc[ai][1][m][1];
                u32x4 w; w.x = cvt_pk_bf16(silu_mul(g0[0], u0[0]), silu_mul(g0[1], u0[1])); w.y = cvt_pk_bf16(silu_mul(g0[2], u0[2]), silu_mul(g0[3], u0[3]));
                w.z = cvt_pk_bf16(silu_mul(g1[0], u1[0]), silu_mul(g1[1], u1[1])); w.w = cvt_pk_bf16(silu_mul(g1[2], u1[2]), silu_mul(g1[3], u1[3]));
                *(u32x4*)rowp = w; }
    }
};

struct PanelOrder {
    int nN, nwg, G, c; unsigned* cnt;
    __device__ void init(int M, int N, int G_, int c_, unsigned* cnt_) { nN = N / BM; nwg = (M / BM) * nN; G = G_; c = c_; cnt = cnt_; }
    __device__ bool next(int i, Unit& u) const { const long L = (long)i * G + c; if (L >= nwg) return false; u.pm = (int)L / nN; u.pn = (int)L % nN; u.kh = 0; u.nt = 0; u.koff = 0; return true; }
    __device__ __forceinline__ void a_ready(const Unit&) const {}
    __device__ __forceinline__ void done(const Unit& u) const {
        asm volatile("s_waitcnt vmcnt(0)" ::: "memory");
        if ((threadIdx.x & 63) == 0) __hip_atomic_fetch_add(cnt + u.pm, 1u, __ATOMIC_RELAXED, __HIP_MEMORY_SCOPE_AGENT);
    }
};

struct SplitTailOrder {
    int G, c, ntf; bool split;
    __device__ void init(int K, int G_, int c_) { G = G_; c = c_; ntf = K / BK; split = (G_ == 256); }
    __device__ bool next(int i, Unit& u) const {
        if (!split) { const long L = (long)i * G + c; if (L >= 384) return false; u.pm = (int)L >> 2; u.pn = (int)L & 3; u.kh = 0; u.nt = 0; u.koff = 0; return true; }
        if (i == 0) { const int t = (c & 7) * 32 + (c >> 3); u.pm = t >> 2; u.pn = t & 3; u.kh = 0; u.nt = 0; u.koff = 0; return true; }
        if (i == 1) { const int t = 256 + (c & 7) * 16 + (c >> 4); u.pm = t >> 2; u.pn = t & 3; u.kh = (c >> 3) & 1; u.nt = ntf / 2; u.koff = u.kh * (ntf / 2) * BK * 2; return true; }
        return false;
    }
    __device__ __forceinline__ void a_ready(const Unit&) const {}
    __device__ __forceinline__ void done(const Unit&) const {}
};
struct EpiStoreSplit {
    static constexpr bool PERM = true, AFTER_DRAIN = false;
    bf16_t* O; bf16_t* O1; int ldc;
    __device__ __forceinline__ void operator()(const f32x4 (&acc)[2][2][4][2], const Unit& u, int wr, int wc, int fr, int fq) const {
        const int row0 = u.pm * BM + wr * 64 + fr; const int col0 = u.pn * BM + wc * 32 + 8 * fq; bf16_t* base = u.kh ? O1 : O;
#pragma unroll
        for (int ai = 0; ai < 2; ++ai)
#pragma unroll
            for (int m = 0; m < 4; ++m) { bf16_t* rowp = base + (size_t)(row0 + ai * HALF + m * 16) * ldc + col0;
#pragma unroll
                for (int bj = 0; bj < 2; ++bj) { const f32x4 v0 = acc[ai][bj][m][0], v1 = acc[ai][bj][m][1];
                    u32x4 w; w.x = cvt_pk_bf16(v0[0], v0[1]); w.y = cvt_pk_bf16(v0[2], v0[3]); w.z = cvt_pk_bf16(v1[0], v1[1]); w.w = cvt_pk_bf16(v1[2], v1[3]);
                    *(u32x4*)(rowp + bj * HALF) = w; } }
    }
};
template <class Epi, class Sched, bool ALIGN_EPI = false, bool SP2 = false>
__device__ __forceinline__ void gemm_phase(PG8_LAS unsigned char* lds, const Gemm g, const Sched& S, const Epi& E) {
    int tid_ = threadIdx.x; asm volatile("" : "+v"(tid_));
    const int tid = tid_, wid = __builtin_amdgcn_readfirstlane(tid >> 6), lane = tid & 63, wr = wid >> 2, wc = wid & 3, fr = lane & 15, fq = lane >> 4;
    const int K = g.K, nt = K / BK;
    unsigned voffA[2], voffB[2];
#pragma unroll
    for (int i = 0; i < 2; ++i) { int R, C; stage_rc(tid * 16 + i * 8192, R, C); const int Rb = Epi::PERM ? ((R & ~31) + perm32(R & 31)) : R;
        voffA[i] = (unsigned)(R * K + C) * 2u; voffB[i] = (unsigned)(Rb * K + C) * 2u; }
    const size_t kstep = (size_t)(BK * 2);
    const size_t hstep = (size_t)HALF * K * 2;
    const size_t tstep = 2 * hstep;
    const unsigned ldsw = (unsigned)wid * 1024u;
    const int aoff = lds_byte(wr * 64 + fr, fq * 8), boff = lds_byte(wc * 32 + fr, fq * 8);
#define PG8_SA(b, h) (((b) * 2 + (h)) * HTB)
#define PG8_SB(b, h) ((4 + (b) * 2 + (h)) * HTB)
#define PG8_STAGE(bufoff, gbase, voff) do { _Pragma("unroll") for (int _i = 0; _i < 2; ++_i) \
        __builtin_amdgcn_global_load_lds((const unsigned*)((const char*)(gbase) + (voff)[_i]), (PG8_LAS unsigned*)(lds + (bufoff) + ldsw + _i * 8192), 16, 0, 0); } while (0)
#define PG8_LDA(dst, b, h) do { _Pragma("unroll") for (int m = 0; m < 4; ++m) _Pragma("unroll") for (int k = 0; k < 2; ++k) dst[m][k] = *(const PG8_LAS bf16x8*)(lds + PG8_SA(b, h) + aoff + m * 2048 + k * 1024); } while (0)
#define PG8_LDB(dst, b, h) do { _Pragma("unroll") for (int n = 0; n < 2; ++n) _Pragma("unroll") for (int k = 0; k < 2; ++k) dst[n][k] = *(const PG8_LAS bf16x8*)(lds + PG8_SB(b, h) + boff + n * 2048 + k * 1024); } while (0)
#define PG8_MMA(ai, bj, At, Bt) do { __builtin_amdgcn_s_setprio(1); _Pragma("unroll") for (int m = 0; m < 4; ++m) _Pragma("unroll") for (int n = 0; n < 2; ++n) _Pragma("unroll") for (int k = 0; k < 2; ++k) \
        acc[ai][bj][m][n] = __builtin_amdgcn_mfma_f32_16x16x32_bf16(Bt[n][k], At[m][k], acc[ai][bj][m][n], 0, 0, 0); __builtin_amdgcn_s_setprio(0); } while (0)
#define PG8_WAIT_V(n) asm volatile("s_waitcnt vmcnt(" #n ")" ::: "memory")
#define PG8_WAIT_L(n) asm volatile("s_waitcnt lgkmcnt(" #n ")" ::: "memory")
#define PG8_BAR __builtin_amdgcn_s_barrier()
#define PG8_SCHED __builtin_amdgcn_sched_barrier(0)
    Unit cur, nxt; int ui = 0;
    if (!S.next(0, cur)) return;
    f32x4 acc[2][2][4][2];
#pragma unroll
    for (int a = 0; a < 2; ++a)
#pragma unroll
        for (int b = 0; b < 2; ++b)
#pragma unroll
            for (int m = 0; m < 4; ++m)
#pragma unroll
                for (int n = 0; n < 2; ++n) acc[a][b][m][n] = (f32x4){0.f, 0.f, 0.f, 0.f};
    bf16x8 At[4][2], B0[2][2], B1[2][2];
    const char* cA = (const char*)g.A + (size_t)cur.pm * tstep + cur.koff; const char* cB = (const char*)g.Bt + (size_t)cur.pn * tstep + cur.koff;
    S.a_ready(cur);
    if constexpr (SP2) {
        PG8_STAGE(PG8_SB(0, 0), cB, voffB); PG8_STAGE(PG8_SB(0, 1), cB + hstep, voffB); PG8_STAGE(PG8_SA(0, 0), cA, voffA); PG8_STAGE(PG8_SA(0, 1), cA + hstep, voffA);
        if (wr == 1) PG8_BAR;
        PG8_WAIT_V(2); PG8_BAR;
        PG8_STAGE(PG8_SB(1, 0), cB + kstep, voffB); PG8_STAGE(PG8_SA(1, 0), cA + kstep, voffA); PG8_STAGE(PG8_SB(1, 1), cB + hstep + kstep, voffB);
        PG8_WAIT_V(6); PG8_BAR;
    } else {
        PG8_STAGE(PG8_SB(0, 0), cB, voffB); PG8_STAGE(PG8_SA(0, 0), cA, voffA); PG8_STAGE(PG8_SB(0, 1), cB + hstep, voffB); PG8_STAGE(PG8_SA(0, 1), cA + hstep, voffA);
        if (wr == 1) PG8_BAR;
        PG8_WAIT_V(4); PG8_BAR;
        PG8_STAGE(PG8_SB(1, 0), cB + kstep, voffB); PG8_STAGE(PG8_SA(1, 0), cA + kstep, voffA); PG8_STAGE(PG8_SB(1, 1), cB + hstep + kstep, voffB);
        PG8_WAIT_V(6); PG8_BAR;
    }
    for (;;) {
        const bool has_next = S.next(ui + 1, nxt);
        const char* nA = has_next ? (const char*)g.A + (size_t)nxt.pm * tstep + nxt.koff : cA; const char* nB = has_next ? (const char*)g.Bt + (size_t)nxt.pn * tstep + nxt.koff : cB;
        const int ntc = cur.nt ? cur.nt : nt;
        for (int t = 0; t < ntc; t += 2) {
            const bool last = (t == ntc - 2);
            const char* a1 = cA + (size_t)(t + 1) * kstep;
            const char* a2 = last ? nA : cA + (size_t)(t + 2) * kstep; const char* b2 = last ? nB : cB + (size_t)(t + 2) * kstep;
            const char* a3 = a2 + kstep; const char* b3 = b2 + kstep;
            if (last && has_next) S.a_ready(nxt);
            if constexpr (SP2) {
            PG8_LDB(B0, 0, 0); PG8_LDB(B1, 0, 1); PG8_SCHED; PG8_LDA(At, 0, 0); PG8_STAGE(PG8_SA(1, 1), a1 + hstep, voffA);
            PG8_WAIT_V(8); PG8_WAIT_L(0); PG8_BAR; PG8_MMA(0, 0, At, B0); PG8_MMA(0, 1, At, B1); PG8_BAR; PG8_SCHED;
            PG8_LDA(At, 0, 1); PG8_STAGE(PG8_SB(0, 0), b2, voffB); PG8_STAGE(PG8_SB(0, 1), b2 + hstep, voffB); PG8_STAGE(PG8_SA(0, 0), a2, voffA);
            PG8_WAIT_V(8); PG8_WAIT_L(0); PG8_BAR; PG8_MMA(1, 0, At, B0); PG8_MMA(1, 1, At, B1); PG8_BAR; PG8_SCHED;
            PG8_LDB(B0, 1, 0); PG8_LDB(B1, 1, 1); PG8_SCHED; PG8_LDA(At, 1, 0); PG8_STAGE(PG8_SA(0, 1), a2 + hstep, voffA);
            PG8_WAIT_V(8); PG8_WAIT_L(0); PG8_BAR; PG8_MMA(0, 0, At, B0); PG8_MMA(0, 1, At, B1); PG8_BAR; PG8_SCHED;
            PG8_LDA(At, 1, 1); PG8_STAGE(PG8_SB(1, 0), b3, voffB); PG8_STAGE(PG8_SB(1, 1), b3 + hstep, voffB); PG8_STAGE(PG8_SA(1, 0), a3, voffA);
            PG8_WAIT_V(8); PG8_WAIT_L(0); PG8_BAR; PG8_MMA(1, 0, At, B0); PG8_MMA(1, 1, At, B1); PG8_BAR; PG8_SCHED;
            } else {
            PG8_LDB(B0, 0, 0); PG8_SCHED; PG8_LDA(At, 0, 0); PG8_STAGE(PG8_SA(1, 1), a1 + hstep, voffA);
            PG8_WAIT_L(8); PG8_BAR; PG8_WAIT_L(0); PG8_MMA(0, 0, At, B0); PG8_BAR; PG8_SCHED;
            PG8_LDB(B1, 0, 1); PG8_STAGE(PG8_SB(0, 0), b2, voffB);
            PG8_BAR; PG8_WAIT_L(0); PG8_MMA(0, 1, At, B1); PG8_BAR;
            PG8_LDA(At, 0, 1); PG8_STAGE(PG8_SA(0, 0), a2, voffA);
            PG8_BAR; PG8_WAIT_L(0); PG8_MMA(1, 0, At, B0); PG8_BAR; PG8_SCHED;
            PG8_STAGE(PG8_SB(0, 1), b2 + hstep, voffB);
            PG8_WAIT_V(6); PG8_BAR; PG8_MMA(1, 1, At, B1); PG8_BAR;
            PG8_LDB(B0, 1, 0); PG8_SCHED; PG8_LDA(At, 1, 0); PG8_STAGE(PG8_SA(0, 1), a2 + hstep, voffA);
            PG8_WAIT_L(8); PG8_BAR; PG8_WAIT_L(0); PG8_MMA(0, 0, At, B0); PG8_BAR; PG8_SCHED;
            PG8_LDB(B1, 1, 1); PG8_STAGE(PG8_SB(1, 0), b3, voffB);
            PG8_BAR; PG8_WAIT_L(0); PG8_MMA(0, 1, At, B1); PG8_BAR;
            PG8_LDA(At, 1, 1); PG8_STAGE(PG8_SA(1, 0), a3, voffA);
            PG8_BAR; PG8_WAIT_L(0); PG8_MMA(1, 0, At, B0); PG8_BAR; PG8_SCHED;
            PG8_STAGE(PG8_SB(1, 1), b3 + hstep, voffB);
            PG8_WAIT_V(6); PG8_BAR; PG8_MMA(1, 1, At, B1); PG8_BAR;
            }
        }
        if constexpr (ALIGN_EPI) { if (wr == 0) PG8_BAR; }
        if constexpr (!Epi::AFTER_DRAIN) { E(acc, cur, wr, wc, fr, fq); S.done(cur); }
        if (!has_next) break;
#pragma unroll
        for (int a = 0; a < 2; ++a)
#pragma unroll
            for (int b = 0; b < 2; ++b)
#pragma unroll
                for (int m = 0; m < 4; ++m)
#pragma unroll
                    for (int n = 0; n < 2; ++n) acc[a][b][m][n] = (f32x4){0.f, 0.f, 0.f, 0.f};
        cur = nxt; cA = nA; cB = nB; ++ui;
        if constexpr (ALIGN_EPI) { if (wr == 1) PG8_BAR; }
    }
    PG8_WAIT_V(0);
    if constexpr (!ALIGN_EPI) { if (wr == 0) PG8_BAR; }
    PG8_BAR;
    if constexpr (Epi::AFTER_DRAIN) { E.fused(acc, cur, wr, wc, fr, fq, lds, wid, lane); S.done(cur); }
#undef PG8_SA
#undef PG8_SB
#undef PG8_STAGE
#undef PG8_LDA
#undef PG8_LDB
#undef PG8_MMA
#undef PG8_WAIT_V
#undef PG8_WAIT_L
#undef PG8_BAR
#undef PG8_SCHED
}
}
#define LAS __attribute__((address_space(3)))
typedef unsigned short bf16_t;
typedef short bf16x8 __attribute__((ext_vector_type(8)));
typedef short bf16x4 __attribute__((ext_vector_type(4)));
typedef float f32x4 __attribute__((ext_vector_type(4)));
typedef float f32x2 __attribute__((ext_vector_type(2)));
typedef float f32x16 __attribute__((ext_vector_type(16)));
typedef unsigned u32x4 __attribute__((ext_vector_type(4)));
typedef unsigned u32x2 __attribute__((ext_vector_type(2)));

constexpr int D = 1024, M_CTX = 8192, M_LAT = 16384, M = M_CTX + M_LAT, NP = 1888, NPP = 2048, FF = 2816, DEPTH = 4;
constexpr int KEYROWS = 8192 + 4 * 4352;
constexpr float EPS = 1e-6f;
constexpr int NTHREADS = 512, NWAVES = 8;
constexpr int LDS_BYTES = 147456;

constexpr size_t OUT_X = 0, OUT_CKV = (size_t)M * D, OUT_KR = OUT_CKV + (size_t)32 * 4 * 256 * 128;
constexpr int PC_U = 0, PC_V = 256, PC_H = 512, PC_B = 768, PC_C = 1024, PC_F = 1280, PC_Q = 1536, PC_KV = 1728, PC_KR = 1856;

constexpr size_t al256(size_t x) { return (x + 255) & ~(size_t)255; }
constexpr size_t WS_BAR = 0, WS_BAR_BYTES = 16384;
constexpr size_t WS_MOD = WS_BAR_BYTES;
constexpr size_t WS_F64 = al256(WS_MOD + (size_t)4 * 5 * 6144 * 4);
constexpr size_t WS_T64R = WS_F64 + 128 * 64 * 2;
constexpr size_t WS_T64I = WS_T64R + 64 * 128 * 2;
constexpr size_t WS_T64B = WS_T64I + 64 * 128 * 2;
constexpr size_t WS_T256 = WS_T64B + 64 * 128 * 2;
constexpr size_t WS_TW = WS_T256 + 256 * 512 * 2;
constexpr size_t WS_ROPE = WS_TW + 4096 * 8;
constexpr size_t WS_W = al256(WS_ROPE + 64 * 8 * 8);
constexpr size_t WL_IN = 0, WL_OUT = WL_IN + (size_t)NPP * D * 2, WL_GU = WL_OUT + (size_t)D * D * 2, WL_DN = WL_GU + (size_t)2 * FF * D * 2,
                 WL_UQ = WL_DN + (size_t)D * FF * 2, WL_UKV = WL_UQ + (size_t)384 * 192 * 2, WL_SP = WL_UKV + (size_t)512 * 128 * 2, WL_SIZE = WL_SP + (size_t)4 * 128 * 128 * 2;
constexpr size_t WS_R1 = al256(WS_W + 4 * WL_SIZE);
constexpr size_t WS_R2 = WS_R1 + (size_t)M * D * 2;
constexpr size_t WS_MLA = WS_R2 + (size_t)M * FF * 2;
constexpr size_t WS_Q = WS_MLA, WS_KN = WS_Q + (size_t)M * 384 * 2, WS_VT = WS_KN + (size_t)KEYROWS * 256 * 2, WS_KR = WS_VT + (size_t)KEYROWS * 256 * 2,
                 WS_GB = WS_KR + (size_t)KEYROWS * 32 * 2, WS_END = WS_GB + (size_t)4 * 4 * 64 * 64 * 128 * 2;
static_assert(WS_END - WS_MLA >= (size_t)M * D * 2, "FFNOUT alias");
static_assert((size_t)M * NP * 2 <= (size_t)M * FF * 2, "PROJ fits R2");

struct Params { const float* in[24]; float* out; unsigned char* ws; };
enum { I_XP = 0, I_XS, I_CCKV, I_CKR, I_C, I_CCTX, I_WADA, I_BADA, I_GPM, I_GPOM, I_GPF, I_GPOF, I_WIN, I_SPW, I_SPB, I_CVW, I_CVB, I_GQ, I_WUQ, I_GKV, I_WUKV, I_WOUT, I_WGU, I_WDN };

__device__ __forceinline__ unsigned f2bf(float f) { unsigned u = __builtin_bit_cast(unsigned, f); return (u + 0x7fffu + ((u >> 16) & 1u)) >> 16; }
typedef __bf16 bf16x2v __attribute__((ext_vector_type(2)));
__device__ __forceinline__ unsigned pk2(float lo, float hi) { const bf16x2v r = __builtin_convertvector((f32x2){lo, hi}, bf16x2v); return __builtin_bit_cast(unsigned, r); }
__device__ __forceinline__ float bflo(unsigned w) { return __builtin_bit_cast(float, w << 16); }
__device__ __forceinline__ float bfhi(unsigned w) { return __builtin_bit_cast(float, w & 0xffff0000u); }
__device__ __forceinline__ float bf1(bf16_t v) { return __builtin_bit_cast(float, (unsigned)v << 16); }
__device__ __forceinline__ f32x4 mma16(bf16x8 a, bf16x8 b, f32x4 c) { return __builtin_amdgcn_mfma_f32_16x16x32_bf16(a, b, c, 0, 0, 0); }
__device__ __forceinline__ f32x16 mma32(bf16x8 a, bf16x8 b, f32x16 c) { return __builtin_amdgcn_mfma_f32_32x32x16_bf16(a, b, c, 0, 0, 0); }
__device__ __forceinline__ float wave_sum(float v) {
#pragma unroll
    for (int o = 1; o < 64; o <<= 1) v += __shfl_xor(v, o);
    return v;
}
__device__ __forceinline__ u32x2 pk4(f32x4 v) { u32x2 w; w.x = pk2(v[0], v[1]); w.y = pk2(v[2], v[3]); return w; }
__device__ __forceinline__ int mod_of_row(int r) { return r < M_CTX ? 0 : 1 + ((r - M_CTX) >> 12); }

struct Ctx {
    Params p; LAS unsigned char* lds; int tid, lane, wave, bid, G;
    unsigned char* ws;
    __device__ __forceinline__ const float* mod(int l, int mi, int chunk) const { return (const float*)(ws + WS_MOD) + ((size_t)(l * 5 + mi) * 6 + chunk) * 1024; }
    __device__ __forceinline__ unsigned char* wl(int l) const { return ws + WS_W + (size_t)l * WL_SIZE; }
    __device__ __forceinline__ void refresh() { int t = threadIdx.x; asm volatile("" : "+v"(t)); tid = t; lane = t & 63; wave = __builtin_amdgcn_readfirstlane(t >> 6);
        size_t z = 0; asm volatile("" : "+s"(z)); ws = p.ws + z;
        int b = blockIdx.x; asm volatile("" : "+s"(b)); bid = b; }
};

constexpr int TPS = 258;
struct TItem { const float* W; bf16_t* WT; int ldw, K, k0, n0, nvalid, gu; };
__device__ __forceinline__ void titem_load(const TItem& t, int wave, int lane, f32x4 (&v)[8]) {
    const int n = t.n0 + 4 * lane;
#pragma unroll
    for (int i = 0; i < 8; ++i) v[i] = n < t.nvalid ? *(const f32x4*)(t.W + (size_t)(t.k0 + 8 * wave + i) * t.ldw + n) : (f32x4){0.f, 0.f, 0.f, 0.f};
}
__device__ __forceinline__ void titem_stage(LAS unsigned char* lds, int wave, int lane, const f32x4 (&v)[8]) {
    LAS bf16_t* T = (LAS bf16_t*)lds;
#pragma unroll
    for (int i = 0; i < 8; ++i) { LAS unsigned* d = (LAS unsigned*)(T + (8 * wave + i) * TPS + 4 * lane); d[0] = pk2(v[i][0], v[i][1]); d[1] = pk2(v[i][2], v[i][3]); }
}
__device__ __forceinline__ void titem_store(const TItem& t, const LAS unsigned char* lds, int tid) {
    const LAS bf16_t* T = (const LAS bf16_t*)lds;
#pragma unroll
    for (int it = 0; it < 4; ++it) { const int q = tid + NTHREADS * it, n = q >> 3, c = q & 7;
        unsigned short e[8];
#pragma unroll
        for (int j = 0; j < 8; ++j) e[j] = T[(8 * c + j) * TPS + n];
        const int sn = t.n0 + n;
        if (sn < t.nvalid) { int dr = sn; if (t.gu) { const int isup = sn >= FF, jj = isup ? sn - FF : sn; dr = (jj >> 7) * 256 + isup * 128 + (jj & 127); }
            u32x4 o; o.x = e[0] | ((unsigned)e[1] << 16); o.y = e[2] | ((unsigned)e[3] << 16); o.z = e[4] | ((unsigned)e[5] << 16); o.w = e[6] | ((unsigned)e[7] << 16);
            *(u32x4*)(t.WT + (size_t)dr * t.K + t.k0 + 8 * c) = o; } }
}
constexpr int TI_IN = 16 * 8, TI_OUT = 16 * 4, TI_GU = 16 * 22, TI_DN = 44 * 4, TI_UQ = 3 * 2, TI_UKV = 2 * 2, TI_L = TI_IN + TI_OUT + TI_GU + TI_DN + TI_UQ + TI_UKV;
__device__ __forceinline__ TItem titem_make(const Ctx& C, int it) {
    const Params& p = C.p; const int l = it / TI_L; int r = it % TI_L; unsigned char* wl = C.wl(l); TItem t; t.gu = 0;
    if (r < TI_IN) { t.W = p.in[I_WIN] + (size_t)l * D * NP; t.WT = (bf16_t*)(wl + WL_IN); t.ldw = NP; t.K = D; t.k0 = (r >> 3) * 64; t.n0 = (r & 7) * 256; t.nvalid = NP; return t; } r -= TI_IN;
    if (r < TI_OUT) { t.W = p.in[I_WOUT] + (size_t)l * D * D; t.WT = (bf16_t*)(wl + WL_OUT); t.ldw = D; t.K = D; t.k0 = (r >> 2) * 64; t.n0 = (r & 3) * 256; t.nvalid = D; return t; } r -= TI_OUT;
    if (r < TI_GU) { t.W = p.in[I_WGU] + (size_t)l * D * 2 * FF; t.WT = (bf16_t*)(wl + WL_GU); t.ldw = 2 * FF; t.K = D; t.k0 = (r / 22) * 64; t.n0 = (r % 22) * 256; t.nvalid = 2 * FF; t.gu = 1; return t; } r -= TI_GU;
    if (r < TI_DN) { t.W = p.in[I_WDN] + (size_t)l * FF * D; t.WT = (bf16_t*)(wl + WL_DN); t.ldw = D; t.K = FF; t.k0 = (r >> 2) * 64; t.n0 = (r & 3) * 256; t.nvalid = D; return t; } r -= TI_DN;
    if (r < TI_UQ) { t.W = p.in[I_WUQ] + (size_t)l * 192 * 384; t.WT = (bf16_t*)(wl + WL_UQ); t.ldw = 384; t.K = 192; t.k0 = (r >> 1) * 64; t.n0 = (r & 1) * 256; t.nvalid = 384; return t; } r -= TI_UQ;
    t.W = p.in[I_WUKV] + (size_t)l * 128 * 512; t.WT = (bf16_t*)(wl + WL_UKV); t.ldw = 512; t.K = 128; t.k0 = (r >> 1) * 64; t.n0 = (r & 1) * 256; t.nvalid = 512; return t;
}

__device__ __forceinline__ void transpose_items(const Ctx& C, int it0, int stride, int end) {
    int it = it0; f32x4 v[8];
    TItem cur; if (it < end) { cur = titem_make(C, it); titem_load(cur, C.wave, C.lane, v); }
    while (it < end) {
        titem_stage(C.lds, C.wave, C.lane, v);
        const int nx = it + stride; TItem nxt = cur; if (nx < end) { nxt = titem_make(C, nx); titem_load(nxt, C.wave, C.lane, v); }
        __syncthreads();
        titem_store(cur, C.lds, C.tid);
        __syncthreads();
        cur = nxt; it = nx;
    }
}

__device__ __forceinline__ void phase_prologue(const Ctx& C) {
    const Params& p = C.p;
    transpose_items(C, C.bid, C.G, (C.G == 256) ? TI_L : 4 * TI_L);
    {
        LAS float* sc = (LAS float*)C.lds;
        LAS float* red = (LAS float*)(C.lds + 5 * 1024 * 4);
        const int ub = C.G - 1 - C.bid;
        if (ub < 96) {
            size_t za = 0, zb = 0; asm volatile("" : "+s"(za), "+s"(zb));
            const float* cctx = p.in[I_CCTX] + za; const float* cc_ = p.in[I_C] + zb;
            for (int i = C.tid; i < 5120; i += NTHREADS) { const int j = i >> 10, k = i & 1023; const float v = (j == 0) ? cctx[k] : cc_[(j - 1) * 1024 + k]; sc[i] = v / (1.f + __expf(-v)); }
            __syncthreads();
            for (int u = ub; u < 96; u += C.G) {
                const int l = u / 24, cb = u % 24;
                const float* w = p.in[I_WADA] + ((size_t)l * 1024 + C.wave * 128) * 6144 + cb * 256 + 4 * C.lane;
                f32x4 a0 = {0.f, 0.f, 0.f, 0.f}, a1 = a0, a2 = a0, a3 = a0, a4 = a0;
#pragma unroll 16
                for (int k = 0; k < 128; ++k) { const f32x4 wv = *(const f32x4*)(w + (size_t)k * 6144); const int kk = C.wave * 128 + k;
                    a0 += wv * sc[kk]; a1 += wv * sc[1024 + kk]; a2 += wv * sc[2048 + kk]; a3 += wv * sc[3072 + kk]; a4 += wv * sc[4096 + kk]; }
                LAS f32x4* rw = (LAS f32x4*)(red + C.wave * 1280) + C.lane;
                rw[0] = a0; rw[64] = a1; rw[128] = a2; rw[192] = a3; rw[256] = a4;
                __syncthreads();
                for (int i = C.tid; i < 1280; i += NTHREADS) { const int j = i >> 8, c2 = i & 255; float sum = p.in[I_BADA][l * 6144 + cb * 256 + c2];
#pragma unroll
                    for (int ww = 0; ww < 8; ++ww) sum += red[ww * 1280 + i];
                    ((float*)(C.ws + WS_MOD))[(size_t)(l * 5 + j) * 6144 + cb * 256 + c2] = sum; }
                __syncthreads();
            }
        }
        __syncthreads();
    }
    {
        const int gt = C.bid * NTHREADS + C.tid, GT = C.G * NTHREADS;
        for (int i = gt; i < 4 * 65536; i += GT) { const int l = i >> 16, e = i & 65535; ((bf16_t*)(C.wl(l) + WL_SP))[e] = (bf16_t)f2bf(p.in[I_SPW][i]); }
        for (int i = gt; i < 4 * 160 * 1024 / 2; i += GT) { const int l = i / (160 * 512), e = i % (160 * 512); ((unsigned*)(C.wl(l) + WL_IN + (size_t)NP * D * 2))[e] = 0u; }
        for (int i = gt; i < 128 * 64; i += GT) { const int m = i >> 6, c = i & 63; const int idx = ((m & 63) * c) & 63; const float a = (float)idx / 32.f;
            ((bf16_t*)(C.ws + WS_F64))[i] = (bf16_t)f2bf(m < 64 ? cospif(a) : sinpif(a)); }
        for (int i = gt; i < 64 * 128; i += GT) { const int k = i >> 7, K = i & 127; const int idx = (k * (K & 63)) & 63; const float a = (float)idx / 32.f; const float cv = cospif(a), sv = sinpif(a);
            ((bf16_t*)(C.ws + WS_T64R))[i] = (bf16_t)f2bf(K < 64 ? cv : -sv);
            ((bf16_t*)(C.ws + WS_T64I))[i] = (bf16_t)f2bf(K < 64 ? -sv : -cv);
            ((bf16_t*)(C.ws + WS_T64B))[i] = (bf16_t)f2bf(K < 64 ? cv : sv); }
        for (int i = gt; i < 256 * 512; i += GT) { const int k = i >> 9, K = i & 511; const int idx = (k * (K & 255)) & 255; const float a = (float)idx / 128.f;
            ((bf16_t*)(C.ws + WS_T256))[i] = (bf16_t)f2bf(K < 256 ? cospif(a) : -sinpif(a)); }
        for (int i = gt; i < 4096; i += GT) { const float a = (float)i / 2048.f; ((f32x2*)(C.ws + WS_TW))[i] = (f32x2){cospif(a), sinpif(a)}; }
        for (int i = gt; i < 512; i += GT) { const int pos = i >> 3, f = i & 7; const float inv = powf(10000.f, -(float)f / 8.f); const float ang = (float)pos * inv;
            ((f32x2*)(C.ws + WS_ROPE))[i] = (f32x2){cosf(ang), sinf(ang)}; }
    }
}

__device__ __forceinline__ void load_row_f32(const float* rowp, int lane, f32x4 (&v)[4]) {
#pragma unroll
    for (int j = 0; j < 4; ++j) v[j] = *(const f32x4*)(rowp + 4 * lane + 256 * j);
}
__device__ __forceinline__ void load_row_bf16(const bf16_t* rowp, int lane, f32x4 (&v)[4]) {
#pragma unroll
    for (int j = 0; j < 4; ++j) { const u32x2 w = *(const u32x2*)(rowp + 4 * lane + 256 * j); v[j] = (f32x4){bflo(w.x), bfhi(w.x), bflo(w.y), bfhi(w.y)}; }
}
__device__ __forceinline__ float row_rstd(const f32x4 (&v)[4]) {
    float s = 0.f;
#pragma unroll
    for (int j = 0; j < 4; ++j) s += (v[j][0] * v[j][0] + v[j][1] * v[j][1]) + (v[j][2] * v[j][2] + v[j][3] * v[j][3]);
    return 1.f / sqrtf(wave_sum(s) * (1.f / 1024.f) + EPS);
}
__device__ __forceinline__ void norm_mod_store(const f32x4 (&x)[4], const float* g, const float* scale, const float* shift, bf16_t* orow, int lane) {
    const float rs = row_rstd(x);
#pragma unroll
    for (int j = 0; j < 4; ++j) { const int c = 4 * lane + 256 * j; const f32x4 gv = *(const f32x4*)(g + c), sv = *(const f32x4*)(scale + c), hv = *(const f32x4*)(shift + c);
        const f32x4 h = x[j] * rs * gv * (1.f + sv) + hv; *(u32x2*)(orow + c) = pk4(h); }
}
__device__ __forceinline__ void norm_mod_store_g(const f32x4 (&x)[4], const f32x4 (&gv)[4], const float* scale, const float* shift, bf16_t* orow, int lane) {
    const float rs = row_rstd(x);
#pragma unroll
    for (int j = 0; j < 4; ++j) { const int c = 4 * lane + 256 * j; const f32x4 sv = *(const f32x4*)(scale + c), hv = *(const f32x4*)(shift + c);
        const f32x4 h = x[j] * rs * gv[j] * (1.f + sv) + hv; *(u32x2*)(orow + c) = pk4(h); }
}
__device__ __forceinline__ const float* xin_row(const Ctx& C, int layer, int r) {
    if (layer > 0) return C.p.out + OUT_X + (size_t)r * D;
    size_t za = 0, zb = 0; asm volatile("" : "+s"(za), "+s"(zb));
    const float* a = C.p.in[I_XP] + za; const float* b = C.p.in[I_XS] + zb;
    return r < M_CTX ? a + (size_t)r * D : b + (size_t)(r - M_CTX) * D;
}
constexpr int SPLIT_ROW0 = 16384;
__device__ __forceinline__ void load_T(const bf16_t* T, const bf16_t* T1, bool split, int r, int lane, f32x4 (&v)[4]) {
    load_row_bf16(T + (size_t)r * D, lane, v);
    if (split && r >= SPLIT_ROW0) { f32x4 w[4]; load_row_bf16(T1 + (size_t)r * D, lane, w);
#pragma unroll
        for (int j = 0; j < 4; ++j) v[j] = v[j] + w[j]; }
}
__device__ __forceinline__ void phase_norm0(const Ctx& C) {
    const int gw = C.bid * NWAVES + C.wave, NGW = C.G * NWAVES;
    bf16_t* H = (bf16_t*)(C.ws + WS_R1);
    f32x4 xn[4]; load_row_f32(xin_row(C, 0, gw), C.lane, xn);
    for (int r = gw; r < M; r += NGW) { f32x4 x[4];
#pragma unroll
        for (int j = 0; j < 4; ++j) x[j] = xn[j];
        if (r + NGW < M) load_row_f32(xin_row(C, 0, r + NGW), C.lane, xn);
        const int mi = mod_of_row(r);
        norm_mod_store(x, C.p.in[I_GPM], C.mod(0, mi, 1), C.mod(0, mi, 0), H + (size_t)r * D, C.lane); }
}
template <int which  > __device__ __forceinline__ void phase_post(const Ctx& C, int layer) {
    const int gw = C.bid * NWAVES + C.wave, NGW = C.G * NWAVES;
    const bf16_t* T = (const bf16_t*)(C.ws + (which == 0 ? WS_R2 : WS_MLA));
    const bf16_t* T1 = T + (size_t)M * D - (size_t)SPLIT_ROW0 * D;
    const bool split = (C.G == 256);
    bf16_t* H = (bf16_t*)(C.ws + WS_R1);
    const float* gpost = (which == 0 ? C.p.in[I_GPOM] : C.p.in[I_GPOF]) + layer * D;
    const bool do_next = (which == 0) || (layer + 1 < DEPTH);
    const int nl = which == 0 ? layer : layer + 1;
    const float* gnext = (which == 0 ? C.p.in[I_GPF] : C.p.in[I_GPM]) + (nl < DEPTH ? nl : 0) * D;
    f32x4 gpv[4], gnv[4];
#pragma unroll
    for (int j = 0; j < 4; ++j) { gpv[j] = *(const f32x4*)(gpost + 4 * C.lane + 256 * j); gnv[j] = *(const f32x4*)(gnext + 4 * C.lane + 256 * j); }
    f32x4 tn[4], xn[4];
    load_T(T, T1, split, gw, C.lane, tn); load_row_f32(which == 0 ? xin_row(C, layer, gw) : C.p.out + OUT_X + (size_t)gw * D, C.lane, xn);
    for (int r = gw; r < M; r += NGW) {
        const int mi = mod_of_row(r);
        f32x4 t[4], x[4];
#pragma unroll
        for (int j = 0; j < 4; ++j) { t[j] = tn[j]; x[j] = xn[j]; }
        if (r + NGW < M) { const int rn = r + NGW; load_T(T, T1, split, rn, C.lane, tn); load_row_f32(which == 0 ? xin_row(C, layer, rn) : C.p.out + OUT_X + (size_t)rn * D, C.lane, xn); }
        const float rs = row_rstd(t); const float* gate = C.mod(layer, mi, which == 0 ? 2 : 5);
        float* xo = C.p.out + OUT_X + (size_t)r * D;
#pragma unroll
        for (int j = 0; j < 4; ++j) { const int c = 4 * C.lane + 256 * j; const f32x4 ga = *(const f32x4*)(gate + c);
            x[j] = x[j] + ga * (t[j] * rs * gpv[j]); *(f32x4*)(xo + c) = x[j]; }
        if (do_next) norm_mod_store_g(x, gnv, C.mod(nl, mi, which == 0 ? 4 : 1), C.mod(nl, mi, which == 0 ? 3 : 0), H + (size_t)r * D, C.lane);
    }
}

__device__ __forceinline__ void unit_chunk_mlp(const Ctx& C, int layer, int u) {
    const int chunk = u >> 2, g = u & 3, r0 = chunk * 128;
    const bf16_t* PROJ = (const bf16_t*)(C.ws + WS_R2); bf16_t* MIX = (bf16_t*)(C.ws + WS_R1);
    constexpr int VS = 136;
    LAS bf16_t* Vt = (LAS bf16_t*)C.lds;
    { const int q = C.tid >> 2, c0 = (C.tid & 3) * 16; const bf16_t* src = PROJ + (size_t)(r0 + q) * NP + PC_V + g * 64 + c0;
      const bf16x8 v0 = *(const bf16x8*)src, v1 = *(const bf16x8*)(src + 8);
#pragma unroll
      for (int j = 0; j < 8; ++j) { Vt[(c0 + j) * VS + q] = (bf16_t)v0[j]; Vt[(c0 + 8 + j) * VS + q] = (bf16_t)v1[j]; } }
    __syncthreads();
    const int l15 = C.lane & 15, hq = C.lane >> 4, w = C.wave;
    const bf16_t* Wg = (const bf16_t*)(C.wl(layer) + WL_SP) + (size_t)g * 128 * 128;
    bf16x8 bw[4];
#pragma unroll
    for (int ks = 0; ks < 4; ++ks) bw[ks] = *(const bf16x8*)(Wg + (size_t)(w * 16 + l15) * 128 + ks * 32 + 8 * hq);
    const int p = w * 16 + l15; const float bias = C.p.in[I_SPB][(layer * 4 + g) * 128 + p];
#pragma unroll
    for (int ct = 0; ct < 4; ++ct) {
        f32x4 acc = {0.f, 0.f, 0.f, 0.f};
#pragma unroll
        for (int ks = 0; ks < 4; ++ks) { const bf16x8 a = *(const LAS bf16x8*)(Vt + (ct * 16 + l15) * VS + ks * 32 + 8 * hq); acc = mma16(a, bw[ks], acc); }
        const int cc = g * 64 + ct * 16 + 4 * hq; const u32x2 uw = *(const u32x2*)(PROJ + (size_t)(r0 + p) * NP + PC_U + cc);
        f32x4 o; o[0] = bflo(uw.x) * (acc[0] + bias); o[1] = bfhi(uw.x) * (acc[1] + bias); o[2] = bflo(uw.y) * (acc[2] + bias); o[3] = bfhi(uw.y) * (acc[3] + bias);
        *(u32x2*)(MIX + (size_t)(r0 + p) * D + cc) = pk4(o);
    }
    __syncthreads();
}
__device__ __forceinline__ void unit_conv(const Ctx& C, int layer, int u) {
    const bf16_t* PROJ = (const bf16_t*)(C.ws + WS_R2); bf16_t* MIX = (bf16_t*)(C.ws + WS_R1);
    const float* cw = C.p.in[I_CVW] + layer * 3 * 256; const float* cb = C.p.in[I_CVB] + layer * 256;
    for (int it = 0; it < 8; ++it) {
        const int item = it * NTHREADS + C.tid, t = item >> 5, ch = (item & 31) * 8, r = u * 128 + t;
        const int pos = r < M_CTX ? (r & 255) : ((r - M_CTX) & 4095), len = r < M_CTX ? 256 : 4096;
        const bf16_t* base = PROJ + (size_t)r * NP;
        const bf16x8 h1 = *(const bf16x8*)(base + PC_H + ch), c1 = *(const bf16x8*)(base + PC_C + ch), gb = *(const bf16x8*)(base + PC_B + ch);
        bf16x8 h0 = h1, c0 = c1, h2 = h1, c2 = c1; const bool hasp = pos > 0, hasn = pos < len - 1;
        if (hasp) { h0 = *(const bf16x8*)(base - NP + PC_H + ch); c0 = *(const bf16x8*)(base - NP + PC_C + ch); }
        if (hasn) { h2 = *(const bf16x8*)(base + NP + PC_H + ch); c2 = *(const bf16x8*)(base + NP + PC_C + ch); }
        float o[8];
#pragma unroll
        for (int j = 0; j < 8; ++j) {
            const float z0 = hasp ? bf1((bf16_t)h0[j]) * bf1((bf16_t)c0[j]) : 0.f, z1 = bf1((bf16_t)h1[j]) * bf1((bf16_t)c1[j]), z2 = hasn ? bf1((bf16_t)h2[j]) * bf1((bf16_t)c2[j]) : 0.f;
            const float y = z0 * cw[ch + j] + z1 * cw[256 + ch + j] + z2 * cw[512 + ch + j] + cb[ch + j];
            o[j] = bf1((bf16_t)gb[j]) * y; }
        u32x4 w; w.x = pk2(o[0], o[1]); w.y = pk2(o[2], o[3]); w.z = pk2(o[4], o[5]); w.w = pk2(o[6], o[7]);
        *(u32x4*)(MIX + (size_t)r * D + 256 + ch) = w;
    }
}
__device__ __forceinline__ void unit_fourier_ctx(const Ctx& C, int u) {
    const int s = u >> 2, g = u & 3, l15 = C.lane & 15, hq = C.lane >> 4, w = C.wave;
    const bf16_t* PROJ = (const bf16_t*)(C.ws + WS_R2); bf16_t* MIX = (bf16_t*)(C.ws + WS_R1);
    const bf16_t* F64 = (const bf16_t*)(C.ws + WS_F64); const bf16_t* T256 = (const bf16_t*)(C.ws + WS_T256);
    constexpr int ZS = 520; LAS bf16_t* Zt = (LAS bf16_t*)C.lds;
#pragma unroll
    for (int i = 0; i < 2; ++i) { const int nt = 2 * w + i;
        bf16x8 a[2];
#pragma unroll
        for (int ks = 0; ks < 2; ++ks) a[ks] = *(const bf16x8*)(PROJ + (size_t)(s * 256 + nt * 16 + l15) * NP + PC_F + g * 64 + ks * 32 + 8 * hq);
#pragma unroll
        for (int mt = 0; mt < 8; ++mt) { f32x4 acc = {0.f, 0.f, 0.f, 0.f};
#pragma unroll
            for (int ks = 0; ks < 2; ++ks) { const bf16x8 b = *(const bf16x8*)(F64 + (size_t)(mt * 16 + l15) * 64 + ks * 32 + 8 * hq); acc = mma16(a[ks], b, acc); }
            const int mp = mt * 16 + l15;
            *(LAS u32x2*)(Zt + (mp & 63) * ZS + (mp >> 6) * 256 + nt * 16 + 4 * hq) = pk4(acc); } }
    __syncthreads();
#pragma unroll 1
    for (int i = 0; i < 2; ++i) { const int kt = 2 * w + i;
        f32x4 acc[4];
#pragma unroll
        for (int mt = 0; mt < 4; ++mt) acc[mt] = (f32x4){0.f, 0.f, 0.f, 0.f};
#pragma unroll 8
        for (int ks = 0; ks < 16; ++ks) { const bf16x8 b = *(const bf16x8*)(T256 + (size_t)(kt * 16 + l15) * 512 + ks * 32 + 8 * hq);
#pragma unroll
            for (int mt = 0; mt < 4; ++mt) { const bf16x8 a = *(const LAS bf16x8*)(Zt + (mt * 16 + l15) * ZS + ks * 32 + 8 * hq); acc[mt] = mma16(a, b, acc[mt]); } }
#pragma unroll
        for (int mt = 0; mt < 4; ++mt) *(u32x2*)(MIX + (size_t)(s * 256 + kt * 16 + l15) * D + 512 + g * 64 + mt * 16 + 4 * hq) = pk4(acc[mt] * (1.f / 128.f)); }
    __syncthreads();
}
__device__ __forceinline__ void unit_fourier_lat1(const Ctx& C, int u) {
    const int b = u >> 5, g = (u >> 3) & 3, nb = u & 7, l15 = C.lane & 15, hq = C.lane >> 4, n2 = nb * 8 + C.wave;
    const bf16_t* PROJ = (const bf16_t*)(C.ws + WS_R2);
    const bf16_t* F64 = (const bf16_t*)(C.ws + WS_F64); const bf16_t* T64R = (const bf16_t*)(C.ws + WS_T64R); const bf16_t* T64I = (const bf16_t*)(C.ws + WS_T64I);
    const f32x2* TW = (const f32x2*)(C.ws + WS_TW);
    bf16_t* GB = (bf16_t*)(C.ws + WS_GB) + (size_t)((b * 4 + g) * 64 + n2) * 64 * 128;
    constexpr int ZS = 136; LAS bf16_t* Zt = (LAS bf16_t*)(C.lds + C.wave * (64 * ZS * 2));
#pragma unroll 2
    for (int nt = 0; nt < 4; ++nt) {
        bf16x8 a[2];
#pragma unroll
        for (int ks = 0; ks < 2; ++ks) a[ks] = *(const bf16x8*)(PROJ + (size_t)(M_CTX + b * 4096 + (nt * 16 + l15) * 64 + n2) * NP + PC_F + g * 64 + ks * 32 + 8 * hq);
#pragma unroll
        for (int mt = 0; mt < 8; ++mt) { f32x4 acc = {0.f, 0.f, 0.f, 0.f};
#pragma unroll
            for (int ks = 0; ks < 2; ++ks) { const bf16x8 bb = *(const bf16x8*)(F64 + (size_t)(mt * 16 + l15) * 64 + ks * 32 + 8 * hq); acc = mma16(a[ks], bb, acc); }
            const int mp = mt * 16 + l15;
            *(LAS u32x2*)(Zt + (mp & 63) * ZS + (mp >> 6) * 64 + nt * 16 + 4 * hq) = pk4(acc); } }
    asm volatile("s_waitcnt lgkmcnt(0)" ::: "memory");
#pragma unroll 2
    for (int kt = 0; kt < 4; ++kt) {
        bf16x8 br[4], bi[4];
#pragma unroll
        for (int ks = 0; ks < 4; ++ks) { br[ks] = *(const bf16x8*)(T64R + (size_t)(kt * 16 + l15) * 128 + ks * 32 + 8 * hq); bi[ks] = *(const bf16x8*)(T64I + (size_t)(kt * 16 + l15) * 128 + ks * 32 + 8 * hq); }
        const int k1 = kt * 16 + l15; const f32x2 tw = TW[k1 * n2];
#pragma unroll
        for (int mt = 0; mt < 4; ++mt) { f32x4 ar = {0.f, 0.f, 0.f, 0.f}, ai = {0.f, 0.f, 0.f, 0.f};
#pragma unroll
            for (int ks = 0; ks < 4; ++ks) { const bf16x8 a = *(const LAS bf16x8*)(Zt + (mt * 16 + l15) * ZS + ks * 32 + 8 * hq); ar = mma16(a, br[ks], ar); ai = mma16(a, bi[ks], ai); }
            const f32x4 gr = ar * tw[0] + ai * tw[1], gi = ai * tw[0] - ar * tw[1];
            bf16_t* dst = GB + (size_t)k1 * 128 + mt * 16 + 4 * hq;
            *(u32x2*)dst = pk4(gr); *(u32x2*)(dst + 64) = pk4(gi); } }
    __syncthreads();
}
__device__ __forceinline__ void unit_fourier_lat2(const Ctx& C, int u) {
    const int b = u >> 5, g = (u >> 3) & 3, kb = u & 7, l15 = C.lane & 15, hq = C.lane >> 4, k1 = kb * 8 + C.wave;
    const bf16_t* T64B = (const bf16_t*)(C.ws + WS_T64B); bf16_t* MIX = (bf16_t*)(C.ws + WS_R1);
    const bf16_t* GB = (const bf16_t*)(C.ws + WS_GB) + (size_t)((b * 4 + g) * 64) * 64 * 128 + (size_t)k1 * 128;
    constexpr int ZS = 136; LAS bf16_t* Tt = (LAS bf16_t*)(C.lds + C.wave * (64 * ZS * 2));
#pragma unroll 4
    for (int it = 0; it < 16; ++it) { const int q = it * 64 + C.lane, n2 = q >> 4, cc = q & 15, part = cc >> 3, m0 = (cc & 7) * 8;
        const bf16x8 v = *(const bf16x8*)(GB + (size_t)n2 * 64 * 128 + cc * 8);
#pragma unroll
        for (int j = 0; j < 8; ++j) Tt[(m0 + j) * ZS + part * 64 + n2] = (bf16_t)v[j]; }
    asm volatile("s_waitcnt lgkmcnt(0)" ::: "memory");
#pragma unroll 2
    for (int kt = 0; kt < 4; ++kt) {
        bf16x8 bb[4];
#pragma unroll
        for (int ks = 0; ks < 4; ++ks) bb[ks] = *(const bf16x8*)(T64B + (size_t)(kt * 16 + l15) * 128 + ks * 32 + 8 * hq);
        const int k2 = kt * 16 + l15; const int row = M_CTX + b * 4096 + k1 + 64 * k2;
#pragma unroll
        for (int mt = 0; mt < 4; ++mt) { f32x4 acc = {0.f, 0.f, 0.f, 0.f};
#pragma unroll
            for (int ks = 0; ks < 4; ++ks) { const bf16x8 a = *(const LAS bf16x8*)(Tt + (mt * 16 + l15) * ZS + ks * 32 + 8 * hq); acc = mma16(a, bb[ks], acc); }
            *(u32x2*)(MIX + (size_t)row * D + 512 + g * 64 + mt * 16 + 4 * hq) = pk4(acc * (1.f / 512.f)); } }
    __syncthreads();
}
constexpr float QSCALE = 0.10206207261596577f * 1.4426950408889634f;
__device__ __forceinline__ void unit_mla_prep(const Ctx& C, int layer, int u) {
    const Params& p = C.p;
    const bf16_t* PROJ = (const bf16_t*)(C.ws + WS_R2);
    bf16_t* Q = (bf16_t*)(C.ws + WS_Q); bf16_t* KN = (bf16_t*)(C.ws + WS_KN); bf16_t* VT = (bf16_t*)(C.ws + WS_VT); bf16_t* KR = (bf16_t*)(C.ws + WS_KR);
    const f32x2* ROPE = (const f32x2*)(C.ws + WS_ROPE);
    constexpr int QS = 200, KS = 136;
    LAS bf16_t* CQ = (LAS bf16_t*)C.lds;
    LAS bf16_t* CK = (LAS bf16_t*)(C.lds + 128 * QS * 2);
    const bool is_tok = u < 192;
    int r0 = 0, keyrow0, keypos0, nk; size_t vtbase; bool lat;
    if (is_tok) { r0 = u * 128; lat = r0 >= M_CTX;
        if (!lat) { keyrow0 = r0; keypos0 = r0 & 255; nk = 256; vtbase = (size_t)(r0 & ~255) * 256; }
        else { const int b = (r0 - M_CTX) >> 12, n = (r0 - M_CTX) & 4095; keyrow0 = M_CTX + b * 4352 + n; keypos0 = n; nk = 4352; vtbase = (size_t)(M_CTX + b * 4352) * 256; } }
    else { const int cu = u - 192, b = cu >> 1, half = cu & 1; lat = true; keyrow0 = M_CTX + b * 4352 + 4096 + half * 128; keypos0 = 4096 + half * 128; nk = 4352; vtbase = (size_t)(M_CTX + b * 4352) * 256; }
    { const int t = C.tid >> 2, sub = C.tid & 3;
      if (is_tok) {
        const int r = r0 + t; const bf16_t* base = PROJ + (size_t)r * NP;
        float q[48], k[32]; float sq = 0.f, sk = 0.f;
#pragma unroll
        for (int i = 0; i < 6; ++i) { const bf16x8 v = *(const bf16x8*)(base + PC_Q + sub * 48 + i * 8);
#pragma unroll
            for (int j = 0; j < 8; ++j) { q[i * 8 + j] = bf1((bf16_t)v[j]); sq += q[i * 8 + j] * q[i * 8 + j]; } }
#pragma unroll
        for (int i = 0; i < 4; ++i) { const bf16x8 v = *(const bf16x8*)(base + PC_KV + sub * 32 + i * 8);
#pragma unroll
            for (int j = 0; j < 8; ++j) { k[i * 8 + j] = bf1((bf16_t)v[j]); sk += k[i * 8 + j] * k[i * 8 + j]; } }
        sq += __shfl_xor(sq, 1); sq += __shfl_xor(sq, 2); sk += __shfl_xor(sk, 1); sk += __shfl_xor(sk, 2);
        const float rq = 1.f / sqrtf(sq * (1.f / 192.f) + EPS), rk = 1.f / sqrtf(sk * (1.f / 128.f) + EPS);
        const float* gq = p.in[I_GQ] + layer * 192 + sub * 48; const float* gk = p.in[I_GKV] + layer * 128 + sub * 32;
#pragma unroll
        for (int i = 0; i < 6; ++i) { u32x4 w; w.x = pk2(q[i * 8 + 0] * rq * gq[i * 8 + 0], q[i * 8 + 1] * rq * gq[i * 8 + 1]); w.y = pk2(q[i * 8 + 2] * rq * gq[i * 8 + 2], q[i * 8 + 3] * rq * gq[i * 8 + 3]);
            w.z = pk2(q[i * 8 + 4] * rq * gq[i * 8 + 4], q[i * 8 + 5] * rq * gq[i * 8 + 5]); w.w = pk2(q[i * 8 + 6] * rq * gq[i * 8 + 6], q[i * 8 + 7] * rq * gq[i * 8 + 7]);
            *(LAS u32x4*)(CQ + t * QS + sub * 48 + i * 8) = w; }
        float* sckv = nullptr;
        if (!lat) { const int s = r >> 8, pos = r & 255; sckv = p.out + OUT_CKV + ((size_t)(s * 4 + layer) * 256 + pos) * 128 + sub * 32; }
#pragma unroll
        for (int i = 0; i < 4; ++i) { float o[8];
#pragma unroll
            for (int j = 0; j < 8; ++j) o[j] = k[i * 8 + j] * rk * gk[i * 8 + j];
            u32x4 w; w.x = pk2(o[0], o[1]); w.y = pk2(o[2], o[3]); w.z = pk2(o[4], o[5]); w.w = pk2(o[6], o[7]);
            *(LAS u32x4*)(CK + t * KS + sub * 32 + i * 8) = w;
            if (!lat) { *(f32x4*)(sckv + i * 8) = (f32x4){o[0], o[1], o[2], o[3]}; *(f32x4*)(sckv + i * 8 + 4) = (f32x4){o[4], o[5], o[6], o[7]}; } }
        { const bf16x8 v = *(const bf16x8*)(base + PC_KR + sub * 8); float x[8], o[8];
#pragma unroll
          for (int j = 0; j < 8; ++j) x[j] = bf1((bf16_t)v[j]);
          if (lat) { const int n = (r - M_CTX) & 4095; const int pos = (sub >> 1) == 0 ? (n >> 6) : (n & 63);
#pragma unroll
              for (int j = 0; j < 8; ++j) { const float pr = __shfl_xor(x[j], 1); const f32x2 cs = ROPE[pos * 8 + j]; o[j] = (sub & 1) == 0 ? x[j] * cs[0] - pr * cs[1] : x[j] * cs[0] + pr * cs[1]; } }
          else {
#pragma unroll
              for (int j = 0; j < 8; ++j) o[j] = x[j];
              const int s = r >> 8, pos = r & 255; float* skr = p.out + OUT_KR + ((size_t)(s * 4 + layer) * 256 + pos) * 32 + sub * 8;
              *(f32x4*)skr = (f32x4){o[0], o[1], o[2], o[3]}; *(f32x4*)(skr + 4) = (f32x4){o[4], o[5], o[6], o[7]}; }
          u32x4 w; w.x = pk2(o[0], o[1]); w.y = pk2(o[2], o[3]); w.z = pk2(o[4], o[5]); w.w = pk2(o[6], o[7]);
          *(u32x4*)(KR + (size_t)(keyrow0 + t) * 32 + sub * 8) = w; }
      } else {
        const int cu = u - 192, b = cu >> 1, half = cu & 1, row = half * 128 + t;
        const float* src = p.in[I_CCKV] + ((size_t)(b * 4 + layer) * 256 + row) * 128 + sub * 32;
#pragma unroll
        for (int i = 0; i < 4; ++i) { const f32x4 v0 = *(const f32x4*)(src + i * 8), v1 = *(const f32x4*)(src + i * 8 + 4);
            u32x4 w; w.x = pk2(v0[0], v0[1]); w.y = pk2(v0[2], v0[3]); w.z = pk2(v1[0], v1[1]); w.w = pk2(v1[2], v1[3]);
            *(LAS u32x4*)(CK + t * KS + sub * 32 + i * 8) = w; }
        const float* ksrc = p.in[I_CKR] + ((size_t)(b * 4 + layer) * 256 + row) * 32 + sub * 8;
        const f32x4 v0 = *(const f32x4*)ksrc, v1 = *(const f32x4*)(ksrc + 4);
        u32x4 w; w.x = pk2(v0[0], v0[1]); w.y = pk2(v0[2], v0[3]); w.z = pk2(v1[0], v1[1]); w.w = pk2(v1[2], v1[3]);
        *(u32x4*)(KR + (size_t)(keyrow0 + t) * 32 + sub * 8) = w;
      } }
    __syncthreads();
    const int l15 = C.lane & 15, hq = C.lane >> 4, w = C.wave;
    if (is_tok) {
        const bf16_t* Wq = (const bf16_t*)(C.wl(layer) + WL_UQ);
        bf16x8 aq[3][6];
#pragma unroll
        for (int j = 0; j < 3; ++j)
#pragma unroll
            for (int ks = 0; ks < 6; ++ks) aq[j][ks] = *(const bf16x8*)(Wq + (size_t)((3 * w + j) * 16 + l15) * 192 + ks * 32 + 8 * hq);
#pragma unroll 2
        for (int tt = 0; tt < 8; ++tt) {
            bf16x8 bq[6];
#pragma unroll
            for (int ks = 0; ks < 6; ++ks) bq[ks] = *(const LAS bf16x8*)(CQ + (tt * 16 + l15) * QS + ks * 32 + 8 * hq);
            const int r = r0 + tt * 16 + l15; const int n = (r - M_CTX) & 4095;
#pragma unroll
            for (int j = 0; j < 3; ++j) { const int nt = 3 * w + j; f32x4 acc = {0.f, 0.f, 0.f, 0.f};
#pragma unroll
                for (int ks = 0; ks < 6; ++ks) acc = mma16(aq[j][ks], bq[ks], acc);
                const int sub6 = nt % 6;
                if (lat && sub6 >= 4) { const int pos = sub6 == 4 ? (n >> 6) : (n & 63);
#pragma unroll
                    for (int jj = 0; jj < 4; ++jj) { const float pr = __shfl_xor(acc[jj], 32); const f32x2 cs = ROPE[pos * 8 + ((4 * hq + jj) & 7)]; acc[jj] = hq < 2 ? acc[jj] * cs[0] - pr * cs[1] : acc[jj] * cs[0] + pr * cs[1]; } }
                *(u32x2*)(Q + (size_t)r * 384 + nt * 16 + 4 * hq) = pk4(acc * QSCALE); }
        }
    }
    { const bf16_t* Wkv = (const bf16_t*)(C.wl(layer) + WL_UKV);
      bf16x8 wf[4][4];
#pragma unroll
      for (int j = 0; j < 4; ++j)
#pragma unroll
          for (int ks = 0; ks < 4; ++ks) wf[j][ks] = *(const bf16x8*)(Wkv + (size_t)((4 * w + j) * 16 + l15) * 128 + ks * 32 + 8 * hq);
      const int h = w >> 1; const bool isv = (w & 1) != 0;
#pragma unroll 2
      for (int tt = 0; tt < 8; ++tt) {
          bf16x8 ck[4];
#pragma unroll
          for (int ks = 0; ks < 4; ++ks) ck[ks] = *(const LAS bf16x8*)(CK + (tt * 16 + l15) * KS + ks * 32 + 8 * hq);
#pragma unroll
          for (int j = 0; j < 4; ++j) { f32x4 acc = {0.f, 0.f, 0.f, 0.f};
              if (!isv) {
#pragma unroll
                  for (int ks = 0; ks < 4; ++ks) acc = mma16(wf[j][ks], ck[ks], acc);
                  *(u32x2*)(KN + (size_t)(keyrow0 + tt * 16 + l15) * 256 + h * 64 + j * 16 + 4 * hq) = pk4(acc);
              } else {
#pragma unroll
                  for (int ks = 0; ks < 4; ++ks) acc = mma16(ck[ks], wf[j][ks], acc);
                  *(u32x2*)(VT + vtbase + (size_t)(h * 64 + j * 16 + l15) * nk + keypos0 + tt * 16 + 4 * hq) = pk4(acc);
              } } } }
    __syncthreads();
}

constexpr int AKS = 104, AVS = 72;
constexpr int ABUF = 64 * AKS * 2 + 64 * AVS * 2;
__device__ __forceinline__ int imax3(int a, int b, int c) { return max(a, max(b, c)); }
constexpr int AVS2 = 136; constexpr int ABUF2 = 128 * AKS * 2 + 64 * AVS2 * 2;
__device__ __forceinline__ void unit_attention(const Ctx& C, int u) {
    int rowbase, keyrow0, nk, h; size_t vtbase;
    if (u < 128) { const int s = u >> 2; h = u & 3; rowbase = s * 256; keyrow0 = s * 256; nk = 256; vtbase = (size_t)(s * 256) * 256; }
    else { const int v0 = u - 128; const int v = (C.G == 256) ? (((v0 & 7) * 2 + (v0 >> 7)) << 4) | ((v0 >> 3) & 15) : v0;
           const int b = v >> 6, qb = v & 15; h = (v >> 4) & 3; rowbase = M_CTX + b * 4096 + qb * 256; keyrow0 = M_CTX + b * 4352; nk = 4352; vtbase = (size_t)keyrow0 * 256; }
    const bf16_t* Q = (const bf16_t*)(C.ws + WS_Q); const bf16_t* KN = (const bf16_t*)(C.ws + WS_KN); const bf16_t* VT = (const bf16_t*)(C.ws + WS_VT); const bf16_t* KR = (const bf16_t*)(C.ws + WS_KR);
    bf16_t* MIX = (bf16_t*)(C.ws + WS_R1);
    const int l31 = C.lane & 31, hh = C.lane >> 5; const int qrow = rowbase + C.wave * 32 + l31;
    bf16x8 qf[6];
#pragma unroll
    for (int ks = 0; ks < 6; ++ks) qf[ks] = *(const bf16x8*)(Q + (size_t)qrow * 384 + h * 96 + ks * 16 + 8 * hh);
    f32x16 o0, o1, o2, negm;
#pragma unroll
    for (int i = 0; i < 16; ++i) { o0[i] = 0.f; o1[i] = 0.f; o2[i] = 0.f; negm[i] = 0.f; }
    const unsigned onew = (l31 == 0) ? 0x3F803F80u : 0u;
    const bf16x8 onesf = __builtin_bit_cast(bf16x8, (u32x4){onew, onew, onew, onew});
    const int skey = C.tid >> 3, sc8 = (C.tid & 7) * 8, rkey = (C.tid & 255) >> 2, rc8 = (C.tid & 3) * 8;
    const bf16_t* gkn = KN + (size_t)(keyrow0 + skey) * 256 + h * 64 + sc8;
    const bf16_t* gkr = KR + (size_t)(keyrow0 + rkey) * 32 + rc8;
    const bf16_t* gvt = VT + vtbase + (size_t)(h * 64 + skey) * nk + sc8;
    const bool do_r = C.tid < 256;
    const int lkn = (skey * AKS + sc8) * 2, lkr = (rkey * AKS + 64 + rc8) * 2, lvt = 128 * AKS * 2 + (skey * AVS2 + sc8) * 2;
    const int ntile = nk >> 7;
    u32x4 rk[2], rr[2] = {{0u, 0u, 0u, 0u}, {0u, 0u, 0u, 0u}}, rv[2];
#define ATT_LD(t) do { _Pragma("unroll") for (int s_ = 0; s_ < 2; ++s_) { rk[s_] = *(const u32x4*)(gkn + (size_t)(2 * (t) + s_) * 64 * 256); if (do_r) rr[s_] = *(const u32x4*)(gkr + (size_t)(2 * (t) + s_) * 64 * 32); rv[s_] = *(const u32x4*)(gvt + (2 * (t) + s_) * 64); } } while (0)
#define ATT_ST(buf) do { LAS unsigned char* b_ = C.lds + (buf) * ABUF2; _Pragma("unroll") for (int s_ = 0; s_ < 2; ++s_) { *(LAS u32x4*)(b_ + lkn + s_ * 64 * AKS * 2) = rk[s_]; if (do_r) *(LAS u32x4*)(b_ + lkr + s_ * 64 * AKS * 2) = rr[s_]; *(LAS u32x4*)(b_ + lvt + s_ * 128) = rv[s_]; } } while (0)
    ATT_LD(0); ATT_ST(0);
    __syncthreads();
#pragma unroll 1
    for (int kt = 0; kt < ntile; ++kt) {
        const bool more = kt + 1 < ntile;
        if (more) ATT_LD(kt + 1);
        LAS unsigned char* B = C.lds + (kt & 1) * ABUF2;
#pragma unroll 1
        for (int sub = 0; sub < 2; ++sub) {
        const LAS bf16_t* Kl = (const LAS bf16_t*)B + sub * 64 * AKS; const LAS bf16_t* Vl = (const LAS bf16_t*)(B + 128 * AKS * 2) + sub * 64;
        bf16x8 ka[2][6];
#pragma unroll
        for (int ks = 0; ks < 6; ++ks) { ka[0][ks] = *(const LAS bf16x8*)(Kl + l31 * AKS + ks * 16 + 8 * hh); ka[1][ks] = *(const LAS bf16x8*)(Kl + (32 + l31) * AKS + ks * 16 + 8 * hh); }
        __builtin_amdgcn_sched_barrier(0);
        f32x16 s0 = mma32(ka[0][0], qf[0], negm), s1 = mma32(ka[1][0], qf[0], negm);
#pragma unroll
        for (int ks = 1; ks < 6; ++ks) { s0 = mma32(ka[0][ks], qf[ks], s0); s1 = mma32(ka[1][ks], qf[ks], s1); }
        __builtin_amdgcn_sched_barrier(0);
        u32x2 vr[2][2][4];
#pragma unroll
        for (int t = 0; t < 2; ++t)
#pragma unroll
            for (int ss = 0; ss < 2; ++ss) { const int ko = 32 * t + 16 * ss + 4 * hh;
                vr[t][ss][0] = *(const LAS u32x2*)(Vl + l31 * AVS2 + ko); vr[t][ss][1] = *(const LAS u32x2*)(Vl + l31 * AVS2 + ko + 8);
                vr[t][ss][2] = *(const LAS u32x2*)(Vl + (32 + l31) * AVS2 + ko); vr[t][ss][3] = *(const LAS u32x2*)(Vl + (32 + l31) * AVS2 + ko + 8); }
        __builtin_amdgcn_sched_barrier(0);
        float d; bool resc;
        if (kt == 0 && sub == 0) {
            float mx = fmaxf(s0[0], s1[0]);
#pragma unroll
            for (int i = 1; i < 16; ++i) mx = fmaxf(mx, fmaxf(s0[i], s1[i]));
            d = fmaxf(mx, __shfl_xor(mx, 32)); resc = true;
        } else {
            int im = imax3(__builtin_bit_cast(int, s0[0]), __builtin_bit_cast(int, s1[0]), __builtin_bit_cast(int, s0[1]));
            im = imax3(im, __builtin_bit_cast(int, s1[1]), __builtin_bit_cast(int, s0[2])); im = imax3(im, __builtin_bit_cast(int, s1[2]), __builtin_bit_cast(int, s0[3]));
            im = imax3(im, __builtin_bit_cast(int, s1[3]), __builtin_bit_cast(int, s0[4])); im = imax3(im, __builtin_bit_cast(int, s1[4]), __builtin_bit_cast(int, s0[5]));
            im = imax3(im, __builtin_bit_cast(int, s1[5]), __builtin_bit_cast(int, s0[6])); im = imax3(im, __builtin_bit_cast(int, s1[6]), __builtin_bit_cast(int, s0[7]));
            im = imax3(im, __builtin_bit_cast(int, s1[7]), __builtin_bit_cast(int, s0[8])); im = imax3(im, __builtin_bit_cast(int, s1[8]), __builtin_bit_cast(int, s0[9]));
            im = imax3(im, __builtin_bit_cast(int, s1[9]), __builtin_bit_cast(int, s0[10])); im = imax3(im, __builtin_bit_cast(int, s1[10]), __builtin_bit_cast(int, s0[11]));
            im = imax3(im, __builtin_bit_cast(int, s1[11]), __builtin_bit_cast(int, s0[12])); im = imax3(im, __builtin_bit_cast(int, s1[12]), __builtin_bit_cast(int, s0[13]));
            im = imax3(im, __builtin_bit_cast(int, s1[13]), __builtin_bit_cast(int, s0[14])); im = imax3(im, __builtin_bit_cast(int, s1[14]), __builtin_bit_cast(int, s0[15]));
            im = max(im, __builtin_bit_cast(int, s1[15]));
            im = max(im, __shfl_xor(im, 32));
            resc = __builtin_amdgcn_ballot_w64(im > 0x41000000) != 0ull; d = im > 0x41000000 ? __builtin_bit_cast(float, im) : 0.f;
        }
        if (resc) {
            if (kt != 0 || sub != 0) { const float alpha = __builtin_amdgcn_exp2f(-d); o0 = o0 * alpha; o1 = o1 * alpha; o2 = o2 * alpha; }
            negm = negm - d; s0 = s0 - d; s1 = s1 - d;
        }
#pragma unroll
        for (int i = 0; i < 16; ++i) { s0[i] = __builtin_amdgcn_exp2f(s0[i]); s1[i] = __builtin_amdgcn_exp2f(s1[i]); }
#pragma unroll
        for (int t = 0; t < 2; ++t)
#pragma unroll
            for (int ss = 0; ss < 2; ++ss) {
                u32x4 w;
                if (t == 0) { w.x = pk2(s0[8 * ss + 0], s0[8 * ss + 1]); w.y = pk2(s0[8 * ss + 2], s0[8 * ss + 3]); w.z = pk2(s0[8 * ss + 4], s0[8 * ss + 5]); w.w = pk2(s0[8 * ss + 6], s0[8 * ss + 7]); }
                else { w.x = pk2(s1[8 * ss + 0], s1[8 * ss + 1]); w.y = pk2(s1[8 * ss + 2], s1[8 * ss + 3]); w.z = pk2(s1[8 * ss + 4], s1[8 * ss + 5]); w.w = pk2(s1[8 * ss + 6], s1[8 * ss + 7]); }
                const bf16x8 pf = __builtin_bit_cast(bf16x8, w);
                const bf16x8 va = __builtin_bit_cast(bf16x8, (u32x4){vr[t][ss][0].x, vr[t][ss][0].y, vr[t][ss][1].x, vr[t][ss][1].y}), vb = __builtin_bit_cast(bf16x8, (u32x4){vr[t][ss][2].x, vr[t][ss][2].y, vr[t][ss][3].x, vr[t][ss][3].y});
                o0 = mma32(va, pf, o0); o1 = mma32(vb, pf, o1); o2 = mma32(onesf, pf, o2);
            }
        }
        if (more) ATT_ST((kt + 1) & 1);
        __syncthreads();
    }
#undef ATT_LD
#undef ATT_ST
    const float lsum = o2[0] + __shfl_xor(o2[0], 32);
    const float inv = 1.f / lsum;
    bf16_t* orow = MIX + (size_t)qrow * D + 768 + h * 64;
#pragma unroll
    for (int i = 0; i < 4; ++i) { const int dv = 8 * i + 4 * hh;
        *(u32x2*)(orow + dv) = pk4((f32x4){o0[4 * i] * inv, o0[4 * i + 1] * inv, o0[4 * i + 2] * inv, o0[4 * i + 3] * inv});
        *(u32x2*)(orow + 32 + dv) = pk4((f32x4){o1[4 * i] * inv, o1[4 * i + 1] * inv, o1[4 * i + 2] * inv, o1[4 * i + 3] * inv}); }
}

#define XB_TMO      128
#define XB_XCNT(j)  (256  + 64 * (j))
#define XB_XSUB(j)  (1280 + 64 * (j))
#define XB_XGEN(j)  (2304 + 64 * (j))
#define XB_TOP      3328
#define XB_TOPGEN   3392
#define XCD_BAR_WORDS 3456
#define XB_SPIN_CAP (1u << 18)

__device__ __forceinline__ unsigned xb_ld(unsigned* p)              { return __hip_atomic_load(p, __ATOMIC_RELAXED, __HIP_MEMORY_SCOPE_AGENT); }
__device__ __forceinline__ unsigned xb_add(unsigned* p, unsigned v) { return __hip_atomic_fetch_add(p, v, __ATOMIC_RELAXED, __HIP_MEMORY_SCOPE_AGENT); }
__device__ __forceinline__ unsigned xb_xcc_id() { return (unsigned)__builtin_amdgcn_s_getreg((3 << 11) | 20) & 0xFu; }
#define XB_SPIN(cond, bar) do { unsigned _sp = 0; while (cond) { __builtin_amdgcn_s_sleep(1); \
    if ((++_sp & 255u) == 0u) { if (xb_ld(&(bar)[XB_TMO])) break; if (_sp > XB_SPIN_CAP) { atomicAdd(&(bar)[XB_TMO], 1u); break; } } } } while (0)

struct XcdBarrier {
    unsigned* bar; unsigned x;
    volatile LAS unsigned* st;
};

__device__ __forceinline__ XcdBarrier xcd_barrier_post(unsigned* bar, volatile LAS unsigned* st) {
    XcdBarrier b; b.bar = bar; b.x = xb_xcc_id(); b.st = st;
    if (threadIdx.x == 0) (void)xb_add(&bar[XB_XCNT(b.x)], 1u);
    return b;
}
__device__ __forceinline__ void xcd_barrier_complete(unsigned* bar, unsigned x, unsigned& nloc, unsigned& nx) {
    const unsigned G = gridDim.x * gridDim.y * gridDim.z;
    unsigned sum, cnt, mine, sp = 0u;
    for (;;) {
        sum = 0u; cnt = 0u; mine = 0u;
#pragma unroll
        for (unsigned j = 0; j < 16; ++j) { const unsigned c = xb_ld(&bar[XB_XCNT(j)]); sum += c; cnt += (c > 0u) ? 1u : 0u; mine = (j == x) ? c : mine; }
        if (sum == G) break;
        __builtin_amdgcn_s_sleep(1);
        if ((++sp & 255u) == 0u) { if (xb_ld(&bar[XB_TMO])) break; if (sp > XB_SPIN_CAP) { atomicAdd(&bar[XB_TMO], 1u); break; } }
    }
    nloc = mine > 0u ? mine : 1u; nx = cnt > 0u ? cnt : 1u;
}

__device__ __forceinline__ void xcd_barrier(const XcdBarrier& b) {
    asm volatile("s_waitcnt vmcnt(0)" ::: "memory");
    __syncthreads();
    if (threadIdx.x == 0) {
        unsigned* bar = b.bar;
        __builtin_amdgcn_s_waitcnt(0);
        unsigned nloc = b.st[0], nx = b.st[1];
        if (nloc == 0u) { xcd_barrier_complete(bar, b.x, nloc, nx); b.st[0] = nloc; b.st[1] = nx; }
        const unsigned old = xb_add(&bar[XB_XSUB(b.x)], 1u);
        const unsigned gen = old / nloc;
        if (old + 1u == (gen + 1u) * nloc) {
            __builtin_amdgcn_fence(__ATOMIC_RELEASE, "agent");
            asm volatile("s_waitcnt vmcnt(0)" ::: "memory");
            const unsigned og = xb_add(&bar[XB_TOP], 1u);
            const unsigned tg = og / nx;
            if (og + 1u == (tg + 1u) * nx) xb_add(&bar[XB_TOPGEN], 1u);
            else XB_SPIN(xb_ld(&bar[XB_TOPGEN]) == tg, bar);
            __builtin_amdgcn_fence(__ATOMIC_ACQUIRE, "agent");
            xb_add(&bar[XB_XGEN(b.x)], 1u);
            asm volatile("s_waitcnt vmcnt(0)" ::: "memory");
        } else {
            XB_SPIN(xb_ld(&bar[XB_XGEN(b.x)]) == gen, bar);
            __builtin_amdgcn_fence(__ATOMIC_ACQUIRE, "agent");
            asm volatile("s_waitcnt vmcnt(0)" ::: "memory");
        }
    }
    __syncthreads();
}

__global__ void __launch_bounds__(NTHREADS, 2) mk_fwd(Params p) {
    extern __shared__ __attribute__((aligned(16))) unsigned char lds_raw[];
    cg::grid_group grid = cg::this_grid();
    Ctx C; C.p = p; C.lds = (LAS unsigned char*)lds_raw; C.tid = threadIdx.x; C.lane = C.tid & 63; C.wave = __builtin_amdgcn_readfirstlane(C.tid >> 6); C.bid = blockIdx.x; C.G = gridDim.x; C.ws = p.ws;

    volatile LAS unsigned* bst = (volatile LAS unsigned*)(C.lds + LDS_BYTES - 64);
    if (threadIdx.x < 2) bst[threadIdx.x] = 0u;
    __syncthreads();
    const XcdBarrier bar = xcd_barrier_post((unsigned*)(p.ws + WS_BAR), bst);
    C.refresh(); phase_prologue(C);
    grid.sync();
    C.refresh(); phase_norm0(C);
    xcd_barrier(bar);
#pragma unroll 1
    for (int layer = 0; layer < DEPTH; ++layer) {
        { C.refresh(); bf16_t* R1 = (bf16_t*)(C.ws + WS_R1); bf16_t* R2 = (bf16_t*)(C.ws + WS_R2); unsigned char* wl = C.wl(layer); pg8::Gemm g{R1, (const bf16_t*)(wl + WL_IN), M, NPP, D}; pg8::StaticOrder S; S.init(M, NPP, C.G, C.bid); pg8::EpiStore E{R2, NP, NP};
          pg8::gemm_phase<pg8::EpiStore, pg8::StaticOrder, true, true>(C.lds, g, S, E); }
        xcd_barrier(bar);
        C.refresh();
        for (int u = C.bid; u < 768 + 192 + 128 + 128 + 200; u += C.G) {
            C.refresh();
            if (u < 768) unit_chunk_mlp(C, layer, u);
            else if (u < 960) unit_conv(C, layer, u - 768);
            else if (u < 1088) unit_fourier_ctx(C, u - 960);
            else if (u < 1216) unit_fourier_lat1(C, u - 1088);
            else unit_mla_prep(C, layer, u - 1216);
        }
        xcd_barrier(bar);
        C.refresh();
        for (int u = C.bid; u < 512; u += C.G) {
            C.refresh();
            if (u < 256) unit_attention(C, 128 + u);
            else if (u < 384) unit_attention(C, u - 256);
            else unit_fourier_lat2(C, u - 384);
        }
        xcd_barrier(bar);
        { C.refresh(); bf16_t* R1 = (bf16_t*)(C.ws + WS_R1); bf16_t* R2 = (bf16_t*)(C.ws + WS_R2); unsigned char* wl = C.wl(layer); pg8::Gemm g{R1, (const bf16_t*)(wl + WL_OUT), M, D, D}; pg8::SplitTailOrder S; S.init(D, C.G, C.bid); pg8::EpiStoreSplit E{R2, R2 + (size_t)M * D - (size_t)SPLIT_ROW0 * D, D};
          pg8::gemm_phase<pg8::EpiStoreSplit, pg8::SplitTailOrder, true, true>(C.lds, g, S, E); }
        xcd_barrier(bar);
        C.refresh(); phase_post<0>(C, layer);
        xcd_barrier(bar);
        { C.refresh(); bf16_t* R1 = (bf16_t*)(C.ws + WS_R1); bf16_t* R2 = (bf16_t*)(C.ws + WS_R2); unsigned char* wl = C.wl(layer); pg8::Gemm g{R1, (const bf16_t*)(wl + WL_GU), M, 2 * FF, D}; pg8::StaticOrder S; S.init(M, 2 * FF, C.G, C.bid); pg8::EpiSwiGLU E{R2, FF};
          pg8::gemm_phase<pg8::EpiSwiGLU, pg8::StaticOrder, true, true>(C.lds, g, S, E);
          if (C.G == 256 && layer + 1 < DEPTH && C.bid >= 64) { C.refresh(); transpose_items(C, (layer + 1) * TI_L + (C.bid - 64), 192, (layer + 2) * TI_L); } }
        xcd_barrier(bar);
        { C.refresh(); bf16_t* R2 = (bf16_t*)(C.ws + WS_R2); bf16_t* R3 = (bf16_t*)(C.ws + WS_MLA); unsigned char* wl = C.wl(layer); pg8::Gemm g{R2, (const bf16_t*)(wl + WL_DN), M, D, FF}; pg8::SplitTailOrder S; S.init(FF, C.G, C.bid); pg8::EpiStoreSplit E{R3, R3 + (size_t)M * D - (size_t)SPLIT_ROW0 * D, D};
          pg8::gemm_phase<pg8::EpiStoreSplit, pg8::SplitTailOrder, true, true>(C.lds, g, S, E); }
        xcd_barrier(bar);
        C.refresh(); phase_post<1>(C, layer);
        if (layer + 1 < DEPTH) xcd_barrier(bar);
    }
}

extern "C" void kernel_launch(void* const* d_in, const int* in_sizes, int n_in, void* d_out, int out_size, void* d_ws, size_t ws_size, hipStream_t stream) {
    static int grid = 0;
    if (grid == 0) {
        if (n_in != 24 || ws_size < WS_END) { fprintf(stderr, "kernel_launch: need 24 inputs and %zu bytes of workspace; got %d, %zu\n", (size_t)WS_END, n_in, ws_size); grid = -1; return; }
        int dev = 0, cus = 0, per_cu = 0;
        if (hipGetDevice(&dev) != hipSuccess || hipDeviceGetAttribute(&cus, hipDeviceAttributeMultiprocessorCount, dev) != hipSuccess) { grid = -1; return; }
        if (hipFuncSetAttribute((const void*)mk_fwd, hipFuncAttributeMaxDynamicSharedMemorySize, LDS_BYTES) != hipSuccess) { fprintf(stderr, "kernel_launch: hipFuncSetAttribute failed\n"); grid = -1; return; }
        if (hipOccupancyMaxActiveBlocksPerMultiprocessor(&per_cu, (const void*)mk_fwd, NTHREADS, LDS_BYTES) != hipSuccess || per_cu < 1) fprintf(stderr, "kernel_launch: occupancy query says %d blocks per CU\n", per_cu);
        (void)hipGetLastError();
        grid = cus;
    }
    if (grid < 0) return;
    Params p{};
    for (int i = 0; i < 24; ++i) p.in[i] = (const float*)d_in[i];
    p.out = (float*)d_out; p.ws = (unsigned char*)d_ws;
    if (hipMemsetAsync((char*)d_ws + WS_BAR, 0, WS_BAR_BYTES, stream) != hipSuccess) { fprintf(stderr, "kernel_launch: memset failed\n"); return; }
    void* args[] = {&p};
    hipError_t e = hipLaunchCooperativeKernel((const void*)mk_fwd, dim3(grid), dim3(NTHREADS), args, LDS_BYTES, stream);
    if (e != hipSuccess) fprintf(stderr, "kernel_launch: cooperative launch failed: %s (grid %d)\n", hipGetErrorString(e), grid);
}
```

```cpp
#include <hip/hip_runtime.h>
#include <hip/hip_cooperative_groups.h>
#include <cstdio>
#include <cstdint>
namespace cg = cooperative_groups;
namespace pg8 {
#define PG8_LAS __attribute__((address_space(3)))
typedef unsigned short bf16_t;
typedef short bf16x8 __attribute__((ext_vector_type(8)));
typedef float f32x4 __attribute__((ext_vector_type(4)));
typedef unsigned u32x4 __attribute__((ext_vector_type(4)));
constexpr int BM = 256, BK = 64, HALF = 128, HTB = HALF * BK * 2  , STAGE_BYTES = 8 * HTB, NXCD = 8, WGM = 8;

__host__ __device__ __forceinline__ int lds_byte(int r, int c) { const int st = (r >> 4) * 2 + (c >> 5), rr = r & 15, cc = c & 31, ob = rr * 64 + cc * 2; return st * 1024 + (ob ^ (((ob >> 9) & 1) << 5)); }
__host__ __device__ __forceinline__ void stage_rc(int b, int& R, int& C) { const int st = b / 1024, sb = b % 1024, swz = sb ^ (((sb >> 9) & 1) << 5); R = (st >> 1) * 16 + swz / 64; C = (st & 1) * 32 + (swz % 64) / 2; }
__host__ __device__ __forceinline__ int perm32(int rho) { const int n = rho >> 4, i = rho & 15; return 8 * (i >> 2) + 4 * n + (i & 3); }

struct Unit { int pm, pn; int kh, nt, koff; };
struct Gemm { const bf16_t* A; const bf16_t* Bt; int M, N, K; };

struct StaticOrder {
    int nM, nN, nwg, G, c;
    __host__ __device__ void init(int M, int N, int G_, int c_) { nM = M / BM; nN = N / BM; nwg = nM * nN; G = G_; c = c_; }
    __host__ __device__ bool next(int i, Unit& u) const {
        const long L = (long)i * G + c; if (L >= nwg) return false;
        int wgid = (int)L; { const int q = nwg / NXCD, r = nwg % NXCD, xcd = wgid % NXCD, off = wgid / NXCD; wgid = (xcd < r ? xcd * (q + 1) : r * (q + 1) + (xcd - r) * q) + off; }
        const int nig = WGM * nN, gid = wgid / nig, fm = gid * WGM, gsz = (nM - fm) < WGM ? (nM - fm) : WGM;
        u.pm = fm + ((wgid % nig) % gsz); u.pn = (wgid % nig) / gsz; u.kh = 0; u.nt = 0; u.koff = 0; return true;
    }
    __device__ __forceinline__ void a_ready(const Unit&) const {}
    __device__ __forceinline__ void done(const Unit&) const {}
};

__device__ __forceinline__ unsigned cvt_pk_bf16(float lo, float hi) { unsigned r; asm volatile("v_cvt_pk_bf16_f32 %0, %1, %2" : "=v"(r) : "v"(lo), "v"(hi)); return r; }
typedef float f32x2 __attribute__((ext_vector_type(2)));
struct EpiStore {
    static constexpr bool PERM = true, AFTER_DRAIN = false;
    bf16_t* O; int ldc; int ncols;
    __device__ __forceinline__ void operator()(const f32x4 (&acc)[2][2][4][2], const Unit& u, int wr, int wc, int fr, int fq) const {
        const int row0 = u.pm * BM + wr * 64 + fr; const int col0 = u.pn * BM + wc * 32 + 8 * fq;
#pragma unroll
        for (int ai = 0; ai < 2; ++ai)
#pragma unroll
            for (int m = 0; m < 4; ++m) { bf16_t* rowp = O + (size_t)(row0 + ai * HALF + m * 16) * ldc + col0;
#pragma unroll
                for (int bj = 0; bj < 2; ++bj) { const f32x4 v0 = acc[ai][bj][m][0], v1 = acc[ai][bj][m][1];
                    u32x4 w; w.x = cvt_pk_bf16(v0[0], v0[1]); w.y = cvt_pk_bf16(v0[2], v0[3]); w.z = cvt_pk_bf16(v1[0], v1[1]); w.w = cvt_pk_bf16(v1[2], v1[3]);
                    if (col0 + bj * HALF < ncols) *(u32x4*)(rowp + bj * HALF) = w; } }
    }
};
struct EpiStoreWT {
    static constexpr bool PERM = true, AFTER_DRAIN = false;
    bf16_t* O; int ldc; int ncols;
    __device__ __forceinline__ void operator()(const f32x4 (&acc)[2][2][4][2], const Unit& u, int wr, int wc, int fr, int fq) const {
        const int row0 = u.pm * BM + wr * 64 + fr; const int col0 = u.pn * BM + wc * 32 + 8 * fq;
#pragma unroll
        for (int ai = 0; ai < 2; ++ai)
#pragma unroll
            for (int m = 0; m < 4; ++m) { bf16_t* rowp = O + (size_t)(row0 + ai * HALF + m * 16) * ldc + col0;
#pragma unroll
                for (int bj = 0; bj < 2; ++bj) { const f32x4 v0 = acc[ai][bj][m][0], v1 = acc[ai][bj][m][1];
                    const unsigned long long lo = (unsigned long long)cvt_pk_bf16(v0[0], v0[1]) | ((unsigned long long)cvt_pk_bf16(v0[2], v0[3]) << 32);
                    const unsigned long long hi = (unsigned long long)cvt_pk_bf16(v1[0], v1[1]) | ((unsigned long long)cvt_pk_bf16(v1[2], v1[3]) << 32);
                    unsigned long long* q = (unsigned long long*)(rowp + bj * HALF);
                    __hip_atomic_store(q, lo, __ATOMIC_RELAXED, __HIP_MEMORY_SCOPE_AGENT); __hip_atomic_store(q + 1, hi, __ATOMIC_RELAXED, __HIP_MEMORY_SCOPE_AGENT); } }
    }
};
__device__ __forceinline__ float silu_mul(float g, float u) { return g * u * __builtin_amdgcn_rcpf(1.f + __expf(-g)); }
struct EpiSwiGLU {
    static constexpr bool PERM = true, AFTER_DRAIN = false;
    bf16_t* O; int ldc;
    __device__ __forceinline__ void operator()(const f32x4 (&acc)[2][2][4][2], const Unit& u, int wr, int wc, int fr, int fq) const {
        const int row0 = u.pm * BM + wr * 64 + fr; const int col0 = u.pn * HALF + wc * 32 + 8 * fq;
#pragma unroll
        for (int ai = 0; ai < 2; ++ai)
#pragma unroll
            for (int m = 0; m < 4; ++m) { bf16_t* rowp = O + (size_t)(row0 + ai * HALF + m * 16) * ldc + col0;
                const f32x4 g0 = acc[ai][0][m][0], g1 = acc[ai][0][m][1], u0 = acc[ai][1][m][0], u1 = acc[ai][1][m][1];
                u32x4 w; w.x = cvt_pk_bf16(silu_mul(g0[0], u0[0]), silu_mul(g0[1], u0[1])); w.y = cvt_pk_bf16(silu_mul(g0[2], u0[2]), silu_mul(g0[3], u0[3]));
                w.z = cvt_pk_bf16(silu_mul(g1[0], u1[0]), silu_mul(g1[1], u1[1])); w.w = cvt_pk_bf16(silu_mul(g1[2], u1[2]), silu_mul(g1[3], u1[3]));
                *(u32x4*)rowp = w; }
    }
};

struct PanelOrder {
    int nN, nwg, G, c; unsigned* cnt;
    __device__ void init(int M, int N, int G_, int c_, unsigned* cnt_) { nN = N / BM; nwg = (M / BM) * nN; G = G_; c = c_; cnt = cnt_; }
    __device__ bool next(int i, Unit& u) const { const long L = (long)i * G + c; if (L >= nwg) return false; u.pm = (int)L / nN; u.pn = (int)L % nN; u.kh = 0; u.nt = 0; u.koff = 0; return true; }
    __device__ __forceinline__ void a_ready(const Unit&) const {}
    __device__ __forceinline__ void done(const Unit& u) const {
        asm volatile("s_waitcnt vmcnt(0)" ::: "memory");
        if ((threadIdx.x & 63) == 0) __hip_atomic_fetch_add(cnt + u.pm, 1u, __ATOMIC_RELAXED, __HIP_MEMORY_SCOPE_AGENT);
    }
};

struct SplitTailOrder {
    int G, c, ntf; bool split;
    __device__ void init(int K, int G_, int c_) { G = G_; c = c_; ntf = K / BK; split = (G_ == 256); }
    __device__ bool next(int i, Unit& u) const {
        if (!split) { const long L = (long)i * G + c; if (L >= 384) return false; u.pm = (int)L >> 2; u.pn = (int)L & 3; u.kh = 0; u.nt = 0; u.koff = 0; return true; }
        if (i == 0) { const int t = (c & 7) * 32 + (c >> 3); u.pm = t >> 2; u.pn = t & 3; u.kh = 0; u.nt = 0; u.koff = 0; return true; }
        if (i == 1) { const int t = 256 + (c & 7) * 16 + (c >> 4); u.pm = t >> 2; u.pn = t & 3; u.kh = (c >> 3) & 1; u.nt = ntf / 2; u.koff = u.kh * (ntf / 2) * BK * 2; return true; }
        return false;
    }
    __device__ __forceinline__ void a_ready(const Unit&) const {}
    __device__ __forceinline__ void done(const Unit&) const {}
};
struct EpiStoreSplit {
    static constexpr bool PERM = true, AFTER_DRAIN = false;
    bf16_t* O; bf16_t* O1; int ldc;
    __device__ __forceinline__ void operator()(const f32x4 (&acc)[2][2][4][2], const Unit& u, int wr, int wc, int fr, int fq) const {
        const int row0 = u.pm * BM + wr * 64 + fr; const int col0 = u.pn * BM + wc * 32 + 8 * fq; bf16_t* base = u.kh ? O1 : O;
#pragma unroll
        for (int ai = 0; ai < 2; ++ai)
#pragma unroll
            for (int m = 0; m < 4; ++m) { bf16_t* rowp = base + (size_t)(row0 + ai * HALF + m * 16) * ldc + col0;
#pragma unroll
                for (int bj = 0; bj < 2; ++bj) { const f32x4 v0 = acc[ai][bj][m][0], v1 = acc[ai][bj][m][1];
                    u32x4 w; w.x = cvt_pk_bf16(v0[0], v0[1]); w.y = cvt_pk_bf16(v0[2], v0[3]); w.z = cvt_pk_bf16(v1[0], v1[1]); w.w = cvt_pk_bf16(v1[2], v1[3]);
                    *(u32x4*)(rowp + bj * HALF) = w; } }
    }
};
template <class Epi, class Sched, bool ALIGN_EPI = false, bool SP2 = false>
__device__ __forceinline__ void gemm_phase(PG8_LAS unsigned char* lds, const Gemm g, const Sched& S, const Epi& E) {
    int tid_ = threadIdx.x; asm volatile("" : "+v"(tid_));
    const int tid = tid_, wid = __builtin_amdgcn_readfirstlane(tid >> 6), lane = tid & 63, wr = wid >> 2, wc = wid & 3, fr = lane & 15, fq = lane >> 4;
    const int K = g.K, nt = K / BK;
    unsigned voffA[2], voffB[2];
#pragma unroll
    for (int i = 0; i < 2; ++i) { int R, C; stage_rc(tid * 16 + i * 8192, R, C); const int Rb = Epi::PERM ? ((R & ~31) + perm32(R & 31)) : R;
        voffA[i] = (unsigned)(R * K + C) * 2u; voffB[i] = (unsigned)(Rb * K + C) * 2u; }
    const size_t kstep = (size_t)(BK * 2);
    const size_t hstep = (size_t)HALF * K * 2;
    const size_t tstep = 2 * hstep;
    const unsigned ldsw = (unsigned)wid * 1024u;
    const int aoff = lds_byte(wr * 64 + fr, fq * 8), boff = lds_byte(wc * 32 + fr, fq * 8);
#define PG8_SA(b, h) (((b) * 2 + (h)) * HTB)
#define PG8_SB(b, h) ((4 + (b) * 2 + (h)) * HTB)
#define PG8_STAGE(bufoff, gbase, voff) do { _Pragma("unroll") for (int _i = 0; _i < 2; ++_i) \
        __builtin_amdgcn_global_load_lds((const unsigned*)((const char*)(gbase) + (voff)[_i]), (PG8_LAS unsigned*)(lds + (bufoff) + ldsw + _i * 8192), 16, 0, 0); } while (0)
#define PG8_LDA(dst, b, h) do { _Pragma("unroll") for (int m = 0; m < 4; ++m) _Pragma("unroll") for (int k = 0; k < 2; ++k) dst[m][k] = *(const PG8_LAS bf16x8*)(lds + PG8_SA(b, h) + aoff + m * 2048 + k * 1024); } while (0)
#define PG8_LDB(dst, b, h) do { _Pragma("unroll") for (int n = 0; n < 2; ++n) _Pragma("unroll") for (int k = 0; k < 2; ++k) dst[n][k] = *(const PG8_LAS bf16x8*)(lds + PG8_SB(b, h) + boff + n * 2048 + k * 1024); } while (0)
#define PG8_MMA(ai, bj, At, Bt) do { __builtin_amdgcn_s_setprio(1); _Pragma("unroll") for (int m = 0; m < 4; ++m) _Pragma("unroll") for (int n = 0; n < 2; ++n) _Pragma("unroll") for (int k = 0; k < 2; ++k) \
        acc[ai][bj][m][n] = __builtin_amdgcn_mfma_f32_16x16x32_bf16(Bt[n][k], At[m][k], acc[ai][bj][m][n], 0, 0, 0); __builtin_amdgcn_s_setprio(0); } while (0)
#define PG8_WAIT_V(n) asm volatile("s_waitcnt vmcnt(" #n ")" ::: "memory")
#define PG8_WAIT_L(n) asm volatile("s_waitcnt lgkmcnt(" #n ")" ::: "memory")
#define PG8_BAR __builtin_amdgcn_s_barrier()
#define PG8_SCHED __builtin_amdgcn_sched_barrier(0)
    Unit cur, nxt; int ui = 0;
    if (!S.next(0, cur)) return;
    f32x4 acc[2][2][4][2];
#pragma unroll
    for (int a = 0; a < 2; ++a)
#pragma unroll
        for (int b = 0; b < 2; ++b)
#pragma unroll
            for (int m = 0; m < 4; ++m)
#pragma unroll
                for (int n = 0; n < 2; ++n) acc[a][b][m][n] = (f32x4){0.f, 0.f, 0.f, 0.f};
    bf16x8 At[4][2], B0[2][2], B1[2][2];
    const char* cA = (const char*)g.A + (size_t)cur.pm * tstep + cur.koff; const char* cB = (const char*)g.Bt + (size_t)cur.pn * tstep + cur.koff;
    S.a_ready(cur);
    if constexpr (SP2) {
        PG8_STAGE(PG8_SB(0, 0), cB, voffB); PG8_STAGE(PG8_SB(0, 1), cB + hstep, voffB); PG8_STAGE(PG8_SA(0, 0), cA, voffA); PG8_STAGE(PG8_SA(0, 1), cA + hstep, voffA);
        if (wr == 1) PG8_BAR;
        PG8_WAIT_V(2); PG8_BAR;
        PG8_STAGE(PG8_SB(1, 0), cB + kstep, voffB); PG8_STAGE(PG8_SA(1, 0), cA + kstep, voffA); PG8_STAGE(PG8_SB(1, 1), cB + hstep + kstep, voffB);
        PG8_WAIT_V(6); PG8_BAR;
    } else {
        PG8_STAGE(PG8_SB(0, 0), cB, voffB); PG8_STAGE(PG8_SA(0, 0), cA, voffA); PG8_STAGE(PG8_SB(0, 1), cB + hstep, voffB); PG8_STAGE(PG8_SA(0, 1), cA + hstep, voffA);
        if (wr == 1) PG8_BAR;
        PG8_WAIT_V(4); PG8_BAR;
        PG8_STAGE(PG8_SB(1, 0), cB + kstep, voffB); PG8_STAGE(PG8_SA(1, 0), cA + kstep, voffA); PG8_STAGE(PG8_SB(1, 1), cB + hstep + kstep, voffB);
        PG8_WAIT_V(6); PG8_BAR;
    }
    for (;;) {
        const bool has_next = S.next(ui + 1, nxt);
        const char* nA = has_next ? (const char*)g.A + (size_t)nxt.pm * tstep + nxt.koff : cA; const char* nB = has_next ? (const char*)g.Bt + (size_t)nxt.pn * tstep + nxt.koff : cB;
        const int ntc = cur.nt ? cur.nt : nt;
        for (int t = 0; t < ntc; t += 2) {
            const bool last = (t == ntc - 2);
            const char* a1 = cA + (size_t)(t + 1) * kstep;
            const char* a2 = last ? nA : cA + (size_t)(t + 2) * kstep; const char* b2 = last ? nB : cB + (size_t)(t + 2) * kstep;
            const char* a3 = a2 + kstep; const char* b3 = b2 + kstep;
            if (last && has_next) S.a_ready(nxt);
            if constexpr (SP2) {
            PG8_LDB(B0, 0, 0); PG8_LDB(B1, 0, 1); PG8_SCHED; PG8_LDA(At, 0, 0); PG8_STAGE(PG8_SA(1, 1), a1 + hstep, voffA);
            PG8_WAIT_V(8); PG8_WAIT_L(0); PG8_BAR; PG8_MMA(0, 0, At, B0); PG8_MMA(0, 1, At, B1); PG8_BAR; PG8_SCHED;
            PG8_LDA(At, 0, 1); PG8_STAGE(PG8_SB(0, 0), b2, voffB); PG8_STAGE(PG8_SB(0, 1), b2 + hstep, voffB); PG8_STAGE(PG8_SA(0, 0), a2, voffA);
            PG8_WAIT_V(8); PG8_WAIT_L(0); PG8_BAR; PG8_MMA(1, 0, At, B0); PG8_MMA(1, 1, At, B1); PG8_BAR; PG8_SCHED;
            PG8_LDB(B0, 1, 0); PG8_LDB(B1, 1, 1); PG8_SCHED; PG8_LDA(At, 1, 0); PG8_STAGE(PG8_SA(0, 1), a2 + hstep, voffA);
            PG8_WAIT_V(8); PG8_WAIT_L(0); PG8_BAR; PG8_MMA(0, 0, At, B0); PG8_MMA(0, 1, At, B1); PG8_BAR; PG8_SCHED;
            PG8_LDA(At, 1, 1); PG8_STAGE(PG8_SB(1, 0), b3, voffB); PG8_STAGE(PG8_SB(1, 1), b3 + hstep, voffB); PG8_STAGE(PG8_SA(1, 0), a3, voffA);
            PG8_WAIT_V(8); PG8_WAIT_L(0); PG8_BAR; PG8_MMA(1, 0, At, B0); PG8_MMA(1, 1, At, B1); PG8_BAR; PG8_SCHED;
            } else {
            PG8_LDB(B0, 0, 0); PG8_SCHED; PG8_LDA(At, 0, 0); PG8_STAGE(PG8_SA(1, 1), a1 + hstep, voffA);
            PG8_WAIT_L(8); PG8_BAR; PG8_WAIT_L(0); PG8_MMA(0, 0, At, B0); PG8_BAR; PG8_SCHED;
            PG8_LDB(B1, 0, 1); PG8_STAGE(PG8_SB(0, 0), b2, voffB);
            PG8_BAR; PG8_WAIT_L(0); PG8_MMA(0, 1, At, B1); PG8_BAR;
            PG8_LDA(At, 0, 1); PG8_STAGE(PG8_SA(0, 0), a2, voffA);
            PG8_BAR; PG8_WAIT_L(0); PG8_MMA(1, 0, At, B0); PG8_BAR; PG8_SCHED;
            PG8_STAGE(PG8_SB(0, 1), b2 + hstep, voffB);
            PG8_WAIT_V(6); PG8_BAR; PG8_MMA(1, 1, At, B1); PG8_BAR;
            PG8_LDB(B0, 1, 0); PG8_SCHED; PG8_LDA(At, 1, 0); PG8_STAGE(PG8_SA(0, 1), a2 + hstep, voffA);
            PG8_WAIT_L(8); PG8_BAR; PG8_WAIT_L(0); PG8_MMA(0, 0, At, B0); PG8_BAR; PG8_SCHED;
            PG8_LDB(B1, 1, 1); PG8_STAGE(PG8_SB(1, 0), b3, voffB);
            PG8_BAR; PG8_WAIT_L(0); PG8_MMA(0, 1, At, B1); PG8_BAR;
            PG8_LDA(At, 1, 1); PG8_STAGE(PG8_SA(1, 0), a3, voffA);
            PG8_BAR; PG8_WAIT_L(0); PG8_MMA(1, 0, At, B0); PG8_BAR; PG8_SCHED;
            PG8_STAGE(PG8_SB(1, 1), b3 + hstep, voffB);
            PG8_WAIT_V(6); PG8_BAR; PG8_MMA(1, 1, At, B1); PG8_BAR;
            }
        }
        if constexpr (ALIGN_EPI) { if (wr == 0) PG8_BAR; }
        if constexpr (!Epi::AFTER_DRAIN) { E(acc, cur, wr, wc, fr, fq); S.done(cur); }
        if (!has_next) break;
#pragma unroll
        for (int a = 0; a < 2; ++a)
#pragma unroll
            for (int b = 0; b < 2; ++b)
#pragma unroll
                for (int m = 0; m < 4; ++m)
#pragma unroll
                    for (int n = 0; n < 2; ++n) acc[a][b][m][n] = (f32x4){0.f, 0.f, 0.f, 0.f};
        cur = nxt; cA = nA; cB = nB; ++ui;
        if constexpr (ALIGN_EPI) { if (wr == 1) PG8_BAR; }
    }
    PG8_WAIT_V(0);
    if constexpr (!ALIGN_EPI) { if (wr == 0) PG8_BAR; }
    PG8_BAR;
    if constexpr (Epi::AFTER_DRAIN) { E.fused(acc, cur, wr, wc, fr, fq, lds, wid, lane); S.done(cur); }
#undef PG8_SA
#undef PG8_SB
#undef PG8_STAGE
#undef PG8_LDA
#undef PG8_LDB
#undef PG8_MMA
#undef PG8_WAIT_V
#undef PG8_WAIT_L
#undef PG8_BAR
#undef PG8_SCHED
}
}
#define LAS __attribute__((address_space(3)))
typedef unsigned short bf16_t;
typedef short bf16x8 __attribute__((ext_vector_type(8)));
typedef short bf16x4 __attribute__((ext_vector_type(4)));
typedef float f32x4 __attribute__((ext_vector_type(4)));
typedef float f32x2 __attribute__((ext_vector_type(2)));
typedef float f32x16 __attribute__((ext_vector_type(16)));
typedef unsigned u32x4 __attribute__((ext_vector_type(4)));
typedef unsigned u32x2 __attribute__((ext_vector_type(2)));

constexpr int D = 1024, M_CTX = 8192, M_LAT = 16384, M = M_CTX + M_LAT, NP = 1888, NPP = 2048, FF = 2816, DEPTH = 4;
constexpr int KEYROWS = 8192 + 4 * 4352;
constexpr float EPS = 1e-6f;
constexpr int NTHREADS = 512, NWAVES = 8;
constexpr int LDS_BYTES = 147456;

constexpr size_t OUT_X = 0, OUT_CKV = (size_t)M * D, OUT_KR = OUT_CKV + (size_t)32 * 4 * 256 * 128;
constexpr int PC_U = 0, PC_V = 256, PC_H = 512, PC_B = 768, PC_C = 1024, PC_F = 1280, PC_Q = 1536, PC_KV = 1728, PC_KR = 1856;

constexpr size_t al256(size_t x) { return (x + 255) & ~(size_t)255; }
constexpr size_t WS_BAR = 0, WS_BAR_BYTES = 16384;
constexpr size_t WS_MOD = WS_BAR_BYTES;
constexpr size_t WS_F64 = al256(WS_MOD + (size_t)4 * 5 * 6144 * 4);
constexpr size_t WS_T64R = WS_F64 + 128 * 64 * 2;
constexpr size_t WS_T64I = WS_T64R + 64 * 128 * 2;
constexpr size_t WS_T64B = WS_T64I + 64 * 128 * 2;
constexpr size_t WS_T256 = WS_T64B + 64 * 128 * 2;
constexpr size_t WS_TW = WS_T256 + 256 * 512 * 2;
constexpr size_t WS_ROPE = WS_TW + 4096 * 8;
constexpr size_t WS_W = al256(WS_ROPE + 64 * 8 * 8);
constexpr size_t WL_IN = 0, WL_OUT = WL_IN + (size_t)NPP * D * 2, WL_GU = WL_OUT + (size_t)D * D * 2, WL_DN = WL_GU + (size_t)2 * FF * D * 2,
                 WL_UQ = WL_DN + (size_t)D * FF * 2, WL_UKV = WL_UQ + (size_t)384 * 192 * 2, WL_SP = WL_UKV + (size_t)512 * 128 * 2, WL_SIZE = WL_SP + (size_t)4 * 128 * 128 * 2;
constexpr size_t WS_R1 = al256(WS_W + 4 * WL_SIZE);
constexpr size_t WS_R2 = WS_R1 + (size_t)M * D * 2;
constexpr size_t WS_MLA = WS_R2 + (size_t)M * FF * 2;
constexpr size_t WS_Q = WS_MLA, WS_KN = WS_Q + (size_t)M * 384 * 2, WS_VT = WS_KN + (size_t)KEYROWS * 256 * 2, WS_KR = WS_VT + (size_t)KEYROWS * 256 * 2,
                 WS_GB = WS_KR + (size_t)KEYROWS * 32 * 2, WS_END = WS_GB + (size_t)4 * 4 * 64 * 64 * 128 * 2;
static_assert(WS_END - WS_MLA >= (size_t)M * D * 2, "FFNOUT alias");
static_assert((size_t)M * NP * 2 <= (size_t)M * FF * 2, "PROJ fits R2");

struct Params { const float* in[24]; float* out; unsigned char* ws; };
enum { I_XP = 0, I_XS, I_CCKV, I_CKR, I_C, I_CCTX, I_WADA, I_BADA, I_GPM, I_GPOM, I_GPF, I_GPOF, I_WIN, I_SPW, I_SPB, I_CVW, I_CVB, I_GQ, I_WUQ, I_GKV, I_WUKV, I_WOUT, I_WGU, I_WDN };

__device__ __forceinline__ unsigned f2bf(float f) { unsigned u = __builtin_bit_cast(unsigned, f); return (u + 0x7fffu + ((u >> 16) & 1u)) >> 16; }
typedef __bf16 bf16x2v __attribute__((ext_vector_type(2)));
__device__ __forceinline__ unsigned pk2(float lo, float hi) { const bf16x2v r = __builtin_convertvector((f32x2){lo, hi}, bf16x2v); return __builtin_bit_cast(unsigned, r); }
__device__ __forceinline__ float bflo(unsigned w) { return __builtin_bit_cast(float, w << 16); }
__device__ __forceinline__ float bfhi(unsigned w) { return __builtin_bit_cast(float, w & 0xffff0000u); }
__device__ __forceinline__ float bf1(bf16_t v) { return __builtin_bit_cast(float, (unsigned)v << 16); }
__device__ __forceinline__ f32x4 mma16(bf16x8 a, bf16x8 b, f32x4 c) { return __builtin_amdgcn_mfma_f32_16x16x32_bf16(a, b, c, 0, 0, 0); }
__device__ __forceinline__ f32x16 mma32(bf16x8 a, bf16x8 b, f32x16 c) { return __builtin_amdgcn_mfma_f32_32x32x16_bf16(a, b, c, 0, 0, 0); }
__device__ __forceinline__ float wave_sum(float v) {
#pragma unroll
    for (int o = 1; o < 64; o <<= 1) v += __shfl_xor(v, o);
    return v;
}
__device__ __forceinline__ u32x2 pk4(f32x4 v) { u32x2 w; w.x = pk2(v[0], v[1]); w.y = pk2(v[2], v[3]); return w; }
__device__ __forceinline__ int mod_of_row(int r) { return r < M_CTX ? 0 : 1 + ((r - M_CTX) >> 12); }

struct Ctx {
    Params p; LAS unsigned char* lds; int tid, lane, wave, bid, G;
    unsigned char* ws;
    __device__ __forceinline__ const float* mod(int l, int mi, int chunk) const { return (const float*)(ws + WS_MOD) + ((size_t)(l * 5 + mi) * 6 + chunk) * 1024; }
    __device__ __forceinline__ unsigned char* wl(int l) const { return ws + WS_W + (size_t)l * WL_SIZE; }
    __device__ __forceinline__ void refresh() { int t = threadIdx.x; asm volatile("" : "+v"(t)); tid = t; lane = t & 63; wave = __builtin_amdgcn_readfirstlane(t >> 6);
        size_t z = 0; asm volatile("" : "+s"(z)); ws = p.ws + z;
        int b = blockIdx.x; asm volatile("" : "+s"(b)); bid = b; }
};

constexpr int TPS = 258;
struct TItem { const float* W; bf16_t* WT; int ldw, K, k0, n0, nvalid, gu; };
__device__ __forceinline__ void titem_load(const TItem& t, int wave, int lane, f32x4 (&v)[8]) {
    const int n = t.n0 + 4 * lane;
#pragma unroll
    for (int i = 0; i < 8; ++i) v[i] = n < t.nvalid ? *(const f32x4*)(t.W + (size_t)(t.k0 + 8 * wave + i) * t.ldw + n) : (f32x4){0.f, 0.f, 0.f, 0.f};
}
__device__ __forceinline__ void titem_stage(LAS unsigned char* lds, int wave, int lane, const f32x4 (&v)[8]) {
    LAS bf16_t* T = (LAS bf16_t*)lds;
#pragma unroll
    for (int i = 0; i < 8; ++i) { LAS unsigned* d = (LAS unsigned*)(T + (8 * wave + i) * TPS + 4 * lane); d[0] = pk2(v[i][0], v[i][1]); d[1] = pk2(v[i][2], v[i][3]); }
}
__device__ __forceinline__ void titem_store(const TItem& t, const LAS unsigned char* lds, int tid) {
    const LAS bf16_t* T = (const LAS bf16_t*)lds;
#pragma unroll
    for (int it = 0; it < 4; ++it) { const int q = tid + NTHREADS * it, n = q >> 3, c = q & 7;
        unsigned short e[8];
#pragma unroll
        for (int j = 0; j < 8; ++j) e[j] = T[(8 * c + j) * TPS + n];
        const int sn = t.n0 + n;
        if (sn < t.nvalid) { int dr = sn; if (t.gu) { const int isup = sn >= FF, jj = isup ? sn - FF : sn; dr = (jj >> 7) * 256 + isup * 128 + (jj & 127); }
            u32x4 o; o.x = e[0] | ((unsigned)e[1] << 16); o.y = e[2] | ((unsigned)e[3] << 16); o.z = e[4] | ((unsigned)e[5] << 16); o.w = e[6] | ((unsigned)e[7] << 16);
            *(u32x4*)(t.WT + (size_t)dr * t.K + t.k0 + 8 * c) = o; } }
}
constexpr int TI_IN = 16 * 8, TI_OUT = 16 * 4, TI_GU = 16 * 22, TI_DN = 44 * 4, TI_UQ = 3 * 2, TI_UKV = 2 * 2, TI_L = TI_IN + TI_OUT + TI_GU + TI_DN + TI_UQ + TI_UKV;
__device__ __forceinline__ TItem titem_make(const Ctx& C, int it) {
    const Params& p = C.p; const int l = it / TI_L; int r = it % TI_L; unsigned char* wl = C.wl(l); TItem t; t.gu = 0;
    if (r < TI_IN) { t.W = p.in[I_WIN] + (size_t)l * D * NP; t.WT = (bf16_t*)(wl + WL_IN); t.ldw = NP; t.K = D; t.k0 = (r >> 3) * 64; t.n0 = (r & 7) * 256; t.nvalid = NP; return t; } r -= TI_IN;
    if (r < TI_OUT) { t.W = p.in[I_WOUT] + (size_t)l * D * D; t.WT = (bf16_t*)(wl + WL_OUT); t.ldw = D; t.K = D; t.k0 = (r >> 2) * 64; t.n0 = (r & 3) * 256; t.nvalid = D; return t; } r -= TI_OUT;
    if (r < TI_GU) { t.W = p.in[I_WGU] + (size_t)l * D * 2 * FF; t.WT = (bf16_t*)(wl + WL_GU); t.ldw = 2 * FF; t.K = D; t.k0 = (r / 22) * 64; t.n0 = (r % 22) * 256; t.nvalid = 2 * FF; t.gu = 1; return t; } r -= TI_GU;
    if (r < TI_DN) { t.W = p.in[I_WDN] + (size_t)l * FF * D; t.WT = (bf16_t*)(wl + WL_DN); t.ldw = D; t.K = FF; t.k0 = (r >> 2) * 64; t.n0 = (r & 3) * 256; t.nvalid = D; return t; } r -= TI_DN;
    if (r < TI_UQ) { t.W = p.in[I_WUQ] + (size_t)l * 192 * 384; t.WT = (bf16_t*)(wl + WL_UQ); t.ldw = 384; t.K = 192; t.k0 = (r >> 1) * 64; t.n0 = (r & 1) * 256; t.nvalid = 384; return t; } r -= TI_UQ;
    t.W = p.in[I_WUKV] + (size_t)l * 128 * 512; t.WT = (bf16_t*)(wl + WL_UKV); t.ldw = 512; t.K = 128; t.k0 = (r >> 1) * 64; t.n0 = (r & 1) * 256; t.nvalid = 512; return t;
}

__device__ __forceinline__ void transpose_items(const Ctx& C, int it0, int stride, int end) {
    int it = it0; f32x4 v[8];
    TItem cur; if (it < end) { cur = titem_make(C, it); titem_load(cur, C.wave, C.lane, v); }
    while (it < end) {
        titem_stage(C.lds, C.wave, C.lane, v);
        const int nx = it + stride; TItem nxt = cur; if (nx < end) { nxt = titem_make(C, nx); titem_load(nxt, C.wave, C.lane, v); }
        __syncthreads();
        titem_store(cur, C.lds, C.tid);
        __syncthreads();
        cur = nxt; it = nx;
    }
}

__device__ __forceinline__ void phase_prologue(const Ctx& C) {
    const Params& p = C.p;
    transpose_items(C, C.bid, C.G, (C.G == 256) ? TI_L : 4 * TI_L);
    {
        LAS float* sc = (LAS float*)C.lds;
        LAS float* red = (LAS float*)(C.lds + 5 * 1024 * 4);
        const int ub = C.G - 1 - C.bid;
        if (ub < 96) {
            size_t za = 0, zb = 0; asm volatile("" : "+s"(za), "+s"(zb));
            const float* cctx = p.in[I_CCTX] + za; const float* cc_ = p.in[I_C] + zb;
            for (int i = C.tid; i < 5120; i += NTHREADS) { const int j = i >> 10, k = i & 1023; const float v = (j == 0) ? cctx[k] : cc_[(j - 1) * 1024 + k]; sc[i] = v / (1.f + __expf(-v)); }
            __syncthreads();
            for (int u = ub; u < 96; u += C.G) {
                const int l = u / 24, cb = u % 24;
                const float* w = p.in[I_WADA] + ((size_t)l * 1024 + C.wave * 128) * 6144 + cb * 256 + 4 * C.lane;
                f32x4 a0 = {0.f, 0.f, 0.f, 0.f}, a1 = a0, a2 = a0, a3 = a0, a4 = a0;
#pragma unroll 16
                for (int k = 0; k < 128; ++k) { const f32x4 wv = *(const f32x4*)(w + (size_t)k * 6144); const int kk = C.wave * 128 + k;
                    a0 += wv * sc[kk]; a1 += wv * sc[1024 + kk]; a2 += wv * sc[2048 + kk]; a3 += wv * sc[3072 + kk]; a4 += wv * sc[4096 + kk]; }
                LAS f32x4* rw = (LAS f32x4*)(red + C.wave * 1280) + C.lane;
                rw[0] = a0; rw[64] = a1; rw[128] = a2; rw[192] = a3; rw[256] = a4;
                __syncthreads();
                for (int i = C.tid; i < 1280; i += NTHREADS) { const int j = i >> 8, c2 = i & 255; float sum = p.in[I_BADA][l * 6144 + cb * 256 + c2];
#pragma unroll
                    for (int ww = 0; ww < 8; ++ww) sum += red[ww * 1280 + i];
                    ((float*)(C.ws + WS_MOD))[(size_t)(l * 5 + j) * 6144 + cb * 256 + c2] = sum; }
                __syncthreads();
            }
        }
        __syncthreads();
    }
    {
        const int gt = C.bid * NTHREADS + C.tid, GT = C.G * NTHREADS;
        for (int i = gt; i < 4 * 65536; i += GT) { const int l = i >> 16, e = i & 65535; ((bf16_t*)(C.wl(l) + WL_SP))[e] = (bf16_t)f2bf(p.in[I_SPW][i]); }
        for (int i = gt; i < 4 * 160 * 1024 / 2; i += GT) { const int l = i / (160 * 512), e = i % (160 * 512); ((unsigned*)(C.wl(l) + WL_IN + (size_t)NP * D * 2))[e] = 0u; }
        for (int i = gt; i < 128 * 64; i += GT) { const int m = i >> 6, c = i & 63; const int idx = ((m & 63) * c) & 63; const float a = (float)idx / 32.f;
            ((bf16_t*)(C.ws + WS_F64))[i] = (bf16_t)f2bf(m < 64 ? cospif(a) : sinpif(a)); }
        for (int i = gt; i < 64 * 128; i += GT) { const int k = i >> 7, K = i & 127; const int idx = (k * (K & 63)) & 63; const float a = (float)idx / 32.f; const float cv = cospif(a), sv = sinpif(a);
            ((bf16_t*)(C.ws + WS_T64R))[i] = (bf16_t)f2bf(K < 64 ? cv : -sv);
            ((bf16_t*)(C.ws + WS_T64I))[i] = (bf16_t)f2bf(K < 64 ? -sv : -cv);
            ((bf16_t*)(C.ws + WS_T64B))[i] = (bf16_t)f2bf(K < 64 ? cv : sv); }
        for (int i = gt; i < 256 * 512; i += GT) { const int k = i >> 9, K = i & 511; const int idx = (k * (K & 255)) & 255; const float a = (float)idx / 128.f;
            ((bf16_t*)(C.ws + WS_T256))[i] = (bf16_t)f2bf(K < 256 ? cospif(a) : -sinpif(a)); }
        for (int i = gt; i < 4096; i += GT) { const float a = (float)i / 2048.f; ((f32x2*)(C.ws + WS_TW))[i] = (f32x2){cospif(a), sinpif(a)}; }
        for (int i = gt; i < 512; i += GT) { const int pos = i >> 3, f = i & 7; const float inv = powf(10000.f, -(float)f / 8.f); const float ang = (float)pos * inv;
            ((f32x2*)(C.ws + WS_ROPE))[i] = (f32x2){cosf(ang), sinf(ang)}; }
    }
}

__device__ __forceinline__ void load_row_f32(const float* rowp, int lane, f32x4 (&v)[4]) {
#pragma unroll
    for (int j = 0; j < 4; ++j) v[j] = *(const f32x4*)(rowp + 4 * lane + 256 * j);
}
__device__ __forceinline__ void load_row_bf16(const bf16_t* rowp, int lane, f32x4 (&v)[4]) {
#pragma unroll
    for (int j = 0; j < 4; ++j) { const u32x2 w = *(const u32x2*)(rowp + 4 * lane + 256 * j); v[j] = (f32x4){bflo(w.x), bfhi(w.x), bflo(w.y), bfhi(w.y)}; }
}
__device__ __forceinline__ float row_rstd(const f32x4 (&v)[4]) {
    float s = 0.f;
#pragma unroll
    for (int j = 0; j < 4; ++j) s += (v[j][0] * v[j][0] + v[j][1] * v[j][1]) + (v[j][2] * v[j][2] + v[j][3] * v[j][3]);
    return 1.f / sqrtf(wave_sum(s) * (1.f / 1024.f) + EPS);
}
__device__ __forceinline__ void norm_mod_store(const f32x4 (&x)[4], const float* g, const float* scale, const float* shift, bf16_t* orow, int lane) {
    const float rs = row_rstd(x);
#pragma unroll
    for (int j = 0; j < 4; ++j) { const int c = 4 * lane + 256 * j; const f32x4 gv = *(const f32x4*)(g + c), sv = *(const f32x4*)(scale + c), hv = *(const f32x4*)(shift + c);
        const f32x4 h = x[j] * rs * gv * (1.f + sv) + hv; *(u32x2*)(orow + c) = pk4(h); }
}
__device__ __forceinline__ void norm_mod_store_g(const f32x4 (&x)[4], const f32x4 (&gv)[4], const float* scale, const float* shift, bf16_t* orow, int lane) {
    const float rs = row_rstd(x);
#pragma unroll
    for (int j = 0; j < 4; ++j) { const int c = 4 * lane + 256 * j; const f32x4 sv = *(const f32x4*)(scale + c), hv = *(const f32x4*)(shift + c);
        const f32x4 h = x[j] * rs * gv[j] * (1.f + sv) + hv; *(u32x2*)(orow + c) = pk4(h); }
}
__device__ __forceinline__ const float* xin_row(const Ctx& C, int layer, int r) {
    if (layer > 0) return C.p.out + OUT_X + (size_t)r * D;
    size_t za = 0, zb = 0; asm volatile("" : "+s"(za), "+s"(zb));
    const float* a = C.p.in[I_XP] + za; const float* b = C.p.in[I_XS] + zb;
    return r < M_CTX ? a + (size_t)r * D : b + (size_t)(r - M_CTX) * D;
}
constexpr int SPLIT_ROW0 = 16384;
__device__ __forceinline__ void load_T(const bf16_t* T, const bf16_t* T1, bool split, int r, int lane, f32x4 (&v)[4]) {
    load_row_bf16(T + (size_t)r * D, lane, v);
    if (split && r >= SPLIT_ROW0) { f32x4 w[4]; load_row_bf16(T1 + (size_t)r * D, lane, w);
#pragma unroll
        for (int j = 0; j < 4; ++j) v[j] = v[j] + w[j]; }
}
__device__ __forceinline__ void phase_norm0(const Ctx& C) {
    const int gw = C.bid * NWAVES + C.wave, NGW = C.G * NWAVES;
    bf16_t* H = (bf16_t*)(C.ws + WS_R1);
    f32x4 xn[4]; load_row_f32(xin_row(C, 0, gw), C.lane, xn);
    for (int r = gw; r < M; r += NGW) { f32x4 x[4];
#pragma unroll
        for (int j = 0; j < 4; ++j) x[j] = xn[j];
        if (r + NGW < M) load_row_f32(xin_row(C, 0, r + NGW), C.lane, xn);
        const int mi = mod_of_row(r);
        norm_mod_store(x, C.p.in[I_GPM], C.mod(0, mi, 1), C.mod(0, mi, 0), H + (size_t)r * D, C.lane); }
}
template <int which  > __device__ __forceinline__ void phase_post(const Ctx& C, int layer) {
    const int gw = C.bid * NWAVES + C.wave, NGW = C.G * NWAVES;
    const bf16_t* T = (const bf16_t*)(C.ws + (which == 0 ? WS_R2 : WS_MLA));
    const bf16_t* T1 = T + (size_t)M * D - (size_t)SPLIT_ROW0 * D;
    const bool split = (C.G == 256);
    bf16_t* H = (bf16_t*)(C.ws + WS_R1);
    const float* gpost = (which == 0 ? C.p.in[I_GPOM] : C.p.in[I_GPOF]) + layer * D;
    const bool do_next = (which == 0) || (layer + 1 < DEPTH);
    const int nl = which == 0 ? layer : layer + 1;
    const float* gnext = (which == 0 ? C.p.in[I_GPF] : C.p.in[I_GPM]) + (nl < DEPTH ? nl : 0) * D;
    f32x4 gg[4], gs[4], sh[4]; int cur_mi = -1;
#pragma unroll
    for (int j = 0; j < 4; ++j) { gg[j] = (f32x4){0.f, 0.f, 0.f, 0.f}; gs[j] = gg[j]; sh[j] = gg[j]; }
    f32x4 tn[4], xn[4];
    load_T(T, T1, split, gw, C.lane, tn); load_row_f32(which == 0 ? xin_row(C, layer, gw) : C.p.out + OUT_X + (size_t)gw * D, C.lane, xn);
    for (int r = gw; r < M; r += NGW) {
        const int mi = mod_of_row(r);
        if (mi != cur_mi) { cur_mi = mi;
            const float* gate = C.mod(layer, mi, which == 0 ? 2 : 5); const float* scale = C.mod(nl, mi, which == 0 ? 4 : 1); const float* shift = C.mod(nl, mi, which == 0 ? 3 : 0);
#pragma unroll
            for (int j = 0; j < 4; ++j) { const int c = 4 * C.lane + 256 * j; gg[j] = *(const f32x4*)(gate + c) * *(const f32x4*)(gpost + c);
                if (do_next) { gs[j] = *(const f32x4*)(gnext + c) * (1.f + *(const f32x4*)(scale + c)); sh[j] = *(const f32x4*)(shift + c); } } }
        f32x4 t[4], x[4];
#pragma unroll
        for (int j = 0; j < 4; ++j) { t[j] = tn[j]; x[j] = xn[j]; }
        if (r + NGW < M) { const int rn = r + NGW; load_T(T, T1, split, rn, C.lane, tn); load_row_f32(which == 0 ? xin_row(C, layer, rn) : C.p.out + OUT_X + (size_t)rn * D, C.lane, xn); }
        const float rs = row_rstd(t);
        float* xo = C.p.out + OUT_X + (size_t)r * D;
#pragma unroll
        for (int j = 0; j < 4; ++j) { const int c = 4 * C.lane + 256 * j; x[j] = x[j] + gg[j] * (t[j] * rs); *(f32x4*)(xo + c) = x[j]; }
        if (do_next) { const float rs2 = row_rstd(x); bf16_t* orow = H + (size_t)r * D;
#pragma unroll
            for (int j = 0; j < 4; ++j) { const int c = 4 * C.lane + 256 * j; const f32x4 h = x[j] * rs2 * gs[j] + sh[j]; *(u32x2*)(orow + c) = pk4(h); } }
    }
}

__device__ __forceinline__ void unit_chunk_mlp(const Ctx& C, int layer, int u) {
    const int chunk = u >> 2, g = u & 3, r0 = chunk * 128;
    const bf16_t* PROJ = (const bf16_t*)(C.ws + WS_R2); bf16_t* MIX = (bf16_t*)(C.ws + WS_R1);
    constexpr int VS = 136;
    LAS bf16_t* Vt = (LAS bf16_t*)C.lds;
    { const int q = C.tid >> 2, c0 = (C.tid & 3) * 16; const bf16_t* src = PROJ + (size_t)(r0 + q) * NP + PC_V + g * 64 + c0;
      const bf16x8 v0 = *(const bf16x8*)src, v1 = *(const bf16x8*)(src + 8);
#pragma unroll
      for (int j = 0; j < 8; ++j) { Vt[(c0 + j) * VS + q] = (bf16_t)v0[j]; Vt[(c0 + 8 + j) * VS + q] = (bf16_t)v1[j]; } }
    __syncthreads();
    const int l15 = C.lane & 15, hq = C.lane >> 4, w = C.wave;
    const bf16_t* Wg = (const bf16_t*)(C.wl(layer) + WL_SP) + (size_t)g * 128 * 128;
    bf16x8 bw[4];
#pragma unroll
    for (int ks = 0; ks < 4; ++ks) bw[ks] = *(const bf16x8*)(Wg + (size_t)(w * 16 + l15) * 128 + ks * 32 + 8 * hq);
    const int p = w * 16 + l15; const float bias = C.p.in[I_SPB][(layer * 4 + g) * 128 + p];
#pragma unroll
    for (int ct = 0; ct < 4; ++ct) {
        f32x4 acc = {0.f, 0.f, 0.f, 0.f};
#pragma unroll
        for (int ks = 0; ks < 4; ++ks) { const bf16x8 a = *(const LAS bf16x8*)(Vt + (ct * 16 + l15) * VS + ks * 32 + 8 * hq); acc = mma16(a, bw[ks], acc); }
        const int cc = g * 64 + ct * 16 + 4 * hq; const u32x2 uw = *(const u32x2*)(PROJ + (size_t)(r0 + p) * NP + PC_U + cc);
        f32x4 o; o[0] = bflo(uw.x) * (acc[0] + bias); o[1] = bfhi(uw.x) * (acc[1] + bias); o[2] = bflo(uw.y) * (acc[2] + bias); o[3] = bfhi(uw.y) * (acc[3] + bias);
        *(u32x2*)(MIX + (size_t)(r0 + p) * D + cc) = pk4(o);
    }
    __syncthreads();
}
__device__ __forceinline__ void unit_conv(const Ctx& C, int layer, int u) {
    const bf16_t* PROJ = (const bf16_t*)(C.ws + WS_R2); bf16_t* MIX = (bf16_t*)(C.ws + WS_R1);
    const float* cw = C.p.in[I_CVW] + layer * 3 * 256; const float* cb = C.p.in[I_CVB] + layer * 256;
    for (int it = 0; it < 8; ++it) {
        const int item = it * NTHREADS + C.tid, t = item >> 5, ch = (item & 31) * 8, r = u * 128 + t;
        const int pos = r < M_CTX ? (r & 255) : ((r - M_CTX) & 4095), len = r < M_CTX ? 256 : 4096;
        const bf16_t* base = PROJ + (size_t)r * NP;
        const bf16x8 h1 = *(const bf16x8*)(base + PC_H + ch), c1 = *(const bf16x8*)(base + PC_C + ch), gb = *(const bf16x8*)(base + PC_B + ch);
        bf16x8 h0 = h1, c0 = c1, h2 = h1, c2 = c1; const bool hasp = pos > 0, hasn = pos < len - 1;
        if (hasp) { h0 = *(const bf16x8*)(base - NP + PC_H + ch); c0 = *(const bf16x8*)(base - NP + PC_C + ch); }
        if (hasn) { h2 = *(const bf16x8*)(base + NP + PC_H + ch); c2 = *(const bf16x8*)(base + NP + PC_C + ch); }
        float o[8];
#pragma unroll
        for (int j = 0; j < 8; ++j) {
            const float z0 = hasp ? bf1((bf16_t)h0[j]) * bf1((bf16_t)c0[j]) : 0.f, z1 = bf1((bf16_t)h1[j]) * bf1((bf16_t)c1[j]), z2 = hasn ? bf1((bf16_t)h2[j]) * bf1((bf16_t)c2[j]) : 0.f;
            const float y = z0 * cw[ch + j] + z1 * cw[256 + ch + j] + z2 * cw[512 + ch + j] + cb[ch + j];
            o[j] = bf1((bf16_t)gb[j]) * y; }
        u32x4 w; w.x = pk2(o[0], o[1]); w.y = pk2(o[2], o[3]); w.z = pk2(o[4], o[5]); w.w = pk2(o[6], o[7]);
        *(u32x4*)(MIX + (size_t)r * D + 256 + ch) = w;
    }
}
__device__ __forceinline__ void unit_fourier_ctx(const Ctx& C, int u) {
    const int s = u >> 2, g = u & 3, l15 = C.lane & 15, hq = C.lane >> 4, w = C.wave;
    const bf16_t* PROJ = (const bf16_t*)(C.ws + WS_R2); bf16_t* MIX = (bf16_t*)(C.ws + WS_R1);
    const bf16_t* F64 = (const bf16_t*)(C.ws + WS_F64); const bf16_t* T256 = (const bf16_t*)(C.ws + WS_T256);
    constexpr int ZS = 520; LAS bf16_t* Zt = (LAS bf16_t*)C.lds;
#pragma unroll
    for (int i = 0; i < 2; ++i) { const int nt = 2 * w + i;
        bf16x8 a[2];
#pragma unroll
        for (int ks = 0; ks < 2; ++ks) a[ks] = *(const bf16x8*)(PROJ + (size_t)(s * 256 + nt * 16 + l15) * NP + PC_F + g * 64 + ks * 32 + 8 * hq);
#pragma unroll
        for (int mt = 0; mt < 8; ++mt) { f32x4 acc = {0.f, 0.f, 0.f, 0.f};
#pragma unroll
            for (int ks = 0; ks < 2; ++ks) { const bf16x8 b = *(const bf16x8*)(F64 + (size_t)(mt * 16 + l15) * 64 + ks * 32 + 8 * hq); acc = mma16(a[ks], b, acc); }
            const int mp = mt * 16 + l15;
            *(LAS u32x2*)(Zt + (mp & 63) * ZS + (mp >> 6) * 256 + nt * 16 + 4 * hq) = pk4(acc); } }
    __syncthreads();
#pragma unroll 1
    for (int i = 0; i < 2; ++i) { const int kt = 2 * w + i;
        f32x4 acc[4];
#pragma unroll
        for (int mt = 0; mt < 4; ++mt) acc[mt] = (f32x4){0.f, 0.f, 0.f, 0.f};
#pragma unroll 8
        for (int ks = 0; ks < 16; ++ks) { const bf16x8 b = *(const bf16x8*)(T256 + (size_t)(kt * 16 + l15) * 512 + ks * 32 + 8 * hq);
#pragma unroll
            for (int mt = 0; mt < 4; ++mt) { const bf16x8 a = *(const LAS bf16x8*)(Zt + (mt * 16 + l15) * ZS + ks * 32 + 8 * hq); acc[mt] = mma16(a, b, acc[mt]); } }
#pragma unroll
        for (int mt = 0; mt < 4; ++mt) *(u32x2*)(MIX + (size_t)(s * 256 + kt * 16 + l15) * D + 512 + g * 64 + mt * 16 + 4 * hq) = pk4(acc[mt] * (1.f / 128.f)); }
    __syncthreads();
}
__device__ __forceinline__ void unit_fourier_lat1(const Ctx& C, int u) {
    const int b = u >> 5, g = (u >> 3) & 3, nb = u & 7, l15 = C.lane & 15, hq = C.lane >> 4, n2 = nb * 8 + C.wave;
    const bf16_t* PROJ = (const bf16_t*)(C.ws + WS_R2);
    const bf16_t* F64 = (const bf16_t*)(C.ws + WS_F64); const bf16_t* T64R = (const bf16_t*)(C.ws + WS_T64R); const bf16_t* T64I = (const bf16_t*)(C.ws + WS_T64I);
    const f32x2* TW = (const f32x2*)(C.ws + WS_TW);
    bf16_t* GB = (bf16_t*)(C.ws + WS_GB) + (size_t)((b * 4 + g) * 64 + n2) * 64 * 128;
    constexpr int ZS = 136; LAS bf16_t* Zt = (LAS bf16_t*)(C.lds + C.wave * (64 * ZS * 2));
#pragma unroll 2
    for (int nt = 0; nt < 4; ++nt) {
        bf16x8 a[2];
#pragma unroll
        for (int ks = 0; ks < 2; ++ks) a[ks] = *(const bf16x8*)(PROJ + (size_t)(M_CTX + b * 4096 + (nt * 16 + l15) * 64 + n2) * NP + PC_F + g * 64 + ks * 32 + 8 * hq);
#pragma unroll
        for (int mt = 0; mt < 8; ++mt) { f32x4 acc = {0.f, 0.f, 0.f, 0.f};
#pragma unroll
            for (int ks = 0; ks < 2; ++ks) { const bf16x8 bb = *(const bf16x8*)(F64 + (size_t)(mt * 16 + l15) * 64 + ks * 32 + 8 * hq); acc = mma16(a[ks], bb, acc); }
            const int mp = mt * 16 + l15;
            *(LAS u32x2*)(Zt + (mp & 63) * ZS + (mp >> 6) * 64 + nt * 16 + 4 * hq) = pk4(acc); } }
    asm volatile("s_waitcnt lgkmcnt(0)" ::: "memory");
#pragma unroll 2
    for (int kt = 0; kt < 4; ++kt) {
        bf16x8 br[4], bi[4];
#pragma unroll
        for (int ks = 0; ks < 4; ++ks) { br[ks] = *(const bf16x8*)(T64R + (size_t)(kt * 16 + l15) * 128 + ks * 32 + 8 * hq); bi[ks] = *(const bf16x8*)(T64I + (size_t)(kt * 16 + l15) * 128 + ks * 32 + 8 * hq); }
        const int k1 = kt * 16 + l15; const f32x2 tw = TW[k1 * n2];
#pragma unroll
        for (int mt = 0; mt < 4; ++mt) { f32x4 ar = {0.f, 0.f, 0.f, 0.f}, ai = {0.f, 0.f, 0.f, 0.f};
#pragma unroll
            for (int ks = 0; ks < 4; ++ks) { const bf16x8 a = *(const LAS bf16x8*)(Zt + (mt * 16 + l15) * ZS + ks * 32 + 8 * hq); ar = mma16(a, br[ks], ar); ai = mma16(a, bi[ks], ai); }
            const f32x4 gr = ar * tw[0] + ai * tw[1], gi = ai * tw[0] - ar * tw[1];
            bf16_t* dst = GB + (size_t)k1 * 128 + mt * 16 + 4 * hq;
            *(u32x2*)dst = pk4(gr); *(u32x2*)(dst + 64) = pk4(gi); } }
    __syncthreads();
}
__device__ __forceinline__ void unit_fourier_lat2(const Ctx& C, int u) {
    const int b = u >> 5, g = (u >> 3) & 3, kb = u & 7, l15 = C.lane & 15, hq = C.lane >> 4, k1 = kb * 8 + C.wave;
    const bf16_t* T64B = (const bf16_t*)(C.ws + WS_T64B); bf16_t* MIX = (bf16_t*)(C.ws + WS_R1);
    const bf16_t* GB = (const bf16_t*)(C.ws + WS_GB) + (size_t)((b * 4 + g) * 64) * 64 * 128 + (size_t)k1 * 128;
    constexpr int ZS = 136; LAS bf16_t* Tt = (LAS bf16_t*)(C.lds + C.wave * (64 * ZS * 2));
#pragma unroll 4
    for (int it = 0; it < 16; ++it) { const int q = it * 64 + C.lane, n2 = q >> 4, cc = q & 15, part = cc >> 3, m0 = (cc & 7) * 8;
        const bf16x8 v = *(const bf16x8*)(GB + (size_t)n2 * 64 * 128 + cc * 8);
#pragma unroll
        for (int j = 0; j < 8; ++j) Tt[(m0 + j) * ZS + part * 64 + n2] = (bf16_t)v[j]; }
    asm volatile("s_waitcnt lgkmcnt(0)" ::: "memory");
#pragma unroll 2
    for (int kt = 0; kt < 4; ++kt) {
        bf16x8 bb[4];
#pragma unroll
        for (int ks = 0; ks < 4; ++ks) bb[ks] = *(const bf16x8*)(T64B + (size_t)(kt * 16 + l15) * 128 + ks * 32 + 8 * hq);
        const int k2 = kt * 16 + l15; const int row = M_CTX + b * 4096 + k1 + 64 * k2;
#pragma unroll
        for (int mt = 0; mt < 4; ++mt) { f32x4 acc = {0.f, 0.f, 0.f, 0.f};
#pragma unroll
            for (int ks = 0; ks < 4; ++ks) { const bf16x8 a = *(const LAS bf16x8*)(Tt + (mt * 16 + l15) * ZS + ks * 32 + 8 * hq); acc = mma16(a, bb[ks], acc); }
            *(u32x2*)(MIX + (size_t)row * D + 512 + g * 64 + mt * 16 + 4 * hq) = pk4(acc * (1.f / 512.f)); } }
    __syncthreads();
}
constexpr float QSCALE = 0.10206207261596577f * 1.4426950408889634f;
__device__ __forceinline__ void unit_mla_prep(const Ctx& C, int layer, int u) {
    const Params& p = C.p;
    const bf16_t* PROJ = (const bf16_t*)(C.ws + WS_R2);
    bf16_t* Q = (bf16_t*)(C.ws + WS_Q); bf16_t* KN = (bf16_t*)(C.ws + WS_KN); bf16_t* VT = (bf16_t*)(C.ws + WS_VT); bf16_t* KR = (bf16_t*)(C.ws + WS_KR);
    const f32x2* ROPE = (const f32x2*)(C.ws + WS_ROPE);
    constexpr int QS = 200, KS = 136;
    LAS bf16_t* CQ = (LAS bf16_t*)C.lds;
    LAS bf16_t* CK = (LAS bf16_t*)(C.lds + 128 * QS * 2);
    const bool is_tok = u < 192;
    int r0 = 0, keyrow0, keypos0, nk; size_t vtbase; bool lat;
    if (is_tok) { r0 = u * 128; lat = r0 >= M_CTX;
        if (!lat) { keyrow0 = r0; keypos0 = r0 & 255; nk = 256; vtbase = (size_t)(r0 & ~255) * 256; }
        else { const int b = (r0 - M_CTX) >> 12, n = (r0 - M_CTX) & 4095; keyrow0 = M_CTX + b * 4352 + n; keypos0 = n; nk = 4352; vtbase = (size_t)(M_CTX + b * 4352) * 256; } }
    else { const int cu = u - 192, b = cu >> 1, half = cu & 1; lat = true; keyrow0 = M_CTX + b * 4352 + 4096 + half * 128; keypos0 = 4096 + half * 128; nk = 4352; vtbase = (size_t)(M_CTX + b * 4352) * 256; }
    { const int t = C.tid >> 2, sub = C.tid & 3;
      if (is_tok) {
        const int r = r0 + t; const bf16_t* base = PROJ + (size_t)r * NP;
        float q[48], k[32]; float sq = 0.f, sk = 0.f;
#pragma unroll
        for (int i = 0; i < 6; ++i) { const bf16x8 v = *(const bf16x8*)(base + PC_Q + sub * 48 + i * 8);
#pragma unroll
            for (int j = 0; j < 8; ++j) { q[i * 8 + j] = bf1((bf16_t)v[j]); sq += q[i * 8 + j] * q[i * 8 + j]; } }
#pragma unroll
        for (int i = 0; i < 4; ++i) { const bf16x8 v = *(const bf16x8*)(base + PC_KV + sub * 32 + i * 8);
#pragma unroll
            for (int j = 0; j < 8; ++j) { k[i * 8 + j] = bf1((bf16_t)v[j]); sk += k[i * 8 + j] * k[i * 8 + j]; } }
        sq += __shfl_xor(sq, 1); sq += __shfl_xor(sq, 2); sk += __shfl_xor(sk, 1); sk += __shfl_xor(sk, 2);
        const float rq = 1.f / sqrtf(sq * (1.f / 192.f) + EPS), rk = 1.f / sqrtf(sk * (1.f / 128.f) + EPS);
        const float* gq = p.in[I_GQ] + layer * 192 + sub * 48; const float* gk = p.in[I_GKV] + layer * 128 + sub * 32;
#pragma unroll
        for (int i = 0; i < 6; ++i) { u32x4 w; w.x = pk2(q[i * 8 + 0] * rq * gq[i * 8 + 0], q[i * 8 + 1] * rq * gq[i * 8 + 1]); w.y = pk2(q[i * 8 + 2] * rq * gq[i * 8 + 2], q[i * 8 + 3] * rq * gq[i * 8 + 3]);
            w.z = pk2(q[i * 8 + 4] * rq * gq[i * 8 + 4], q[i * 8 + 5] * rq * gq[i * 8 + 5]); w.w = pk2(q[i * 8 + 6] * rq * gq[i * 8 + 6], q[i * 8 + 7] * rq * gq[i * 8 + 7]);
            *(LAS u32x4*)(CQ + t * QS + sub * 48 + i * 8) = w; }
        float* sckv = nullptr;
        if (!lat) { const int s = r >> 8, pos = r & 255; sckv = p.out + OUT_CKV + ((size_t)(s * 4 + layer) * 256 + pos) * 128 + sub * 32; }
#pragma unroll
        for (int i = 0; i < 4; ++i) { float o[8];
#pragma unroll
            for (int j = 0; j < 8; ++j) o[j] = k[i * 8 + j] * rk * gk[i * 8 + j];
            u32x4 w; w.x = pk2(o[0], o[1]); w.y = pk2(o[2], o[3]); w.z = pk2(o[4], o[5]); w.w = pk2(o[6], o[7]);
            *(LAS u32x4*)(CK + t * KS + sub * 32 + i * 8) = w;
            if (!lat) { *(f32x4*)(sckv + i * 8) = (f32x4){o[0], o[1], o[2], o[3]}; *(f32x4*)(sckv + i * 8 + 4) = (f32x4){o[4], o[5], o[6], o[7]}; } }
        { const bf16x8 v = *(const bf16x8*)(base + PC_KR + sub * 8); float x[8], o[8];
#pragma unroll
          for (int j = 0; j < 8; ++j) x[j] = bf1((bf16_t)v[j]);
          if (lat) { const int n = (r - M_CTX) & 4095; const int pos = (sub >> 1) == 0 ? (n >> 6) : (n & 63);
#pragma unroll
              for (int j = 0; j < 8; ++j) { const float pr = __shfl_xor(x[j], 1); const f32x2 cs = ROPE[pos * 8 + j]; o[j] = (sub & 1) == 0 ? x[j] * cs[0] - pr * cs[1] : x[j] * cs[0] + pr * cs[1]; } }
          else {
#pragma unroll
              for (int j = 0; j < 8; ++j) o[j] = x[j];
              const int s = r >> 8, pos = r & 255; float* skr = p.out + OUT_KR + ((size_t)(s * 4 + layer) * 256 + pos) * 32 + sub * 8;
              *(f32x4*)skr = (f32x4){o[0], o[1], o[2], o[3]}; *(f32x4*)(skr + 4) = (f32x4){o[4], o[5], o[6], o[7]}; }
          u32x4 w; w.x = pk2(o[0], o[1]); w.y = pk2(o[2], o[3]); w.z = pk2(o[4], o[5]); w.w = pk2(o[6], o[7]);
          *(u32x4*)(KR + (size_t)(keyrow0 + t) * 32 + sub * 8) = w; }
      } else {
        const int cu = u - 192, b = cu >> 1, half = cu & 1, row = half * 128 + t;
        const float* src = p.in[I_CCKV] + ((size_t)(b * 4 + layer) * 256 + row) * 128 + sub * 32;
#pragma unroll
        for (int i = 0; i < 4; ++i) { const f32x4 v0 = *(const f32x4*)(src + i * 8), v1 = *(const f32x4*)(src + i * 8 + 4);
            u32x4 w; w.x = pk2(v0[0], v0[1]); w.y = pk2(v0[2], v0[3]); w.z = pk2(v1[0], v1[1]); w.w = pk2(v1[2], v1[3]);
            *(LAS u32x4*)(CK + t * KS + sub * 32 + i * 8) = w; }
        const float* ksrc = p.in[I_CKR] + ((size_t)(b * 4 + layer) * 256 + row) * 32 + sub * 8;
        const f32x4 v0 = *(const f32x4*)ksrc, v1 = *(const f32x4*)(ksrc + 4);
        u32x4 w; w.x = pk2(v0[0], v0[1]); w.y = pk2(v0[2], v0[3]); w.z = pk2(v1[0], v1[1]); w.w = pk2(v1[2], v1[3]);
        *(u32x4*)(KR + (size_t)(keyrow0 + t) * 32 + sub * 8) = w;
      } }
    __syncthreads();
    const int l15 = C.lane & 15, hq = C.lane >> 4, w = C.wave;
    if (is_tok) {
        const bf16_t* Wq = (const bf16_t*)(C.wl(layer) + WL_UQ);
        bf16x8 aq[3][6];
#pragma unroll
        for (int j = 0; j < 3; ++j)
#pragma unroll
            for (int ks = 0; ks < 6; ++ks) aq[j][ks] = *(const bf16x8*)(Wq + (size_t)((3 * w + j) * 16 + l15) * 192 + ks * 32 + 8 * hq);
#pragma unroll 2
        for (int tt = 0; tt < 8; ++tt) {
            bf16x8 bq[6];
#pragma unroll
            for (int ks = 0; ks < 6; ++ks) bq[ks] = *(const LAS bf16x8*)(CQ + (tt * 16 + l15) * QS + ks * 32 + 8 * hq);
            const int r = r0 + tt * 16 + l15; const int n = (r - M_CTX) & 4095;
#pragma unroll
            for (int j = 0; j < 3; ++j) { const int nt = 3 * w + j; f32x4 acc = {0.f, 0.f, 0.f, 0.f};
#pragma unroll
                for (int ks = 0; ks < 6; ++ks) acc = mma16(aq[j][ks], bq[ks], acc);
                const int sub6 = nt % 6;
                if (lat && sub6 >= 4) { const int pos = sub6 == 4 ? (n >> 6) : (n & 63);
#pragma unroll
                    for (int jj = 0; jj < 4; ++jj) { const float pr = __shfl_xor(acc[jj], 32); const f32x2 cs = ROPE[pos * 8 + ((4 * hq + jj) & 7)]; acc[jj] = hq < 2 ? acc[jj] * cs[0] - pr * cs[1] : acc[jj] * cs[0] + pr * cs[1]; } }
                *(u32x2*)(Q + (size_t)r * 384 + nt * 16 + 4 * hq) = pk4(acc * QSCALE); }
        }
    }
    { const bf16_t* Wkv = (const bf16_t*)(C.wl(layer) + WL_UKV);
      bf16x8 wf[4][4];
#pragma unroll
      for (int j = 0; j < 4; ++j)
#pragma unroll
          for (int ks = 0; ks < 4; ++ks) wf[j][ks] = *(const bf16x8*)(Wkv + (size_t)((4 * w + j) * 16 + l15) * 128 + ks * 32 + 8 * hq);
      const int h = w >> 1; const bool isv = (w & 1) != 0;
#pragma unroll 2
      for (int tt = 0; tt < 8; ++tt) {
          bf16x8 ck[4];
#pragma unroll
          for (int ks = 0; ks < 4; ++ks) ck[ks] = *(const LAS bf16x8*)(CK + (tt * 16 + l15) * KS + ks * 32 + 8 * hq);
#pragma unroll
          for (int j = 0; j < 4; ++j) { f32x4 acc = {0.f, 0.f, 0.f, 0.f};
              if (!isv) {
#pragma unroll
                  for (int ks = 0; ks < 4; ++ks) acc = mma16(wf[j][ks], ck[ks], acc);
                  *(u32x2*)(KN + (size_t)(keyrow0 + tt * 16 + l15) * 256 + h * 64 + j * 16 + 4 * hq) = pk4(acc);
              } else {
#pragma unroll
                  for (int ks = 0; ks < 4; ++ks) acc = mma16(ck[ks], wf[j][ks], acc);
                  *(u32x2*)(VT + vtbase + (size_t)(h * 64 + j * 16 + l15) * nk + keypos0 + tt * 16 + 4 * hq) = pk4(acc);
              } } } }
    __syncthreads();
}

constexpr int AKS = 104, AVS = 72;
constexpr int ABUF = 64 * AKS * 2 + 64 * AVS * 2;
__device__ __forceinline__ int imax3(int a, int b, int c) { return max(a, max(b, c)); }
constexpr int AVS2 = 136; constexpr int ABUF2 = 128 * AKS * 2 + 64 * AVS2 * 2;
__device__ __forceinline__ void unit_attention(const Ctx& C, int u) {
    int rowbase, keyrow0, nk, h; size_t vtbase;
    if (u < 128) { const int s = u >> 2; h = u & 3; rowbase = s * 256; keyrow0 = s * 256; nk = 256; vtbase = (size_t)(s * 256) * 256; }
    else { const int v0 = u - 128; const int v = (C.G == 256) ? (((v0 & 7) * 2 + (v0 >> 7)) << 4) | ((v0 >> 3) & 15) : v0;
           const int b = v >> 6, qb = v & 15; h = (v >> 4) & 3; rowbase = M_CTX + b * 4096 + qb * 256; keyrow0 = M_CTX + b * 4352; nk = 4352; vtbase = (size_t)keyrow0 * 256; }
    const bf16_t* Q = (const bf16_t*)(C.ws + WS_Q); const bf16_t* KN = (const bf16_t*)(C.ws + WS_KN); const bf16_t* VT = (const bf16_t*)(C.ws + WS_VT); const bf16_t* KR = (const bf16_t*)(C.ws + WS_KR);
    bf16_t* MIX = (bf16_t*)(C.ws + WS_R1);
    const int l31 = C.lane & 31, hh = C.lane >> 5; const int qrow = rowbase + C.wave * 32 + l31;
    bf16x8 qf[6];
#pragma unroll
    for (int ks = 0; ks < 6; ++ks) qf[ks] = *(const bf16x8*)(Q + (size_t)qrow * 384 + h * 96 + ks * 16 + 8 * hh);
    f32x16 o0, o1, o2, negm;
#pragma unroll
    for (int i = 0; i < 16; ++i) { o0[i] = 0.f; o1[i] = 0.f; o2[i] = 0.f; negm[i] = 0.f; }
    const unsigned onew = (l31 == 0) ? 0x3F803F80u : 0u;
    const bf16x8 onesf = __builtin_bit_cast(bf16x8, (u32x4){onew, onew, onew, onew});
    const int skey = C.tid >> 3, sc8 = (C.tid & 7) * 8, rkey = (C.tid & 255) >> 2, rc8 = (C.tid & 3) * 8;
    const bf16_t* gkn = KN + (size_t)(keyrow0 + skey) * 256 + h * 64 + sc8;
    const bf16_t* gkr = KR + (size_t)(keyrow0 + rkey) * 32 + rc8;
    const bf16_t* gvt = VT + vtbase + (size_t)(h * 64 + skey) * nk + sc8;
    const bool do_r = C.tid < 256;
    const int lkn = (skey * AKS + sc8) * 2, lkr = (rkey * AKS + 64 + rc8) * 2, lvt = 128 * AKS * 2 + (skey * AVS2 + sc8) * 2;
    const int ntile = nk >> 7;
    u32x4 rk[2], rr[2] = {{0u, 0u, 0u, 0u}, {0u, 0u, 0u, 0u}}, rv[2];
#define ATT_LD(t) do { _Pragma("unroll") for (int s_ = 0; s_ < 2; ++s_) { rk[s_] = *(const u32x4*)(gkn + (size_t)(2 * (t) + s_) * 64 * 256); if (do_r) rr[s_] = *(const u32x4*)(gkr + (size_t)(2 * (t) + s_) * 64 * 32); rv[s_] = *(const u32x4*)(gvt + (2 * (t) + s_) * 64); } } while (0)
#define ATT_ST(buf) do { LAS unsigned char* b_ = C.lds + (buf) * ABUF2; _Pragma("unroll") for (int s_ = 0; s_ < 2; ++s_) { *(LAS u32x4*)(b_ + lkn + s_ * 64 * AKS * 2) = rk[s_]; if (do_r) *(LAS u32x4*)(b_ + lkr + s_ * 64 * AKS * 2) = rr[s_]; *(LAS u32x4*)(b_ + lvt + s_ * 128) = rv[s_]; } } while (0)
    ATT_LD(0); ATT_ST(0);
    __syncthreads();
#pragma unroll 1
    for (int kt = 0; kt < ntile; ++kt) {
        const bool more = kt + 1 < ntile;
        if (more) ATT_LD(kt + 1);
        LAS unsigned char* B = C.lds + (kt & 1) * ABUF2;
#pragma unroll 1
        for (int sub = 0; sub < 2; ++sub) {
        const LAS bf16_t* Kl = (const LAS bf16_t*)B + sub * 64 * AKS; const LAS bf16_t* Vl = (const LAS bf16_t*)(B + 128 * AKS * 2) + sub * 64;
        bf16x8 ka[2][6];
#pragma unroll
        for (int ks = 0; ks < 6; ++ks) { ka[0][ks] = *(const LAS bf16x8*)(Kl + l31 * AKS + ks * 16 + 8 * hh); ka[1][ks] = *(const LAS bf16x8*)(Kl + (32 + l31) * AKS + ks * 16 + 8 * hh); }
        __builtin_amdgcn_sched_barrier(0);
        f32x16 s0 = mma32(ka[0][0], qf[0], negm), s1 = mma32(ka[1][0], qf[0], negm);
#pragma unroll
        for (int ks = 1; ks < 6; ++ks) { s0 = mma32(ka[0][ks], qf[ks], s0); s1 = mma32(ka[1][ks], qf[ks], s1); }
        __builtin_amdgcn_sched_barrier(0);
        u32x2 vr[2][2][4];
#pragma unroll
        for (int t = 0; t < 2; ++t)
#pragma unroll
            for (int ss = 0; ss < 2; ++ss) { const int ko = 32 * t + 16 * ss + 4 * hh;
                vr[t][ss][0] = *(const LAS u32x2*)(Vl + l31 * AVS2 + ko); vr[t][ss][1] = *(const LAS u32x2*)(Vl + l31 * AVS2 + ko + 8);
                vr[t][ss][2] = *(const LAS u32x2*)(Vl + (32 + l31) * AVS2 + ko); vr[t][ss][3] = *(const LAS u32x2*)(Vl + (32 + l31) * AVS2 + ko + 8); }
        __builtin_amdgcn_sched_barrier(0);
        float d; bool resc;
        if (kt == 0 && sub == 0) {
            float mx = fmaxf(s0[0], s1[0]);
#pragma unroll
            for (int i = 1; i < 16; ++i) mx = fmaxf(mx, fmaxf(s0[i], s1[i]));
            d = fmaxf(mx, __shfl_xor(mx, 32)); resc = true;
        } else {
            int im = imax3(__builtin_bit_cast(int, s0[0]), __builtin_bit_cast(int, s1[0]), __builtin_bit_cast(int, s0[1]));
            im = imax3(im, __builtin_bit_cast(int, s1[1]), __builtin_bit_cast(int, s0[2])); im = imax3(im, __builtin_bit_cast(int, s1[2]), __builtin_bit_cast(int, s0[3]));
            im = imax3(im, __builtin_bit_cast(int, s1[3]), __builtin_bit_cast(int, s0[4])); im = imax3(im, __builtin_bit_cast(int, s1[4]), __builtin_bit_cast(int, s0[5]));
            im = imax3(im, __builtin_bit_cast(int, s1[5]), __builtin_bit_cast(int, s0[6])); im = imax3(im, __builtin_bit_cast(int, s1[6]), __builtin_bit_cast(int, s0[7]));
            im = imax3(im, __builtin_bit_cast(int, s1[7]), __builtin_bit_cast(int, s0[8])); im = imax3(im, __builtin_bit_cast(int, s1[8]), __builtin_bit_cast(int, s0[9]));
            im = imax3(im, __builtin_bit_cast(int, s1[9]), __builtin_bit_cast(int, s0[10])); im = imax3(im, __builtin_bit_cast(int, s1[10]), __builtin_bit_cast(int, s0[11]));
            im = imax3(im, __builtin_bit_cast(int, s1[11]), __builtin_bit_cast(int, s0[12])); im = imax3(im, __builtin_bit_cast(int, s1[12]), __builtin_bit_cast(int, s0[13]));
            im = imax3(im, __builtin_bit_cast(int, s1[13]), __builtin_bit_cast(int, s0[14])); im = imax3(im, __builtin_bit_cast(int, s1[14]), __builtin_bit_cast(int, s0[15]));
            im = max(im, __builtin_bit_cast(int, s1[15]));
            im = max(im, __shfl_xor(im, 32));
            resc = __builtin_amdgcn_ballot_w64(im > 0x41000000) != 0ull; d = im > 0x41000000 ? __builtin_bit_cast(float, im) : 0.f;
        }
        if (resc) {
            if (kt != 0 || sub != 0) { const float alpha = __builtin_amdgcn_exp2f(-d); o0 = o0 * alpha; o1 = o1 * alpha; o2 = o2 * alpha; }
            negm = negm - d; s0 = s0 - d; s1 = s1 - d;
        }
#pragma unroll
        for (int i = 0; i < 16; ++i) { s0[i] = __builtin_amdgcn_exp2f(s0[i]); s1[i] = __builtin_amdgcn_exp2f(s1[i]); }
#pragma unroll
        for (int t = 0; t < 2; ++t)
#pragma unroll
            for (int ss = 0; ss < 2; ++ss) {
                u32x4 w;
                if (t == 0) { w.x = pk2(s0[8 * ss + 0], s0[8 * ss + 1]); w.y = pk2(s0[8 * ss + 2], s0[8 * ss + 3]); w.z = pk2(s0[8 * ss + 4], s0[8 * ss + 5]); w.w = pk2(s0[8 * ss + 6], s0[8 * ss + 7]); }
                else { w.x = pk2(s1[8 * ss + 0], s1[8 * ss + 1]); w.y = pk2(s1[8 * ss + 2], s1[8 * ss + 3]); w.z = pk2(s1[8 * ss + 4], s1[8 * ss + 5]); w.w = pk2(s1[8 * ss + 6], s1[8 * ss + 7]); }
                const bf16x8 pf = __builtin_bit_cast(bf16x8, w);
                const bf16x8 va = __builtin_bit_cast(bf16x8, (u32x4){vr[t][ss][0].x, vr[t][ss][0].y, vr[t][ss][1].x, vr[t][ss][1].y}), vb = __builtin_bit_cast(bf16x8, (u32x4){vr[t][ss][2].x, vr[t][ss][2].y, vr[t][ss][3].x, vr[t][ss][3].y});
                o0 = mma32(va, pf, o0); o1 = mma32(vb, pf, o1); o2 = mma32(onesf, pf, o2);
            }
        }
        if (more) ATT_ST((kt + 1) & 1);
        __syncthreads();
    }
#undef ATT_LD
#undef ATT_ST
    const float lsum = o2[0] + __shfl_xor(o2[0], 32);
    const float inv = 1.f / lsum;
    bf16_t* orow = MIX + (size_t)qrow * D + 768 + h * 64;
#pragma unroll
    for (int i = 0; i < 4; ++i) { const int dv = 8 * i + 4 * hh;
        *(u32x2*)(orow + dv) = pk4((f32x4){o0[4 * i] * inv, o0[4 * i + 1] * inv, o0[4 * i + 2] * inv, o0[4 * i + 3] * inv});
        *(u32x2*)(orow + 32 + dv) = pk4((f32x4){o1[4 * i] * inv, o1[4 * i + 1] * inv, o1[4 * i + 2] * inv, o1[4 * i + 3] * inv}); }
}

#define XB_TMO      128
#define XB_XCNT(j)  (256  + 64 * (j))
#define XB_XSUB(j)  (1280 + 64 * (j))
#define XB_XGEN(j)  (2304 + 64 * (j))
#define XB_TOP      3328
#define XB_TOPGEN   3392
#define XCD_BAR_WORDS 3456
#define XB_SPIN_CAP (1u << 18)

__device__ __forceinline__ unsigned xb_ld(unsigned* p)              { return __hip_atomic_load(p, __ATOMIC_RELAXED, __HIP_MEMORY_SCOPE_AGENT); }
__device__ __forceinline__ unsigned xb_add(unsigned* p, unsigned v) { return __hip_atomic_fetch_add(p, v, __ATOMIC_RELAXED, __HIP_MEMORY_SCOPE_AGENT); }
__device__ __forceinline__ unsigned xb_xcc_id() { return (unsigned)__builtin_amdgcn_s_getreg((3 << 11) | 20) & 0xFu; }
#define XB_SPIN(cond, bar) do { unsigned _sp = 0; while (cond) { __builtin_amdgcn_s_sleep(1); \
    if ((++_sp & 255u) == 0u) { if (xb_ld(&(bar)[XB_TMO])) break; if (_sp > XB_SPIN_CAP) { atomicAdd(&(bar)[XB_TMO], 1u); break; } } } } while (0)

struct XcdBarrier {
    unsigned* bar; unsigned x;
    volatile LAS unsigned* st;
};

__device__ __forceinline__ XcdBarrier xcd_barrier_post(unsigned* bar, volatile LAS unsigned* st) {
    XcdBarrier b; b.bar = bar; b.x = xb_xcc_id(); b.st = st;
    if (threadIdx.x == 0) (void)xb_add(&bar[XB_XCNT(b.x)], 1u);
    return b;
}
__device__ __forceinline__ void xcd_barrier_complete(unsigned* bar, unsigned x, unsigned& nloc, unsigned& nx) {
    const unsigned G = gridDim.x * gridDim.y * gridDim.z;
    unsigned sum, cnt, mine, sp = 0u;
    for (;;) {
        sum = 0u; cnt = 0u; mine = 0u;
#pragma unroll
        for (unsigned j = 0; j < 16; ++j) { const unsigned c = xb_ld(&bar[XB_XCNT(j)]); sum += c; cnt += (c > 0u) ? 1u : 0u; mine = (j == x) ? c : mine; }
        if (sum == G) break;
        __builtin_amdgcn_s_sleep(1);
        if ((++sp & 255u) == 0u) { if (xb_ld(&bar[XB_TMO])) break; if (sp > XB_SPIN_CAP) { atomicAdd(&bar[XB_TMO], 1u); break; } }
    }
    nloc = mine > 0u ? mine : 1u; nx = cnt > 0u ? cnt : 1u;
}

__device__ __forceinline__ void xcd_barrier(const XcdBarrier& b) {
    asm volatile("s_waitcnt vmcnt(0)" ::: "memory");
    __syncthreads();
    if (threadIdx.x == 0) {
        unsigned* bar = b.bar;
        __builtin_amdgcn_s_waitcnt(0);
        unsigned nloc = b.st[0], nx = b.st[1];
        if (nloc == 0u) { xcd_barrier_complete(bar, b.x, nloc, nx); b.st[0] = nloc; b.st[1] = nx; }
        const unsigned old = xb_add(&bar[XB_XSUB(b.x)], 1u);
        const unsigned gen = old / nloc;
        if (old + 1u == (gen + 1u) * nloc) {
            __builtin_amdgcn_fence(__ATOMIC_RELEASE, "agent");
            asm volatile("s_waitcnt vmcnt(0)" ::: "memory");
            const unsigned og = xb_add(&bar[XB_TOP], 1u);
            const unsigned tg = og / nx;
            if (og + 1u == (tg + 1u) * nx) xb_add(&bar[XB_TOPGEN], 1u);
            else XB_SPIN(xb_ld(&bar[XB_TOPGEN]) == tg, bar);
            __builtin_amdgcn_fence(__ATOMIC_ACQUIRE, "agent");
            xb_add(&bar[XB_XGEN(b.x)], 1u);
            asm volatile("s_waitcnt vmcnt(0)" ::: "memory");
        } else {
            XB_SPIN(xb_ld(&bar[XB_XGEN(b.x)]) == gen, bar);
            __builtin_amdgcn_fence(__ATOMIC_ACQUIRE, "agent");
            asm volatile("s_waitcnt vmcnt(0)" ::: "memory");
        }
    }
    __syncthreads();
}

__global__ void __launch_bounds__(NTHREADS, 2) mk_fwd(Params p) {
    extern __shared__ __attribute__((aligned(16))) unsigned char lds_raw[];
    cg::grid_group grid = cg::this_grid();
    Ctx C; C.p = p; C.lds = (LAS unsigned char*)lds_raw; C.tid = threadIdx.x; C.lane = C.tid & 63; C.wave = __builtin_amdgcn_readfirstlane(C.tid >> 6); C.bid = blockIdx.x; C.G = gridDim.x; C.ws = p.ws;

    volatile LAS unsigned* bst = (volatile LAS unsigned*)(C.lds + LDS_BYTES - 64);
    if (threadIdx.x < 2) bst[threadIdx.x] = 0u;
    __syncthreads();
    const XcdBarrier bar = xcd_barrier_post((unsigned*)(p.ws + WS_BAR), bst);
    C.refresh(); phase_prologue(C);
    grid.sync();
    C.refresh(); phase_norm0(C);
    xcd_barrier(bar);
#pragma unroll 1
    for (int layer = 0; layer < DEPTH; ++layer) {
        { C.refresh(); bf16_t* R1 = (bf16_t*)(C.ws + WS_R1); bf16_t* R2 = (bf16_t*)(C.ws + WS_R2); unsigned char* wl = C.wl(layer); pg8::Gemm g{R1, (const bf16_t*)(wl + WL_IN), M, NPP, D}; pg8::StaticOrder S; S.init(M, NPP, C.G, C.bid); pg8::EpiStore E{R2, NP, NP};
          pg8::gemm_phase<pg8::EpiStore, pg8::StaticOrder, true, true>(C.lds, g, S, E); }
        xcd_barrier(bar);
        C.refresh();
        for (int u = C.bid; u < 768 + 192 + 128 + 128 + 200; u += C.G) {
            C.refresh();
            if (u < 768) unit_chunk_mlp(C, layer, u);
            else if (u < 960) unit_conv(C, layer, u - 768);
            else if (u < 1088) unit_fourier_ctx(C, u - 960);
            else if (u < 1216) unit_fourier_lat1(C, u - 1088);
            else unit_mla_prep(C, layer, u - 1216);
        }
        xcd_barrier(bar);
        C.refresh();
        for (int u = C.bid; u < 512; u += C.G) {
            C.refresh();
            if (u < 256) unit_attention(C, 128 + u);
            else if (u < 384) unit_attention(C, u - 256);
            else unit_fourier_lat2(C, u - 384);
        }
        xcd_barrier(bar);
        { C.refresh(); bf16_t* R1 = (bf16_t*)(C.ws + WS_R1); bf16_t* R2 = (bf16_t*)(C.ws + WS_R2); unsigned char* wl = C.wl(layer); pg8::Gemm g{R1, (const bf16_t*)(wl + WL_OUT), M, D, D}; pg8::SplitTailOrder S; S.init(D, C.G, C.bid); pg8::EpiStoreSplit E{R2, R2 + (size_t)M * D - (size_t)SPLIT_ROW0 * D, D};
          pg8::gemm_phase<pg8::EpiStoreSplit, pg8::SplitTailOrder, true, true>(C.lds, g, S, E); }
        xcd_barrier(bar);
        C.refresh(); phase_post<0>(C, layer);
        xcd_barrier(bar);
        { C.refresh(); bf16_t* R1 = (bf16_t*)(C.ws + WS_R1); bf16_t* R2 = (bf16_t*)(C.ws + WS_R2); unsigned char* wl = C.wl(layer); pg8::Gemm g{R1, (const bf16_t*)(wl + WL_GU), M, 2 * FF, D}; pg8::StaticOrder S; S.init(M, 2 * FF, C.G, C.bid); pg8::EpiSwiGLU E{R2, FF};
          pg8::gemm_phase<pg8::EpiSwiGLU, pg8::StaticOrder, true, true>(C.lds, g, S, E);
          if (C.G == 256 && layer + 1 < DEPTH && C.bid >= 64) { C.refresh(); transpose_items(C, (layer + 1) * TI_L + (C.bid - 64), 192, (layer + 2) * TI_L); } }
        xcd_barrier(bar);
        { C.refresh(); bf16_t* R2 = (bf16_t*)(C.ws + WS_R2); bf16_t* R3 = (bf16_t*)(C.ws + WS_MLA); unsigned char* wl = C.wl(layer); pg8::Gemm g{R2, (const bf16_t*)(wl + WL_DN), M, D, FF}; pg8::SplitTailOrder S; S.init(FF, C.G, C.bid); pg8::EpiStoreSplit E{R3, R3 + (size_t)M * D - (size_t)SPLIT_ROW0 * D, D};
          pg8::gemm_phase<pg8::EpiStoreSplit, pg8::SplitTailOrder, true, true>(C.lds, g, S, E); }
        xcd_barrier(bar);
        C.refresh(); phase_post<1>(C, layer);
        if (layer + 1 < DEPTH) xcd_barrier(bar);
    }
}

extern "C" void kernel_launch(void* const* d_in, const int* in_sizes, int n_in, void* d_out, int out_size, void* d_ws, size_t ws_size, hipStream_t stream) {
    static int grid = 0;
    if (grid == 0) {
        if (n_in != 24 || ws_size < WS_END) { fprintf(stderr, "kernel_launch: need 24 inputs and %zu bytes of workspace; got %d, %zu\n", (size_t)WS_END, n_in, ws_size); grid = -1; return; }
        int dev = 0, cus = 0, per_cu = 0;
        if (hipGetDevice(&dev) != hipSuccess || hipDeviceGetAttribute(&cus, hipDeviceAttributeMultiprocessorCount, dev) != hipSuccess) { grid = -1; return; }
        if (hipFuncSetAttribute((const void*)mk_fwd, hipFuncAttributeMaxDynamicSharedMemorySize, LDS_BYTES) != hipSuccess) { fprintf(stderr, "kernel_launch: hipFuncSetAttribute failed\n"); grid = -1; return; }
        if (hipOccupancyMaxActiveBlocksPerMultiprocessor(&per_cu, (const void*)mk_fwd, NTHREADS, LDS_BYTES) != hipSuccess || per_cu < 1) fprintf(stderr, "kernel_launch: occupancy query says %d blocks per CU\n", per_cu);
        (void)hipGetLastError();
        grid = cus;
    }
    if (grid < 0) return;
    Params p{};
    for (int i = 0; i < 24; ++i) p.in[i] = (const float*)d_in[i];
    p.out = (float*)d_out; p.ws = (unsigned char*)d_ws;
    if (hipMemsetAsync((char*)d_ws + WS_BAR, 0, WS_BAR_BYTES, stream) != hipSuccess) { fprintf(stderr, "kernel_launch: memset failed\n"); return; }
    void* args[] = {&p};
    hipError_t e = hipLaunchCooperativeKernel((const void*)mk_fwd, dim3(grid), dim3(NTHREADS), args, LDS_BYTES, stream);
    if (e != hipSuccess) fprintf(stderr, "kernel_launch: cooperative launch failed: %s (grid %d)\n", hipGetErrorString(e), grid);
}
```

```cpp
#include <hip/hip_runtime.h>
#include <hip/hip_cooperative_groups.h>
#include <cstdio>
#include <cstdint>
namespace cg = cooperative_groups;
namespace pg8 {
#define PG8_LAS __attribute__((address_space(3)))
typedef unsigned short bf16_t;
typedef short bf16x8 __attribute__((ext_vector_type(8)));
typedef float f32x4 __attribute__((ext_vector_type(4)));
typedef unsigned u32x4 __attribute__((ext_vector_type(4)));
constexpr int BM = 256, BK = 64, HALF = 128, HTB = HALF * BK * 2  , STAGE_BYTES = 8 * HTB, NXCD = 8, WGM = 8;

__host__ __device__ __forceinline__ int lds_byte(int r, int c) { const int st = (r >> 4) * 2 + (c >> 5), rr = r & 15, cc = c & 31, ob = rr * 64 + cc * 2; return st * 1024 + (ob ^ (((ob >> 9) & 1) << 5)); }
__host__ __device__ __forceinline__ void stage_rc(int b, int& R, int& C) { const int st = b / 1024, sb = b % 1024, swz = sb ^ (((sb >> 9) & 1) << 5); R = (st >> 1) * 16 + swz / 64; C = (st & 1) * 32 + (swz % 64) / 2; }
__host__ __device__ __forceinline__ int perm32(int rho) { const int n = rho >> 4, i = rho & 15; return 8 * (i >> 2) + 4 * n + (i & 3); }

struct Unit { int pm, pn; int kh, nt, koff; };
struct Gemm { const bf16_t* A; const bf16_t* Bt; int M, N, K; };

struct StaticOrder {
    int nM, nN, nwg, G, c;
    __host__ __device__ void init(int M, int N, int G_, int c_) { nM = M / BM; nN = N / BM; nwg = nM * nN; G = G_; c = c_; }
    __host__ __device__ bool next(int i, Unit& u) const {
        const long L = (long)i * G + c; if (L >= nwg) return false;
        int wgid = (int)L; { const int q = nwg / NXCD, r = nwg % NXCD, xcd = wgid % NXCD, off = wgid / NXCD; wgid = (xcd < r ? xcd * (q + 1) : r * (q + 1) + (xcd - r) * q) + off; }
        const int nig = WGM * nN, gid = wgid / nig, fm = gid * WGM, gsz = (nM - fm) < WGM ? (nM - fm) : WGM;
        u.pm = fm + ((wgid % nig) % gsz); u.pn = (wgid % nig) / gsz; u.kh = 0; u.nt = 0; u.koff = 0; return true;
    }
    __device__ __forceinline__ void a_ready(const Unit&) const {}
    __device__ __forceinline__ void done(const Unit&) const {}
};

__device__ __forceinline__ unsigned cvt_pk_bf16(float lo, float hi) { unsigned r; asm volatile("v_cvt_pk_bf16_f32 %0, %1, %2" : "=v"(r) : "v"(lo), "v"(hi)); return r; }
typedef float f32x2 __attribute__((ext_vector_type(2)));
struct EpiStore {
    static constexpr bool PERM = true, AFTER_DRAIN = false;
    bf16_t* O; int ldc; int ncols;
    __device__ __forceinline__ void operator()(const f32x4 (&acc)[2][2][4][2], const Unit& u, int wr, int wc, int fr, int fq) const {
        const int row0 = u.pm * BM + wr * 64 + fr; const int col0 = u.pn * BM + wc * 32 + 8 * fq;
#pragma unroll
        for (int ai = 0; ai < 2; ++ai)
#pragma unroll
            for (int m = 0; m < 4; ++m) { bf16_t* rowp = O + (size_t)(row0 + ai * HALF + m * 16) * ldc + col0;
#pragma unroll
                for (int bj = 0; bj < 2; ++bj) { const f32x4 v0 = acc[ai][bj][m][0], v1 = acc[ai][bj][m][1];
                    u32x4 w; w.x = cvt_pk_bf16(v0[0], v0[1]); w.y = cvt_pk_bf16(v0[2], v0[3]); w.z = cvt_pk_bf16(v1[0], v1[1]); w.w = cvt_pk_bf16(v1[2], v1[3]);
                    if (col0 + bj * HALF < ncols) *(u32x4*)(rowp + bj * HALF) = w; } }
    }
};
struct EpiStoreWT {
    static constexpr bool PERM = true, AFTER_DRAIN = false;
    bf16_t* O; int ldc; int ncols;
    __device__ __forceinline__ void operator()(const f32x4 (&acc)[2][2][4][2], const Unit& u, int wr, int wc, int fr, int fq) const {
        const int row0 = u.pm * BM + wr * 64 + fr; const int col0 = u.pn * BM + wc * 32 + 8 * fq;
#pragma unroll
        for (int ai = 0; ai < 2; ++ai)
#pragma unroll
            for (int m = 0; m < 4; ++m) { bf16_t* rowp = O + (size_t)(row0 + ai * HALF + m * 16) * ldc + col0;
#pragma unroll
                for (int bj = 0; bj < 2; ++bj) { const f32x4 v0 = acc[ai][bj][m][0], v1 = acc[ai][bj][m][1];
                    const unsigned long long lo = (unsigned long long)cvt_pk_bf16(v0[0], v0[1]) | ((unsigned long long)cvt_pk_bf16(v0[2], v0[3]) << 32);
                    const unsigned long long hi = (unsigned long long)cvt_pk_bf16(v1[0], v1[1]) | ((unsigned long long)cvt_pk_bf16(v1[2], v1[3]) << 32);
                    unsigned long long* q = (unsigned long long*)(rowp + bj * HALF);
                    __hip_atomic_store(q, lo, __ATOMIC_RELAXED, __HIP_MEMORY_SCOPE_AGENT); __hip_atomic_store(q + 1, hi, __ATOMIC_RELAXED, __HIP_MEMORY_SCOPE_AGENT); } }
    }
};
__device__ __forceinline__ float silu_mul(float g, float u) { return g * u * __builtin_amdgcn_rcpf(1.f + __expf(-g)); }
struct EpiSwiGLU {
    static constexpr bool PERM = true, AFTER_DRAIN = false;
    bf16_t* O; int ldc;
    __device__ __forceinline__ void operator()(const f32x4 (&acc)[2][2][4][2], const Unit& u, int wr, int wc, int fr, int fq) const {
        const int row0 = u.pm * BM + wr * 64 + fr; const int col0 = u.pn * HALF + wc * 32 + 8 * fq;
#pragma unroll
        for (int ai = 0; ai < 2; ++ai)
#pragma unroll
            for (int m = 0; m < 4; ++m) { bf16_t* rowp = O + (size_t)(row0 + ai * HALF + m * 16) * ldc + col0;
                const f32x4 g0 = acc[ai][0][m][0], g1 = acc[ai][0][m][1], u0 = acc[ai][1][m][0], u1 = acc[ai][1][m][1];
                u32x4 w; w.x = cvt_pk_bf16(silu_mul(g0[0], u0[0]), silu_mul(g0[1], u0[1])); w.y = cvt_pk_bf16(silu_mul(g0[2], u0[2]), silu_mul(g0[3], u0[3]));
                w.z = cvt_pk_bf16(silu_mul(g1[0], u1[0]), silu_mul(g1[1], u1[1])); w.w = cvt_pk_bf16(silu_mul(g1[2], u1[2]), silu_mul(g1[3], u1[3]));
                *(u32x4*)rowp = w; }
    }
};

struct PanelOrder {
    int nN, nwg, G, c; unsigned* cnt;
    __device__ void init(int M, int N, int G_, int c_, unsigned* cnt_) { nN = N / BM; nwg = (M / BM) * nN; G = G_; c = c_; cnt = cnt_; }
    __device__ bool next(int i, Unit& u) const { const long L = (long)i * G + c; if (L >= nwg) return false; u.pm = (int)L / nN; u.pn = (int)L % nN; u.kh = 0; u.nt = 0; u.koff = 0; return true; }
    __device__ __forceinline__ void a_ready(const Unit&) const {}
    __device__ __forceinline__ void done(const Unit& u) const {
        asm volatile("s_waitcnt vmcnt(0)" ::: "memory");
        if ((threadIdx.x & 63) == 0) __hip_atomic_fetch_add(cnt + u.pm, 1u, __ATOMIC_RELAXED, __HIP_MEMORY_SCOPE_AGENT);
    }
};

struct SplitTailOrder {
    int G, c, ntf; bool split;
    __device__ void init(int K, int G_, int c_) { G = G_; c = c_; ntf = K / BK; split = (G_ == 256); }
    __device__ bool next(int i, Unit& u) const {
        if (!split) { const long L = (long)i * G + c; if (L >= 384) return false; u.pm = (int)L >> 2; u.pn = (int)L & 3; u.kh = 0; u.nt = 0; u.koff = 0; return true; }
        if (i == 0) { const int t = (c & 7) * 32 + (c >> 3); u.pm = t >> 2; u.pn = t & 3; u.kh = 0; u.nt = 0; u.koff = 0; return true; }
        if (i == 1) { const int t = 256 + (c & 7) * 16 + (c >> 4); u.pm = t >> 2; u.pn = t & 3; u.kh = (c >> 3) & 1; u.nt = ntf / 2; u.koff = u.kh * (ntf / 2) * BK * 2; return true; }
        return false;
    }
    __device__ __forceinline__ void a_ready(const Unit&) const {}
    __device__ __forceinline__ void done(const Unit&) const {}
};
struct EpiStoreSplit {
    static constexpr bool PERM = true, AFTER_DRAIN = false;
    bf16_t* O; bf16_t* O1; int ldc;
    __device__ __forceinline__ void operator()(const f32x4 (&acc)[2][2][4][2], const Unit& u, int wr, int wc, int fr, int fq) const {
        const int row0 = u.pm * BM + wr * 64 + fr; const int col0 = u.pn * BM + wc * 32 + 8 * fq; bf16_t* base = u.kh ? O1 : O;
#pragma unroll
        for (int ai = 0; ai < 2; ++ai)
#pragma unroll
            for (int m = 0; m < 4; ++m) { bf16_t* rowp = base + (size_t)(row0 + ai * HALF + m * 16) * ldc + col0;
#pragma unroll
                for (int bj = 0; bj < 2; ++bj) { const f32x4 v0 = acc[ai][bj][m][0], v1 = acc[ai][bj][m][1];
                    u32x4 w; w.x = cvt_pk_bf16(v0[0], v0[1]); w.y = cvt_pk_bf16(v0[2], v0[3]); w.z = cvt_pk_bf16(v1[0], v1[1]); w.w = cvt_pk_bf16(v1[2], v1[3]);
                    *(u32x4*)(rowp + bj * HALF) = w; } }
    }
};
template <class Epi, class Sched, bool ALIGN_EPI = false, bool SP2 = false>
__device__ __forceinline__ void gemm_phase(PG8_LAS unsigned char* lds, const Gemm g, const Sched& S, const Epi& E) {
    int tid_ = threadIdx.x; asm volatile("" : "+v"(tid_));
    const int tid = tid_, wid = __builtin_amdgcn_readfirstlane(tid >> 6), lane = tid & 63, wr = wid >> 2, wc = wid & 3, fr = lane & 15, fq = lane >> 4;
    const int K = g.K, nt = K / BK;
    unsigned voffA[2], voffB[2];
#pragma unroll
    for (int i = 0; i < 2; ++i) { int R, C; stage_rc(tid * 16 + i * 8192, R, C); const int Rb = Epi::PERM ? ((R & ~31) + perm32(R & 31)) : R;
        voffA[i] = (unsigned)(R * K + C) * 2u; voffB[i] = (unsigned)(Rb * K + C) * 2u; }
    const size_t kstep = (size_t)(BK * 2);
    const size_t hstep = (size_t)HALF * K * 2;
    const size_t tstep = 2 * hstep;
    const unsigned ldsw = (unsigned)wid * 1024u;
    const int aoff = lds_byte(wr * 64 + fr, fq * 8), boff = lds_byte(wc * 32 + fr, fq * 8);
#define PG8_SA(b, h) (((b) * 2 + (h)) * HTB)
#define PG8_SB(b, h) ((4 + (b) * 2 + (h)) * HTB)
#define PG8_STAGE(bufoff, gbase, voff) do { _Pragma("unroll") for (int _i = 0; _i < 2; ++_i) \
        __builtin_amdgcn_global_load_lds((const unsigned*)((const char*)(gbase) + (voff)[_i]), (PG8_LAS unsigned*)(lds + (bufoff) + ldsw + _i * 8192), 16, 0, 0); } while (0)
#define PG8_LDA(dst, b, h) do { _Pragma("unroll") for (int m = 0; m < 4; ++m) _Pragma("unroll") for (int k = 0; k < 2; ++k) dst[m][k] = *(const PG8_LAS bf16x8*)(lds + PG8_SA(b, h) + aoff + m * 2048 + k * 1024); } while (0)
#define PG8_LDB(dst, b, h) do { _Pragma("unroll") for (int n = 0; n < 2; ++n) _Pragma("unroll") for (int k = 0; k < 2; ++k) dst[n][k] = *(const PG8_LAS bf16x8*)(lds + PG8_SB(b, h) + boff + n * 2048 + k * 1024); } while (0)
#define PG8_MMA(ai, bj, At, Bt) do { __builtin_amdgcn_s_setprio(1); _Pragma("unroll") for (int m = 0; m < 4; ++m) _Pragma("unroll") for (int n = 0; n < 2; ++n) _Pragma("unroll") for (int k = 0; k < 2; ++k) \
        acc[ai][bj][m][n] = __builtin_amdgcn_mfma_f32_16x16x32_bf16(Bt[n][k], At[m][k], acc[ai][bj][m][n], 0, 0, 0); __builtin_amdgcn_s_setprio(0); } while (0)
#define PG8_WAIT_V(n) asm volatile("s_waitcnt vmcnt(" #n ")" ::: "memory")
#define PG8_WAIT_L(n) asm volatile("s_waitcnt lgkmcnt(" #n ")" ::: "memory")
#define PG8_BAR __builtin_amdgcn_s_barrier()
#define PG8_SCHED __builtin_amdgcn_sched_barrier(0)
    Unit cur, nxt; int ui = 0;
    if (!S.next(0, cur)) return;
    f32x4 acc[2][2][4][2];
#pragma unroll
    for (int a = 0; a < 2; ++a)
#pragma unroll
        for (int b = 0; b < 2; ++b)
#pragma unroll
            for (int m = 0; m < 4; ++m)
#pragma unroll
                for (int n = 0; n < 2; ++n) acc[a][b][m][n] = (f32x4){0.f, 0.f, 0.f, 0.f};
    bf16x8 At[4][2], B0[2][2], B1[2][2];
    const char* cA = (const char*)g.A + (size_t)cur.pm * tstep + cur.koff; const char* cB = (const char*)g.Bt + (size_t)cur.pn * tstep + cur.koff;
    S.a_ready(cur);
    if constexpr (SP2) {
        PG8_STAGE(PG8_SB(0, 0), cB, voffB); PG8_STAGE(PG8_SB(0, 1), cB + hstep, voffB); PG8_STAGE(PG8_SA(0, 0), cA, voffA); PG8_STAGE(PG8_SA(0, 1), cA + hstep, voffA);
        if (wr == 1) PG8_BAR;
        PG8_WAIT_V(2); PG8_BAR;
        PG8_STAGE(PG8_SB(1, 0), cB + kstep, voffB); PG8_STAGE(PG8_SA(1, 0), cA + kstep, voffA); PG8_STAGE(PG8_SB(1, 1), cB + hstep + kstep, voffB);
        PG8_WAIT_V(6); PG8_BAR;
    } else {
        PG8_STAGE(PG8_SB(0, 0), cB, voffB); PG8_STAGE(PG8_SA(0, 0), cA, voffA); PG8_STAGE(PG8_SB(0, 1), cB + hstep, voffB); PG8_STAGE(PG8_SA(0, 1), cA + hstep, voffA);
        if (wr == 1) PG8_BAR;
        PG8_WAIT_V(4); PG8_BAR;
        PG8_STAGE(PG8_SB(1, 0), cB + kstep, voffB); PG8_STAGE(PG8_SA(1, 0), cA + kstep, voffA); PG8_STAGE(PG8_SB(1, 1), cB + hstep + kstep, voffB);
        PG8_WAIT_V(6); PG8_BAR;
    }
    for (;;) {
        const bool has_next = S.next(ui + 1, nxt);
        const char* nA = has_next ? (const char*)g.A + (size_t)nxt.pm * tstep + nxt.koff : cA; const char* nB = has_next ? (const char*)g.Bt + (size_t)nxt.pn * tstep + nxt.koff : cB;
        const int ntc = cur.nt ? cur.nt : nt;
        for (int t = 0; t < ntc; t += 2) {
            const bool last = (t == ntc - 2);
            const char* a1 = cA + (size_t)(t + 1) * kstep;
            const char* a2 = last ? nA : cA + (size_t)(t + 2) * kstep; const char* b2 = last ? nB : cB + (size_t)(t + 2) * kstep;
            const char* a3 = a2 + kstep; const char* b3 = b2 + kstep;
            if (last && has_next) S.a_ready(nxt);
            if constexpr (SP2) {
            PG8_LDB(B0, 0, 0); PG8_LDB(B1, 0, 1); PG8_SCHED; PG8_LDA(At, 0, 0); PG8_STAGE(PG8_SA(1, 1), a1 + hstep, voffA);
            PG8_WAIT_V(8); PG8_WAIT_L(0); PG8_BAR; PG8_MMA(0, 0, At, B0); PG8_MMA(0, 1, At, B1); PG8_BAR; PG8_SCHED;
            PG8_LDA(At, 0, 1); PG8_STAGE(PG8_SB(0, 0), b2, voffB); PG8_STAGE(PG8_SB(0, 1), b2 + hstep, voffB); PG8_STAGE(PG8_SA(0, 0), a2, voffA);
            PG8_WAIT_V(8); PG8_WAIT_L(0); PG8_BAR; PG8_MMA(1, 0, At, B0); PG8_MMA(1, 1, At, B1); PG8_BAR; PG8_SCHED;
            PG8_LDB(B0, 1, 0); PG8_LDB(B1, 1, 1); PG8_SCHED; PG8_LDA(At, 1, 0); PG8_STAGE(PG8_SA(0, 1), a2 + hstep, voffA);
            PG8_WAIT_V(8); PG8_WAIT_L(0); PG8_BAR; PG8_MMA(0, 0, At, B0); PG8_MMA(0, 1, At, B1); PG8_BAR; PG8_SCHED;
            PG8_LDA(At, 1, 1); PG8_STAGE(PG8_SB(1, 0), b3, voffB); PG8_STAGE(PG8_SB(1, 1), b3 + hstep, voffB); PG8_STAGE(PG8_SA(1, 0), a3, voffA);
            PG8_WAIT_V(8); PG8_WAIT_L(0); PG8_BAR; PG8_MMA(1, 0, At, B0); PG8_MMA(1, 1, At, B1); PG8_BAR; PG8_SCHED;
            } else {
            PG8_LDB(B0, 0, 0); PG8_SCHED; PG8_LDA(At, 0, 0); PG8_STAGE(PG8_SA(1, 1), a1 + hstep, voffA);
            PG8_WAIT_L(8); PG8_BAR; PG8_WAIT_L(0); PG8_MMA(0, 0, At, B0); PG8_BAR; PG8_SCHED;
            PG8_LDB(B1, 0, 1); PG8_STAGE(PG8_SB(0, 0), b2, voffB);
            PG8_BAR; PG8_WAIT_L(0); PG8_MMA(0, 1, At, B1); PG8_BAR;
            PG8_LDA(At, 0, 1); PG8_STAGE(PG8_SA(0, 0), a2, voffA);
            PG8_BAR; PG8_WAIT_L(0); PG8_MMA(1, 0, At, B0); PG8_BAR; PG8_SCHED;
            PG8_STAGE(PG8_SB(0, 1), b2 + hstep, voffB);
            PG8_WAIT_V(6); PG8_BAR; PG8_MMA(1, 1, At, B1); PG8_BAR;
            PG8_LDB(B0, 1, 0); PG8_SCHED; PG8_LDA(At, 1, 0); PG8_STAGE(PG8_SA(0, 1), a2 + hstep, voffA);
            PG8_WAIT_L(8); PG8_BAR; PG8_WAIT_L(0); PG8_MMA(0, 0, At, B0); PG8_BAR; PG8_SCHED;
            PG8_LDB(B1, 1, 1); PG8_STAGE(PG8_SB(1, 0), b3, voffB);
            PG8_BAR; PG8_WAIT_L(0); PG8_MMA(0, 1, At, B1); PG8_BAR;
            PG8_LDA(At, 1, 1); PG8_STAGE(PG8_SA(1, 0), a3, voffA);
            PG8_BAR; PG8_WAIT_L(0); PG8_MMA(1, 0, At, B0); PG8_BAR; PG8_SCHED;
            PG8_STAGE(PG8_SB(1, 1), b3 + hstep, voffB);
            PG8_WAIT_V(6); PG8_BAR; PG8_MMA(1, 1, At, B1); PG8_BAR;
            }
        }
        if constexpr (ALIGN_EPI) { if (wr == 0) PG8_BAR; }
        if constexpr (!Epi::AFTER_DRAIN) { E(acc, cur, wr, wc, fr, fq); S.done(cur); }
        if (!has_next) break;
#pragma unroll
        for (int a = 0; a < 2; ++a)
#pragma unroll
            for (int b = 0; b < 2; ++b)
#pragma unroll
                for (int m = 0; m < 4; ++m)
#pragma unroll
                    for (int n = 0; n < 2; ++n) acc[a][b][m][n] = (f32x4){0.f, 0.f, 0.f, 0.f};
        cur = nxt; cA = nA; cB = nB; ++ui;
        if constexpr (ALIGN_EPI) { if (wr == 1) PG8_BAR; }
    }
    PG8_WAIT_V(0);
    if constexpr (!ALIGN_EPI) { if (wr == 0) PG8_BAR; }
    PG8_BAR;
    if constexpr (Epi::AFTER_DRAIN) { E.fused(acc, cur, wr, wc, fr, fq, lds, wid, lane); S.done(cur); }
#undef PG8_SA
#undef PG8_SB
#undef PG8_STAGE
#undef PG8_LDA
#undef PG8_LDB
#undef PG8_MMA
#undef PG8_WAIT_V
#undef PG8_WAIT_L
#undef PG8_BAR
#undef PG8_SCHED
}
}
#define LAS __attribute__((address_space(3)))
typedef unsigned short bf16_t;
typedef short bf16x8 __attribute__((ext_vector_type(8)));
typedef short bf16x4 __attribute__((ext_vector_type(4)));
typedef float f32x4 __attribute__((ext_vector_type(4)));
typedef float f32x2 __attribute__((ext_vector_type(2)));
typedef float f32x16 __attribute__((ext_vector_type(16)));
typedef unsigned u32x4 __attribute__((ext_vector_type(4)));
typedef unsigned u32x2 __attribute__((ext_vector_type(2)));

constexpr int D = 1024, M_CTX = 8192, M_LAT = 16384, M = M_CTX + M_LAT, NP = 1888, NPP = 2048, FF = 2816, DEPTH = 4;
constexpr int KEYROWS = 8192 + 4 * 4352;
constexpr float EPS = 1e-6f;
constexpr int NTHREADS = 512, NWAVES = 8;
constexpr int LDS_BYTES = 147456;

constexpr size_t OUT_X = 0, OUT_CKV = (size_t)M * D, OUT_KR = OUT_CKV + (size_t)32 * 4 * 256 * 128;
constexpr int PC_U = 0, PC_V = 256, PC_H = 512, PC_B = 768, PC_C = 1024, PC_F = 1280, PC_Q = 1536, PC_KV = 1728, PC_KR = 1856;

constexpr size_t al256(size_t x) { return (x + 255) & ~(size_t)255; }
constexpr size_t WS_BAR = 0, WS_BAR_BYTES = 16384;
constexpr size_t WS_MOD = WS_BAR_BYTES;
constexpr size_t WS_F64 = al256(WS_MOD + (size_t)4 * 5 * 6144 * 4);
constexpr size_t WS_T64R = WS_F64 + 128 * 64 * 2;
constexpr size_t WS_T64I = WS_T64R + 64 * 128 * 2;
constexpr size_t WS_T64B = WS_T64I + 64 * 128 * 2;
constexpr size_t WS_T256 = WS_T64B + 64 * 128 * 2;
constexpr size_t WS_TW = WS_T256 + 256 * 512 * 2;
constexpr size_t WS_ROPE = WS_TW + 4096 * 8;
constexpr size_t WS_W = al256(WS_ROPE + 64 * 8 * 8);
constexpr size_t WL_IN = 0, WL_OUT = WL_IN + (size_t)NPP * D * 2, WL_GU = WL_OUT + (size_t)D * D * 2, WL_DN = WL_GU + (size_t)2 * FF * D * 2,
                 WL_UQ = WL_DN + (size_t)D * FF * 2, WL_UKV = WL_UQ + (size_t)384 * 192 * 2, WL_SP = WL_UKV + (size_t)512 * 128 * 2, WL_SIZE = WL_SP + (size_t)4 * 128 * 128 * 2;
constexpr size_t WS_R1 = al256(WS_W + 4 * WL_SIZE);
constexpr size_t WS_R2 = WS_R1 + (size_t)M * D * 2;
constexpr size_t WS_MLA = WS_R2 + (size_t)M * FF * 2;
constexpr size_t WS_Q = WS_MLA, WS_KN = WS_Q + (size_t)M * 384 * 2, WS_VT = WS_KN + (size_t)KEYROWS * 256 * 2, WS_KR = WS_VT + (size_t)KEYROWS * 256 * 2,
                 WS_GB = WS_KR + (size_t)KEYROWS * 32 * 2, WS_END = WS_GB + (size_t)4 * 4 * 64 * 64 * 128 * 2;
static_assert(WS_END - WS_MLA >= (size_t)M * D * 2, "FFNOUT alias");
static_assert((size_t)M * NP * 2 <= (size_t)M * FF * 2, "PROJ fits R2");

struct Params { const float* in[24]; float* out; unsigned char* ws; };
enum { I_XP = 0, I_XS, I_CCKV, I_CKR, I_C, I_CCTX, I_WADA, I_BADA, I_GPM, I_GPOM, I_GPF, I_GPOF, I_WIN, I_SPW, I_SPB, I_CVW, I_CVB, I_GQ, I_WUQ, I_GKV, I_WUKV, I_WOUT, I_WGU, I_WDN };

__device__ __forceinline__ unsigned f2bf(float f) { unsigned u = __builtin_bit_cast(unsigned, f); return (u + 0x7fffu + ((u >> 16) & 1u)) >> 16; }
typedef __bf16 bf16x2v __attribute__((ext_vector_type(2)));
__device__ __forceinline__ unsigned pk2(float lo, float hi) { const bf16x2v r = __builtin_convertvector((f32x2){lo, hi}, bf16x2v); return __builtin_bit_cast(unsigned, r); }
__device__ __forceinline__ float bflo(unsigned w) { return __builtin_bit_cast(float, w << 16); }
__device__ __forceinline__ float bfhi(unsigned w) { return __builtin_bit_cast(float, w & 0xffff0000u); }
__device__ __forceinline__ float bf1(bf16_t v) { return __builtin_bit_cast(float, (unsigned)v << 16); }
__device__ __forceinline__ f32x4 mma16(bf16x8 a, bf16x8 b, f32x4 c) { return __builtin_amdgcn_mfma_f32_16x16x32_bf16(a, b, c, 0, 0, 0); }
__device__ __forceinline__ f32x16 mma32(bf16x8 a, bf16x8 b, f32x16 c) { return __builtin_amdgcn_mfma_f32_32x32x16_bf16(a, b, c, 0, 0, 0); }
__device__ __forceinline__ float wave_sum(float v) {
#pragma unroll
    for (int o = 1; o < 64; o <<= 1) v += __shfl_xor(v, o);
    return v;
}
__device__ __forceinline__ u32x2 pk4(f32x4 v) { u32x2 w; w.x = pk2(v[0], v[1]); w.y = pk2(v[2], v[3]); return w; }
__device__ __forceinline__ int mod_of_row(int r) { return r < M_CTX ? 0 : 1 + ((r - M_CTX) >> 12); }

struct Ctx {
    Params p; LAS unsigned char* lds; int tid, lane, wave, bid, G;
    unsigned char* ws;
    __device__ __forceinline__ const float* mod(int l, int mi, int chunk) const { return (const float*)(ws + WS_MOD) + ((size_t)(l * 5 + mi) * 6 + chunk) * 1024; }
    __device__ __forceinline__ unsigned char* wl(int l) const { return ws + WS_W + (size_t)l * WL_SIZE; }
    __device__ __forceinline__ void refresh() { int t = threadIdx.x; asm volatile("" : "+v"(t)); tid = t; lane = t & 63; wave = __builtin_amdgcn_readfirstlane(t >> 6);
        size_t z = 0; asm volatile("" : "+s"(z)); ws = p.ws + z;
        int b = blockIdx.x; asm volatile("" : "+s"(b)); bid = b; }
};

constexpr int TPS = 258;
struct TItem { const float* W; bf16_t* WT; int ldw, K, k0, n0, nvalid, gu; };
__device__ __forceinline__ void titem_load(const TItem& t, int wave, int lane, f32x4 (&v)[8]) {
    const int n = t.n0 + 4 * lane;
#pragma unroll
    for (int i = 0; i < 8; ++i) v[i] = n < t.nvalid ? *(const f32x4*)(t.W + (size_t)(t.k0 + 8 * wave + i) * t.ldw + n) : (f32x4){0.f, 0.f, 0.f, 0.f};
}
__device__ __forceinline__ void titem_stage(LAS unsigned char* lds, int wave, int lane, const f32x4 (&v)[8]) {
    LAS bf16_t* T = (LAS bf16_t*)lds;
#pragma unroll
    for (int i = 0; i < 8; ++i) { LAS unsigned* d = (LAS unsigned*)(T + (8 * wave + i) * TPS + 4 * lane); d[0] = pk2(v[i][0], v[i][1]); d[1] = pk2(v[i][2], v[i][3]); }
}
__device__ __forceinline__ void titem_store(const TItem& t, const LAS unsigned char* lds, int tid) {
    const LAS bf16_t* T = (const LAS bf16_t*)lds;
#pragma unroll
    for (int it = 0; it < 4; ++it) { const int q = tid + NTHREADS * it, n = q >> 3, c = q & 7;
        unsigned short e[8];
#pragma unroll
        for (int j = 0; j < 8; ++j) e[j] = T[(8 * c + j) * TPS + n];
        const int sn = t.n0 + n;
        if (sn < t.nvalid) { int dr = sn; if (t.gu) { const int isup = sn >= FF, jj = isup ? sn - FF : sn; dr = (jj >> 7) * 256 + isup * 128 + (jj & 127); }
            u32x4 o; o.x = e[0] | ((unsigned)e[1] << 16); o.y = e[2] | ((unsigned)e[3] << 16); o.z = e[4] | ((unsigned)e[5] << 16); o.w = e[6] | ((unsigned)e[7] << 16);
            *(u32x4*)(t.WT + (size_t)dr * t.K + t.k0 + 8 * c) = o; } }
}
constexpr int TI_IN = 16 * 8, TI_OUT = 16 * 4, TI_GU = 16 * 22, TI_DN = 44 * 4, TI_UQ = 3 * 2, TI_UKV = 2 * 2, TI_L = TI_IN + TI_OUT + TI_GU + TI_DN + TI_UQ + TI_UKV;
__device__ __forceinline__ TItem titem_make(const Ctx& C, int it) {
    const Params& p = C.p; const int l = it / TI_L; int r = it % TI_L; unsigned char* wl = C.wl(l); TItem t; t.gu = 0;
    if (r < TI_IN) { t.W = p.in[I_WIN] + (size_t)l * D * NP; t.WT = (bf16_t*)(wl + WL_IN); t.ldw = NP; t.K = D; t.k0 = (r >> 3) * 64; t.n0 = (r & 7) * 256; t.nvalid = NP; return t; } r -= TI_IN;
    if (r < TI_OUT) { t.W = p.in[I_WOUT] + (size_t)l * D * D; t.WT = (bf16_t*)(wl + WL_OUT); t.ldw = D; t.K = D; t.k0 = (r >> 2) * 64; t.n0 = (r & 3) * 256; t.nvalid = D; return t; } r -= TI_OUT;
    if (r < TI_GU) { t.W = p.in[I_WGU] + (size_t)l * D * 2 * FF; t.WT = (bf16_t*)(wl + WL_GU); t.ldw = 2 * FF; t.K = D; t.k0 = (r / 22) * 64; t.n0 = (r % 22) * 256; t.nvalid = 2 * FF; t.gu = 1; return t; } r -= TI_GU;
    if (r < TI_DN) { t.W = p.in[I_WDN] + (size_t)l * FF * D; t.WT = (bf16_t*)(wl + WL_DN); t.ldw = D; t.K = FF; t.k0 = (r >> 2) * 64; t.n0 = (r & 3) * 256; t.nvalid = D; return t; } r -= TI_DN;
    if (r < TI_UQ) { t.W = p.in[I_WUQ] + (size_t)l * 192 * 384; t.WT = (bf16_t*)(wl + WL_UQ); t.ldw = 384; t.K = 192; t.k0 = (r >> 1) * 64; t.n0 = (r & 1) * 256; t.nvalid = 384; return t; } r -= TI_UQ;
    t.W = p.in[I_WUKV] + (size_t)l * 128 * 512; t.WT = (bf16_t*)(wl + WL_UKV); t.ldw = 512; t.K = 128; t.k0 = (r >> 1) * 64; t.n0 = (r & 1) * 256; t.nvalid = 512; return t;
}

__device__ __forceinline__ void transpose_items(const Ctx& C, int it0, int stride, int end) {
    int it = it0; f32x4 v[8];
    TItem cur; if (it < end) { cur = titem_make(C, it); titem_load(cur, C.wave, C.lane, v); }
    while (it < end) {
        titem_stage(C.lds, C.wave, C.lane, v);
        const int nx = it + stride; TItem nxt = cur; if (nx < end) { nxt = titem_make(C, nx); titem_load(nxt, C.wave, C.lane, v); }
        __syncthreads();
        titem_store(cur, C.lds, C.tid);
        __syncthreads();
        cur = nxt; it = nx;
    }
}

__device__ __forceinline__ void phase_prologue(const Ctx& C) {
    const Params& p = C.p;
    transpose_items(C, C.bid, C.G, (C.G == 256) ? TI_L : 4 * TI_L);
    {
        LAS float* sc = (LAS float*)C.lds;
        LAS float* red = (LAS float*)(C.lds + 5 * 1024 * 4);
        const int ub = C.G - 1 - C.bid;
        if (ub < 96) {
            size_t za = 0, zb = 0; asm volatile("" : "+s"(za), "+s"(zb));
            const float* cctx = p.in[I_CCTX] + za; const float* cc_ = p.in[I_C] + zb;
            for (int i = C.tid; i < 5120; i += NTHREADS) { const int j = i >> 10, k = i & 1023; const float v = (j == 0) ? cctx[k] : cc_[(j - 1) * 1024 + k]; sc[i] = v / (1.f + __expf(-v)); }
            __syncthreads();
            for (int u = ub; u < 96; u += C.G) {
                const int l = u / 24, cb = u % 24;
                const float* w = p.in[I_WADA] + ((size_t)l * 1024 + C.wave * 128) * 6144 + cb * 256 + 4 * C.lane;
                f32x4 a0 = {0.f, 0.f, 0.f, 0.f}, a1 = a0, a2 = a0, a3 = a0, a4 = a0;
#pragma unroll 16
                for (int k = 0; k < 128; ++k) { const f32x4 wv = *(const f32x4*)(w + (size_t)k * 6144); const int kk = C.wave * 128 + k;
                    a0 += wv * sc[kk]; a1 += wv * sc[1024 + kk]; a2 += wv * sc[2048 + kk]; a3 += wv * sc[3072 + kk]; a4 += wv * sc[4096 + kk]; }
                LAS f32x4* rw = (LAS f32x4*)(red + C.wave * 1280) + C.lane;
                rw[0] = a0; rw[64] = a1; rw[128] = a2; rw[192] = a3; rw[256] = a4;
                __syncthreads();
                for (int i = C.tid; i < 1280; i += NTHREADS) { const int j = i >> 8, c2 = i & 255; float sum = p.in[I_BADA][l * 6144 + cb * 256 + c2];
#pragma unroll
                    for (int ww = 0; ww < 8; ++ww) sum += red[ww * 1280 + i];
                    ((float*)(C.ws + WS_MOD))[(size_t)(l * 5 + j) * 6144 + cb * 256 + c2] = sum; }
                __syncthreads();
            }
        }
        __syncthreads();
    }
    {
        const int gt = C.bid * NTHREADS + C.tid, GT = C.G * NTHREADS;
        for (int i = gt; i < 4 * 65536; i += GT) { const int l = i >> 16, e = i & 65535; ((bf16_t*)(C.wl(l) + WL_SP))[e] = (bf16_t)f2bf(p.in[I_SPW][i]); }
        for (int i = gt; i < 4 * 160 * 1024 / 2; i += GT) { const int l = i / (160 * 512), e = i % (160 * 512); ((unsigned*)(C.wl(l) + WL_IN + (size_t)NP * D * 2))[e] = 0u; }
        for (int i = gt; i < 128 * 64; i += GT) { const int m = i >> 6, c = i & 63; const int idx = ((m & 63) * c) & 63; const float a = (float)idx / 32.f;
            ((bf16_t*)(C.ws + WS_F64))[i] = (bf16_t)f2bf(m < 64 ? cospif(a) : sinpif(a)); }
        for (int i = gt; i < 64 * 128; i += GT) { const int k = i >> 7, K = i & 127; const int idx = (k * (K & 63)) & 63; const float a = (float)idx / 32.f; const float cv = cospif(a), sv = sinpif(a);
            ((bf16_t*)(C.ws + WS_T64R))[i] = (bf16_t)f2bf(K < 64 ? cv : -sv);
            ((bf16_t*)(C.ws + WS_T64I))[i] = (bf16_t)f2bf(K < 64 ? -sv : -cv);
            ((bf16_t*)(C.ws + WS_T64B))[i] = (bf16_t)f2bf(K < 64 ? cv : sv); }
        for (int i = gt; i < 256 * 512; i += GT) { const int k = i >> 9, K = i & 511; const int idx = (k * (K & 255)) & 255; const float a = (float)idx / 128.f;
            ((bf16_t*)(C.ws + WS_T256))[i] = (bf16_t)f2bf(K < 256 ? cospif(a) : -sinpif(a)); }
        for (int i = gt; i < 4096; i += GT) { const float a = (float)i / 2048.f; ((f32x2*)(C.ws + WS_TW))[i] = (f32x2){cospif(a), sinpif(a)}; }
        for (int i = gt; i < 512; i += GT) { const int pos = i >> 3, f = i & 7; const float inv = powf(10000.f, -(float)f / 8.f); const float ang = (float)pos * inv;
            ((f32x2*)(C.ws + WS_ROPE))[i] = (f32x2){cosf(ang), sinf(ang)}; }
    }
}

__device__ __forceinline__ void load_row_f32(const float* rowp, int lane, f32x4 (&v)[4]) {
#pragma unroll
    for (int j = 0; j < 4; ++j) v[j] = *(const f32x4*)(rowp + 4 * lane + 256 * j);
}
__device__ __forceinline__ void load_row_bf16(const bf16_t* rowp, int lane, f32x4 (&v)[4]) {
#pragma unroll
    for (int j = 0; j < 4; ++j) { const u32x2 w = *(const u32x2*)(rowp + 4 * lane + 256 * j); v[j] = (f32x4){bflo(w.x), bfhi(w.x), bflo(w.y), bfhi(w.y)}; }
}
__device__ __forceinline__ float row_rstd(const f32x4 (&v)[4]) {
    float s = 0.f;
#pragma unroll
    for (int j = 0; j < 4; ++j) s += (v[j][0] * v[j][0] + v[j][1] * v[j][1]) + (v[j][2] * v[j][2] + v[j][3] * v[j][3]);
    return 1.f / sqrtf(wave_sum(s) * (1.f / 1024.f) + EPS);
}
__device__ __forceinline__ void norm_mod_store(const f32x4 (&x)[4], const float* g, const float* scale, const float* shift, bf16_t* orow, int lane) {
    const float rs = row_rstd(x);
#pragma unroll
    for (int j = 0; j < 4; ++j) { const int c = 4 * lane + 256 * j; const f32x4 gv = *(const f32x4*)(g + c), sv = *(const f32x4*)(scale + c), hv = *(const f32x4*)(shift + c);
        const f32x4 h = x[j] * rs * gv * (1.f + sv) + hv; *(u32x2*)(orow + c) = pk4(h); }
}
__device__ __forceinline__ void norm_mod_store_g(const f32x4 (&x)[4], const f32x4 (&gv)[4], const float* scale, const float* shift, bf16_t* orow, int lane) {
    const float rs = row_rstd(x);
#pragma unroll
    for (int j = 0; j < 4; ++j) { const int c = 4 * lane + 256 * j; const f32x4 sv = *(const f32x4*)(scale + c), hv = *(const f32x4*)(shift + c);
        const f32x4 h = x[j] * rs * gv[j] * (1.f + sv) + hv; *(u32x2*)(orow + c) = pk4(h); }
}
__device__ __forceinline__ const float* xin_row(const Ctx& C, int layer, int r) {
    if (layer > 0) return C.p.out + OUT_X + (size_t)r * D;
    size_t za = 0, zb = 0; asm volatile("" : "+s"(za), "+s"(zb));
    const float* a = C.p.in[I_XP] + za; const float* b = C.p.in[I_XS] + zb;
    return r < M_CTX ? a + (size_t)r * D : b + (size_t)(r - M_CTX) * D;
}
constexpr int SPLIT_ROW0 = 16384;
__device__ __forceinline__ void load_T(const bf16_t* T, const bf16_t* T1, bool split, int r, int lane, f32x4 (&v)[4]) {
    load_row_bf16(T + (size_t)r * D, lane, v);
    if (split && r >= SPLIT_ROW0) { f32x4 w[4]; load_row_bf16(T1 + (size_t)r * D, lane, w);
#pragma unroll
        for (int j = 0; j < 4; ++j) v[j] = v[j] + w[j]; }
}
__device__ __forceinline__ void phase_norm0(const Ctx& C) {
    const int gw = C.bid * NWAVES + C.wave, NGW = C.G * NWAVES;
    bf16_t* H = (bf16_t*)(C.ws + WS_R1);
    f32x4 xn[4]; load_row_f32(xin_row(C, 0, gw), C.lane, xn);
    for (int r = gw; r < M; r += NGW) { f32x4 x[4];
#pragma unroll
        for (int j = 0; j < 4; ++j) x[j] = xn[j];
        if (r + NGW < M) load_row_f32(xin_row(C, 0, r + NGW), C.lane, xn);
        const int mi = mod_of_row(r);
        norm_mod_store(x, C.p.in[I_GPM], C.mod(0, mi, 1), C.mod(0, mi, 0), H + (size_t)r * D, C.lane); }
}
template <int which  > __device__ __forceinline__ void phase_post(const Ctx& C, int layer) {
    const int gw = C.bid * NWAVES + C.wave, NGW = C.G * NWAVES;
    const bf16_t* T = (const bf16_t*)(C.ws + (which == 0 ? WS_R2 : WS_MLA));
    const bf16_t* T1 = T + (size_t)M * D - (size_t)SPLIT_ROW0 * D;
    const bool split = (C.G == 256);
    bf16_t* H = (bf16_t*)(C.ws + WS_R1);
    const float* gpost = (which == 0 ? C.p.in[I_GPOM] : C.p.in[I_GPOF]) + layer * D;
    const bool do_next = (which == 0) || (layer + 1 < DEPTH);
    const int nl = which == 0 ? layer : layer + 1;
    const float* gnext = (which == 0 ? C.p.in[I_GPF] : C.p.in[I_GPM]) + (nl < DEPTH ? nl : 0) * D;
    f32x4 gg[4], gs[4], sh[4]; int cur_mi = -1;
#pragma unroll
    for (int j = 0; j < 4; ++j) { gg[j] = (f32x4){0.f, 0.f, 0.f, 0.f}; gs[j] = gg[j]; sh[j] = gg[j]; }
    f32x4 tn[4], xn[4];
    load_T(T, T1, split, gw, C.lane, tn); load_row_f32(which == 0 ? xin_row(C, layer, gw) : C.p.out + OUT_X + (size_t)gw * D, C.lane, xn);
    for (int r = gw; r < M; r += NGW) {
        const int mi = mod_of_row(r);
        if (mi != cur_mi) { cur_mi = mi;
            const float* gate = C.mod(layer, mi, which == 0 ? 2 : 5); const float* scale = C.mod(nl, mi, which == 0 ? 4 : 1); const float* shift = C.mod(nl, mi, which == 0 ? 3 : 0);
#pragma unroll
            for (int j = 0; j < 4; ++j) { const int c = 4 * C.lane + 256 * j; gg[j] = *(const f32x4*)(gate + c) * *(const f32x4*)(gpost + c);
                if (do_next) { gs[j] = *(const f32x4*)(gnext + c) * (1.f + *(const f32x4*)(scale + c)); sh[j] = *(const f32x4*)(shift + c); } } }
        f32x4 t[4], x[4];
#pragma unroll
        for (int j = 0; j < 4; ++j) { t[j] = tn[j]; x[j] = xn[j]; }
        if (r + NGW < M) { const int rn = r + NGW; load_T(T, T1, split, rn, C.lane, tn); load_row_f32(which == 0 ? xin_row(C, layer, rn) : C.p.out + OUT_X + (size_t)rn * D, C.lane, xn); }
        const float rs = row_rstd(t);
        float* xo = C.p.out + OUT_X + (size_t)r * D;
#pragma unroll
        for (int j = 0; j < 4; ++j) { const int c = 4 * C.lane + 256 * j; x[j] = x[j] + gg[j] * (t[j] * rs); *(f32x4*)(xo + c) = x[j]; }
        if (do_next) { const float rs2 = row_rstd(x); bf16_t* orow = H + (size_t)r * D;
#pragma unroll
            for (int j = 0; j < 4; ++j) { const int c = 4 * C.lane + 256 * j; const f32x4 h = x[j] * rs2 * gs[j] + sh[j]; *(u32x2*)(orow + c) = pk4(h); } }
    }
}

__device__ __forceinline__ void unit_chunk_mlp(const Ctx& C, int layer, int u) {
    const int chunk = u >> 2, g = u & 3, r0 = chunk * 128;
    const bf16_t* PROJ = (const bf16_t*)(C.ws + WS_R2); bf16_t* MIX = (bf16_t*)(C.ws + WS_R1);
    constexpr int VS = 136;
    LAS bf16_t* Vt = (LAS bf16_t*)C.lds;
    { const int q = C.tid >> 2, c0 = (C.tid & 3) * 16; const bf16_t* src = PROJ + (size_t)(r0 + q) * NP + PC_V + g * 64 + c0;
      const bf16x8 v0 = *(const bf16x8*)src, v1 = *(const bf16x8*)(src + 8);
#pragma unroll
      for (int j = 0; j < 8; ++j) { Vt[(c0 + j) * VS + q] = (bf16_t)v0[j]; Vt[(c0 + 8 + j) * VS + q] = (bf16_t)v1[j]; } }
    __syncthreads();
    const int l15 = C.lane & 15, hq = C.lane >> 4, w = C.wave;
    const bf16_t* Wg = (const bf16_t*)(C.wl(layer) + WL_SP) + (size_t)g * 128 * 128;
    bf16x8 bw[4];
#pragma unroll
    for (int ks = 0; ks < 4; ++ks) bw[ks] = *(const bf16x8*)(Wg + (size_t)(w * 16 + l15) * 128 + ks * 32 + 8 * hq);
    const int p = w * 16 + l15; const float bias = C.p.in[I_SPB][(layer * 4 + g) * 128 + p];
#pragma unroll
    for (int ct = 0; ct < 4; ++ct) {
        f32x4 acc = {0.f, 0.f, 0.f, 0.f};
#pragma unroll
        for (int ks = 0; ks < 4; ++ks) { const bf16x8 a = *(const LAS bf16x8*)(Vt + (ct * 16 + l15) * VS + ks * 32 + 8 * hq); acc = mma16(a, bw[ks], acc); }
        const int cc = g * 64 + ct * 16 + 4 * hq; const u32x2 uw = *(const u32x2*)(PROJ + (size_t)(r0 + p) * NP + PC_U + cc);
        f32x4 o; o[0] = bflo(uw.x) * (acc[0] + bias); o[1] = bfhi(uw.x) * (acc[1] + bias); o[2] = bflo(uw.y) * (acc[2] + bias); o[3] = bfhi(uw.y) * (acc[3] + bias);
        *(u32x2*)(MIX + (size_t)(r0 + p) * D + cc) = pk4(o);
    }
    __syncthreads();
}
__device__ __forceinline__ void unit_conv(const Ctx& C, int layer, int u) {
    const bf16_t* PROJ = (const bf16_t*)(C.ws + WS_R2); bf16_t* MIX = (bf16_t*)(C.ws + WS_R1);
    const float* cw = C.p.in[I_CVW] + layer * 3 * 256; const float* cb = C.p.in[I_CVB] + layer * 256;
    for (int it = 0; it < 8; ++it) {
        const int item = it * NTHREADS + C.tid, t = item >> 5, ch = (item & 31) * 8, r = u * 128 + t;
        const int pos = r < M_CTX ? (r & 255) : ((r - M_CTX) & 4095), len = r < M_CTX ? 256 : 4096;
        const bf16_t* base = PROJ + (size_t)r * NP;
        const bf16x8 h1 = *(const bf16x8*)(base + PC_H + ch), c1 = *(const bf16x8*)(base + PC_C + ch), gb = *(const bf16x8*)(base + PC_B + ch);
        bf16x8 h0 = h1, c0 = c1, h2 = h1, c2 = c1; const bool hasp = pos > 0, hasn = pos < len - 1;
        if (hasp) { h0 = *(const bf16x8*)(base - NP + PC_H + ch); c0 = *(const bf16x8*)(base - NP + PC_C + ch); }
        if (hasn) { h2 = *(const bf16x8*)(base + NP + PC_H + ch); c2 = *(const bf16x8*)(base + NP + PC_C + ch); }
        float o[8];
#pragma unroll
        for (int j = 0; j < 8; ++j) {
            const float z0 = hasp ? bf1((bf16_t)h0[j]) * bf1((bf16_t)c0[j]) : 0.f, z1 = bf1((bf16_t)h1[j]) * bf1((bf16_t)c1[j]), z2 = hasn ? bf1((bf16_t)h2[j]) * bf1((bf16_t)c2[j]) : 0.f;
            const float y = z0 * cw[ch + j] + z1 * cw[256 + ch + j] + z2 * cw[512 + ch + j] + cb[ch + j];
            o[j] = bf1((bf16_t)gb[j]) * y; }
        u32x4 w; w.x = pk2(o[0], o[1]); w.y = pk2(o[2], o[3]); w.z = pk2(o[4], o[5]); w.w = pk2(o[6], o[7]);
        *(u32x4*)(MIX + (size_t)r * D + 256 + ch) = w;
    }
}
__device__ __forceinline__ void unit_fourier_ctx(const Ctx& C, int u) {
    const int s = u >> 2, g = u & 3, l15 = C.lane & 15, hq = C.lane >> 4, w = C.wave;
    const bf16_t* PROJ = (const bf16_t*)(C.ws + WS_R2); bf16_t* MIX = (bf16_t*)(C.ws + WS_R1);
    const bf16_t* F64 = (const bf16_t*)(C.ws + WS_F64); const bf16_t* T256 = (const bf16_t*)(C.ws + WS_T256);
    constexpr int ZS = 520; LAS bf16_t* Zt = (LAS bf16_t*)C.lds;
#pragma unroll
    for (int i = 0; i < 2; ++i) { const int nt = 2 * w + i;
        bf16x8 a[2];
#pragma unroll
        for (int ks = 0; ks < 2; ++ks) a[ks] = *(const bf16x8*)(PROJ + (size_t)(s * 256 + nt * 16 + l15) * NP + PC_F + g * 64 + ks * 32 + 8 * hq);
#pragma unroll
        for (int mt = 0; mt < 8; ++mt) { f32x4 acc = {0.f, 0.f, 0.f, 0.f};
#pragma unroll
            for (int ks = 0; ks < 2; ++ks) { const bf16x8 b = *(const bf16x8*)(F64 + (size_t)(mt * 16 + l15) * 64 + ks * 32 + 8 * hq); acc = mma16(a[ks], b, acc); }
            const int mp = mt * 16 + l15;
            *(LAS u32x2*)(Zt + (mp & 63) * ZS + (mp >> 6) * 256 + nt * 16 + 4 * hq) = pk4(acc); } }
    __syncthreads();
#pragma unroll 1
    for (int i = 0; i < 2; ++i) { const int kt = 2 * w + i;
        f32x4 acc[4];
#pragma unroll
        for (int mt = 0; mt < 4; ++mt) acc[mt] = (f32x4){0.f, 0.f, 0.f, 0.f};
#pragma unroll 8
        for (int ks = 0; ks < 16; ++ks) { const bf16x8 b = *(const bf16x8*)(T256 + (size_t)(kt * 16 + l15) * 512 + ks * 32 + 8 * hq);
#pragma unroll
            for (int mt = 0; mt < 4; ++mt) { const bf16x8 a = *(const LAS bf16x8*)(Zt + (mt * 16 + l15) * ZS + ks * 32 + 8 * hq); acc[mt] = mma16(a, b, acc[mt]); } }
#pragma unroll
        for (int mt = 0; mt < 4; ++mt) *(u32x2*)(MIX + (size_t)(s * 256 + kt * 16 + l15) * D + 512 + g * 64 + mt * 16 + 4 * hq) = pk4(acc[mt] * (1.f / 128.f)); }
    __syncthreads();
}
__device__ __forceinline__ void unit_fourier_lat1(const Ctx& C, int u) {
    const int b = u >> 5, g = (u >> 3) & 3, nb = u & 7, l15 = C.lane & 15, hq = C.lane >> 4, n2 = nb * 8 + C.wave;
    const bf16_t* PROJ = (const bf16_t*)(C.ws + WS_R2);
    const bf16_t* F64 = (const bf16_t*)(C.ws + WS_F64); const bf16_t* T64R = (const bf16_t*)(C.ws + WS_T64R); const bf16_t* T64I = (const bf16_t*)(C.ws + WS_T64I);
    const f32x2* TW = (const f32x2*)(C.ws + WS_TW);
    bf16_t* GB = (bf16_t*)(C.ws + WS_GB) + (size_t)((b * 4 + g) * 64 + n2) * 64 * 128;
    constexpr int ZS = 136; LAS bf16_t* Zt = (LAS bf16_t*)(C.lds + C.wave * (64 * ZS * 2));
#pragma unroll 2
    for (int nt = 0; nt < 4; ++nt) {
        bf16x8 a[2];
#pragma unroll
        for (int ks = 0; ks < 2; ++ks) a[ks] = *(const bf16x8*)(PROJ + (size_t)(M_CTX + b * 4096 + (nt * 16 + l15) * 64 + n2) * NP + PC_F + g * 64 + ks * 32 + 8 * hq);
#pragma unroll
        for (int mt = 0; mt < 8; ++mt) { f32x4 acc = {0.f, 0.f, 0.f, 0.f};
#pragma unroll
            for (int ks = 0; ks < 2; ++ks) { const bf16x8 bb = *(const bf16x8*)(F64 + (size_t)(mt * 16 + l15) * 64 + ks * 32 + 8 * hq); acc = mma16(a[ks], bb, acc); }
            const int mp = mt * 16 + l15;
            *(LAS u32x2*)(Zt + (mp & 63) * ZS + (mp >> 6) * 64 + nt * 16 + 4 * hq) = pk4(acc); } }
    asm volatile("s_waitcnt lgkmcnt(0)" ::: "memory");
#pragma unroll 2
    for (int kt = 0; kt < 4; ++kt) {
        bf16x8 br[4], bi[4];
#pragma unroll
        for (int ks = 0; ks < 4; ++ks) { br[ks] = *(const bf16x8*)(T64R + (size_t)(kt * 16 + l15) * 128 + ks * 32 + 8 * hq); bi[ks] = *(const bf16x8*)(T64I + (size_t)(kt * 16 + l15) * 128 + ks * 32 + 8 * hq); }
        const int k1 = kt * 16 + l15; const f32x2 tw = TW[k1 * n2];
#pragma unroll
        for (int mt = 0; mt < 4; ++mt) { f32x4 ar = {0.f, 0.f, 0.f, 0.f}, ai = {0.f, 0.f, 0.f, 0.f};
#pragma unroll
            for (int ks = 0; ks < 4; ++ks) { const bf16x8 a = *(const LAS bf16x8*)(Zt + (mt * 16 + l15) * ZS + ks * 32 + 8 * hq); ar = mma16(a, br[ks], ar); ai = mma16(a, bi[ks], ai); }
            const f32x4 gr = ar * tw[0] + ai * tw[1], gi = ai * tw[0] - ar * tw[1];
            bf16_t* dst = GB + (size_t)k1 * 128 + mt * 16 + 4 * hq;
            *(u32x2*)dst = pk4(gr); *(u32x2*)(dst + 64) = pk4(gi); } }
    __syncthreads();
}
__device__ __forceinline__ void unit_fourier_lat2(const Ctx& C, int u) {
    const int b = u >> 5, g = (u >> 3) & 3, kb = u & 7, l15 = C.lane & 15, hq = C.lane >> 4, k1 = kb * 8 + C.wave;
    const bf16_t* T64B = (const bf16_t*)(C.ws + WS_T64B); bf16_t* MIX = (bf16_t*)(C.ws + WS_R1);
    const bf16_t* GB = (const bf16_t*)(C.ws + WS_GB) + (size_t)((b * 4 + g) * 64) * 64 * 128 + (size_t)k1 * 128;
    constexpr int ZS = 136; LAS bf16_t* Tt = (LAS bf16_t*)(C.lds + C.wave * (64 * ZS * 2));
#pragma unroll 4
    for (int it = 0; it < 16; ++it) { const int q = it * 64 + C.lane, n2 = q >> 4, cc = q & 15, part = cc >> 3, m0 = (cc & 7) * 8;
        const bf16x8 v = *(const bf16x8*)(GB + (size_t)n2 * 64 * 128 + cc * 8);
#pragma unroll
        for (int j = 0; j < 8; ++j) Tt[(m0 + j) * ZS + part * 64 + n2] = (bf16_t)v[j]; }
    asm volatile("s_waitcnt lgkmcnt(0)" ::: "memory");
#pragma unroll 2
    for (int kt = 0; kt < 4; ++kt) {
        bf16x8 bb[4];
#pragma unroll
        for (int ks = 0; ks < 4; ++ks) bb[ks] = *(const bf16x8*)(T64B + (size_t)(kt * 16 + l15) * 128 + ks * 32 + 8 * hq);
        const int k2 = kt * 16 + l15; const int row = M_CTX + b * 4096 + k1 + 64 * k2;
#pragma unroll
        for (int mt = 0; mt < 4; ++mt) { f32x4 acc = {0.f, 0.f, 0.f, 0.f};
#pragma unroll
            for (int ks = 0; ks < 4; ++ks) { const bf16x8 a = *(const LAS bf16x8*)(Tt + (mt * 16 + l15) * ZS + ks * 32 + 8 * hq); acc = mma16(a, bb[ks], acc); }
            *(u32x2*)(MIX + (size_t)row * D + 512 + g * 64 + mt * 16 + 4 * hq) = pk4(acc * (1.f / 512.f)); } }
    __syncthreads();
}
constexpr float QSCALE = 0.10206207261596577f * 1.4426950408889634f;
__device__ __forceinline__ void unit_mla_prep(const Ctx& C, int layer, int u) {
    const Params& p = C.p;
    const bf16_t* PROJ = (const bf16_t*)(C.ws + WS_R2);
    bf16_t* Q = (bf16_t*)(C.ws + WS_Q); bf16_t* KN = (bf16_t*)(C.ws + WS_KN); bf16_t* VT = (bf16_t*)(C.ws + WS_VT); bf16_t* KR = (bf16_t*)(C.ws + WS_KR);
    const f32x2* ROPE = (const f32x2*)(C.ws + WS_ROPE);
    constexpr int QS = 200, KS = 136;
    LAS bf16_t* CQ = (LAS bf16_t*)C.lds;
    LAS bf16_t* CK = (LAS bf16_t*)(C.lds + 128 * QS * 2);
    const bool is_tok = u < 192;
    int r0 = 0, keyrow0, keypos0, nk; size_t vtbase; bool lat;
    if (is_tok) { r0 = u * 128; lat = r0 >= M_CTX;
        if (!lat) { keyrow0 = r0; keypos0 = r0 & 255; nk = 256; vtbase = (size_t)(r0 & ~255) * 256; }
        else { const int b = (r0 - M_CTX) >> 12, n = (r0 - M_CTX) & 4095; keyrow0 = M_CTX + b * 4352 + n; keypos0 = n; nk = 4352; vtbase = (size_t)(M_CTX + b * 4352) * 256; } }
    else { const int cu = u - 192, b = cu >> 1, half = cu & 1; lat = true; keyrow0 = M_CTX + b * 4352 + 4096 + half * 128; keypos0 = 4096 + half * 128; nk = 4352; vtbase = (size_t)(M_CTX + b * 4352) * 256; }
    { const int t = C.tid >> 2, sub = C.tid & 3;
      if (is_tok) {
        const int r = r0 + t; const bf16_t* base = PROJ + (size_t)r * NP;
        float q[48], k[32]; float sq = 0.f, sk = 0.f;
#pragma unroll
        for (int i = 0; i < 6; ++i) { const bf16x8 v = *(const bf16x8*)(base + PC_Q + sub * 48 + i * 8);
#pragma unroll
            for (int j = 0; j < 8; ++j) { q[i * 8 + j] = bf1((bf16_t)v[j]); sq += q[i * 8 + j] * q[i * 8 + j]; } }
#pragma unroll
        for (int i = 0; i < 4; ++i) { const bf16x8 v = *(const bf16x8*)(base + PC_KV + sub * 32 + i * 8);
#pragma unroll
            for (int j = 0; j < 8; ++j) { k[i * 8 + j] = bf1((bf16_t)v[j]); sk += k[i * 8 + j] * k[i * 8 + j]; } }
        sq += __shfl_xor(sq, 1); sq += __shfl_xor(sq, 2); sk += __shfl_xor(sk, 1); sk += __shfl_xor(sk, 2);
        const float rq = 1.f / sqrtf(sq * (1.f / 192.f) + EPS), rk = 1.f / sqrtf(sk * (1.f / 128.f) + EPS);
        const float* gq = p.in[I_GQ] + layer * 192 + sub * 48; const float* gk = p.in[I_GKV] + layer * 128 + sub * 32;
#pragma unroll
        for (int i = 0; i < 6; ++i) { u32x4 w; w.x = pk2(q[i * 8 + 0] * rq * gq[i * 8 + 0], q[i * 8 + 1] * rq * gq[i * 8 + 1]); w.y = pk2(q[i * 8 + 2] * rq * gq[i * 8 + 2], q[i * 8 + 3] * rq * gq[i * 8 + 3]);
            w.z = pk2(q[i * 8 + 4] * rq * gq[i * 8 + 4], q[i * 8 + 5] * rq * gq[i * 8 + 5]); w.w = pk2(q[i * 8 + 6] * rq * gq[i * 8 + 6], q[i * 8 + 7] * rq * gq[i * 8 + 7]);
            *(LAS u32x4*)(CQ + t * QS + sub * 48 + i * 8) = w; }
        float* sckv = nullptr;
        if (!lat) { const int s = r >> 8, pos = r & 255; sckv = p.out + OUT_CKV + ((size_t)(s * 4 + layer) * 256 + pos) * 128 + sub * 32; }
#pragma unroll
        for (int i = 0; i < 4; ++i) { float o[8];
#pragma unroll
            for (int j = 0; j < 8; ++j) o[j] = k[i * 8 + j] * rk * gk[i * 8 + j];
            u32x4 w; w.x = pk2(o[0], o[1]); w.y = pk2(o[2], o[3]); w.z = pk2(o[4], o[5]); w.w = pk2(o[6], o[7]);
            *(LAS u32x4*)(CK + t * KS + sub * 32 + i * 8) = w;
            if (!lat) { *(f32x4*)(sckv + i * 8) = (f32x4){o[0], o[1], o[2], o[3]}; *(f32x4*)(sckv + i * 8 + 4) = (f32x4){o[4], o[5], o[6], o[7]}; } }
        { const bf16x8 v = *(const bf16x8*)(base + PC_KR + sub * 8); float x[8], o[8];
#pragma unroll
          for (int j = 0; j < 8; ++j) x[j] = bf1((bf16_t)v[j]);
          if (lat) { const int n = (r - M_CTX) & 4095; const int pos = (sub >> 1) == 0 ? (n >> 6) : (n & 63);
#pragma unroll
              for (int j = 0; j < 8; ++j) { const float pr = __shfl_xor(x[j], 1); const f32x2 cs = ROPE[pos * 8 + j]; o[j] = (sub & 1) == 0 ? x[j] * cs[0] - pr * cs[1] : x[j] * cs[0] + pr * cs[1]; } }
          else {
#pragma unroll
              for (int j = 0; j < 8; ++j) o[j] = x[j];
              const int s = r >> 8, pos = r & 255; float* skr = p.out + OUT_KR + ((size_t)(s * 4 + layer) * 256 + pos) * 32 + sub * 8;
              *(f32x4*)skr = (f32x4){o[0], o[1], o[2], o[3]}; *(f32x4*)(skr + 4) = (f32x4){o[4], o[5], o[6], o[7]}; }
          u32x4 w; w.x = pk2(o[0], o[1]); w.y = pk2(o[2], o[3]); w.z = pk2(o[4], o[5]); w.w = pk2(o[6], o[7]);
          *(u32x4*)(KR + (size_t)(keyrow0 + t) * 32 + sub * 8) = w; }
      } else {
        const int cu = u - 192, b = cu >> 1, half = cu & 1, row = half * 128 + t;
        const float* src = p.in[I_CCKV] + ((size_t)(b * 4 + layer) * 256 + row) * 128 + sub * 32;
#pragma unroll
        for (int i = 0; i < 4; ++i) { const f32x4 v0 = *(const f32x4*)(src + i * 8), v1 = *(const f32x4*)(src + i * 8 + 4);
            u32x4 w; w.x = pk2(v0[0], v0[1]); w.y = pk2(v0[2], v0[3]); w.z = pk2(v1[0], v1[1]); w.w = pk2(v1[2], v1[3]);
            *(LAS u32x4*)(CK + t * KS + sub * 32 + i * 8) = w; }
        const float* ksrc = p.in[I_CKR] + ((size_t)(b * 4 + layer) * 256 + row) * 32 + sub * 8;
        const f32x4 v0 = *(const f32x4*)ksrc, v1 = *(const f32x4*)(ksrc + 4);
        u32x4 w; w.x = pk2(v0[0], v0[1]); w.y = pk2(v0[2], v0[3]); w.z = pk2(v1[0], v1[1]); w.w = pk2(v1[2], v1[3]);
        *(u32x4*)(KR + (size_t)(keyrow0 + t) * 32 + sub * 8) = w;
      } }
    __syncthreads();
    const int l15 = C.lane & 15, hq = C.lane >> 4, w = C.wave;
    if (is_tok) {
        const bf16_t* Wq = (const bf16_t*)(C.wl(layer) + WL_UQ);
        bf16x8 aq[3][6];
#pragma unroll
        for (int j = 0; j < 3; ++j)
#pragma unroll
            for (int ks = 0; ks < 6; ++ks) aq[j][ks] = *(const bf16x8*)(Wq + (size_t)((3 * w + j) * 16 + l15) * 192 + ks * 32 + 8 * hq);
#pragma unroll 2
        for (int tt = 0; tt < 8; ++tt) {
            bf16x8 bq[6];
#pragma unroll
            for (int ks = 0; ks < 6; ++ks) bq[ks] = *(const LAS bf16x8*)(CQ + (tt * 16 + l15) * QS + ks * 32 + 8 * hq);
            const int r = r0 + tt * 16 + l15; const int n = (r - M_CTX) & 4095;
#pragma unroll
            for (int j = 0; j < 3; ++j) { const int nt = 3 * w + j; f32x4 acc = {0.f, 0.f, 0.f, 0.f};
#pragma unroll
                for (int ks = 0; ks < 6; ++ks) acc = mma16(aq[j][ks], bq[ks], acc);
                const int sub6 = nt % 6;
                if (lat && sub6 >= 4) { const int pos = sub6 == 4 ? (n >> 6) : (n & 63);
#pragma unroll
                    for (int jj = 0; jj < 4; ++jj) { const float pr = __shfl_xor(acc[jj], 32); const f32x2 cs = ROPE[pos * 8 + ((4 * hq + jj) & 7)]; acc[jj] = hq < 2 ? acc[jj] * cs[0] - pr * cs[1] : acc[jj] * cs[0] + pr * cs[1]; } }
                *(u32x2*)(Q + (size_t)r * 384 + nt * 16 + 4 * hq) = pk4(acc * QSCALE); }
        }
    }
    { const bf16_t* Wkv = (const bf16_t*)(C.wl(layer) + WL_UKV);
      bf16x8 wf[4][4];
#pragma unroll
      for (int j = 0; j < 4; ++j)
#pragma unroll
          for (int ks = 0; ks < 4; ++ks) wf[j][ks] = *(const bf16x8*)(Wkv + (size_t)((4 * w + j) * 16 + l15) * 128 + ks * 32 + 8 * hq);
      const int h = w >> 1; const bool isv = (w & 1) != 0;
#pragma unroll 2
      for (int tt = 0; tt < 8; ++tt) {
          bf16x8 ck[4];
#pragma unroll
          for (int ks = 0; ks < 4; ++ks) ck[ks] = *(const LAS bf16x8*)(CK + (tt * 16 + l15) * KS + ks * 32 + 8 * hq);
#pragma unroll
          for (int j = 0; j < 4; ++j) { f32x4 acc = {0.f, 0.f, 0.f, 0.f};
              if (!isv) {
#pragma unroll
                  for (int ks = 0; ks < 4; ++ks) acc = mma16(wf[j][ks], ck[ks], acc);
                  *(u32x2*)(KN + (size_t)(keyrow0 + tt * 16 + l15) * 256 + h * 64 + j * 16 + 4 * hq) = pk4(acc);
              } else {
#pragma unroll
                  for (int ks = 0; ks < 4; ++ks) acc = mma16(ck[ks], wf[j][ks], acc);
                  *(u32x2*)(VT + vtbase + (size_t)(h * 64 + j * 16 + l15) * nk + keypos0 + tt * 16 + 4 * hq) = pk4(acc);
              } } } }
    __syncthreads();
}

constexpr int AKS = 104, AVS = 72;
constexpr int ABUF = 64 * AKS * 2 + 64 * AVS * 2;
__device__ __forceinline__ int imax3(int a, int b, int c) { return max(a, max(b, c)); }
constexpr int AVS2 = 136; constexpr int ABUF2 = 128 * AKS * 2 + 64 * AVS2 * 2;
__device__ __forceinline__ void unit_attention(const Ctx& C, int u) {
    int rowbase, keyrow0, nk, h; size_t vtbase;
    if (u < 128) { const int s = u >> 2; h = u & 3; rowbase = s * 256; keyrow0 = s * 256; nk = 256; vtbase = (size_t)(s * 256) * 256; }
    else { const int v0 = u - 128; const int v = (C.G == 256) ? (((v0 & 7) * 2 + (v0 >> 7)) << 4) | ((v0 >> 3) & 15) : v0;
           const int b = v >> 6, qb = v & 15; h = (v >> 4) & 3; rowbase = M_CTX + b * 4096 + qb * 256; keyrow0 = M_CTX + b * 4352; nk = 4352; vtbase = (size_t)keyrow0 * 256; }
    const bf16_t* Q = (const bf16_t*)(C.ws + WS_Q); const bf16_t* KN = (const bf16_t*)(C.ws + WS_KN); const bf16_t* VT = (const bf16_t*)(C.ws + WS_VT); const bf16_t* KR = (const bf16_t*)(C.ws + WS_KR);
    bf16_t* MIX = (bf16_t*)(C.ws + WS_R1);
    const int l31 = C.lane & 31, hh = C.lane >> 5; const int qrow = rowbase + C.wave * 32 + l31;
    bf16x8 qf[6];
#pragma unroll
    for (int ks = 0; ks < 6; ++ks) qf[ks] = *(const bf16x8*)(Q + (size_t)qrow * 384 + h * 96 + ks * 16 + 8 * hh);
    f32x16 o0, o1, o2, negm;
#pragma unroll
    for (int i = 0; i < 16; ++i) { o0[i] = 0.f; o1[i] = 0.f; o2[i] = 0.f; negm[i] = 0.f; }
    const unsigned onew = (l31 == 0) ? 0x3F803F80u : 0u;
    const bf16x8 onesf = __builtin_bit_cast(bf16x8, (u32x4){onew, onew, onew, onew});
    const int skey = C.tid >> 3, sc8 = (C.tid & 7) * 8, rkey = (C.tid & 255) >> 2, rc8 = (C.tid & 3) * 8;
    const bf16_t* gkn = KN + (size_t)(keyrow0 + skey) * 256 + h * 64 + sc8;
    const bf16_t* gkr = KR + (size_t)(keyrow0 + rkey) * 32 + rc8;
    const bf16_t* gvt = VT + vtbase + (size_t)(h * 64 + skey) * nk + sc8;
    const bool do_r = C.tid < 256;
    const int lkn = (skey * AKS + sc8) * 2, lkr = (rkey * AKS + 64 + rc8) * 2, lvt = 128 * AKS * 2 + (skey * AVS2 + sc8) * 2;
    const int ntile = nk >> 7;
    u32x4 rk[2], rr[2] = {{0u, 0u, 0u, 0u}, {0u, 0u, 0u, 0u}}, rv[2];
#define ATT_LD(t) do { _Pragma("unroll") for (int s_ = 0; s_ < 2; ++s_) { rk[s_] = *(const u32x4*)(gkn + (size_t)(2 * (t) + s_) * 64 * 256); if (do_r) rr[s_] = *(const u32x4*)(gkr + (size_t)(2 * (t) + s_) * 64 * 32); rv[s_] = *(const u32x4*)(gvt + (2 * (t) + s_) * 64); } } while (0)
#define ATT_ST(buf) do { LAS unsigned char* b_ = C.lds + (buf) * ABUF2; _Pragma("unroll") for (int s_ = 0; s_ < 2; ++s_) { *(LAS u32x4*)(b_ + lkn + s_ * 64 * AKS * 2) = rk[s_]; if (do_r) *(LAS u32x4*)(b_ + lkr + s_ * 64 * AKS * 2) = rr[s_]; *(LAS u32x4*)(b_ + lvt + s_ * 128) = rv[s_]; } } while (0)
    ATT_LD(0); ATT_ST(0);
    __syncthreads();
#pragma unroll 1
    for (int kt = 0; kt < ntile; ++kt) {
        const bool more = kt + 1 < ntile;
        if (more) ATT_LD(kt + 1);
        LAS unsigned char* B = C.lds + (kt & 1) * ABUF2;
#pragma unroll 1
        for (int sub = 0; sub < 2; ++sub) {
        const LAS bf16_t* Kl = (const LAS bf16_t*)B + sub * 64 * AKS; const LAS bf16_t* Vl = (const LAS bf16_t*)(B + 128 * AKS * 2) + sub * 64;
        bf16x8 ka[2][6];
#pragma unroll
        for (int ks = 0; ks < 6; ++ks) { ka[0][ks] = *(const LAS bf16x8*)(Kl + l31 * AKS + ks * 16 + 8 * hh); ka[1][ks] = *(const LAS bf16x8*)(Kl + (32 + l31) * AKS + ks * 16 + 8 * hh); }
        __builtin_amdgcn_sched_barrier(0);
        f32x16 s0 = mma32(ka[0][0], qf[0], negm), s1 = mma32(ka[1][0], qf[0], negm);
#pragma unroll
        for (int ks = 1; ks < 6; ++ks) { s0 = mma32(ka[0][ks], qf[ks], s0); s1 = mma32(ka[1][ks], qf[ks], s1); }
        __builtin_amdgcn_sched_barrier(0);
        u32x2 vr[2][2][4];
#pragma unroll
        for (int t = 0; t < 2; ++t)
#pragma unroll
            for (int ss = 0; ss < 2; ++ss) { const int ko = 32 * t + 16 * ss + 4 * hh;
                vr[t][ss][0] = *(const LAS u32x2*)(Vl + l31 * AVS2 + ko); vr[t][ss][1] = *(const LAS u32x2*)(Vl + l31 * AVS2 + ko + 8);
                vr[t][ss][2] = *(const LAS u32x2*)(Vl + (32 + l31) * AVS2 + ko); vr[t][ss][3] = *(const LAS u32x2*)(Vl + (32 + l31) * AVS2 + ko + 8); }
        __builtin_amdgcn_sched_barrier(0);
        float d; bool resc;
        if (kt == 0 && sub == 0) {
            float mx = fmaxf(s0[0], s1[0]);
#pragma unroll
            for (int i = 1; i < 16; ++i) mx = fmaxf(mx, fmaxf(s0[i], s1[i]));
            d = fmaxf(mx, __shfl_xor(mx, 32)); resc = true;
        } else {
            int im = imax3(__builtin_bit_cast(int, s0[0]), __builtin_bit_cast(int, s1[0]), __builtin_bit_cast(int, s0[1]));
            im = imax3(im, __builtin_bit_cast(int, s1[1]), __builtin_bit_cast(int, s0[2])); im = imax3(im, __builtin_bit_cast(int, s1[2]), __builtin_bit_cast(int, s0[3]));
            im = imax3(im, __builtin_bit_cast(int, s1[3]), __builtin_bit_cast(int, s0[4])); im = imax3(im, __builtin_bit_cast(int, s1[4]), __builtin_bit_cast(int, s0[5]));
            im = imax3(im, __builtin_bit_cast(int, s1[5]), __builtin_bit_cast(int, s0[6])); im = imax3(im, __builtin_bit_cast(int, s1[6]), __builtin_bit_cast(int, s0[7]));
            im = imax3(im, __builtin_bit_cast(int, s1[7]), __builtin_bit_cast(int, s0[8])); im = imax3(im, __builtin_bit_cast(int, s1[8]), __builtin_bit_cast(int, s0[9]));
            im = imax3(im, __builtin_bit_cast(int, s1[9]), __builtin_bit_cast(int, s0[10])); im = imax3(im, __builtin_bit_cast(int, s1[10]), __builtin_bit_cast(int, s0[11]));
            im = imax3(im, __builtin_bit_cast(int, s1[11]), __builtin_bit_cast(int, s0[12])); im = imax3(im, __builtin_bit_cast(int, s1[12]), __builtin_bit_cast(int, s0[13]));
            im = imax3(im, __builtin_bit_cast(int, s1[13]), __builtin_bit_cast(int, s0[14])); im = imax3(im, __builtin_bit_cast(int, s1[14]), __builtin_bit_cast(int, s0[15]));
            im = max(im, __builtin_bit_cast(int, s1[15]));
            im = max(im, __shfl_xor(im, 32));
            resc = __builtin_amdgcn_ballot_w64(im > 0x41000000) != 0ull; d = im > 0x41000000 ? __builtin_bit_cast(float, im) : 0.f;
        }
        if (resc) {
            if (kt != 0 || sub != 0) { const float alpha = __builtin_amdgcn_exp2f(-d); o0 = o0 * alpha; o1 = o1 * alpha; o2 = o2 * alpha; }
            negm = negm - d; s0 = s0 - d; s1 = s1 - d;
        }
#pragma unroll
        for (int i = 0; i < 16; ++i) { s0[i] = __builtin_amdgcn_exp2f(s0[i]); s1[i] = __builtin_amdgcn_exp2f(s1[i]); }
#pragma unroll
        for (int t = 0; t < 2; ++t)
#pragma unroll
            for (int ss = 0; ss < 2; ++ss) {
                u32x4 w;
                if (t == 0) { w.x = pk2(s0[8 * ss + 0], s0[8 * ss + 1]); w.y = pk2(s0[8 * ss + 2], s0[8 * ss + 3]); w.z = pk2(s0[8 * ss + 4], s0[8 * ss + 5]); w.w = pk2(s0[8 * ss + 6], s0[8 * ss + 7]); }
                else { w.x = pk2(s1[8 * ss + 0], s1[8 * ss + 1]); w.y = pk2(s1[8 * ss + 2], s1[8 * ss + 3]); w.z = pk2(s1[8 * ss + 4], s1[8 * ss + 5]); w.w = pk2(s1[8 * ss + 6], s1[8 * ss + 7]); }
                const bf16x8 pf = __builtin_bit_cast(bf16x8, w);
                const bf16x8 va = __builtin_bit_cast(bf16x8, (u32x4){vr[t][ss][0].x, vr[t][ss][0].y, vr[t][ss][1].x, vr[t][ss][1].y}), vb = __builtin_bit_cast(bf16x8, (u32x4){vr[t][ss][2].x, vr[t][ss][2].y, vr[t][ss][3].x, vr[t][ss][3].y});
                o0 = mma32(va, pf, o0); o1 = mma32(vb, pf, o1); o2 = mma32(onesf, pf, o2);
            }
        }
        if (more) ATT_ST((kt + 1) & 1);
        __syncthreads();
    }
#undef ATT_LD
#undef ATT_ST
    const float lsum = o2[0] + __shfl_xor(o2[0], 32);
    const float inv = 1.f / lsum;
    bf16_t* orow = MIX + (size_t)qrow * D + 768 + h * 64;
#pragma unroll
    for (int i = 0; i < 4; ++i) { const int dv = 8 * i + 4 * hh;
        *(u32x2*)(orow + dv) = pk4((f32x4){o0[4 * i] * inv, o0[4 * i + 1] * inv, o0[4 * i + 2] * inv, o0[4 * i + 3] * inv});
        *(u32x2*)(orow + 32 + dv) = pk4((f32x4){o1[4 * i] * inv, o1[4 * i + 1] * inv, o1[4 * i + 2] * inv, o1[4 * i + 3] * inv}); }
}

#define XB_TMO      128
#define XB_XCNT(j)  (256  + 64 * (j))
#define XB_XSUB(j)  (1280 + 64 * (j))
#define XB_XGEN(j)  (2304 + 64 * (j))
#define XB_TOP      3328
#define XB_TOPGEN   3392
#define XCD_BAR_WORDS 3456
#define XB_SPIN_CAP (1u << 18)

__device__ __forceinline__ unsigned xb_ld(unsigned* p)              { return __hip_atomic_load(p, __ATOMIC_RELAXED, __HIP_MEMORY_SCOPE_AGENT); }
__device__ __forceinline__ unsigned xb_add(unsigned* p, unsigned v) { return __hip_atomic_fetch_add(p, v, __ATOMIC_RELAXED, __HIP_MEMORY_SCOPE_AGENT); }
__device__ __forceinline__ unsigned xb_xcc_id() { return (unsigned)__builtin_amdgcn_s_getreg((3 << 11) | 20) & 0xFu; }
#define XB_SPIN(cond, bar) do { unsigned _sp = 0; while (cond) { __builtin_amdgcn_s_sleep(1); \
    if ((++_sp & 255u) == 0u) { if (xb_ld(&(bar)[XB_TMO])) break; if (_sp > XB_SPIN_CAP) { atomicAdd(&(bar)[XB_TMO], 1u); break; } } } } while (0)

struct XcdBarrier {
    unsigned* bar; unsigned x;
    volatile LAS unsigned* st;
};

__device__ __forceinline__ XcdBarrier xcd_barrier_post(unsigned* bar, volatile LAS unsigned* st) {
    XcdBarrier b; b.bar = bar; b.x = xb_xcc_id(); b.st = st;
    if (threadIdx.x == 0) (void)xb_add(&bar[XB_XCNT(b.x)], 1u);
    return b;
}
__device__ __forceinline__ void xcd_barrier_complete(unsigned* bar, unsigned x, unsigned& nloc, unsigned& nx) {
    const unsigned G = gridDim.x * gridDim.y * gridDim.z;
    unsigned sum, cnt, mine, sp = 0u;
    for (;;) {
        sum = 0u; cnt = 0u; mine = 0u;
#pragma unroll
        for (unsigned j = 0; j < 16; ++j) { const unsigned c = xb_ld(&bar[XB_XCNT(j)]); sum += c; cnt += (c > 0u) ? 1u : 0u; mine = (j == x) ? c : mine; }
        if (sum == G) break;
        __builtin_amdgcn_s_sleep(1);
        if ((++sp & 255u) == 0u) { if (xb_ld(&bar[XB_TMO])) break; if (sp > XB_SPIN_CAP) { atomicAdd(&bar[XB_TMO], 1u); break; } }
    }
    nloc = mine > 0u ? mine : 1u; nx = cnt > 0u ? cnt : 1u;
}

__device__ __forceinline__ void xcd_barrier(const XcdBarrier& b) {
    asm volatile("s_waitcnt vmcnt(0)" ::: "memory");
    __syncthreads();
    if (threadIdx.x == 0) {
        unsigned* bar = b.bar;
        __builtin_amdgcn_s_waitcnt(0);
        unsigned nloc = b.st[0], nx = b.st[1];
        if (nloc == 0u) { xcd_barrier_complete(bar, b.x, nloc, nx); b.st[0] = nloc; b.st[1] = nx; }
        const unsigned old = xb_add(&bar[XB_XSUB(b.x)], 1u);
        const unsigned gen = old / nloc;
        if (old + 1u == (gen + 1u) * nloc) {
            __builtin_amdgcn_fence(__ATOMIC_RELEASE, "agent");
            asm volatile("s_waitcnt vmcnt(0)" ::: "memory");
            const unsigned og = xb_add(&bar[XB_TOP], 1u);
            const unsigned tg = og / nx;
            if (og + 1u == (tg + 1u) * nx) xb_add(&bar[XB_TOPGEN], 1u);
            else XB_SPIN(xb_ld(&bar[XB_TOPGEN]) == tg, bar);
            __builtin_amdgcn_fence(__ATOMIC_ACQUIRE, "agent");
            xb_add(&bar[XB_XGEN(b.x)], 1u);
            asm volatile("s_waitcnt vmcnt(0)" ::: "memory");
        } else {
            XB_SPIN(xb_ld(&bar[XB_XGEN(b.x)]) == gen, bar);
            __builtin_amdgcn_fence(__ATOMIC_ACQUIRE, "agent");
            asm volatile("s_waitcnt vmcnt(0)" ::: "memory");
        }
    }
    __syncthreads();
}

__global__ void __launch_bounds__(NTHREADS, 2) mk_fwd(Params p) {
    extern __shared__ __attribute__((aligned(16))) unsigned char lds_raw[];
    cg::grid_group grid = cg::this_grid();
    Ctx C; C.p = p; C.lds = (LAS unsigned char*)lds_raw; C.tid = threadIdx.x; C.lane = C.tid & 63; C.wave = __builtin_amdgcn_readfirstlane(C.tid >> 6); C.bid = blockIdx.x; C.G = gridDim.x; C.ws = p.ws;

    volatile LAS unsigned* bst = (volatile LAS unsigned*)(C.lds + LDS_BYTES - 64);
    if (threadIdx.x < 2) bst[threadIdx.x] = 0u;
    __syncthreads();
    const XcdBarrier bar = xcd_barrier_post((unsigned*)(p.ws + WS_BAR), bst);
    C.refresh(); phase_prologue(C);
    if (p.ws == nullptr) grid.sync();
    xcd_barrier(bar);
    C.refresh(); phase_norm0(C);
    xcd_barrier(bar);
#pragma unroll 1
    for (int layer = 0; layer < DEPTH; ++layer) {
        { C.refresh(); bf16_t* R1 = (bf16_t*)(C.ws + WS_R1); bf16_t* R2 = (bf16_t*)(C.ws + WS_R2); unsigned char* wl = C.wl(layer); pg8::Gemm g{R1, (const bf16_t*)(wl + WL_IN), M, NPP, D}; pg8::StaticOrder S; S.init(M, NPP, C.G, C.bid); pg8::EpiStore E{R2, NP, NP};
          pg8::gemm_phase<pg8::EpiStore, pg8::StaticOrder, true, true>(C.lds, g, S, E); }
        xcd_barrier(bar);
        C.refresh();
        for (int u = C.bid; u < 768 + 192 + 128 + 128 + 200; u += C.G) {
            C.refresh();
            if (u < 768) unit_chunk_mlp(C, layer, u);
            else if (u < 960) unit_conv(C, layer, u - 768);
            else if (u < 1088) unit_fourier_ctx(C, u - 960);
            else if (u < 1216) unit_fourier_lat1(C, u - 1088);
            else unit_mla_prep(C, layer, u - 1216);
        }
        xcd_barrier(bar);
        C.refresh();
        for (int u = C.bid; u < 512; u += C.G) {
            C.refresh();
            if (u < 256) unit_attention(C, 128 + u);
            else if (u < 384) unit_attention(C, u - 256);
            else unit_fourier_lat2(C, u - 384);
        }
        xcd_barrier(bar);
        { C.refresh(); bf16_t* R1 = (bf16_t*)(C.ws + WS_R1); bf16_t* R2 = (bf16_t*)(C.ws + WS_R2); unsigned char* wl = C.wl(layer); pg8::Gemm g{R1, (const bf16_t*)(wl + WL_OUT), M, D, D}; pg8::SplitTailOrder S; S.init(D, C.G, C.bid); pg8::EpiStoreSplit E{R2, R2 + (size_t)M * D - (size_t)SPLIT_ROW0 * D, D};
          pg8::gemm_phase<pg8::EpiStoreSplit, pg8::SplitTailOrder, true, true>(C.lds, g, S, E); }
        xcd_barrier(bar);
        C.refresh(); phase_post<0>(C, layer);
        xcd_barrier(bar);
        { C.refresh(); bf16_t* R1 = (bf16_t*)(C.ws + WS_R1); bf16_t* R2 = (bf16_t*)(C.ws + WS_R2); unsigned char* wl = C.wl(layer); pg8::Gemm g{R1, (const bf16_t*)(wl + WL_GU), M, 2 * FF, D}; pg8::StaticOrder S; S.init(M, 2 * FF, C.G, C.bid); pg8::EpiSwiGLU E{R2, FF};
          pg8::gemm_phase<pg8::EpiSwiGLU, pg8::StaticOrder, true, true>(C.lds, g, S, E);
          if (C.G == 256 && layer + 1 < DEPTH && C.bid >= 64) { C.refresh(); transpose_items(C, (layer + 1) * TI_L + (C.bid - 64), 192, (layer + 2) * TI_L); } }
        xcd_barrier(bar);
        { C.refresh(); bf16_t* R2 = (bf16_t*)(C.ws + WS_R2); bf16_t* R3 = (bf16_t*)(C.ws + WS_MLA); unsigned char* wl = C.wl(layer); pg8::Gemm g{R2, (const bf16_t*)(wl + WL_DN), M, D, FF}; pg8::SplitTailOrder S; S.init(FF, C.G, C.bid); pg8::EpiStoreSplit E{R3, R3 + (size_t)M * D - (size_t)SPLIT_ROW0 * D, D};
          pg8::gemm_phase<pg8::EpiStoreSplit, pg8::SplitTailOrder, true, true>(C.lds, g, S, E); }
        xcd_barrier(bar);
        C.refresh(); phase_post<1>(C, layer);
        if (layer + 1 < DEPTH) xcd_barrier(bar);
    }
}

extern "C" void kernel_launch(void* const* d_in, const int* in_sizes, int n_in, void* d_out, int out_size, void* d_ws, size_t ws_size, hipStream_t stream) {
    static int grid = 0;
    if (grid == 0) {
        if (n_in != 24 || ws_size < WS_END) { fprintf(stderr, "kernel_launch: need 24 inputs and %zu bytes of workspace; got %d, %zu\n", (size_t)WS_END, n_in, ws_size); grid = -1; return; }
        int dev = 0, cus = 0, per_cu = 0;
        if (hipGetDevice(&dev) != hipSuccess || hipDeviceGetAttribute(&cus, hipDeviceAttributeMultiprocessorCount, dev) != hipSuccess) { grid = -1; return; }
        if (hipFuncSetAttribute((const void*)mk_fwd, hipFuncAttributeMaxDynamicSharedMemorySize, LDS_BYTES) != hipSuccess) { fprintf(stderr, "kernel_launch: hipFuncSetAttribute failed\n"); grid = -1; return; }
        if (hipOccupancyMaxActiveBlocksPerMultiprocessor(&per_cu, (const void*)mk_fwd, NTHREADS, LDS_BYTES) != hipSuccess || per_cu < 1) fprintf(stderr, "kernel_launch: occupancy query says %d blocks per CU\n", per_cu);
        (void)hipGetLastError();
        grid = cus;
    }
    if (grid < 0) return;
    Params p{};
    for (int i = 0; i < 24; ++i) p.in[i] = (const float*)d_in[i];
    p.out = (float*)d_out; p.ws = (unsigned char*)d_ws;
    if (hipMemsetAsync((char*)d_ws + WS_BAR, 0, WS_BAR_BYTES, stream) != hipSuccess) { fprintf(stderr, "kernel_launch: memset failed\n"); return; }
    void* args[] = {&p};
    hipError_t e = hipLaunchCooperativeKernel((const void*)mk_fwd, dim3(grid), dim3(NTHREADS), args, LDS_BYTES, stream);
    if (e != hipSuccess) fprintf(stderr, "kernel_launch: cooperative launch failed: %s (grid %d)\n", hipGetErrorString(e), grid);
}
```

```cpp
#include <hip/hip_runtime.h>
#include <hip/hip_cooperative_groups.h>
#include <cstdio>
#include <cstdint>
namespace cg = cooperative_groups;
namespace pg8 {
#define PG8_LAS __attribute__((address_space(3)))
typedef unsigned short bf16_t;
typedef short bf16x8 __attribute__((ext_vector_type(8)));
typedef float f32x4 __attribute__((ext_vector_type(4)));
typedef unsigned u32x4 __attribute__((ext_vector_type(4)));
constexpr int BM = 256, BK = 64, HALF = 128, HTB = HALF * BK * 2  , STAGE_BYTES = 8 * HTB, NXCD = 8, WGM = 8;

__host__ __device__ __forceinline__ int lds_byte(int r, int c) { const int st = (r >> 4) * 2 + (c >> 5), rr = r & 15, cc = c & 31, ob = rr * 64 + cc * 2; return st * 1024 + (ob ^ (((ob >> 9) & 1) << 5)); }
__host__ __device__ __forceinline__ void stage_rc(int b, int& R, int& C) { const int st = b / 1024, sb = b % 1024, swz = sb ^ (((sb >> 9) & 1) << 5); R = (st >> 1) * 16 + swz / 64; C = (st & 1) * 32 + (swz % 64) / 2; }
__host__ __device__ __forceinline__ int perm32(int rho) { const int n = rho >> 4, i = rho & 15; return 8 * (i >> 2) + 4 * n + (i & 3); }

struct Unit { int pm, pn; int kh, nt, koff; };
struct Gemm { const bf16_t* A; const bf16_t* Bt; int M, N, K; };

struct StaticOrder {
    int nM, nN, nwg, G, c;
    __host__ __device__ void init(int M, int N, int G_, int c_) { nM = M / BM; nN = N / BM; nwg = nM * nN; G = G_; c = c_; }
    __host__ __device__ bool next(int i, Unit& u) const {
        const long L = (long)i * G + c; if (L >= nwg) return false;
        int wgid = (int)L; { const int q = nwg / NXCD, r = nwg % NXCD, xcd = wgid % NXCD, off = wgid / NXCD; wgid = (xcd < r ? xcd * (q + 1) : r * (q + 1) + (xcd - r) * q) + off; }
        const int nig = WGM * nN, gid = wgid / nig, fm = gid * WGM, gsz = (nM - fm) < WGM ? (nM - fm) : WGM;
        u.pm = fm + ((wgid % nig) % gsz); u.pn = (wgid % nig) / gsz; u.kh = 0; u.nt = 0; u.koff = 0; return true;
    }
    __device__ __forceinline__ void a_ready(const Unit&) const {}
    __device__ __forceinline__ void done(const Unit&) const {}
};

__device__ __forceinline__ unsigned cvt_pk_bf16(float lo, float hi) { unsigned r; asm volatile("v_cvt_pk_bf16_f32 %0, %1, %2" : "=v"(r) : "v"(lo), "v"(hi)); return r; }
typedef float f32x2 __attribute__((ext_vector_type(2)));
struct EpiStore {
    static constexpr bool PERM = true, AFTER_DRAIN = false;
    bf16_t* O; int ldc; int ncols;
    __device__ __forceinline__ void operator()(const f32x4 (&acc)[2][2][4][2], const Unit& u, int wr, int wc, int fr, int fq) const {
        const int row0 = u.pm * BM + wr * 64 + fr; const int col0 = u.pn * BM + wc * 32 + 8 * fq;
#pragma unroll
        for (int ai = 0; ai < 2; ++ai)
#pragma unroll
            for (int m = 0; m < 4; ++m) { bf16_t* rowp = O + (size_t)(row0 + ai * HALF + m * 16) * ldc + col0;
#pragma unroll
                for (int bj = 0; bj < 2; ++bj) { const f32x4 v0 = acc[ai][bj][m][0], v1 = acc[ai][bj][m][1];
                    u32x4 w; w.x = cvt_pk_bf16(v0[0], v0[1]); w.y = cvt_pk_bf16(v0[2], v0[3]); w.z = cvt_pk_bf16(v1[0], v1[1]); w.w = cvt_pk_bf16(v1[2], v1[3]);
                    if (col0 + bj * HALF < ncols) *(u32x4*)(rowp + bj * HALF) = w; } }
    }
};
struct EpiStoreWT {
    static constexpr bool PERM = true, AFTER_DRAIN = false;
    bf16_t* O; int ldc; int ncols;
    __device__ __forceinline__ void operator()(const f32x4 (&acc)[2][2][4][2], const Unit& u, int wr, int wc, int fr, int fq) const {
        const int row0 = u.pm * BM + wr * 64 + fr; const int col0 = u.pn * BM + wc * 32 + 8 * fq;
#pragma unroll
        for (int ai = 0; ai < 2; ++ai)
#pragma unroll
            for (int m = 0; m < 4; ++m) { bf16_t* rowp = O + (size_t)(row0 + ai * HALF + m * 16) * ldc + col0;
#pragma unroll
                for (int bj = 0; bj < 2; ++bj) { const f32x4 v0 = acc[ai][bj][m][0], v1 = acc[ai][bj][m][1];
                    const unsigned long long lo = (unsigned long long)cvt_pk_bf16(v0[0], v0[1]) | ((unsigned long long)cvt_pk_bf16(v0[2], v0[3]) << 32);
                    const unsigned long long hi = (unsigned long long)cvt_pk_bf16(v1[0], v1[1]) | ((unsigned long long)cvt_pk_bf16(v1[2], v1[3]) << 32);
                    unsigned long long* q = (unsigned long long*)(rowp + bj * HALF);
                    __hip_atomic_store(q, lo, __ATOMIC_RELAXED, __HIP_MEMORY_SCOPE_AGENT); __hip_atomic_store(q + 1, hi, __ATOMIC_RELAXED, __HIP_MEMORY_SCOPE_AGENT); } }
    }
};
__device__ __forceinline__ float silu_mul(float g, float u) { return g * u * __builtin_amdgcn_rcpf(1.f + __expf(-g)); }
struct EpiSwiGLU {
    static constexpr bool PERM = true, AFTER_DRAIN = false;
    bf16_t* O; int ldc;
    __device__ __forceinline__ void operator()(const f32x4 (&acc)[2][2][4][2], const Unit& u, int wr, int wc, int fr, int fq) const {
        const int row0 = u.pm * BM + wr * 64 + fr; const int col0 = u.pn * HALF + wc * 32 + 8 * fq;
#pragma unroll
        for (int ai = 0; ai < 2; ++ai)
#pragma unroll
            for (int m = 0; m < 4; ++m) { bf16_t* rowp = O + (size_t)(row0 + ai * HALF + m * 16) * ldc + col0;
                const f32x4 g0 = acc[ai][0][m][0], g1 = acc[ai][0][m][1], u0 = acc[ai][1][m][0], u1 = acc[ai][1][m][1];
                u32x4 w; w.x = cvt_pk_bf16(silu_mul(g0[0], u0[0]), silu_mul(g0[1], u0[1])); w.y = cvt_pk_bf16(silu_mul(g0[2], u0[2]), silu_mul(g0[3], u0[3]));
                w.z = cvt_pk_bf16(silu_mul(g1[0], u1[0]), silu_mul(g1[1], u1[1])); w.w = cvt_pk_bf16(silu_mul(g1[2], u1[2]), silu_mul(g1[3], u1[3]));
                *(u32x4*)rowp = w; }
    }
};

struct PanelOrder {
    int nN, nwg, G, c; unsigned* cnt;
    __device__ void init(int M, int N, int G_, int c_, unsigned* cnt_) { nN = N / BM; nwg = (M / BM) * nN; G = G_; c = c_; cnt = cnt_; }
    __device__ bool next(int i, Unit& u) const { const long L = (long)i * G + c; if (L >= nwg) return false; u.pm = (int)L / nN; u.pn = (int)L % nN; u.kh = 0; u.nt = 0; u.koff = 0; return true; }
    __device__ __forceinline__ void a_ready(const Unit&) const {}
    __device__ __forceinline__ void done(const Unit& u) const {
        asm volatile("s_waitcnt vmcnt(0)" ::: "memory");
        if ((threadIdx.x & 63) == 0) __hip_atomic_fetch_add(cnt + u.pm, 1u, __ATOMIC_RELAXED, __HIP_MEMORY_SCOPE_AGENT);
    }
};

struct SplitTailOrder {
    int G, c, ntf; bool split;
    __device__ void init(int K, int G_, int c_) { G = G_; c = c_; ntf = K / BK; split = (G_ == 256); }
    __device__ bool next(int i, Unit& u) const {
        if (!split) { const long L = (long)i * G + c; if (L >= 384) return false; u.pm = (int)L >> 2; u.pn = (int)L & 3; u.kh = 0; u.nt = 0; u.koff = 0; return true; }
        if (i == 0) { const int t = (c & 7) * 32 + (c >> 3); u.pm = t >> 2; u.pn = t & 3; u.kh = 0; u.nt = 0; u.koff = 0; return true; }
        if (i == 1) { const int t = 256 + (c & 7) * 16 + (c >> 4); u.pm = t >> 2; u.pn = t & 3; u.kh = (c >> 3) & 1; u.nt = ntf / 2; u.koff = u.kh * (ntf / 2) * BK * 2; return true; }
        return false;
    }
    __device__ __forceinline__ void a_ready(const Unit&) const {}
    __device__ __forceinline__ void done(const Unit&) const {}
};
struct EpiStoreSplit {
    static constexpr bool PERM = true, AFTER_DRAIN = false;
    bf16_t* O; bf16_t* O1; int ldc;
    __device__ __forceinline__ void operator()(const f32x4 (&acc)[2][2][4][2], const Unit& u, int wr, int wc, int fr, int fq) const {
        const int row0 = u.pm * BM + wr * 64 + fr; const int col0 = u.pn * BM + wc * 32 + 8 * fq; bf16_t* base = u.kh ? O1 : O;
#pragma unroll
        for (int ai = 0; ai < 2; ++ai)
#pragma unroll
            for (int m = 0; m < 4; ++m) { bf16_t* rowp = base + (size_t)(row0 + ai * HALF + m * 16) * ldc + col0;
#pragma unroll
                for (int bj = 0; bj < 2; ++bj) { const f32x4 v0 = acc[ai][bj][m][0], v1 = acc[ai][bj][m][1];
                    u32x4 w; w.x = cvt_pk_bf16(v0[0], v0[1]); w.y = cvt_pk_bf16(v0[2], v0[3]); w.z = cvt_pk_bf16(v1[0], v1[1]); w.w = cvt_pk_bf16(v1[2], v1[3]);
                    *(u32x4*)(rowp + bj * HALF) = w; } }
    }
};
template <class Epi, class Sched, bool ALIGN_EPI = false, bool SP2 = false>
__device__ __forceinline__ void gemm_phase(PG8_LAS unsigned char* lds, const Gemm g, const Sched& S, const Epi& E) {
    int tid_ = threadIdx.x; asm volatile("" : "+v"(tid_));
    const int tid = tid_, wid = __builtin_amdgcn_readfirstlane(tid >> 6), lane = tid & 63, wr = wid >> 2, wc = wid & 3, fr = lane & 15, fq = lane >> 4;
    const int K = g.K, nt = K / BK;
    unsigned voffA[2], voffB[2];
#pragma unroll
    for (int i = 0; i < 2; ++i) { int R, C; stage_rc(tid * 16 + i * 8192, R, C); const int Rb = Epi::PERM ? ((R & ~31) + perm32(R & 31)) : R;
        voffA[i] = (unsigned)(R * K + C) * 2u; voffB[i] = (unsigned)(Rb * K + C) * 2u; }
    const size_t kstep = (size_t)(BK * 2);
    const size_t hstep = (size_t)HALF * K * 2;
    const size_t tstep = 2 * hstep;
    const unsigned ldsw = (unsigned)wid * 1024u;
    const int aoff = lds_byte(wr * 64 + fr, fq * 8), boff = lds_byte(wc * 32 + fr, fq * 8);
#define PG8_SA(b, h) (((b) * 2 + (h)) * HTB)
#define PG8_SB(b, h) ((4 + (b) * 2 + (h)) * HTB)
#define PG8_STAGE(bufoff, gbase, voff) do { _Pragma("unroll") for (int _i = 0; _i < 2; ++_i) \
        __builtin_amdgcn_global_load_lds((const unsigned*)((const char*)(gbase) + (voff)[_i]), (PG8_LAS unsigned*)(lds + (bufoff) + ldsw + _i * 8192), 16, 0, 0); } while (0)
#define PG8_LDA(dst, b, h) do { _Pragma("unroll") for (int m = 0; m < 4; ++m) _Pragma("unroll") for (int k = 0; k < 2; ++k) dst[m][k] = *(const PG8_LAS bf16x8*)(lds + PG8_SA(b, h) + aoff + m * 2048 + k * 1024); } while (0)
#define PG8_LDB(dst, b, h) do { _Pragma("unroll") for (int n = 0; n < 2; ++n) _Pragma("unroll") for (int k = 0; k < 2; ++k) dst[n][k] = *(const PG8_LAS bf16x8*)(lds + PG8_SB(b, h) + boff + n * 2048 + k * 1024); } while (0)
#define PG8_MMA(ai, bj, At, Bt) do { __builtin_amdgcn_s_setprio(1); _Pragma("unroll") for (int m = 0; m < 4; ++m) _Pragma("unroll") for (int n = 0; n < 2; ++n) _Pragma("unroll") for (int k = 0; k < 2; ++k) \
        acc[ai][bj][m][n] = __builtin_amdgcn_mfma_f32_16x16x32_bf16(Bt[n][k], At[m][k], acc[ai][bj][m][n], 0, 0, 0); __builtin_amdgcn_s_setprio(0); } while (0)
#define PG8_WAIT_V(n) asm volatile("s_waitcnt vmcnt(" #n ")" ::: "memory")
#define PG8_WAIT_L(n) asm volatile("s_waitcnt lgkmcnt(" #n ")" ::: "memory")
#define PG8_BAR __builtin_amdgcn_s_barrier()
#define PG8_SCHED __builtin_amdgcn_sched_barrier(0)
    Unit cur, nxt; int ui = 0;
    if (!S.next(0, cur)) return;
    f32x4 acc[2][2][4][2];
#pragma unroll
    for (int a = 0; a < 2; ++a)
#pragma unroll
        for (int b = 0; b < 2; ++b)
#pragma unroll
            for (int m = 0; m < 4; ++m)
#pragma unroll
                for (int n = 0; n < 2; ++n) acc[a][b][m][n] = (f32x4){0.f, 0.f, 0.f, 0.f};
    bf16x8 At[4][2], B0[2][2], B1[2][2];
    const char* cA = (const char*)g.A + (size_t)cur.pm * tstep + cur.koff; const char* cB = (const char*)g.Bt + (size_t)cur.pn * tstep + cur.koff;
    S.a_ready(cur);
    if constexpr (SP2) {
        PG8_STAGE(PG8_SB(0, 0), cB, voffB); PG8_STAGE(PG8_SB(0, 1), cB + hstep, voffB); PG8_STAGE(PG8_SA(0, 0), cA, voffA); PG8_STAGE(PG8_SA(0, 1), cA + hstep, voffA);
        if (wr == 1) PG8_BAR;
        PG8_WAIT_V(2); PG8_BAR;
        PG8_STAGE(PG8_SB(1, 0), cB + kstep, voffB); PG8_STAGE(PG8_SA(1, 0), cA + kstep, voffA); PG8_STAGE(PG8_SB(1, 1), cB + hstep + kstep, voffB);
        PG8_WAIT_V(6); PG8_BAR;
    } else {
        PG8_STAGE(PG8_SB(0, 0), cB, voffB); PG8_STAGE(PG8_SA(0, 0), cA, voffA); PG8_STAGE(PG8_SB(0, 1), cB + hstep, voffB); PG8_STAGE(PG8_SA(0, 1), cA + hstep, voffA);
        if (wr == 1) PG8_BAR;
        PG8_WAIT_V(4); PG8_BAR;
        PG8_STAGE(PG8_SB(1, 0), cB + kstep, voffB); PG8_STAGE(PG8_SA(1, 0), cA + kstep, voffA); PG8_STAGE(PG8_SB(1, 1), cB + hstep + kstep, voffB);
        PG8_WAIT_V(6); PG8_BAR;
    }
    for (;;) {
        const bool has_next = S.next(ui + 1, nxt);
        const char* nA = has_next ? (const char*)g.A + (size_t)nxt.pm * tstep + nxt.koff : cA; const char* nB = has_next ? (const char*)g.Bt + (size_t)nxt.pn * tstep + nxt.koff : cB;
        const int ntc = cur.nt ? cur.nt : nt;
        for (int t = 0; t < ntc; t += 2) {
            const bool last = (t == ntc - 2);
            const char* a1 = cA + (size_t)(t + 1) * kstep;
            const char* a2 = last ? nA : cA + (size_t)(t + 2) * kstep; const char* b2 = last ? nB : cB + (size_t)(t + 2) * kstep;
            const char* a3 = a2 + kstep; const char* b3 = b2 + kstep;
            if (last && has_next) S.a_ready(nxt);
            if constexpr (SP2) {
            PG8_LDB(B0, 0, 0); PG8_LDB(B1, 0, 1); PG8_SCHED; PG8_LDA(At, 0, 0); PG8_STAGE(PG8_SA(1, 1), a1 + hstep, voffA);
            PG8_WAIT_V(8); PG8_WAIT_L(0); PG8_BAR; PG8_MMA(0, 0, At, B0); PG8_MMA(0, 1, At, B1); PG8_BAR; PG8_SCHED;
            PG8_LDA(At, 0, 1); PG8_STAGE(PG8_SB(0, 0), b2, voffB); PG8_STAGE(PG8_SB(0, 1), b2 + hstep, voffB); PG8_STAGE(PG8_SA(0, 0), a2, voffA);
            PG8_WAIT_V(8); PG8_WAIT_L(0); PG8_BAR; PG8_MMA(1, 0, At, B0); PG8_MMA(1, 1, At, B1); PG8_BAR; PG8_SCHED;
            PG8_LDB(B0, 1, 0); PG8_LDB(B1, 1, 1); PG8_SCHED; PG8_LDA(At, 1, 0); PG8_STAGE(PG8_SA(0, 1), a2 + hstep, voffA);
            PG8_WAIT_V(8); PG8_WAIT_L(0); PG8_BAR; PG8_MMA(0, 0, At, B0); PG8_MMA(0, 1, At, B1); PG8_BAR; PG8_SCHED;
            PG8_LDA(At, 1, 1); PG8_STAGE(PG8_SB(1, 0), b3, voffB); PG8_STAGE(PG8_SB(1, 1), b3 + hstep, voffB); PG8_STAGE(PG8_SA(1, 0), a3, voffA);
            PG8_WAIT_V(8); PG8_WAIT_L(0); PG8_BAR; PG8_MMA(1, 0, At, B0); PG8_MMA(1, 1, At, B1); PG8_BAR; PG8_SCHED;
            } else {
            PG8_LDB(B0, 0, 0); PG8_SCHED; PG8_LDA(At, 0, 0); PG8_STAGE(PG8_SA(1, 1), a1 + hstep, voffA);
            PG8_WAIT_L(8); PG8_BAR; PG8_WAIT_L(0); PG8_MMA(0, 0, At, B0); PG8_BAR; PG8_SCHED;
            PG8_LDB(B1, 0, 1); PG8_STAGE(PG8_SB(0, 0), b2, voffB);
            PG8_BAR; PG8_WAIT_L(0); PG8_MMA(0, 1, At, B1); PG8_BAR;
            PG8_LDA(At, 0, 1); PG8_STAGE(PG8_SA(0, 0), a2, voffA);
            PG8_BAR; PG8_WAIT_L(0); PG8_MMA(1, 0, At, B0); PG8_BAR; PG8_SCHED;
            PG8_STAGE(PG8_SB(0, 1), b2 + hstep, voffB);
            PG8_WAIT_V(6); PG8_BAR; PG8_MMA(1, 1, At, B1); PG8_BAR;
            PG8_LDB(B0, 1, 0); PG8_SCHED; PG8_LDA(At, 1, 0); PG8_STAGE(PG8_SA(0, 1), a2 + hstep, voffA);
            PG8_WAIT_L(8); PG8_BAR; PG8_WAIT_L(0); PG8_MMA(0, 0, At, B0); PG8_BAR; PG8_SCHED;
            PG8_LDB(B1, 1, 1); PG8_STAGE(PG8_SB(1, 0), b3, voffB);
            PG8_BAR; PG8_WAIT_L(0); PG8_MMA(0, 1, At, B1); PG8_BAR;
            PG8_LDA(At, 1, 1); PG8_STAGE(PG8_SA(1, 0), a3, voffA);
            PG8_BAR; PG8_WAIT_L(0); PG8_MMA(1, 0, At, B0); PG8_BAR; PG8_SCHED;
            PG8_STAGE(PG8_SB(1, 1), b3 + hstep, voffB);
            PG8_WAIT_V(6); PG8_BAR; PG8_MMA(1, 1, At, B1); PG8_BAR;
            }
        }
        if constexpr (ALIGN_EPI) { if (wr == 0) PG8_BAR; }
        if constexpr (!Epi::AFTER_DRAIN) { E(acc, cur, wr, wc, fr, fq); S.done(cur); }
        if (!has_next) break;
#pragma unroll
        for (int a = 0; a < 2; ++a)
#pragma unroll
            for (int b = 0; b < 2; ++b)
#pragma unroll
                for (int m = 0; m < 4; ++m)
#pragma unroll
                    for (int n = 0; n < 2; ++n) acc[a][b][m][n] = (f32x4){0.f, 0.f, 0.f, 0.f};
        cur = nxt; cA = nA; cB = nB; ++ui;
        if constexpr (ALIGN_EPI) { if (wr == 1) PG8_BAR; }
    }
    PG8_WAIT_V(0);
    if constexpr (!ALIGN_EPI) { if (wr == 0) PG8_BAR; }
    PG8_BAR;
    if constexpr (Epi::AFTER_DRAIN) { E.fused(acc, cur, wr, wc, fr, fq, lds, wid, lane); S.done(cur); }
#undef PG8_SA
#undef PG8_SB
#undef PG8_STAGE
#undef PG8_LDA
#undef PG8_LDB
#undef PG8_MMA
#undef PG8_WAIT_V
#undef PG8_WAIT_L
#undef PG8_BAR
#undef PG8_SCHED
}
}
#define LAS __attribute__((address_space(3)))
typedef unsigned short bf16_t;
typedef short bf16x8 __attribute__((ext_vector_type(8)));
typedef short bf16x4 __attribute__((ext_vector_type(4)));
typedef float f32x4 __attribute__((ext_vector_type(4)));
typedef float f32x2 __attribute__((ext_vector_type(2)));
typedef float f32x16 __attribute__((ext_vector_type(16)));
typedef unsigned u32x4 __attribute__((ext_vector_type(4)));
typedef unsigned u32x2 __attribute__((ext_vector_type(2)));

constexpr int D = 1024, M_CTX = 8192, M_LAT = 16384, M = M_CTX + M_LAT, NP = 1888, NPP = 2048, FF = 2816, DEPTH = 4;
constexpr int KEYROWS = 8192 + 4 * 4352;
constexpr float EPS = 1e-6f;
constexpr int NTHREADS = 512, NWAVES = 8;
constexpr int LDS_BYTES = 147456;

constexpr size_t OUT_X = 0, OUT_CKV = (size_t)M * D, OUT_KR = OUT_CKV + (size_t)32 * 4 * 256 * 128;
constexpr int PC_U = 0, PC_V = 256, PC_H = 512, PC_B = 768, PC_C = 1024, PC_F = 1280, PC_Q = 1536, PC_KV = 1728, PC_KR = 1856;

constexpr size_t al256(size_t x) { return (x + 255) & ~(size_t)255; }
constexpr size_t WS_BAR = 0, WS_BAR_BYTES = 16384;
constexpr size_t WS_MOD = WS_BAR_BYTES;
constexpr size_t WS_F64 = al256(WS_MOD + (size_t)4 * 5 * 6144 * 4);
constexpr size_t WS_T64R = WS_F64 + 128 * 64 * 2;
constexpr size_t WS_T64I = WS_T64R + 64 * 128 * 2;
constexpr size_t WS_T64B = WS_T64I + 64 * 128 * 2;
constexpr size_t WS_T256 = WS_T64B + 64 * 128 * 2;
constexpr size_t WS_TW = WS_T256 + 256 * 512 * 2;
constexpr size_t WS_ROPE = WS_TW + 4096 * 8;
constexpr size_t WS_W = al256(WS_ROPE + 64 * 8 * 8);
constexpr size_t WL_IN = 0, WL_OUT = WL_IN + (size_t)NPP * D * 2, WL_GU = WL_OUT + (size_t)D * D * 2, WL_DN = WL_GU + (size_t)2 * FF * D * 2,
                 WL_UQ = WL_DN + (size_t)D * FF * 2, WL_UKV = WL_UQ + (size_t)384 * 192 * 2, WL_SP = WL_UKV + (size_t)512 * 128 * 2, WL_SIZE = WL_SP + (size_t)4 * 128 * 128 * 2;
constexpr size_t WS_R1 = al256(WS_W + 4 * WL_SIZE);
constexpr size_t WS_R2 = WS_R1 + (size_t)M * D * 2;
constexpr size_t WS_MLA = WS_R2 + (size_t)M * FF * 2;
constexpr size_t WS_Q = WS_MLA, WS_KN = WS_Q + (size_t)M * 384 * 2, WS_VT = WS_KN + (size_t)KEYROWS * 256 * 2, WS_KR = WS_VT + (size_t)KEYROWS * 256 * 2,
                 WS_GB = WS_KR + (size_t)KEYROWS * 32 * 2, WS_END = WS_GB + (size_t)4 * 4 * 64 * 64 * 128 * 2;
static_assert(WS_END - WS_MLA >= (size_t)M * D * 2, "FFNOUT alias");
static_assert((size_t)M * NP * 2 <= (size_t)M * FF * 2, "PROJ fits R2");

struct Params { const float* in[24]; float* out; unsigned char* ws; };
enum { I_XP = 0, I_XS, I_CCKV, I_CKR, I_C, I_CCTX, I_WADA, I_BADA, I_GPM, I_GPOM, I_GPF, I_GPOF, I_WIN, I_SPW, I_SPB, I_CVW, I_CVB, I_GQ, I_WUQ, I_GKV, I_WUKV, I_WOUT, I_WGU, I_WDN };

__device__ __forceinline__ unsigned f2bf(float f) { unsigned u = __builtin_bit_cast(unsigned, f); return (u + 0x7fffu + ((u >> 16) & 1u)) >> 16; }
typedef __bf16 bf16x2v __attribute__((ext_vector_type(2)));
__device__ __forceinline__ unsigned pk2(float lo, float hi) { const bf16x2v r = __builtin_convertvector((f32x2){lo, hi}, bf16x2v); return __builtin_bit_cast(unsigned, r); }
__device__ __forceinline__ float bflo(unsigned w) { return __builtin_bit_cast(float, w << 16); }
__device__ __forceinline__ float bfhi(unsigned w) { return __builtin_bit_cast(float, w & 0xffff0000u); }
__device__ __forceinline__ float bf1(bf16_t v) { return __builtin_bit_cast(float, (unsigned)v << 16); }
__device__ __forceinline__ f32x4 mma16(bf16x8 a, bf16x8 b, f32x4 c) { return __builtin_amdgcn_mfma_f32_16x16x32_bf16(a, b, c, 0, 0, 0); }
__device__ __forceinline__ f32x16 mma32(bf16x8 a, bf16x8 b, f32x16 c) { return __builtin_amdgcn_mfma_f32_32x32x16_bf16(a, b, c, 0, 0, 0); }
__device__ __forceinline__ float wave_sum(float v) {
#pragma unroll
    for (int o = 1; o < 64; o <<= 1) v += __shfl_xor(v, o);
    return v;
}
__device__ __forceinline__ u32x2 pk4(f32x4 v) { u32x2 w; w.x = pk2(v[0], v[1]); w.y = pk2(v[2], v[3]); return w; }
__device__ __forceinline__ int mod_of_row(int r) { return r < M_CTX ? 0 : 1 + ((r - M_CTX) >> 12); }

struct Ctx {
    Params p; LAS unsigned char* lds; int tid, lane, wave, bid, G;
    unsigned char* ws;
    __device__ __forceinline__ const float* mod(int l, int mi, int chunk) const { return (const float*)(ws + WS_MOD) + ((size_t)(l * 5 + mi) * 6 + chunk) * 1024; }
    __device__ __forceinline__ unsigned char* wl(int l) const { return ws + WS_W + (size_t)l * WL_SIZE; }
    __device__ __forceinline__ void refresh() { int t = threadIdx.x; asm volatile("" : "+v"(t)); tid = t; lane = t & 63; wave = __builtin_amdgcn_readfirstlane(t >> 6);
        size_t z = 0; asm volatile("" : "+s"(z)); ws = p.ws + z;
        int b = blockIdx.x; asm volatile("" : "+s"(b)); bid = b; }
};

constexpr int TPS = 258;
struct TItem { const float* W; bf16_t* WT; int ldw, K, k0, n0, nvalid, gu; };
__device__ __forceinline__ void titem_load(const TItem& t, int wave, int lane, f32x4 (&v)[8]) {
    const int n = t.n0 + 4 * lane;
#pragma unroll
    for (int i = 0; i < 8; ++i) v[i] = n < t.nvalid ? *(const f32x4*)(t.W + (size_t)(t.k0 + 8 * wave + i) * t.ldw + n) : (f32x4){0.f, 0.f, 0.f, 0.f};
}
__device__ __forceinline__ void titem_stage(LAS unsigned char* lds, int wave, int lane, const f32x4 (&v)[8]) {
    LAS bf16_t* T = (LAS bf16_t*)lds;
#pragma unroll
    for (int i = 0; i < 8; ++i) { LAS unsigned* d = (LAS unsigned*)(T + (8 * wave + i) * TPS + 4 * lane); d[0] = pk2(v[i][0], v[i][1]); d[1] = pk2(v[i][2], v[i][3]); }
}
__device__ __forceinline__ void titem_store(const TItem& t, const LAS unsigned char* lds, int tid) {
    const LAS bf16_t* T = (const LAS bf16_t*)lds;
#pragma unroll
    for (int it = 0; it < 4; ++it) { const int q = tid + NTHREADS * it, n = q >> 3, c = q & 7;
        unsigned short e[8];
#pragma unroll
        for (int j = 0; j < 8; ++j) e[j] = T[(8 * c + j) * TPS + n];
        const int sn = t.n0 + n;
        if (sn < t.nvalid) { int dr = sn; if (t.gu) { const int isup = sn >= FF, jj = isup ? sn - FF : sn; dr = (jj >> 7) * 256 + isup * 128 + (jj & 127); }
            u32x4 o; o.x = e[0] | ((unsigned)e[1] << 16); o.y = e[2] | ((unsigned)e[3] << 16); o.z = e[4] | ((unsigned)e[5] << 16); o.w = e[6] | ((unsigned)e[7] << 16);
            *(u32x4*)(t.WT + (size_t)dr * t.K + t.k0 + 8 * c) = o; } }
}
constexpr int TI_IN = 16 * 8, TI_OUT = 16 * 4, TI_GU = 16 * 22, TI_DN = 44 * 4, TI_UQ = 3 * 2, TI_UKV = 2 * 2, TI_L = TI_IN + TI_OUT + TI_GU + TI_DN + TI_UQ + TI_UKV;
__device__ __forceinline__ TItem titem_make(const Ctx& C, int it) {
    const Params& p = C.p; const int l = it / TI_L; int r = it % TI_L; unsigned char* wl = C.wl(l); TItem t; t.gu = 0;
    if (r < TI_IN) { t.W = p.in[I_WIN] + (size_t)l * D * NP; t.WT = (bf16_t*)(wl + WL_IN); t.ldw = NP; t.K = D; t.k0 = (r >> 3) * 64; t.n0 = (r & 7) * 256; t.nvalid = NP; return t; } r -= TI_IN;
    if (r < TI_OUT) { t.W = p.in[I_WOUT] + (size_t)l * D * D; t.WT = (bf16_t*)(wl + WL_OUT); t.ldw = D; t.K = D; t.k0 = (r >> 2) * 64; t.n0 = (r & 3) * 256; t.nvalid = D; return t; } r -= TI_OUT;
    if (r < TI_GU) { t.W = p.in[I_WGU] + (size_t)l * D * 2 * FF; t.WT = (bf16_t*)(wl + WL_GU); t.ldw = 2 * FF; t.K = D; t.k0 = (r / 22) * 64; t.n0 = (r % 22) * 256; t.nvalid = 2 * FF; t.gu = 1; return t; } r -= TI_GU;
    if (r < TI_DN) { t.W = p.in[I_WDN] + (size_t)l * FF * D; t.WT = (bf16_t*)(wl + WL_DN); t.ldw = D; t.K = FF; t.k0 = (r >> 2) * 64; t.n0 = (r & 3) * 256; t.nvalid = D; return t; } r -= TI_DN;
    if (r < TI_UQ) { t.W = p.in[I_WUQ] + (size_t)l * 192 * 384; t.WT = (bf16_t*)(wl + WL_UQ); t.ldw = 384; t.K = 192; t.k0 = (r >> 1) * 64; t.n0 = (r & 1) * 256; t.nvalid = 384; return t; } r -= TI_UQ;
    t.W = p.in[I_WUKV] + (size_t)l * 128 * 512; t.WT = (bf16_t*)(wl + WL_UKV); t.ldw = 512; t.K = 128; t.k0 = (r >> 1) * 64; t.n0 = (r & 1) * 256; t.nvalid = 512; return t;
}

__device__ __forceinline__ void transpose_items(const Ctx& C, int it0, int stride, int end) {
    int it = it0; f32x4 v[8];
    TItem cur; if (it < end) { cur = titem_make(C, it); titem_load(cur, C.wave, C.lane, v); }
    while (it < end) {
        titem_stage(C.lds, C.wave, C.lane, v);
        const int nx = it + stride; TItem nxt = cur; if (nx < end) { nxt = titem_make(C, nx); titem_load(nxt, C.wave, C.lane, v); }
        __syncthreads();
        titem_store(cur, C.lds, C.tid);
        __syncthreads();
        cur = nxt; it = nx;
    }
}

__device__ __forceinline__ void phase_prologue(const Ctx& C) {
    const Params& p = C.p;
    transpose_items(C, C.bid, C.G, (C.G == 256) ? TI_L : 4 * TI_L);
    {
        LAS float* sc = (LAS float*)C.lds;
        LAS float* red = (LAS float*)(C.lds + 5 * 1024 * 4);
        const int ub = C.G - 1 - C.bid;
        if (ub < 96) {
            size_t za = 0, zb = 0; asm volatile("" : "+s"(za), "+s"(zb));
            const float* cctx = p.in[I_CCTX] + za; const float* cc_ = p.in[I_C] + zb;
            for (int i = C.tid; i < 5120; i += NTHREADS) { const int j = i >> 10, k = i & 1023; const float v = (j == 0) ? cctx[k] : cc_[(j - 1) * 1024 + k]; sc[i] = v / (1.f + __expf(-v)); }
            __syncthreads();
            for (int u = ub; u < 96; u += C.G) {
                const int l = u / 24, cb = u % 24;
                const float* w = p.in[I_WADA] + ((size_t)l * 1024 + C.wave * 128) * 6144 + cb * 256 + 4 * C.lane;
                f32x4 a0 = {0.f, 0.f, 0.f, 0.f}, a1 = a0, a2 = a0, a3 = a0, a4 = a0;
#pragma unroll 16
                for (int k = 0; k < 128; ++k) { const f32x4 wv = *(const f32x4*)(w + (size_t)k * 6144); const int kk = C.wave * 128 + k;
                    a0 += wv * sc[kk]; a1 += wv * sc[1024 + kk]; a2 += wv * sc[2048 + kk]; a3 += wv * sc[3072 + kk]; a4 += wv * sc[4096 + kk]; }
                LAS f32x4* rw = (LAS f32x4*)(red + C.wave * 1280) + C.lane;
                rw[0] = a0; rw[64] = a1; rw[128] = a2; rw[192] = a3; rw[256] = a4;
                __syncthreads();
                for (int i = C.tid; i < 1280; i += NTHREADS) { const int j = i >> 8, c2 = i & 255; float sum = p.in[I_BADA][l * 6144 + cb * 256 + c2];
#pragma unroll
                    for (int ww = 0; ww < 8; ++ww) sum += red[ww * 1280 + i];
                    ((float*)(C.ws + WS_MOD))[(size_t)(l * 5 + j) * 6144 + cb * 256 + c2] = sum; }
                __syncthreads();
            }
        }
        __syncthreads();
    }
    {
        const int gt = C.bid * NTHREADS + C.tid, GT = C.G * NTHREADS;
        for (int i = gt; i < 4 * 65536; i += GT) { const int l = i >> 16, e = i & 65535; ((bf16_t*)(C.wl(l) + WL_SP))[e] = (bf16_t)f2bf(p.in[I_SPW][i]); }
        for (int i = gt; i < 4 * 160 * 1024 / 2; i += GT) { const int l = i / (160 * 512), e = i % (160 * 512); ((unsigned*)(C.wl(l) + WL_IN + (size_t)NP * D * 2))[e] = 0u; }
        for (int i = gt; i < 128 * 64; i += GT) { const int m = i >> 6, c = i & 63; const int idx = ((m & 63) * c) & 63; const float a = (float)idx / 32.f;
            ((bf16_t*)(C.ws + WS_F64))[i] = (bf16_t)f2bf(m < 64 ? cospif(a) : sinpif(a)); }
        for (int i = gt; i < 64 * 128; i += GT) { const int k = i >> 7, K = i & 127; const int idx = (k * (K & 63)) & 63; const float a = (float)idx / 32.f; const float cv = cospif(a), sv = sinpif(a);
            ((bf16_t*)(C.ws + WS_T64R))[i] = (bf16_t)f2bf(K < 64 ? cv : -sv);
            ((bf16_t*)(C.ws + WS_T64I))[i] = (bf16_t)f2bf(K < 64 ? -sv : -cv);
            ((bf16_t*)(C.ws + WS_T64B))[i] = (bf16_t)f2bf(K < 64 ? cv : sv); }
        for (int i = gt; i < 256 * 512; i += GT) { const int k = i >> 9, K = i & 511; const int idx = (k * (K & 255)) & 255; const float a = (float)idx / 128.f;
            ((bf16_t*)(C.ws + WS_T256))[i] = (bf16_t)f2bf(K < 256 ? cospif(a) : -sinpif(a)); }
        for (int i = gt; i < 4096; i += GT) { const float a = (float)i / 2048.f; ((f32x2*)(C.ws + WS_TW))[i] = (f32x2){cospif(a), sinpif(a)}; }
        for (int i = gt; i < 512; i += GT) { const int pos = i >> 3, f = i & 7; const float inv = powf(10000.f, -(float)f / 8.f); const float ang = (float)pos * inv;
            ((f32x2*)(C.ws + WS_ROPE))[i] = (f32x2){cosf(ang), sinf(ang)}; }
    }
}

__device__ __forceinline__ void load_row_f32(const float* rowp, int lane, f32x4 (&v)[4]) {
#pragma unroll
    for (int j = 0; j < 4; ++j) v[j] = *(const f32x4*)(rowp + 4 * lane + 256 * j);
}
__device__ __forceinline__ void load_row_bf16(const bf16_t* rowp, int lane, f32x4 (&v)[4]) {
#pragma unroll
    for (int j = 0; j < 4; ++j) { const u32x2 w = *(const u32x2*)(rowp + 4 * lane + 256 * j); v[j] = (f32x4){bflo(w.x), bfhi(w.x), bflo(w.y), bfhi(w.y)}; }
}
__device__ __forceinline__ float row_rstd(const f32x4 (&v)[4]) {
    float s = 0.f;
#pragma unroll
    for (int j = 0; j < 4; ++j) s += (v[j][0] * v[j][0] + v[j][1] * v[j][1]) + (v[j][2] * v[j][2] + v[j][3] * v[j][3]);
    return 1.f / sqrtf(wave_sum(s) * (1.f / 1024.f) + EPS);
}
__device__ __forceinline__ void norm_mod_store(const f32x4 (&x)[4], const float* g, const float* scale, const float* shift, bf16_t* orow, int lane) {
    const float rs = row_rstd(x);
#pragma unroll
    for (int j = 0; j < 4; ++j) { const int c = 4 * lane + 256 * j; const f32x4 gv = *(const f32x4*)(g + c), sv = *(const f32x4*)(scale + c), hv = *(const f32x4*)(shift + c);
        const f32x4 h = x[j] * rs * gv * (1.f + sv) + hv; *(u32x2*)(orow + c) = pk4(h); }
}
__device__ __forceinline__ void norm_mod_store_g(const f32x4 (&x)[4], const f32x4 (&gv)[4], const float* scale, const float* shift, bf16_t* orow, int lane) {
    const float rs = row_rstd(x);
#pragma unroll
    for (int j = 0; j < 4; ++j) { const int c = 4 * lane + 256 * j; const f32x4 sv = *(const f32x4*)(scale + c), hv = *(const f32x4*)(shift + c);
        const f32x4 h = x[j] * rs * gv[j] * (1.f + sv) + hv; *(u32x2*)(orow + c) = pk4(h); }
}
__device__ __forceinline__ const float* xin_row(const Ctx& C, int layer, int r) {
    if (layer > 0) return C.p.out + OUT_X + (size_t)r * D;
    size_t za = 0, zb = 0; asm volatile("" : "+s"(za), "+s"(zb));
    const float* a = C.p.in[I_XP] + za; const float* b = C.p.in[I_XS] + zb;
    return r < M_CTX ? a + (size_t)r * D : b + (size_t)(r - M_CTX) * D;
}
constexpr int SPLIT_ROW0 = 16384;
__device__ __forceinline__ void load_T(const bf16_t* T, const bf16_t* T1, bool split, int r, int lane, f32x4 (&v)[4]) {
    load_row_bf16(T + (size_t)r * D, lane, v);
    if (split && r >= SPLIT_ROW0) { f32x4 w[4]; load_row_bf16(T1 + (size_t)r * D, lane, w);
#pragma unroll
        for (int j = 0; j < 4; ++j) v[j] = v[j] + w[j]; }
}
__device__ __forceinline__ void phase_norm0(const Ctx& C) {
    const int gw = C.bid * NWAVES + C.wave, NGW = C.G * NWAVES;
    bf16_t* H = (bf16_t*)(C.ws + WS_R1);
    f32x4 xn[4]; load_row_f32(xin_row(C, 0, gw), C.lane, xn);
    for (int r = gw; r < M; r += NGW) { f32x4 x[4];
#pragma unroll
        for (int j = 0; j < 4; ++j) x[j] = xn[j];
        if (r + NGW < M) load_row_f32(xin_row(C, 0, r + NGW), C.lane, xn);
        const int mi = mod_of_row(r);
        norm_mod_store(x, C.p.in[I_GPM], C.mod(0, mi, 1), C.mod(0, mi, 0), H + (size_t)r * D, C.lane); }
}
template <int which  > __device__ __forceinline__ void phase_post(const Ctx& C, int layer) {
    const int gw = C.bid * NWAVES + C.wave, NGW = C.G * NWAVES;
    const bf16_t* T = (const bf16_t*)(C.ws + (which == 0 ? WS_R2 : WS_MLA));
    const bf16_t* T1 = T + (size_t)M * D - (size_t)SPLIT_ROW0 * D;
    const bool split = (C.G == 256);
    bf16_t* H = (bf16_t*)(C.ws + WS_R1);
    const float* gpost = (which == 0 ? C.p.in[I_GPOM] : C.p.in[I_GPOF]) + layer * D;
    const bool do_next = (which == 0) || (layer + 1 < DEPTH);
    const int nl = which == 0 ? layer : layer + 1;
    const float* gnext = (which == 0 ? C.p.in[I_GPF] : C.p.in[I_GPM]) + (nl < DEPTH ? nl : 0) * D;
    f32x4 gg[4], gs[4], sh[4]; int cur_mi = -1;
#pragma unroll
    for (int j = 0; j < 4; ++j) { gg[j] = (f32x4){0.f, 0.f, 0.f, 0.f}; gs[j] = gg[j]; sh[j] = gg[j]; }
    f32x4 tn[4], xn[4];
    load_T(T, T1, split, gw, C.lane, tn); load_row_f32(which == 0 ? xin_row(C, layer, gw) : C.p.out + OUT_X + (size_t)gw * D, C.lane, xn);
    for (int r = gw; r < M; r += NGW) {
        const int mi = mod_of_row(r);
        if (mi != cur_mi) { cur_mi = mi;
            const float* gate = C.mod(layer, mi, which == 0 ? 2 : 5); const float* scale = C.mod(nl, mi, which == 0 ? 4 : 1); const float* shift = C.mod(nl, mi, which == 0 ? 3 : 0);
#pragma unroll
            for (int j = 0; j < 4; ++j) { const int c = 4 * C.lane + 256 * j; gg[j] = *(const f32x4*)(gate + c) * *(const f32x4*)(gpost + c);
                if (do_next) { gs[j] = *(const f32x4*)(gnext + c) * (1.f + *(const f32x4*)(scale + c)); sh[j] = *(const f32x4*)(shift + c); } } }
        f32x4 t[4], x[4];
#pragma unroll
        for (int j = 0; j < 4; ++j) { t[j] = tn[j]; x[j] = xn[j]; }
        if (r + NGW < M) { const int rn = r + NGW; load_T(T, T1, split, rn, C.lane, tn); load_row_f32(which == 0 ? xin_row(C, layer, rn) : C.p.out + OUT_X + (size_t)rn * D, C.lane, xn); }
        const float rs = row_rstd(t);
        float* xo = C.p.out + OUT_X + (size_t)r * D;
#pragma unroll
        for (int j = 0; j < 4; ++j) { const int c = 4 * C.lane + 256 * j; x[j] = x[j] + gg[j] * (t[j] * rs); __builtin_nontemporal_store(x[j], (f32x4*)(xo + c)); }
        if (do_next) { const float rs2 = row_rstd(x); bf16_t* orow = H + (size_t)r * D;
#pragma unroll
            for (int j = 0; j < 4; ++j) { const int c = 4 * C.lane + 256 * j; const f32x4 h = x[j] * rs2 * gs[j] + sh[j]; *(u32x2*)(orow + c) = pk4(h); } }
    }
}

__device__ __forceinline__ void unit_chunk_mlp(const Ctx& C, int layer, int u) {
    const int chunk = u >> 2, g = u & 3, r0 = chunk * 128;
    const bf16_t* PROJ = (const bf16_t*)(C.ws + WS_R2); bf16_t* MIX = (bf16_t*)(C.ws + WS_R1);
    constexpr int VS = 136;
    LAS bf16_t* Vt = (LAS bf16_t*)C.lds;
    { const int q = C.tid >> 2, c0 = (C.tid & 3) * 16; const bf16_t* src = PROJ + (size_t)(r0 + q) * NP + PC_V + g * 64 + c0;
      const bf16x8 v0 = *(const bf16x8*)src, v1 = *(const bf16x8*)(src + 8);
#pragma unroll
      for (int j = 0; j < 8; ++j) { Vt[(c0 + j) * VS + q] = (bf16_t)v0[j]; Vt[(c0 + 8 + j) * VS + q] = (bf16_t)v1[j]; } }
    __syncthreads();
    const int l15 = C.lane & 15, hq = C.lane >> 4, w = C.wave;
    const bf16_t* Wg = (const bf16_t*)(C.wl(layer) + WL_SP) + (size_t)g * 128 * 128;
    bf16x8 bw[4];
#pragma unroll
    for (int ks = 0; ks < 4; ++ks) bw[ks] = *(const bf16x8*)(Wg + (size_t)(w * 16 + l15) * 128 + ks * 32 + 8 * hq);
    const int p = w * 16 + l15; const float bias = C.p.in[I_SPB][(layer * 4 + g) * 128 + p];
#pragma unroll
    for (int ct = 0; ct < 4; ++ct) {
        f32x4 acc = {0.f, 0.f, 0.f, 0.f};
#pragma unroll
        for (int ks = 0; ks < 4; ++ks) { const bf16x8 a = *(const LAS bf16x8*)(Vt + (ct * 16 + l15) * VS + ks * 32 + 8 * hq); acc = mma16(a, bw[ks], acc); }
        const int cc = g * 64 + ct * 16 + 4 * hq; const u32x2 uw = *(const u32x2*)(PROJ + (size_t)(r0 + p) * NP + PC_U + cc);
        f32x4 o; o[0] = bflo(uw.x) * (acc[0] + bias); o[1] = bfhi(uw.x) * (acc[1] + bias); o[2] = bflo(uw.y) * (acc[2] + bias); o[3] = bfhi(uw.y) * (acc[3] + bias);
        *(u32x2*)(MIX + (size_t)(r0 + p) * D + cc) = pk4(o);
    }
    __syncthreads();
}
__device__ __forceinline__ void unit_conv(const Ctx& C, int layer, int u) {
    const bf16_t* PROJ = (const bf16_t*)(C.ws + WS_R2); bf16_t* MIX = (bf16_t*)(C.ws + WS_R1);
    const float* cw = C.p.in[I_CVW] + layer * 3 * 256; const float* cb = C.p.in[I_CVB] + layer * 256;
    for (int it = 0; it < 8; ++it) {
        const int item = it * NTHREADS + C.tid, t = item >> 5, ch = (item & 31) * 8, r = u * 128 + t;
        const int pos = r < M_CTX ? (r & 255) : ((r - M_CTX) & 4095), len = r < M_CTX ? 256 : 4096;
        const bf16_t* base = PROJ + (size_t)r * NP;
        const bf16x8 h1 = *(const bf16x8*)(base + PC_H + ch), c1 = *(const bf16x8*)(base + PC_C + ch), gb = *(const bf16x8*)(base + PC_B + ch);
        bf16x8 h0 = h1, c0 = c1, h2 = h1, c2 = c1; const bool hasp = pos > 0, hasn = pos < len - 1;
        if (hasp) { h0 = *(const bf16x8*)(base - NP + PC_H + ch); c0 = *(const bf16x8*)(base - NP + PC_C + ch); }
        if (hasn) { h2 = *(const bf16x8*)(base + NP + PC_H + ch); c2 = *(const bf16x8*)(base + NP + PC_C + ch); }
        float o[8];
#pragma unroll
        for (int j = 0; j < 8; ++j) {
            const float z0 = hasp ? bf1((bf16_t)h0[j]) * bf1((bf16_t)c0[j]) : 0.f, z1 = bf1((bf16_t)h1[j]) * bf1((bf16_t)c1[j]), z2 = hasn ? bf1((bf16_t)h2[j]) * bf1((bf16_t)c2[j]) : 0.f;
            const float y = z0 * cw[ch + j] + z1 * cw[256 + ch + j] + z2 * cw[512 + ch + j] + cb[ch + j];
            o[j] = bf1((bf16_t)gb[j]) * y; }
        u32x4 w; w.x = pk2(o[0], o[1]); w.y = pk2(o[2], o[3]); w.z = pk2(o[4], o[5]); w.w = pk2(o[6], o[7]);
        *(u32x4*)(MIX + (size_t)r * D + 256 + ch) = w;
    }
}
__device__ __forceinline__ void unit_fourier_ctx(const Ctx& C, int u) {
    const int s = u >> 2, g = u & 3, l15 = C.lane & 15, hq = C.lane >> 4, w = C.wave;
    const bf16_t* PROJ = (const bf16_t*)(C.ws + WS_R2); bf16_t* MIX = (bf16_t*)(C.ws + WS_R1);
    const bf16_t* F64 = (const bf16_t*)(C.ws + WS_F64); const bf16_t* T256 = (const bf16_t*)(C.ws + WS_T256);
    constexpr int ZS = 520; LAS bf16_t* Zt = (LAS bf16_t*)C.lds;
#pragma unroll
    for (int i = 0; i < 2; ++i) { const int nt = 2 * w + i;
        bf16x8 a[2];
#pragma unroll
        for (int ks = 0; ks < 2; ++ks) a[ks] = *(const bf16x8*)(PROJ + (size_t)(s * 256 + nt * 16 + l15) * NP + PC_F + g * 64 + ks * 32 + 8 * hq);
#pragma unroll
        for (int mt = 0; mt < 8; ++mt) { f32x4 acc = {0.f, 0.f, 0.f, 0.f};
#pragma unroll
            for (int ks = 0; ks < 2; ++ks) { const bf16x8 b = *(const bf16x8*)(F64 + (size_t)(mt * 16 + l15) * 64 + ks * 32 + 8 * hq); acc = mma16(a[ks], b, acc); }
            const int mp = mt * 16 + l15;
            *(LAS u32x2*)(Zt + (mp & 63) * ZS + (mp >> 6) * 256 + nt * 16 + 4 * hq) = pk4(acc); } }
    __syncthreads();
#pragma unroll 1
    for (int i = 0; i < 2; ++i) { const int kt = 2 * w + i;
        f32x4 acc[4];
#pragma unroll
        for (int mt = 0; mt < 4; ++mt) acc[mt] = (f32x4){0.f, 0.f, 0.f, 0.f};
#pragma unroll 8
        for (int ks = 0; ks < 16; ++ks) { const bf16x8 b = *(const bf16x8*)(T256 + (size_t)(kt * 16 + l15) * 512 + ks * 32 + 8 * hq);
#pragma unroll
            for (int mt = 0; mt < 4; ++mt) { const bf16x8 a = *(const LAS bf16x8*)(Zt + (mt * 16 + l15) * ZS + ks * 32 + 8 * hq); acc[mt] = mma16(a, b, acc[mt]); } }
#pragma unroll
        for (int mt = 0; mt < 4; ++mt) *(u32x2*)(MIX + (size_t)(s * 256 + kt * 16 + l15) * D + 512 + g * 64 + mt * 16 + 4 * hq) = pk4(acc[mt] * (1.f / 128.f)); }
    __syncthreads();
}
__device__ __forceinline__ void unit_fourier_lat1(const Ctx& C, int u) {
    const int b = u >> 5, g = (u >> 3) & 3, nb = u & 7, l15 = C.lane & 15, hq = C.lane >> 4, n2 = nb * 8 + C.wave;
    const bf16_t* PROJ = (const bf16_t*)(C.ws + WS_R2);
    const bf16_t* F64 = (const bf16_t*)(C.ws + WS_F64); const bf16_t* T64R = (const bf16_t*)(C.ws + WS_T64R); const bf16_t* T64I = (const bf16_t*)(C.ws + WS_T64I);
    const f32x2* TW = (const f32x2*)(C.ws + WS_TW);
    bf16_t* GB = (bf16_t*)(C.ws + WS_GB) + (size_t)((b * 4 + g) * 64 + n2) * 64 * 128;
    constexpr int ZS = 136; LAS bf16_t* Zt = (LAS bf16_t*)(C.lds + C.wave * (64 * ZS * 2));
#pragma unroll 2
    for (int nt = 0; nt < 4; ++nt) {
        bf16x8 a[2];
#pragma unroll
        for (int ks = 0; ks < 2; ++ks) a[ks] = *(const bf16x8*)(PROJ + (size_t)(M_CTX + b * 4096 + (nt * 16 + l15) * 64 + n2) * NP + PC_F + g * 64 + ks * 32 + 8 * hq);
#pragma unroll
        for (int mt = 0; mt < 8; ++mt) { f32x4 acc = {0.f, 0.f, 0.f, 0.f};
#pragma unroll
            for (int ks = 0; ks < 2; ++ks) { const bf16x8 bb = *(const bf16x8*)(F64 + (size_t)(mt * 16 + l15) * 64 + ks * 32 + 8 * hq); acc = mma16(a[ks], bb, acc); }
            const int mp = mt * 16 + l15;
            *(LAS u32x2*)(Zt + (mp & 63) * ZS + (mp >> 6) * 64 + nt * 16 + 4 * hq) = pk4(acc); } }
    asm volatile("s_waitcnt lgkmcnt(0)" ::: "memory");
#pragma unroll 2
    for (int kt = 0; kt < 4; ++kt) {
        bf16x8 br[4], bi[4];
#pragma unroll
        for (int ks = 0; ks < 4; ++ks) { br[ks] = *(const bf16x8*)(T64R + (size_t)(kt * 16 + l15) * 128 + ks * 32 + 8 * hq); bi[ks] = *(const bf16x8*)(T64I + (size_t)(kt * 16 + l15) * 128 + ks * 32 + 8 * hq); }
        const int k1 = kt * 16 + l15; const f32x2 tw = TW[k1 * n2];
#pragma unroll
        for (int mt = 0; mt < 4; ++mt) { f32x4 ar = {0.f, 0.f, 0.f, 0.f}, ai = {0.f, 0.f, 0.f, 0.f};
#pragma unroll
            for (int ks = 0; ks < 4; ++ks) { const bf16x8 a = *(const LAS bf16x8*)(Zt + (mt * 16 + l15) * ZS + ks * 32 + 8 * hq); ar = mma16(a, br[ks], ar); ai = mma16(a, bi[ks], ai); }
            const f32x4 gr = ar * tw[0] + ai * tw[1], gi = ai * tw[0] - ar * tw[1];
            bf16_t* dst = GB + (size_t)k1 * 128 + mt * 16 + 4 * hq;
            *(u32x2*)dst = pk4(gr); *(u32x2*)(dst + 64) = pk4(gi); } }
    __syncthreads();
}
__device__ __forceinline__ void unit_fourier_lat2(const Ctx& C, int u) {
    const int b = u >> 5, g = (u >> 3) & 3, kb = u & 7, l15 = C.lane & 15, hq = C.lane >> 4, k1 = kb * 8 + C.wave;
    const bf16_t* T64B = (const bf16_t*)(C.ws + WS_T64B); bf16_t* MIX = (bf16_t*)(C.ws + WS_R1);
    const bf16_t* GB = (const bf16_t*)(C.ws + WS_GB) + (size_t)((b * 4 + g) * 64) * 64 * 128 + (size_t)k1 * 128;
    constexpr int ZS = 136; LAS bf16_t* Tt = (LAS bf16_t*)(C.lds + C.wave * (64 * ZS * 2));
#pragma unroll 4
    for (int it = 0; it < 16; ++it) { const int q = it * 64 + C.lane, n2 = q >> 4, cc = q & 15, part = cc >> 3, m0 = (cc & 7) * 8;
        const bf16x8 v = *(const bf16x8*)(GB + (size_t)n2 * 64 * 128 + cc * 8);
#pragma unroll
        for (int j = 0; j < 8; ++j) Tt[(m0 + j) * ZS + part * 64 + n2] = (bf16_t)v[j]; }
    asm volatile("s_waitcnt lgkmcnt(0)" ::: "memory");
#pragma unroll 2
    for (int kt = 0; kt < 4; ++kt) {
        bf16x8 bb[4];
#pragma unroll
        for (int ks = 0; ks < 4; ++ks) bb[ks] = *(const bf16x8*)(T64B + (size_t)(kt * 16 + l15) * 128 + ks * 32 + 8 * hq);
        const int k2 = kt * 16 + l15; const int row = M_CTX + b * 4096 + k1 + 64 * k2;
#pragma unroll
        for (int mt = 0; mt < 4; ++mt) { f32x4 acc = {0.f, 0.f, 0.f, 0.f};
#pragma unroll
            for (int ks = 0; ks < 4; ++ks) { const bf16x8 a = *(const LAS bf16x8*)(Tt + (mt * 16 + l15) * ZS + ks * 32 + 8 * hq); acc = mma16(a, bb[ks], acc); }
            *(u32x2*)(MIX + (size_t)row * D + 512 + g * 64 + mt * 16 + 4 * hq) = pk4(acc * (1.f / 512.f)); } }
    __syncthreads();
}
constexpr float QSCALE = 0.10206207261596577f * 1.4426950408889634f;
__device__ __forceinline__ void unit_mla_prep(const Ctx& C, int layer, int u) {
    const Params& p = C.p;
    const bf16_t* PROJ = (const bf16_t*)(C.ws + WS_R2);
    bf16_t* Q = (bf16_t*)(C.ws + WS_Q); bf16_t* KN = (bf16_t*)(C.ws + WS_KN); bf16_t* VT = (bf16_t*)(C.ws + WS_VT); bf16_t* KR = (bf16_t*)(C.ws + WS_KR);
    const f32x2* ROPE = (const f32x2*)(C.ws + WS_ROPE);
    constexpr int QS = 200, KS = 136;
    LAS bf16_t* CQ = (LAS bf16_t*)C.lds;
    LAS bf16_t* CK = (LAS bf16_t*)(C.lds + 128 * QS * 2);
    const bool is_tok = u < 192;
    int r0 = 0, keyrow0, keypos0, nk; size_t vtbase; bool lat;
    if (is_tok) { r0 = u * 128; lat = r0 >= M_CTX;
        if (!lat) { keyrow0 = r0; keypos0 = r0 & 255; nk = 256; vtbase = (size_t)(r0 & ~255) * 256; }
        else { const int b = (r0 - M_CTX) >> 12, n = (r0 - M_CTX) & 4095; keyrow0 = M_CTX + b * 4352 + n; keypos0 = n; nk = 4352; vtbase = (size_t)(M_CTX + b * 4352) * 256; } }
    else { const int cu = u - 192, b = cu >> 1, half = cu & 1; lat = true; keyrow0 = M_CTX + b * 4352 + 4096 + half * 128; keypos0 = 4096 + half * 128; nk = 4352; vtbase = (size_t)(M_CTX + b * 4352) * 256; }
    { const int t = C.tid >> 2, sub = C.tid & 3;
      if (is_tok) {
        const int r = r0 + t; const bf16_t* base = PROJ + (size_t)r * NP;
        float q[48], k[32]; float sq = 0.f, sk = 0.f;
#pragma unroll
        for (int i = 0; i < 6; ++i) { const bf16x8 v = *(const bf16x8*)(base + PC_Q + sub * 48 + i * 8);
#pragma unroll
            for (int j = 0; j < 8; ++j) { q[i * 8 + j] = bf1((bf16_t)v[j]); sq += q[i * 8 + j] * q[i * 8 + j]; } }
#pragma unroll
        for (int i = 0; i < 4; ++i) { const bf16x8 v = *(const bf16x8*)(base + PC_KV + sub * 32 + i * 8);
#pragma unroll
            for (int j = 0; j < 8; ++j) { k[i * 8 + j] = bf1((bf16_t)v[j]); sk += k[i * 8 + j] * k[i * 8 + j]; } }
        sq += __shfl_xor(sq, 1); sq += __shfl_xor(sq, 2); sk += __shfl_xor(sk, 1); sk += __shfl_xor(sk, 2);
        const float rq = 1.f / sqrtf(sq * (1.f / 192.f) + EPS), rk = 1.f / sqrtf(sk * (1.f / 128.f) + EPS);
        const float* gq = p.in[I_GQ] + layer * 192 + sub * 48; const float* gk = p.in[I_GKV] + layer * 128 + sub * 32;
#pragma unroll
        for (int i = 0; i < 6; ++i) { u32x4 w; w.x = pk2(q[i * 8 + 0] * rq * gq[i * 8 + 0], q[i * 8 + 1] * rq * gq[i * 8 + 1]); w.y = pk2(q[i * 8 + 2] * rq * gq[i * 8 + 2], q[i * 8 + 3] * rq * gq[i * 8 + 3]);
            w.z = pk2(q[i * 8 + 4] * rq * gq[i * 8 + 4], q[i * 8 + 5] * rq * gq[i * 8 + 5]); w.w = pk2(q[i * 8 + 6] * rq * gq[i * 8 + 6], q[i * 8 + 7] * rq * gq[i * 8 + 7]);
            *(LAS u32x4*)(CQ + t * QS + sub * 48 + i * 8) = w; }
        float* sckv = nullptr;
        if (!lat) { const int s = r >> 8, pos = r & 255; sckv = p.out + OUT_CKV + ((size_t)(s * 4 + layer) * 256 + pos) * 128 + sub * 32; }
#pragma unroll
        for (int i = 0; i < 4; ++i) { float o[8];
#pragma unroll
            for (int j = 0; j < 8; ++j) o[j] = k[i * 8 + j] * rk * gk[i * 8 + j];
            u32x4 w; w.x = pk2(o[0], o[1]); w.y = pk2(o[2], o[3]); w.z = pk2(o[4], o[5]); w.w = pk2(o[6], o[7]);
            *(LAS u32x4*)(CK + t * KS + sub * 32 + i * 8) = w;
            if (!lat) { *(f32x4*)(sckv + i * 8) = (f32x4){o[0], o[1], o[2], o[3]}; *(f32x4*)(sckv + i * 8 + 4) = (f32x4){o[4], o[5], o[6], o[7]}; } }
        { const bf16x8 v = *(const bf16x8*)(base + PC_KR + sub * 8); float x[8], o[8];
#pragma unroll
          for (int j = 0; j < 8; ++j) x[j] = bf1((bf16_t)v[j]);
          if (lat) { const int n = (r - M_CTX) & 4095; const int pos = (sub >> 1) == 0 ? (n >> 6) : (n & 63);
#pragma unroll
              for (int j = 0; j < 8; ++j) { const float pr = __shfl_xor(x[j], 1); const f32x2 cs = ROPE[pos * 8 + j]; o[j] = (sub & 1) == 0 ? x[j] * cs[0] - pr * cs[1] : x[j] * cs[0] + pr * cs[1]; } }
          else {
#pragma unroll
              for (int j = 0; j < 8; ++j) o[j] = x[j];
              const int s = r >> 8, pos = r & 255; float* skr = p.out + OUT_KR + ((size_t)(s * 4 + layer) * 256 + pos) * 32 + sub * 8;
              *(f32x4*)skr = (f32x4){o[0], o[1], o[2], o[3]}; *(f32x4*)(skr + 4) = (f32x4){o[4], o[5], o[6], o[7]}; }
          u32x4 w; w.x = pk2(o[0], o[1]); w.y = pk2(o[2], o[3]); w.z = pk2(o[4], o[5]); w.w = pk2(o[6], o[7]);
          *(u32x4*)(KR + (size_t)(keyrow0 + t) * 32 + sub * 8) = w; }
      } else {
        const int cu = u - 192, b = cu >> 1, half = cu & 1, row = half * 128 + t;
        const float* src = p.in[I_CCKV] + ((size_t)(b * 4 + layer) * 256 + row) * 128 + sub * 32;
#pragma unroll
        for (int i = 0; i < 4; ++i) { const f32x4 v0 = *(const f32x4*)(src + i * 8), v1 = *(const f32x4*)(src + i * 8 + 4);
            u32x4 w; w.x = pk2(v0[0], v0[1]); w.y = pk2(v0[2], v0[3]); w.z = pk2(v1[0], v1[1]); w.w = pk2(v1[2], v1[3]);
            *(LAS u32x4*)(CK + t * KS + sub * 32 + i * 8) = w; }
        const float* ksrc = p.in[I_CKR] + ((size_t)(b * 4 + layer) * 256 + row) * 32 + sub * 8;
        const f32x4 v0 = *(const f32x4*)ksrc, v1 = *(const f32x4*)(ksrc + 4);
        u32x4 w; w.x = pk2(v0[0], v0[1]); w.y = pk2(v0[2], v0[3]); w.z = pk2(v1[0], v1[1]); w.w = pk2(v1[2], v1[3]);
        *(u32x4*)(KR + (size_t)(keyrow0 + t) * 32 + sub * 8) = w;
      } }
    __syncthreads();
    const int l15 = C.lane & 15, hq = C.lane >> 4, w = C.wave;
    if (is_tok) {
        const bf16_t* Wq = (const bf16_t*)(C.wl(layer) + WL_UQ);
        bf16x8 aq[3][6];
#pragma unroll
        for (int j = 0; j < 3; ++j)
#pragma unroll
            for (int ks = 0; ks < 6; ++ks) aq[j][ks] = *(const bf16x8*)(Wq + (size_t)((3 * w + j) * 16 + l15) * 192 + ks * 32 + 8 * hq);
#pragma unroll 2
        for (int tt = 0; tt < 8; ++tt) {
            bf16x8 bq[6];
#pragma unroll
            for (int ks = 0; ks < 6; ++ks) bq[ks] = *(const LAS bf16x8*)(CQ + (tt * 16 + l15) * QS + ks * 32 + 8 * hq);
            const int r = r0 + tt * 16 + l15; const int n = (r - M_CTX) & 4095;
#pragma unroll
            for (int j = 0; j < 3; ++j) { const int nt = 3 * w + j; f32x4 acc = {0.f, 0.f, 0.f, 0.f};
#pragma unroll
                for (int ks = 0; ks < 6; ++ks) acc = mma16(aq[j][ks], bq[ks], acc);
                const int sub6 = nt % 6;
                if (lat && sub6 >= 4) { const int pos = sub6 == 4 ? (n >> 6) : (n & 63);
#pragma unroll
                    for (int jj = 0; jj < 4; ++jj) { const float pr = __shfl_xor(acc[jj], 32); const f32x2 cs = ROPE[pos * 8 + ((4 * hq + jj) & 7)]; acc[jj] = hq < 2 ? acc[jj] * cs[0] - pr * cs[1] : acc[jj] * cs[0] + pr * cs[1]; } }
                *(u32x2*)(Q + (size_t)r * 384 + nt * 16 + 4 * hq) = pk4(acc * QSCALE); }
        }
    }
    { const bf16_t* Wkv = (const bf16_t*)(C.wl(layer) + WL_UKV);
      bf16x8 wf[4][4];
#pragma unroll
      for (int j = 0; j < 4; ++j)
#pragma unroll
          for (int ks = 0; ks < 4; ++ks) wf[j][ks] = *(const bf16x8*)(Wkv + (size_t)((4 * w + j) * 16 + l15) * 128 + ks * 32 + 8 * hq);
      const int h = w >> 1; const bool isv = (w & 1) != 0;
#pragma unroll 2
      for (int tt = 0; tt < 8; ++tt) {
          bf16x8 ck[4];
#pragma unroll
          for (int ks = 0; ks < 4; ++ks) ck[ks] = *(const LAS bf16x8*)(CK + (tt * 16 + l15) * KS + ks * 32 + 8 * hq);
#pragma unroll
          for (int j = 0; j < 4; ++j) { f32x4 acc = {0.f, 0.f, 0.f, 0.f};
              if (!isv) {
#pragma unroll
                  for (int ks = 0; ks < 4; ++ks) acc = mma16(wf[j][ks], ck[ks], acc);
                  *(u32x2*)(KN + (size_t)(keyrow0 + tt * 16 + l15) * 256 + h * 64 + j * 16 + 4 * hq) = pk4(acc);
              } else {
#pragma unroll
                  for (int ks = 0; ks < 4; ++ks) acc = mma16(ck[ks], wf[j][ks], acc);
                  *(u32x2*)(VT + vtbase + (size_t)(h * 64 + j * 16 + l15) * nk + keypos0 + tt * 16 + 4 * hq) = pk4(acc);
              } } } }
    __syncthreads();
}

constexpr int AKS = 104, AVS = 72;
constexpr int ABUF = 64 * AKS * 2 + 64 * AVS * 2;
__device__ __forceinline__ int imax3(int a, int b, int c) { return max(a, max(b, c)); }
constexpr int AVS2 = 136; constexpr int ABUF2 = 128 * AKS * 2 + 64 * AVS2 * 2;
__device__ __forceinline__ void unit_attention(const Ctx& C, int u) {
    int rowbase, keyrow0, nk, h; size_t vtbase;
    if (u < 128) { const int s = u >> 2; h = u & 3; rowbase = s * 256; keyrow0 = s * 256; nk = 256; vtbase = (size_t)(s * 256) * 256; }
    else { const int v0 = u - 128; const int v = (C.G == 256) ? (((v0 & 7) * 2 + (v0 >> 7)) << 4) | ((v0 >> 3) & 15) : v0;
           const int b = v >> 6, qb = v & 15; h = (v >> 4) & 3; rowbase = M_CTX + b * 4096 + qb * 256; keyrow0 = M_CTX + b * 4352; nk = 4352; vtbase = (size_t)keyrow0 * 256; }
    const bf16_t* Q = (const bf16_t*)(C.ws + WS_Q); const bf16_t* KN = (const bf16_t*)(C.ws + WS_KN); const bf16_t* VT = (const bf16_t*)(C.ws + WS_VT); const bf16_t* KR = (const bf16_t*)(C.ws + WS_KR);
    bf16_t* MIX = (bf16_t*)(C.ws + WS_R1);
    const int l31 = C.lane & 31, hh = C.lane >> 5; const int qrow = rowbase + C.wave * 32 + l31;
    bf16x8 qf[6];
#pragma unroll
    for (int ks = 0; ks < 6; ++ks) qf[ks] = *(const bf16x8*)(Q + (size_t)qrow * 384 + h * 96 + ks * 16 + 8 * hh);
    f32x16 o0, o1, o2, negm;
#pragma unroll
    for (int i = 0; i < 16; ++i) { o0[i] = 0.f; o1[i] = 0.f; o2[i] = 0.f; negm[i] = 0.f; }
    const unsigned onew = (l31 == 0) ? 0x3F803F80u : 0u;
    const bf16x8 onesf = __builtin_bit_cast(bf16x8, (u32x4){onew, onew, onew, onew});
    const int skey = C.tid >> 3, sc8 = (C.tid & 7) * 8, rkey = (C.tid & 255) >> 2, rc8 = (C.tid & 3) * 8;
    const bf16_t* gkn = KN + (size_t)(keyrow0 + skey) * 256 + h * 64 + sc8;
    const bf16_t* gkr = KR + (size_t)(keyrow0 + rkey) * 32 + rc8;
    const bf16_t* gvt = VT + vtbase + (size_t)(h * 64 + skey) * nk + sc8;
    const bool do_r = C.tid < 256;
    const int lkn = (skey * AKS + sc8) * 2, lkr = (rkey * AKS + 64 + rc8) * 2, lvt = 128 * AKS * 2 + (skey * AVS2 + sc8) * 2;
    const int ntile = nk >> 7;
    u32x4 rk[2], rr[2] = {{0u, 0u, 0u, 0u}, {0u, 0u, 0u, 0u}}, rv[2];
#define ATT_LD(t) do { _Pragma("unroll") for (int s_ = 0; s_ < 2; ++s_) { rk[s_] = *(const u32x4*)(gkn + (size_t)(2 * (t) + s_) * 64 * 256); if (do_r) rr[s_] = *(const u32x4*)(gkr + (size_t)(2 * (t) + s_) * 64 * 32); rv[s_] = *(const u32x4*)(gvt + (2 * (t) + s_) * 64); } } while (0)
#define ATT_ST(buf) do { LAS unsigned char* b_ = C.lds + (buf) * ABUF2; _Pragma("unroll") for (int s_ = 0; s_ < 2; ++s_) { *(LAS u32x4*)(b_ + lkn + s_ * 64 * AKS * 2) = rk[s_]; if (do_r) *(LAS u32x4*)(b_ + lkr + s_ * 64 * AKS * 2) = rr[s_]; *(LAS u32x4*)(b_ + lvt + s_ * 128) = rv[s_]; } } while (0)
    ATT_LD(0); ATT_ST(0);
    __syncthreads();
#pragma unroll 1
    for (int kt = 0; kt < ntile; ++kt) {
        const bool more = kt + 1 < ntile;
        if (more) ATT_LD(kt + 1);
        LAS unsigned char* B = C.lds + (kt & 1) * ABUF2;
#pragma unroll 1
        for (int sub = 0; sub < 2; ++sub) {
        const LAS bf16_t* Kl = (const LAS bf16_t*)B + sub * 64 * AKS; const LAS bf16_t* Vl = (const LAS bf16_t*)(B + 128 * AKS * 2) + sub * 64;
        bf16x8 ka[2][6];
#pragma unroll
        for (int ks = 0; ks < 6; ++ks) { ka[0][ks] = *(const LAS bf16x8*)(Kl + l31 * AKS + ks * 16 + 8 * hh); ka[1][ks] = *(const LAS bf16x8*)(Kl + (32 + l31) * AKS + ks * 16 + 8 * hh); }
        __builtin_amdgcn_sched_barrier(0);
        f32x16 s0 = mma32(ka[0][0], qf[0], negm), s1 = mma32(ka[1][0], qf[0], negm);
#pragma unroll
        for (int ks = 1; ks < 6; ++ks) { s0 = mma32(ka[0][ks], qf[ks], s0); s1 = mma32(ka[1][ks], qf[ks], s1); }
        __builtin_amdgcn_sched_barrier(0);
        u32x2 vr[2][2][4];
#pragma unroll
        for (int t = 0; t < 2; ++t)
#pragma unroll
            for (int ss = 0; ss < 2; ++ss) { const int ko = 32 * t + 16 * ss + 4 * hh;
                vr[t][ss][0] = *(const LAS u32x2*)(Vl + l31 * AVS2 + ko); vr[t][ss][1] = *(const LAS u32x2*)(Vl + l31 * AVS2 + ko + 8);
                vr[t][ss][2] = *(const LAS u32x2*)(Vl + (32 + l31) * AVS2 + ko); vr[t][ss][3] = *(const LAS u32x2*)(Vl + (32 + l31) * AVS2 + ko + 8); }
        __builtin_amdgcn_sched_barrier(0);
        float d; bool resc;
        if (kt == 0 && sub == 0) {
            float mx = fmaxf(s0[0], s1[0]);
#pragma unroll
            for (int i = 1; i < 16; ++i) mx = fmaxf(mx, fmaxf(s0[i], s1[i]));
            d = fmaxf(mx, __shfl_xor(mx, 32)); resc = true;
        } else {
            int im = imax3(__builtin_bit_cast(int, s0[0]), __builtin_bit_cast(int, s1[0]), __builtin_bit_cast(int, s0[1]));
            im = imax3(im, __builtin_bit_cast(int, s1[1]), __builtin_bit_cast(int, s0[2])); im = imax3(im, __builtin_bit_cast(int, s1[2]), __builtin_bit_cast(int, s0[3]));
            im = imax3(im, __builtin_bit_cast(int, s1[3]), __builtin_bit_cast(int, s0[4])); im = imax3(im, __builtin_bit_cast(int, s1[4]), __builtin_bit_cast(int, s0[5]));
            im = imax3(im, __builtin_bit_cast(int, s1[5]), __builtin_bit_cast(int, s0[6])); im = imax3(im, __builtin_bit_cast(int, s1[6]), __builtin_bit_cast(int, s0[7]));
            im = imax3(im, __builtin_bit_cast(int, s1[7]), __builtin_bit_cast(int, s0[8])); im = imax3(im, __builtin_bit_cast(int, s1[8]), __builtin_bit_cast(int, s0[9]));
            im = imax3(im, __builtin_bit_cast(int, s1[9]), __builtin_bit_cast(int, s0[10])); im = imax3(im, __builtin_bit_cast(int, s1[10]), __builtin_bit_cast(int, s0[11]));
            im = imax3(im, __builtin_bit_cast(int, s1[11]), __builtin_bit_cast(int, s0[12])); im = imax3(im, __builtin_bit_cast(int, s1[12]), __builtin_bit_cast(int, s0[13]));
            im = imax3(im, __builtin_bit_cast(int, s1[13]), __builtin_bit_cast(int, s0[14])); im = imax3(im, __builtin_bit_cast(int, s1[14]), __builtin_bit_cast(int, s0[15]));
            im = max(im, __builtin_bit_cast(int, s1[15]));
            im = max(im, __shfl_xor(im, 32));
            resc = __builtin_amdgcn_ballot_w64(im > 0x41000000) != 0ull; d = im > 0x41000000 ? __builtin_bit_cast(float, im) : 0.f;
        }
        if (resc) {
            if (kt != 0 || sub != 0) { const float alpha = __builtin_amdgcn_exp2f(-d); o0 = o0 * alpha; o1 = o1 * alpha; o2 = o2 * alpha; }
            negm = negm - d; s0 = s0 - d; s1 = s1 - d;
        }
#pragma unroll
        for (int i = 0; i < 16; ++i) { s0[i] = __builtin_amdgcn_exp2f(s0[i]); s1[i] = __builtin_amdgcn_exp2f(s1[i]); }
#pragma unroll
        for (int t = 0; t < 2; ++t)
#pragma unroll
            for (int ss = 0; ss < 2; ++ss) {
                u32x4 w;
                if (t == 0) { w.x = pk2(s0[8 * ss + 0], s0[8 * ss + 1]); w.y = pk2(s0[8 * ss + 2], s0[8 * ss + 3]); w.z = pk2(s0[8 * ss + 4], s0[8 * ss + 5]); w.w = pk2(s0[8 * ss + 6], s0[8 * ss + 7]); }
                else { w.x = pk2(s1[8 * ss + 0], s1[8 * ss + 1]); w.y = pk2(s1[8 * ss + 2], s1[8 * ss + 3]); w.z = pk2(s1[8 * ss + 4], s1[8 * ss + 5]); w.w = pk2(s1[8 * ss + 6], s1[8 * ss + 7]); }
                const bf16x8 pf = __builtin_bit_cast(bf16x8, w);
                const bf16x8 va = __builtin_bit_cast(bf16x8, (u32x4){vr[t][ss][0].x, vr[t][ss][0].y, vr[t][ss][1].x, vr[t][ss][1].y}), vb = __builtin_bit_cast(bf16x8, (u32x4){vr[t][ss][2].x, vr[t][ss][2].y, vr[t][ss][3].x, vr[t][ss][3].y});
                o0 = mma32(va, pf, o0); o1 = mma32(vb, pf, o1); o2 = mma32(onesf, pf, o2);
            }
        }
        if (more) ATT_ST((kt + 1) & 1);
        __syncthreads();
    }
#undef ATT_LD
#undef ATT_ST
    const float lsum = o2[0] + __shfl_xor(o2[0], 32);
    const float inv = 1.f / lsum;
    bf16_t* orow = MIX + (size_t)qrow * D + 768 + h * 64;
#pragma unroll
    for (int i = 0; i < 4; ++i) { const int dv = 8 * i + 4 * hh;
        *(u32x2*)(orow + dv) = pk4((f32x4){o0[4 * i] * inv, o0[4 * i + 1] * inv, o0[4 * i + 2] * inv, o0[4 * i + 3] * inv});
        *(u32x2*)(orow + 32 + dv) = pk4((f32x4){o1[4 * i] * inv, o1[4 * i + 1] * inv, o1[4 * i + 2] * inv, o1[4 * i + 3] * inv}); }
}

#define XB_TMO      128
#define XB_XCNT(j)  (256  + 64 * (j))
#define XB_XSUB(j)  (1280 + 64 * (j))
#define XB_XGEN(j)  (2304 + 64 * (j))
#define XB_TOP      3328
#define XB_TOPGEN   3392
#define XCD_BAR_WORDS 3456
#define XB_SPIN_CAP (1u << 18)

__device__ __forceinline__ unsigned xb_ld(unsigned* p)              { return __hip_atomic_load(p, __ATOMIC_RELAXED, __HIP_MEMORY_SCOPE_AGENT); }
__device__ __forceinline__ unsigned xb_add(unsigned* p, unsigned v) { return __hip_atomic_fetch_add(p, v, __ATOMIC_RELAXED, __HIP_MEMORY_SCOPE_AGENT); }
__device__ __forceinline__ unsigned xb_xcc_id() { return (unsigned)__builtin_amdgcn_s_getreg((3 << 11) | 20) & 0xFu; }
#define XB_SPIN(cond, bar) do { unsigned _sp = 0; while (cond) { __builtin_amdgcn_s_sleep(1); \
    if ((++_sp & 255u) == 0u) { if (xb_ld(&(bar)[XB_TMO])) break; if (_sp > XB_SPIN_CAP) { atomicAdd(&(bar)[XB_TMO], 1u); break; } } } } while (0)

struct XcdBarrier {
    unsigned* bar; unsigned x;
    volatile LAS unsigned* st;
};

__device__ __forceinline__ XcdBarrier xcd_barrier_post(unsigned* bar, volatile LAS unsigned* st) {
    XcdBarrier b; b.bar = bar; b.x = xb_xcc_id(); b.st = st;
    if (threadIdx.x == 0) (void)xb_add(&bar[XB_XCNT(b.x)], 1u);
    return b;
}
__device__ __forceinline__ void xcd_barrier_complete(unsigned* bar, unsigned x, unsigned& nloc, unsigned& nx) {
    const unsigned G = gridDim.x * gridDim.y * gridDim.z;
    unsigned sum, cnt, mine, sp = 0u;
    for (;;) {
        sum = 0u; cnt = 0u; mine = 0u;
#pragma unroll
        for (unsigned j = 0; j < 16; ++j) { const unsigned c = xb_ld(&bar[XB_XCNT(j)]); sum += c; cnt += (c > 0u) ? 1u : 0u; mine = (j == x) ? c : mine; }
        if (sum == G) break;
        __builtin_amdgcn_s_sleep(1);
        if ((++sp & 255u) == 0u) { if (xb_ld(&bar[XB_TMO])) break; if (sp > XB_SPIN_CAP) { atomicAdd(&bar[XB_TMO], 1u); break; } }
    }
    nloc = mine > 0u ? mine : 1u; nx = cnt > 0u ? cnt : 1u;
}

__device__ __forceinline__ void xcd_barrier(const XcdBarrier& b) {
    asm volatile("s_waitcnt vmcnt(0)" ::: "memory");
    __syncthreads();
    if (threadIdx.x == 0) {
        unsigned* bar = b.bar;
        __builtin_amdgcn_s_waitcnt(0);
        unsigned nloc = b.st[0], nx = b.st[1];
        if (nloc == 0u) { xcd_barrier_complete(bar, b.x, nloc, nx); b.st[0] = nloc; b.st[1] = nx; }
        const unsigned old = xb_add(&bar[XB_XSUB(b.x)], 1u);
        const unsigned gen = old / nloc;
        if (old + 1u == (gen + 1u) * nloc) {
            __builtin_amdgcn_fence(__ATOMIC_RELEASE, "agent");
            asm volatile("s_waitcnt vmcnt(0)" ::: "memory");
            const unsigned og = xb_add(&bar[XB_TOP], 1u);
            const unsigned tg = og / nx;
            if (og + 1u == (tg + 1u) * nx) xb_add(&bar[XB_TOPGEN], 1u);
            else XB_SPIN(xb_ld(&bar[XB_TOPGEN]) == tg, bar);
            __builtin_amdgcn_fence(__ATOMIC_ACQUIRE, "agent");
            xb_add(&bar[XB_XGEN(b.x)], 1u);
            asm volatile("s_waitcnt vmcnt(0)" ::: "memory");
        } else {
            XB_SPIN(xb_ld(&bar[XB_XGEN(b.x)]) == gen, bar);
            __builtin_amdgcn_fence(__ATOMIC_ACQUIRE, "agent");
            asm volatile("s_waitcnt vmcnt(0)" ::: "memory");
        }
    }
    __syncthreads();
}

__global__ void __launch_bounds__(NTHREADS, 2) mk_fwd(Params p) {
    extern __shared__ __attribute__((aligned(16))) unsigned char lds_raw[];
    cg::grid_group grid = cg::this_grid();
    Ctx C; C.p = p; C.lds = (LAS unsigned char*)lds_raw; C.tid = threadIdx.x; C.lane = C.tid & 63; C.wave = __builtin_amdgcn_readfirstlane(C.tid >> 6); C.bid = blockIdx.x; C.G = gridDim.x; C.ws = p.ws;

    volatile LAS unsigned* bst = (volatile LAS unsigned*)(C.lds + LDS_BYTES - 64);
    if (threadIdx.x < 2) bst[threadIdx.x] = 0u;
    __syncthreads();
    const XcdBarrier bar = xcd_barrier_post((unsigned*)(p.ws + WS_BAR), bst);
    C.refresh(); phase_prologue(C);
    if (p.ws == nullptr) grid.sync();
    xcd_barrier(bar);
    C.refresh(); phase_norm0(C);
    xcd_barrier(bar);
#pragma unroll 1
    for (int layer = 0; layer < DEPTH; ++layer) {
        { C.refresh(); bf16_t* R1 = (bf16_t*)(C.ws + WS_R1); bf16_t* R2 = (bf16_t*)(C.ws + WS_R2); unsigned char* wl = C.wl(layer); pg8::Gemm g{R1, (const bf16_t*)(wl + WL_IN), M, NPP, D}; pg8::StaticOrder S; S.init(M, NPP, C.G, C.bid); pg8::EpiStore E{R2, NP, NP};
          pg8::gemm_phase<pg8::EpiStore, pg8::StaticOrder, true, true>(C.lds, g, S, E); }
        xcd_barrier(bar);
        C.refresh();
        for (int u = C.bid; u < 768 + 192 + 128 + 128 + 200; u += C.G) {
            C.refresh();
            if (u < 768) unit_chunk_mlp(C, layer, u);
            else if (u < 960) unit_conv(C, layer, u - 768);
            else if (u < 1088) unit_fourier_ctx(C, u - 960);
            else if (u < 1216) unit_fourier_lat1(C, u - 1088);
            else unit_mla_prep(C, layer, u - 1216);
        }
        xcd_barrier(bar);
        C.refresh();
        for (int u = C.bid; u < 512; u += C.G) {
            C.refresh();
            if (u < 256) unit_attention(C, 128 + u);
            else if (u < 384) unit_attention(C, u - 256);
            else unit_fourier_lat2(C, u - 384);
        }
        xcd_barrier(bar);
        { C.refresh(); bf16_t* R1 = (bf16_t*)(C.ws + WS_R1); bf16_t* R2 = (bf16_t*)(C.ws + WS_R2); unsigned char* wl = C.wl(layer); pg8::Gemm g{R1, (const bf16_t*)(wl + WL_OUT), M, D, D}; pg8::SplitTailOrder S; S.init(D, C.G, C.bid); pg8::EpiStoreSplit E{R2, R2 + (size_t)M * D - (size_t)SPLIT_ROW0 * D, D};
          pg8::gemm_phase<pg8::EpiStoreSplit, pg8::SplitTailOrder, true, true>(C.lds, g, S, E); }
        xcd_barrier(bar);
        C.refresh(); phase_post<0>(C, layer);
        xcd_barrier(bar);
        { C.refresh(); bf16_t* R1 = (bf16_t*)(C.ws + WS_R1); bf16_t* R2 = (bf16_t*)(C.ws + WS_R2); unsigned char* wl = C.wl(layer); pg8::Gemm g{R1, (const bf16_t*)(wl + WL_GU), M, 2 * FF, D}; pg8::StaticOrder S; S.init(M, 2 * FF, C.G, C.bid); pg8::EpiSwiGLU E{R2, FF};
          pg8::gemm_phase<pg8::EpiSwiGLU, pg8::StaticOrder, true, true>(C.lds, g, S, E);
          if (C.G == 256 && layer + 1 < DEPTH && C.bid >= 64) { C.refresh(); transpose_items(C, (layer + 1) * TI_L + (C.bid - 64), 192, (layer + 2) * TI_L); } }
        xcd_barrier(bar);
        { C.refresh(); bf16_t* R2 = (bf16_t*)(C.ws + WS_R2); bf16_t* R3 = (bf16_t*)(C.ws + WS_MLA); unsigned char* wl = C.wl(layer); pg8::Gemm g{R2, (const bf16_t*)(wl + WL_DN), M, D, FF}; pg8::SplitTailOrder S; S.init(FF, C.G, C.bid); pg8::EpiStoreSplit E{R3, R3 + (size_t)M * D - (size_t)SPLIT_ROW0 * D, D};
          pg8::gemm_phase<pg8::EpiStoreSplit, pg8::SplitTailOrder, true, true>(C.lds, g, S, E); }
        xcd_barrier(bar);
        C.refresh(); phase_post<1>(C, layer);
        if (layer + 1 < DEPTH) xcd_barrier(bar);
    }
}

extern "C" void kernel_launch(void* const* d_in, const int* in_sizes, int n_in, void* d_out, int out_size, void* d_ws, size_t ws_size, hipStream_t stream) {
    static int grid = 0;
    if (grid == 0) {
        if (n_in != 24 || ws_size < WS_END) { fprintf(stderr, "kernel_launch: need 24 inputs and %zu bytes of workspace; got %d, %zu\n", (size_t)WS_END, n_in, ws_size); grid = -1; return; }
        int dev = 0, cus = 0, per_cu = 0;
        if (hipGetDevice(&dev) != hipSuccess || hipDeviceGetAttribute(&cus, hipDeviceAttributeMultiprocessorCount, dev) != hipSuccess) { grid = -1; return; }
        if (hipFuncSetAttribute((const void*)mk_fwd, hipFuncAttributeMaxDynamicSharedMemorySize, LDS_BYTES) != hipSuccess) { fprintf(stderr, "kernel_launch: hipFuncSetAttribute failed\n"); grid = -1; return; }
        if (hipOccupancyMaxActiveBlocksPerMultiprocessor(&per_cu, (const void*)mk_fwd, NTHREADS, LDS_BYTES) != hipSuccess || per_cu < 1) fprintf(stderr, "kernel_launch: occupancy query says %d blocks per CU\n", per_cu);
        (void)hipGetLastError();
        grid = cus;
    }
    if (grid < 0) return;
    Params p{};
    for (int i = 0; i < 24; ++i) p.in[i] = (const float*)d_in[i];
    p.out = (float*)d_out; p.ws = (unsigned char*)d_ws;
    if (hipMemsetAsync((char*)d_ws + WS_BAR, 0, WS_BAR_BYTES, stream) != hipSuccess) { fprintf(stderr, "kernel_launch: memset failed\n"); return; }
    void* args[] = {&p};
    hipError_t e = hipLaunchCooperativeKernel((const void*)mk_fwd, dim3(grid), dim3(NTHREADS), args, LDS_BYTES, stream);
    if (e != hipSuccess) fprintf(stderr, "kernel_launch: cooperative launch failed: %s (grid %d)\n", hipGetErrorString(e), grid);
}
```

```cpp
#include <hip/hip_runtime.h>
#include <hip/hip_cooperative_groups.h>
#include <cstdio>
#include <cstdint>
namespace cg = cooperative_groups;
namespace pg8 {
#define PG8_LAS __attribute__((address_space(3)))
typedef unsigned short bf16_t;
typedef short bf16x8 __attribute__((ext_vector_type(8)));
typedef float f32x4 __attribute__((ext_vector_type(4)));
typedef unsigned u32x4 __attribute__((ext_vector_type(4)));
constexpr int BM = 256, BK = 64, HALF = 128, HTB = HALF * BK * 2  , STAGE_BYTES = 8 * HTB, NXCD = 8, WGM = 8;

__host__ __device__ __forceinline__ int lds_byte(int r, int c) { const int st = (r >> 4) * 2 + (c >> 5), rr = r & 15, cc = c & 31, ob = rr * 64 + cc * 2; return st * 1024 + (ob ^ (((ob >> 9) & 1) << 5)); }
__host__ __device__ __forceinline__ void stage_rc(int b, int& R, int& C) { const int st = b / 1024, sb = b % 1024, swz = sb ^ (((sb >> 9) & 1) << 5); R = (st >> 1) * 16 + swz / 64; C = (st & 1) * 32 + (swz % 64) / 2; }
__host__ __device__ __forceinline__ int perm32(int rho) { const int n = rho >> 4, i = rho & 15; return 8 * (i >> 2) + 4 * n + (i & 3); }

struct Unit { int pm, pn; int kh, nt, koff; };
struct Gemm { const bf16_t* A; const bf16_t* Bt; int M, N, K; };

struct StaticOrder {
    int nM, nN, nwg, G, c;
    __host__ __device__ void init(int M, int N, int G_, int c_) { nM = M / BM; nN = N / BM; nwg = nM * nN; G = G_; c = c_; }
    __host__ __device__ bool next(int i, Unit& u) const {
        const long L = (long)i * G + c; if (L >= nwg) return false;
        int wgid = (int)L; { const int q = nwg / NXCD, r = nwg % NXCD, xcd = wgid % NXCD, off = wgid / NXCD; wgid = (xcd < r ? xcd * (q + 1) : r * (q + 1) + (xcd - r) * q) + off; }
        const int nig = WGM * nN, gid = wgid / nig, fm = gid * WGM, gsz = (nM - fm) < WGM ? (nM - fm) : WGM;
        u.pm = fm + ((wgid % nig) % gsz); u.pn = (wgid % nig) / gsz; u.kh = 0; u.nt = 0; u.koff = 0; return true;
    }
    __device__ __forceinline__ void a_ready(const Unit&) const {}
    __device__ __forceinline__ void done(const Unit&) const {}
};

__device__ __forceinline__ unsigned cvt_pk_bf16(float lo, float hi) { unsigned r; asm volatile("v_cvt_pk_bf16_f32 %0, %1, %2" : "=v"(r) : "v"(lo), "v"(hi)); return r; }
typedef float f32x2 __attribute__((ext_vector_type(2)));
struct EpiStore {
    static constexpr bool PERM = true, AFTER_DRAIN = false;
    bf16_t* O; int ldc; int ncols;
    __device__ __forceinline__ void operator()(const f32x4 (&acc)[2][2][4][2], const Unit& u, int wr, int wc, int fr, int fq) const {
        const int row0 = u.pm * BM + wr * 64 + fr; const int col0 = u.pn * BM + wc * 32 + 8 * fq;
#pragma unroll
        for (int ai = 0; ai < 2; ++ai)
#pragma unroll
            for (int m = 0; m < 4; ++m) { bf16_t* rowp = O + (size_t)(row0 + ai * HALF + m * 16) * ldc + col0;
#pragma unroll
                for (int bj = 0; bj < 2; ++bj) { const f32x4 v0 = acc[ai][bj][m][0], v1 = acc[ai][bj][m][1];
                    u32x4 w; w.x = cvt_pk_bf16(v0[0], v0[1]); w.y = cvt_pk_bf16(v0[2], v0[3]); w.z = cvt_pk_bf16(v1[0], v1[1]); w.w = cvt_pk_bf16(v1[2], v1[3]);
                    if (col0 + bj * HALF < ncols) *(u32x4*)(rowp + bj * HALF) = w; } }
    }
};
struct EpiStoreWT {
    static constexpr bool PERM = true, AFTER_DRAIN = false;
    bf16_t* O; int ldc; int ncols;
    __device__ __forceinline__ void operator()(const f32x4 (&acc)[2][2][4][2], const Unit& u, int wr, int wc, int fr, int fq) const {
        const int row0 = u.pm * BM + wr * 64 + fr; const int col0 = u.pn * BM + wc * 32 + 8 * fq;
#pragma unroll
        for (int ai = 0; ai < 2; ++ai)
#pragma unroll
            for (int m = 0; m < 4; ++m) { bf16_t* rowp = O + (size_t)(row0 + ai * HALF + m * 16) * ldc + col0;
#pragma unroll
                for (int bj = 0; bj < 2; ++bj) { const f32x4 v0 = acc[ai][bj][m][0], v1 = acc[ai][bj][m][1];
                    const unsigned long long lo = (unsigned long long)cvt_pk_bf16(v0[0], v0[1]) | ((unsigned long long)cvt_pk_bf16(v0[2], v0[3]) << 32);
                    const unsigned long long hi = (unsigned long long)cvt_pk_bf16(v1[0], v1[1]) | ((unsigned long long)cvt_pk_bf16(v1[2], v1[3]) << 32);
                    unsigned long long* q = (unsigned long long*)(rowp + bj * HALF);
                    __hip_atomic_store(q, lo, __ATOMIC_RELAXED, __HIP_MEMORY_SCOPE_AGENT); __hip_atomic_store(q + 1, hi, __ATOMIC_RELAXED, __HIP_MEMORY_SCOPE_AGENT); } }
    }
};
__device__ __forceinline__ float silu_mul(float g, float u) { return g * u * __builtin_amdgcn_rcpf(1.f + __expf(-g)); }
struct EpiSwiGLU {
    static constexpr bool PERM = true, AFTER_DRAIN = false;
    bf16_t* O; int ldc;
    __device__ __forceinline__ void operator()(const f32x4 (&acc)[2][2][4][2], const Unit& u, int wr, int wc, int fr, int fq) const {
        const int row0 = u.pm * BM + wr * 64 + fr; const int col0 = u.pn * HALF + wc * 32 + 8 * fq;
#pragma unroll
        for (int ai = 0; ai < 2; ++ai)
#pragma unroll
            for (int m = 0; m < 4; ++m) { bf16_t* rowp = O + (size_t)(row0 + ai * HALF + m * 16) * ldc + col0;
                const f32x4 g0 = acc[ai][0][m][0], g1 = acc[ai][0][m][1], u0 = acc[ai][1][m][0], u1 = acc[ai][1][m][1];
                u32x4 w; w.x = cvt_pk_bf16(silu_mul(g0[0], u0[0]), silu_mul(g0[1], u0[1])); w.y = cvt_pk_bf16(silu_mul(g0[2], u0[2]), silu_mul(g0[3], u0[3]));
                w.z = cvt_pk_bf16(silu_mul(g1[0], u1[0]), silu_mul(g1[1], u1[1])); w.w = cvt_pk_bf16(silu_mul(g1[2], u1[2]), silu_mul(g1[3], u1[3]));
                *(u32x4*)rowp = w; }
    }
};

struct PanelOrder {
    int nN, nwg, G, c; unsigned* cnt;
    __device__ void init(int M, int N, int G_, int c_, unsigned* cnt_) { nN = N / BM; nwg = (M / BM) * nN; G = G_; c = c_; cnt = cnt_; }
    __device__ bool next(int i, Unit& u) const { const long L = (long)i * G + c; if (L >= nwg) return false; u.pm = (int)L / nN; u.pn = (int)L % nN; u.kh = 0; u.nt = 0; u.koff = 0; return true; }
    __device__ __forceinline__ void a_ready(const Unit&) const {}
    __device__ __forceinline__ void done(const Unit& u) const {
        asm volatile("s_waitcnt vmcnt(0)" ::: "memory");
        if ((threadIdx.x & 63) == 0) __hip_atomic_fetch_add(cnt + u.pm, 1u, __ATOMIC_RELAXED, __HIP_MEMORY_SCOPE_AGENT);
    }
};

struct SplitTailOrder {
    int G, c, ntf; bool split;
    __device__ void init(int K, int G_, int c_) { G = G_; c = c_; ntf = K / BK; split = (G_ == 256); }
    __device__ bool next(int i, Unit& u) const {
        if (!split) { const long L = (long)i * G + c; if (L >= 384) return false; u.pm = (int)L >> 2; u.pn = (int)L & 3; u.kh = 0; u.nt = 0; u.koff = 0; return true; }
        if (i == 0) { const int t = (c & 7) * 32 + (c >> 3); u.pm = t >> 2; u.pn = t & 3; u.kh = 0; u.nt = 0; u.koff = 0; return true; }
        if (i == 1) { const int t = 256 + (c & 7) * 16 + (c >> 4); u.pm = t >> 2; u.pn = t & 3; u.kh = (c >> 3) & 1; u.nt = ntf / 2; u.koff = u.kh * (ntf / 2) * BK * 2; return true; }
        return false;
    }
    __device__ __forceinline__ void a_ready(const Unit&) const {}
    __device__ __forceinline__ void done(const Unit&) const {}
};
struct EpiStoreSplit {
    static constexpr bool PERM = true, AFTER_DRAIN = false;
    bf16_t* O; bf16_t* O1; int ldc;
    __device__ __forceinline__ void operator()(const f32x4 (&acc)[2][2][4][2], const Unit& u, int wr, int wc, int fr, int fq) const {
        const int row0 = u.pm * BM + wr * 64 + fr; const int col0 = u.pn * BM + wc * 32 + 8 * fq; bf16_t* base = u.kh ? O1 : O;
#pragma unroll
        for (int ai = 0; ai < 2; ++ai)
#pragma unroll
            for (int m = 0; m < 4; ++m) { bf16_t* rowp = base + (size_t)(row0 + ai * HALF + m * 16) * ldc + col0;
#pragma unroll
                for (int bj = 0; bj < 2; ++bj) { const f32x4 v0 = acc[ai][bj][m][0], v1 = acc[ai][bj][m][1];
                    u32x4 w; w.x = cvt_pk_bf16(v0[0], v0[1]); w.y = cvt_pk_bf16(v0[2], v0[3]); w.z = cvt_pk_bf16(v1[0], v1[1]); w.w = cvt_pk_bf16(v1[2], v1[3]);
                    *(u32x4*)(rowp + bj * HALF) = w; } }
    }
};
template <class Epi, class Sched, bool ALIGN_EPI = false, bool SP2 = false>
__device__ __forceinline__ void gemm_phase(PG8_LAS unsigned char* lds, const Gemm g, const Sched& S, const Epi& E) {
    int tid_ = threadIdx.x; asm volatile("" : "+v"(tid_));
    const int tid = tid_, wid = __builtin_amdgcn_readfirstlane(tid >> 6), lane = tid & 63, wr = wid >> 2, wc = wid & 3, fr = lane & 15, fq = lane >> 4;
    const int K = g.K, nt = K / BK;
    unsigned voffA[2], voffB[2];
#pragma unroll
    for (int i = 0; i < 2; ++i) { int R, C; stage_rc(tid * 16 + i * 8192, R, C); const int Rb = Epi::PERM ? ((R & ~31) + perm32(R & 31)) : R;
        voffA[i] = (unsigned)(R * K + C) * 2u; voffB[i] = (unsigned)(Rb * K + C) * 2u; }
    const size_t kstep = (size_t)(BK * 2);
    const size_t hstep = (size_t)HALF * K * 2;
    const size_t tstep = 2 * hstep;
    const unsigned ldsw = (unsigned)wid * 1024u;
    const int aoff = lds_byte(wr * 64 + fr, fq * 8), boff = lds_byte(wc * 32 + fr, fq * 8);
#define PG8_SA(b, h) (((b) * 2 + (h)) * HTB)
#define PG8_SB(b, h) ((4 + (b) * 2 + (h)) * HTB)
#define PG8_STAGE(bufoff, gbase, voff) do { _Pragma("unroll") for (int _i = 0; _i < 2; ++_i) \
        __builtin_amdgcn_global_load_lds((const unsigned*)((const char*)(gbase) + (voff)[_i]), (PG8_LAS unsigned*)(lds + (bufoff) + ldsw + _i * 8192), 16, 0, 0); } while (0)
#define PG8_LDA(dst, b, h) do { _Pragma("unroll") for (int m = 0; m < 4; ++m) _Pragma("unroll") for (int k = 0; k < 2; ++k) dst[m][k] = *(const PG8_LAS bf16x8*)(lds + PG8_SA(b, h) + aoff + m * 2048 + k * 1024); } while (0)
#define PG8_LDB(dst, b, h) do { _Pragma("unroll") for (int n = 0; n < 2; ++n) _Pragma("unroll") for (int k = 0; k < 2; ++k) dst[n][k] = *(const PG8_LAS bf16x8*)(lds + PG8_SB(b, h) + boff + n * 2048 + k * 1024); } while (0)
#define PG8_MMA(ai, bj, At, Bt) do { __builtin_amdgcn_s_setprio(1); _Pragma("unroll") for (int m = 0; m < 4; ++m) _Pragma("unroll") for (int n = 0; n < 2; ++n) _Pragma("unroll") for (int k = 0; k < 2; ++k) \
        acc[ai][bj][m][n] = __builtin_amdgcn_mfma_f32_16x16x32_bf16(Bt[n][k], At[m][k], acc[ai][bj][m][n], 0, 0, 0); __builtin_amdgcn_s_setprio(0); } while (0)
#define PG8_WAIT_V(n) asm volatile("s_waitcnt vmcnt(" #n ")" ::: "memory")
#define PG8_WAIT_L(n) asm volatile("s_waitcnt lgkmcnt(" #n ")" ::: "memory")
#define PG8_BAR __builtin_amdgcn_s_barrier()
#define PG8_SCHED __builtin_amdgcn_sched_barrier(0)
    Unit cur, nxt; int ui = 0;
    if (!S.next(0, cur)) return;
    f32x4 acc[2][2][4][2];
#pragma unroll
    for (int a = 0; a < 2; ++a)
#pragma unroll
        for (int b = 0; b < 2; ++b)
#pragma unroll
            for (int m = 0; m < 4; ++m)
#pragma unroll
                for (int n = 0; n < 2; ++n) acc[a][b][m][n] = (f32x4){0.f, 0.f, 0.f, 0.f};
    bf16x8 At[4][2], B0[2][2], B1[2][2];
    const char* cA = (const char*)g.A + (size_t)cur.pm * tstep + cur.koff; const char* cB = (const char*)g.Bt + (size_t)cur.pn * tstep + cur.koff;
    S.a_ready(cur);
    if constexpr (SP2) {
        PG8_STAGE(PG8_SB(0, 0), cB, voffB); PG8_STAGE(PG8_SB(0, 1), cB + hstep, voffB); PG8_STAGE(PG8_SA(0, 0), cA, voffA); PG8_STAGE(PG8_SA(0, 1), cA + hstep, voffA);
        if (wr == 1) PG8_BAR;
        PG8_WAIT_V(2); PG8_BAR;
        PG8_STAGE(PG8_SB(1, 0), cB + kstep, voffB); PG8_STAGE(PG8_SA(1, 0), cA + kstep, voffA); PG8_STAGE(PG8_SB(1, 1), cB + hstep + kstep, voffB);
        PG8_WAIT_V(6); PG8_BAR;
    } else {
        PG8_STAGE(PG8_SB(0, 0), cB, voffB); PG8_STAGE(PG8_SA(0, 0), cA, voffA); PG8_STAGE(PG8_SB(0, 1), cB + hstep, voffB); PG8_STAGE(PG8_SA(0, 1), cA + hstep, voffA);
        if (wr == 1) PG8_BAR;
        PG8_WAIT_V(4); PG8_BAR;
        PG8_STAGE(PG8_SB(1, 0), cB + kstep, voffB); PG8_STAGE(PG8_SA(1, 0), cA + kstep, voffA); PG8_STAGE(PG8_SB(1, 1), cB + hstep + kstep, voffB);
        PG8_WAIT_V(6); PG8_BAR;
    }
    for (;;) {
        const bool has_next = S.next(ui + 1, nxt);
        const char* nA = has_next ? (const char*)g.A + (size_t)nxt.pm * tstep + nxt.koff : cA; const char* nB = has_next ? (const char*)g.Bt + (size_t)nxt.pn * tstep + nxt.koff : cB;
        const int ntc = cur.nt ? cur.nt : nt;
        for (int t = 0; t < ntc; t += 2) {
            const bool last = (t == ntc - 2);
            const char* a1 = cA + (size_t)(t + 1) * kstep;
            const char* a2 = last ? nA : cA + (size_t)(t + 2) * kstep; const char* b2 = last ? nB : cB + (size_t)(t + 2) * kstep;
            const char* a3 = a2 + kstep; const char* b3 = b2 + kstep;
            if (last && has_next) S.a_ready(nxt);
            if constexpr (SP2) {
            PG8_LDB(B0, 0, 0); PG8_LDB(B1, 0, 1); PG8_SCHED; PG8_LDA(At, 0, 0); PG8_STAGE(PG8_SA(1, 1), a1 + hstep, voffA);
            PG8_WAIT_V(8); PG8_WAIT_L(0); PG8_BAR; PG8_MMA(0, 0, At, B0); PG8_MMA(0, 1, At, B1); PG8_BAR; PG8_SCHED;
            PG8_LDA(At, 0, 1); PG8_STAGE(PG8_SB(0, 0), b2, voffB); PG8_STAGE(PG8_SB(0, 1), b2 + hstep, voffB); PG8_STAGE(PG8_SA(0, 0), a2, voffA);
            PG8_WAIT_V(8); PG8_WAIT_L(0); PG8_BAR; PG8_MMA(1, 0, At, B0); PG8_MMA(1, 1, At, B1); PG8_BAR; PG8_SCHED;
            PG8_LDB(B0, 1, 0); PG8_LDB(B1, 1, 1); PG8_SCHED; PG8_LDA(At, 1, 0); PG8_STAGE(PG8_SA(0, 1), a2 + hstep, voffA);
            PG8_WAIT_V(8); PG8_WAIT_L(0); PG8_BAR; PG8_MMA(0, 0, At, B0); PG8_MMA(0, 1, At, B1); PG8_BAR; PG8_SCHED;
            PG8_LDA(At, 1, 1); PG8_STAGE(PG8_SB(1, 0), b3, voffB); PG8_STAGE(PG8_SB(1, 1), b3 + hstep, voffB); PG8_STAGE(PG8_SA(1, 0), a3, voffA);
            PG8_WAIT_V(8); PG8_WAIT_L(0); PG8_BAR; PG8_MMA(1, 0, At, B0); PG8_MMA(1, 1, At, B1); PG8_BAR; PG8_SCHED;
            } else {
            PG8_LDB(B0, 0, 0); PG8_SCHED; PG8_LDA(At, 0, 0); PG8_STAGE(PG8_SA(1, 1), a1 + hstep, voffA);
            PG8_WAIT_L(8); PG8_BAR; PG8_WAIT_L(0); PG8_MMA(0, 0, At, B0); PG8_BAR; PG8_SCHED;
            PG8_LDB(B1, 0, 1); PG8_STAGE(PG8_SB(0, 0), b2, voffB);
            PG8_BAR; PG8_WAIT_L(0); PG8_MMA(0, 1, At, B1); PG8_BAR;
            PG8_LDA(At, 0, 1); PG8_STAGE(PG8_SA(0, 0), a2, voffA);
            PG8_BAR; PG8_WAIT_L(0); PG8_MMA(1, 0, At, B0); PG8_BAR; PG8_SCHED;
            PG8_STAGE(PG8_SB(0, 1), b2 + hstep, voffB);
            PG8_WAIT_V(6); PG8_BAR; PG8_MMA(1, 1, At, B1); PG8_BAR;
            PG8_LDB(B0, 1, 0); PG8_SCHED; PG8_LDA(At, 1, 0); PG8_STAGE(PG8_SA(0, 1), a2 + hstep, voffA);
            PG8_WAIT_L(8); PG8_BAR; PG8_WAIT_L(0); PG8_MMA(0, 0, At, B0); PG8_BAR; PG8_SCHED;
            PG8_LDB(B1, 1, 1); PG8_STAGE(PG8_SB(1, 0), b3, voffB);
            PG8_BAR; PG8_WAIT_L(0); PG8_MMA(0, 1, At, B1); PG8_BAR;
            PG8_LDA(At, 1, 1); PG8_STAGE(PG8_SA(1, 0), a3, voffA);
            PG8_BAR; PG8_WAIT_L(0); PG8_MMA(1, 0, At, B0); PG8_BAR; PG8_SCHED;
            PG8_STAGE(PG8_SB(1, 1), b3 + hstep, voffB);
            PG8_WAIT_V(6); PG8_BAR; PG8_MMA(1, 1, At, B1); PG8_BAR;
            }
        }
        if constexpr (ALIGN_EPI) { if (wr == 0) PG8_BAR; }
        if constexpr (!Epi::AFTER_DRAIN) { E(acc, cur, wr, wc, fr, fq); S.done(cur); }
        if (!has_next) break;
#pragma unroll
        for (int a = 0; a < 2; ++a)
#pragma unroll
            for (int b = 0; b < 2; ++b)
#pragma unroll
                for (int m = 0; m < 4; ++m)
#pragma unroll
                    for (int n = 0; n < 2; ++n) acc[a][b][m][n] = (f32x4){0.f, 0.f, 0.f, 0.f};
        cur = nxt; cA = nA; cB = nB; ++ui;
        if constexpr (ALIGN_EPI) { if (wr == 1) PG8_BAR; }
    }
    PG8_WAIT_V(0);
    if constexpr (!ALIGN_EPI) { if (wr == 0) PG8_BAR; }
    PG8_BAR;
    if constexpr (Epi::AFTER_DRAIN) { E.fused(acc, cur, wr, wc, fr, fq, lds, wid, lane); S.done(cur); }
#undef PG8_SA
#undef PG8_SB
#undef PG8_STAGE
#undef PG8_LDA
#undef PG8_LDB
#undef PG8_MMA
#undef PG8_WAIT_V
#undef PG8_WAIT_L
#undef PG8_BAR
#undef PG8_SCHED
}
}
#define LAS __attribute__((address_space(3)))
typedef unsigned short bf16_t;
typedef short bf16x8 __attribute__((ext_vector_type(8)));
typedef short bf16x4 __attribute__((ext_vector_type(4)));
typedef float f32x4 __attribute__((ext_vector_type(4)));
typedef float f32x2 __attribute__((ext_vector_type(2)));
typedef float f32x16 __attribute__((ext_vector_type(16)));
typedef unsigned u32x4 __attribute__((ext_vector_type(4)));
typedef unsigned u32x2 __attribute__((ext_vector_type(2)));

constexpr int D = 1024, M_CTX = 8192, M_LAT = 16384, M = M_CTX + M_LAT, NP = 1888, NPP = 2048, FF = 2816, DEPTH = 4;
constexpr int KEYROWS = 8192 + 4 * 4352;
constexpr float EPS = 1e-6f;
constexpr int NTHREADS = 512, NWAVES = 8;
constexpr int LDS_BYTES = 147456;

constexpr size_t OUT_X = 0, OUT_CKV = (size_t)M * D, OUT_KR = OUT_CKV + (size_t)32 * 4 * 256 * 128;
constexpr int PC_U = 0, PC_V = 256, PC_H = 512, PC_B = 768, PC_C = 1024, PC_F = 1280, PC_Q = 1536, PC_KV = 1728, PC_KR = 1856;

constexpr size_t al256(size_t x) { return (x + 255) & ~(size_t)255; }
constexpr size_t WS_BAR = 0, WS_BAR_BYTES = 16384;
constexpr size_t WS_MOD = WS_BAR_BYTES;
constexpr size_t WS_F64 = al256(WS_MOD + (size_t)4 * 5 * 6144 * 4);
constexpr size_t WS_T64R = WS_F64 + 128 * 64 * 2;
constexpr size_t WS_T64I = WS_T64R + 64 * 128 * 2;
constexpr size_t WS_T64B = WS_T64I + 64 * 128 * 2;
constexpr size_t WS_T256 = WS_T64B + 64 * 128 * 2;
constexpr size_t WS_TW = WS_T256 + 256 * 512 * 2;
constexpr size_t WS_ROPE = WS_TW + 4096 * 8;
constexpr size_t WS_W = al256(WS_ROPE + 64 * 8 * 8);
constexpr size_t WL_IN = 0, WL_OUT = WL_IN + (size_t)NPP * D * 2, WL_GU = WL_OUT + (size_t)D * D * 2, WL_DN = WL_GU + (size_t)2 * FF * D * 2,
                 WL_UQ = WL_DN + (size_t)D * FF * 2, WL_UKV = WL_UQ + (size_t)384 * 192 * 2, WL_SP = WL_UKV + (size_t)512 * 128 * 2, WL_SIZE = WL_SP + (size_t)4 * 128 * 128 * 2;
constexpr size_t WS_R1 = al256(WS_W + 4 * WL_SIZE);
constexpr size_t WS_R2 = WS_R1 + (size_t)M * D * 2;
constexpr size_t WS_MLA = WS_R2 + (size_t)M * FF * 2;
constexpr size_t WS_Q = WS_MLA, WS_KN = WS_Q + (size_t)M * 384 * 2, WS_VT = WS_KN + (size_t)KEYROWS * 256 * 2, WS_KR = WS_VT + (size_t)KEYROWS * 256 * 2,
                 WS_GB = WS_KR + (size_t)KEYROWS * 32 * 2, WS_END = WS_GB + (size_t)4 * 4 * 64 * 64 * 128 * 2;
static_assert(WS_END - WS_MLA >= (size_t)M * D * 2, "FFNOUT alias");
static_assert((size_t)M * NP * 2 <= (size_t)M * FF * 2, "PROJ fits R2");

struct Params { const float* in[24]; float* out; unsigned char* ws; };
enum { I_XP = 0, I_XS, I_CCKV, I_CKR, I_C, I_CCTX, I_WADA, I_BADA, I_GPM, I_GPOM, I_GPF, I_GPOF, I_WIN, I_SPW, I_SPB, I_CVW, I_CVB, I_GQ, I_WUQ, I_GKV, I_WUKV, I_WOUT, I_WGU, I_WDN };

__device__ __forceinline__ unsigned f2bf(float f) { unsigned u = __builtin_bit_cast(unsigned, f); return (u + 0x7fffu + ((u >> 16) & 1u)) >> 16; }
typedef __bf16 bf16x2v __attribute__((ext_vector_type(2)));
__device__ __forceinline__ unsigned pk2(float lo, float hi) { const bf16x2v r = __builtin_convertvector((f32x2){lo, hi}, bf16x2v); return __builtin_bit_cast(unsigned, r); }
__device__ __forceinline__ float bflo(unsigned w) { return __builtin_bit_cast(float, w << 16); }
__device__ __forceinline__ float bfhi(unsigned w) { return __builtin_bit_cast(float, w & 0xffff0000u); }
__device__ __forceinline__ float bf1(bf16_t v) { return __builtin_bit_cast(float, (unsigned)v << 16); }
__device__ __forceinline__ f32x4 mma16(bf16x8 a, bf16x8 b, f32x4 c) { return __builtin_amdgcn_mfma_f32_16x16x32_bf16(a, b, c, 0, 0, 0); }
__device__ __forceinline__ f32x16 mma32(bf16x8 a, bf16x8 b, f32x16 c) { return __builtin_amdgcn_mfma_f32_32x32x16_bf16(a, b, c, 0, 0, 0); }
__device__ __forceinline__ float wave_sum(float v) {
#pragma unroll
    for (int o = 1; o < 64; o <<= 1) v += __shfl_xor(v, o);
    return v;
}
__device__ __forceinline__ u32x2 pk4(f32x4 v) { u32x2 w; w.x = pk2(v[0], v[1]); w.y = pk2(v[2], v[3]); return w; }
__device__ __forceinline__ int mod_of_row(int r) { return r < M_CTX ? 0 : 1 + ((r - M_CTX) >> 12); }

struct Ctx {
    Params p; LAS unsigned char* lds; int tid, lane, wave, bid, G;
    unsigned char* ws;
    __device__ __forceinline__ const float* mod(int l, int mi, int chunk) const { return (const float*)(ws + WS_MOD) + ((size_t)(l * 5 + mi) * 6 + chunk) * 1024; }
    __device__ __forceinline__ unsigned char* wl(int l) const { return ws + WS_W + (size_t)l * WL_SIZE; }
    __device__ __forceinline__ void refresh() { int t = threadIdx.x; asm volatile("" : "+v"(t)); tid = t; lane = t & 63; wave = __builtin_amdgcn_readfirstlane(t >> 6);
        size_t z = 0; asm volatile("" : "+s"(z)); ws = p.ws + z;
        int b = blockIdx.x; asm volatile("" : "+s"(b)); bid = b; }
};

constexpr int TPS = 258;
struct TItem { const float* W; bf16_t* WT; int ldw, K, k0, n0, nvalid, gu; };
__device__ __forceinline__ void titem_load(const TItem& t, int wave, int lane, f32x4 (&v)[8]) {
    const int n = t.n0 + 4 * lane;
#pragma unroll
    for (int i = 0; i < 8; ++i) v[i] = n < t.nvalid ? *(const f32x4*)(t.W + (size_t)(t.k0 + 8 * wave + i) * t.ldw + n) : (f32x4){0.f, 0.f, 0.f, 0.f};
}
__device__ __forceinline__ void titem_stage(LAS unsigned char* lds, int wave, int lane, const f32x4 (&v)[8]) {
    LAS bf16_t* T = (LAS bf16_t*)lds;
#pragma unroll
    for (int i = 0; i < 8; ++i) { LAS unsigned* d = (LAS unsigned*)(T + (8 * wave + i) * TPS + 4 * lane); d[0] = pk2(v[i][0], v[i][1]); d[1] = pk2(v[i][2], v[i][3]); }
}
__device__ __forceinline__ void titem_store(const TItem& t, const LAS unsigned char* lds, int tid) {
    const LAS bf16_t* T = (const LAS bf16_t*)lds;
#pragma unroll
    for (int it = 0; it < 4; ++it) { const int q = tid + NTHREADS * it, n = q >> 3, c = q & 7;
        unsigned short e[8];
#pragma unroll
        for (int j = 0; j < 8; ++j) e[j] = T[(8 * c + j) * TPS + n];
        const int sn = t.n0 + n;
        if (sn < t.nvalid) { int dr = sn; if (t.gu) { const int isup = sn >= FF, jj = isup ? sn - FF : sn; dr = (jj >> 7) * 256 + isup * 128 + (jj & 127); }
            u32x4 o; o.x = e[0] | ((unsigned)e[1] << 16); o.y = e[2] | ((unsigned)e[3] << 16); o.z = e[4] | ((unsigned)e[5] << 16); o.w = e[6] | ((unsigned)e[7] << 16);
            *(u32x4*)(t.WT + (size_t)dr * t.K + t.k0 + 8 * c) = o; } }
}
constexpr int TI_IN = 16 * 8, TI_OUT = 16 * 4, TI_GU = 16 * 22, TI_DN = 44 * 4, TI_UQ = 3 * 2, TI_UKV = 2 * 2, TI_L = TI_IN + TI_OUT + TI_GU + TI_DN + TI_UQ + TI_UKV;
__device__ __forceinline__ TItem titem_make(const Ctx& C, int it) {
    const Params& p = C.p; const int l = it / TI_L; int r = it % TI_L; unsigned char* wl = C.wl(l); TItem t; t.gu = 0;
    if (r < TI_IN) { t.W = p.in[I_WIN] + (size_t)l * D * NP; t.WT = (bf16_t*)(wl + WL_IN); t.ldw = NP; t.K = D; t.k0 = (r >> 3) * 64; t.n0 = (r & 7) * 256; t.nvalid = NP; return t; } r -= TI_IN;
    if (r < TI_OUT) { t.W = p.in[I_WOUT] + (size_t)l * D * D; t.WT = (bf16_t*)(wl + WL_OUT); t.ldw = D; t.K = D; t.k0 = (r >> 2) * 64; t.n0 = (r & 3) * 256; t.nvalid = D; return t; } r -= TI_OUT;
    if (r < TI_GU) { t.W = p.in[I_WGU] + (size_t)l * D * 2 * FF; t.WT = (bf16_t*)(wl + WL_GU); t.ldw = 2 * FF; t.K = D; t.k0 = (r / 22) * 64; t.n0 = (r % 22) * 256; t.nvalid = 2 * FF; t.gu = 1; return t; } r -= TI_GU;
    if (r < TI_DN) { t.W = p.in[I_WDN] + (size_t)l * FF * D; t.WT = (bf16_t*)(wl + WL_DN); t.ldw = D; t.K = FF; t.k0 = (r >> 2) * 64; t.n0 = (r & 3) * 256; t.nvalid = D; return t; } r -= TI_DN;
    if (r < TI_UQ) { t.W = p.in[I_WUQ] + (size_t)l * 192 * 384; t.WT = (bf16_t*)(wl + WL_UQ); t.ldw = 384; t.K = 192; t.k0 = (r >> 1) * 64; t.n0 = (r & 1) * 256; t.nvalid = 384; return t; } r -= TI_UQ;
    t.W = p.in[I_WUKV] + (size_t)l * 128 * 512; t.WT = (bf16_t*)(wl + WL_UKV); t.ldw = 512; t.K = 128; t.k0 = (r >> 1) * 64; t.n0 = (r & 1) * 256; t.nvalid = 512; return t;
}

__device__ __forceinline__ void transpose_items(const Ctx& C, int it0, int stride, int end) {
    int it = it0; f32x4 v[8];
    TItem cur; if (it < end) { cur = titem_make(C, it); titem_load(cur, C.wave, C.lane, v); }
    while (it < end) {
        titem_stage(C.lds, C.wave, C.lane, v);
        const int nx = it + stride; TItem nxt = cur; if (nx < end) { nxt = titem_make(C, nx); titem_load(nxt, C.wave, C.lane, v); }
        __syncthreads();
        titem_store(cur, C.lds, C.tid);
        __syncthreads();
        cur = nxt; it = nx;
    }
}

__device__ __forceinline__ void phase_prologue(const Ctx& C) {
    const Params& p = C.p;
    transpose_items(C, C.bid, C.G, (C.G == 256) ? TI_L : 4 * TI_L);
    {
        LAS float* sc = (LAS float*)C.lds;
        LAS float* red = (LAS float*)(C.lds + 5 * 1024 * 4);
        const int ub = C.G - 1 - C.bid;
        if (ub < 96) {
            size_t za = 0, zb = 0; asm volatile("" : "+s"(za), "+s"(zb));
            const float* cctx = p.in[I_CCTX] + za; const float* cc_ = p.in[I_C] + zb;
            for (int i = C.tid; i < 5120; i += NTHREADS) { const int j = i >> 10, k = i & 1023; const float v = (j == 0) ? cctx[k] : cc_[(j - 1) * 1024 + k]; sc[i] = v / (1.f + __expf(-v)); }
            __syncthreads();
            for (int u = ub; u < 96; u += C.G) {
                const int l = u / 24, cb = u % 24;
                const float* w = p.in[I_WADA] + ((size_t)l * 1024 + C.wave * 128) * 6144 + cb * 256 + 4 * C.lane;
                f32x4 a0 = {0.f, 0.f, 0.f, 0.f}, a1 = a0, a2 = a0, a3 = a0, a4 = a0;
#pragma unroll 16
                for (int k = 0; k < 128; ++k) { const f32x4 wv = *(const f32x4*)(w + (size_t)k * 6144); const int kk = C.wave * 128 + k;
                    a0 += wv * sc[kk]; a1 += wv * sc[1024 + kk]; a2 += wv * sc[2048 + kk]; a3 += wv * sc[3072 + kk]; a4 += wv * sc[4096 + kk]; }
                LAS f32x4* rw = (LAS f32x4*)(red + C.wave * 1280) + C.lane;
                rw[0] = a0; rw[64] = a1; rw[128] = a2; rw[192] = a3; rw[256] = a4;
                __syncthreads();
                for (int i = C.tid; i < 1280; i += NTHREADS) { const int j = i >> 8, c2 = i & 255; float sum = p.in[I_BADA][l * 6144 + cb * 256 + c2];
#pragma unroll
                    for (int ww = 0; ww < 8; ++ww) sum += red[ww * 1280 + i];
                    ((float*)(C.ws + WS_MOD))[(size_t)(l * 5 + j) * 6144 + cb * 256 + c2] = sum; }
                __syncthreads();
            }
        }
        __syncthreads();
    }
    {
        const int gt = C.bid * NTHREADS + C.tid, GT = C.G * NTHREADS;
        for (int i = gt; i < 4 * 65536; i += GT) { const int l = i >> 16, e = i & 65535; ((bf16_t*)(C.wl(l) + WL_SP))[e] = (bf16_t)f2bf(p.in[I_SPW][i]); }
        for (int i = gt; i < 4 * 160 * 1024 / 2; i += GT) { const int l = i / (160 * 512), e = i % (160 * 512); ((unsigned*)(C.wl(l) + WL_IN + (size_t)NP * D * 2))[e] = 0u; }
        for (int i = gt; i < 128 * 64; i += GT) { const int m = i >> 6, c = i & 63; const int idx = ((m & 63) * c) & 63; const float a = (float)idx / 32.f;
            ((bf16_t*)(C.ws + WS_F64))[i] = (bf16_t)f2bf(m < 64 ? cospif(a) : sinpif(a)); }
        for (int i = gt; i < 64 * 128; i += GT) { const int k = i >> 7, K = i & 127; const int idx = (k * (K & 63)) & 63; const float a = (float)idx / 32.f; const float cv = cospif(a), sv = sinpif(a);
            ((bf16_t*)(C.ws + WS_T64R))[i] = (bf16_t)f2bf(K < 64 ? cv : -sv);
            ((bf16_t*)(C.ws + WS_T64I))[i] = (bf16_t)f2bf(K < 64 ? -sv : -cv);
            ((bf16_t*)(C.ws + WS_T64B))[i] = (bf16_t)f2bf(K < 64 ? cv : sv); }
        for (int i = gt; i < 256 * 512; i += GT) { const int k = i >> 9, K = i & 511; const int idx = (k * (K & 255)) & 255; const float a = (float)idx / 128.f;
            ((bf16_t*)(C.ws + WS_T256))[i] = (bf16_t)f2bf(K < 256 ? cospif(a) : -sinpif(a)); }
        for (int i = gt; i < 4096; i += GT) { const float a = (float)i / 2048.f; ((f32x2*)(C.ws + WS_TW))[i] = (f32x2){cospif(a), sinpif(a)}; }
        for (int i = gt; i < 512; i += GT) { const int pos = i >> 3, f = i & 7; const float inv = powf(10000.f, -(float)f / 8.f); const float ang = (float)pos * inv;
            ((f32x2*)(C.ws + WS_ROPE))[i] = (f32x2){cosf(ang), sinf(ang)}; }
    }
}

__device__ __forceinline__ void load_row_f32(const float* rowp, int lane, f32x4 (&v)[4]) {
#pragma unroll
    for (int j = 0; j < 4; ++j) v[j] = *(const f32x4*)(rowp + 4 * lane + 256 * j);
}
__device__ __forceinline__ void load_row_f32_nt(const float* rowp, int lane, f32x4 (&v)[4]) {
#pragma unroll
    for (int j = 0; j < 4; ++j) v[j] = __builtin_nontemporal_load((const f32x4*)(rowp + 4 * lane + 256 * j));
}
__device__ __forceinline__ void load_row_bf16(const bf16_t* rowp, int lane, f32x4 (&v)[4]) {
#pragma unroll
    for (int j = 0; j < 4; ++j) { const u32x2 w = *(const u32x2*)(rowp + 4 * lane + 256 * j); v[j] = (f32x4){bflo(w.x), bfhi(w.x), bflo(w.y), bfhi(w.y)}; }
}
__device__ __forceinline__ float row_rstd(const f32x4 (&v)[4]) {
    float s = 0.f;
#pragma unroll
    for (int j = 0; j < 4; ++j) s += (v[j][0] * v[j][0] + v[j][1] * v[j][1]) + (v[j][2] * v[j][2] + v[j][3] * v[j][3]);
    return 1.f / sqrtf(wave_sum(s) * (1.f / 1024.f) + EPS);
}
__device__ __forceinline__ void norm_mod_store(const f32x4 (&x)[4], const float* g, const float* scale, const float* shift, bf16_t* orow, int lane) {
    const float rs = row_rstd(x);
#pragma unroll
    for (int j = 0; j < 4; ++j) { const int c = 4 * lane + 256 * j; const f32x4 gv = *(const f32x4*)(g + c), sv = *(const f32x4*)(scale + c), hv = *(const f32x4*)(shift + c);
        const f32x4 h = x[j] * rs * gv * (1.f + sv) + hv; *(u32x2*)(orow + c) = pk4(h); }
}
__device__ __forceinline__ void norm_mod_store_g(const f32x4 (&x)[4], const f32x4 (&gv)[4], const float* scale, const float* shift, bf16_t* orow, int lane) {
    const float rs = row_rstd(x);
#pragma unroll
    for (int j = 0; j < 4; ++j) { const int c = 4 * lane + 256 * j; const f32x4 sv = *(const f32x4*)(scale + c), hv = *(const f32x4*)(shift + c);
        const f32x4 h = x[j] * rs * gv[j] * (1.f + sv) + hv; *(u32x2*)(orow + c) = pk4(h); }
}
__device__ __forceinline__ const float* xin_row(const Ctx& C, int layer, int r) {
    if (layer > 0) return C.p.out + OUT_X + (size_t)r * D;
    size_t za = 0, zb = 0; asm volatile("" : "+s"(za), "+s"(zb));
    const float* a = C.p.in[I_XP] + za; const float* b = C.p.in[I_XS] + zb;
    return r < M_CTX ? a + (size_t)r * D : b + (size_t)(r - M_CTX) * D;
}
constexpr int SPLIT_ROW0 = 16384;
__device__ __forceinline__ void load_T(const bf16_t* T, const bf16_t* T1, bool split, int r, int lane, f32x4 (&v)[4]) {
    load_row_bf16(T + (size_t)r * D, lane, v);
    if (split && r >= SPLIT_ROW0) { f32x4 w[4]; load_row_bf16(T1 + (size_t)r * D, lane, w);
#pragma unroll
        for (int j = 0; j < 4; ++j) v[j] = v[j] + w[j]; }
}
__device__ __forceinline__ void phase_norm0(const Ctx& C) {
    const int gw = C.bid * NWAVES + C.wave, NGW = C.G * NWAVES;
    bf16_t* H = (bf16_t*)(C.ws + WS_R1);
    f32x4 xn[4]; load_row_f32(xin_row(C, 0, gw), C.lane, xn);
    for (int r = gw; r < M; r += NGW) { f32x4 x[4];
#pragma unroll
        for (int j = 0; j < 4; ++j) x[j] = xn[j];
        if (r + NGW < M) load_row_f32(xin_row(C, 0, r + NGW), C.lane, xn);
        const int mi = mod_of_row(r);
        norm_mod_store(x, C.p.in[I_GPM], C.mod(0, mi, 1), C.mod(0, mi, 0), H + (size_t)r * D, C.lane); }
}
template <int which  > __device__ __forceinline__ void phase_post(const Ctx& C, int layer) {
    const int gw = C.bid * NWAVES + C.wave, NGW = C.G * NWAVES;
    const bf16_t* T = (const bf16_t*)(C.ws + (which == 0 ? WS_R2 : WS_MLA));
    const bf16_t* T1 = T + (size_t)M * D - (size_t)SPLIT_ROW0 * D;
    const bool split = (C.G == 256);
    bf16_t* H = (bf16_t*)(C.ws + WS_R1);
    const float* gpost = (which == 0 ? C.p.in[I_GPOM] : C.p.in[I_GPOF]) + layer * D;
    const bool do_next = (which == 0) || (layer + 1 < DEPTH);
    const int nl = which == 0 ? layer : layer + 1;
    const float* gnext = (which == 0 ? C.p.in[I_GPF] : C.p.in[I_GPM]) + (nl < DEPTH ? nl : 0) * D;
    f32x4 gg[4], gs[4], sh[4]; int cur_mi = -1;
#pragma unroll
    for (int j = 0; j < 4; ++j) { gg[j] = (f32x4){0.f, 0.f, 0.f, 0.f}; gs[j] = gg[j]; sh[j] = gg[j]; }
    f32x4 tn[4], xn[4];
    load_T(T, T1, split, gw, C.lane, tn); load_row_f32_nt(which == 0 ? xin_row(C, layer, gw) : C.p.out + OUT_X + (size_t)gw * D, C.lane, xn);
    for (int r = gw; r < M; r += NGW) {
        const int mi = mod_of_row(r);
        if (mi != cur_mi) { cur_mi = mi;
            const float* gate = C.mod(layer, mi, which == 0 ? 2 : 5); const float* scale = C.mod(nl, mi, which == 0 ? 4 : 1); const float* shift = C.mod(nl, mi, which == 0 ? 3 : 0);
#pragma unroll
            for (int j = 0; j < 4; ++j) { const int c = 4 * C.lane + 256 * j; gg[j] = *(const f32x4*)(gate + c) * *(const f32x4*)(gpost + c);
                if (do_next) { gs[j] = *(const f32x4*)(gnext + c) * (1.f + *(const f32x4*)(scale + c)); sh[j] = *(const f32x4*)(shift + c); } } }
        f32x4 t[4], x[4];
#pragma unroll
        for (int j = 0; j < 4; ++j) { t[j] = tn[j]; x[j] = xn[j]; }
        if (r + NGW < M) { const int rn = r + NGW; load_T(T, T1, split, rn, C.lane, tn); load_row_f32_nt(which == 0 ? xin_row(C, layer, rn) : C.p.out + OUT_X + (size_t)rn * D, C.lane, xn); }
        const float rs = row_rstd(t);
        float* xo = C.p.out + OUT_X + (size_t)r * D;
#pragma unroll
        for (int j = 0; j < 4; ++j) { const int c = 4 * C.lane + 256 * j; x[j] = x[j] + gg[j] * (t[j] * rs); __builtin_nontemporal_store(x[j], (f32x4*)(xo + c)); }
        if (do_next) { const float rs2 = row_rstd(x); bf16_t* orow = H + (size_t)r * D;
#pragma unroll
            for (int j = 0; j < 4; ++j) { const int c = 4 * C.lane + 256 * j; const f32x4 h = x[j] * rs2 * gs[j] + sh[j]; *(u32x2*)(orow + c) = pk4(h); } }
    }
}

__device__ __forceinline__ void unit_chunk_mlp(const Ctx& C, int layer, int u) {
    const int chunk = u >> 2, g = u & 3, r0 = chunk * 128;
    const bf16_t* PROJ = (const bf16_t*)(C.ws + WS_R2); bf16_t* MIX = (bf16_t*)(C.ws + WS_R1);
    constexpr int VS = 136;
    LAS bf16_t* Vt = (LAS bf16_t*)C.lds;
    { const int q = C.tid >> 2, c0 = (C.tid & 3) * 16; const bf16_t* src = PROJ + (size_t)(r0 + q) * NP + PC_V + g * 64 + c0;
      const bf16x8 v0 = *(const bf16x8*)src, v1 = *(const bf16x8*)(src + 8);
#pragma unroll
      for (int j = 0; j < 8; ++j) { Vt[(c0 + j) * VS + q] = (bf16_t)v0[j]; Vt[(c0 + 8 + j) * VS + q] = (bf16_t)v1[j]; } }
    __syncthreads();
    const int l15 = C.lane & 15, hq = C.lane >> 4, w = C.wave;
    const bf16_t* Wg = (const bf16_t*)(C.wl(layer) + WL_SP) + (size_t)g * 128 * 128;
    bf16x8 bw[4];
#pragma unroll
    for (int ks = 0; ks < 4; ++ks) bw[ks] = *(const bf16x8*)(Wg + (size_t)(w * 16 + l15) * 128 + ks * 32 + 8 * hq);
    const int p = w * 16 + l15; const float bias = C.p.in[I_SPB][(layer * 4 + g) * 128 + p];
#pragma unroll
    for (int ct = 0; ct < 4; ++ct) {
        f32x4 acc = {0.f, 0.f, 0.f, 0.f};
#pragma unroll
        for (int ks = 0; ks < 4; ++ks) { const bf16x8 a = *(const LAS bf16x8*)(Vt + (ct * 16 + l15) * VS + ks * 32 + 8 * hq); acc = mma16(a, bw[ks], acc); }
        const int cc = g * 64 + ct * 16 + 4 * hq; const u32x2 uw = *(const u32x2*)(PROJ + (size_t)(r0 + p) * NP + PC_U + cc);
        f32x4 o; o[0] = bflo(uw.x) * (acc[0] + bias); o[1] = bfhi(uw.x) * (acc[1] + bias); o[2] = bflo(uw.y) * (acc[2] + bias); o[3] = bfhi(uw.y) * (acc[3] + bias);
        *(u32x2*)(MIX + (size_t)(r0 + p) * D + cc) = pk4(o);
    }
    __syncthreads();
}
__device__ __forceinline__ void unit_conv(const Ctx& C, int layer, int u) {
    const bf16_t* PROJ = (const bf16_t*)(C.ws + WS_R2); bf16_t* MIX = (bf16_t*)(C.ws + WS_R1);
    const float* cw = C.p.in[I_CVW] + layer * 3 * 256; const float* cb = C.p.in[I_CVB] + layer * 256;
    for (int it = 0; it < 8; ++it) {
        const int item = it * NTHREADS + C.tid, t = item >> 5, ch = (item & 31) * 8, r = u * 128 + t;
        const int pos = r < M_CTX ? (r & 255) : ((r - M_CTX) & 4095), len = r < M_CTX ? 256 : 4096;
        const bf16_t* base = PROJ + (size_t)r * NP;
        const bf16x8 h1 = *(const bf16x8*)(base + PC_H + ch), c1 = *(const bf16x8*)(base + PC_C + ch), gb = *(const bf16x8*)(base + PC_B + ch);
        bf16x8 h0 = h1, c0 = c1, h2 = h1, c2 = c1; const bool hasp = pos > 0, hasn = pos < len - 1;
        if (hasp) { h0 = *(const bf16x8*)(base - NP + PC_H + ch); c0 = *(const bf16x8*)(base - NP + PC_C + ch); }
        if (hasn) { h2 = *(const bf16x8*)(base + NP + PC_H + ch); c2 = *(const bf16x8*)(base + NP + PC_C + ch); }
        float o[8];
#pragma unroll
        for (int j = 0; j < 8; ++j) {
            const float z0 = hasp ? bf1((bf16_t)h0[j]) * bf1((bf16_t)c0[j]) : 0.f, z1 = bf1((bf16_t)h1[j]) * bf1((bf16_t)c1[j]), z2 = hasn ? bf1((bf16_t)h2[j]) * bf1((bf16_t)c2[j]) : 0.f;
            const float y = z0 * cw[ch + j] + z1 * cw[256 + ch + j] + z2 * cw[512 + ch + j] + cb[ch + j];
            o[j] = bf1((bf16_t)gb[j]) * y; }
        u32x4 w; w.x = pk2(o[0], o[1]); w.y = pk2(o[2], o[3]); w.z = pk2(o[4], o[5]); w.w = pk2(o[6], o[7]);
        *(u32x4*)(MIX + (size_t)r * D + 256 + ch) = w;
    }
}
__device__ __forceinline__ void unit_fourier_ctx(const Ctx& C, int u) {
    const int s = u >> 2, g = u & 3, l15 = C.lane & 15, hq = C.lane >> 4, w = C.wave;
    const bf16_t* PROJ = (const bf16_t*)(C.ws + WS_R2); bf16_t* MIX = (bf16_t*)(C.ws + WS_R1);
    const bf16_t* F64 = (const bf16_t*)(C.ws + WS_F64); const bf16_t* T256 = (const bf16_t*)(C.ws + WS_T256);
    constexpr int ZS = 520; LAS bf16_t* Zt = (LAS bf16_t*)C.lds;
#pragma unroll
    for (int i = 0; i < 2; ++i) { const int nt = 2 * w + i;
        bf16x8 a[2];
#pragma unroll
        for (int ks = 0; ks < 2; ++ks) a[ks] = *(const bf16x8*)(PROJ + (size_t)(s * 256 + nt * 16 + l15) * NP + PC_F + g * 64 + ks * 32 + 8 * hq);
#pragma unroll
        for (int mt = 0; mt < 8; ++mt) { f32x4 acc = {0.f, 0.f, 0.f, 0.f};
#pragma unroll
            for (int ks = 0; ks < 2; ++ks) { const bf16x8 b = *(const bf16x8*)(F64 + (size_t)(mt * 16 + l15) * 64 + ks * 32 + 8 * hq); acc = mma16(a[ks], b, acc); }
            const int mp = mt * 16 + l15;
            *(LAS u32x2*)(Zt + (mp & 63) * ZS + (mp >> 6) * 256 + nt * 16 + 4 * hq) = pk4(acc); } }
    __syncthreads();
#pragma unroll 1
    for (int i = 0; i < 2; ++i) { const int kt = 2 * w + i;
        f32x4 acc[4];
#pragma unroll
        for (int mt = 0; mt < 4; ++mt) acc[mt] = (f32x4){0.f, 0.f, 0.f, 0.f};
#pragma unroll 8
        for (int ks = 0; ks < 16; ++ks) { const bf16x8 b = *(const bf16x8*)(T256 + (size_t)(kt * 16 + l15) * 512 + ks * 32 + 8 * hq);
#pragma unroll
            for (int mt = 0; mt < 4; ++mt) { const bf16x8 a = *(const LAS bf16x8*)(Zt + (mt * 16 + l15) * ZS + ks * 32 + 8 * hq); acc[mt] = mma16(a, b, acc[mt]); } }
#pragma unroll
        for (int mt = 0; mt < 4; ++mt) *(u32x2*)(MIX + (size_t)(s * 256 + kt * 16 + l15) * D + 512 + g * 64 + mt * 16 + 4 * hq) = pk4(acc[mt] * (1.f / 128.f)); }
    __syncthreads();
}
__device__ __forceinline__ void unit_fourier_lat1(const Ctx& C, int u) {
    const int b = u >> 5, g = (u >> 3) & 3, nb = u & 7, l15 = C.lane & 15, hq = C.lane >> 4, n2 = nb * 8 + C.wave;
    const bf16_t* PROJ = (const bf16_t*)(C.ws + WS_R2);
    const bf16_t* F64 = (const bf16_t*)(C.ws + WS_F64); const bf16_t* T64R = (const bf16_t*)(C.ws + WS_T64R); const bf16_t* T64I = (const bf16_t*)(C.ws + WS_T64I);
    const f32x2* TW = (const f32x2*)(C.ws + WS_TW);
    bf16_t* GB = (bf16_t*)(C.ws + WS_GB) + (size_t)((b * 4 + g) * 64 + n2) * 64 * 128;
    constexpr int ZS = 136; LAS bf16_t* Zt = (LAS bf16_t*)(C.lds + C.wave * (64 * ZS * 2));
#pragma unroll 2
    for (int nt = 0; nt < 4; ++nt) {
        bf16x8 a[2];
#pragma unroll
        for (int ks = 0; ks < 2; ++ks) a[ks] = *(const bf16x8*)(PROJ + (size_t)(M_CTX + b * 4096 + (nt * 16 + l15) * 64 + n2) * NP + PC_F + g * 64 + ks * 32 + 8 * hq);
#pragma unroll
        for (int mt = 0; mt < 8; ++mt) { f32x4 acc = {0.f, 0.f, 0.f, 0.f};
#pragma unroll
            for (int ks = 0; ks < 2; ++ks) { const bf16x8 bb = *(const bf16x8*)(F64 + (size_t)(mt * 16 + l15) * 64 + ks * 32 + 8 * hq); acc = mma16(a[ks], bb, acc); }
            const int mp = mt * 16 + l15;
            *(LAS u32x2*)(Zt + (mp & 63) * ZS + (mp >> 6) * 64 + nt * 16 + 4 * hq) = pk4(acc); } }
    asm volatile("s_waitcnt lgkmcnt(0)" ::: "memory");
#pragma unroll 2
    for (int kt = 0; kt < 4; ++kt) {
        bf16x8 br[4], bi[4];
#pragma unroll
        for (int ks = 0; ks < 4; ++ks) { br[ks] = *(const bf16x8*)(T64R + (size_t)(kt * 16 + l15) * 128 + ks * 32 + 8 * hq); bi[ks] = *(const bf16x8*)(T64I + (size_t)(kt * 16 + l15) * 128 + ks * 32 + 8 * hq); }
        const int k1 = kt * 16 + l15; const f32x2 tw = TW[k1 * n2];
#pragma unroll
        for (int mt = 0; mt < 4; ++mt) { f32x4 ar = {0.f, 0.f, 0.f, 0.f}, ai = {0.f, 0.f, 0.f, 0.f};
#pragma unroll
            for (int ks = 0; ks < 4; ++ks) { const bf16x8 a = *(const LAS bf16x8*)(Zt + (mt * 16 + l15) * ZS + ks * 32 + 8 * hq); ar = mma16(a, br[ks], ar); ai = mma16(a, bi[ks], ai); }
            const f32x4 gr = ar * tw[0] + ai * tw[1], gi = ai * tw[0] - ar * tw[1];
            bf16_t* dst = GB + (size_t)k1 * 128 + mt * 16 + 4 * hq;
            *(u32x2*)dst = pk4(gr); *(u32x2*)(dst + 64) = pk4(gi); } }
    __syncthreads();
}
__device__ __forceinline__ void unit_fourier_lat2(const Ctx& C, int u) {
    const int b = u >> 5, g = (u >> 3) & 3, kb = u & 7, l15 = C.lane & 15, hq = C.lane >> 4, k1 = kb * 8 + C.wave;
    const bf16_t* T64B = (const bf16_t*)(C.ws + WS_T64B); bf16_t* MIX = (bf16_t*)(C.ws + WS_R1);
    const bf16_t* GB = (const bf16_t*)(C.ws + WS_GB) + (size_t)((b * 4 + g) * 64) * 64 * 128 + (size_t)k1 * 128;
    constexpr int ZS = 136; LAS bf16_t* Tt = (LAS bf16_t*)(C.lds + C.wave * (64 * ZS * 2));
#pragma unroll 4
    for (int it = 0; it < 16; ++it) { const int q = it * 64 + C.lane, n2 = q >> 4, cc = q & 15, part = cc >> 3, m0 = (cc & 7) * 8;
        const bf16x8 v = *(const bf16x8*)(GB + (size_t)n2 * 64 * 128 + cc * 8);
#pragma unroll
        for (int j = 0; j < 8; ++j) Tt[(m0 + j) * ZS + part * 64 + n2] = (bf16_t)v[j]; }
    asm volatile("s_waitcnt lgkmcnt(0)" ::: "memory");
#pragma unroll 2
    for (int kt = 0; kt < 4; ++kt) {
        bf16x8 bb[4];
#pragma unroll
        for (int ks = 0; ks < 4; ++ks) bb[ks] = *(const bf16x8*)(T64B + (size_t)(kt * 16 + l15) * 128 + ks * 32 + 8 * hq);
        const int k2 = kt * 16 + l15; const int row = M_CTX + b * 4096 + k1 + 64 * k2;
#pragma unroll
        for (int mt = 0; mt < 4; ++mt) { f32x4 acc = {0.f, 0.f, 0.f, 0.f};
#pragma unroll
            for (int ks = 0; ks < 4; ++ks) { const bf16x8 a = *(const LAS bf16x8*)(Tt + (mt * 16 + l15) * ZS + ks * 32 + 8 * hq); acc = mma16(a, bb[ks], acc); }
            *(u32x2*)(MIX + (size_t)row * D + 512 + g * 64 + mt * 16 + 4 * hq) = pk4(acc * (1.f / 512.f)); } }
    __syncthreads();
}
constexpr float QSCALE = 0.10206207261596577f * 1.4426950408889634f;
__device__ __forceinline__ void unit_mla_prep(const Ctx& C, int layer, int u) {
    const Params& p = C.p;
    const bf16_t* PROJ = (const bf16_t*)(C.ws + WS_R2);
    bf16_t* Q = (bf16_t*)(C.ws + WS_Q); bf16_t* KN = (bf16_t*)(C.ws + WS_KN); bf16_t* VT = (bf16_t*)(C.ws + WS_VT); bf16_t* KR = (bf16_t*)(C.ws + WS_KR);
    const f32x2* ROPE = (const f32x2*)(C.ws + WS_ROPE);
    constexpr int QS = 200, KS = 136;
    LAS bf16_t* CQ = (LAS bf16_t*)C.lds;
    LAS bf16_t* CK = (LAS bf16_t*)(C.lds + 128 * QS * 2);
    const bool is_tok = u < 192;
    int r0 = 0, keyrow0, keypos0, nk; size_t vtbase; bool lat;
    if (is_tok) { r0 = u * 128; lat = r0 >= M_CTX;
        if (!lat) { keyrow0 = r0; keypos0 = r0 & 255; nk = 256; vtbase = (size_t)(r0 & ~255) * 256; }
        else { const int b = (r0 - M_CTX) >> 12, n = (r0 - M_CTX) & 4095; keyrow0 = M_CTX + b * 4352 + n; keypos0 = n; nk = 4352; vtbase = (size_t)(M_CTX + b * 4352) * 256; } }
    else { const int cu = u - 192, b = cu >> 1, half = cu & 1; lat = true; keyrow0 = M_CTX + b * 4352 + 4096 + half * 128; keypos0 = 4096 + half * 128; nk = 4352; vtbase = (size_t)(M_CTX + b * 4352) * 256; }
    { const int t = C.tid >> 2, sub = C.tid & 3;
      if (is_tok) {
        const int r = r0 + t; const bf16_t* base = PROJ + (size_t)r * NP;
        float q[48], k[32]; float sq = 0.f, sk = 0.f;
#pragma unroll
        for (int i = 0; i < 6; ++i) { const bf16x8 v = *(const bf16x8*)(base + PC_Q + sub * 48 + i * 8);
#pragma unroll
            for (int j = 0; j < 8; ++j) { q[i * 8 + j] = bf1((bf16_t)v[j]); sq += q[i * 8 + j] * q[i * 8 + j]; } }
#pragma unroll
        for (int i = 0; i < 4; ++i) { const bf16x8 v = *(const bf16x8*)(base + PC_KV + sub * 32 + i * 8);
#pragma unroll
            for (int j = 0; j < 8; ++j) { k[i * 8 + j] = bf1((bf16_t)v[j]); sk += k[i * 8 + j] * k[i * 8 + j]; } }
        sq += __shfl_xor(sq, 1); sq += __shfl_xor(sq, 2); sk += __shfl_xor(sk, 1); sk += __shfl_xor(sk, 2);
        const float rq = 1.f / sqrtf(sq * (1.f / 192.f) + EPS), rk = 1.f / sqrtf(sk * (1.f / 128.f) + EPS);
        const float* gq = p.in[I_GQ] + layer * 192 + sub * 48; const float* gk = p.in[I_GKV] + layer * 128 + sub * 32;
#pragma unroll
        for (int i = 0; i < 6; ++i) { u32x4 w; w.x = pk2(q[i * 8 + 0] * rq * gq[i * 8 + 0], q[i * 8 + 1] * rq * gq[i * 8 + 1]); w.y = pk2(q[i * 8 + 2] * rq * gq[i * 8 + 2], q[i * 8 + 3] * rq * gq[i * 8 + 3]);
            w.z = pk2(q[i * 8 + 4] * rq * gq[i * 8 + 4], q[i * 8 + 5] * rq * gq[i * 8 + 5]); w.w = pk2(q[i * 8 + 6] * rq * gq[i * 8 + 6], q[i * 8 + 7] * rq * gq[i * 8 + 7]);
            *(LAS u32x4*)(CQ + t * QS + sub * 48 + i * 8) = w; }
        float* sckv = nullptr;
        if (!lat) { const int s = r >> 8, pos = r & 255; sckv = p.out + OUT_CKV + ((size_t)(s * 4 + layer) * 256 + pos) * 128 + sub * 32; }
#pragma unroll
        for (int i = 0; i < 4; ++i) { float o[8];
#pragma unroll
            for (int j = 0; j < 8; ++j) o[j] = k[i * 8 + j] * rk * gk[i * 8 + j];
            u32x4 w; w.x = pk2(o[0], o[1]); w.y = pk2(o[2], o[3]); w.z = pk2(o[4], o[5]); w.w = pk2(o[6], o[7]);
            *(LAS u32x4*)(CK + t * KS + sub * 32 + i * 8) = w;
            if (!lat) { *(f32x4*)(sckv + i * 8) = (f32x4){o[0], o[1], o[2], o[3]}; *(f32x4*)(sckv + i * 8 + 4) = (f32x4){o[4], o[5], o[6], o[7]}; } }
        { const bf16x8 v = *(const bf16x8*)(base + PC_KR + sub * 8); float x[8], o[8];
#pragma unroll
          for (int j = 0; j < 8; ++j) x[j] = bf1((bf16_t)v[j]);
          if (lat) { const int n = (r - M_CTX) & 4095; const int pos = (sub >> 1) == 0 ? (n >> 6) : (n & 63);
#pragma unroll
              for (int j = 0; j < 8; ++j) { const float pr = __shfl_xor(x[j], 1); const f32x2 cs = ROPE[pos * 8 + j]; o[j] = (sub & 1) == 0 ? x[j] * cs[0] - pr * cs[1] : x[j] * cs[0] + pr * cs[1]; } }
          else {
#pragma unroll
              for (int j = 0; j < 8; ++j) o[j] = x[j];
              const int s = r >> 8, pos = r & 255; float* skr = p.out + OUT_KR + ((size_t)(s * 4 + layer) * 256 + pos) * 32 + sub * 8;
              *(f32x4*)skr = (f32x4){o[0], o[1], o[2], o[3]}; *(f32x4*)(skr + 4) = (f32x4){o[4], o[5], o[6], o[7]}; }
          u32x4 w; w.x = pk2(o[0], o[1]); w.y = pk2(o[2], o[3]); w.z = pk2(o[4], o[5]); w.w = pk2(o[6], o[7]);
          *(u32x4*)(KR + (size_t)(keyrow0 + t) * 32 + sub * 8) = w; }
      } else {
        const int cu = u - 192, b = cu >> 1, half = cu & 1, row = half * 128 + t;
        const float* src = p.in[I_CCKV] + ((size_t)(b * 4 + layer) * 256 + row) * 128 + sub * 32;
#pragma unroll
        for (int i = 0; i < 4; ++i) { const f32x4 v0 = *(const f32x4*)(src + i * 8), v1 = *(const f32x4*)(src + i * 8 + 4);
            u32x4 w; w.x = pk2(v0[0], v0[1]); w.y = pk2(v0[2], v0[3]); w.z = pk2(v1[0], v1[1]); w.w = pk2(v1[2], v1[3]);
            *(LAS u32x4*)(CK + t * KS + sub * 32 + i * 8) = w; }
        const float* ksrc = p.in[I_CKR] + ((size_t)(b * 4 + layer) * 256 + row) * 32 + sub * 8;
        const f32x4 v0 = *(const f32x4*)ksrc, v1 = *(const f32x4*)(ksrc + 4);
        u32x4 w; w.x = pk2(v0[0], v0[1]); w.y = pk2(v0[2], v0[3]); w.z = pk2(v1[0], v1[1]); w.w = pk2(v1[2], v1[3]);
        *(u32x4*)(KR + (size_t)(keyrow0 + t) * 32 + sub * 8) = w;
      } }
    __syncthreads();
    const int l15 = C.lane & 15, hq = C.lane >> 4, w = C.wave;
    if (is_tok) {
        const bf16_t* Wq = (const bf16_t*)(C.wl(layer) + WL_UQ);
        bf16x8 aq[3][6];
#pragma unroll
        for (int j = 0; j < 3; ++j)
#pragma unroll
            for (int ks = 0; ks < 6; ++ks) aq[j][ks] = *(const bf16x8*)(Wq + (size_t)((3 * w + j) * 16 + l15) * 192 + ks * 32 + 8 * hq);
#pragma unroll 2
        for (int tt = 0; tt < 8; ++tt) {
            bf16x8 bq[6];
#pragma unroll
            for (int ks = 0; ks < 6; ++ks) bq[ks] = *(const LAS bf16x8*)(CQ + (tt * 16 + l15) * QS + ks * 32 + 8 * hq);
            const int r = r0 + tt * 16 + l15; const int n = (r - M_CTX) & 4095;
#pragma unroll
            for (int j = 0; j < 3; ++j) { const int nt = 3 * w + j; f32x4 acc = {0.f, 0.f, 0.f, 0.f};
#pragma unroll
                for (int ks = 0; ks < 6; ++ks) acc = mma16(aq[j][ks], bq[ks], acc);
                const int sub6 = nt % 6;
                if (lat && sub6 >= 4) { const int pos = sub6 == 4 ? (n >> 6) : (n & 63);
#pragma unroll
                    for (int jj = 0; jj < 4; ++jj) { const float pr = __shfl_xor(acc[jj], 32); const f32x2 cs = ROPE[pos * 8 + ((4 * hq + jj) & 7)]; acc[jj] = hq < 2 ? acc[jj] * cs[0] - pr * cs[1] : acc[jj] * cs[0] + pr * cs[1]; } }
                *(u32x2*)(Q + (size_t)r * 384 + nt * 16 + 4 * hq) = pk4(acc * QSCALE); }
        }
    }
    { const bf16_t* Wkv = (const bf16_t*)(C.wl(layer) + WL_UKV);
      bf16x8 wf[4][4];
#pragma unroll
      for (int j = 0; j < 4; ++j)
#pragma unroll
          for (int ks = 0; ks < 4; ++ks) wf[j][ks] = *(const bf16x8*)(Wkv + (size_t)((4 * w + j) * 16 + l15) * 128 + ks * 32 + 8 * hq);
      const int h = w >> 1; const bool isv = (w & 1) != 0;
#pragma unroll 2
      for (int tt = 0; tt < 8; ++tt) {
          bf16x8 ck[4];
#pragma unroll
          for (int ks = 0; ks < 4; ++ks) ck[ks] = *(const LAS bf16x8*)(CK + (tt * 16 + l15) * KS + ks * 32 + 8 * hq);
#pragma unroll
          for (int j = 0; j < 4; ++j) { f32x4 acc = {0.f, 0.f, 0.f, 0.f};
              if (!isv) {
#pragma unroll
                  for (int ks = 0; ks < 4; ++ks) acc = mma16(wf[j][ks], ck[ks], acc);
                  *(u32x2*)(KN + (size_t)(keyrow0 + tt * 16 + l15) * 256 + h * 64 + j * 16 + 4 * hq) = pk4(acc);
              } else {
#pragma unroll
                  for (int ks = 0; ks < 4; ++ks) acc = mma16(ck[ks], wf[j][ks], acc);
                  *(u32x2*)(VT + vtbase + (size_t)(h * 64 + j * 16 + l15) * nk + keypos0 + tt * 16 + 4 * hq) = pk4(acc);
              } } } }
    __syncthreads();
}

constexpr int AKS = 104, AVS = 72;
constexpr int ABUF = 64 * AKS * 2 + 64 * AVS * 2;
__device__ __forceinline__ int imax3(int a, int b, int c) { return max(a, max(b, c)); }
constexpr int AVS2 = 136; constexpr int ABUF2 = 128 * AKS * 2 + 64 * AVS2 * 2;
__device__ __forceinline__ void unit_attention(const Ctx& C, int u) {
    int rowbase, keyrow0, nk, h; size_t vtbase;
    if (u < 128) { const int s = u >> 2; h = u & 3; rowbase = s * 256; keyrow0 = s * 256; nk = 256; vtbase = (size_t)(s * 256) * 256; }
    else { const int v0 = u - 128; const int v = (C.G == 256) ? (((v0 & 7) * 2 + (v0 >> 7)) << 4) | ((v0 >> 3) & 15) : v0;
           const int b = v >> 6, qb = v & 15; h = (v >> 4) & 3; rowbase = M_CTX + b * 4096 + qb * 256; keyrow0 = M_CTX + b * 4352; nk = 4352; vtbase = (size_t)keyrow0 * 256; }
    const bf16_t* Q = (const bf16_t*)(C.ws + WS_Q); const bf16_t* KN = (const bf16_t*)(C.ws + WS_KN); const bf16_t* VT = (const bf16_t*)(C.ws + WS_VT); const bf16_t* KR = (const bf16_t*)(C.ws + WS_KR);
    bf16_t* MIX = (bf16_t*)(C.ws + WS_R1);
    const int l31 = C.lane & 31, hh = C.lane >> 5; const int qrow = rowbase + C.wave * 32 + l31;
    bf16x8 qf[6];
#pragma unroll
    for (int ks = 0; ks < 6; ++ks) qf[ks] = *(const bf16x8*)(Q + (size_t)qrow * 384 + h * 96 + ks * 16 + 8 * hh);
    f32x16 o0, o1, o2, negm;
#pragma unroll
    for (int i = 0; i < 16; ++i) { o0[i] = 0.f; o1[i] = 0.f; o2[i] = 0.f; negm[i] = 0.f; }
    const unsigned onew = (l31 == 0) ? 0x3F803F80u : 0u;
    const bf16x8 onesf = __builtin_bit_cast(bf16x8, (u32x4){onew, onew, onew, onew});
    const int skey = C.tid >> 3, sc8 = (C.tid & 7) * 8, rkey = (C.tid & 255) >> 2, rc8 = (C.tid & 3) * 8;
    const bf16_t* gkn = KN + (size_t)(keyrow0 + skey) * 256 + h * 64 + sc8;
    const bf16_t* gkr = KR + (size_t)(keyrow0 + rkey) * 32 + rc8;
    const bf16_t* gvt = VT + vtbase + (size_t)(h * 64 + skey) * nk + sc8;
    const bool do_r = C.tid < 256;
    const int lkn = (skey * AKS + sc8) * 2, lkr = (rkey * AKS + 64 + rc8) * 2, lvt = 128 * AKS * 2 + (skey * AVS2 + sc8) * 2;
    const int ntile = nk >> 7;
    u32x4 rk[2], rr[2] = {{0u, 0u, 0u, 0u}, {0u, 0u, 0u, 0u}}, rv[2];
#define ATT_LD(t) do { _Pragma("unroll") for (int s_ = 0; s_ < 2; ++s_) { rk[s_] = *(const u32x4*)(gkn + (size_t)(2 * (t) + s_) * 64 * 256); if (do_r) rr[s_] = *(const u32x4*)(gkr + (size_t)(2 * (t) + s_) * 64 * 32); rv[s_] = *(const u32x4*)(gvt + (2 * (t) + s_) * 64); } } while (0)
#define ATT_ST(buf) do { LAS unsigned char* b_ = C.lds + (buf) * ABUF2; _Pragma("unroll") for (int s_ = 0; s_ < 2; ++s_) { *(LAS u32x4*)(b_ + lkn + s_ * 64 * AKS * 2) = rk[s_]; if (do_r) *(LAS u32x4*)(b_ + lkr + s_ * 64 * AKS * 2) = rr[s_]; *(LAS u32x4*)(b_ + lvt + s_ * 128) = rv[s_]; } } while (0)
    ATT_LD(0); ATT_ST(0);
    __syncthreads();
#pragma unroll 1
    for (int kt = 0; kt < ntile; ++kt) {
        const bool more = kt + 1 < ntile;
        if (more) ATT_LD(kt + 1);
        LAS unsigned char* B = C.lds + (kt & 1) * ABUF2;
#pragma unroll 1
        for (int sub = 0; sub < 2; ++sub) {
        const LAS bf16_t* Kl = (const LAS bf16_t*)B + sub * 64 * AKS; const LAS bf16_t* Vl = (const LAS bf16_t*)(B + 128 * AKS * 2) + sub * 64;
        bf16x8 ka[2][6];
#pragma unroll
        for (int ks = 0; ks < 6; ++ks) { ka[0][ks] = *(const LAS bf16x8*)(Kl + l31 * AKS + ks * 16 + 8 * hh); ka[1][ks] = *(const LAS bf16x8*)(Kl + (32 + l31) * AKS + ks * 16 + 8 * hh); }
        __builtin_amdgcn_sched_barrier(0);
        f32x16 s0 = mma32(ka[0][0], qf[0], negm), s1 = mma32(ka[1][0], qf[0], negm);
#pragma unroll
        for (int ks = 1; ks < 6; ++ks) { s0 = mma32(ka[0][ks], qf[ks], s0); s1 = mma32(ka[1][ks], qf[ks], s1); }
        __builtin_amdgcn_sched_barrier(0);
        u32x2 vr[2][2][4];
#pragma unroll
        for (int t = 0; t < 2; ++t)
#pragma unroll
            for (int ss = 0; ss < 2; ++ss) { const int ko = 32 * t + 16 * ss + 4 * hh;
                vr[t][ss][0] = *(const LAS u32x2*)(Vl + l31 * AVS2 + ko); vr[t][ss][1] = *(const LAS u32x2*)(Vl + l31 * AVS2 + ko + 8);
                vr[t][ss][2] = *(const LAS u32x2*)(Vl + (32 + l31) * AVS2 + ko); vr[t][ss][3] = *(const LAS u32x2*)(Vl + (32 + l31) * AVS2 + ko + 8); }
        __builtin_amdgcn_sched_barrier(0);
        float d; bool resc;
        if (kt == 0 && sub == 0) {
            float mx = fmaxf(s0[0], s1[0]);
#pragma unroll
            for (int i = 1; i < 16; ++i) mx = fmaxf(mx, fmaxf(s0[i], s1[i]));
            d = fmaxf(mx, __shfl_xor(mx, 32)); resc = true;
        } else {
            int im = imax3(__builtin_bit_cast(int, s0[0]), __builtin_bit_cast(int, s1[0]), __builtin_bit_cast(int, s0[1]));
            im = imax3(im, __builtin_bit_cast(int, s1[1]), __builtin_bit_cast(int, s0[2])); im = imax3(im, __builtin_bit_cast(int, s1[2]), __builtin_bit_cast(int, s0[3]));
            im = imax3(im, __builtin_bit_cast(int, s1[3]), __builtin_bit_cast(int, s0[4])); im = imax3(im, __builtin_bit_cast(int, s1[4]), __builtin_bit_cast(int, s0[5]));
            im = imax3(im, __builtin_bit_cast(int, s1[5]), __builtin_bit_cast(int, s0[6])); im = imax3(im, __builtin_bit_cast(int, s1[6]), __builtin_bit_cast(int, s0[7]));
            im = imax3(im, __builtin_bit_cast(int, s1[7]), __builtin_bit_cast(int, s0[8])); im = imax3(im, __builtin_bit_cast(int, s1[8]), __builtin_bit_cast(int, s0[9]));
            im = imax3(im, __builtin_bit_cast(int, s1[9]), __builtin_bit_cast(int, s0[10])); im = imax3(im, __builtin_bit_cast(int, s1[10]), __builtin_bit_cast(int, s0[11]));
            im = imax3(im, __builtin_bit_cast(int, s1[11]), __builtin_bit_cast(int, s0[12])); im = imax3(im, __builtin_bit_cast(int, s1[12]), __builtin_bit_cast(int, s0[13]));
            im = imax3(im, __builtin_bit_cast(int, s1[13]), __builtin_bit_cast(int, s0[14])); im = imax3(im, __builtin_bit_cast(int, s1[14]), __builtin_bit_cast(int, s0[15]));
            im = max(im, __builtin_bit_cast(int, s1[15]));
            im = max(im, __shfl_xor(im, 32));
            resc = __builtin_amdgcn_ballot_w64(im > 0x41000000) != 0ull; d = im > 0x41000000 ? __builtin_bit_cast(float, im) : 0.f;
        }
        if (resc) {
            if (kt != 0 || sub != 0) { const float alpha = __builtin_amdgcn_exp2f(-d); o0 = o0 * alpha; o1 = o1 * alpha; o2 = o2 * alpha; }
            negm = negm - d; s0 = s0 - d; s1 = s1 - d;
        }
#pragma unroll
        for (int i = 0; i < 16; ++i) { s0[i] = __builtin_amdgcn_exp2f(s0[i]); s1[i] = __builtin_amdgcn_exp2f(s1[i]); }
#pragma unroll
        for (int t = 0; t < 2; ++t)
#pragma unroll
            for (int ss = 0; ss < 2; ++ss) {
                u32x4 w;
                if (t == 0) { w.x = pk2(s0[8 * ss + 0], s0[8 * ss + 1]); w.y = pk2(s0[8 * ss + 2], s0[8 * ss + 3]); w.z = pk2(s0[8 * ss + 4], s0[8 * ss + 5]); w.w = pk2(s0[8 * ss + 6], s0[8 * ss + 7]); }
                else { w.x = pk2(s1[8 * ss + 0], s1[8 * ss + 1]); w.y = pk2(s1[8 * ss + 2], s1[8 * ss + 3]); w.z = pk2(s1[8 * ss + 4], s1[8 * ss + 5]); w.w = pk2(s1[8 * ss + 6], s1[8 * ss + 7]); }
                const bf16x8 pf = __builtin_bit_cast(bf16x8, w);
                const bf16x8 va = __builtin_bit_cast(bf16x8, (u32x4){vr[t][ss][0].x, vr[t][ss][0].y, vr[t][ss][1].x, vr[t][ss][1].y}), vb = __builtin_bit_cast(bf16x8, (u32x4){vr[t][ss][2].x, vr[t][ss][2].y, vr[t][ss][3].x, vr[t][ss][3].y});
                o0 = mma32(va, pf, o0); o1 = mma32(vb, pf, o1); o2 = mma32(onesf, pf, o2);
            }
        }
        if (more) ATT_ST((kt + 1) & 1);
        __syncthreads();
    }
#undef ATT_LD
#undef ATT_ST
    const float lsum = o2[0] + __shfl_xor(o2[0], 32);
    const float inv = 1.f / lsum;
    bf16_t* orow = MIX + (size_t)qrow * D + 768 + h * 64;
#pragma unroll
    for (int i = 0; i < 4; ++i) { const int dv = 8 * i + 4 * hh;
        *(u32x2*)(orow + dv) = pk4((f32x4){o0[4 * i] * inv, o0[4 * i + 1] * inv, o0[4 * i + 2] * inv, o0[4 * i + 3] * inv});
        *(u32x2*)(orow + 32 + dv) = pk4((f32x4){o1[4 * i] * inv, o1[4 * i + 1] * inv, o1[4 * i + 2] * inv, o1[4 * i + 3] * inv}); }
}

#define XB_TMO      128
#define XB_XCNT(j)  (256  + 64 * (j))
#define XB_XSUB(j)  (1280 + 64 * (j))
#define XB_XGEN(j)  (2304 + 64 * (j))
#define XB_TOP      3328
#define XB_TOPGEN   3392
#define XCD_BAR_WORDS 3456
#define XB_SPIN_CAP (1u << 18)

__device__ __forceinline__ unsigned xb_ld(unsigned* p)              { return __hip_atomic_load(p, __ATOMIC_RELAXED, __HIP_MEMORY_SCOPE_AGENT); }
__device__ __forceinline__ unsigned xb_add(unsigned* p, unsigned v) { return __hip_atomic_fetch_add(p, v, __ATOMIC_RELAXED, __HIP_MEMORY_SCOPE_AGENT); }
__device__ __forceinline__ unsigned xb_xcc_id() { return (unsigned)__builtin_amdgcn_s_getreg((3 << 11) | 20) & 0xFu; }
#define XB_SPIN(cond, bar) do { unsigned _sp = 0; while (cond) { __builtin_amdgcn_s_sleep(1); \
    if ((++_sp & 255u) == 0u) { if (xb_ld(&(bar)[XB_TMO])) break; if (_sp > XB_SPIN_CAP) { atomicAdd(&(bar)[XB_TMO], 1u); break; } } } } while (0)

struct XcdBarrier {
    unsigned* bar; unsigned x;
    volatile LAS unsigned* st;
};

__device__ __forceinline__ XcdBarrier xcd_barrier_post(unsigned* bar, volatile LAS unsigned* st) {
    XcdBarrier b; b.bar = bar; b.x = xb_xcc_id(); b.st = st;
    if (threadIdx.x == 0) (void)xb_add(&bar[XB_XCNT(b.x)], 1u);
    return b;
}
__device__ __forceinline__ void xcd_barrier_complete(unsigned* bar, unsigned x, unsigned& nloc, unsigned& nx) {
    const unsigned G = gridDim.x * gridDim.y * gridDim.z;
    unsigned sum, cnt, mine, sp = 0u;
    for (;;) {
        sum = 0u; cnt = 0u; mine = 0u;
#pragma unroll
        for (unsigned j = 0; j < 16; ++j) { const unsigned c = xb_ld(&bar[XB_XCNT(j)]); sum += c; cnt += (c > 0u) ? 1u : 0u; mine = (j == x) ? c : mine; }
        if (sum == G) break;
        __builtin_amdgcn_s_sleep(1);
        if ((++sp & 255u) == 0u) { if (xb_ld(&bar[XB_TMO])) break; if (sp > XB_SPIN_CAP) { atomicAdd(&bar[XB_TMO], 1u); break; } }
    }
    nloc = mine > 0u ? mine : 1u; nx = cnt > 0u ? cnt : 1u;
}

__device__ __forceinline__ void xcd_barrier(const XcdBarrier& b) {
    asm volatile("s_waitcnt vmcnt(0)" ::: "memory");
    __syncthreads();
    if (threadIdx.x == 0) {
        unsigned* bar = b.bar;
        __builtin_amdgcn_s_waitcnt(0);
        unsigned nloc = b.st[0], nx = b.st[1];
        if (nloc == 0u) { xcd_barrier_complete(bar, b.x, nloc, nx); b.st[0] = nloc; b.st[1] = nx; }
        const unsigned old = xb_add(&bar[XB_XSUB(b.x)], 1u);
        const unsigned gen = old / nloc;
        if (old + 1u == (gen + 1u) * nloc) {
            __builtin_amdgcn_fence(__ATOMIC_RELEASE, "agent");
            asm volatile("s_waitcnt vmcnt(0)" ::: "memory");
            const unsigned og = xb_add(&bar[XB_TOP], 1u);
            const unsigned tg = og / nx;
            if (og + 1u == (tg + 1u) * nx) xb_add(&bar[XB_TOPGEN], 1u);
            else XB_SPIN(xb_ld(&bar[XB_TOPGEN]) == tg, bar);
            __builtin_amdgcn_fence(__ATOMIC_ACQUIRE, "agent");
            xb_add(&bar[XB_XGEN(b.x)], 1u);
            asm volatile("s_waitcnt vmcnt(0)" ::: "memory");
        } else {
            XB_SPIN(xb_ld(&bar[XB_XGEN(b.x)]) == gen, bar);
            __builtin_amdgcn_fence(__ATOMIC_ACQUIRE, "agent");
            asm volatile("s_waitcnt vmcnt(0)" ::: "memory");
        }
    }
    __syncthreads();
}

__global__ void __launch_bounds__(NTHREADS, 2) mk_fwd(Params p) {
    extern __shared__ __attribute__((aligned(16))) unsigned char lds_raw[];
    cg::grid_group grid = cg::this_grid();
    Ctx C; C.p = p; C.lds = (LAS unsigned char*)lds_raw; C.tid = threadIdx.x; C.lane = C.tid & 63; C.wave = __builtin_amdgcn_readfirstlane(C.tid >> 6); C.bid = blockIdx.x; C.G = gridDim.x; C.ws = p.ws;

    volatile LAS unsigned* bst = (volatile LAS unsigned*)(C.lds + LDS_BYTES - 64);
    if (threadIdx.x < 2) bst[threadIdx.x] = 0u;
    __syncthreads();
    const XcdBarrier bar = xcd_barrier_post((unsigned*)(p.ws + WS_BAR), bst);
    C.refresh(); phase_prologue(C);
    if (p.ws == nullptr) grid.sync();
    xcd_barrier(bar);
    C.refresh(); phase_norm0(C);
    xcd_barrier(bar);
#pragma unroll 1
    for (int layer = 0; layer < DEPTH; ++layer) {
        { C.refresh(); bf16_t* R1 = (bf16_t*)(C.ws + WS_R1); bf16_t* R2 = (bf16_t*)(C.ws + WS_R2); unsigned char* wl = C.wl(layer); pg8::Gemm g{R1, (const bf16_t*)(wl + WL_IN), M, NPP, D}; pg8::StaticOrder S; S.init(M, NPP, C.G, C.bid); pg8::EpiStore E{R2, NP, NP};
          pg8::gemm_phase<pg8::EpiStore, pg8::StaticOrder, true, true>(C.lds, g, S, E); }
        xcd_barrier(bar);
        C.refresh();
        for (int u = C.bid; u < 768 + 192 + 128 + 128 + 200; u += C.G) {
            C.refresh();
            if (u < 768) unit_chunk_mlp(C, layer, u);
            else if (u < 960) unit_conv(C, layer, u - 768);
            else if (u < 1088) unit_fourier_ctx(C, u - 960);
            else if (u < 1216) unit_fourier_lat1(C, u - 1088);
            else unit_mla_prep(C, layer, u - 1216);
        }
        xcd_barrier(bar);
        C.refresh();
        for (int u = C.bid; u < 512; u += C.G) {
            C.refresh();
            if (u < 256) unit_attention(C, 128 + u);
            else if (u < 384) unit_attention(C, u - 256);
            else unit_fourier_lat2(C, u - 384);
        }
        xcd_barrier(bar);
        { C.refresh(); bf16_t* R1 = (bf16_t*)(C.ws + WS_R1); bf16_t* R2 = (bf16_t*)(C.ws + WS_R2); unsigned char* wl = C.wl(layer); pg8::Gemm g{R1, (const bf16_t*)(wl + WL_OUT), M, D, D}; pg8::SplitTailOrder S; S.init(D, C.G, C.bid); pg8::EpiStoreSplit E{R2, R2 + (size_t)M * D - (size_t)SPLIT_ROW0 * D, D};
          pg8::gemm_phase<pg8::EpiStoreSplit, pg8::SplitTailOrder, true, true>(C.lds, g, S, E); }
        xcd_barrier(bar);
        C.refresh(); phase_post<0>(C, layer);
        xcd_barrier(bar);
        { C.refresh(); bf16_t* R1 = (bf16_t*)(C.ws + WS_R1); bf16_t* R2 = (bf16_t*)(C.ws + WS_R2); unsigned char* wl = C.wl(layer); pg8::Gemm g{R1, (const bf16_t*)(wl + WL_GU), M, 2 * FF, D}; pg8::StaticOrder S; S.init(M, 2 * FF, C.G, C.bid); pg8::EpiSwiGLU E{R2, FF};
          pg8::gemm_phase<pg8::EpiSwiGLU, pg8::StaticOrder, true, true>(C.lds, g, S, E);
          if (C.G == 256 && layer + 1 < DEPTH && C.bid >= 64) { C.refresh(); transpose_items(C, (layer + 1) * TI_L + (C.bid - 64), 192, (layer + 2) * TI_L); } }
        xcd_barrier(bar);
        { C.refresh(); bf16_t* R2 = (bf16_t*)(C.ws + WS_R2); bf16_t* R3 = (bf16_t*)(C.ws + WS_MLA); unsigned char* wl = C.wl(layer); pg8::Gemm g{R2, (const bf16_t*)(wl + WL_DN), M, D, FF}; pg8::SplitTailOrder S; S.init(FF, C.G, C.bid); pg8::EpiStoreSplit E{R3, R3 + (size_t)M * D - (size_t)SPLIT_ROW0 * D, D};
          pg8::gemm_phase<pg8::EpiStoreSplit, pg8::SplitTailOrder, true, true>(C.lds, g, S, E); }
        xcd_barrier(bar);
        C.refresh(); phase_post<1>(C, layer);
        if (layer + 1 < DEPTH) xcd_barrier(bar);
    }
}

extern "C" void kernel_launch(void* const* d_in, const int* in_sizes, int n_in, void* d_out, int out_size, void* d_ws, size_t ws_size, hipStream_t stream) {
    static int grid = 0;
    if (grid == 0) {
        if (n_in != 24 || ws_size < WS_END) { fprintf(stderr, "kernel_launch: need 24 inputs and %zu bytes of workspace; got %d, %zu\n", (size_t)WS_END, n_in, ws_size); grid = -1; return; }
        int dev = 0, cus = 0, per_cu = 0;
        if (hipGetDevice(&dev) != hipSuccess || hipDeviceGetAttribute(&cus, hipDeviceAttributeMultiprocessorCount, dev) != hipSuccess) { grid = -1; return; }
        if (hipFuncSetAttribute((const void*)mk_fwd, hipFuncAttributeMaxDynamicSharedMemorySize, LDS_BYTES) != hipSuccess) { fprintf(stderr, "kernel_launch: hipFuncSetAttribute failed\n"); grid = -1; return; }
        if (hipOccupancyMaxActiveBlocksPerMultiprocessor(&per_cu, (const void*)mk_fwd, NTHREADS, LDS_BYTES) != hipSuccess || per_cu < 1) fprintf(stderr, "kernel_launch: occupancy query says %d blocks per CU\n", per_cu);
        (void)hipGetLastError();
        grid = cus;
    }
    if (grid < 0) return;
    Params p{};
    for (int i = 0; i < 24; ++i) p.in[i] = (const float*)d_in[i];
    p.out = (float*)d_out; p.ws = (unsigned char*)d_ws;
    if (hipMemsetAsync((char*)d_ws + WS_BAR, 0, WS_BAR_BYTES, stream) != hipSuccess) { fprintf(stderr, "kernel_launch: memset failed\n"); return; }
    void* args[] = {&p};
    hipError_t e = hipLaunchCooperativeKernel((const void*)mk_fwd, dim3(grid), dim3(NTHREADS), args, LDS_BYTES, stream);
    if (e != hipSuccess) fprintf(stderr, "kernel_launch: cooperative launch failed: %s (grid %d)\n", hipGetErrorString(e), grid);
}
```

```cpp
#include <hip/hip_runtime.h>
#include <hip/hip_cooperative_groups.h>
#include <cstdio>
#include <cstdint>
namespace cg = cooperative_groups;
namespace pg8 {
#define PG8_LAS __attribute__((address_space(3)))
typedef unsigned short bf16_t;
typedef short bf16x8 __attribute__((ext_vector_type(8)));
typedef float f32x4 __attribute__((ext_vector_type(4)));
typedef unsigned u32x4 __attribute__((ext_vector_type(4)));
constexpr int BM = 256, BK = 64, HALF = 128, HTB = HALF * BK * 2  , STAGE_BYTES = 8 * HTB, NXCD = 8, WGM = 8;

__host__ __device__ __forceinline__ int lds_byte(int r, int c) { const int st = (r >> 4) * 2 + (c >> 5), rr = r & 15, cc = c & 31, ob = rr * 64 + cc * 2; return st * 1024 + (ob ^ (((ob >> 9) & 1) << 5)); }
__host__ __device__ __forceinline__ void stage_rc(int b, int& R, int& C) { const int st = b / 1024, sb = b % 1024, swz = sb ^ (((sb >> 9) & 1) << 5); R = (st >> 1) * 16 + swz / 64; C = (st & 1) * 32 + (swz % 64) / 2; }
__host__ __device__ __forceinline__ int perm32(int rho) { const int n = rho >> 4, i = rho & 15; return 8 * (i >> 2) + 4 * n + (i & 3); }

struct Unit { int pm, pn; int kh, nt, koff; };
struct Gemm { const bf16_t* A; const bf16_t* Bt; int M, N, K; };

struct StaticOrder {
    int nM, nN, nwg, G, c;
    __host__ __device__ void init(int M, int N, int G_, int c_) { nM = M / BM; nN = N / BM; nwg = nM * nN; G = G_; c = c_; }
    __host__ __device__ bool next(int i, Unit& u) const {
        const long L = (long)i * G + c; if (L >= nwg) return false;
        int wgid = (int)L; { const int q = nwg / NXCD, r = nwg % NXCD, xcd = wgid % NXCD, off = wgid / NXCD; wgid = (xcd < r ? xcd * (q + 1) : r * (q + 1) + (xcd - r) * q) + off; }
        const int nig = WGM * nN, gid = wgid / nig, fm = gid * WGM, gsz = (nM - fm) < WGM ? (nM - fm) : WGM;
        u.pm = fm + ((wgid % nig) % gsz); u.pn = (wgid % nig) / gsz; u.kh = 0; u.nt = 0; u.koff = 0; return true;
    }
    __device__ __forceinline__ void a_ready(const Unit&) const {}
    __device__ __forceinline__ void done(const Unit&) const {}
};

__device__ __forceinline__ unsigned cvt_pk_bf16(float lo, float hi) { unsigned r; asm volatile("v_cvt_pk_bf16_f32 %0, %1, %2" : "=v"(r) : "v"(lo), "v"(hi)); return r; }
typedef float f32x2 __attribute__((ext_vector_type(2)));
struct EpiStore {
    static constexpr bool PERM = true, AFTER_DRAIN = false;
    bf16_t* O; int ldc; int ncols;
    __device__ __forceinline__ void operator()(const f32x4 (&acc)[2][2][4][2], const Unit& u, int wr, int wc, int fr, int fq) const {
        const int row0 = u.pm * BM + wr * 64 + fr; const int col0 = u.pn * BM + wc * 32 + 8 * fq;
#pragma unroll
        for (int ai = 0; ai < 2; ++ai)
#pragma unroll
            for (int m = 0; m < 4; ++m) { bf16_t* rowp = O + (size_t)(row0 + ai * HALF + m * 16) * ldc + col0;
#pragma unroll
                for (int bj = 0; bj < 2; ++bj) { const f32x4 v0 = acc[ai][bj][m][0], v1 = acc[ai][bj][m][1];
                    u32x4 w; w.x = cvt_pk_bf16(v0[0], v0[1]); w.y = cvt_pk_bf16(v0[2], v0[3]); w.z = cvt_pk_bf16(v1[0], v1[1]); w.w = cvt_pk_bf16(v1[2], v1[3]);
                    if (col0 + bj * HALF < ncols) *(u32x4*)(rowp + bj * HALF) = w; } }
    }
};
struct EpiStoreWT {
    static constexpr bool PERM = true, AFTER_DRAIN = false;
    bf16_t* O; int ldc; int ncols;
    __device__ __forceinline__ void operator()(const f32x4 (&acc)[2][2][4][2], const Unit& u, int wr, int wc, int fr, int fq) const {
        const int row0 = u.pm * BM + wr * 64 + fr; const int col0 = u.pn * BM + wc * 32 + 8 * fq;
#pragma unroll
        for (int ai = 0; ai < 2; ++ai)
#pragma unroll
            for (int m = 0; m < 4; ++m) { bf16_t* rowp = O + (size_t)(row0 + ai * HALF + m * 16) * ldc + col0;
#pragma unroll
                for (int bj = 0; bj < 2; ++bj) { const f32x4 v0 = acc[ai][bj][m][0], v1 = acc[ai][bj][m][1];
                    const unsigned long long lo = (unsigned long long)cvt_pk_bf16(v0[0], v0[1]) | ((unsigned long long)cvt_pk_bf16(v0[2], v0[3]) << 32);
                    const unsigned long long hi = (unsigned long long)cvt_pk_bf16(v1[0], v1[1]) | ((unsigned long long)cvt_pk_bf16(v1[2], v1[3]) << 32);
                    unsigned long long* q = (unsigned long long*)(rowp + bj * HALF);
                    __hip_atomic_store(q, lo, __ATOMIC_RELAXED, __HIP_MEMORY_SCOPE_AGENT); __hip_atomic_store(q + 1, hi, __ATOMIC_RELAXED, __HIP_MEMORY_SCOPE_AGENT); } }
    }
};
__device__ __forceinline__ float silu_mul(float g, float u) { return g * u * __builtin_amdgcn_rcpf(1.f + __expf(-g)); }
struct EpiSwiGLU {
    static constexpr bool PERM = true, AFTER_DRAIN = false;
    bf16_t* O; int ldc;
    __device__ __forceinline__ void operator()(const f32x4 (&acc)[2][2][4][2], const Unit& u, int wr, int wc, int fr, int fq) const {
        const int row0 = u.pm * BM + wr * 64 + fr; const int col0 = u.pn * HALF + wc * 32 + 8 * fq;
#pragma unroll
        for (int ai = 0; ai < 2; ++ai)
#pragma unroll
            for (int m = 0; m < 4; ++m) { bf16_t* rowp = O + (size_t)(row0 + ai * HALF + m * 16) * ldc + col0;
                const f32x4 g0 = acc[ai][0][m][0], g1 = acc[ai][0][m][1], u0 = acc[ai][1][m][0], u1 = acc[ai][1][m][1];
                u32x4 w; w.x = cvt_pk_bf16(silu_mul(g0[0], u0[0]), silu_mul(g0[1], u0[1])); w.y = cvt_pk_bf16(silu_mul(g0[2], u0[2]), silu_mul(g0[3], u0[3]));
                w.z = cvt_pk_bf16(silu_mul(g1[0], u1[0]), silu_mul(g1[1], u1[1])); w.w = cvt_pk_bf16(silu_mul(g1[2], u1[2]), silu_mul(g1[3], u1[3]));
                *(u32x4*)rowp = w; }
    }
};

struct PanelOrder {
    int nN, nwg, G, c; unsigned* cnt;
    __device__ void init(int M, int N, int G_, int c_, unsigned* cnt_) { nN = N / BM; nwg = (M / BM) * nN; G = G_; c = c_; cnt = cnt_; }
    __device__ bool next(int i, Unit& u) const { const long L = (long)i * G + c; if (L >= nwg) return false; u.pm = (int)L / nN; u.pn = (int)L % nN; u.kh = 0; u.nt = 0; u.koff = 0; return true; }
    __device__ __forceinline__ void a_ready(const Unit&) const {}
    __device__ __forceinline__ void done(const Unit& u) const {
        asm volatile("s_waitcnt vmcnt(0)" ::: "memory");
        if ((threadIdx.x & 63) == 0) __hip_atomic_fetch_add(cnt + u.pm, 1u, __ATOMIC_RELAXED, __HIP_MEMORY_SCOPE_AGENT);
    }
};

struct SplitTailOrder {
    int G, c, ntf; bool split;
    __device__ void init(int K, int G_, int c_) { G = G_; c = c_; ntf = K / BK; split = (G_ == 256); }
    __device__ bool next(int i, Unit& u) const {
        if (!split) { const long L = (long)i * G + c; if (L >= 384) return false; u.pm = (int)L >> 2; u.pn = (int)L & 3; u.kh = 0; u.nt = 0; u.koff = 0; return true; }
        if (i == 0) { const int t = (c & 7) * 32 + (c >> 3); u.pm = t >> 2; u.pn = t & 3; u.kh = 0; u.nt = 0; u.koff = 0; return true; }
        if (i == 1) { const int t = 256 + (c & 7) * 16 + (c >> 4); u.pm = t >> 2; u.pn = t & 3; u.kh = (c >> 3) & 1; u.nt = ntf / 2; u.koff = u.kh * (ntf / 2) * BK * 2; return true; }
        return false;
    }
    __device__ __forceinline__ void a_ready(const Unit&) const {}
    __device__ __forceinline__ void done(const Unit&) const {}
};
struct EpiStoreSplit {
    static constexpr bool PERM = true, AFTER_DRAIN = false;
    bf16_t* O; bf16_t* O1; int ldc;
    __device__ __forceinline__ void operator()(const f32x4 (&acc)[2][2][4][2], const Unit& u, int wr, int wc, int fr, int fq) const {
        const int row0 = u.pm * BM + wr * 64 + fr; const int col0 = u.pn * BM + wc * 32 + 8 * fq; bf16_t* base = u.kh ? O1 : O;
#pragma unroll
        for (int ai = 0; ai < 2; ++ai)
#pragma unroll
            for (int m = 0; m < 4; ++m) { bf16_t* rowp = base + (size_t)(row0 + ai * HALF + m * 16) * ldc + col0;
#pragma unroll
                for (int bj = 0; bj < 2; ++bj) { const f32x4 v0 = acc[ai][bj][m][0], v1 = acc[ai][bj][m][1];
                    u32x4 w; w.x = cvt_pk_bf16(v0[0], v0[1]); w.y = cvt_pk_bf16(v0[2], v0[3]); w.z = cvt_pk_bf16(v1[0], v1[1]); w.w = cvt_pk_bf16(v1[2], v1[3]);
                    *(u32x4*)(rowp + bj * HALF) = w; } }
    }
};
template <class Epi, class Sched, bool ALIGN_EPI = false, bool SP2 = false>
__device__ __forceinline__ void gemm_phase(PG8_LAS unsigned char* lds, const Gemm g, const Sched& S, const Epi& E) {
    int tid_ = threadIdx.x; asm volatile("" : "+v"(tid_));
    const int tid = tid_, wid = __builtin_amdgcn_readfirstlane(tid >> 6), lane = tid & 63, wr = wid >> 2, wc = wid & 3, fr = lane & 15, fq = lane >> 4;
    const int K = g.K, nt = K / BK;
    unsigned voffA[2], voffB[2];
#pragma unroll
    for (int i = 0; i < 2; ++i) { int R, C; stage_rc(tid * 16 + i * 8192, R, C); const int Rb = Epi::PERM ? ((R & ~31) + perm32(R & 31)) : R;
        voffA[i] = (unsigned)(R * K + C) * 2u; voffB[i] = (unsigned)(Rb * K + C) * 2u; }
    const size_t kstep = (size_t)(BK * 2);
    const size_t hstep = (size_t)HALF * K * 2;
    const size_t tstep = 2 * hstep;
    const unsigned ldsw = (unsigned)wid * 1024u;
    const int aoff = lds_byte(wr * 64 + fr, fq * 8), boff = lds_byte(wc * 32 + fr, fq * 8);
#define PG8_SA(b, h) (((b) * 2 + (h)) * HTB)
#define PG8_SB(b, h) ((4 + (b) * 2 + (h)) * HTB)
#define PG8_STAGE(bufoff, gbase, voff) do { _Pragma("unroll") for (int _i = 0; _i < 2; ++_i) \
        __builtin_amdgcn_global_load_lds((const unsigned*)((const char*)(gbase) + (voff)[_i]), (PG8_LAS unsigned*)(lds + (bufoff) + ldsw + _i * 8192), 16, 0, 0); } while (0)
#define PG8_LDA(dst, b, h) do { _Pragma("unroll") for (int m = 0; m < 4; ++m) _Pragma("unroll") for (int k = 0; k < 2; ++k) dst[m][k] = *(const PG8_LAS bf16x8*)(lds + PG8_SA(b, h) + aoff + m * 2048 + k * 1024); } while (0)
#define PG8_LDB(dst, b, h) do { _Pragma("unroll") for (int n = 0; n < 2; ++n) _Pragma("unroll") for (int k = 0; k < 2; ++k) dst[n][k] = *(const PG8_LAS bf16x8*)(lds + PG8_SB(b, h) + boff + n * 2048 + k * 1024); } while (0)
#define PG8_MMA(ai, bj, At, Bt) do { __builtin_amdgcn_s_setprio(1); _Pragma("unroll") for (int m = 0; m < 4; ++m) _Pragma("unroll") for (int n = 0; n < 2; ++n) _Pragma("unroll") for (int k = 0; k < 2; ++k) \
        acc[ai][bj][m][n] = __builtin_amdgcn_mfma_f32_16x16x32_bf16(Bt[n][k], At[m][k], acc[ai][bj][m][n], 0, 0, 0); __builtin_amdgcn_s_setprio(0); } while (0)
#define PG8_WAIT_V(n) asm volatile("s_waitcnt vmcnt(" #n ")" ::: "memory")
#define PG8_WAIT_L(n) asm volatile("s_waitcnt lgkmcnt(" #n ")" ::: "memory")
#define PG8_BAR __builtin_amdgcn_s_barrier()
#define PG8_SCHED __builtin_amdgcn_sched_barrier(0)
    Unit cur, nxt; int ui = 0;
    if (!S.next(0, cur)) return;
    f32x4 acc[2][2][4][2];
#pragma unroll
    for (int a = 0; a < 2; ++a)
#pragma unroll
        for (int b = 0; b < 2; ++b)
#pragma unroll
            for (int m = 0; m < 4; ++m)
#pragma unroll
                for (int n = 0; n < 2; ++n) acc[a][b][m][n] = (f32x4){0.f, 0.f, 0.f, 0.f};
    bf16x8 At[4][2], B0[2][2], B1[2][2];
    const char* cA = (const char*)g.A + (size_t)cur.pm * tstep + cur.koff; const char* cB = (const char*)g.Bt + (size_t)cur.pn * tstep + cur.koff;
    S.a_ready(cur);
    if constexpr (SP2) {
        PG8_STAGE(PG8_SB(0, 0), cB, voffB); PG8_STAGE(PG8_SB(0, 1), cB + hstep, voffB); PG8_STAGE(PG8_SA(0, 0), cA, voffA); PG8_STAGE(PG8_SA(0, 1), cA + hstep, voffA);
        if (wr == 1) PG8_BAR;
        PG8_WAIT_V(2); PG8_BAR;
        PG8_STAGE(PG8_SB(1, 0), cB + kstep, voffB); PG8_STAGE(PG8_SA(1, 0), cA + kstep, voffA); PG8_STAGE(PG8_SB(1, 1), cB + hstep + kstep, voffB);
        PG8_WAIT_V(6); PG8_BAR;
    } else {
        PG8_STAGE(PG8_SB(0, 0), cB, voffB); PG8_STAGE(PG8_SA(0, 0), cA, voffA); PG8_STAGE(PG8_SB(0, 1), cB + hstep, voffB); PG8_STAGE(PG8_SA(0, 1), cA + hstep, voffA);
        if (wr == 1) PG8_BAR;
        PG8_WAIT_V(4); PG8_BAR;
        PG8_STAGE(PG8_SB(1, 0), cB + kstep, voffB); PG8_STAGE(PG8_SA(1, 0), cA + kstep, voffA); PG8_STAGE(PG8_SB(1, 1), cB + hstep + kstep, voffB);
        PG8_WAIT_V(6); PG8_BAR;
    }
    for (;;) {
        const bool has_next = S.next(ui + 1, nxt);
        const char* nA = has_next ? (const char*)g.A + (size_t)nxt.pm * tstep + nxt.koff : cA; const char* nB = has_next ? (const char*)g.Bt + (size_t)nxt.pn * tstep + nxt.koff : cB;
        const int ntc = cur.nt ? cur.nt : nt;
        for (int t = 0; t < ntc; t += 2) {
            const bool last = (t == ntc - 2);
            const char* a1 = cA + (size_t)(t + 1) * kstep;
            const char* a2 = last ? nA : cA + (size_t)(t + 2) * kstep; const char* b2 = last ? nB : cB + (size_t)(t + 2) * kstep;
            const char* a3 = a2 + kstep; const char* b3 = b2 + kstep;
            if (last && has_next) S.a_ready(nxt);
            if constexpr (SP2) {
            PG8_LDB(B0, 0, 0); PG8_LDB(B1, 0, 1); PG8_SCHED; PG8_LDA(At, 0, 0); PG8_STAGE(PG8_SA(1, 1), a1 + hstep, voffA);
            PG8_WAIT_V(8); PG8_WAIT_L(0); PG8_BAR; PG8_MMA(0, 0, At, B0); PG8_MMA(0, 1, At, B1); PG8_BAR; PG8_SCHED;
            PG8_LDA(At, 0, 1); PG8_STAGE(PG8_SB(0, 0), b2, voffB); PG8_STAGE(PG8_SB(0, 1), b2 + hstep, voffB); PG8_STAGE(PG8_SA(0, 0), a2, voffA);
            PG8_WAIT_V(8); PG8_WAIT_L(0); PG8_BAR; PG8_MMA(1, 0, At, B0); PG8_MMA(1, 1, At, B1); PG8_BAR; PG8_SCHED;
            PG8_LDB(B0, 1, 0); PG8_LDB(B1, 1, 1); PG8_SCHED; PG8_LDA(At, 1, 0); PG8_STAGE(PG8_SA(0, 1), a2 + hstep, voffA);
            PG8_WAIT_V(8); PG8_WAIT_L(0); PG8_BAR; PG8_MMA(0, 0, At, B0); PG8_MMA(0, 1, At, B1); PG8_BAR; PG8_SCHED;
            PG8_LDA(At, 1, 1); PG8_STAGE(PG8_SB(1, 0), b3, voffB); PG8_STAGE(PG8_SB(1, 1), b3 + hstep, voffB); PG8_STAGE(PG8_SA(1, 0), a3, voffA);
            PG8_WAIT_V(8); PG8_WAIT_L(0); PG8_BAR; PG8_MMA(1, 0, At, B0); PG8_MMA(1, 1, At, B1); PG8_BAR; PG8_SCHED;
            } else {
            PG8_LDB(B0, 0, 0); PG8_SCHED; PG8_LDA(At, 0, 0); PG8_STAGE(PG8_SA(1, 1), a1 + hstep, voffA);
            PG8_WAIT_L(8); PG8_BAR; PG8_WAIT_L(0); PG8_MMA(0, 0, At, B0); PG8_BAR; PG8_SCHED;
            PG8_LDB(B1, 0, 1); PG8_STAGE(PG8_SB(0, 0), b2, voffB);
            PG8_BAR; PG8_WAIT_L(0); PG8_MMA(0, 1, At, B1); PG8_BAR;
            PG8_LDA(At, 0, 1); PG8_STAGE(PG8_SA(0, 0), a2, voffA);
            PG8_BAR; PG8_WAIT_L(0); PG8_MMA(1, 0, At, B0); PG8_BAR; PG8_SCHED;
            PG8_STAGE(PG8_SB(0, 1), b2 + hstep, voffB);
            PG8_WAIT_V(6); PG8_BAR; PG8_MMA(1, 1, At, B1); PG8_BAR;
            PG8_LDB(B0, 1, 0); PG8_SCHED; PG8_LDA(At, 1, 0); PG8_STAGE(PG8_SA(0, 1), a2 + hstep, voffA);
            PG8_WAIT_L(8); PG8_BAR; PG8_WAIT_L(0); PG8_MMA(0, 0, At, B0); PG8_BAR; PG8_SCHED;
            PG8_LDB(B1, 1, 1); PG8_STAGE(PG8_SB(1, 0), b3, voffB);
            PG8_BAR; PG8_WAIT_L(0); PG8_MMA(0, 1, At, B1); PG8_BAR;
            PG8_LDA(At, 1, 1); PG8_STAGE(PG8_SA(1, 0), a3, voffA);
            PG8_BAR; PG8_WAIT_L(0); PG8_MMA(1, 0, At, B0); PG8_BAR; PG8_SCHED;
            PG8_STAGE(PG8_SB(1, 1), b3 + hstep, voffB);
            PG8_WAIT_V(6); PG8_BAR; PG8_MMA(1, 1, At, B1); PG8_BAR;
            }
        }
        if constexpr (ALIGN_EPI) { if (wr == 0) PG8_BAR; }
        if constexpr (!Epi::AFTER_DRAIN) { E(acc, cur, wr, wc, fr, fq); S.done(cur); }
        if (!has_next) break;
#pragma unroll
        for (int a = 0; a < 2; ++a)
#pragma unroll
            for (int b = 0; b < 2; ++b)
#pragma unroll
                for (int m = 0; m < 4; ++m)
#pragma unroll
                    for (int n = 0; n < 2; ++n) acc[a][b][m][n] = (f32x4){0.f, 0.f, 0.f, 0.f};
        cur = nxt; cA = nA; cB = nB; ++ui;
        if constexpr (ALIGN_EPI) { if (wr == 1) PG8_BAR; }
    }
    PG8_WAIT_V(0);
    if constexpr (!ALIGN_EPI) { if (wr == 0) PG8_BAR; }
    PG8_BAR;
    if constexpr (Epi::AFTER_DRAIN) { E.fused(acc, cur, wr, wc, fr, fq, lds, wid, lane); S.done(cur); }
#undef PG8_SA
#undef PG8_SB
#undef PG8_STAGE
#undef PG8_LDA
#undef PG8_LDB
#undef PG8_MMA
#undef PG8_WAIT_V
#undef PG8_WAIT_L
#undef PG8_BAR
#undef PG8_SCHED
}
}
#define LAS __attribute__((address_space(3)))
typedef unsigned short bf16_t;
typedef short bf16x8 __attribute__((ext_vector_type(8)));
typedef short bf16x4 __attribute__((ext_vector_type(4)));
typedef float f32x4 __attribute__((ext_vector_type(4)));
typedef float f32x2 __attribute__((ext_vector_type(2)));
typedef float f32x16 __attribute__((ext_vector_type(16)));
typedef unsigned u32x4 __attribute__((ext_vector_type(4)));
typedef unsigned u32x2 __attribute__((ext_vector_type(2)));

constexpr int D = 1024, M_CTX = 8192, M_LAT = 16384, M = M_CTX + M_LAT, NP = 1888, NPP = 2048, FF = 2816, DEPTH = 4;
constexpr int KEYROWS = 8192 + 4 * 4352;
constexpr float EPS = 1e-6f;
constexpr int NTHREADS = 512, NWAVES = 8;
constexpr int LDS_BYTES = 147456;

constexpr size_t OUT_X = 0, OUT_CKV = (size_t)M * D, OUT_KR = OUT_CKV + (size_t)32 * 4 * 256 * 128;
constexpr int PC_U = 0, PC_V = 256, PC_H = 512, PC_B = 768, PC_C = 1024, PC_F = 1280, PC_Q = 1536, PC_KV = 1728, PC_KR = 1856;

constexpr size_t al256(size_t x) { return (x + 255) & ~(size_t)255; }
constexpr size_t WS_BAR = 0, WS_BAR_BYTES = 16384;
constexpr size_t WS_MOD = WS_BAR_BYTES;
constexpr size_t WS_F64 = al256(WS_MOD + (size_t)4 * 5 * 6144 * 4);
constexpr size_t WS_T64R = WS_F64 + 128 * 64 * 2;
constexpr size_t WS_T64I = WS_T64R + 64 * 128 * 2;
constexpr size_t WS_T64B = WS_T64I + 64 * 128 * 2;
constexpr size_t WS_T256 = WS_T64B + 64 * 128 * 2;
constexpr size_t WS_TW = WS_T256 + 256 * 512 * 2;
constexpr size_t WS_ROPE = WS_TW + 4096 * 8;
constexpr size_t WS_W = al256(WS_ROPE + 64 * 8 * 8);
constexpr size_t WL_IN = 0, WL_OUT = WL_IN + (size_t)NPP * D * 2, WL_GU = WL_OUT + (size_t)D * D * 2, WL_DN = WL_GU + (size_t)2 * FF * D * 2,
                 WL_UQ = WL_DN + (size_t)D * FF * 2, WL_UKV = WL_UQ + (size_t)384 * 192 * 2, WL_SP = WL_UKV + (size_t)512 * 128 * 2, WL_SIZE = WL_SP + (size_t)4 * 128 * 128 * 2;
constexpr size_t WS_R1 = al256(WS_W + 4 * WL_SIZE);
constexpr size_t WS_R2 = WS_R1 + (size_t)M * D * 2;
constexpr size_t WS_MLA = WS_R2 + (size_t)M * FF * 2;
constexpr size_t WS_Q = WS_MLA, WS_KN = WS_Q + (size_t)M * 384 * 2, WS_VT = WS_KN + (size_t)KEYROWS * 256 * 2, WS_KR = WS_VT + (size_t)KEYROWS * 256 * 2,
                 WS_GB = WS_KR + (size_t)KEYROWS * 32 * 2, WS_END = WS_GB + (size_t)4 * 4 * 64 * 64 * 128 * 2;
static_assert(WS_END - WS_MLA >= (size_t)M * D * 2, "FFNOUT alias");
static_assert((size_t)M * NP * 2 <= (size_t)M * FF * 2, "PROJ fits R2");

struct Params { const float* in[24]; float* out; unsigned char* ws; };
enum { I_XP = 0, I_XS, I_CCKV, I_CKR, I_C, I_CCTX, I_WADA, I_BADA, I_GPM, I_GPOM, I_GPF, I_GPOF, I_WIN, I_SPW, I_SPB, I_CVW, I_CVB, I_GQ, I_WUQ, I_GKV, I_WUKV, I_WOUT, I_WGU, I_WDN };

__device__ __forceinline__ unsigned f2bf(float f) { unsigned u = __builtin_bit_cast(unsigned, f); return (u + 0x7fffu + ((u >> 16) & 1u)) >> 16; }
typedef __bf16 bf16x2v __attribute__((ext_vector_type(2)));
__device__ __forceinline__ unsigned pk2(float lo, float hi) { const bf16x2v r = __builtin_convertvector((f32x2){lo, hi}, bf16x2v); return __builtin_bit_cast(unsigned, r); }
__device__ __forceinline__ float bflo(unsigned w) { return __builtin_bit_cast(float, w << 16); }
__device__ __forceinline__ float bfhi(unsigned w) { return __builtin_bit_cast(float, w & 0xffff0000u); }
__device__ __forceinline__ float bf1(bf16_t v) { return __builtin_bit_cast(float, (unsigned)v << 16); }
__device__ __forceinline__ f32x4 mma16(bf16x8 a, bf16x8 b, f32x4 c) { return __builtin_amdgcn_mfma_f32_16x16x32_bf16(a, b, c, 0, 0, 0); }
__device__ __forceinline__ f32x16 mma32(bf16x8 a, bf16x8 b, f32x16 c) { return __builtin_amdgcn_mfma_f32_32x32x16_bf16(a, b, c, 0, 0, 0); }
__device__ __forceinline__ float wave_sum(float v) {
#pragma unroll
    for (int o = 1; o < 64; o <<= 1) v += __shfl_xor(v, o);
    return v;
}
__device__ __forceinline__ u32x2 pk4(f32x4 v) { u32x2 w; w.x = pk2(v[0], v[1]); w.y = pk2(v[2], v[3]); return w; }
__device__ __forceinline__ int mod_of_row(int r) { return r < M_CTX ? 0 : 1 + ((r - M_CTX) >> 12); }

struct Ctx {
    Params p; LAS unsigned char* lds; int tid, lane, wave, bid, G;
    unsigned char* ws;
    __device__ __forceinline__ const float* mod(int l, int mi, int chunk) const { return (const float*)(ws + WS_MOD) + ((size_t)(l * 5 + mi) * 6 + chunk) * 1024; }
    __device__ __forceinline__ unsigned char* wl(int l) const { return ws + WS_W + (size_t)l * WL_SIZE; }
    __device__ __forceinline__ void refresh() { int t = threadIdx.x; asm volatile("" : "+v"(t)); tid = t; lane = t & 63; wave = __builtin_amdgcn_readfirstlane(t >> 6);
        size_t z = 0; asm volatile("" : "+s"(z)); ws = p.ws + z;
        int b = blockIdx.x; asm volatile("" : "+s"(b)); bid = b; }
};

constexpr int TPS = 258;
struct TItem { const float* W; bf16_t* WT; int ldw, K, k0, n0, nvalid, gu; };
__device__ __forceinline__ void titem_load(const TItem& t, int wave, int lane, f32x4 (&v)[8]) {
    const int n = t.n0 + 4 * lane;
#pragma unroll
    for (int i = 0; i < 8; ++i) v[i] = n < t.nvalid ? __builtin_nontemporal_load((const f32x4*)(t.W + (size_t)(t.k0 + 8 * wave + i) * t.ldw + n)) : (f32x4){0.f, 0.f, 0.f, 0.f};
}
__device__ __forceinline__ void titem_stage(LAS unsigned char* lds, int wave, int lane, const f32x4 (&v)[8]) {
    LAS bf16_t* T = (LAS bf16_t*)lds;
#pragma unroll
    for (int i = 0; i < 8; ++i) { LAS unsigned* d = (LAS unsigned*)(T + (8 * wave + i) * TPS + 4 * lane); d[0] = pk2(v[i][0], v[i][1]); d[1] = pk2(v[i][2], v[i][3]); }
}
__device__ __forceinline__ void titem_store(const TItem& t, const LAS unsigned char* lds, int tid) {
    const LAS bf16_t* T = (const LAS bf16_t*)lds;
#pragma unroll
    for (int it = 0; it < 4; ++it) { const int q = tid + NTHREADS * it, n = q >> 3, c = q & 7;
        unsigned short e[8];
#pragma unroll
        for (int j = 0; j < 8; ++j) e[j] = T[(8 * c + j) * TPS + n];
        const int sn = t.n0 + n;
        if (sn < t.nvalid) { int dr = sn; if (t.gu) { const int isup = sn >= FF, jj = isup ? sn - FF : sn; dr = (jj >> 7) * 256 + isup * 128 + (jj & 127); }
            u32x4 o; o.x = e[0] | ((unsigned)e[1] << 16); o.y = e[2] | ((unsigned)e[3] << 16); o.z = e[4] | ((unsigned)e[5] << 16); o.w = e[6] | ((unsigned)e[7] << 16);
            *(u32x4*)(t.WT + (size_t)dr * t.K + t.k0 + 8 * c) = o; } }
}
constexpr int TI_IN = 16 * 8, TI_OUT = 16 * 4, TI_GU = 16 * 22, TI_DN = 44 * 4, TI_UQ = 3 * 2, TI_UKV = 2 * 2, TI_L = TI_IN + TI_OUT + TI_GU + TI_DN + TI_UQ + TI_UKV;
__device__ __forceinline__ TItem titem_make(const Ctx& C, int it) {
    const Params& p = C.p; const int l = it / TI_L; int r = it % TI_L; unsigned char* wl = C.wl(l); TItem t; t.gu = 0;
    if (r < TI_IN) { t.W = p.in[I_WIN] + (size_t)l * D * NP; t.WT = (bf16_t*)(wl + WL_IN); t.ldw = NP; t.K = D; t.k0 = (r >> 3) * 64; t.n0 = (r & 7) * 256; t.nvalid = NP; return t; } r -= TI_IN;
    if (r < TI_OUT) { t.W = p.in[I_WOUT] + (size_t)l * D * D; t.WT = (bf16_t*)(wl + WL_OUT); t.ldw = D; t.K = D; t.k0 = (r >> 2) * 64; t.n0 = (r & 3) * 256; t.nvalid = D; return t; } r -= TI_OUT;
    if (r < TI_GU) { t.W = p.in[I_WGU] + (size_t)l * D * 2 * FF; t.WT = (bf16_t*)(wl + WL_GU); t.ldw = 2 * FF; t.K = D; t.k0 = (r / 22) * 64; t.n0 = (r % 22) * 256; t.nvalid = 2 * FF; t.gu = 1; return t; } r -= TI_GU;
    if (r < TI_DN) { t.W = p.in[I_WDN] + (size_t)l * FF * D; t.WT = (bf16_t*)(wl + WL_DN); t.ldw = D; t.K = FF; t.k0 = (r >> 2) * 64; t.n0 = (r & 3) * 256; t.nvalid = D; return t; } r -= TI_DN;
    if (r < TI_UQ) { t.W = p.in[I_WUQ] + (size_t)l * 192 * 384; t.WT = (bf16_t*)(wl + WL_UQ); t.ldw = 384; t.K = 192; t.k0 = (r >> 1) * 64; t.n0 = (r & 1) * 256; t.nvalid = 384; return t; } r -= TI_UQ;
    t.W = p.in[I_WUKV] + (size_t)l * 128 * 512; t.WT = (bf16_t*)(wl + WL_UKV); t.ldw = 512; t.K = 128; t.k0 = (r >> 1) * 64; t.n0 = (r & 1) * 256; t.nvalid = 512; return t;
}

__device__ __forceinline__ void transpose_items(const Ctx& C, int it0, int stride, int end) {
    int it = it0; f32x4 v[8];
    TItem cur; if (it < end) { cur = titem_make(C, it); titem_load(cur, C.wave, C.lane, v); }
    while (it < end) {
        titem_stage(C.lds, C.wave, C.lane, v);
        const int nx = it + stride; TItem nxt = cur; if (nx < end) { nxt = titem_make(C, nx); titem_load(nxt, C.wave, C.lane, v); }
        __syncthreads();
        titem_store(cur, C.lds, C.tid);
        __syncthreads();
        cur = nxt; it = nx;
    }
}

__device__ __forceinline__ void phase_prologue(const Ctx& C) {
    const Params& p = C.p;
    transpose_items(C, C.bid, C.G, (C.G == 256) ? TI_L : 4 * TI_L);
    {
        LAS float* sc = (LAS float*)C.lds;
        LAS float* red = (LAS float*)(C.lds + 5 * 1024 * 4);
        const int ub = C.G - 1 - C.bid;
        if (ub < 96) {
            size_t za = 0, zb = 0; asm volatile("" : "+s"(za), "+s"(zb));
            const float* cctx = p.in[I_CCTX] + za; const float* cc_ = p.in[I_C] + zb;
            for (int i = C.tid; i < 5120; i += NTHREADS) { const int j = i >> 10, k = i & 1023; const float v = (j == 0) ? cctx[k] : cc_[(j - 1) * 1024 + k]; sc[i] = v / (1.f + __expf(-v)); }
            __syncthreads();
            for (int u = ub; u < 96; u += C.G) {
                const int l = u / 24, cb = u % 24;
                const float* w = p.in[I_WADA] + ((size_t)l * 1024 + C.wave * 128) * 6144 + cb * 256 + 4 * C.lane;
                f32x4 a0 = {0.f, 0.f, 0.f, 0.f}, a1 = a0, a2 = a0, a3 = a0, a4 = a0;
#pragma unroll 16
                for (int k = 0; k < 128; ++k) { const f32x4 wv = __builtin_nontemporal_load((const f32x4*)(w + (size_t)k * 6144)); const int kk = C.wave * 128 + k;
                    a0 += wv * sc[kk]; a1 += wv * sc[1024 + kk]; a2 += wv * sc[2048 + kk]; a3 += wv * sc[3072 + kk]; a4 += wv * sc[4096 + kk]; }
                LAS f32x4* rw = (LAS f32x4*)(red + C.wave * 1280) + C.lane;
                rw[0] = a0; rw[64] = a1; rw[128] = a2; rw[192] = a3; rw[256] = a4;
                __syncthreads();
                for (int i = C.tid; i < 1280; i += NTHREADS) { const int j = i >> 8, c2 = i & 255; float sum = p.in[I_BADA][l * 6144 + cb * 256 + c2];
#pragma unroll
                    for (int ww = 0; ww < 8; ++ww) sum += red[ww * 1280 + i];
                    ((float*)(C.ws + WS_MOD))[(size_t)(l * 5 + j) * 6144 + cb * 256 + c2] = sum; }
                __syncthreads();
            }
        }
        __syncthreads();
    }
    {
        const int gt = C.bid * NTHREADS + C.tid, GT = C.G * NTHREADS;
        for (int i = gt; i < 4 * 65536; i += GT) { const int l = i >> 16, e = i & 65535; ((bf16_t*)(C.wl(l) + WL_SP))[e] = (bf16_t)f2bf(p.in[I_SPW][i]); }
        for (int i = gt; i < 4 * 160 * 1024 / 2; i += GT) { const int l = i / (160 * 512), e = i % (160 * 512); ((unsigned*)(C.wl(l) + WL_IN + (size_t)NP * D * 2))[e] = 0u; }
        for (int i = gt; i < 128 * 64; i += GT) { const int m = i >> 6, c = i & 63; const int idx = ((m & 63) * c) & 63; const float a = (float)idx / 32.f;
            ((bf16_t*)(C.ws + WS_F64))[i] = (bf16_t)f2bf(m < 64 ? cospif(a) : sinpif(a)); }
        for (int i = gt; i < 64 * 128; i += GT) { const int k = i >> 7, K = i & 127; const int idx = (k * (K & 63)) & 63; const float a = (float)idx / 32.f; const float cv = cospif(a), sv = sinpif(a);
            ((bf16_t*)(C.ws + WS_T64R))[i] = (bf16_t)f2bf(K < 64 ? cv : -sv);
            ((bf16_t*)(C.ws + WS_T64I))[i] = (bf16_t)f2bf(K < 64 ? -sv : -cv);
            ((bf16_t*)(C.ws + WS_T64B))[i] = (bf16_t)f2bf(K < 64 ? cv : sv); }
        for (int i = gt; i < 256 * 512; i += GT) { const int k = i >> 9, K = i & 511; const int idx = (k * (K & 255)) & 255; const float a = (float)idx / 128.f;
            ((bf16_t*)(C.ws + WS_T256))[i] = (bf16_t)f2bf(K < 256 ? cospif(a) : -sinpif(a)); }
        for (int i = gt; i < 4096; i += GT) { const float a = (float)i / 2048.f; ((f32x2*)(C.ws + WS_TW))[i] = (f32x2){cospif(a), sinpif(a)}; }
        for (int i = gt; i < 512; i += GT) { const int pos = i >> 3, f = i & 7; const float inv = powf(10000.f, -(float)f / 8.f); const float ang = (float)pos * inv;
            ((f32x2*)(C.ws + WS_ROPE))[i] = (f32x2){cosf(ang), sinf(ang)}; }
    }
}

__device__ __forceinline__ void load_row_f32(const float* rowp, int lane, f32x4 (&v)[4]) {
#pragma unroll
    for (int j = 0; j < 4; ++j) v[j] = *(const f32x4*)(rowp + 4 * lane + 256 * j);
}
__device__ __forceinline__ void load_row_f32_nt(const float* rowp, int lane, f32x4 (&v)[4]) {
#pragma unroll
    for (int j = 0; j < 4; ++j) v[j] = __builtin_nontemporal_load((const f32x4*)(rowp + 4 * lane + 256 * j));
}
__device__ __forceinline__ void load_row_bf16(const bf16_t* rowp, int lane, f32x4 (&v)[4]) {
#pragma unroll
    for (int j = 0; j < 4; ++j) { const u32x2 w = *(const u32x2*)(rowp + 4 * lane + 256 * j); v[j] = (f32x4){bflo(w.x), bfhi(w.x), bflo(w.y), bfhi(w.y)}; }
}
__device__ __forceinline__ float row_rstd(const f32x4 (&v)[4]) {
    float s = 0.f;
#pragma unroll
    for (int j = 0; j < 4; ++j) s += (v[j][0] * v[j][0] + v[j][1] * v[j][1]) + (v[j][2] * v[j][2] + v[j][3] * v[j][3]);
    return 1.f / sqrtf(wave_sum(s) * (1.f / 1024.f) + EPS);
}
__device__ __forceinline__ void norm_mod_store(const f32x4 (&x)[4], const float* g, const float* scale, const float* shift, bf16_t* orow, int lane) {
    const float rs = row_rstd(x);
#pragma unroll
    for (int j = 0; j < 4; ++j) { const int c = 4 * lane + 256 * j; const f32x4 gv = *(const f32x4*)(g + c), sv = *(const f32x4*)(scale + c), hv = *(const f32x4*)(shift + c);
        const f32x4 h = x[j] * rs * gv * (1.f + sv) + hv; *(u32x2*)(orow + c) = pk4(h); }
}
__device__ __forceinline__ void norm_mod_store_g(const f32x4 (&x)[4], const f32x4 (&gv)[4], const float* scale, const float* shift, bf16_t* orow, int lane) {
    const float rs = row_rstd(x);
#pragma unroll
    for (int j = 0; j < 4; ++j) { const int c = 4 * lane + 256 * j; const f32x4 sv = *(const f32x4*)(scale + c), hv = *(const f32x4*)(shift + c);
        const f32x4 h = x[j] * rs * gv[j] * (1.f + sv) + hv; *(u32x2*)(orow + c) = pk4(h); }
}
__device__ __forceinline__ const float* xin_row(const Ctx& C, int layer, int r) {
    if (layer > 0) return C.p.out + OUT_X + (size_t)r * D;
    size_t za = 0, zb = 0; asm volatile("" : "+s"(za), "+s"(zb));
    const float* a = C.p.in[I_XP] + za; const float* b = C.p.in[I_XS] + zb;
    return r < M_CTX ? a + (size_t)r * D : b + (size_t)(r - M_CTX) * D;
}
constexpr int SPLIT_ROW0 = 16384;
__device__ __forceinline__ void load_row_bf16_nt(const bf16_t* rowp, int lane, f32x4 (&v)[4]) {
#pragma unroll
    for (int j = 0; j < 4; ++j) { const u32x2 w = __builtin_nontemporal_load((const u32x2*)(rowp + 4 * lane + 256 * j)); v[j] = (f32x4){bflo(w.x), bfhi(w.x), bflo(w.y), bfhi(w.y)}; }
}
__device__ __forceinline__ void load_T(const bf16_t* T, const bf16_t* T1, bool split, int r, int lane, f32x4 (&v)[4]) {
    load_row_bf16_nt(T + (size_t)r * D, lane, v);
    if (split && r >= SPLIT_ROW0) { f32x4 w[4]; load_row_bf16_nt(T1 + (size_t)r * D, lane, w);
#pragma unroll
        for (int j = 0; j < 4; ++j) v[j] = v[j] + w[j]; }
}
__device__ __forceinline__ void phase_norm0(const Ctx& C) {
    const int gw = C.bid * NWAVES + C.wave, NGW = C.G * NWAVES;
    bf16_t* H = (bf16_t*)(C.ws + WS_R1);
    f32x4 xn[4]; load_row_f32_nt(xin_row(C, 0, gw), C.lane, xn);
    for (int r = gw; r < M; r += NGW) { f32x4 x[4];
#pragma unroll
        for (int j = 0; j < 4; ++j) x[j] = xn[j];
        if (r + NGW < M) load_row_f32_nt(xin_row(C, 0, r + NGW), C.lane, xn);
        const int mi = mod_of_row(r);
        norm_mod_store(x, C.p.in[I_GPM], C.mod(0, mi, 1), C.mod(0, mi, 0), H + (size_t)r * D, C.lane); }
}
template <int which  > __device__ __forceinline__ void phase_post(const Ctx& C, int layer) {
    const int gw = C.bid * NWAVES + C.wave, NGW = C.G * NWAVES;
    const bf16_t* T = (const bf16_t*)(C.ws + (which == 0 ? WS_R2 : WS_MLA));
    const bf16_t* T1 = T + (size_t)M * D - (size_t)SPLIT_ROW0 * D;
    const bool split = (C.G == 256);
    bf16_t* H = (bf16_t*)(C.ws + WS_R1);
    const float* gpost = (which == 0 ? C.p.in[I_GPOM] : C.p.in[I_GPOF]) + layer * D;
    const bool do_next = (which == 0) || (layer + 1 < DEPTH);
    const int nl = which == 0 ? layer : layer + 1;
    const float* gnext = (which == 0 ? C.p.in[I_GPF] : C.p.in[I_GPM]) + (nl < DEPTH ? nl : 0) * D;
    f32x4 gg[4], gs[4], sh[4]; int cur_mi = -1;
#pragma unroll
    for (int j = 0; j < 4; ++j) { gg[j] = (f32x4){0.f, 0.f, 0.f, 0.f}; gs[j] = gg[j]; sh[j] = gg[j]; }
    f32x4 tn[4], xn[4];
    load_T(T, T1, split, gw, C.lane, tn); load_row_f32_nt(which == 0 ? xin_row(C, layer, gw) : C.p.out + OUT_X + (size_t)gw * D, C.lane, xn);
    for (int r = gw; r < M; r += NGW) {
        const int mi = mod_of_row(r);
        if (mi != cur_mi) { cur_mi = mi;
            const float* gate = C.mod(layer, mi, which == 0 ? 2 : 5); const float* scale = C.mod(nl, mi, which == 0 ? 4 : 1); const float* shift = C.mod(nl, mi, which == 0 ? 3 : 0);
#pragma unroll
            for (int j = 0; j < 4; ++j) { const int c = 4 * C.lane + 256 * j; gg[j] = *(const f32x4*)(gate + c) * *(const f32x4*)(gpost + c);
                if (do_next) { gs[j] = *(const f32x4*)(gnext + c) * (1.f + *(const f32x4*)(scale + c)); sh[j] = *(const f32x4*)(shift + c); } } }
        f32x4 t[4], x[4];
#pragma unroll
        for (int j = 0; j < 4; ++j) { t[j] = tn[j]; x[j] = xn[j]; }
        if (r + NGW < M) { const int rn = r + NGW; load_T(T, T1, split, rn, C.lane, tn); load_row_f32_nt(which == 0 ? xin_row(C, layer, rn) : C.p.out + OUT_X + (size_t)rn * D, C.lane, xn); }
        const float rs = row_rstd(t);
        float* xo = C.p.out + OUT_X + (size_t)r * D;
#pragma unroll
        for (int j = 0; j < 4; ++j) { const int c = 4 * C.lane + 256 * j; x[j] = x[j] + gg[j] * (t[j] * rs); __builtin_nontemporal_store(x[j], (f32x4*)(xo + c)); }
        if (do_next) { const float rs2 = row_rstd(x); bf16_t* orow = H + (size_t)r * D;
#pragma unroll
            for (int j = 0; j < 4; ++j) { const int c = 4 * C.lane + 256 * j; const f32x4 h = x[j] * rs2 * gs[j] + sh[j]; *(u32x2*)(orow + c) = pk4(h); } }
    }
}

__device__ __forceinline__ void unit_chunk_mlp(const Ctx& C, int layer, int u) {
    const int chunk = u >> 2, g = u & 3, r0 = chunk * 128;
    const bf16_t* PROJ = (const bf16_t*)(C.ws + WS_R2); bf16_t* MIX = (bf16_t*)(C.ws + WS_R1);
    constexpr int VS = 136;
    LAS bf16_t* Vt = (LAS bf16_t*)C.lds;
    { const int q = C.tid >> 2, c0 = (C.tid & 3) * 16; const bf16_t* src = PROJ + (size_t)(r0 + q) * NP + PC_V + g * 64 + c0;
      const bf16x8 v0 = *(const bf16x8*)src, v1 = *(const bf16x8*)(src + 8);
#pragma unroll
      for (int j = 0; j < 8; ++j) { Vt[(c0 + j) * VS + q] = (bf16_t)v0[j]; Vt[(c0 + 8 + j) * VS + q] = (bf16_t)v1[j]; } }
    __syncthreads();
    const int l15 = C.lane & 15, hq = C.lane >> 4, w = C.wave;
    const bf16_t* Wg = (const bf16_t*)(C.wl(layer) + WL_SP) + (size_t)g * 128 * 128;
    bf16x8 bw[4];
#pragma unroll
    for (int ks = 0; ks < 4; ++ks) bw[ks] = *(const bf16x8*)(Wg + (size_t)(w * 16 + l15) * 128 + ks * 32 + 8 * hq);
    const int p = w * 16 + l15; const float bias = C.p.in[I_SPB][(layer * 4 + g) * 128 + p];
#pragma unroll
    for (int ct = 0; ct < 4; ++ct) {
        f32x4 acc = {0.f, 0.f, 0.f, 0.f};
#pragma unroll
        for (int ks = 0; ks < 4; ++ks) { const bf16x8 a = *(const LAS bf16x8*)(Vt + (ct * 16 + l15) * VS + ks * 32 + 8 * hq); acc = mma16(a, bw[ks], acc); }
        const int cc = g * 64 + ct * 16 + 4 * hq; const u32x2 uw = *(const u32x2*)(PROJ + (size_t)(r0 + p) * NP + PC_U + cc);
        f32x4 o; o[0] = bflo(uw.x) * (acc[0] + bias); o[1] = bfhi(uw.x) * (acc[1] + bias); o[2] = bflo(uw.y) * (acc[2] + bias); o[3] = bfhi(uw.y) * (acc[3] + bias);
        *(u32x2*)(MIX + (size_t)(r0 + p) * D + cc) = pk4(o);
    }
    __syncthreads();
}
__device__ __forceinline__ void unit_conv(const Ctx& C, int layer, int u) {
    const bf16_t* PROJ = (const bf16_t*)(C.ws + WS_R2); bf16_t* MIX = (bf16_t*)(C.ws + WS_R1);
    const float* cw = C.p.in[I_CVW] + layer * 3 * 256; const float* cb = C.p.in[I_CVB] + layer * 256;
    for (int it = 0; it < 8; ++it) {
        const int item = it * NTHREADS + C.tid, t = item >> 5, ch = (item & 31) * 8, r = u * 128 + t;
        const int pos = r < M_CTX ? (r & 255) : ((r - M_CTX) & 4095), len = r < M_CTX ? 256 : 4096;
        const bf16_t* base = PROJ + (size_t)r * NP;
        const bf16x8 h1 = *(const bf16x8*)(base + PC_H + ch), c1 = *(const bf16x8*)(base + PC_C + ch), gb = *(const bf16x8*)(base + PC_B + ch);
        bf16x8 h0 = h1, c0 = c1, h2 = h1, c2 = c1; const bool hasp = pos > 0, hasn = pos < len - 1;
        if (hasp) { h0 = *(const bf16x8*)(base - NP + PC_H + ch); c0 = *(const bf16x8*)(base - NP + PC_C + ch); }
        if (hasn) { h2 = *(const bf16x8*)(base + NP + PC_H + ch); c2 = *(const bf16x8*)(base + NP + PC_C + ch); }
        float o[8];
#pragma unroll
        for (int j = 0; j < 8; ++j) {
            const float z0 = hasp ? bf1((bf16_t)h0[j]) * bf1((bf16_t)c0[j]) : 0.f, z1 = bf1((bf16_t)h1[j]) * bf1((bf16_t)c1[j]), z2 = hasn ? bf1((bf16_t)h2[j]) * bf1((bf16_t)c2[j]) : 0.f;
            const float y = z0 * cw[ch + j] + z1 * cw[256 + ch + j] + z2 * cw[512 + ch + j] + cb[ch + j];
            o[j] = bf1((bf16_t)gb[j]) * y; }
        u32x4 w; w.x = pk2(o[0], o[1]); w.y = pk2(o[2], o[3]); w.z = pk2(o[4], o[5]); w.w = pk2(o[6], o[7]);
        *(u32x4*)(MIX + (size_t)r * D + 256 + ch) = w;
    }
}
__device__ __forceinline__ void unit_fourier_ctx(const Ctx& C, int u) {
    const int s = u >> 2, g = u & 3, l15 = C.lane & 15, hq = C.lane >> 4, w = C.wave;
    const bf16_t* PROJ = (const bf16_t*)(C.ws + WS_R2); bf16_t* MIX = (bf16_t*)(C.ws + WS_R1);
    const bf16_t* F64 = (const bf16_t*)(C.ws + WS_F64); const bf16_t* T256 = (const bf16_t*)(C.ws + WS_T256);
    constexpr int ZS = 520; LAS bf16_t* Zt = (LAS bf16_t*)C.lds;
#pragma unroll
    for (int i = 0; i < 2; ++i) { const int nt = 2 * w + i;
        bf16x8 a[2];
#pragma unroll
        for (int ks = 0; ks < 2; ++ks) a[ks] = *(const bf16x8*)(PROJ + (size_t)(s * 256 + nt * 16 + l15) * NP + PC_F + g * 64 + ks * 32 + 8 * hq);
#pragma unroll
        for (int mt = 0; mt < 8; ++mt) { f32x4 acc = {0.f, 0.f, 0.f, 0.f};
#pragma unroll
            for (int ks = 0; ks < 2; ++ks) { const bf16x8 b = *(const bf16x8*)(F64 + (size_t)(mt * 16 + l15) * 64 + ks * 32 + 8 * hq); acc = mma16(a[ks], b, acc); }
            const int mp = mt * 16 + l15;
            *(LAS u32x2*)(Zt + (mp & 63) * ZS + (mp >> 6) * 256 + nt * 16 + 4 * hq) = pk4(acc); } }
    __syncthreads();
#pragma unroll 1
    for (int i = 0; i < 2; ++i) { const int kt = 2 * w + i;
        f32x4 acc[4];
#pragma unroll
        for (int mt = 0; mt < 4; ++mt) acc[mt] = (f32x4){0.f, 0.f, 0.f, 0.f};
#pragma unroll 8
        for (int ks = 0; ks < 16; ++ks) { const bf16x8 b = *(const bf16x8*)(T256 + (size_t)(kt * 16 + l15) * 512 + ks * 32 + 8 * hq);
#pragma unroll
            for (int mt = 0; mt < 4; ++mt) { const bf16x8 a = *(const LAS bf16x8*)(Zt + (mt * 16 + l15) * ZS + ks * 32 + 8 * hq); acc[mt] = mma16(a, b, acc[mt]); } }
#pragma unroll
        for (int mt = 0; mt < 4; ++mt) *(u32x2*)(MIX + (size_t)(s * 256 + kt * 16 + l15) * D + 512 + g * 64 + mt * 16 + 4 * hq) = pk4(acc[mt] * (1.f / 128.f)); }
    __syncthreads();
}
__device__ __forceinline__ void unit_fourier_lat1(const Ctx& C, int u) {
    const int b = u >> 5, g = (u >> 3) & 3, nb = u & 7, l15 = C.lane & 15, hq = C.lane >> 4, n2 = nb * 8 + C.wave;
    const bf16_t* PROJ = (const bf16_t*)(C.ws + WS_R2);
    const bf16_t* F64 = (const bf16_t*)(C.ws + WS_F64); const bf16_t* T64R = (const bf16_t*)(C.ws + WS_T64R); const bf16_t* T64I = (const bf16_t*)(C.ws + WS_T64I);
    const f32x2* TW = (const f32x2*)(C.ws + WS_TW);
    bf16_t* GB = (bf16_t*)(C.ws + WS_GB) + (size_t)((b * 4 + g) * 64 + n2) * 64 * 128;
    constexpr int ZS = 136; LAS bf16_t* Zt = (LAS bf16_t*)(C.lds + C.wave * (64 * ZS * 2));
#pragma unroll 2
    for (int nt = 0; nt < 4; ++nt) {
        bf16x8 a[2];
#pragma unroll
        for (int ks = 0; ks < 2; ++ks) a[ks] = *(const bf16x8*)(PROJ + (size_t)(M_CTX + b * 4096 + (nt * 16 + l15) * 64 + n2) * NP + PC_F + g * 64 + ks * 32 + 8 * hq);
#pragma unroll
        for (int mt = 0; mt < 8; ++mt) { f32x4 acc = {0.f, 0.f, 0.f, 0.f};
#pragma unroll
            for (int ks = 0; ks < 2; ++ks) { const bf16x8 bb = *(const bf16x8*)(F64 + (size_t)(mt * 16 + l15) * 64 + ks * 32 + 8 * hq); acc = mma16(a[ks], bb, acc); }
            const int mp = mt * 16 + l15;
            *(LAS u32x2*)(Zt + (mp & 63) * ZS + (mp >> 6) * 64 + nt * 16 + 4 * hq) = pk4(acc); } }
    asm volatile("s_waitcnt lgkmcnt(0)" ::: "memory");
#pragma unroll 2
    for (int kt = 0; kt < 4; ++kt) {
        bf16x8 br[4], bi[4];
#pragma unroll
        for (int ks = 0; ks < 4; ++ks) { br[ks] = *(const bf16x8*)(T64R + (size_t)(kt * 16 + l15) * 128 + ks * 32 + 8 * hq); bi[ks] = *(const bf16x8*)(T64I + (size_t)(kt * 16 + l15) * 128 + ks * 32 + 8 * hq); }
        const int k1 = kt * 16 + l15; const f32x2 tw = TW[k1 * n2];
#pragma unroll
        for (int mt = 0; mt < 4; ++mt) { f32x4 ar = {0.f, 0.f, 0.f, 0.f}, ai = {0.f, 0.f, 0.f, 0.f};
#pragma unroll
            for (int ks = 0; ks < 4; ++ks) { const bf16x8 a = *(const LAS bf16x8*)(Zt + (mt * 16 + l15) * ZS + ks * 32 + 8 * hq); ar = mma16(a, br[ks], ar); ai = mma16(a, bi[ks], ai); }
            const f32x4 gr = ar * tw[0] + ai * tw[1], gi = ai * tw[0] - ar * tw[1];
            bf16_t* dst = GB + (size_t)k1 * 128 + mt * 16 + 4 * hq;
            *(u32x2*)dst = pk4(gr); *(u32x2*)(dst + 64) = pk4(gi); } }
    __syncthreads();
}
__device__ __forceinline__ void unit_fourier_lat2(const Ctx& C, int u) {
    const int b = u >> 5, g = (u >> 3) & 3, kb = u & 7, l15 = C.lane & 15, hq = C.lane >> 4, k1 = kb * 8 + C.wave;
    const bf16_t* T64B = (const bf16_t*)(C.ws + WS_T64B); bf16_t* MIX = (bf16_t*)(C.ws + WS_R1);
    const bf16_t* GB = (const bf16_t*)(C.ws + WS_GB) + (size_t)((b * 4 + g) * 64) * 64 * 128 + (size_t)k1 * 128;
    constexpr int ZS = 136; LAS bf16_t* Tt = (LAS bf16_t*)(C.lds + C.wave * (64 * ZS * 2));
#pragma unroll 4
    for (int it = 0; it < 16; ++it) { const int q = it * 64 + C.lane, n2 = q >> 4, cc = q & 15, part = cc >> 3, m0 = (cc & 7) * 8;
        const bf16x8 v = *(const bf16x8*)(GB + (size_t)n2 * 64 * 128 + cc * 8);
#pragma unroll
        for (int j = 0; j < 8; ++j) Tt[(m0 + j) * ZS + part * 64 + n2] = (bf16_t)v[j]; }
    asm volatile("s_waitcnt lgkmcnt(0)" ::: "memory");
#pragma unroll 2
    for (int kt = 0; kt < 4; ++kt) {
        bf16x8 bb[4];
#pragma unroll
        for (int ks = 0; ks < 4; ++ks) bb[ks] = *(const bf16x8*)(T64B + (size_t)(kt * 16 + l15) * 128 + ks * 32 + 8 * hq);
        const int k2 = kt * 16 + l15; const int row = M_CTX + b * 4096 + k1 + 64 * k2;
#pragma unroll
        for (int mt = 0; mt < 4; ++mt) { f32x4 acc = {0.f, 0.f, 0.f, 0.f};
#pragma unroll
            for (int ks = 0; ks < 4; ++ks) { const bf16x8 a = *(const LAS bf16x8*)(Tt + (mt * 16 + l15) * ZS + ks * 32 + 8 * hq); acc = mma16(a, bb[ks], acc); }
            *(u32x2*)(MIX + (size_t)row * D + 512 + g * 64 + mt * 16 + 4 * hq) = pk4(acc * (1.f / 512.f)); } }
    __syncthreads();
}
constexpr float QSCALE = 0.10206207261596577f * 1.4426950408889634f;
__device__ __forceinline__ void unit_mla_prep(const Ctx& C, int layer, int u) {
    const Params& p = C.p;
    const bf16_t* PROJ = (const bf16_t*)(C.ws + WS_R2);
    bf16_t* Q = (bf16_t*)(C.ws + WS_Q); bf16_t* KN = (bf16_t*)(C.ws + WS_KN); bf16_t* VT = (bf16_t*)(C.ws + WS_VT); bf16_t* KR = (bf16_t*)(C.ws + WS_KR);
    const f32x2* ROPE = (const f32x2*)(C.ws + WS_ROPE);
    constexpr int QS = 200, KS = 136;
    LAS bf16_t* CQ = (LAS bf16_t*)C.lds;
    LAS bf16_t* CK = (LAS bf16_t*)(C.lds + 128 * QS * 2);
    const bool is_tok = u < 192;
    int r0 = 0, keyrow0, keypos0, nk; size_t vtbase; bool lat;
    if (is_tok) { r0 = u * 128; lat = r0 >= M_CTX;
        if (!lat) { keyrow0 = r0; keypos0 = r0 & 255; nk = 256; vtbase = (size_t)(r0 & ~255) * 256; }
        else { const int b = (r0 - M_CTX) >> 12, n = (r0 - M_CTX) & 4095; keyrow0 = M_CTX + b * 4352 + n; keypos0 = n; nk = 4352; vtbase = (size_t)(M_CTX + b * 4352) * 256; } }
    else { const int cu = u - 192, b = cu >> 1, half = cu & 1; lat = true; keyrow0 = M_CTX + b * 4352 + 4096 + half * 128; keypos0 = 4096 + half * 128; nk = 4352; vtbase = (size_t)(M_CTX + b * 4352) * 256; }
    { const int t = C.tid >> 2, sub = C.tid & 3;
      if (is_tok) {
        const int r = r0 + t; const bf16_t* base = PROJ + (size_t)r * NP;
        float q[48], k[32]; float sq = 0.f, sk = 0.f;
#pragma unroll
        for (int i = 0; i < 6; ++i) { const bf16x8 v = *(const bf16x8*)(base + PC_Q + sub * 48 + i * 8);
#pragma unroll
            for (int j = 0; j < 8; ++j) { q[i * 8 + j] = bf1((bf16_t)v[j]); sq += q[i * 8 + j] * q[i * 8 + j]; } }
#pragma unroll
        for (int i = 0; i < 4; ++i) { const bf16x8 v = *(const bf16x8*)(base + PC_KV + sub * 32 + i * 8);
#pragma unroll
            for (int j = 0; j < 8; ++j) { k[i * 8 + j] = bf1((bf16_t)v[j]); sk += k[i * 8 + j] * k[i * 8 + j]; } }
        sq += __shfl_xor(sq, 1); sq += __shfl_xor(sq, 2); sk += __shfl_xor(sk, 1); sk += __shfl_xor(sk, 2);
        const float rq = 1.f / sqrtf(sq * (1.f / 192.f) + EPS), rk = 1.f / sqrtf(sk * (1.f / 128.f) + EPS);
        const float* gq = p.in[I_GQ] + layer * 192 + sub * 48; const float* gk = p.in[I_GKV] + layer * 128 + sub * 32;
#pragma unroll
        for (int i = 0; i < 6; ++i) { u32x4 w; w.x = pk2(q[i * 8 + 0] * rq * gq[i * 8 + 0], q[i * 8 + 1] * rq * gq[i * 8 + 1]); w.y = pk2(q[i * 8 + 2] * rq * gq[i * 8 + 2], q[i * 8 + 3] * rq * gq[i * 8 + 3]);
            w.z = pk2(q[i * 8 + 4] * rq * gq[i * 8 + 4], q[i * 8 + 5] * rq * gq[i * 8 + 5]); w.w = pk2(q[i * 8 + 6] * rq * gq[i * 8 + 6], q[i * 8 + 7] * rq * gq[i * 8 + 7]);
            *(LAS u32x4*)(CQ + t * QS + sub * 48 + i * 8) = w; }
        float* sckv = nullptr;
        if (!lat) { const int s = r >> 8, pos = r & 255; sckv = p.out + OUT_CKV + ((size_t)(s * 4 + layer) * 256 + pos) * 128 + sub * 32; }
#pragma unroll
        for (int i = 0; i < 4; ++i) { float o[8];
#pragma unroll
            for (int j = 0; j < 8; ++j) o[j] = k[i * 8 + j] * rk * gk[i * 8 + j];
            u32x4 w; w.x = pk2(o[0], o[1]); w.y = pk2(o[2], o[3]); w.z = pk2(o[4], o[5]); w.w = pk2(o[6], o[7]);
            *(LAS u32x4*)(CK + t * KS + sub * 32 + i * 8) = w;
            if (!lat) { *(f32x4*)(sckv + i * 8) = (f32x4){o[0], o[1], o[2], o[3]}; *(f32x4*)(sckv + i * 8 + 4) = (f32x4){o[4], o[5], o[6], o[7]}; } }
        { const bf16x8 v = *(const bf16x8*)(base + PC_KR + sub * 8); float x[8], o[8];
#pragma unroll
          for (int j = 0; j < 8; ++j) x[j] = bf1((bf16_t)v[j]);
          if (lat) { const int n = (r - M_CTX) & 4095; const int pos = (sub >> 1) == 0 ? (n >> 6) : (n & 63);
#pragma unroll
              for (int j = 0; j < 8; ++j) { const float pr = __shfl_xor(x[j], 1); const f32x2 cs = ROPE[pos * 8 + j]; o[j] = (sub & 1) == 0 ? x[j] * cs[0] - pr * cs[1] : x[j] * cs[0] + pr * cs[1]; } }
          else {
#pragma unroll
              for (int j = 0; j < 8; ++j) o[j] = x[j];
              const int s = r >> 8, pos = r & 255; float* skr = p.out + OUT_KR + ((size_t)(s * 4 + layer) * 256 + pos) * 32 + sub * 8;
              *(f32x4*)skr = (f32x4){o[0], o[1], o[2], o[3]}; *(f32x4*)(skr + 4) = (f32x4){o[4], o[5], o[6], o[7]}; }
          u32x4 w; w.x = pk2(o[0], o[1]); w.y = pk2(o[2], o[3]); w.z = pk2(o[4], o[5]); w.w = pk2(o[6], o[7]);
          *(u32x4*)(KR + (size_t)(keyrow0 + t) * 32 + sub * 8) = w; }
      } else {
        const int cu = u - 192, b = cu >> 1, half = cu & 1, row = half * 128 + t;
        const float* src = p.in[I_CCKV] + ((size_t)(b * 4 + layer) * 256 + row) * 128 + sub * 32;
#pragma unroll
        for (int i = 0; i < 4; ++i) { const f32x4 v0 = *(const f32x4*)(src + i * 8), v1 = *(const f32x4*)(src + i * 8 + 4);
            u32x4 w; w.x = pk2(v0[0], v0[1]); w.y = pk2(v0[2], v0[3]); w.z = pk2(v1[0], v1[1]); w.w = pk2(v1[2], v1[3]);
            *(LAS u32x4*)(CK + t * KS + sub * 32 + i * 8) = w; }
        const float* ksrc = p.in[I_CKR] + ((size_t)(b * 4 + layer) * 256 + row) * 32 + sub * 8;
        const f32x4 v0 = *(const f32x4*)ksrc, v1 = *(const f32x4*)(ksrc + 4);
        u32x4 w; w.x = pk2(v0[0], v0[1]); w.y = pk2(v0[2], v0[3]); w.z = pk2(v1[0], v1[1]); w.w = pk2(v1[2], v1[3]);
        *(u32x4*)(KR + (size_t)(keyrow0 + t) * 32 + sub * 8) = w;
      } }
    __syncthreads();
    const int l15 = C.lane & 15, hq = C.lane >> 4, w = C.wave;
    if (is_tok) {
        const bf16_t* Wq = (const bf16_t*)(C.wl(layer) + WL_UQ);
        bf16x8 aq[3][6];
#pragma unroll
        for (int j = 0; j < 3; ++j)
#pragma unroll
            for (int ks = 0; ks < 6; ++ks) aq[j][ks] = *(const bf16x8*)(Wq + (size_t)((3 * w + j) * 16 + l15) * 192 + ks * 32 + 8 * hq);
#pragma unroll 2
        for (int tt = 0; tt < 8; ++tt) {
            bf16x8 bq[6];
#pragma unroll
            for (int ks = 0; ks < 6; ++ks) bq[ks] = *(const LAS bf16x8*)(CQ + (tt * 16 + l15) * QS + ks * 32 + 8 * hq);
            const int r = r0 + tt * 16 + l15; const int n = (r - M_CTX) & 4095;
#pragma unroll
            for (int j = 0; j < 3; ++j) { const int nt = 3 * w + j; f32x4 acc = {0.f, 0.f, 0.f, 0.f};
#pragma unroll
                for (int ks = 0; ks < 6; ++ks) acc = mma16(aq[j][ks], bq[ks], acc);
                const int sub6 = nt % 6;
                if (lat && sub6 >= 4) { const int pos = sub6 == 4 ? (n >> 6) : (n & 63);
#pragma unroll
                    for (int jj = 0; jj < 4; ++jj) { const float pr = __shfl_xor(acc[jj], 32); const f32x2 cs = ROPE[pos * 8 + ((4 * hq + jj) & 7)]; acc[jj] = hq < 2 ? acc[jj] * cs[0] - pr * cs[1] : acc[jj] * cs[0] + pr * cs[1]; } }
                *(u32x2*)(Q + (size_t)r * 384 + nt * 16 + 4 * hq) = pk4(acc * QSCALE); }
        }
    }
    { const bf16_t* Wkv = (const bf16_t*)(C.wl(layer) + WL_UKV);
      bf16x8 wf[4][4];
#pragma unroll
      for (int j = 0; j < 4; ++j)
#pragma unroll
          for (int ks = 0; ks < 4; ++ks) wf[j][ks] = *(const bf16x8*)(Wkv + (size_t)((4 * w + j) * 16 + l15) * 128 + ks * 32 + 8 * hq);
      const int h = w >> 1; const bool isv = (w & 1) != 0;
#pragma unroll 2
      for (int tt = 0; tt < 8; ++tt) {
          bf16x8 ck[4];
#pragma unroll
          for (int ks = 0; ks < 4; ++ks) ck[ks] = *(const LAS bf16x8*)(CK + (tt * 16 + l15) * KS + ks * 32 + 8 * hq);
#pragma unroll
          for (int j = 0; j < 4; ++j) { f32x4 acc = {0.f, 0.f, 0.f, 0.f};
              if (!isv) {
#pragma unroll
                  for (int ks = 0; ks < 4; ++ks) acc = mma16(wf[j][ks], ck[ks], acc);
                  *(u32x2*)(KN + (size_t)(keyrow0 + tt * 16 + l15) * 256 + h * 64 + j * 16 + 4 * hq) = pk4(acc);
              } else {
#pragma unroll
                  for (int ks = 0; ks < 4; ++ks) acc = mma16(ck[ks], wf[j][ks], acc);
                  *(u32x2*)(VT + vtbase + (size_t)(h * 64 + j * 16 + l15) * nk + keypos0 + tt * 16 + 4 * hq) = pk4(acc);
              } } } }
    __syncthreads();
}

constexpr int AKS = 104, AVS = 72;
constexpr int ABUF = 64 * AKS * 2 + 64 * AVS * 2;
__device__ __forceinline__ int imax3(int a, int b, int c) { return max(a, max(b, c)); }
constexpr int AVS2 = 136; constexpr int ABUF2 = 128 * AKS * 2 + 64 * AVS2 * 2;
__device__ __forceinline__ void unit_attention(const Ctx& C, int u) {
    int rowbase, keyrow0, nk, h; size_t vtbase;
    if (u < 128) { const int s = u >> 2; h = u & 3; rowbase = s * 256; keyrow0 = s * 256; nk = 256; vtbase = (size_t)(s * 256) * 256; }
    else { const int v0 = u - 128; const int v = (C.G == 256) ? (((v0 & 7) * 2 + (v0 >> 7)) << 4) | ((v0 >> 3) & 15) : v0;
           const int b = v >> 6, qb = v & 15; h = (v >> 4) & 3; rowbase = M_CTX + b * 4096 + qb * 256; keyrow0 = M_CTX + b * 4352; nk = 4352; vtbase = (size_t)keyrow0 * 256; }
    const bf16_t* Q = (const bf16_t*)(C.ws + WS_Q); const bf16_t* KN = (const bf16_t*)(C.ws + WS_KN); const bf16_t* VT = (const bf16_t*)(C.ws + WS_VT); const bf16_t* KR = (const bf16_t*)(C.ws + WS_KR);
    bf16_t* MIX = (bf16_t*)(C.ws + WS_R1);
    const int l31 = C.lane & 31, hh = C.lane >> 5; const int qrow = rowbase + C.wave * 32 + l31;
    bf16x8 qf[6];
#pragma unroll
    for (int ks = 0; ks < 6; ++ks) qf[ks] = *(const bf16x8*)(Q + (size_t)qrow * 384 + h * 96 + ks * 16 + 8 * hh);
    f32x16 o0, o1, o2, negm;
#pragma unroll
    for (int i = 0; i < 16; ++i) { o0[i] = 0.f; o1[i] = 0.f; o2[i] = 0.f; negm[i] = 0.f; }
    const unsigned onew = (l31 == 0) ? 0x3F803F80u : 0u;
    const bf16x8 onesf = __builtin_bit_cast(bf16x8, (u32x4){onew, onew, onew, onew});
    const int skey = C.tid >> 3, sc8 = (C.tid & 7) * 8, rkey = (C.tid & 255) >> 2, rc8 = (C.tid & 3) * 8;
    const bf16_t* gkn = KN + (size_t)(keyrow0 + skey) * 256 + h * 64 + sc8;
    const bf16_t* gkr = KR + (size_t)(keyrow0 + rkey) * 32 + rc8;
    const bf16_t* gvt = VT + vtbase + (size_t)(h * 64 + skey) * nk + sc8;
    const bool do_r = C.tid < 256;
    const int lkn = (skey * AKS + sc8) * 2, lkr = (rkey * AKS + 64 + rc8) * 2, lvt = 128 * AKS * 2 + (skey * AVS2 + sc8) * 2;
    const int ntile = nk >> 7;
    u32x4 rk[2], rr[2] = {{0u, 0u, 0u, 0u}, {0u, 0u, 0u, 0u}}, rv[2];
#define ATT_LD(t) do { _Pragma("unroll") for (int s_ = 0; s_ < 2; ++s_) { rk[s_] = *(const u32x4*)(gkn + (size_t)(2 * (t) + s_) * 64 * 256); if (do_r) rr[s_] = *(const u32x4*)(gkr + (size_t)(2 * (t) + s_) * 64 * 32); rv[s_] = *(const u32x4*)(gvt + (2 * (t) + s_) * 64); } } while (0)
#define ATT_ST(buf) do { LAS unsigned char* b_ = C.lds + (buf) * ABUF2; _Pragma("unroll") for (int s_ = 0; s_ < 2; ++s_) { *(LAS u32x4*)(b_ + lkn + s_ * 64 * AKS * 2) = rk[s_]; if (do_r) *(LAS u32x4*)(b_ + lkr + s_ * 64 * AKS * 2) = rr[s_]; *(LAS u32x4*)(b_ + lvt + s_ * 128) = rv[s_]; } } while (0)
    ATT_LD(0); ATT_ST(0);
    __syncthreads();
#pragma unroll 1
    for (int kt = 0; kt < ntile; ++kt) {
        const bool more = kt + 1 < ntile;
        if (more) ATT_LD(kt + 1);
        LAS unsigned char* B = C.lds + (kt & 1) * ABUF2;
#pragma unroll 1
        for (int sub = 0; sub < 2; ++sub) {
        const LAS bf16_t* Kl = (const LAS bf16_t*)B + sub * 64 * AKS; const LAS bf16_t* Vl = (const LAS bf16_t*)(B + 128 * AKS * 2) + sub * 64;
        bf16x8 ka[2][6];
#pragma unroll
        for (int ks = 0; ks < 6; ++ks) { ka[0][ks] = *(const LAS bf16x8*)(Kl + l31 * AKS + ks * 16 + 8 * hh); ka[1][ks] = *(const LAS bf16x8*)(Kl + (32 + l31) * AKS + ks * 16 + 8 * hh); }
        __builtin_amdgcn_sched_barrier(0);
        f32x16 s0 = mma32(ka[0][0], qf[0], negm), s1 = mma32(ka[1][0], qf[0], negm);
#pragma unroll
        for (int ks = 1; ks < 6; ++ks) { s0 = mma32(ka[0][ks], qf[ks], s0); s1 = mma32(ka[1][ks], qf[ks], s1); }
        __builtin_amdgcn_sched_barrier(0);
        u32x2 vr[2][2][4];
#pragma unroll
        for (int t = 0; t < 2; ++t)
#pragma unroll
            for (int ss = 0; ss < 2; ++ss) { const int ko = 32 * t + 16 * ss + 4 * hh;
                vr[t][ss][0] = *(const LAS u32x2*)(Vl + l31 * AVS2 + ko); vr[t][ss][1] = *(const LAS u32x2*)(Vl + l31 * AVS2 + ko + 8);
                vr[t][ss][2] = *(const LAS u32x2*)(Vl + (32 + l31) * AVS2 + ko); vr[t][ss][3] = *(const LAS u32x2*)(Vl + (32 + l31) * AVS2 + ko + 8); }
        __builtin_amdgcn_sched_barrier(0);
        float d; bool resc;
        if (kt == 0 && sub == 0) {
            float mx = fmaxf(s0[0], s1[0]);
#pragma unroll
            for (int i = 1; i < 16; ++i) mx = fmaxf(mx, fmaxf(s0[i], s1[i]));
            d = fmaxf(mx, __shfl_xor(mx, 32)); resc = true;
        } else {
            int im = imax3(__builtin_bit_cast(int, s0[0]), __builtin_bit_cast(int, s1[0]), __builtin_bit_cast(int, s0[1]));
            im = imax3(im, __builtin_bit_cast(int, s1[1]), __builtin_bit_cast(int, s0[2])); im = imax3(im, __builtin_bit_cast(int, s1[2]), __builtin_bit_cast(int, s0[3]));
            im = imax3(im, __builtin_bit_cast(int, s1[3]), __builtin_bit_cast(int, s0[4])); im = imax3(im, __builtin_bit_cast(int, s1[4]), __builtin_bit_cast(int, s0[5]));
            im = imax3(im, __builtin_bit_cast(int, s1[5]), __builtin_bit_cast(int, s0[6])); im = imax3(im, __builtin_bit_cast(int, s1[6]), __builtin_bit_cast(int, s0[7]));
            im = imax3(im, __builtin_bit_cast(int, s1[7]), __builtin_bit_cast(int, s0[8])); im = imax3(im, __builtin_bit_cast(int, s1[8]), __builtin_bit_cast(int, s0[9]));
            im = imax3(im, __builtin_bit_cast(int, s1[9]), __builtin_bit_cast(int, s0[10])); im = imax3(im, __builtin_bit_cast(int, s1[10]), __builtin_bit_cast(int, s0[11]));
            im = imax3(im, __builtin_bit_cast(int, s1[11]), __builtin_bit_cast(int, s0[12])); im = imax3(im, __builtin_bit_cast(int, s1[12]), __builtin_bit_cast(int, s0[13]));
            im = imax3(im, __builtin_bit_cast(int, s1[13]), __builtin_bit_cast(int, s0[14])); im = imax3(im, __builtin_bit_cast(int, s1[14]), __builtin_bit_cast(int, s0[15]));
            im = max(im, __builtin_bit_cast(int, s1[15]));
            im = max(im, __shfl_xor(im, 32));
            resc = __builtin_amdgcn_ballot_w64(im > 0x41000000) != 0ull; d = im > 0x41000000 ? __builtin_bit_cast(float, im) : 0.f;
        }
        if (resc) {
            if (kt != 0 || sub != 0) { const float alpha = __builtin_amdgcn_exp2f(-d); o0 = o0 * alpha; o1 = o1 * alpha; o2 = o2 * alpha; }
            negm = negm - d; s0 = s0 - d; s1 = s1 - d;
        }
#pragma unroll
        for (int i = 0; i < 16; ++i) { s0[i] = __builtin_amdgcn_exp2f(s0[i]); s1[i] = __builtin_amdgcn_exp2f(s1[i]); }
#pragma unroll
        for (int t = 0; t < 2; ++t)
#pragma unroll
            for (int ss = 0; ss < 2; ++ss) {
                u32x4 w;
                if (t == 0) { w.x = pk2(s0[8 * ss + 0], s0[8 * ss + 1]); w.y = pk2(s0[8 * ss + 2], s0[8 * ss + 3]); w.z = pk2(s0[8 * ss + 4], s0[8 * ss + 5]); w.w = pk2(s0[8 * ss + 6], s0[8 * ss + 7]); }
                else { w.x = pk2(s1[8 * ss + 0], s1[8 * ss + 1]); w.y = pk2(s1[8 * ss + 2], s1[8 * ss + 3]); w.z = pk2(s1[8 * ss + 4], s1[8 * ss + 5]); w.w = pk2(s1[8 * ss + 6], s1[8 * ss + 7]); }
                const bf16x8 pf = __builtin_bit_cast(bf16x8, w);
                const bf16x8 va = __builtin_bit_cast(bf16x8, (u32x4){vr[t][ss][0].x, vr[t][ss][0].y, vr[t][ss][1].x, vr[t][ss][1].y}), vb = __builtin_bit_cast(bf16x8, (u32x4){vr[t][ss][2].x, vr[t][ss][2].y, vr[t][ss][3].x, vr[t][ss][3].y});
                o0 = mma32(va, pf, o0); o1 = mma32(vb, pf, o1); o2 = mma32(onesf, pf, o2);
            }
        }
        if (more) ATT_ST((kt + 1) & 1);
        __syncthreads();
    }
#undef ATT_LD
#undef ATT_ST
    const float lsum = o2[0] + __shfl_xor(o2[0], 32);
    const float inv = 1.f / lsum;
    bf16_t* orow = MIX + (size_t)qrow * D + 768 + h * 64;
#pragma unroll
    for (int i = 0; i < 4; ++i) { const int dv = 8 * i + 4 * hh;
        *(u32x2*)(orow + dv) = pk4((f32x4){o0[4 * i] * inv, o0[4 * i + 1] * inv, o0[4 * i + 2] * inv, o0[4 * i + 3] * inv});
        *(u32x2*)(orow + 32 + dv) = pk4((f32x4){o1[4 * i] * inv, o1[4 * i + 1] * inv, o1[4 * i + 2] * inv, o1[4 * i + 3] * inv}); }
}

#define XB_TMO      128
#define XB_XCNT(j)  (256  + 64 * (j))
#define XB_XSUB(j)  (1280 + 64 * (j))
#define XB_XGEN(j)  (2304 + 64 * (j))
#define XB_TOP      3328
#define XB_TOPGEN   3392
#define XCD_BAR_WORDS 3456
#define XB_SPIN_CAP (1u << 18)

__device__ __forceinline__ unsigned xb_ld(unsigned* p)              { return __hip_atomic_load(p, __ATOMIC_RELAXED, __HIP_MEMORY_SCOPE_AGENT); }
__device__ __forceinline__ unsigned xb_add(unsigned* p, unsigned v) { return __hip_atomic_fetch_add(p, v, __ATOMIC_RELAXED, __HIP_MEMORY_SCOPE_AGENT); }
__device__ __forceinline__ unsigned xb_xcc_id() { return (unsigned)__builtin_amdgcn_s_getreg((3 << 11) | 20) & 0xFu; }
#define XB_SPIN(cond, bar) do { unsigned _sp = 0; while (cond) { __builtin_amdgcn_s_sleep(1); \
    if ((++_sp & 255u) == 0u) { if (xb_ld(&(bar)[XB_TMO])) break; if (_sp > XB_SPIN_CAP) { atomicAdd(&(bar)[XB_TMO], 1u); break; } } } } while (0)

struct XcdBarrier {
    unsigned* bar; unsigned x;
    volatile LAS unsigned* st;
};

__device__ __forceinline__ XcdBarrier xcd_barrier_post(unsigned* bar, volatile LAS unsigned* st) {
    XcdBarrier b; b.bar = bar; b.x = xb_xcc_id(); b.st = st;
    if (threadIdx.x == 0) (void)xb_add(&bar[XB_XCNT(b.x)], 1u);
    return b;
}
__device__ __forceinline__ void xcd_barrier_complete(unsigned* bar, unsigned x, unsigned& nloc, unsigned& nx) {
    const unsigned G = gridDim.x * gridDim.y * gridDim.z;
    unsigned sum, cnt, mine, sp = 0u;
    for (;;) {
        sum = 0u; cnt = 0u; mine = 0u;
#pragma unroll
        for (unsigned j = 0; j < 16; ++j) { const unsigned c = xb_ld(&bar[XB_XCNT(j)]); sum += c; cnt += (c > 0u) ? 1u : 0u; mine = (j == x) ? c : mine; }
        if (sum == G) break;
        __builtin_amdgcn_s_sleep(1);
        if ((++sp & 255u) == 0u) { if (xb_ld(&bar[XB_TMO])) break; if (sp > XB_SPIN_CAP) { atomicAdd(&bar[XB_TMO], 1u); break; } }
    }
    nloc = mine > 0u ? mine : 1u; nx = cnt > 0u ? cnt : 1u;
}

__device__ __forceinline__ void xcd_barrier(const XcdBarrier& b) {
    asm volatile("s_waitcnt vmcnt(0)" ::: "memory");
    __syncthreads();
    if (threadIdx.x == 0) {
        unsigned* bar = b.bar;
        __builtin_amdgcn_s_waitcnt(0);
        unsigned nloc = b.st[0], nx = b.st[1];
        if (nloc == 0u) { xcd_barrier_complete(bar, b.x, nloc, nx); b.st[0] = nloc; b.st[1] = nx; }
        const unsigned old = xb_add(&bar[XB_XSUB(b.x)], 1u);
        const unsigned gen = old / nloc;
        if (old + 1u == (gen + 1u) * nloc) {
            __builtin_amdgcn_fence(__ATOMIC_RELEASE, "agent");
            asm volatile("s_waitcnt vmcnt(0)" ::: "memory");
            const unsigned og = xb_add(&bar[XB_TOP], 1u);
            const unsigned tg = og / nx;
            if (og + 1u == (tg + 1u) * nx) xb_add(&bar[XB_TOPGEN], 1u);
            else XB_SPIN(xb_ld(&bar[XB_TOPGEN]) == tg, bar);
            __builtin_amdgcn_fence(__ATOMIC_ACQUIRE, "agent");
            xb_add(&bar[XB_XGEN(b.x)], 1u);
            asm volatile("s_waitcnt vmcnt(0)" ::: "memory");
        } else {
            XB_SPIN(xb_ld(&bar[XB_XGEN(b.x)]) == gen, bar);
            __builtin_amdgcn_fence(__ATOMIC_ACQUIRE, "agent");
            asm volatile("s_waitcnt vmcnt(0)" ::: "memory");
        }
    }
    __syncthreads();
}

__global__ void __launch_bounds__(NTHREADS, 2) mk_fwd(Params p) {
    extern __shared__ __attribute__((aligned(16))) unsigned char lds_raw[];
    cg::grid_group grid = cg::this_grid();
    Ctx C; C.p = p; C.lds = (LAS unsigned char*)lds_raw; C.tid = threadIdx.x; C.lane = C.tid & 63; C.wave = __builtin_amdgcn_readfirstlane(C.tid >> 6); C.bid = blockIdx.x; C.G = gridDim.x; C.ws = p.ws;

    volatile LAS unsigned* bst = (volatile LAS unsigned*)(C.lds + LDS_BYTES - 64);
    if (threadIdx.x < 2) bst[threadIdx.x] = 0u;
    __syncthreads();
    const XcdBarrier bar = xcd_barrier_post((unsigned*)(p.ws + WS_BAR), bst);
    C.refresh(); phase_prologue(C);
    if (p.ws == nullptr) grid.sync();
    xcd_barrier(bar);
    C.refresh(); phase_norm0(C);
    xcd_barrier(bar);
#pragma unroll 1
    for (int layer = 0; layer < DEPTH; ++layer) {
        { C.refresh(); bf16_t* R1 = (bf16_t*)(C.ws + WS_R1); bf16_t* R2 = (bf16_t*)(C.ws + WS_R2); unsigned char* wl = C.wl(layer); pg8::Gemm g{R1, (const bf16_t*)(wl + WL_IN), M, NPP, D}; pg8::StaticOrder S; S.init(M, NPP, C.G, C.bid); pg8::EpiStore E{R2, NP, NP};
          pg8::gemm_phase<pg8::EpiStore, pg8::StaticOrder, true, true>(C.lds, g, S, E); }
        xcd_barrier(bar);
        C.refresh();
        for (int u = C.bid; u < 768 + 192 + 128 + 128 + 200; u += C.G) {
            C.refresh();
            if (u < 768) unit_chunk_mlp(C, layer, u);
            else if (u < 960) unit_conv(C, layer, u - 768);
            else if (u < 1088) unit_fourier_ctx(C, u - 960);
            else if (u < 1216) unit_fourier_lat1(C, u - 1088);
            else unit_mla_prep(C, layer, u - 1216);
        }
        xcd_barrier(bar);
        C.refresh();
        for (int u = C.bid; u < 512; u += C.G) {
            C.refresh();
            if (u < 256) unit_attention(C, 128 + u);
            else if (u < 384) unit_attention(C, u - 256);
            else unit_fourier_lat2(C, u - 384);
        }
        xcd_barrier(bar);
        { C.refresh(); bf16_t* R1 = (bf16_t*)(C.ws + WS_R1); bf16_t* R2 = (bf16_t*)(C.ws + WS_R2); unsigned char* wl = C.wl(layer); pg8::Gemm g{R1, (const bf16_t*)(wl + WL_OUT), M, D, D}; pg8::SplitTailOrder S; S.init(D, C.G, C.bid); pg8::EpiStoreSplit E{R2, R2 + (size_t)M * D - (size_t)SPLIT_ROW0 * D, D};
          pg8::gemm_phase<pg8::EpiStoreSplit, pg8::SplitTailOrder, true, true>(C.lds, g, S, E); }
        xcd_barrier(bar);
        C.refresh(); phase_post<0>(C, layer);
        xcd_barrier(bar);
        { C.refresh(); bf16_t* R1 = (bf16_t*)(C.ws + WS_R1); bf16_t* R2 = (bf16_t*)(C.ws + WS_R2); unsigned char* wl = C.wl(layer); pg8::Gemm g{R1, (const bf16_t*)(wl + WL_GU), M, 2 * FF, D}; pg8::StaticOrder S; S.init(M, 2 * FF, C.G, C.bid); pg8::EpiSwiGLU E{R2, FF};
          pg8::gemm_phase<pg8::EpiSwiGLU, pg8::StaticOrder, true, true>(C.lds, g, S, E);
          if (C.G == 256 && layer + 1 < DEPTH && C.bid >= 64) { C.refresh(); transpose_items(C, (layer + 1) * TI_L + (C.bid - 64), 192, (layer + 2) * TI_L); } }
        xcd_barrier(bar);
        { C.refresh(); bf16_t* R2 = (bf16_t*)(C.ws + WS_R2); bf16_t* R3 = (bf16_t*)(C.ws + WS_MLA); unsigned char* wl = C.wl(layer); pg8::Gemm g{R2, (const bf16_t*)(wl + WL_DN), M, D, FF}; pg8::SplitTailOrder S; S.init(FF, C.G, C.bid); pg8::EpiStoreSplit E{R3, R3 + (size_t)M * D - (size_t)SPLIT_ROW0 * D, D};
          pg8::gemm_phase<pg8::EpiStoreSplit, pg8::SplitTailOrder, true, true>(C.lds, g, S, E); }
        xcd_barrier(bar);
        C.refresh(); phase_post<1>(C, layer);
        if (layer + 1 < DEPTH) xcd_barrier(bar);
    }
}

extern "C" void kernel_launch(void* const* d_in, const int* in_sizes, int n_in, void* d_out, int out_size, void* d_ws, size_t ws_size, hipStream_t stream) {
    static int grid = 0;
    if (grid == 0) {
        if (n_in != 24 || ws_size < WS_END) { fprintf(stderr, "kernel_launch: need 24 inputs and %zu bytes of workspace; got %d, %zu\n", (size_t)WS_END, n_in, ws_size); grid = -1; return; }
        int dev = 0, cus = 0, per_cu = 0;
        if (hipGetDevice(&dev) != hipSuccess || hipDeviceGetAttribute(&cus, hipDeviceAttributeMultiprocessorCount, dev) != hipSuccess) { grid = -1; return; }
        if (hipFuncSetAttribute((const void*)mk_fwd, hipFuncAttributeMaxDynamicSharedMemorySize, LDS_BYTES) != hipSuccess) { fprintf(stderr, "kernel_launch: hipFuncSetAttribute failed\n"); grid = -1; return; }
        if (hipOccupancyMaxActiveBlocksPerMultiprocessor(&per_cu, (const void*)mk_fwd, NTHREADS, LDS_BYTES) != hipSuccess || per_cu < 1) fprintf(stderr, "kernel_launch: occupancy query says %d blocks per CU\n", per_cu);
        (void)hipGetLastError();
        grid = cus;
    }
    if (grid < 0) return;
    Params p{};
    for (int i = 0; i < 24; ++i) p.in[i] = (const float*)d_in[i];
    p.out = (float*)d_out; p.ws = (unsigned char*)d_ws;
    if (hipMemsetAsync((char*)d_ws + WS_BAR, 0, WS_BAR_BYTES, stream) != hipSuccess) { fprintf(stderr, "kernel_launch: memset failed\n"); return; }
    void* args[] = {&p};
    hipError_t e = hipLaunchCooperativeKernel((const void*)mk_fwd, dim3(grid), dim3(NTHREADS), args, LDS_BYTES, stream);
    if (e != hipSuccess) fprintf(stderr, "kernel_launch: cooperative launch failed: %s (grid %d)\n", hipGetErrorString(e), grid);
}
```

```cpp
#include <hip/hip_runtime.h>
#include <hip/hip_cooperative_groups.h>
#include <cstdio>
#include <cstdint>
namespace cg = cooperative_groups;
namespace pg8 {
#define PG8_LAS __attribute__((address_space(3)))
typedef unsigned short bf16_t;
typedef short bf16x8 __attribute__((ext_vector_type(8)));
typedef float f32x4 __attribute__((ext_vector_type(4)));
typedef unsigned u32x4 __attribute__((ext_vector_type(4)));
constexpr int BM = 256, BK = 64, HALF = 128, HTB = HALF * BK * 2  , STAGE_BYTES = 8 * HTB, NXCD = 8, WGM = 8;

__host__ __device__ __forceinline__ int lds_byte(int r, int c) { const int st = (r >> 4) * 2 + (c >> 5), rr = r & 15, cc = c & 31, ob = rr * 64 + cc * 2; return st * 1024 + (ob ^ (((ob >> 9) & 1) << 5)); }
__host__ __device__ __forceinline__ void stage_rc(int b, int& R, int& C) { const int st = b / 1024, sb = b % 1024, swz = sb ^ (((sb >> 9) & 1) << 5); R = (st >> 1) * 16 + swz / 64; C = (st & 1) * 32 + (swz % 64) / 2; }
__host__ __device__ __forceinline__ int perm32(int rho) { const int n = rho >> 4, i = rho & 15; return 8 * (i >> 2) + 4 * n + (i & 3); }

struct Unit { int pm, pn; int kh, nt, koff; };
struct Gemm { const bf16_t* A; const bf16_t* Bt; int M, N, K; };

struct StaticOrder {
    int nM, nN, nwg, G, c;
    __host__ __device__ void init(int M, int N, int G_, int c_) { nM = M / BM; nN = N / BM; nwg = nM * nN; G = G_; c = c_; }
    __host__ __device__ bool next(int i, Unit& u) const {
        const long L = (long)i * G + c; if (L >= nwg) return false;
        int wgid = (int)L; { const int q = nwg / NXCD, r = nwg % NXCD, xcd = wgid % NXCD, off = wgid / NXCD; wgid = (xcd < r ? xcd * (q + 1) : r * (q + 1) + (xcd - r) * q) + off; }
        const int nig = WGM * nN, gid = wgid / nig, fm = gid * WGM, gsz = (nM - fm) < WGM ? (nM - fm) : WGM;
        u.pm = fm + ((wgid % nig) % gsz); u.pn = (wgid % nig) / gsz; u.kh = 0; u.nt = 0; u.koff = 0; return true;
    }
    __device__ __forceinline__ void a_ready(const Unit&) const {}
    __device__ __forceinline__ void done(const Unit&) const {}
};

__device__ __forceinline__ unsigned cvt_pk_bf16(float lo, float hi) { unsigned r; asm volatile("v_cvt_pk_bf16_f32 %0, %1, %2" : "=v"(r) : "v"(lo), "v"(hi)); return r; }
typedef float f32x2 __attribute__((ext_vector_type(2)));
struct EpiStore {
    static constexpr bool PERM = true, AFTER_DRAIN = false;
    bf16_t* O; int ldc; int ncols;
    __device__ __forceinline__ void operator()(const f32x4 (&acc)[2][2][4][2], const Unit& u, int wr, int wc, int fr, int fq) const {
        const int row0 = u.pm * BM + wr * 64 + fr; const int col0 = u.pn * BM + wc * 32 + 8 * fq;
#pragma unroll
        for (int ai = 0; ai < 2; ++ai)
#pragma unroll
            for (int m = 0; m < 4; ++m) { bf16_t* rowp = O + (size_t)(row0 + ai * HALF + m * 16) * ldc + col0;
#pragma unroll
                for (int bj = 0; bj < 2; ++bj) { const f32x4 v0 = acc[ai][bj][m][0], v1 = acc[ai][bj][m][1];
                    u32x4 w; w.x = cvt_pk_bf16(v0[0], v0[1]); w.y = cvt_pk_bf16(v0[2], v0[3]); w.z = cvt_pk_bf16(v1[0], v1[1]); w.w = cvt_pk_bf16(v1[2], v1[3]);
                    if (col0 + bj * HALF < ncols) *(u32x4*)(rowp + bj * HALF) = w; } }
    }
};
struct EpiStoreWT {
    static constexpr bool PERM = true, AFTER_DRAIN = false;
    bf16_t* O; int ldc; int ncols;
    __device__ __forceinline__ void operator()(const f32x4 (&acc)[2][2][4][2], const Unit& u, int wr, int wc, int fr, int fq) const {
        const int row0 = u.pm * BM + wr * 64 + fr; const int col0 = u.pn * BM + wc * 32 + 8 * fq;
#pragma unroll
        for (int ai = 0; ai < 2; ++ai)
#pragma unroll
            for (int m = 0; m < 4; ++m) { bf16_t* rowp = O + (size_t)(row0 + ai * HALF + m * 16) * ldc + col0;
#pragma unroll
                for (int bj = 0; bj < 2; ++bj) { const f32x4 v0 = acc[ai][bj][m][0], v1 = acc[ai][bj][m][1];
                    const unsigned long long lo = (unsigned long long)cvt_pk_bf16(v0[0], v0[1]) | ((unsigned long long)cvt_pk_bf16(v0[2], v0[3]) << 32);
                    const unsigned long long hi = (unsigned long long)cvt_pk_bf16(v1[0], v1[1]) | ((unsigned long long)cvt_pk_bf16(v1[2], v1[3]) << 32);
                    unsigned long long* q = (unsigned long long*)(rowp + bj * HALF);
                    __hip_atomic_store(q, lo, __ATOMIC_RELAXED, __HIP_MEMORY_SCOPE_AGENT); __hip_atomic_store(q + 1, hi, __ATOMIC_RELAXED, __HIP_MEMORY_SCOPE_AGENT); } }
    }
};
__device__ __forceinline__ float silu_mul(float g, float u) { return g * u * __builtin_amdgcn_rcpf(1.f + __expf(-g)); }
struct EpiSwiGLU {
    static constexpr bool PERM = true, AFTER_DRAIN = false;
    bf16_t* O; int ldc;
    __device__ __forceinline__ void operator()(const f32x4 (&acc)[2][2][4][2], const Unit& u, int wr, int wc, int fr, int fq) const {
        const int row0 = u.pm * BM + wr * 64 + fr; const int col0 = u.pn * HALF + wc * 32 + 8 * fq;
#pragma unroll
        for (int ai = 0; ai < 2; ++ai)
#pragma unroll
            for (int m = 0; m < 4; ++m) { bf16_t* rowp = O + (size_t)(row0 + ai * HALF + m * 16) * ldc + col0;
                const f32x4 g0 = acc[ai][0][m][0], g1 = acc[ai][0][m][1], u0 = acc[ai][1][m][0], u1 = acc[ai][1][m][1];
                u32x4 w; w.x = cvt_pk_bf16(silu_mul(g0[0], u0[0]), silu_mul(g0[1], u0[1])); w.y = cvt_pk_bf16(silu_mul(g0[2], u0[2]), silu_mul(g0[3], u0[3]));
                w.z = cvt_pk_bf16(silu_mul(g1[0], u1[0]), silu_mul(g1[1], u1[1])); w.w = cvt_pk_bf16(silu_mul(g1[2], u1[2]), silu_mul(g1[3], u1[3]));
                *(u32x4*)rowp = w; }
    }
};

struct PanelOrder {
    int nN, nwg, G, c; unsigned* cnt;
    __device__ void init(int M, int N, int G_, int c_, unsigned* cnt_) { nN = N / BM; nwg = (M / BM) * nN; G = G_; c = c_; cnt = cnt_; }
    __device__ bool next(int i, Unit& u) const { const long L = (long)i * G + c; if (L >= nwg) return false; u.pm = (int)L / nN; u.pn = (int)L % nN; u.kh = 0; u.nt = 0; u.koff = 0; return true; }
    __device__ __forceinline__ void a_ready(const Unit&) const {}
    __device__ __forceinline__ void done(const Unit& u) const {
        asm volatile("s_waitcnt vmcnt(0)" ::: "memory");
        if ((threadIdx.x & 63) == 0) __hip_atomic_fetch_add(cnt + u.pm, 1u, __ATOMIC_RELAXED, __HIP_MEMORY_SCOPE_AGENT);
    }
};

struct SplitTailOrder {
    int G, c, ntf; bool split;
    __device__ void init(int K, int G_, int c_) { G = G_; c = c_; ntf = K / BK; split = (G_ == 256); }
    __device__ bool next(int i, Unit& u) const {
        if (!split) { const long L = (long)i * G + c; if (L >= 384) return false; u.pm = (int)L >> 2; u.pn = (int)L & 3; u.kh = 0; u.nt = 0; u.koff = 0; return true; }
        if (i == 0) { const int t = (c & 7) * 32 + (c >> 3); u.pm = t >> 2; u.pn = t & 3; u.kh = 0; u.nt = 0; u.koff = 0; return true; }
        if (i == 1) { const int t = 256 + (c & 7) * 16 + (c >> 4); u.pm = t >> 2; u.pn = t & 3; u.kh = (c >> 3) & 1; u.nt = ntf / 2; u.koff = u.kh * (ntf / 2) * BK * 2; return true; }
        return false;
    }
    __device__ __forceinline__ void a_ready(const Unit&) const {}
    __device__ __forceinline__ void done(const Unit&) const {}
};
struct EpiStoreSplit {
    static constexpr bool PERM = true, AFTER_DRAIN = false;
    bf16_t* O; bf16_t* O1; int ldc;
    __device__ __forceinline__ void operator()(const f32x4 (&acc)[2][2][4][2], const Unit& u, int wr, int wc, int fr, int fq) const {
        const int row0 = u.pm * BM + wr * 64 + fr; const int col0 = u.pn * BM + wc * 32 + 8 * fq; bf16_t* base = u.kh ? O1 : O;
#pragma unroll
        for (int ai = 0; ai < 2; ++ai)
#pragma unroll
            for (int m = 0; m < 4; ++m) { bf16_t* rowp = base + (size_t)(row0 + ai * HALF + m * 16) * ldc + col0;
#pragma unroll
                for (int bj = 0; bj < 2; ++bj) { const f32x4 v0 = acc[ai][bj][m][0], v1 = acc[ai][bj][m][1];
                    u32x4 w; w.x = cvt_pk_bf16(v0[0], v0[1]); w.y = cvt_pk_bf16(v0[2], v0[3]); w.z = cvt_pk_bf16(v1[0], v1[1]); w.w = cvt_pk_bf16(v1[2], v1[3]);
                    *(u32x4*)(rowp + bj * HALF) = w; } }
    }
};
template <class Epi, class Sched, bool ALIGN_EPI = false, bool SP2 = false>
__device__ __forceinline__ void gemm_phase(PG8_LAS unsigned char* lds, const Gemm g, const Sched& S, const Epi& E) {
    int tid_ = threadIdx.x; asm volatile("" : "+v"(tid_));
    const int tid = tid_, wid = __builtin_amdgcn_readfirstlane(tid >> 6), lane = tid & 63, wr = wid >> 2, wc = wid & 3, fr = lane & 15, fq = lane >> 4;
    const int K = g.K, nt = K / BK;
    unsigned voffA[2], voffB[2];
#pragma unroll
    for (int i = 0; i < 2; ++i) { int R, C; stage_rc(tid * 16 + i * 8192, R, C); const int Rb = Epi::PERM ? ((R & ~31) + perm32(R & 31)) : R;
        voffA[i] = (unsigned)(R * K + C) * 2u; voffB[i] = (unsigned)(Rb * K + C) * 2u; }
    const size_t kstep = (size_t)(BK * 2);
    const size_t hstep = (size_t)HALF * K * 2;
    const size_t tstep = 2 * hstep;
    const unsigned ldsw = (unsigned)wid * 1024u;
    const int aoff = lds_byte(wr * 64 + fr, fq * 8), boff = lds_byte(wc * 32 + fr, fq * 8);
#define PG8_SA(b, h) (((b) * 2 + (h)) * HTB)
#define PG8_SB(b, h) ((4 + (b) * 2 + (h)) * HTB)
#define PG8_STAGE(bufoff, gbase, voff) do { _Pragma("unroll") for (int _i = 0; _i < 2; ++_i) \
        __builtin_amdgcn_global_load_lds((const unsigned*)((const char*)(gbase) + (voff)[_i]), (PG8_LAS unsigned*)(lds + (bufoff) + ldsw + _i * 8192), 16, 0, 0); } while (0)
#define PG8_LDA(dst, b, h) do { _Pragma("unroll") for (int m = 0; m < 4; ++m) _Pragma("unroll") for (int k = 0; k < 2; ++k) dst[m][k] = *(const PG8_LAS bf16x8*)(lds + PG8_SA(b, h) + aoff + m * 2048 + k * 1024); } while (0)
#define PG8_LDB(dst, b, h) do { _Pragma("unroll") for (int n = 0; n < 2; ++n) _Pragma("unroll") for (int k = 0; k < 2; ++k) dst[n][k] = *(const PG8_LAS bf16x8*)(lds + PG8_SB(b, h) + boff + n * 2048 + k * 1024); } while (0)
#define PG8_MMA(ai, bj, At, Bt) do { __builtin_amdgcn_s_setprio(1); _Pragma("unroll") for (int m = 0; m < 4; ++m) _Pragma("unroll") for (int n = 0; n < 2; ++n) _Pragma("unroll") for (int k = 0; k < 2; ++k) \
        acc[ai][bj][m][n] = __builtin_amdgcn_mfma_f32_16x16x32_bf16(Bt[n][k], At[m][k], acc[ai][bj][m][n], 0, 0, 0); __builtin_amdgcn_s_setprio(0); } while (0)
#define PG8_WAIT_V(n) asm volatile("s_waitcnt vmcnt(" #n ")" ::: "memory")
#define PG8_WAIT_L(n) asm volatile("s_waitcnt lgkmcnt(" #n ")" ::: "memory")
#define PG8_BAR __builtin_amdgcn_s_barrier()
#define PG8_SCHED __builtin_amdgcn_sched_barrier(0)
    Unit cur, nxt; int ui = 0;
    if (!S.next(0, cur)) return;
    f32x4 acc[2][2][4][2];
#pragma unroll
    for (int a = 0; a < 2; ++a)
#pragma unroll
        for (int b = 0; b < 2; ++b)
#pragma unroll
            for (int m = 0; m < 4; ++m)
#pragma unroll
                for (int n = 0; n < 2; ++n) acc[a][b][m][n] = (f32x4){0.f, 0.f, 0.f, 0.f};
    bf16x8 At[4][2], B0[2][2], B1[2][2];
    const char* cA = (const char*)g.A + (size_t)cur.pm * tstep + cur.koff; const char* cB = (const char*)g.Bt + (size_t)cur.pn * tstep + cur.koff;
    S.a_ready(cur);
    if constexpr (SP2) {
        PG8_STAGE(PG8_SB(0, 0), cB, voffB); PG8_STAGE(PG8_SB(0, 1), cB + hstep, voffB); PG8_STAGE(PG8_SA(0, 0), cA, voffA); PG8_STAGE(PG8_SA(0, 1), cA + hstep, voffA);
        if (wr == 1) PG8_BAR;
        PG8_WAIT_V(2); PG8_BAR;
        PG8_STAGE(PG8_SB(1, 0), cB + kstep, voffB); PG8_STAGE(PG8_SA(1, 0), cA + kstep, voffA); PG8_STAGE(PG8_SB(1, 1), cB + hstep + kstep, voffB);
        PG8_WAIT_V(6); PG8_BAR;
    } else {
        PG8_STAGE(PG8_SB(0, 0), cB, voffB); PG8_STAGE(PG8_SA(0, 0), cA, voffA); PG8_STAGE(PG8_SB(0, 1), cB + hstep, voffB); PG8_STAGE(PG8_SA(0, 1), cA + hstep, voffA);
        if (wr == 1) PG8_BAR;
        PG8_WAIT_V(4); PG8_BAR;
        PG8_STAGE(PG8_SB(1, 0), cB + kstep, voffB); PG8_STAGE(PG8_SA(1, 0), cA + kstep, voffA); PG8_STAGE(PG8_SB(1, 1), cB + hstep + kstep, voffB);
        PG8_WAIT_V(6); PG8_BAR;
    }
    for (;;) {
        const bool has_next = S.next(ui + 1, nxt);
        const char* nA = has_next ? (const char*)g.A + (size_t)nxt.pm * tstep + nxt.koff : cA; const char* nB = has_next ? (const char*)g.Bt + (size_t)nxt.pn * tstep + nxt.koff : cB;
        const int ntc = cur.nt ? cur.nt : nt;
        for (int t = 0; t < ntc; t += 2) {
            const bool last = (t == ntc - 2);
            const char* a1 = cA + (size_t)(t + 1) * kstep;
            const char* a2 = last ? nA : cA + (size_t)(t + 2) * kstep; const char* b2 = last ? nB : cB + (size_t)(t + 2) * kstep;
            const char* a3 = a2 + kstep; const char* b3 = b2 + kstep;
            if (last && has_next) S.a_ready(nxt);
            if constexpr (SP2) {
            PG8_LDB(B0, 0, 0); PG8_LDB(B1, 0, 1); PG8_SCHED; PG8_LDA(At, 0, 0); PG8_STAGE(PG8_SA(1, 1), a1 + hstep, voffA);
            PG8_WAIT_V(8); PG8_WAIT_L(0); PG8_BAR; PG8_MMA(0, 0, At, B0); PG8_MMA(0, 1, At, B1); PG8_BAR; PG8_SCHED;
            PG8_LDA(At, 0, 1); PG8_STAGE(PG8_SB(0, 0), b2, voffB); PG8_STAGE(PG8_SB(0, 1), b2 + hstep, voffB); PG8_STAGE(PG8_SA(0, 0), a2, voffA);
            PG8_WAIT_V(8); PG8_WAIT_L(0); PG8_BAR; PG8_MMA(1, 0, At, B0); PG8_MMA(1, 1, At, B1); PG8_BAR; PG8_SCHED;
            PG8_LDB(B0, 1, 0); PG8_LDB(B1, 1, 1); PG8_SCHED; PG8_LDA(At, 1, 0); PG8_STAGE(PG8_SA(0, 1), a2 + hstep, voffA);
            PG8_WAIT_V(8); PG8_WAIT_L(0); PG8_BAR; PG8_MMA(0, 0, At, B0); PG8_MMA(0, 1, At, B1); PG8_BAR; PG8_SCHED;
            PG8_LDA(At, 1, 1); PG8_STAGE(PG8_SB(1, 0), b3, voffB); PG8_STAGE(PG8_SB(1, 1), b3 + hstep, voffB); PG8_STAGE(PG8_SA(1, 0), a3, voffA);
            PG8_WAIT_V(8); PG8_WAIT_L(0); PG8_BAR; PG8_MMA(1, 0, At, B0); PG8_MMA(1, 1, At, B1); PG8_BAR; PG8_SCHED;
            } else {
            PG8_LDB(B0, 0, 0); PG8_SCHED; PG8_LDA(At, 0, 0); PG8_STAGE(PG8_SA(1, 1), a1 + hstep, voffA);
            PG8_WAIT_L(8); PG8_BAR; PG8_WAIT_L(0); PG8_MMA(0, 0, At, B0); PG8_BAR; PG8_SCHED;
            PG8_LDB(B1, 0, 1); PG8_STAGE(PG8_SB(0, 0), b2, voffB);
            PG8_BAR; PG8_WAIT_L(0); PG8_MMA(0, 1, At, B1); PG8_BAR;
            PG8_LDA(At, 0, 1); PG8_STAGE(PG8_SA(0, 0), a2, voffA);
            PG8_BAR; PG8_WAIT_L(0); PG8_MMA(1, 0, At, B0); PG8_BAR; PG8_SCHED;
            PG8_STAGE(PG8_SB(0, 1), b2 + hstep, voffB);
            PG8_WAIT_V(6); PG8_BAR; PG8_MMA(1, 1, At, B1); PG8_BAR;
            PG8_LDB(B0, 1, 0); PG8_SCHED; PG8_LDA(At, 1, 0); PG8_STAGE(PG8_SA(0, 1), a2 + hstep, voffA);
            PG8_WAIT_L(8); PG8_BAR; PG8_WAIT_L(0); PG8_MMA(0, 0, At, B0); PG8_BAR; PG8_SCHED;
            PG8_LDB(B1, 1, 1); PG8_STAGE(PG8_SB(1, 0), b3, voffB);
            PG8_BAR; PG8_WAIT_L(0); PG8_MMA(0, 1, At, B1); PG8_BAR;
            PG8_LDA(At, 1, 1); PG8_STAGE(PG8_SA(1, 0), a3, voffA);
            PG8_BAR; PG8_WAIT_L(0); PG8_MMA(1, 0, At, B0); PG8_BAR; PG8_SCHED;
            PG8_STAGE(PG8_SB(1, 1), b3 + hstep, voffB);
            PG8_WAIT_V(6); PG8_BAR; PG8_MMA(1, 1, At, B1); PG8_BAR;
            }
        }
        if constexpr (ALIGN_EPI) { if (wr == 0) PG8_BAR; }
        if constexpr (!Epi::AFTER_DRAIN) { E(acc, cur, wr, wc, fr, fq); S.done(cur); }
        if (!has_next) break;
#pragma unroll
        for (int a = 0; a < 2; ++a)
#pragma unroll
            for (int b = 0; b < 2; ++b)
#pragma unroll
                for (int m = 0; m < 4; ++m)
#pragma unroll
                    for (int n = 0; n < 2; ++n) acc[a][b][m][n] = (f32x4){0.f, 0.f, 0.f, 0.f};
        cur = nxt; cA = nA; cB = nB; ++ui;
        if constexpr (ALIGN_EPI) { if (wr == 1) PG8_BAR; }
    }
    PG8_WAIT_V(0);
    if constexpr (!ALIGN_EPI) { if (wr == 0) PG8_BAR; }
    PG8_BAR;
    if constexpr (Epi::AFTER_DRAIN) { E.fused(acc, cur, wr, wc, fr, fq, lds, wid, lane); S.done(cur); }
#undef PG8_SA
#undef PG8_SB
#undef PG8_STAGE
#undef PG8_LDA
#undef PG8_LDB
#undef PG8_MMA
#undef PG8_WAIT_V
#undef PG8_WAIT_L
#undef PG8_BAR
#undef PG8_SCHED
}
}
#define LAS __attribute__((address_space(3)))
typedef unsigned short bf16_t;
typedef short bf16x8 __attribute__((ext_vector_type(8)));
typedef short bf16x4 __attribute__((ext_vector_type(4)));
typedef float f32x4 __attribute__((ext_vector_type(4)));
typedef float f32x2 __attribute__((ext_vector_type(2)));
typedef float f32x16 __attribute__((ext_vector_type(16)));
typedef unsigned u32x4 __attribute__((ext_vector_type(4)));
typedef unsigned u32x2 __attribute__((ext_vector_type(2)));

constexpr int D = 1024, M_CTX = 8192, M_LAT = 16384, M = M_CTX + M_LAT, NP = 1888, NPP = 2048, FF = 2816, DEPTH = 4;
constexpr int KEYROWS = 8192 + 4 * 4352;
constexpr float EPS = 1e-6f;
constexpr int NTHREADS = 512, NWAVES = 8;
constexpr int LDS_BYTES = 147456;

constexpr size_t OUT_X = 0, OUT_CKV = (size_t)M * D, OUT_KR = OUT_CKV + (size_t)32 * 4 * 256 * 128;
constexpr int PC_U = 0, PC_V = 256, PC_H = 512, PC_B = 768, PC_C = 1024, PC_F = 1280, PC_Q = 1536, PC_KV = 1728, PC_KR = 1856;

constexpr size_t al256(size_t x) { return (x + 255) & ~(size_t)255; }
constexpr size_t WS_BAR = 0, WS_BAR_BYTES = 16384;
constexpr size_t WS_MOD = WS_BAR_BYTES;
constexpr size_t WS_F64 = al256(WS_MOD + (size_t)4 * 5 * 6144 * 4);
constexpr size_t WS_T64R = WS_F64 + 128 * 64 * 2;
constexpr size_t WS_T64I = WS_T64R + 64 * 128 * 2;
constexpr size_t WS_T64B = WS_T64I + 64 * 128 * 2;
constexpr size_t WS_T256 = WS_T64B + 64 * 128 * 2;
constexpr size_t WS_TW = WS_T256 + 256 * 512 * 2;
constexpr size_t WS_ROPE = WS_TW + 4096 * 8;
constexpr size_t WS_W = al256(WS_ROPE + 64 * 8 * 8);
constexpr size_t WL_IN = 0, WL_OUT = WL_IN + (size_t)NPP * D * 2, WL_GU = WL_OUT + (size_t)D * D * 2, WL_DN = WL_GU + (size_t)2 * FF * D * 2,
                 WL_UQ = WL_DN + (size_t)D * FF * 2, WL_UKV = WL_UQ + (size_t)384 * 192 * 2, WL_SP = WL_UKV + (size_t)512 * 128 * 2, WL_SIZE = WL_SP + (size_t)4 * 128 * 128 * 2;
constexpr size_t WS_R1 = al256(WS_W + 4 * WL_SIZE);
constexpr size_t WS_R2 = WS_R1 + (size_t)M * D * 2;
constexpr size_t WS_MLA = WS_R2 + (size_t)M * FF * 2;
constexpr size_t WS_Q = WS_MLA, WS_KN = WS_Q + (size_t)M * 384 * 2, WS_VT = WS_KN + (size_t)KEYROWS * 256 * 2, WS_KR = WS_VT + (size_t)KEYROWS * 256 * 2,
                 WS_GB = WS_KR + (size_t)KEYROWS * 32 * 2, WS_END = WS_GB + (size_t)4 * 4 * 64 * 64 * 128 * 2;
static_assert(WS_END - WS_MLA >= (size_t)M * D * 2, "FFNOUT alias");
static_assert((size_t)M * NP * 2 <= (size_t)M * FF * 2, "PROJ fits R2");

struct Params { const float* in[24]; float* out; unsigned char* ws; };
enum { I_XP = 0, I_XS, I_CCKV, I_CKR, I_C, I_CCTX, I_WADA, I_BADA, I_GPM, I_GPOM, I_GPF, I_GPOF, I_WIN, I_SPW, I_SPB, I_CVW, I_CVB, I_GQ, I_WUQ, I_GKV, I_WUKV, I_WOUT, I_WGU, I_WDN };

__device__ __forceinline__ unsigned f2bf(float f) { unsigned u = __builtin_bit_cast(unsigned, f); return (u + 0x7fffu + ((u >> 16) & 1u)) >> 16; }
typedef __bf16 bf16x2v __attribute__((ext_vector_type(2)));
__device__ __forceinline__ unsigned pk2(float lo, float hi) { const bf16x2v r = __builtin_convertvector((f32x2){lo, hi}, bf16x2v); return __builtin_bit_cast(unsigned, r); }
__device__ __forceinline__ float bflo(unsigned w) { return __builtin_bit_cast(float, w << 16); }
__device__ __forceinline__ float bfhi(unsigned w) { return __builtin_bit_cast(float, w & 0xffff0000u); }
__device__ __forceinline__ float bf1(bf16_t v) { return __builtin_bit_cast(float, (unsigned)v << 16); }
__device__ __forceinline__ f32x4 mma16(bf16x8 a, bf16x8 b, f32x4 c) { return __builtin_amdgcn_mfma_f32_16x16x32_bf16(a, b, c, 0, 0, 0); }
__device__ __forceinline__ f32x16 mma32(bf16x8 a, bf16x8 b, f32x16 c) { return __builtin_amdgcn_mfma_f32_32x32x16_bf16(a, b, c, 0, 0, 0); }
__device__ __forceinline__ float wave_sum(float v) {
#pragma unroll
    for (int o = 1; o < 64; o <<= 1) v += __shfl_xor(v, o);
    return v;
}
__device__ __forceinline__ u32x2 pk4(f32x4 v) { u32x2 w; w.x = pk2(v[0], v[1]); w.y = pk2(v[2], v[3]); return w; }
__device__ __forceinline__ int mod_of_row(int r) { return r < M_CTX ? 0 : 1 + ((r - M_CTX) >> 12); }

struct Ctx {
    Params p; LAS unsigned char* lds; int tid, lane, wave, bid, G;
    unsigned char* ws;
    __device__ __forceinline__ const float* mod(int l, int mi, int chunk) const { return (const float*)(ws + WS_MOD) + ((size_t)(l * 5 + mi) * 6 + chunk) * 1024; }
    __device__ __forceinline__ unsigned char* wl(int l) const { return ws + WS_W + (size_t)l * WL_SIZE; }
    __device__ __forceinline__ void refresh() { int t = threadIdx.x; asm volatile("" : "+v"(t)); tid = t; lane = t & 63; wave = __builtin_amdgcn_readfirstlane(t >> 6);
        size_t z = 0; asm volatile("" : "+s"(z)); ws = p.ws + z;
        int b = blockIdx.x; asm volatile("" : "+s"(b)); bid = b; }
};

constexpr int TPS = 258;
struct TItem { const float* W; bf16_t* WT; int ldw, K, k0, n0, nvalid, gu; };
__device__ __forceinline__ void titem_load(const TItem& t, int wave, int lane, f32x4 (&v)[8]) {
    const int n = t.n0 + 4 * lane;
#pragma unroll
    for (int i = 0; i < 8; ++i) v[i] = n < t.nvalid ? __builtin_nontemporal_load((const f32x4*)(t.W + (size_t)(t.k0 + 8 * wave + i) * t.ldw + n)) : (f32x4){0.f, 0.f, 0.f, 0.f};
}
__device__ __forceinline__ void titem_stage(LAS unsigned char* lds, int wave, int lane, const f32x4 (&v)[8]) {
    LAS bf16_t* T = (LAS bf16_t*)lds;
#pragma unroll
    for (int i = 0; i < 8; ++i) { LAS unsigned* d = (LAS unsigned*)(T + (8 * wave + i) * TPS + 4 * lane); d[0] = pk2(v[i][0], v[i][1]); d[1] = pk2(v[i][2], v[i][3]); }
}
__device__ __forceinline__ void titem_store(const TItem& t, const LAS unsigned char* lds, int tid) {
    const LAS bf16_t* T = (const LAS bf16_t*)lds;
#pragma unroll
    for (int it = 0; it < 4; ++it) { const int q = tid + NTHREADS * it, n = q >> 3, c = q & 7;
        unsigned short e[8];
#pragma unroll
        for (int j = 0; j < 8; ++j) e[j] = T[(8 * c + j) * TPS + n];
        const int sn = t.n0 + n;
        if (sn < t.nvalid) { int dr = sn; if (t.gu) { const int isup = sn >= FF, jj = isup ? sn - FF : sn; dr = (jj >> 7) * 256 + isup * 128 + (jj & 127); }
            u32x4 o; o.x = e[0] | ((unsigned)e[1] << 16); o.y = e[2] | ((unsigned)e[3] << 16); o.z = e[4] | ((unsigned)e[5] << 16); o.w = e[6] | ((unsigned)e[7] << 16);
            *(u32x4*)(t.WT + (size_t)dr * t.K + t.k0 + 8 * c) = o; } }
}
constexpr int TI_IN = 16 * 8, TI_OUT = 16 * 4, TI_GU = 16 * 22, TI_DN = 44 * 4, TI_UQ = 3 * 2, TI_UKV = 2 * 2, TI_L = TI_IN + TI_OUT + TI_GU + TI_DN + TI_UQ + TI_UKV;
__device__ __forceinline__ TItem titem_make(const Ctx& C, int it) {
    const Params& p = C.p; const int l = it / TI_L; int r = it % TI_L; unsigned char* wl = C.wl(l); TItem t; t.gu = 0;
    if (r < TI_IN) { t.W = p.in[I_WIN] + (size_t)l * D * NP; t.WT = (bf16_t*)(wl + WL_IN); t.ldw = NP; t.K = D; t.k0 = (r >> 3) * 64; t.n0 = (r & 7) * 256; t.nvalid = NP; return t; } r -= TI_IN;
    if (r < TI_OUT) { t.W = p.in[I_WOUT] + (size_t)l * D * D; t.WT = (bf16_t*)(wl + WL_OUT); t.ldw = D; t.K = D; t.k0 = (r >> 2) * 64; t.n0 = (r & 3) * 256; t.nvalid = D; return t; } r -= TI_OUT;
    if (r < TI_GU) { t.W = p.in[I_WGU] + (size_t)l * D * 2 * FF; t.WT = (bf16_t*)(wl + WL_GU); t.ldw = 2 * FF; t.K = D; t.k0 = (r / 22) * 64; t.n0 = (r % 22) * 256; t.nvalid = 2 * FF; t.gu = 1; return t; } r -= TI_GU;
    if (r < TI_DN) { t.W = p.in[I_WDN] + (size_t)l * FF * D; t.WT = (bf16_t*)(wl + WL_DN); t.ldw = D; t.K = FF; t.k0 = (r >> 2) * 64; t.n0 = (r & 3) * 256; t.nvalid = D; return t; } r -= TI_DN;
    if (r < TI_UQ) { t.W = p.in[I_WUQ] + (size_t)l * 192 * 384; t.WT = (bf16_t*)(wl + WL_UQ); t.ldw = 384; t.K = 192; t.k0 = (r >> 1) * 64; t.n0 = (r & 1) * 256; t.nvalid = 384; return t; } r -= TI_UQ;
    t.W = p.in[I_WUKV] + (size_t)l * 128 * 512; t.WT = (bf16_t*)(wl + WL_UKV); t.ldw = 512; t.K = 128; t.k0 = (r >> 1) * 64; t.n0 = (r & 1) * 256; t.nvalid = 512; return t;
}

__device__ __forceinline__ void transpose_items(const Ctx& C, int it0, int stride, int end) {
    int it = it0; f32x4 v[8];
    TItem cur; if (it < end) { cur = titem_make(C, it); titem_load(cur, C.wave, C.lane, v); }
    while (it < end) {
        titem_stage(C.lds, C.wave, C.lane, v);
        const int nx = it + stride; TItem nxt = cur; if (nx < end) { nxt = titem_make(C, nx); titem_load(nxt, C.wave, C.lane, v); }
        __syncthreads();
        titem_store(cur, C.lds, C.tid);
        __syncthreads();
        cur = nxt; it = nx;
    }
}

__device__ __forceinline__ void phase_prologue(const Ctx& C) {
    const Params& p = C.p;
    transpose_items(C, C.bid, C.G, (C.G == 256) ? TI_L : 4 * TI_L);
    {
        LAS float* sc = (LAS float*)C.lds;
        LAS float* red = (LAS float*)(C.lds + 5 * 1024 * 4);
        const int ub = C.G - 1 - C.bid;
        if (ub < 96) {
            size_t za = 0, zb = 0; asm volatile("" : "+s"(za), "+s"(zb));
            const float* cctx = p.in[I_CCTX] + za; const float* cc_ = p.in[I_C] + zb;
            for (int i = C.tid; i < 5120; i += NTHREADS) { const int j = i >> 10, k = i & 1023; const float v = (j == 0) ? cctx[k] : cc_[(j - 1) * 1024 + k]; sc[i] = v / (1.f + __expf(-v)); }
            __syncthreads();
            for (int u = ub; u < 96; u += C.G) {
                const int l = u / 24, cb = u % 24;
                const float* w = p.in[I_WADA] + ((size_t)l * 1024 + C.wave * 128) * 6144 + cb * 256 + 4 * C.lane;
                f32x4 a0 = {0.f, 0.f, 0.f, 0.f}, a1 = a0, a2 = a0, a3 = a0, a4 = a0;
#pragma unroll 16
                for (int k = 0; k < 128; ++k) { const f32x4 wv = __builtin_nontemporal_load((const f32x4*)(w + (size_t)k * 6144)); const int kk = C.wave * 128 + k;
                    a0 += wv * sc[kk]; a1 += wv * sc[1024 + kk]; a2 += wv * sc[2048 + kk]; a3 += wv * sc[3072 + kk]; a4 += wv * sc[4096 + kk]; }
                LAS f32x4* rw = (LAS f32x4*)(red + C.wave * 1280) + C.lane;
                rw[0] = a0; rw[64] = a1; rw[128] = a2; rw[192] = a3; rw[256] = a4;
                __syncthreads();
                for (int i = C.tid; i < 1280; i += NTHREADS) { const int j = i >> 8, c2 = i & 255; float sum = p.in[I_BADA][l * 6144 + cb * 256 + c2];
#pragma unroll
                    for (int ww = 0; ww < 8; ++ww) sum += red[ww * 1280 + i];
                    ((float*)(C.ws + WS_MOD))[(size_t)(l * 5 + j) * 6144 + cb * 256 + c2] = sum; }
                __syncthreads();
            }
        }
        __syncthreads();
    }
    {
        const int gt = C.bid * NTHREADS + C.tid, GT = C.G * NTHREADS;
        for (int i = gt; i < 4 * 65536; i += GT) { const int l = i >> 16, e = i & 65535; ((bf16_t*)(C.wl(l) + WL_SP))[e] = (bf16_t)f2bf(p.in[I_SPW][i]); }
        for (int i = gt; i < 4 * 160 * 1024 / 2; i += GT) { const int l = i / (160 * 512), e = i % (160 * 512); ((unsigned*)(C.wl(l) + WL_IN + (size_t)NP * D * 2))[e] = 0u; }
        for (int i = gt; i < 128 * 64; i += GT) { const int m = i >> 6, c = i & 63; const int idx = ((m & 63) * c) & 63; const float a = (float)idx / 32.f;
            ((bf16_t*)(C.ws + WS_F64))[i] = (bf16_t)f2bf(m < 64 ? cospif(a) : sinpif(a)); }
        for (int i = gt; i < 64 * 128; i += GT) { const int k = i >> 7, K = i & 127; const int idx = (k * (K & 63)) & 63; const float a = (float)idx / 32.f; const float cv = cospif(a), sv = sinpif(a);
            ((bf16_t*)(C.ws + WS_T64R))[i] = (bf16_t)f2bf(K < 64 ? cv : -sv);
            ((bf16_t*)(C.ws + WS_T64I))[i] = (bf16_t)f2bf(K < 64 ? -sv : -cv);
            ((bf16_t*)(C.ws + WS_T64B))[i] = (bf16_t)f2bf(K < 64 ? cv : sv); }
        for (int i = gt; i < 256 * 512; i += GT) { const int k = i >> 9, K = i & 511; const int idx = (k * (K & 255)) & 255; const float a = (float)idx / 128.f;
            ((bf16_t*)(C.ws + WS_T256))[i] = (bf16_t)f2bf(K < 256 ? cospif(a) : -sinpif(a)); }
        for (int i = gt; i < 4096; i += GT) { const float a = (float)i / 2048.f; ((f32x2*)(C.ws + WS_TW))[i] = (f32x2){cospif(a), sinpif(a)}; }
        for (int i = gt; i < 512; i += GT) { const int pos = i >> 3, f = i & 7; const float inv = powf(10000.f, -(float)f / 8.f); const float ang = (float)pos * inv;
            ((f32x2*)(C.ws + WS_ROPE))[i] = (f32x2){cosf(ang), sinf(ang)}; }
    }
}

__device__ __forceinline__ void load_row_f32(const float* rowp, int lane, f32x4 (&v)[4]) {
#pragma unroll
    for (int j = 0; j < 4; ++j) v[j] = *(const f32x4*)(rowp + 4 * lane + 256 * j);
}
__device__ __forceinline__ void load_row_f32_nt(const float* rowp, int lane, f32x4 (&v)[4]) {
#pragma unroll
    for (int j = 0; j < 4; ++j) v[j] = __builtin_nontemporal_load((const f32x4*)(rowp + 4 * lane + 256 * j));
}
__device__ __forceinline__ void load_row_bf16(const bf16_t* rowp, int lane, f32x4 (&v)[4]) {
#pragma unroll
    for (int j = 0; j < 4; ++j) { const u32x2 w = *(const u32x2*)(rowp + 4 * lane + 256 * j); v[j] = (f32x4){bflo(w.x), bfhi(w.x), bflo(w.y), bfhi(w.y)}; }
}
__device__ __forceinline__ float row_rstd(const f32x4 (&v)[4]) {
    float s = 0.f;
#pragma unroll
    for (int j = 0; j < 4; ++j) s += (v[j][0] * v[j][0] + v[j][1] * v[j][1]) + (v[j][2] * v[j][2] + v[j][3] * v[j][3]);
    return 1.f / sqrtf(wave_sum(s) * (1.f / 1024.f) + EPS);
}
__device__ __forceinline__ void norm_mod_store(const f32x4 (&x)[4], const float* g, const float* scale, const float* shift, bf16_t* orow, int lane) {
    const float rs = row_rstd(x);
#pragma unroll
    for (int j = 0; j < 4; ++j) { const int c = 4 * lane + 256 * j; const f32x4 gv = *(const f32x4*)(g + c), sv = *(const f32x4*)(scale + c), hv = *(const f32x4*)(shift + c);
        const f32x4 h = x[j] * rs * gv * (1.f + sv) + hv; *(u32x2*)(orow + c) = pk4(h); }
}
__device__ __forceinline__ void norm_mod_store_g(const f32x4 (&x)[4], const f32x4 (&gv)[4], const float* scale, const float* shift, bf16_t* orow, int lane) {
    const float rs = row_rstd(x);
#pragma unroll
    for (int j = 0; j < 4; ++j) { const int c = 4 * lane + 256 * j; const f32x4 sv = *(const f32x4*)(scale + c), hv = *(const f32x4*)(shift + c);
        const f32x4 h = x[j] * rs * gv[j] * (1.f + sv) + hv; *(u32x2*)(orow + c) = pk4(h); }
}
__device__ __forceinline__ const float* xin_row(const Ctx& C, int layer, int r) {
    if (layer > 0) return C.p.out + OUT_X + (size_t)r * D;
    size_t za = 0, zb = 0; asm volatile("" : "+s"(za), "+s"(zb));
    const float* a = C.p.in[I_XP] + za; const float* b = C.p.in[I_XS] + zb;
    return r < M_CTX ? a + (size_t)r * D : b + (size_t)(r - M_CTX) * D;
}
constexpr int SPLIT_ROW0 = 16384;
__device__ __forceinline__ void load_row_bf16_nt(const bf16_t* rowp, int lane, f32x4 (&v)[4]) {
#pragma unroll
    for (int j = 0; j < 4; ++j) { const u32x2 w = __builtin_nontemporal_load((const u32x2*)(rowp + 4 * lane + 256 * j)); v[j] = (f32x4){bflo(w.x), bfhi(w.x), bflo(w.y), bfhi(w.y)}; }
}
__device__ __forceinline__ void load_T(const bf16_t* T, const bf16_t* T1, bool split, int r, int lane, f32x4 (&v)[4]) {
    load_row_bf16_nt(T + (size_t)r * D, lane, v);
    if (split && r >= SPLIT_ROW0) { f32x4 w[4]; load_row_bf16_nt(T1 + (size_t)r * D, lane, w);
#pragma unroll
        for (int j = 0; j < 4; ++j) v[j] = v[j] + w[j]; }
}
__device__ __forceinline__ void phase_norm0(const Ctx& C) {
    const int gw = C.bid * NWAVES + C.wave, NGW = C.G * NWAVES;
    bf16_t* H = (bf16_t*)(C.ws + WS_R1);
    f32x4 xn[4]; load_row_f32_nt(xin_row(C, 0, gw), C.lane, xn);
    for (int r = gw; r < M; r += NGW) { f32x4 x[4];
#pragma unroll
        for (int j = 0; j < 4; ++j) x[j] = xn[j];
        if (r + NGW < M) load_row_f32_nt(xin_row(C, 0, r + NGW), C.lane, xn);
        const int mi = mod_of_row(r);
        norm_mod_store(x, C.p.in[I_GPM], C.mod(0, mi, 1), C.mod(0, mi, 0), H + (size_t)r * D, C.lane); }
}
template <int which  > __device__ __forceinline__ void phase_post(const Ctx& C, int layer) {
    const int gw = C.bid * NWAVES + C.wave, NGW = C.G * NWAVES;
    const bf16_t* T = (const bf16_t*)(C.ws + (which == 0 ? WS_R2 : WS_MLA));
    const bf16_t* T1 = T + (size_t)M * D - (size_t)SPLIT_ROW0 * D;
    const bool split = (C.G == 256);
    bf16_t* H = (bf16_t*)(C.ws + WS_R1);
    const float* gpost = (which == 0 ? C.p.in[I_GPOM] : C.p.in[I_GPOF]) + layer * D;
    const bool do_next = (which == 0) || (layer + 1 < DEPTH);
    const int nl = which == 0 ? layer : layer + 1;
    const float* gnext = (which == 0 ? C.p.in[I_GPF] : C.p.in[I_GPM]) + (nl < DEPTH ? nl : 0) * D;
    f32x4 gg[4], gs[4], sh[4]; int cur_mi = -1;
#pragma unroll
    for (int j = 0; j < 4; ++j) { gg[j] = (f32x4){0.f, 0.f, 0.f, 0.f}; gs[j] = gg[j]; sh[j] = gg[j]; }
    f32x4 tq[3][4], xq[3][4];
#define POST_LOAD(s_, r_) do { load_T(T, T1, split, (r_), C.lane, tq[s_]); load_row_f32_nt(which == 0 ? xin_row(C, layer, (r_)) : C.p.out + OUT_X + (size_t)(r_) * D, C.lane, xq[s_]); } while (0)
#define POST_ROW(s_, r_) do { const int rr_ = (r_); const int mi = mod_of_row(rr_); \
        if (mi != cur_mi) { cur_mi = mi; \
            const float* gate = C.mod(layer, mi, which == 0 ? 2 : 5); const float* scale = C.mod(nl, mi, which == 0 ? 4 : 1); const float* shift = C.mod(nl, mi, which == 0 ? 3 : 0); \
            _Pragma("unroll") for (int j = 0; j < 4; ++j) { const int c = 4 * C.lane + 256 * j; gg[j] = *(const f32x4*)(gate + c) * *(const f32x4*)(gpost + c); \
                if (do_next) { gs[j] = *(const f32x4*)(gnext + c) * (1.f + *(const f32x4*)(scale + c)); sh[j] = *(const f32x4*)(shift + c); } } } \
        const float rs = row_rstd(tq[s_]); float* xo = C.p.out + OUT_X + (size_t)rr_ * D; \
        _Pragma("unroll") for (int j = 0; j < 4; ++j) { const int c = 4 * C.lane + 256 * j; xq[s_][j] = xq[s_][j] + gg[j] * (tq[s_][j] * rs); __builtin_nontemporal_store(xq[s_][j], (f32x4*)(xo + c)); } \
        if (do_next) { const float rs2 = row_rstd(xq[s_]); bf16_t* orow = H + (size_t)rr_ * D; \
            _Pragma("unroll") for (int j = 0; j < 4; ++j) { const int c = 4 * C.lane + 256 * j; const f32x4 h = xq[s_][j] * rs2 * gs[j] + sh[j]; *(u32x2*)(orow + c) = pk4(h); } } } while (0)
    POST_LOAD(0, gw); if (gw + NGW < M) POST_LOAD(1, gw + NGW);
    for (int r = gw; r < M; r += 3 * NGW) {
        if (r + 2 * NGW < M) POST_LOAD(2, r + 2 * NGW);
        POST_ROW(0, r);
        if (r + NGW < M) { if (r + 3 * NGW < M) POST_LOAD(0, r + 3 * NGW); POST_ROW(1, r + NGW); }
        if (r + 2 * NGW < M) { if (r + 4 * NGW < M) POST_LOAD(1, r + 4 * NGW); POST_ROW(2, r + 2 * NGW); }
    }
#undef POST_LOAD
#undef POST_ROW
}

__device__ __forceinline__ void unit_chunk_mlp(const Ctx& C, int layer, int u) {
    const int chunk = u >> 2, g = u & 3, r0 = chunk * 128;
    const bf16_t* PROJ = (const bf16_t*)(C.ws + WS_R2); bf16_t* MIX = (bf16_t*)(C.ws + WS_R1);
    constexpr int VS = 136;
    LAS bf16_t* Vt = (LAS bf16_t*)C.lds;
    { const int q = C.tid >> 2, c0 = (C.tid & 3) * 16; const bf16_t* src = PROJ + (size_t)(r0 + q) * NP + PC_V + g * 64 + c0;
      const bf16x8 v0 = *(const bf16x8*)src, v1 = *(const bf16x8*)(src + 8);
#pragma unroll
      for (int j = 0; j < 8; ++j) { Vt[(c0 + j) * VS + q] = (bf16_t)v0[j]; Vt[(c0 + 8 + j) * VS + q] = (bf16_t)v1[j]; } }
    __syncthreads();
    const int l15 = C.lane & 15, hq = C.lane >> 4, w = C.wave;
    const bf16_t* Wg = (const bf16_t*)(C.wl(layer) + WL_SP) + (size_t)g * 128 * 128;
    bf16x8 bw[4];
#pragma unroll
    for (int ks = 0; ks < 4; ++ks) bw[ks] = *(const bf16x8*)(Wg + (size_t)(w * 16 + l15) * 128 + ks * 32 + 8 * hq);
    const int p = w * 16 + l15; const float bias = C.p.in[I_SPB][(layer * 4 + g) * 128 + p];
#pragma unroll
    for (int ct = 0; ct < 4; ++ct) {
        f32x4 acc = {0.f, 0.f, 0.f, 0.f};
#pragma unroll
        for (int ks = 0; ks < 4; ++ks) { const bf16x8 a = *(const LAS bf16x8*)(Vt + (ct * 16 + l15) * VS + ks * 32 + 8 * hq); acc = mma16(a, bw[ks], acc); }
        const int cc = g * 64 + ct * 16 + 4 * hq; const u32x2 uw = *(const u32x2*)(PROJ + (size_t)(r0 + p) * NP + PC_U + cc);
        f32x4 o; o[0] = bflo(uw.x) * (acc[0] + bias); o[1] = bfhi(uw.x) * (acc[1] + bias); o[2] = bflo(uw.y) * (acc[2] + bias); o[3] = bfhi(uw.y) * (acc[3] + bias);
        *(u32x2*)(MIX + (size_t)(r0 + p) * D + cc) = pk4(o);
    }
    __syncthreads();
}
__device__ __forceinline__ void unit_conv(const Ctx& C, int layer, int u) {
    const bf16_t* PROJ = (const bf16_t*)(C.ws + WS_R2); bf16_t* MIX = (bf16_t*)(C.ws + WS_R1);
    const float* cw = C.p.in[I_CVW] + layer * 3 * 256; const float* cb = C.p.in[I_CVB] + layer * 256;
    for (int it = 0; it < 8; ++it) {
        const int item = it * NTHREADS + C.tid, t = item >> 5, ch = (item & 31) * 8, r = u * 128 + t;
        const int pos = r < M_CTX ? (r & 255) : ((r - M_CTX) & 4095), len = r < M_CTX ? 256 : 4096;
        const bf16_t* base = PROJ + (size_t)r * NP;
        const bf16x8 h1 = *(const bf16x8*)(base + PC_H + ch), c1 = *(const bf16x8*)(base + PC_C + ch), gb = *(const bf16x8*)(base + PC_B + ch);
        bf16x8 h0 = h1, c0 = c1, h2 = h1, c2 = c1; const bool hasp = pos > 0, hasn = pos < len - 1;
        if (hasp) { h0 = *(const bf16x8*)(base - NP + PC_H + ch); c0 = *(const bf16x8*)(base - NP + PC_C + ch); }
        if (hasn) { h2 = *(const bf16x8*)(base + NP + PC_H + ch); c2 = *(const bf16x8*)(base + NP + PC_C + ch); }
        float o[8];
#pragma unroll
        for (int j = 0; j < 8; ++j) {
            const float z0 = hasp ? bf1((bf16_t)h0[j]) * bf1((bf16_t)c0[j]) : 0.f, z1 = bf1((bf16_t)h1[j]) * bf1((bf16_t)c1[j]), z2 = hasn ? bf1((bf16_t)h2[j]) * bf1((bf16_t)c2[j]) : 0.f;
            const float y = z0 * cw[ch + j] + z1 * cw[256 + ch + j] + z2 * cw[512 + ch + j] + cb[ch + j];
            o[j] = bf1((bf16_t)gb[j]) * y; }
        u32x4 w; w.x = pk2(o[0], o[1]); w.y = pk2(o[2], o[3]); w.z = pk2(o[4], o[5]); w.w = pk2(o[6], o[7]);
        *(u32x4*)(MIX + (size_t)r * D + 256 + ch) = w;
    }
}
__device__ __forceinline__ void unit_fourier_ctx(const Ctx& C, int u) {
    const int s = u >> 2, g = u & 3, l15 = C.lane & 15, hq = C.lane >> 4, w = C.wave;
    const bf16_t* PROJ = (const bf16_t*)(C.ws + WS_R2); bf16_t* MIX = (bf16_t*)(C.ws + WS_R1);
    const bf16_t* F64 = (const bf16_t*)(C.ws + WS_F64); const bf16_t* T256 = (const bf16_t*)(C.ws + WS_T256);
    constexpr int ZS = 520; LAS bf16_t* Zt = (LAS bf16_t*)C.lds;
#pragma unroll
    for (int i = 0; i < 2; ++i) { const int nt = 2 * w + i;
        bf16x8 a[2];
#pragma unroll
        for (int ks = 0; ks < 2; ++ks) a[ks] = *(const bf16x8*)(PROJ + (size_t)(s * 256 + nt * 16 + l15) * NP + PC_F + g * 64 + ks * 32 + 8 * hq);
#pragma unroll
        for (int mt = 0; mt < 8; ++mt) { f32x4 acc = {0.f, 0.f, 0.f, 0.f};
#pragma unroll
            for (int ks = 0; ks < 2; ++ks) { const bf16x8 b = *(const bf16x8*)(F64 + (size_t)(mt * 16 + l15) * 64 + ks * 32 + 8 * hq); acc = mma16(a[ks], b, acc); }
            const int mp = mt * 16 + l15;
            *(LAS u32x2*)(Zt + (mp & 63) * ZS + (mp >> 6) * 256 + nt * 16 + 4 * hq) = pk4(acc); } }
    __syncthreads();
#pragma unroll 1
    for (int i = 0; i < 2; ++i) { const int kt = 2 * w + i;
        f32x4 acc[4];
#pragma unroll
        for (int mt = 0; mt < 4; ++mt) acc[mt] = (f32x4){0.f, 0.f, 0.f, 0.f};
#pragma unroll 8
        for (int ks = 0; ks < 16; ++ks) { const bf16x8 b = *(const bf16x8*)(T256 + (size_t)(kt * 16 + l15) * 512 + ks * 32 + 8 * hq);
#pragma unroll
            for (int mt = 0; mt < 4; ++mt) { const bf16x8 a = *(const LAS bf16x8*)(Zt + (mt * 16 + l15) * ZS + ks * 32 + 8 * hq); acc[mt] = mma16(a, b, acc[mt]); } }
#pragma unroll
        for (int mt = 0; mt < 4; ++mt) *(u32x2*)(MIX + (size_t)(s * 256 + kt * 16 + l15) * D + 512 + g * 64 + mt * 16 + 4 * hq) = pk4(acc[mt] * (1.f / 128.f)); }
    __syncthreads();
}
__device__ __forceinline__ void unit_fourier_lat1(const Ctx& C, int u) {
    const int b = u >> 5, g = (u >> 3) & 3, nb = u & 7, l15 = C.lane & 15, hq = C.lane >> 4, n2 = nb * 8 + C.wave;
    const bf16_t* PROJ = (const bf16_t*)(C.ws + WS_R2);
    const bf16_t* F64 = (const bf16_t*)(C.ws + WS_F64); const bf16_t* T64R = (const bf16_t*)(C.ws + WS_T64R); const bf16_t* T64I = (const bf16_t*)(C.ws + WS_T64I);
    const f32x2* TW = (const f32x2*)(C.ws + WS_TW);
    bf16_t* GB = (bf16_t*)(C.ws + WS_GB) + (size_t)((b * 4 + g) * 64 + n2) * 64 * 128;
    constexpr int ZS = 136; LAS bf16_t* Zt = (LAS bf16_t*)(C.lds + C.wave * (64 * ZS * 2));
#pragma unroll 2
    for (int nt = 0; nt < 4; ++nt) {
        bf16x8 a[2];
#pragma unroll
        for (int ks = 0; ks < 2; ++ks) a[ks] = *(const bf16x8*)(PROJ + (size_t)(M_CTX + b * 4096 + (nt * 16 + l15) * 64 + n2) * NP + PC_F + g * 64 + ks * 32 + 8 * hq);
#pragma unroll
        for (int mt = 0; mt < 8; ++mt) { f32x4 acc = {0.f, 0.f, 0.f, 0.f};
#pragma unroll
            for (int ks = 0; ks < 2; ++ks) { const bf16x8 bb = *(const bf16x8*)(F64 + (size_t)(mt * 16 + l15) * 64 + ks * 32 + 8 * hq); acc = mma16(a[ks], bb, acc); }
            const int mp = mt * 16 + l15;
            *(LAS u32x2*)(Zt + (mp & 63) * ZS + (mp >> 6) * 64 + nt * 16 + 4 * hq) = pk4(acc); } }
    asm volatile("s_waitcnt lgkmcnt(0)" ::: "memory");
#pragma unroll 2
    for (int kt = 0; kt < 4; ++kt) {
        bf16x8 br[4], bi[4];
#pragma unroll
        for (int ks = 0; ks < 4; ++ks) { br[ks] = *(const bf16x8*)(T64R + (size_t)(kt * 16 + l15) * 128 + ks * 32 + 8 * hq); bi[ks] = *(const bf16x8*)(T64I + (size_t)(kt * 16 + l15) * 128 + ks * 32 + 8 * hq); }
        const int k1 = kt * 16 + l15; const f32x2 tw = TW[k1 * n2];
#pragma unroll
        for (int mt = 0; mt < 4; ++mt) { f32x4 ar = {0.f, 0.f, 0.f, 0.f}, ai = {0.f, 0.f, 0.f, 0.f};
#pragma unroll
            for (int ks = 0; ks < 4; ++ks) { const bf16x8 a = *(const LAS bf16x8*)(Zt + (mt * 16 + l15) * ZS + ks * 32 + 8 * hq); ar = mma16(a, br[ks], ar); ai = mma16(a, bi[ks], ai); }
            const f32x4 gr = ar * tw[0] + ai * tw[1], gi = ai * tw[0] - ar * tw[1];
            bf16_t* dst = GB + (size_t)k1 * 128 + mt * 16 + 4 * hq;
            *(u32x2*)dst = pk4(gr); *(u32x2*)(dst + 64) = pk4(gi); } }
    __syncthreads();
}
__device__ __forceinline__ void unit_fourier_lat2(const Ctx& C, int u) {
    const int b = u >> 5, g = (u >> 3) & 3, kb = u & 7, l15 = C.lane & 15, hq = C.lane >> 4, k1 = kb * 8 + C.wave;
    const bf16_t* T64B = (const bf16_t*)(C.ws + WS_T64B); bf16_t* MIX = (bf16_t*)(C.ws + WS_R1);
    const bf16_t* GB = (const bf16_t*)(C.ws + WS_GB) + (size_t)((b * 4 + g) * 64) * 64 * 128 + (size_t)k1 * 128;
    constexpr int ZS = 136; LAS bf16_t* Tt = (LAS bf16_t*)(C.lds + C.wave * (64 * ZS * 2));
#pragma unroll 4
    for (int it = 0; it < 16; ++it) { const int q = it * 64 + C.lane, n2 = q >> 4, cc = q & 15, part = cc >> 3, m0 = (cc & 7) * 8;
        const bf16x8 v = *(const bf16x8*)(GB + (size_t)n2 * 64 * 128 + cc * 8);
#pragma unroll
        for (int j = 0; j < 8; ++j) Tt[(m0 + j) * ZS + part * 64 + n2] = (bf16_t)v[j]; }
    asm volatile("s_waitcnt lgkmcnt(0)" ::: "memory");
#pragma unroll 2
    for (int kt = 0; kt < 4; ++kt) {
        bf16x8 bb[4];
#pragma unroll
        for (int ks = 0; ks < 4; ++ks) bb[ks] = *(const bf16x8*)(T64B + (size_t)(kt * 16 + l15) * 128 + ks * 32 + 8 * hq);
        const int k2 = kt * 16 + l15; const int row = M_CTX + b * 4096 + k1 + 64 * k2;
#pragma unroll
        for (int mt = 0; mt < 4; ++mt) { f32x4 acc = {0.f, 0.f, 0.f, 0.f};
#pragma unroll
            for (int ks = 0; ks < 4; ++ks) { const bf16x8 a = *(const LAS bf16x8*)(Tt + (mt * 16 + l15) * ZS + ks * 32 + 8 * hq); acc = mma16(a, bb[ks], acc); }
            *(u32x2*)(MIX + (size_t)row * D + 512 + g * 64 + mt * 16 + 4 * hq) = pk4(acc * (1.f / 512.f)); } }
    __syncthreads();
}
constexpr float QSCALE = 0.10206207261596577f * 1.4426950408889634f;
__device__ __forceinline__ void unit_mla_prep(const Ctx& C, int layer, int u) {
    const Params& p = C.p;
    const bf16_t* PROJ = (const bf16_t*)(C.ws + WS_R2);
    bf16_t* Q = (bf16_t*)(C.ws + WS_Q); bf16_t* KN = (bf16_t*)(C.ws + WS_KN); bf16_t* VT = (bf16_t*)(C.ws + WS_VT); bf16_t* KR = (bf16_t*)(C.ws + WS_KR);
    const f32x2* ROPE = (const f32x2*)(C.ws + WS_ROPE);
    constexpr int QS = 200, KS = 136;
    LAS bf16_t* CQ = (LAS bf16_t*)C.lds;
    LAS bf16_t* CK = (LAS bf16_t*)(C.lds + 128 * QS * 2);
    const bool is_tok = u < 192;
    int r0 = 0, keyrow0, keypos0, nk; size_t vtbase; bool lat;
    if (is_tok) { r0 = u * 128; lat = r0 >= M_CTX;
        if (!lat) { keyrow0 = r0; keypos0 = r0 & 255; nk = 256; vtbase = (size_t)(r0 & ~255) * 256; }
        else { const int b = (r0 - M_CTX) >> 12, n = (r0 - M_CTX) & 4095; keyrow0 = M_CTX + b * 4352 + n; keypos0 = n; nk = 4352; vtbase = (size_t)(M_CTX + b * 4352) * 256; } }
    else { const int cu = u - 192, b = cu >> 1, half = cu & 1; lat = true; keyrow0 = M_CTX + b * 4352 + 4096 + half * 128; keypos0 = 4096 + half * 128; nk = 4352; vtbase = (size_t)(M_CTX + b * 4352) * 256; }
    { const int t = C.tid >> 2, sub = C.tid & 3;
      if (is_tok) {
        const int r = r0 + t; const bf16_t* base = PROJ + (size_t)r * NP;
        float q[48], k[32]; float sq = 0.f, sk = 0.f;
#pragma unroll
        for (int i = 0; i < 6; ++i) { const bf16x8 v = *(const bf16x8*)(base + PC_Q + sub * 48 + i * 8);
#pragma unroll
            for (int j = 0; j < 8; ++j) { q[i * 8 + j] = bf1((bf16_t)v[j]); sq += q[i * 8 + j] * q[i * 8 + j]; } }
#pragma unroll
        for (int i = 0; i < 4; ++i) { const bf16x8 v = *(const bf16x8*)(base + PC_KV + sub * 32 + i * 8);
#pragma unroll
            for (int j = 0; j < 8; ++j) { k[i * 8 + j] = bf1((bf16_t)v[j]); sk += k[i * 8 + j] * k[i * 8 + j]; } }
        sq += __shfl_xor(sq, 1); sq += __shfl_xor(sq, 2); sk += __shfl_xor(sk, 1); sk += __shfl_xor(sk, 2);
        const float rq = 1.f / sqrtf(sq * (1.f / 192.f) + EPS), rk = 1.f / sqrtf(sk * (1.f / 128.f) + EPS);
        const float* gq = p.in[I_GQ] + layer * 192 + sub * 48; const float* gk = p.in[I_GKV] + layer * 128 + sub * 32;
#pragma unroll
        for (int i = 0; i < 6; ++i) { u32x4 w; w.x = pk2(q[i * 8 + 0] * rq * gq[i * 8 + 0], q[i * 8 + 1] * rq * gq[i * 8 + 1]); w.y = pk2(q[i * 8 + 2] * rq * gq[i * 8 + 2], q[i * 8 + 3] * rq * gq[i * 8 + 3]);
            w.z = pk2(q[i * 8 + 4] * rq * gq[i * 8 + 4], q[i * 8 + 5] * rq * gq[i * 8 + 5]); w.w = pk2(q[i * 8 + 6] * rq * gq[i * 8 + 6], q[i * 8 + 7] * rq * gq[i * 8 + 7]);
            *(LAS u32x4*)(CQ + t * QS + sub * 48 + i * 8) = w; }
        float* sckv = nullptr;
        if (!lat) { const int s = r >> 8, pos = r & 255; sckv = p.out + OUT_CKV + ((size_t)(s * 4 + layer) * 256 + pos) * 128 + sub * 32; }
#pragma unroll
        for (int i = 0; i < 4; ++i) { float o[8];
#pragma unroll
            for (int j = 0; j < 8; ++j) o[j] = k[i * 8 + j] * rk * gk[i * 8 + j];
            u32x4 w; w.x = pk2(o[0], o[1]); w.y = pk2(o[2], o[3]); w.z = pk2(o[4], o[5]); w.w = pk2(o[6], o[7]);
            *(LAS u32x4*)(CK + t * KS + sub * 32 + i * 8) = w;
            if (!lat) { *(f32x4*)(sckv + i * 8) = (f32x4){o[0], o[1], o[2], o[3]}; *(f32x4*)(sckv + i * 8 + 4) = (f32x4){o[4], o[5], o[6], o[7]}; } }
        { const bf16x8 v = *(const bf16x8*)(base + PC_KR + sub * 8); float x[8], o[8];
#pragma unroll
          for (int j = 0; j < 8; ++j) x[j] = bf1((bf16_t)v[j]);
          if (lat) { const int n = (r - M_CTX) & 4095; const int pos = (sub >> 1) == 0 ? (n >> 6) : (n & 63);
#pragma unroll
              for (int j = 0; j < 8; ++j) { const float pr = __shfl_xor(x[j], 1); const f32x2 cs = ROPE[pos * 8 + j]; o[j] = (sub & 1) == 0 ? x[j] * cs[0] - pr * cs[1] : x[j] * cs[0] + pr * cs[1]; } }
          else {
#pragma unroll
              for (int j = 0; j < 8; ++j) o[j] = x[j];
              const int s = r >> 8, pos = r & 255; float* skr = p.out + OUT_KR + ((size_t)(s * 4 + layer) * 256 + pos) * 32 + sub * 8;
              *(f32x4*)skr = (f32x4){o[0], o[1], o[2], o[3]}; *(f32x4*)(skr + 4) = (f32x4){o[4], o[5], o[6], o[7]}; }
          u32x4 w; w.x = pk2(o[0], o[1]); w.y = pk2(o[2], o[3]); w.z = pk2(o[4], o[5]); w.w = pk2(o[6], o[7]);
          *(u32x4*)(KR + (size_t)(keyrow0 + t) * 32 + sub * 8) = w; }
      } else {
        const int cu = u - 192, b = cu >> 1, half = cu & 1, row = half * 128 + t;
        const float* src = p.in[I_CCKV] + ((size_t)(b * 4 + layer) * 256 + row) * 128 + sub * 32;
#pragma unroll
        for (int i = 0; i < 4; ++i) { const f32x4 v0 = *(const f32x4*)(src + i * 8), v1 = *(const f32x4*)(src + i * 8 + 4);
            u32x4 w; w.x = pk2(v0[0], v0[1]); w.y = pk2(v0[2], v0[3]); w.z = pk2(v1[0], v1[1]); w.w = pk2(v1[2], v1[3]);
            *(LAS u32x4*)(CK + t * KS + sub * 32 + i * 8) = w; }
        const float* ksrc = p.in[I_CKR] + ((size_t)(b * 4 + layer) * 256 + row) * 32 + sub * 8;
        const f32x4 v0 = *(const f32x4*)ksrc, v1 = *(const f32x4*)(ksrc + 4);
        u32x4 w; w.x = pk2(v0[0], v0[1]); w.y = pk2(v0[2], v0[3]); w.z = pk2(v1[0], v1[1]); w.w = pk2(v1[2], v1[3]);
        *(u32x4*)(KR + (size_t)(keyrow0 + t) * 32 + sub * 8) = w;
      } }
    __syncthreads();
    const int l15 = C.lane & 15, hq = C.lane >> 4, w = C.wave;
    if (is_tok) {
        const bf16_t* Wq = (const bf16_t*)(C.wl(layer) + WL_UQ);
        bf16x8 aq[3][6];
#pragma unroll
        for (int j = 0; j < 3; ++j)
#pragma unroll
            for (int ks = 0; ks < 6; ++ks) aq[j][ks] = *(const bf16x8*)(Wq + (size_t)((3 * w + j) * 16 + l15) * 192 + ks * 32 + 8 * hq);
#pragma unroll 2
        for (int tt = 0; tt < 8; ++tt) {
            bf16x8 bq[6];
#pragma unroll
            for (int ks = 0; ks < 6; ++ks) bq[ks] = *(const LAS bf16x8*)(CQ + (tt * 16 + l15) * QS + ks * 32 + 8 * hq);
            const int r = r0 + tt * 16 + l15; const int n = (r - M_CTX) & 4095;
#pragma unroll
            for (int j = 0; j < 3; ++j) { const int nt = 3 * w + j; f32x4 acc = {0.f, 0.f, 0.f, 0.f};
#pragma unroll
                for (int ks = 0; ks < 6; ++ks) acc = mma16(aq[j][ks], bq[ks], acc);
                const int sub6 = nt % 6;
                if (lat && sub6 >= 4) { const int pos = sub6 == 4 ? (n >> 6) : (n & 63);
#pragma unroll
                    for (int jj = 0; jj < 4; ++jj) { const float pr = __shfl_xor(acc[jj], 32); const f32x2 cs = ROPE[pos * 8 + ((4 * hq + jj) & 7)]; acc[jj] = hq < 2 ? acc[jj] * cs[0] - pr * cs[1] : acc[jj] * cs[0] + pr * cs[1]; } }
                *(u32x2*)(Q + (size_t)r * 384 + nt * 16 + 4 * hq) = pk4(acc * QSCALE); }
        }
    }
    { const bf16_t* Wkv = (const bf16_t*)(C.wl(layer) + WL_UKV);
      bf16x8 wf[4][4];
#pragma unroll
      for (int j = 0; j < 4; ++j)
#pragma unroll
          for (int ks = 0; ks < 4; ++ks) wf[j][ks] = *(const bf16x8*)(Wkv + (size_t)((4 * w + j) * 16 + l15) * 128 + ks * 32 + 8 * hq);
      const int h = w >> 1; const bool isv = (w & 1) != 0;
#pragma unroll 2
      for (int tt = 0; tt < 8; ++tt) {
          bf16x8 ck[4];
#pragma unroll
          for (int ks = 0; ks < 4; ++ks) ck[ks] = *(const LAS bf16x8*)(CK + (tt * 16 + l15) * KS + ks * 32 + 8 * hq);
#pragma unroll
          for (int j = 0; j < 4; ++j) { f32x4 acc = {0.f, 0.f, 0.f, 0.f};
              if (!isv) {
#pragma unroll
                  for (int ks = 0; ks < 4; ++ks) acc = mma16(wf[j][ks], ck[ks], acc);
                  *(u32x2*)(KN + (size_t)(keyrow0 + tt * 16 + l15) * 256 + h * 64 + j * 16 + 4 * hq) = pk4(acc);
              } else {
#pragma unroll
                  for (int ks = 0; ks < 4; ++ks) acc = mma16(ck[ks], wf[j][ks], acc);
                  *(u32x2*)(VT + vtbase + (size_t)(h * 64 + j * 16 + l15) * nk + keypos0 + tt * 16 + 4 * hq) = pk4(acc);
              } } } }
    __syncthreads();
}

constexpr int AKS = 104, AVS = 72;
constexpr int ABUF = 64 * AKS * 2 + 64 * AVS * 2;
__device__ __forceinline__ int imax3(int a, int b, int c) { return max(a, max(b, c)); }
constexpr int AVS2 = 136; constexpr int ABUF2 = 128 * AKS * 2 + 64 * AVS2 * 2;
__device__ __forceinline__ void unit_attention(const Ctx& C, int u) {
    int rowbase, keyrow0, nk, h; size_t vtbase;
    if (u < 128) { const int s = u >> 2; h = u & 3; rowbase = s * 256; keyrow0 = s * 256; nk = 256; vtbase = (size_t)(s * 256) * 256; }
    else { const int v0 = u - 128; const int v = (C.G == 256) ? (((v0 & 7) * 2 + (v0 >> 7)) << 4) | ((v0 >> 3) & 15) : v0;
           const int b = v >> 6, qb = v & 15; h = (v >> 4) & 3; rowbase = M_CTX + b * 4096 + qb * 256; keyrow0 = M_CTX + b * 4352; nk = 4352; vtbase = (size_t)keyrow0 * 256; }
    const bf16_t* Q = (const bf16_t*)(C.ws + WS_Q); const bf16_t* KN = (const bf16_t*)(C.ws + WS_KN); const bf16_t* VT = (const bf16_t*)(C.ws + WS_VT); const bf16_t* KR = (const bf16_t*)(C.ws + WS_KR);
    bf16_t* MIX = (bf16_t*)(C.ws + WS_R1);
    const int l31 = C.lane & 31, hh = C.lane >> 5; const int qrow = rowbase + C.wave * 32 + l31;
    bf16x8 qf[6];
#pragma unroll
    for (int ks = 0; ks < 6; ++ks) qf[ks] = *(const bf16x8*)(Q + (size_t)qrow * 384 + h * 96 + ks * 16 + 8 * hh);
    f32x16 o0, o1, o2, negm;
#pragma unroll
    for (int i = 0; i < 16; ++i) { o0[i] = 0.f; o1[i] = 0.f; o2[i] = 0.f; negm[i] = 0.f; }
    const unsigned onew = (l31 == 0) ? 0x3F803F80u : 0u;
    const bf16x8 onesf = __builtin_bit_cast(bf16x8, (u32x4){onew, onew, onew, onew});
    const int skey = C.tid >> 3, sc8 = (C.tid & 7) * 8, rkey = (C.tid & 255) >> 2, rc8 = (C.tid & 3) * 8;
    const bf16_t* gkn = KN + (size_t)(keyrow0 + skey) * 256 + h * 64 + sc8;
    const bf16_t* gkr = KR + (size_t)(keyrow0 + rkey) * 32 + rc8;
    const bf16_t* gvt = VT + vtbase + (size_t)(h * 64 + skey) * nk + sc8;
    const bool do_r = C.tid < 256;
    const int lkn = (skey * AKS + sc8) * 2, lkr = (rkey * AKS + 64 + rc8) * 2, lvt = 128 * AKS * 2 + (skey * AVS2 + sc8) * 2;
    const int ntile = nk >> 7;
    u32x4 rk[2], rr[2] = {{0u, 0u, 0u, 0u}, {0u, 0u, 0u, 0u}}, rv[2];
#define ATT_LD(t) do { _Pragma("unroll") for (int s_ = 0; s_ < 2; ++s_) { rk[s_] = *(const u32x4*)(gkn + (size_t)(2 * (t) + s_) * 64 * 256); if (do_r) rr[s_] = *(const u32x4*)(gkr + (size_t)(2 * (t) + s_) * 64 * 32); rv[s_] = *(const u32x4*)(gvt + (2 * (t) + s_) * 64); } } while (0)
#define ATT_ST(buf) do { LAS unsigned char* b_ = C.lds + (buf) * ABUF2; _Pragma("unroll") for (int s_ = 0; s_ < 2; ++s_) { *(LAS u32x4*)(b_ + lkn + s_ * 64 * AKS * 2) = rk[s_]; if (do_r) *(LAS u32x4*)(b_ + lkr + s_ * 64 * AKS * 2) = rr[s_]; *(LAS u32x4*)(b_ + lvt + s_ * 128) = rv[s_]; } } while (0)
    ATT_LD(0); ATT_ST(0);
    __syncthreads();
#pragma unroll 1
    for (int kt = 0; kt < ntile; ++kt) {
        const bool more = kt + 1 < ntile;
        if (more) ATT_LD(kt + 1);
        LAS unsigned char* B = C.lds + (kt & 1) * ABUF2;
#pragma unroll 1
        for (int sub = 0; sub < 2; ++sub) {
        const LAS bf16_t* Kl = (const LAS bf16_t*)B + sub * 64 * AKS; const LAS bf16_t* Vl = (const LAS bf16_t*)(B + 128 * AKS * 2) + sub * 64;
        bf16x8 ka[2][6];
#pragma unroll
        for (int ks = 0; ks < 6; ++ks) { ka[0][ks] = *(const LAS bf16x8*)(Kl + l31 * AKS + ks * 16 + 8 * hh); ka[1][ks] = *(const LAS bf16x8*)(Kl + (32 + l31) * AKS + ks * 16 + 8 * hh); }
        __builtin_amdgcn_sched_barrier(0);
        f32x16 s0 = mma32(ka[0][0], qf[0], negm), s1 = mma32(ka[1][0], qf[0], negm);
#pragma unroll
        for (int ks = 1; ks < 6; ++ks) { s0 = mma32(ka[0][ks], qf[ks], s0); s1 = mma32(ka[1][ks], qf[ks], s1); }
        __builtin_amdgcn_sched_barrier(0);
        u32x2 vr[2][2][4];
#pragma unroll
        for (int t = 0; t < 2; ++t)
#pragma unroll
            for (int ss = 0; ss < 2; ++ss) { const int ko = 32 * t + 16 * ss + 4 * hh;
                vr[t][ss][0] = *(const LAS u32x2*)(Vl + l31 * AVS2 + ko); vr[t][ss][1] = *(const LAS u32x2*)(Vl + l31 * AVS2 + ko + 8);
                vr[t][ss][2] = *(const LAS u32x2*)(Vl + (32 + l31) * AVS2 + ko); vr[t][ss][3] = *(const LAS u32x2*)(Vl + (32 + l31) * AVS2 + ko + 8); }
        __builtin_amdgcn_sched_barrier(0);
        float d; bool resc;
        if (kt == 0 && sub == 0) {
            float mx = fmaxf(s0[0], s1[0]);
#pragma unroll
            for (int i = 1; i < 16; ++i) mx = fmaxf(mx, fmaxf(s0[i], s1[i]));
            d = fmaxf(mx, __shfl_xor(mx, 32)); resc = true;
        } else {
            int im = imax3(__builtin_bit_cast(int, s0[0]), __builtin_bit_cast(int, s1[0]), __builtin_bit_cast(int, s0[1]));
            im = imax3(im, __builtin_bit_cast(int, s1[1]), __builtin_bit_cast(int, s0[2])); im = imax3(im, __builtin_bit_cast(int, s1[2]), __builtin_bit_cast(int, s0[3]));
            im = imax3(im, __builtin_bit_cast(int, s1[3]), __builtin_bit_cast(int, s0[4])); im = imax3(im, __builtin_bit_cast(int, s1[4]), __builtin_bit_cast(int, s0[5]));
            im = imax3(im, __builtin_bit_cast(int, s1[5]), __builtin_bit_cast(int, s0[6])); im = imax3(im, __builtin_bit_cast(int, s1[6]), __builtin_bit_cast(int, s0[7]));
            im = imax3(im, __builtin_bit_cast(int, s1[7]), __builtin_bit_cast(int, s0[8])); im = imax3(im, __builtin_bit_cast(int, s1[8]), __builtin_bit_cast(int, s0[9]));
            im = imax3(im, __builtin_bit_cast(int, s1[9]), __builtin_bit_cast(int, s0[10])); im = imax3(im, __builtin_bit_cast(int, s1[10]), __builtin_bit_cast(int, s0[11]));
            im = imax3(im, __builtin_bit_cast(int, s1[11]), __builtin_bit_cast(int, s0[12])); im = imax3(im, __builtin_bit_cast(int, s1[12]), __builtin_bit_cast(int, s0[13]));
            im = imax3(im, __builtin_bit_cast(int, s1[13]), __builtin_bit_cast(int, s0[14])); im = imax3(im, __builtin_bit_cast(int, s1[14]), __builtin_bit_cast(int, s0[15]));
            im = max(im, __builtin_bit_cast(int, s1[15]));
            im = max(im, __shfl_xor(im, 32));
            resc = __builtin_amdgcn_ballot_w64(im > 0x41000000) != 0ull; d = im > 0x41000000 ? __builtin_bit_cast(float, im) : 0.f;
        }
        if (resc) {
            if (kt != 0 || sub != 0) { const float alpha = __builtin_amdgcn_exp2f(-d); o0 = o0 * alpha; o1 = o1 * alpha; o2 = o2 * alpha; }
            negm = negm - d; s0 = s0 - d; s1 = s1 - d;
        }
#pragma unroll
        for (int i = 0; i < 16; ++i) { s0[i] = __builtin_amdgcn_exp2f(s0[i]); s1[i] = __builtin_amdgcn_exp2f(s1[i]); }
#pragma unroll
        for (int t = 0; t < 2; ++t)
#pragma unroll
            for (int ss = 0; ss < 2; ++ss) {
                u32x4 w;
                if (t == 0) { w.x = pk2(s0[8 * ss + 0], s0[8 * ss + 1]); w.y = pk2(s0[8 * ss + 2], s0[8 * ss + 3]); w.z = pk2(s0[8 * ss + 4], s0[8 * ss + 5]); w.w = pk2(s0[8 * ss + 6], s0[8 * ss + 7]); }
                else { w.x = pk2(s1[8 * ss + 0], s1[8 * ss + 1]); w.y = pk2(s1[8 * ss + 2], s1[8 * ss + 3]); w.z = pk2(s1[8 * ss + 4], s1[8 * ss + 5]); w.w = pk2(s1[8 * ss + 6], s1[8 * ss + 7]); }
                const bf16x8 pf = __builtin_bit_cast(bf16x8, w);
                const bf16x8 va = __builtin_bit_cast(bf16x8, (u32x4){vr[t][ss][0].x, vr[t][ss][0].y, vr[t][ss][1].x, vr[t][ss][1].y}), vb = __builtin_bit_cast(bf16x8, (u32x4){vr[t][ss][2].x, vr[t][ss][2].y, vr[t][ss][3].x, vr[t][ss][3].y});
                o0 = mma32(va, pf, o0); o1 = mma32(vb, pf, o1); o2 = mma32(onesf, pf, o2);
            }
        }
        if (more) ATT_ST((kt + 1) & 1);
        __syncthreads();
    }
#undef ATT_LD
#undef ATT_ST
    const float lsum = o2[0] + __shfl_xor(o2[0], 32);
    const float inv = 1.f / lsum;
    bf16_t* orow = MIX + (size_t)qrow * D + 768 + h * 64;
#pragma unroll
    for (int i = 0; i < 4; ++i) { const int dv = 8 * i + 4 * hh;
        *(u32x2*)(orow + dv) = pk4((f32x4){o0[4 * i] * inv, o0[4 * i + 1] * inv, o0[4 * i + 2] * inv, o0[4 * i + 3] * inv});
        *(u32x2*)(orow + 32 + dv) = pk4((f32x4){o1[4 * i] * inv, o1[4 * i + 1] * inv, o1[4 * i + 2] * inv, o1[4 * i + 3] * inv}); }
}

#define XB_TMO      128
#define XB_XCNT(j)  (256  + 64 * (j))
#define XB_XSUB(j)  (1280 + 64 * (j))
#define XB_XGEN(j)  (2304 + 64 * (j))
#define XB_TOP      3328
#define XB_TOPGEN   3392
#define XCD_BAR_WORDS 3456
#define XB_SPIN_CAP (1u << 18)

__device__ __forceinline__ unsigned xb_ld(unsigned* p)              { return __hip_atomic_load(p, __ATOMIC_RELAXED, __HIP_MEMORY_SCOPE_AGENT); }
__device__ __forceinline__ unsigned xb_add(unsigned* p, unsigned v) { return __hip_atomic_fetch_add(p, v, __ATOMIC_RELAXED, __HIP_MEMORY_SCOPE_AGENT); }
__device__ __forceinline__ unsigned xb_xcc_id() { return (unsigned)__builtin_amdgcn_s_getreg((3 << 11) | 20) & 0xFu; }
#define XB_SPIN(cond, bar) do { unsigned _sp = 0; while (cond) { __builtin_amdgcn_s_sleep(1); \
    if ((++_sp & 255u) == 0u) { if (xb_ld(&(bar)[XB_TMO])) break; if (_sp > XB_SPIN_CAP) { atomicAdd(&(bar)[XB_TMO], 1u); break; } } } } while (0)

struct XcdBarrier {
    unsigned* bar; unsigned x;
    volatile LAS unsigned* st;
};

__device__ __forceinline__ XcdBarrier xcd_barrier_post(unsigned* bar, volatile LAS unsigned* st) {
    XcdBarrier b; b.bar = bar; b.x = xb_xcc_id(); b.st = st;
    if (threadIdx.x == 0) (void)xb_add(&bar[XB_XCNT(b.x)], 1u);
    return b;
}
__device__ __forceinline__ void xcd_barrier_complete(unsigned* bar, unsigned x, unsigned& nloc, unsigned& nx) {
    const unsigned G = gridDim.x * gridDim.y * gridDim.z;
    unsigned sum, cnt, mine, sp = 0u;
    for (;;) {
        sum = 0u; cnt = 0u; mine = 0u;
#pragma unroll
        for (unsigned j = 0; j < 16; ++j) { const unsigned c = xb_ld(&bar[XB_XCNT(j)]); sum += c; cnt += (c > 0u) ? 1u : 0u; mine = (j == x) ? c : mine; }
        if (sum == G) break;
        __builtin_amdgcn_s_sleep(1);
        if ((++sp & 255u) == 0u) { if (xb_ld(&bar[XB_TMO])) break; if (sp > XB_SPIN_CAP) { atomicAdd(&bar[XB_TMO], 1u); break; } }
    }
    nloc = mine > 0u ? mine : 1u; nx = cnt > 0u ? cnt : 1u;
}

__device__ __forceinline__ void xcd_barrier(const XcdBarrier& b) {
    asm volatile("s_waitcnt vmcnt(0)" ::: "memory");
    __syncthreads();
    if (threadIdx.x == 0) {
        unsigned* bar = b.bar;
        __builtin_amdgcn_s_waitcnt(0);
        unsigned nloc = b.st[0], nx = b.st[1];
        if (nloc == 0u) { xcd_barrier_complete(bar, b.x, nloc, nx); b.st[0] = nloc; b.st[1] = nx; }
        const unsigned old = xb_add(&bar[XB_XSUB(b.x)], 1u);
        const unsigned gen = old / nloc;
        if (old + 1u == (gen + 1u) * nloc) {
            __builtin_amdgcn_fence(__ATOMIC_RELEASE, "agent");
            asm volatile("s_waitcnt vmcnt(0)" ::: "memory");
            const unsigned og = xb_add(&bar[XB_TOP], 1u);
            const unsigned tg = og / nx;
            if (og + 1u == (tg + 1u) * nx) xb_add(&bar[XB_TOPGEN], 1u);
            else XB_SPIN(xb_ld(&bar[XB_TOPGEN]) == tg, bar);
            __builtin_amdgcn_fence(__ATOMIC_ACQUIRE, "agent");
            xb_add(&bar[XB_XGEN(b.x)], 1u);
            asm volatile("s_waitcnt vmcnt(0)" ::: "memory");
        } else {
            XB_SPIN(xb_ld(&bar[XB_XGEN(b.x)]) == gen, bar);
            __builtin_amdgcn_fence(__ATOMIC_ACQUIRE, "agent");
            asm volatile("s_waitcnt vmcnt(0)" ::: "memory");
        }
    }
    __syncthreads();
}

__global__ void __launch_bounds__(NTHREADS, 2) mk_fwd(Params p) {
    extern __shared__ __attribute__((aligned(16))) unsigned char lds_raw[];
    cg::grid_group grid = cg::this_grid();
    Ctx C; C.p = p; C.lds = (LAS unsigned char*)lds_raw; C.tid = threadIdx.x; C.lane = C.tid & 63; C.wave = __builtin_amdgcn_readfirstlane(C.tid >> 6); C.bid = blockIdx.x; C.G = gridDim.x; C.ws = p.ws;

    volatile LAS unsigned* bst = (volatile LAS unsigned*)(C.lds + LDS_BYTES - 64);
    if (threadIdx.x < 2) bst[threadIdx.x] = 0u;
    __syncthreads();
    const XcdBarrier bar = xcd_barrier_post((unsigned*)(p.ws + WS_BAR), bst);
    C.refresh(); phase_prologue(C);
    if (p.ws == nullptr) grid.sync();
    xcd_barrier(bar);
    C.refresh(); phase_norm0(C);
    xcd_barrier(bar);
#pragma unroll 1
    for (int layer = 0; layer < DEPTH; ++layer) {
        { C.refresh(); bf16_t* R1 = (bf16_t*)(C.ws + WS_R1); bf16_t* R2 = (bf16_t*)(C.ws + WS_R2); unsigned char* wl = C.wl(layer); pg8::Gemm g{R1, (const bf16_t*)(wl + WL_IN), M, NPP, D}; pg8::StaticOrder S; S.init(M, NPP, C.G, C.bid); pg8::EpiStore E{R2, NP, NP};
          pg8::gemm_phase<pg8::EpiStore, pg8::StaticOrder, true, true>(C.lds, g, S, E); }
        xcd_barrier(bar);
        C.refresh();
        for (int u = C.bid; u < 768 + 192 + 128 + 128 + 200; u += C.G) {
            C.refresh();
            if (u < 768) unit_chunk_mlp(C, layer, u);
            else if (u < 960) unit_conv(C, layer, u - 768);
            else if (u < 1088) unit_fourier_ctx(C, u - 960);
            else if (u < 1216) unit_fourier_lat1(C, u - 1088);
            else unit_mla_prep(C, layer, u - 1216);
        }
        xcd_barrier(bar);
        C.refresh();
        for (int u = C.bid; u < 512; u += C.G) {
            C.refresh();
            if (u < 256) unit_attention(C, 128 + u);
            else if (u < 384) unit_attention(C, u - 256);
            else unit_fourier_lat2(C, u - 384);
        }
        xcd_barrier(bar);
        { C.refresh(); bf16_t* R1 = (bf16_t*)(C.ws + WS_R1); bf16_t* R2 = (bf16_t*)(C.ws + WS_R2); unsigned char* wl = C.wl(layer); pg8::Gemm g{R1, (const bf16_t*)(wl + WL_OUT), M, D, D}; pg8::SplitTailOrder S; S.init(D, C.G, C.bid); pg8::EpiStoreSplit E{R2, R2 + (size_t)M * D - (size_t)SPLIT_ROW0 * D, D};
          pg8::gemm_phase<pg8::EpiStoreSplit, pg8::SplitTailOrder, true, true>(C.lds, g, S, E); }
        xcd_barrier(bar);
        C.refresh(); phase_post<0>(C, layer);
        xcd_barrier(bar);
        { C.refresh(); bf16_t* R1 = (bf16_t*)(C.ws + WS_R1); bf16_t* R2 = (bf16_t*)(C.ws + WS_R2); unsigned char* wl = C.wl(layer); pg8::Gemm g{R1, (const bf16_t*)(wl + WL_GU), M, 2 * FF, D}; pg8::StaticOrder S; S.init(M, 2 * FF, C.G, C.bid); pg8::EpiSwiGLU E{R2, FF};
          pg8::gemm_phase<pg8::EpiSwiGLU, pg8::StaticOrder, true, true>(C.lds, g, S, E);
          if (C.G == 256 && layer + 1 < DEPTH && C.bid >= 64) { C.refresh(); transpose_items(C, (layer + 1) * TI_L + (C.bid - 64), 192, (layer + 2) * TI_L); } }
        xcd_barrier(bar);
        { C.refresh(); bf16_t* R2 = (bf16_t*)(C.ws + WS_R2); bf16_t* R3 = (bf16_t*)(C.ws + WS_MLA); unsigned char* wl = C.wl(layer); pg8::Gemm g{R2, (const bf16_t*)(wl + WL_DN), M, D, FF}; pg8::SplitTailOrder S; S.init(FF, C.G, C.bid); pg8::EpiStoreSplit E{R3, R3 + (size_t)M * D - (size_t)SPLIT_ROW0 * D, D};
          pg8::gemm_phase<pg8::EpiStoreSplit, pg8::SplitTailOrder, true, true>(C.lds, g, S, E); }
        xcd_barrier(bar);
        C.refresh(); phase_post<1>(C, layer);
        if (layer + 1 < DEPTH) xcd_barrier(bar);
    }
}

extern "C" void kernel_launch(void* const* d_in, const int* in_sizes, int n_in, void* d_out, int out_size, void* d_ws, size_t ws_size, hipStream_t stream) {
    static int grid = 0;
    if (grid == 0) {
        if (n_in != 24 || ws_size < WS_END) { fprintf(stderr, "kernel_launch: need 24 inputs and %zu bytes of workspace; got %d, %zu\n", (size_t)WS_END, n_in, ws_size); grid = -1; return; }
        int dev = 0, cus = 0, per_cu = 0;
        if (hipGetDevice(&dev) != hipSuccess || hipDeviceGetAttribute(&cus, hipDeviceAttributeMultiprocessorCount, dev) != hipSuccess) { grid = -1; return; }
        if (hipFuncSetAttribute((const void*)mk_fwd, hipFuncAttributeMaxDynamicSharedMemorySize, LDS_BYTES) != hipSuccess) { fprintf(stderr, "kernel_launch: hipFuncSetAttribute failed\n"); grid = -1; return; }
        if (hipOccupancyMaxActiveBlocksPerMultiprocessor(&per_cu, (const void*)mk_fwd, NTHREADS, LDS_BYTES) != hipSuccess || per_cu < 1) fprintf(stderr, "kernel_launch: occupancy query says %d blocks per CU\n", per_cu);
        (void)hipGetLastError();
        grid = cus;
    }
    if (grid < 0) return;
    Params p{};
    for (int i = 0; i < 24; ++i) p.in[i] = (const float*)d_in[i];
    p.out = (float*)d_out; p.ws = (unsigned char*)d_ws;
    if (hipMemsetAsync((char*)d_ws + WS_BAR, 0, WS_BAR_BYTES, stream) != hipSuccess) { fprintf(stderr, "kernel_launch: memset failed\n"); return; }
    void* args[] = {&p};
    hipError_t e = hipLaunchCooperativeKernel((const void*)mk_fwd, dim3(grid), dim3(NTHREADS), args, LDS_BYTES, stream);
    if (e != hipSuccess) fprintf(stderr, "kernel_launch: cooperative launch failed: %s (grid %d)\n", hipGetErrorString(e), grid);
}
```

```cpp
#include <hip/hip_runtime.h>
#include <hip/hip_cooperative_groups.h>
#include <cstdio>
#include <cstdint>
namespace cg = cooperative_groups;
namespace pg8 {
#define PG8_LAS __attribute__((address_space(3)))
typedef unsigned short bf16_t;
typedef short bf16x8 __attribute__((ext_vector_type(8)));
typedef float f32x4 __attribute__((ext_vector_type(4)));
typedef unsigned u32x4 __attribute__((ext_vector_type(4)));
constexpr int BM = 256, BK = 64, HALF = 128, HTB = HALF * BK * 2  , STAGE_BYTES = 8 * HTB, NXCD = 8, WGM = 8;

__host__ __device__ __forceinline__ int lds_byte(int r, int c) { const int st = (r >> 4) * 2 + (c >> 5), rr = r & 15, cc = c & 31, ob = rr * 64 + cc * 2; return st * 1024 + (ob ^ (((ob >> 9) & 1) << 5)); }
__host__ __device__ __forceinline__ void stage_rc(int b, int& R, int& C) { const int st = b / 1024, sb = b % 1024, swz = sb ^ (((sb >> 9) & 1) << 5); R = (st >> 1) * 16 + swz / 64; C = (st & 1) * 32 + (swz % 64) / 2; }
__host__ __device__ __forceinline__ int perm32(int rho) { const int n = rho >> 4, i = rho & 15; return 8 * (i >> 2) + 4 * n + (i & 3); }

struct Unit { int pm, pn; int kh, nt, koff; };
struct Gemm { const bf16_t* A; const bf16_t* Bt; int M, N, K; };

struct StaticOrder {
    int nM, nN, nwg, G, c;
    __host__ __device__ void init(int M, int N, int G_, int c_) { nM = M / BM; nN = N / BM; nwg = nM * nN; G = G_; c = c_; }
    __host__ __device__ bool next(int i, Unit& u) const {
        const long L = (long)i * G + c; if (L >= nwg) return false;
        int wgid = (int)L; { const int q = nwg / NXCD, r = nwg % NXCD, xcd = wgid % NXCD, off = wgid / NXCD; wgid = (xcd < r ? xcd * (q + 1) : r * (q + 1) + (xcd - r) * q) + off; }
        const int nig = WGM * nN, gid = wgid / nig, fm = gid * WGM, gsz = (nM - fm) < WGM ? (nM - fm) : WGM;
        u.pm = fm + ((wgid % nig) % gsz); u.pn = (wgid % nig) / gsz; u.kh = 0; u.nt = 0; u.koff = 0; return true;
    }
    __device__ __forceinline__ void a_ready(const Unit&) const {}
    __device__ __forceinline__ void done(const Unit&) const {}
};

__device__ __forceinline__ unsigned cvt_pk_bf16(float lo, float hi) { unsigned r; asm volatile("v_cvt_pk_bf16_f32 %0, %1, %2" : "=v"(r) : "v"(lo), "v"(hi)); return r; }
typedef float f32x2 __attribute__((ext_vector_type(2)));
struct EpiStore {
    static constexpr bool PERM = true, AFTER_DRAIN = false;
    bf16_t* O; int ldc; int ncols;
    __device__ __forceinline__ void operator()(const f32x4 (&acc)[2][2][4][2], const Unit& u, int wr, int wc, int fr, int fq) const {
        const int row0 = u.pm * BM + wr * 64 + fr; const int col0 = u.pn * BM + wc * 32 + 8 * fq;
#pragma unroll
        for (int ai = 0; ai < 2; ++ai)
#pragma unroll
            for (int m = 0; m < 4; ++m) { bf16_t* rowp = O + (size_t)(row0 + ai * HALF + m * 16) * ldc + col0;
#pragma unroll
                for (int bj = 0; bj < 2; ++bj) { const f32x4 v0 = acc[ai][bj][m][0], v1 = acc[ai][bj][m][1];
                    u32x4 w; w.x = cvt_pk_bf16(v0[0], v0[1]); w.y = cvt_pk_bf16(v0[2], v0[3]); w.z = cvt_pk_bf16(v1[0], v1[1]); w.w = cvt_pk_bf16(v1[2], v1[3]);
                    if (col0 + bj * HALF < ncols) *(u32x4*)(rowp + bj * HALF) = w; } }
    }
};
struct EpiStoreWT {
    static constexpr bool PERM = true, AFTER_DRAIN = false;
    bf16_t* O; int ldc; int ncols;
    __device__ __forceinline__ void operator()(const f32x4 (&acc)[2][2][4][2], const Unit& u, int wr, int wc, int fr, int fq) const {
        const int row0 = u.pm * BM + wr * 64 + fr; const int col0 = u.pn * BM + wc * 32 + 8 * fq;
#pragma unroll
        for (int ai = 0; ai < 2; ++ai)
#pragma unroll
            for (int m = 0; m < 4; ++m) { bf16_t* rowp = O + (size_t)(row0 + ai * HALF + m * 16) * ldc + col0;
#pragma unroll
                for (int bj = 0; bj < 2; ++bj) { const f32x4 v0 = acc[ai][bj][m][0], v1 = acc[ai][bj][m][1];
                    const unsigned long long lo = (unsigned long long)cvt_pk_bf16(v0[0], v0[1]) | ((unsigned long long)cvt_pk_bf16(v0[2], v0[3]) << 32);
                    const unsigned long long hi = (unsigned long long)cvt_pk_bf16(v1[0], v1[1]) | ((unsigned long long)cvt_pk_bf16(v1[2], v1[3]) << 32);
                    unsigned long long* q = (unsigned long long*)(rowp + bj * HALF);
                    __hip_atomic_store(q, lo, __ATOMIC_RELAXED, __HIP_MEMORY_SCOPE_AGENT); __hip_atomic_store(q + 1, hi, __ATOMIC_RELAXED, __HIP_MEMORY_SCOPE_AGENT); } }
    }
};
__device__ __forceinline__ float silu_mul(float g, float u) { return g * u * __builtin_amdgcn_rcpf(1.f + __expf(-g)); }
struct EpiSwiGLU {
    static constexpr bool PERM = true, AFTER_DRAIN = false;
    bf16_t* O; int ldc;
    __device__ __forceinline__ void operator()(const f32x4 (&acc)[2][2][4][2], const Unit& u, int wr, int wc, int fr, int fq) const {
        const int row0 = u.pm * BM + wr * 64 + fr; const int col0 = u.pn * HALF + wc * 32 + 8 * fq;
#pragma unroll
        for (int ai = 0; ai < 2; ++ai)
#pragma unroll
            for (int m = 0; m < 4; ++m) { bf16_t* rowp = O + (size_t)(row0 + ai * HALF + m * 16) * ldc + col0;
                const f32x4 g0 = acc[ai][0][m][0], g1 = acc[ai][0][m][1], u0 = acc[ai][1][m][0], u1 = acc[ai][1][m][1];
                u32x4 w; w.x = cvt_pk_bf16(silu_mul(g0[0], u0[0]), silu_mul(g0[1], u0[1])); w.y = cvt_pk_bf16(silu_mul(g0[2], u0[2]), silu_mul(g0[3], u0[3]));
                w.z = cvt_pk_bf16(silu_mul(g1[0], u1[0]), silu_mul(g1[1], u1[1])); w.w = cvt_pk_bf16(silu_mul(g1[2], u1[2]), silu_mul(g1[3], u1[3]));
                *(u32x4*)rowp = w; }
    }
};

struct PanelOrder {
    int nN, nwg, G, c; unsigned* cnt;
    __device__ void init(int M, int N, int G_, int c_, unsigned* cnt_) { nN = N / BM; nwg = (M / BM) * nN; G = G_; c = c_; cnt = cnt_; }
    __device__ bool next(int i, Unit& u) const { const long L = (long)i * G + c; if (L >= nwg) return false; u.pm = (int)L / nN; u.pn = (int)L % nN; u.kh = 0; u.nt = 0; u.koff = 0; return true; }
    __device__ __forceinline__ void a_ready(const Unit&) const {}
    __device__ __forceinline__ void done(const Unit& u) const {
        asm volatile("s_waitcnt vmcnt(0)" ::: "memory");
        if ((threadIdx.x & 63) == 0) __hip_atomic_fetch_add(cnt + u.pm, 1u, __ATOMIC_RELAXED, __HIP_MEMORY_SCOPE_AGENT);
    }
};

struct SplitTailOrder {
    int G, c, ntf; bool split;
    __device__ void init(int K, int G_, int c_) { G = G_; c = c_; ntf = K / BK; split = (G_ == 256); }
    __device__ bool next(int i, Unit& u) const {
        if (!split) { const long L = (long)i * G + c; if (L >= 384) return false; u.pm = (int)L >> 2; u.pn = (int)L & 3; u.kh = 0; u.nt = 0; u.koff = 0; return true; }
        if (i == 0) { const int t = (c & 7) * 32 + (c >> 3); u.pm = t >> 2; u.pn = t & 3; u.kh = 0; u.nt = 0; u.koff = 0; return true; }
        if (i == 1) { const int t = 256 + (c & 7) * 16 + (c >> 4); u.pm = t >> 2; u.pn = t & 3; u.kh = (c >> 3) & 1; u.nt = ntf / 2; u.koff = u.kh * (ntf / 2) * BK * 2; return true; }
        return false;
    }
    __device__ __forceinline__ void a_ready(const Unit&) const {}
    __device__ __forceinline__ void done(const Unit&) const {}
};
struct EpiStoreSplit {
    static constexpr bool PERM = true, AFTER_DRAIN = false;
    bf16_t* O; bf16_t* O1; int ldc;
    __device__ __forceinline__ void operator()(const f32x4 (&acc)[2][2][4][2], const Unit& u, int wr, int wc, int fr, int fq) const {
        const int row0 = u.pm * BM + wr * 64 + fr; const int col0 = u.pn * BM + wc * 32 + 8 * fq; bf16_t* base = u.kh ? O1 : O;
#pragma unroll
        for (int ai = 0; ai < 2; ++ai)
#pragma unroll
            for (int m = 0; m < 4; ++m) { bf16_t* rowp = base + (size_t)(row0 + ai * HALF + m * 16) * ldc + col0;
#pragma unroll
                for (int bj = 0; bj < 2; ++bj) { const f32x4 v0 = acc[ai][bj][m][0], v1 = acc[ai][bj][m][1];
                    u32x4 w; w.x = cvt_pk_bf16(v0[0], v0[1]); w.y = cvt_pk_bf16(v0[2], v0[3]); w.z = cvt_pk_bf16(v1[0], v1[1]); w.w = cvt_pk_bf16(v1[2], v1[3]);
                    *(u32x4*)(rowp + bj * HALF) = w; } }
    }
};
template <class Epi, class Sched, bool ALIGN_EPI = false, bool SP2 = false>
__device__ __forceinline__ void gemm_phase(PG8_LAS unsigned char* lds, const Gemm g, const Sched& S, const Epi& E) {
    int tid_ = threadIdx.x; asm volatile("" : "+v"(tid_));
    const int tid = tid_, wid = __builtin_amdgcn_readfirstlane(tid >> 6), lane = tid & 63, wr = wid >> 2, wc = wid & 3, fr = lane & 15, fq = lane >> 4;
    const int K = g.K, nt = K / BK;
    unsigned voffA[2], voffB[2];
#pragma unroll
    for (int i = 0; i < 2; ++i) { int R, C; stage_rc(tid * 16 + i * 8192, R, C); const int Rb = Epi::PERM ? ((R & ~31) + perm32(R & 31)) : R;
        voffA[i] = (unsigned)(R * K + C) * 2u; voffB[i] = (unsigned)(Rb * K + C) * 2u; }
    const size_t kstep = (size_t)(BK * 2);
    const size_t hstep = (size_t)HALF * K * 2;
    const size_t tstep = 2 * hstep;
    const unsigned ldsw = (unsigned)wid * 1024u;
    const int aoff = lds_byte(wr * 64 + fr, fq * 8), boff = lds_byte(wc * 32 + fr, fq * 8);
#define PG8_SA(b, h) (((b) * 2 + (h)) * HTB)
#define PG8_SB(b, h) ((4 + (b) * 2 + (h)) * HTB)
#define PG8_STAGE(bufoff, gbase, voff) do { _Pragma("unroll") for (int _i = 0; _i < 2; ++_i) \
        __builtin_amdgcn_global_load_lds((const unsigned*)((const char*)(gbase) + (voff)[_i]), (PG8_LAS unsigned*)(lds + (bufoff) + ldsw + _i * 8192), 16, 0, 0); } while (0)
#define PG8_LDA(dst, b, h) do { _Pragma("unroll") for (int m = 0; m < 4; ++m) _Pragma("unroll") for (int k = 0; k < 2; ++k) dst[m][k] = *(const PG8_LAS bf16x8*)(lds + PG8_SA(b, h) + aoff + m * 2048 + k * 1024); } while (0)
#define PG8_LDB(dst, b, h) do { _Pragma("unroll") for (int n = 0; n < 2; ++n) _Pragma("unroll") for (int k = 0; k < 2; ++k) dst[n][k] = *(const PG8_LAS bf16x8*)(lds + PG8_SB(b, h) + boff + n * 2048 + k * 1024); } while (0)
#define PG8_MMA(ai, bj, At, Bt) do { __builtin_amdgcn_s_setprio(1); _Pragma("unroll") for (int m = 0; m < 4; ++m) _Pragma("unroll") for (int n = 0; n < 2; ++n) _Pragma("unroll") for (int k = 0; k < 2; ++k) \
        acc[ai][bj][m][n] = __builtin_amdgcn_mfma_f32_16x16x32_bf16(Bt[n][k], At[m][k], acc[ai][bj][m][n], 0, 0, 0); __builtin_amdgcn_s_setprio(0); } while (0)
#define PG8_WAIT_V(n) asm volatile("s_waitcnt vmcnt(" #n ")" ::: "memory")
#define PG8_WAIT_L(n) asm volatile("s_waitcnt lgkmcnt(" #n ")" ::: "memory")
#define PG8_BAR __builtin_amdgcn_s_barrier()
#define PG8_SCHED __builtin_amdgcn_sched_barrier(0)
    Unit cur, nxt; int ui = 0;
    if (!S.next(0, cur)) return;
    f32x4 acc[2][2][4][2];
#pragma unroll
    for (int a = 0; a < 2; ++a)
#pragma unroll
        for (int b = 0; b < 2; ++b)
#pragma unroll
            for (int m = 0; m < 4; ++m)
#pragma unroll
                for (int n = 0; n < 2; ++n) acc[a][b][m][n] = (f32x4){0.f, 0.f, 0.f, 0.f};
    bf16x8 At[4][2], B0[2][2], B1[2][2];
    const char* cA = (const char*)g.A + (size_t)cur.pm * tstep + cur.koff; const char* cB = (const char*)g.Bt + (size_t)cur.pn * tstep + cur.koff;
    S.a_ready(cur);
    if constexpr (SP2) {
        PG8_STAGE(PG8_SB(0, 0), cB, voffB); PG8_STAGE(PG8_SB(0, 1), cB + hstep, voffB); PG8_STAGE(PG8_SA(0, 0), cA, voffA); PG8_STAGE(PG8_SA(0, 1), cA + hstep, voffA);
        if (wr == 1) PG8_BAR;
        PG8_WAIT_V(2); PG8_BAR;
        PG8_STAGE(PG8_SB(1, 0), cB + kstep, voffB); PG8_STAGE(PG8_SA(1, 0), cA + kstep, voffA); PG8_STAGE(PG8_SB(1, 1), cB + hstep + kstep, voffB);
        PG8_WAIT_V(6); PG8_BAR;
    } else {
        PG8_STAGE(PG8_SB(0, 0), cB, voffB); PG8_STAGE(PG8_SA(0, 0), cA, voffA); PG8_STAGE(PG8_SB(0, 1), cB + hstep, voffB); PG8_STAGE(PG8_SA(0, 1), cA + hstep, voffA);
        if (wr == 1) PG8_BAR;
        PG8_WAIT_V(4); PG8_BAR;
        PG8_STAGE(PG8_SB(1, 0), cB + kstep, voffB); PG8_STAGE(PG8_SA(1, 0), cA + kstep, voffA); PG8_STAGE(PG8_SB(1, 1), cB + hstep + kstep, voffB);
        PG8_WAIT_V(6); PG8_BAR;
    }
    for (;;) {
        const bool has_next = S.next(ui + 1, nxt);
        const char* nA = has_next ? (const char*)g.A + (size_t)nxt.pm * tstep + nxt.koff : cA; const char* nB = has_next ? (const char*)g.Bt + (size_t)nxt.pn * tstep + nxt.koff : cB;
        const int ntc = cur.nt ? cur.nt : nt;
        for (int t = 0; t < ntc; t += 2) {
            const bool last = (t == ntc - 2);
            const char* a1 = cA + (size_t)(t + 1) * kstep;
            const char* a2 = last ? nA : cA + (size_t)(t + 2) * kstep; const char* b2 = last ? nB : cB + (size_t)(t + 2) * kstep;
            const char* a3 = a2 + kstep; const char* b3 = b2 + kstep;
            if (last && has_next) S.a_ready(nxt);
            if constexpr (SP2) {
            PG8_LDB(B0, 0, 0); PG8_LDB(B1, 0, 1); PG8_SCHED; PG8_LDA(At, 0, 0); PG8_STAGE(PG8_SA(1, 1), a1 + hstep, voffA);
            PG8_WAIT_V(8); PG8_WAIT_L(0); PG8_BAR; PG8_MMA(0, 0, At, B0); PG8_MMA(0, 1, At, B1); PG8_BAR; PG8_SCHED;
            PG8_LDA(At, 0, 1); PG8_STAGE(PG8_SB(0, 0), b2, voffB); PG8_STAGE(PG8_SB(0, 1), b2 + hstep, voffB); PG8_STAGE(PG8_SA(0, 0), a2, voffA);
            PG8_WAIT_V(8); PG8_WAIT_L(0); PG8_BAR; PG8_MMA(1, 0, At, B0); PG8_MMA(1, 1, At, B1); PG8_BAR; PG8_SCHED;
            PG8_LDB(B0, 1, 0); PG8_LDB(B1, 1, 1); PG8_SCHED; PG8_LDA(At, 1, 0); PG8_STAGE(PG8_SA(0, 1), a2 + hstep, voffA);
            PG8_WAIT_V(8); PG8_WAIT_L(0); PG8_BAR; PG8_MMA(0, 0, At, B0); PG8_MMA(0, 1, At, B1); PG8_BAR; PG8_SCHED;
            PG8_LDA(At, 1, 1); PG8_STAGE(PG8_SB(1, 0), b3, voffB); PG8_STAGE(PG8_SB(1, 1), b3 + hstep, voffB); PG8_STAGE(PG8_SA(1, 0), a3, voffA);
            PG8_WAIT_V(8); PG8_WAIT_L(0); PG8_BAR; PG8_MMA(1, 0, At, B0); PG8_MMA(1, 1, At, B1); PG8_BAR; PG8_SCHED;
            } else {
            PG8_LDB(B0, 0, 0); PG8_SCHED; PG8_LDA(At, 0, 0); PG8_STAGE(PG8_SA(1, 1), a1 + hstep, voffA);
            PG8_WAIT_L(8); PG8_BAR; PG8_WAIT_L(0); PG8_MMA(0, 0, At, B0); PG8_BAR; PG8_SCHED;
            PG8_LDB(B1, 0, 1); PG8_STAGE(PG8_SB(0, 0), b2, voffB);
            PG8_BAR; PG8_WAIT_L(0); PG8_MMA(0, 1, At, B1); PG8_BAR;
            PG8_LDA(At, 0, 1); PG8_STAGE(PG8_SA(0, 0), a2, voffA);
            PG8_BAR; PG8_WAIT_L(0); PG8_MMA(1, 0, At, B0); PG8_BAR; PG8_SCHED;
            PG8_STAGE(PG8_SB(0, 1), b2 + hstep, voffB);
            PG8_WAIT_V(6); PG8_BAR; PG8_MMA(1, 1, At, B1); PG8_BAR;
            PG8_LDB(B0, 1, 0); PG8_SCHED; PG8_LDA(At, 1, 0); PG8_STAGE(PG8_SA(0, 1), a2 + hstep, voffA);
            PG8_WAIT_L(8); PG8_BAR; PG8_WAIT_L(0); PG8_MMA(0, 0, At, B0); PG8_BAR; PG8_SCHED;
            PG8_LDB(B1, 1, 1); PG8_STAGE(PG8_SB(1, 0), b3, voffB);
            PG8_BAR; PG8_WAIT_L(0); PG8_MMA(0, 1, At, B1); PG8_BAR;
            PG8_LDA(At, 1, 1); PG8_STAGE(PG8_SA(1, 0), a3, voffA);
            PG8_BAR; PG8_WAIT_L(0); PG8_MMA(1, 0, At, B0); PG8_BAR; PG8_SCHED;
            PG8_STAGE(PG8_SB(1, 1), b3 + hstep, voffB);
            PG8_WAIT_V(6); PG8_BAR; PG8_MMA(1, 1, At, B1); PG8_BAR;
            }
        }
        if constexpr (ALIGN_EPI) { if (wr == 0) PG8_BAR; }
        if constexpr (!Epi::AFTER_DRAIN) { E(acc, cur, wr, wc, fr, fq); S.done(cur); }
        if (!has_next) break;
#pragma unroll
        for (int a = 0; a < 2; ++a)
#pragma unroll
            for (int b = 0; b < 2; ++b)
#pragma unroll
                for (int m = 0; m < 4; ++m)
#pragma unroll
                    for (int n = 0; n < 2; ++n) acc[a][b][m][n] = (f32x4){0.f, 0.f, 0.f, 0.f};
        cur = nxt; cA = nA; cB = nB; ++ui;
        if constexpr (ALIGN_EPI) { if (wr == 1) PG8_BAR; }
    }
    PG8_WAIT_V(0);
    if constexpr (!ALIGN_EPI) { if (wr == 0) PG8_BAR; }
    PG8_BAR;
    if constexpr (Epi::AFTER_DRAIN) { E.fused(acc, cur, wr, wc, fr, fq, lds, wid, lane); S.done(cur); }
#undef PG8_SA
#undef PG8_SB
#undef PG8_STAGE
#undef PG8_LDA
#undef PG8_LDB
#undef PG8_MMA
#undef PG8_WAIT_V
#undef PG8_WAIT_L
#undef PG8_BAR
#undef PG8_SCHED
}
}
#define LAS __attribute__((address_space(3)))
typedef unsigned short bf16_t;
typedef short bf16x8 __attribute__((ext_vector_type(8)));
typedef short bf16x4 __attribute__((ext_vector_type(4)));
typedef float f32x4 __attribute__((ext_vector_type(4)));
typedef float f32x2 __attribute__((ext_vector_type(2)));
typedef float f32x16 __attribute__((ext_vector_type(16)));
typedef unsigned u32x4 __attribute__((ext_vector_type(4)));
typedef unsigned u32x2 __attribute__((ext_vector_type(2)));

constexpr int D = 1024, M_CTX = 8192, M_LAT = 16384, M = M_CTX + M_LAT, NP = 1888, NPP = 2048, FF = 2816, DEPTH = 4;
constexpr int KEYROWS = 8192 + 4 * 4352;
constexpr float EPS = 1e-6f;
constexpr int NTHREADS = 512, NWAVES = 8;
constexpr int LDS_BYTES = 147456;

constexpr size_t OUT_X = 0, OUT_CKV = (size_t)M * D, OUT_KR = OUT_CKV + (size_t)32 * 4 * 256 * 128;
constexpr int PC_U = 0, PC_V = 256, PC_H = 512, PC_B = 768, PC_C = 1024, PC_F = 1280, PC_Q = 1536, PC_KV = 1728, PC_KR = 1856;

constexpr size_t al256(size_t x) { return (x + 255) & ~(size_t)255; }
constexpr size_t WS_BAR = 0, WS_BAR_BYTES = 16384;
constexpr size_t WS_MOD = WS_BAR_BYTES;
constexpr size_t WS_F64 = al256(WS_MOD + (size_t)4 * 5 * 6144 * 4);
constexpr size_t WS_T64R = WS_F64 + 128 * 64 * 2;
constexpr size_t WS_T64I = WS_T64R + 64 * 128 * 2;
constexpr size_t WS_T64B = WS_T64I + 64 * 128 * 2;
constexpr size_t WS_T256 = WS_T64B + 64 * 128 * 2;
constexpr size_t WS_TW = WS_T256 + 256 * 512 * 2;
constexpr size_t WS_ROPE = WS_TW + 4096 * 8;
constexpr size_t WS_W = al256(WS_ROPE + 64 * 8 * 8);
constexpr size_t WL_IN = 0, WL_OUT = WL_IN + (size_t)NPP * D * 2, WL_GU = WL_OUT + (size_t)D * D * 2, WL_DN = WL_GU + (size_t)2 * FF * D * 2,
                 WL_UQ = WL_DN + (size_t)D * FF * 2, WL_UKV = WL_UQ + (size_t)384 * 192 * 2, WL_SP = WL_UKV + (size_t)512 * 128 * 2, WL_SIZE = WL_SP + (size_t)4 * 128 * 128 * 2;
constexpr size_t WS_R1 = al256(WS_W + 4 * WL_SIZE);
constexpr size_t WS_R2 = WS_R1 + (size_t)M * D * 2;
constexpr size_t WS_MLA = WS_R2 + (size_t)M * FF * 2;
constexpr size_t WS_Q = WS_MLA, WS_KN = WS_Q + (size_t)M * 384 * 2, WS_VT = WS_KN + (size_t)KEYROWS * 256 * 2, WS_KR = WS_VT + (size_t)KEYROWS * 256 * 2,
                 WS_GB = WS_KR + (size_t)KEYROWS * 32 * 2, WS_END = WS_GB + (size_t)4 * 4 * 64 * 64 * 128 * 2;
static_assert(WS_END - WS_MLA >= (size_t)M * D * 2, "FFNOUT alias");
static_assert((size_t)M * NP * 2 <= (size_t)M * FF * 2, "PROJ fits R2");

struct Params { const float* in[24]; float* out; unsigned char* ws; };
enum { I_XP = 0, I_XS, I_CCKV, I_CKR, I_C, I_CCTX, I_WADA, I_BADA, I_GPM, I_GPOM, I_GPF, I_GPOF, I_WIN, I_SPW, I_SPB, I_CVW, I_CVB, I_GQ, I_WUQ, I_GKV, I_WUKV, I_WOUT, I_WGU, I_WDN };

__device__ __forceinline__ unsigned f2bf(float f) { unsigned u = __builtin_bit_cast(unsigned, f); return (u + 0x7fffu + ((u >> 16) & 1u)) >> 16; }
typedef __bf16 bf16x2v __attribute__((ext_vector_type(2)));
__device__ __forceinline__ unsigned pk2(float lo, float hi) { const bf16x2v r = __builtin_convertvector((f32x2){lo, hi}, bf16x2v); return __builtin_bit_cast(unsigned, r); }
__device__ __forceinline__ float bflo(unsigned w) { return __builtin_bit_cast(float, w << 16); }
__device__ __forceinline__ float bfhi(unsigned w) { return __builtin_bit_cast(float, w & 0xffff0000u); }
__device__ __forceinline__ float bf1(bf16_t v) { return __builtin_bit_cast(float, (unsigned)v << 16); }
__device__ __forceinline__ f32x4 mma16(bf16x8 a, bf16x8 b, f32x4 c) { return __builtin_amdgcn_mfma_f32_16x16x32_bf16(a, b, c, 0, 0, 0); }
__device__ __forceinline__ f32x16 mma32(bf16x8 a, bf16x8 b, f32x16 c) { return __builtin_amdgcn_mfma_f32_32x32x16_bf16(a, b, c, 0, 0, 0); }
__device__ __forceinline__ float wave_sum(float v) {
#pragma unroll
    for (int o = 1; o < 64; o <<= 1) v += __shfl_xor(v, o);
    return v;
}
__device__ __forceinline__ u32x2 pk4(f32x4 v) { u32x2 w; w.x = pk2(v[0], v[1]); w.y = pk2(v[2], v[3]); return w; }
__device__ __forceinline__ int mod_of_row(int r) { return r < M_CTX ? 0 : 1 + ((r - M_CTX) >> 12); }

struct Ctx {
    Params p; LAS unsigned char* lds; int tid, lane, wave, bid, G;
    unsigned char* ws;
    __device__ __forceinline__ const float* mod(int l, int mi, int chunk) const { return (const float*)(ws + WS_MOD) + ((size_t)(l * 5 + mi) * 6 + chunk) * 1024; }
    __device__ __forceinline__ unsigned char* wl(int l) const { return ws + WS_W + (size_t)l * WL_SIZE; }
    __device__ __forceinline__ void refresh() { int t = threadIdx.x; asm volatile("" : "+v"(t)); tid = t; lane = t & 63; wave = __builtin_amdgcn_readfirstlane(t >> 6);
        size_t z = 0; asm volatile("" : "+s"(z)); ws = p.ws + z;
        int b = blockIdx.x; asm volatile("" : "+s"(b)); bid = b; }
};

constexpr int TPS = 258;
struct TItem { const float* W; bf16_t* WT; int ldw, K, k0, n0, nvalid, gu; };
__device__ __forceinline__ void titem_load(const TItem& t, int wave, int lane, f32x4 (&v)[8]) {
    const int n = t.n0 + 4 * lane;
#pragma unroll
    for (int i = 0; i < 8; ++i) v[i] = n < t.nvalid ? __builtin_nontemporal_load((const f32x4*)(t.W + (size_t)(t.k0 + 8 * wave + i) * t.ldw + n)) : (f32x4){0.f, 0.f, 0.f, 0.f};
}
__device__ __forceinline__ void titem_stage(LAS unsigned char* lds, int wave, int lane, const f32x4 (&v)[8]) {
    LAS bf16_t* T = (LAS bf16_t*)lds;
#pragma unroll
    for (int i = 0; i < 8; ++i) { LAS unsigned* d = (LAS unsigned*)(T + (8 * wave + i) * TPS + 4 * lane); d[0] = pk2(v[i][0], v[i][1]); d[1] = pk2(v[i][2], v[i][3]); }
}
__device__ __forceinline__ void titem_store(const TItem& t, const LAS unsigned char* lds, int tid) {
    const LAS bf16_t* T = (const LAS bf16_t*)lds;
#pragma unroll
    for (int it = 0; it < 4; ++it) { const int q = tid + NTHREADS * it, n = q >> 3, c = q & 7;
        unsigned short e[8];
#pragma unroll
        for (int j = 0; j < 8; ++j) e[j] = T[(8 * c + j) * TPS + n];
        const int sn = t.n0 + n;
        if (sn < t.nvalid) { int dr = sn; if (t.gu) { const int isup = sn >= FF, jj = isup ? sn - FF : sn; dr = (jj >> 7) * 256 + isup * 128 + (jj & 127); }
            u32x4 o; o.x = e[0] | ((unsigned)e[1] << 16); o.y = e[2] | ((unsigned)e[3] << 16); o.z = e[4] | ((unsigned)e[5] << 16); o.w = e[6] | ((unsigned)e[7] << 16);
            *(u32x4*)(t.WT + (size_t)dr * t.K + t.k0 + 8 * c) = o; } }
}
constexpr int TI_IN = 16 * 8, TI_OUT = 16 * 4, TI_GU = 16 * 22, TI_DN = 44 * 4, TI_UQ = 3 * 2, TI_UKV = 2 * 2, TI_L = TI_IN + TI_OUT + TI_GU + TI_DN + TI_UQ + TI_UKV;
__device__ __forceinline__ TItem titem_make(const Ctx& C, int it) {
    const Params& p = C.p; const int l = it / TI_L; int r = it % TI_L; unsigned char* wl = C.wl(l); TItem t; t.gu = 0;
    if (r < TI_IN) { t.W = p.in[I_WIN] + (size_t)l * D * NP; t.WT = (bf16_t*)(wl + WL_IN); t.ldw = NP; t.K = D; t.k0 = (r >> 3) * 64; t.n0 = (r & 7) * 256; t.nvalid = NP; return t; } r -= TI_IN;
    if (r < TI_OUT) { t.W = p.in[I_WOUT] + (size_t)l * D * D; t.WT = (bf16_t*)(wl + WL_OUT); t.ldw = D; t.K = D; t.k0 = (r >> 2) * 64; t.n0 = (r & 3) * 256; t.nvalid = D; return t; } r -= TI_OUT;
    if (r < TI_GU) { t.W = p.in[I_WGU] + (size_t)l * D * 2 * FF; t.WT = (bf16_t*)(wl + WL_GU); t.ldw = 2 * FF; t.K = D; t.k0 = (r / 22) * 64; t.n0 = (r % 22) * 256; t.nvalid = 2 * FF; t.gu = 1; return t; } r -= TI_GU;
    if (r < TI_DN) { t.W = p.in[I_WDN] + (size_t)l * FF * D; t.WT = (bf16_t*)(wl + WL_DN); t.ldw = D; t.K = FF; t.k0 = (r >> 2) * 64; t.n0 = (r & 3) * 256; t.nvalid = D; return t; } r -= TI_DN;
    if (r < TI_UQ) { t.W = p.in[I_WUQ] + (size_t)l * 192 * 384; t.WT = (bf16_t*)(wl + WL_UQ); t.ldw = 384; t.K = 192; t.k0 = (r >> 1) * 64; t.n0 = (r & 1) * 256; t.nvalid = 384; return t; } r -= TI_UQ;
    t.W = p.in[I_WUKV] + (size_t)l * 128 * 512; t.WT = (bf16_t*)(wl + WL_UKV); t.ldw = 512; t.K = 128; t.k0 = (r >> 1) * 64; t.n0 = (r & 1) * 256; t.nvalid = 512; return t;
}

__device__ __forceinline__ void transpose_items(const Ctx& C, int it0, int stride, int end) {
    int it = it0; f32x4 v[8];
    TItem cur; if (it < end) { cur = titem_make(C, it); titem_load(cur, C.wave, C.lane, v); }
    while (it < end) {
        titem_stage(C.lds, C.wave, C.lane, v);
        const int nx = it + stride; TItem nxt = cur; if (nx < end) { nxt = titem_make(C, nx); titem_load(nxt, C.wave, C.lane, v); }
        __syncthreads();
        titem_store(cur, C.lds, C.tid);
        __syncthreads();
        cur = nxt; it = nx;
    }
}

__device__ __forceinline__ void phase_prologue(const Ctx& C) {
    const Params& p = C.p;
    transpose_items(C, C.bid, C.G, (C.G == 256) ? TI_L : 4 * TI_L);
    {
        LAS float* sc = (LAS float*)C.lds;
        LAS float* red = (LAS float*)(C.lds + 5 * 1024 * 4);
        const int ub = C.G - 1 - C.bid;
        if (ub < 96) {
            size_t za = 0, zb = 0; asm volatile("" : "+s"(za), "+s"(zb));
            const float* cctx = p.in[I_CCTX] + za; const float* cc_ = p.in[I_C] + zb;
            for (int i = C.tid; i < 5120; i += NTHREADS) { const int j = i >> 10, k = i & 1023; const float v = (j == 0) ? cctx[k] : cc_[(j - 1) * 1024 + k]; sc[i] = v / (1.f + __expf(-v)); }
            __syncthreads();
            for (int u = ub; u < 96; u += C.G) {
                const int l = u / 24, cb = u % 24;
                const float* w = p.in[I_WADA] + ((size_t)l * 1024 + C.wave * 128) * 6144 + cb * 256 + 4 * C.lane;
                f32x4 a0 = {0.f, 0.f, 0.f, 0.f}, a1 = a0, a2 = a0, a3 = a0, a4 = a0;
#pragma unroll 16
                for (int k = 0; k < 128; ++k) { const f32x4 wv = __builtin_nontemporal_load((const f32x4*)(w + (size_t)k * 6144)); const int kk = C.wave * 128 + k;
                    a0 += wv * sc[kk]; a1 += wv * sc[1024 + kk]; a2 += wv * sc[2048 + kk]; a3 += wv * sc[3072 + kk]; a4 += wv * sc[4096 + kk]; }
                LAS f32x4* rw = (LAS f32x4*)(red + C.wave * 1280) + C.lane;
                rw[0] = a0; rw[64] = a1; rw[128] = a2; rw[192] = a3; rw[256] = a4;
                __syncthreads();
                for (int i = C.tid; i < 1280; i += NTHREADS) { const int j = i >> 8, c2 = i & 255; float sum = p.in[I_BADA][l * 6144 + cb * 256 + c2];
#pragma unroll
                    for (int ww = 0; ww < 8; ++ww) sum += red[ww * 1280 + i];
                    ((float*)(C.ws + WS_MOD))[(size_t)(l * 5 + j) * 6144 + cb * 256 + c2] = sum; }
                __syncthreads();
            }
        }
        __syncthreads();
    }
    {
        const int gt = C.bid * NTHREADS + C.tid, GT = C.G * NTHREADS;
        for (int i = gt; i < 4 * 65536; i += GT) { const int l = i >> 16, e = i & 65535; ((bf16_t*)(C.wl(l) + WL_SP))[e] = (bf16_t)f2bf(p.in[I_SPW][i]); }
        for (int i = gt; i < 4 * 160 * 1024 / 2; i += GT) { const int l = i / (160 * 512), e = i % (160 * 512); ((unsigned*)(C.wl(l) + WL_IN + (size_t)NP * D * 2))[e] = 0u; }
        for (int i = gt; i < 128 * 64; i += GT) { const int m = i >> 6, c = i & 63; const int idx = ((m & 63) * c) & 63; const float a = (float)idx / 32.f;
            ((bf16_t*)(C.ws + WS_F64))[i] = (bf16_t)f2bf(m < 64 ? cospif(a) : sinpif(a)); }
        for (int i = gt; i < 64 * 128; i += GT) { const int k = i >> 7, K = i & 127; const int idx = (k * (K & 63)) & 63; const float a = (float)idx / 32.f; const float cv = cospif(a), sv = sinpif(a);
            ((bf16_t*)(C.ws + WS_T64R))[i] = (bf16_t)f2bf(K < 64 ? cv : -sv);
            ((bf16_t*)(C.ws + WS_T64I))[i] = (bf16_t)f2bf(K < 64 ? -sv : -cv);
            ((bf16_t*)(C.ws + WS_T64B))[i] = (bf16_t)f2bf(K < 64 ? cv : sv); }
        for (int i = gt; i < 256 * 512; i += GT) { const int k = i >> 9, K = i & 511; const int idx = (k * (K & 255)) & 255; const float a = (float)idx / 128.f;
            ((bf16_t*)(C.ws + WS_T256))[i] = (bf16_t)f2bf(K < 256 ? cospif(a) : -sinpif(a)); }
        for (int i = gt; i < 4096; i += GT) { const float a = (float)i / 2048.f; ((f32x2*)(C.ws + WS_TW))[i] = (f32x2){cospif(a), sinpif(a)}; }
        for (int i = gt; i < 512; i += GT) { const int pos = i >> 3, f = i & 7; const float inv = powf(10000.f, -(float)f / 8.f); const float ang = (float)pos * inv;
            ((f32x2*)(C.ws + WS_ROPE))[i] = (f32x2){cosf(ang), sinf(ang)}; }
    }
}

__device__ __forceinline__ void load_row_f32(const float* rowp, int lane, f32x4 (&v)[4]) {
#pragma unroll
    for (int j = 0; j < 4; ++j) v[j] = *(const f32x4*)(rowp + 4 * lane + 256 * j);
}
__device__ __forceinline__ void load_row_f32_nt(const float* rowp, int lane, f32x4 (&v)[4]) {
#pragma unroll
    for (int j = 0; j < 4; ++j) v[j] = __builtin_nontemporal_load((const f32x4*)(rowp + 4 * lane + 256 * j));
}
__device__ __forceinline__ void load_row_bf16(const bf16_t* rowp, int lane, f32x4 (&v)[4]) {
#pragma unroll
    for (int j = 0; j < 4; ++j) { const u32x2 w = *(const u32x2*)(rowp + 4 * lane + 256 * j); v[j] = (f32x4){bflo(w.x), bfhi(w.x), bflo(w.y), bfhi(w.y)}; }
}
__device__ __forceinline__ float row_rstd(const f32x4 (&v)[4]) {
    float s = 0.f;
#pragma unroll
    for (int j = 0; j < 4; ++j) s += (v[j][0] * v[j][0] + v[j][1] * v[j][1]) + (v[j][2] * v[j][2] + v[j][3] * v[j][3]);
    return 1.f / sqrtf(wave_sum(s) * (1.f / 1024.f) + EPS);
}
__device__ __forceinline__ void norm_mod_store(const f32x4 (&x)[4], const float* g, const float* scale, const float* shift, bf16_t* orow, int lane) {
    const float rs = row_rstd(x);
#pragma unroll
    for (int j = 0; j < 4; ++j) { const int c = 4 * lane + 256 * j; const f32x4 gv = *(const f32x4*)(g + c), sv = *(const f32x4*)(scale + c), hv = *(const f32x4*)(shift + c);
        const f32x4 h = x[j] * rs * gv * (1.f + sv) + hv; *(u32x2*)(orow + c) = pk4(h); }
}
__device__ __forceinline__ void norm_mod_store_g(const f32x4 (&x)[4], const f32x4 (&gv)[4], const float* scale, const float* shift, bf16_t* orow, int lane) {
    const float rs = row_rstd(x);
#pragma unroll
    for (int j = 0; j < 4; ++j) { const int c = 4 * lane + 256 * j; const f32x4 sv = *(const f32x4*)(scale + c), hv = *(const f32x4*)(shift + c);
        const f32x4 h = x[j] * rs * gv[j] * (1.f + sv) + hv; *(u32x2*)(orow + c) = pk4(h); }
}
__device__ __forceinline__ const float* xin_row(const Ctx& C, int layer, int r) {
    if (layer > 0) return C.p.out + OUT_X + (size_t)r * D;
    size_t za = 0, zb = 0; asm volatile("" : "+s"(za), "+s"(zb));
    const float* a = C.p.in[I_XP] + za; const float* b = C.p.in[I_XS] + zb;
    return r < M_CTX ? a + (size_t)r * D : b + (size_t)(r - M_CTX) * D;
}
constexpr int SPLIT_ROW0 = 16384;
__device__ __forceinline__ void load_row_bf16_nt(const bf16_t* rowp, int lane, f32x4 (&v)[4]) {
#pragma unroll
    for (int j = 0; j < 4; ++j) { const u32x2 w = __builtin_nontemporal_load((const u32x2*)(rowp + 4 * lane + 256 * j)); v[j] = (f32x4){bflo(w.x), bfhi(w.x), bflo(w.y), bfhi(w.y)}; }
}
__device__ __forceinline__ void load_T(const bf16_t* T, const bf16_t* T1, bool split, int r, int lane, f32x4 (&v)[4]) {
    load_row_bf16_nt(T + (size_t)r * D, lane, v);
    if (split && r >= SPLIT_ROW0) { f32x4 w[4]; load_row_bf16_nt(T1 + (size_t)r * D, lane, w);
#pragma unroll
        for (int j = 0; j < 4; ++j) v[j] = v[j] + w[j]; }
}
__device__ __forceinline__ void phase_norm0(const Ctx& C) {
    const int gw = C.bid * NWAVES + C.wave, NGW = C.G * NWAVES;
    bf16_t* H = (bf16_t*)(C.ws + WS_R1); const float* g0 = C.p.in[I_GPM];
    f32x4 gs[4], sh[4]; int cur_mi = -1;
#pragma unroll
    for (int j = 0; j < 4; ++j) { gs[j] = (f32x4){0.f, 0.f, 0.f, 0.f}; sh[j] = gs[j]; }
    f32x4 xq[3][4];
#define N0_ROW(s_, r_) do { const int rr_ = (r_); const int mi = mod_of_row(rr_); \
        if (mi != cur_mi) { cur_mi = mi; const float* scale = C.mod(0, mi, 1); const float* shift = C.mod(0, mi, 0); \
            _Pragma("unroll") for (int j = 0; j < 4; ++j) { const int c = 4 * C.lane + 256 * j; gs[j] = *(const f32x4*)(g0 + c) * (1.f + *(const f32x4*)(scale + c)); sh[j] = *(const f32x4*)(shift + c); } } \
        const float rs = row_rstd(xq[s_]); bf16_t* orow = H + (size_t)rr_ * D; \
        _Pragma("unroll") for (int j = 0; j < 4; ++j) { const int c = 4 * C.lane + 256 * j; const f32x4 h = xq[s_][j] * rs * gs[j] + sh[j]; *(u32x2*)(orow + c) = pk4(h); } } while (0)
    load_row_f32_nt(xin_row(C, 0, gw), C.lane, xq[0]); if (gw + NGW < M) load_row_f32_nt(xin_row(C, 0, gw + NGW), C.lane, xq[1]);
    for (int r = gw; r < M; r += 3 * NGW) {
        if (r + 2 * NGW < M) load_row_f32_nt(xin_row(C, 0, r + 2 * NGW), C.lane, xq[2]);
        N0_ROW(0, r);
        if (r + NGW < M) { if (r + 3 * NGW < M) load_row_f32_nt(xin_row(C, 0, r + 3 * NGW), C.lane, xq[0]); N0_ROW(1, r + NGW); }
        if (r + 2 * NGW < M) { if (r + 4 * NGW < M) load_row_f32_nt(xin_row(C, 0, r + 4 * NGW), C.lane, xq[1]); N0_ROW(2, r + 2 * NGW); }
    }
#undef N0_ROW
}
template <int which  > __device__ __forceinline__ void phase_post(const Ctx& C, int layer) {
    const int gw = C.bid * NWAVES + C.wave, NGW = C.G * NWAVES;
    const bf16_t* T = (const bf16_t*)(C.ws + (which == 0 ? WS_R2 : WS_MLA));
    const bf16_t* T1 = T + (size_t)M * D - (size_t)SPLIT_ROW0 * D;
    const bool split = (C.G == 256);
    bf16_t* H = (bf16_t*)(C.ws + WS_R1);
    const float* gpost = (which == 0 ? C.p.in[I_GPOM] : C.p.in[I_GPOF]) + layer * D;
    const bool do_next = (which == 0) || (layer + 1 < DEPTH);
    const int nl = which == 0 ? layer : layer + 1;
    const float* gnext = (which == 0 ? C.p.in[I_GPF] : C.p.in[I_GPM]) + (nl < DEPTH ? nl : 0) * D;
    f32x4 gg[4], gs[4], sh[4]; int cur_mi = -1;
#pragma unroll
    for (int j = 0; j < 4; ++j) { gg[j] = (f32x4){0.f, 0.f, 0.f, 0.f}; gs[j] = gg[j]; sh[j] = gg[j]; }
    f32x4 tq[3][4], xq[3][4];
#define POST_LOAD(s_, r_) do { load_T(T, T1, split, (r_), C.lane, tq[s_]); load_row_f32_nt(which == 0 ? xin_row(C, layer, (r_)) : C.p.out + OUT_X + (size_t)(r_) * D, C.lane, xq[s_]); } while (0)
#define POST_ROW(s_, r_) do { const int rr_ = (r_); const int mi = mod_of_row(rr_); \
        if (mi != cur_mi) { cur_mi = mi; \
            const float* gate = C.mod(layer, mi, which == 0 ? 2 : 5); const float* scale = C.mod(nl, mi, which == 0 ? 4 : 1); const float* shift = C.mod(nl, mi, which == 0 ? 3 : 0); \
            _Pragma("unroll") for (int j = 0; j < 4; ++j) { const int c = 4 * C.lane + 256 * j; gg[j] = *(const f32x4*)(gate + c) * *(const f32x4*)(gpost + c); \
                if (do_next) { gs[j] = *(const f32x4*)(gnext + c) * (1.f + *(const f32x4*)(scale + c)); sh[j] = *(const f32x4*)(shift + c); } } } \
        const float rs = row_rstd(tq[s_]); float* xo = C.p.out + OUT_X + (size_t)rr_ * D; \
        _Pragma("unroll") for (int j = 0; j < 4; ++j) { const int c = 4 * C.lane + 256 * j; xq[s_][j] = xq[s_][j] + gg[j] * (tq[s_][j] * rs); __builtin_nontemporal_store(xq[s_][j], (f32x4*)(xo + c)); } \
        if (do_next) { const float rs2 = row_rstd(xq[s_]); bf16_t* orow = H + (size_t)rr_ * D; \
            _Pragma("unroll") for (int j = 0; j < 4; ++j) { const int c = 4 * C.lane + 256 * j; const f32x4 h = xq[s_][j] * rs2 * gs[j] + sh[j]; *(u32x2*)(orow + c) = pk4(h); } } } while (0)
    POST_LOAD(0, gw); if (gw + NGW < M) POST_LOAD(1, gw + NGW);
    for (int r = gw; r < M; r += 3 * NGW) {
        if (r + 2 * NGW < M) POST_LOAD(2, r + 2 * NGW);
        POST_ROW(0, r);
        if (r + NGW < M) { if (r + 3 * NGW < M) POST_LOAD(0, r + 3 * NGW); POST_ROW(1, r + NGW); }
        if (r + 2 * NGW < M) { if (r + 4 * NGW < M) POST_LOAD(1, r + 4 * NGW); POST_ROW(2, r + 2 * NGW); }
    }
#undef POST_LOAD
#undef POST_ROW
}

__device__ __forceinline__ void unit_chunk_mlp(const Ctx& C, int layer, int u) {
    const int chunk = u >> 2, g = u & 3, r0 = chunk * 128;
    const bf16_t* PROJ = (const bf16_t*)(C.ws + WS_R2); bf16_t* MIX = (bf16_t*)(C.ws + WS_R1);
    constexpr int VS = 136;
    LAS bf16_t* Vt = (LAS bf16_t*)C.lds;
    { const int q = C.tid >> 2, c0 = (C.tid & 3) * 16; const bf16_t* src = PROJ + (size_t)(r0 + q) * NP + PC_V + g * 64 + c0;
      const bf16x8 v0 = *(const bf16x8*)src, v1 = *(const bf16x8*)(src + 8);
#pragma unroll
      for (int j = 0; j < 8; ++j) { Vt[(c0 + j) * VS + q] = (bf16_t)v0[j]; Vt[(c0 + 8 + j) * VS + q] = (bf16_t)v1[j]; } }
    __syncthreads();
    const int l15 = C.lane & 15, hq = C.lane >> 4, w = C.wave;
    const bf16_t* Wg = (const bf16_t*)(C.wl(layer) + WL_SP) + (size_t)g * 128 * 128;
    bf16x8 bw[4];
#pragma unroll
    for (int ks = 0; ks < 4; ++ks) bw[ks] = *(const bf16x8*)(Wg + (size_t)(w * 16 + l15) * 128 + ks * 32 + 8 * hq);
    const int p = w * 16 + l15; const float bias = C.p.in[I_SPB][(layer * 4 + g) * 128 + p];
#pragma unroll
    for (int ct = 0; ct < 4; ++ct) {
        f32x4 acc = {0.f, 0.f, 0.f, 0.f};
#pragma unroll
        for (int ks = 0; ks < 4; ++ks) { const bf16x8 a = *(const LAS bf16x8*)(Vt + (ct * 16 + l15) * VS + ks * 32 + 8 * hq); acc = mma16(a, bw[ks], acc); }
        const int cc = g * 64 + ct * 16 + 4 * hq; const u32x2 uw = *(const u32x2*)(PROJ + (size_t)(r0 + p) * NP + PC_U + cc);
        f32x4 o; o[0] = bflo(uw.x) * (acc[0] + bias); o[1] = bfhi(uw.x) * (acc[1] + bias); o[2] = bflo(uw.y) * (acc[2] + bias); o[3] = bfhi(uw.y) * (acc[3] + bias);
        *(u32x2*)(MIX + (size_t)(r0 + p) * D + cc) = pk4(o);
    }
    __syncthreads();
}
__device__ __forceinline__ void unit_conv(const Ctx& C, int layer, int u) {
    const bf16_t* PROJ = (const bf16_t*)(C.ws + WS_R2); bf16_t* MIX = (bf16_t*)(C.ws + WS_R1);
    const float* cw = C.p.in[I_CVW] + layer * 3 * 256; const float* cb = C.p.in[I_CVB] + layer * 256;
    for (int it = 0; it < 8; ++it) {
        const int item = it * NTHREADS + C.tid, t = item >> 5, ch = (item & 31) * 8, r = u * 128 + t;
        const int pos = r < M_CTX ? (r & 255) : ((r - M_CTX) & 4095), len = r < M_CTX ? 256 : 4096;
        const bf16_t* base = PROJ + (size_t)r * NP;
        const bf16x8 h1 = *(const bf16x8*)(base + PC_H + ch), c1 = *(const bf16x8*)(base + PC_C + ch), gb = *(const bf16x8*)(base + PC_B + ch);
        bf16x8 h0 = h1, c0 = c1, h2 = h1, c2 = c1; const bool hasp = pos > 0, hasn = pos < len - 1;
        if (hasp) { h0 = *(const bf16x8*)(base - NP + PC_H + ch); c0 = *(const bf16x8*)(base - NP + PC_C + ch); }
        if (hasn) { h2 = *(const bf16x8*)(base + NP + PC_H + ch); c2 = *(const bf16x8*)(base + NP + PC_C + ch); }
        float o[8];
#pragma unroll
        for (int j = 0; j < 8; ++j) {
            const float z0 = hasp ? bf1((bf16_t)h0[j]) * bf1((bf16_t)c0[j]) : 0.f, z1 = bf1((bf16_t)h1[j]) * bf1((bf16_t)c1[j]), z2 = hasn ? bf1((bf16_t)h2[j]) * bf1((bf16_t)c2[j]) : 0.f;
            const float y = z0 * cw[ch + j] + z1 * cw[256 + ch + j] + z2 * cw[512 + ch + j] + cb[ch + j];
            o[j] = bf1((bf16_t)gb[j]) * y; }
        u32x4 w; w.x = pk2(o[0], o[1]); w.y = pk2(o[2], o[3]); w.z = pk2(o[4], o[5]); w.w = pk2(o[6], o[7]);
        *(u32x4*)(MIX + (size_t)r * D + 256 + ch) = w;
    }
}
__device__ __forceinline__ void unit_fourier_ctx(const Ctx& C, int u) {
    const int s = u >> 2, g = u & 3, l15 = C.lane & 15, hq = C.lane >> 4, w = C.wave;
    const bf16_t* PROJ = (const bf16_t*)(C.ws + WS_R2); bf16_t* MIX = (bf16_t*)(C.ws + WS_R1);
    const bf16_t* F64 = (const bf16_t*)(C.ws + WS_F64); const bf16_t* T256 = (const bf16_t*)(C.ws + WS_T256);
    constexpr int ZS = 520; LAS bf16_t* Zt = (LAS bf16_t*)C.lds;
#pragma unroll
    for (int i = 0; i < 2; ++i) { const int nt = 2 * w + i;
        bf16x8 a[2];
#pragma unroll
        for (int ks = 0; ks < 2; ++ks) a[ks] = *(const bf16x8*)(PROJ + (size_t)(s * 256 + nt * 16 + l15) * NP + PC_F + g * 64 + ks * 32 + 8 * hq);
#pragma unroll
        for (int mt = 0; mt < 8; ++mt) { f32x4 acc = {0.f, 0.f, 0.f, 0.f};
#pragma unroll
            for (int ks = 0; ks < 2; ++ks) { const bf16x8 b = *(const bf16x8*)(F64 + (size_t)(mt * 16 + l15) * 64 + ks * 32 + 8 * hq); acc = mma16(a[ks], b, acc); }
            const int mp = mt * 16 + l15;
            *(LAS u32x2*)(Zt + (mp & 63) * ZS + (mp >> 6) * 256 + nt * 16 + 4 * hq) = pk4(acc); } }
    __syncthreads();
#pragma unroll 1
    for (int i = 0; i < 2; ++i) { const int kt = 2 * w + i;
        f32x4 acc[4];
#pragma unroll
        for (int mt = 0; mt < 4; ++mt) acc[mt] = (f32x4){0.f, 0.f, 0.f, 0.f};
#pragma unroll 8
        for (int ks = 0; ks < 16; ++ks) { const bf16x8 b = *(const bf16x8*)(T256 + (size_t)(kt * 16 + l15) * 512 + ks * 32 + 8 * hq);
#pragma unroll
            for (int mt = 0; mt < 4; ++mt) { const bf16x8 a = *(const LAS bf16x8*)(Zt + (mt * 16 + l15) * ZS + ks * 32 + 8 * hq); acc[mt] = mma16(a, b, acc[mt]); } }
#pragma unroll
        for (int mt = 0; mt < 4; ++mt) *(u32x2*)(MIX + (size_t)(s * 256 + kt * 16 + l15) * D + 512 + g * 64 + mt * 16 + 4 * hq) = pk4(acc[mt] * (1.f / 128.f)); }
    __syncthreads();
}
__device__ __forceinline__ void unit_fourier_lat1(const Ctx& C, int u) {
    const int b = u >> 5, g = (u >> 3) & 3, nb = u & 7, l15 = C.lane & 15, hq = C.lane >> 4, n2 = nb * 8 + C.wave;
    const bf16_t* PROJ = (const bf16_t*)(C.ws + WS_R2);
    const bf16_t* F64 = (const bf16_t*)(C.ws + WS_F64); const bf16_t* T64R = (const bf16_t*)(C.ws + WS_T64R); const bf16_t* T64I = (const bf16_t*)(C.ws + WS_T64I);
    const f32x2* TW = (const f32x2*)(C.ws + WS_TW);
    bf16_t* GB = (bf16_t*)(C.ws + WS_GB) + (size_t)((b * 4 + g) * 64 + n2) * 64 * 128;
    constexpr int ZS = 136; LAS bf16_t* Zt = (LAS bf16_t*)(C.lds + C.wave * (64 * ZS * 2));
#pragma unroll 2
    for (int nt = 0; nt < 4; ++nt) {
        bf16x8 a[2];
#pragma unroll
        for (int ks = 0; ks < 2; ++ks) a[ks] = *(const bf16x8*)(PROJ + (size_t)(M_CTX + b * 4096 + (nt * 16 + l15) * 64 + n2) * NP + PC_F + g * 64 + ks * 32 + 8 * hq);
#pragma unroll
        for (int mt = 0; mt < 8; ++mt) { f32x4 acc = {0.f, 0.f, 0.f, 0.f};
#pragma unroll
            for (int ks = 0; ks < 2; ++ks) { const bf16x8 bb = *(const bf16x8*)(F64 + (size_t)(mt * 16 + l15) * 64 + ks * 32 + 8 * hq); acc = mma16(a[ks], bb, acc); }
            const int mp = mt * 16 + l15;
            *(LAS u32x2*)(Zt + (mp & 63) * ZS + (mp >> 6) * 64 + nt * 16 + 4 * hq) = pk4(acc); } }
    asm volatile("s_waitcnt lgkmcnt(0)" ::: "memory");
#pragma unroll 2
    for (int kt = 0; kt < 4; ++kt) {
        bf16x8 br[4], bi[4];
#pragma unroll
        for (int ks = 0; ks < 4; ++ks) { br[ks] = *(const bf16x8*)(T64R + (size_t)(kt * 16 + l15) * 128 + ks * 32 + 8 * hq); bi[ks] = *(const bf16x8*)(T64I + (size_t)(kt * 16 + l15) * 128 + ks * 32 + 8 * hq); }
        const int k1 = kt * 16 + l15; const f32x2 tw = TW[k1 * n2];
#pragma unroll
        for (int mt = 0; mt < 4; ++mt) { f32x4 ar = {0.f, 0.f, 0.f, 0.f}, ai = {0.f, 0.f, 0.f, 0.f};
#pragma unroll
            for (int ks = 0; ks < 4; ++ks) { const bf16x8 a = *(const LAS bf16x8*)(Zt + (mt * 16 + l15) * ZS + ks * 32 + 8 * hq); ar = mma16(a, br[ks], ar); ai = mma16(a, bi[ks], ai); }
            const f32x4 gr = ar * tw[0] + ai * tw[1], gi = ai * tw[0] - ar * tw[1];
            bf16_t* dst = GB + (size_t)k1 * 128 + mt * 16 + 4 * hq;
            *(u32x2*)dst = pk4(gr); *(u32x2*)(dst + 64) = pk4(gi); } }
    __syncthreads();
}
__device__ __forceinline__ void unit_fourier_lat2(const Ctx& C, int u) {
    const int b = u >> 5, g = (u >> 3) & 3, kb = u & 7, l15 = C.lane & 15, hq = C.lane >> 4, k1 = kb * 8 + C.wave;
    const bf16_t* T64B = (const bf16_t*)(C.ws + WS_T64B); bf16_t* MIX = (bf16_t*)(C.ws + WS_R1);
    const bf16_t* GB = (const bf16_t*)(C.ws + WS_GB) + (size_t)((b * 4 + g) * 64) * 64 * 128 + (size_t)k1 * 128;
    constexpr int ZS = 136; LAS bf16_t* Tt = (LAS bf16_t*)(C.lds + C.wave * (64 * ZS * 2));
#pragma unroll 4
    for (int it = 0; it < 16; ++it) { const int q = it * 64 + C.lane, n2 = q >> 4, cc = q & 15, part = cc >> 3, m0 = (cc & 7) * 8;
        const bf16x8 v = *(const bf16x8*)(GB + (size_t)n2 * 64 * 128 + cc * 8);
#pragma unroll
        for (int j = 0; j < 8; ++j) Tt[(m0 + j) * ZS + part * 64 + n2] = (bf16_t)v[j]; }
    asm volatile("s_waitcnt lgkmcnt(0)" ::: "memory");
#pragma unroll 2
    for (int kt = 0; kt < 4; ++kt) {
        bf16x8 bb[4];
#pragma unroll
        for (int ks = 0; ks < 4; ++ks) bb[ks] = *(const bf16x8*)(T64B + (size_t)(kt * 16 + l15) * 128 + ks * 32 + 8 * hq);
        const int k2 = kt * 16 + l15; const int row = M_CTX + b * 4096 + k1 + 64 * k2;
#pragma unroll
        for (int mt = 0; mt < 4; ++mt) { f32x4 acc = {0.f, 0.f, 0.f, 0.f};
#pragma unroll
            for (int ks = 0; ks < 4; ++ks) { const bf16x8 a = *(const LAS bf16x8*)(Tt + (mt * 16 + l15) * ZS + ks * 32 + 8 * hq); acc = mma16(a, bb[ks], acc); }
            *(u32x2*)(MIX + (size_t)row * D + 512 + g * 64 + mt * 16 + 4 * hq) = pk4(acc * (1.f / 512.f)); } }
    __syncthreads();
}
constexpr float QSCALE = 0.10206207261596577f * 1.4426950408889634f;
__device__ __forceinline__ void unit_mla_prep(const Ctx& C, int layer, int u) {
    const Params& p = C.p;
    const bf16_t* PROJ = (const bf16_t*)(C.ws + WS_R2);
    bf16_t* Q = (bf16_t*)(C.ws + WS_Q); bf16_t* KN = (bf16_t*)(C.ws + WS_KN); bf16_t* VT = (bf16_t*)(C.ws + WS_VT); bf16_t* KR = (bf16_t*)(C.ws + WS_KR);
    const f32x2* ROPE = (const f32x2*)(C.ws + WS_ROPE);
    constexpr int QS = 200, KS = 136;
    LAS bf16_t* CQ = (LAS bf16_t*)C.lds;
    LAS bf16_t* CK = (LAS bf16_t*)(C.lds + 128 * QS * 2);
    const bool is_tok = u < 192;
    int r0 = 0, keyrow0, keypos0, nk; size_t vtbase; bool lat;
    if (is_tok) { r0 = u * 128; lat = r0 >= M_CTX;
        if (!lat) { keyrow0 = r0; keypos0 = r0 & 255; nk = 256; vtbase = (size_t)(r0 & ~255) * 256; }
        else { const int b = (r0 - M_CTX) >> 12, n = (r0 - M_CTX) & 4095; keyrow0 = M_CTX + b * 4352 + n; keypos0 = n; nk = 4352; vtbase = (size_t)(M_CTX + b * 4352) * 256; } }
    else { const int cu = u - 192, b = cu >> 1, half = cu & 1; lat = true; keyrow0 = M_CTX + b * 4352 + 4096 + half * 128; keypos0 = 4096 + half * 128; nk = 4352; vtbase = (size_t)(M_CTX + b * 4352) * 256; }
    { const int t = C.tid >> 2, sub = C.tid & 3;
      if (is_tok) {
        const int r = r0 + t; const bf16_t* base = PROJ + (size_t)r * NP;
        float q[48], k[32]; float sq = 0.f, sk = 0.f;
#pragma unroll
        for (int i = 0; i < 6; ++i) { const bf16x8 v = *(const bf16x8*)(base + PC_Q + sub * 48 + i * 8);
#pragma unroll
            for (int j = 0; j < 8; ++j) { q[i * 8 + j] = bf1((bf16_t)v[j]); sq += q[i * 8 + j] * q[i * 8 + j]; } }
#pragma unroll
        for (int i = 0; i < 4; ++i) { const bf16x8 v = *(const bf16x8*)(base + PC_KV + sub * 32 + i * 8);
#pragma unroll
            for (int j = 0; j < 8; ++j) { k[i * 8 + j] = bf1((bf16_t)v[j]); sk += k[i * 8 + j] * k[i * 8 + j]; } }
        sq += __shfl_xor(sq, 1); sq += __shfl_xor(sq, 2); sk += __shfl_xor(sk, 1); sk += __shfl_xor(sk, 2);
        const float rq = 1.f / sqrtf(sq * (1.f / 192.f) + EPS), rk = 1.f / sqrtf(sk * (1.f / 128.f) + EPS);
        const float* gq = p.in[I_GQ] + layer * 192 + sub * 48; const float* gk = p.in[I_GKV] + layer * 128 + sub * 32;
#pragma unroll
        for (int i = 0; i < 6; ++i) { u32x4 w; w.x = pk2(q[i * 8 + 0] * rq * gq[i * 8 + 0], q[i * 8 + 1] * rq * gq[i * 8 + 1]); w.y = pk2(q[i * 8 + 2] * rq * gq[i * 8 + 2], q[i * 8 + 3] * rq * gq[i * 8 + 3]);
            w.z = pk2(q[i * 8 + 4] * rq * gq[i * 8 + 4], q[i * 8 + 5] * rq * gq[i * 8 + 5]); w.w = pk2(q[i * 8 + 6] * rq * gq[i * 8 + 6], q[i * 8 + 7] * rq * gq[i * 8 + 7]);
            *(LAS u32x4*)(CQ + t * QS + sub * 48 + i * 8) = w; }
        float* sckv = nullptr;
        if (!lat) { const int s = r >> 8, pos = r & 255; sckv = p.out + OUT_CKV + ((size_t)(s * 4 + layer) * 256 + pos) * 128 + sub * 32; }
#pragma unroll
        for (int i = 0; i < 4; ++i) { float o[8];
#pragma unroll
            for (int j = 0; j < 8; ++j) o[j] = k[i * 8 + j] * rk * gk[i * 8 + j];
            u32x4 w; w.x = pk2(o[0], o[1]); w.y = pk2(o[2], o[3]); w.z = pk2(o[4], o[5]); w.w = pk2(o[6], o[7]);
            *(LAS u32x4*)(CK + t * KS + sub * 32 + i * 8) = w;
            if (!lat) { *(f32x4*)(sckv + i * 8) = (f32x4){o[0], o[1], o[2], o[3]}; *(f32x4*)(sckv + i * 8 + 4) = (f32x4){o[4], o[5], o[6], o[7]}; } }
        { const bf16x8 v = *(const bf16x8*)(base + PC_KR + sub * 8); float x[8], o[8];
#pragma unroll
          for (int j = 0; j < 8; ++j) x[j] = bf1((bf16_t)v[j]);
          if (lat) { const int n = (r - M_CTX) & 4095; const int pos = (sub >> 1) == 0 ? (n >> 6) : (n & 63);
#pragma unroll
              for (int j = 0; j < 8; ++j) { const float pr = __shfl_xor(x[j], 1); const f32x2 cs = ROPE[pos * 8 + j]; o[j] = (sub & 1) == 0 ? x[j] * cs[0] - pr * cs[1] : x[j] * cs[0] + pr * cs[1]; } }
          else {
#pragma unroll
              for (int j = 0; j < 8; ++j) o[j] = x[j];
              const int s = r >> 8, pos = r & 255; float* skr = p.out + OUT_KR + ((size_t)(s * 4 + layer) * 256 + pos) * 32 + sub * 8;
              *(f32x4*)skr = (f32x4){o[0], o[1], o[2], o[3]}; *(f32x4*)(skr + 4) = (f32x4){o[4], o[5], o[6], o[7]}; }
          u32x4 w; w.x = pk2(o[0], o[1]); w.y = pk2(o[2], o[3]); w.z = pk2(o[4], o[5]); w.w = pk2(o[6], o[7]);
          *(u32x4*)(KR + (size_t)(keyrow0 + t) * 32 + sub * 8) = w; }
      } else {
        const int cu = u - 192, b = cu >> 1, half = cu & 1, row = half * 128 + t;
        const float* src = p.in[I_CCKV] + ((size_t)(b * 4 + layer) * 256 + row) * 128 + sub * 32;
#pragma unroll
        for (int i = 0; i < 4; ++i) { const f32x4 v0 = *(const f32x4*)(src + i * 8), v1 = *(const f32x4*)(src + i * 8 + 4);
            u32x4 w; w.x = pk2(v0[0], v0[1]); w.y = pk2(v0[2], v0[3]); w.z = pk2(v1[0], v1[1]); w.w = pk2(v1[2], v1[3]);
            *(LAS u32x4*)(CK + t * KS + sub * 32 + i * 8) = w; }
        const float* ksrc = p.in[I_CKR] + ((size_t)(b * 4 + layer) * 256 + row) * 32 + sub * 8;
        const f32x4 v0 = *(const f32x4*)ksrc, v1 = *(const f32x4*)(ksrc + 4);
        u32x4 w; w.x = pk2(v0[0], v0[1]); w.y = pk2(v0[2], v0[3]); w.z = pk2(v1[0], v1[1]); w.w = pk2(v1[2], v1[3]);
        *(u32x4*)(KR + (size_t)(keyrow0 + t) * 32 + sub * 8) = w;
      } }
    __syncthreads();
    const int l15 = C.lane & 15, hq = C.lane >> 4, w = C.wave;
    if (is_tok) {
        const bf16_t* Wq = (const bf16_t*)(C.wl(layer) + WL_UQ);
        bf16x8 aq[3][6];
#pragma unroll
        for (int j = 0; j < 3; ++j)
#pragma unroll
            for (int ks = 0; ks < 6; ++ks) aq[j][ks] = *(const bf16x8*)(Wq + (size_t)((3 * w + j) * 16 + l15) * 192 + ks * 32 + 8 * hq);
#pragma unroll 2
        for (int tt = 0; tt < 8; ++tt) {
            bf16x8 bq[6];
#pragma unroll
            for (int ks = 0; ks < 6; ++ks) bq[ks] = *(const LAS bf16x8*)(CQ + (tt * 16 + l15) * QS + ks * 32 + 8 * hq);
            const int r = r0 + tt * 16 + l15; const int n = (r - M_CTX) & 4095;
#pragma unroll
            for (int j = 0; j < 3; ++j) { const int nt = 3 * w + j; f32x4 acc = {0.f, 0.f, 0.f, 0.f};
#pragma unroll
                for (int ks = 0; ks < 6; ++ks) acc = mma16(aq[j][ks], bq[ks], acc);
                const int sub6 = nt % 6;
                if (lat && sub6 >= 4) { const int pos = sub6 == 4 ? (n >> 6) : (n & 63);
#pragma unroll
                    for (int jj = 0; jj < 4; ++jj) { const float pr = __shfl_xor(acc[jj], 32); const f32x2 cs = ROPE[pos * 8 + ((4 * hq + jj) & 7)]; acc[jj] = hq < 2 ? acc[jj] * cs[0] - pr * cs[1] : acc[jj] * cs[0] + pr * cs[1]; } }
                *(u32x2*)(Q + (size_t)r * 384 + nt * 16 + 4 * hq) = pk4(acc * QSCALE); }
        }
    }
    { const bf16_t* Wkv = (const bf16_t*)(C.wl(layer) + WL_UKV);
      bf16x8 wf[4][4];
#pragma unroll
      for (int j = 0; j < 4; ++j)
#pragma unroll
          for (int ks = 0; ks < 4; ++ks) wf[j][ks] = *(const bf16x8*)(Wkv + (size_t)((4 * w + j) * 16 + l15) * 128 + ks * 32 + 8 * hq);
      const int h = w >> 1; const bool isv = (w & 1) != 0;
#pragma unroll 2
      for (int tt = 0; tt < 8; ++tt) {
          bf16x8 ck[4];
#pragma unroll
          for (int ks = 0; ks < 4; ++ks) ck[ks] = *(const LAS bf16x8*)(CK + (tt * 16 + l15) * KS + ks * 32 + 8 * hq);
#pragma unroll
          for (int j = 0; j < 4; ++j) { f32x4 acc = {0.f, 0.f, 0.f, 0.f};
              if (!isv) {
#pragma unroll
                  for (int ks = 0; ks < 4; ++ks) acc = mma16(wf[j][ks], ck[ks], acc);
                  *(u32x2*)(KN + (size_t)(keyrow0 + tt * 16 + l15) * 256 + h * 64 + j * 16 + 4 * hq) = pk4(acc);
              } else {
#pragma unroll
                  for (int ks = 0; ks < 4; ++ks) acc = mma16(ck[ks], wf[j][ks], acc);
                  *(u32x2*)(VT + vtbase + (size_t)(h * 64 + j * 16 + l15) * nk + keypos0 + tt * 16 + 4 * hq) = pk4(acc);
              } } } }
    __syncthreads();
}

constexpr int AKS = 104, AVS = 72;
constexpr int ABUF = 64 * AKS * 2 + 64 * AVS * 2;
__device__ __forceinline__ int imax3(int a, int b, int c) { return max(a, max(b, c)); }
constexpr int AVS2 = 136; constexpr int ABUF2 = 128 * AKS * 2 + 64 * AVS2 * 2;
__device__ __forceinline__ void unit_attention(const Ctx& C, int u) {
    int rowbase, keyrow0, nk, h; size_t vtbase;
    if (u < 128) { const int s = u >> 2; h = u & 3; rowbase = s * 256; keyrow0 = s * 256; nk = 256; vtbase = (size_t)(s * 256) * 256; }
    else { const int v0 = u - 128; const int v = (C.G == 256) ? (((v0 & 7) * 2 + (v0 >> 7)) << 4) | ((v0 >> 3) & 15) : v0;
           const int b = v >> 6, qb = v & 15; h = (v >> 4) & 3; rowbase = M_CTX + b * 4096 + qb * 256; keyrow0 = M_CTX + b * 4352; nk = 4352; vtbase = (size_t)keyrow0 * 256; }
    const bf16_t* Q = (const bf16_t*)(C.ws + WS_Q); const bf16_t* KN = (const bf16_t*)(C.ws + WS_KN); const bf16_t* VT = (const bf16_t*)(C.ws + WS_VT); const bf16_t* KR = (const bf16_t*)(C.ws + WS_KR);
    bf16_t* MIX = (bf16_t*)(C.ws + WS_R1);
    const int l31 = C.lane & 31, hh = C.lane >> 5; const int qrow = rowbase + C.wave * 32 + l31;
    bf16x8 qf[6];
#pragma unroll
    for (int ks = 0; ks < 6; ++ks) qf[ks] = *(const bf16x8*)(Q + (size_t)qrow * 384 + h * 96 + ks * 16 + 8 * hh);
    f32x16 o0, o1, o2, negm;
#pragma unroll
    for (int i = 0; i < 16; ++i) { o0[i] = 0.f; o1[i] = 0.f; o2[i] = 0.f; negm[i] = 0.f; }
    const unsigned onew = (l31 == 0) ? 0x3F803F80u : 0u;
    const bf16x8 onesf = __builtin_bit_cast(bf16x8, (u32x4){onew, onew, onew, onew});
    const int skey = C.tid >> 3, sc8 = (C.tid & 7) * 8, rkey = (C.tid & 255) >> 2, rc8 = (C.tid & 3) * 8;
    const bf16_t* gkn = KN + (size_t)(keyrow0 + skey) * 256 + h * 64 + sc8;
    const bf16_t* gkr = KR + (size_t)(keyrow0 + rkey) * 32 + rc8;
    const bf16_t* gvt = VT + vtbase + (size_t)(h * 64 + skey) * nk + sc8;
    const bool do_r = C.tid < 256;
    const int lkn = (skey * AKS + sc8) * 2, lkr = (rkey * AKS + 64 + rc8) * 2, lvt = 128 * AKS * 2 + (skey * AVS2 + sc8) * 2;
    const int ntile = nk >> 7;
    u32x4 rk[2], rr[2] = {{0u, 0u, 0u, 0u}, {0u, 0u, 0u, 0u}}, rv[2];
#define ATT_LD(t) do { _Pragma("unroll") for (int s_ = 0; s_ < 2; ++s_) { rk[s_] = *(const u32x4*)(gkn + (size_t)(2 * (t) + s_) * 64 * 256); if (do_r) rr[s_] = *(const u32x4*)(gkr + (size_t)(2 * (t) + s_) * 64 * 32); rv[s_] = *(const u32x4*)(gvt + (2 * (t) + s_) * 64); } } while (0)
#define ATT_ST(buf) do { LAS unsigned char* b_ = C.lds + (buf) * ABUF2; _Pragma("unroll") for (int s_ = 0; s_ < 2; ++s_) { *(LAS u32x4*)(b_ + lkn + s_ * 64 * AKS * 2) = rk[s_]; if (do_r) *(LAS u32x4*)(b_ + lkr + s_ * 64 * AKS * 2) = rr[s_]; *(LAS u32x4*)(b_ + lvt + s_ * 128) = rv[s_]; } } while (0)
    ATT_LD(0); ATT_ST(0);
    __syncthreads();
#pragma unroll 1
    for (int kt = 0; kt < ntile; ++kt) {
        const bool more = kt + 1 < ntile;
        if (more) ATT_LD(kt + 1);
        LAS unsigned char* B = C.lds + (kt & 1) * ABUF2;
#pragma unroll 1
        for (int sub = 0; sub < 2; ++sub) {
        const LAS bf16_t* Kl = (const LAS bf16_t*)B + sub * 64 * AKS; const LAS bf16_t* Vl = (const LAS bf16_t*)(B + 128 * AKS * 2) + sub * 64;
        bf16x8 ka[2][6];
#pragma unroll
        for (int ks = 0; ks < 6; ++ks) { ka[0][ks] = *(const LAS bf16x8*)(Kl + l31 * AKS + ks * 16 + 8 * hh); ka[1][ks] = *(const LAS bf16x8*)(Kl + (32 + l31) * AKS + ks * 16 + 8 * hh); }
        __builtin_amdgcn_sched_barrier(0);
        f32x16 s0 = mma32(ka[0][0], qf[0], negm), s1 = mma32(ka[1][0], qf[0], negm);
#pragma unroll
        for (int ks = 1; ks < 6; ++ks) { s0 = mma32(ka[0][ks], qf[ks], s0); s1 = mma32(ka[1][ks], qf[ks], s1); }
        __builtin_amdgcn_sched_barrier(0);
        u32x2 vr[2][2][4];
#pragma unroll
        for (int t = 0; t < 2; ++t)
#pragma unroll
            for (int ss = 0; ss < 2; ++ss) { const int ko = 32 * t + 16 * ss + 4 * hh;
                vr[t][ss][0] = *(const LAS u32x2*)(Vl + l31 * AVS2 + ko); vr[t][ss][1] = *(const LAS u32x2*)(Vl + l31 * AVS2 + ko + 8);
                vr[t][ss][2] = *(const LAS u32x2*)(Vl + (32 + l31) * AVS2 + ko); vr[t][ss][3] = *(const LAS u32x2*)(Vl + (32 + l31) * AVS2 + ko + 8); }
        __builtin_amdgcn_sched_barrier(0);
        float d; bool resc;
        if (kt == 0 && sub == 0) {
            float mx = fmaxf(s0[0], s1[0]);
#pragma unroll
            for (int i = 1; i < 16; ++i) mx = fmaxf(mx, fmaxf(s0[i], s1[i]));
            d = fmaxf(mx, __shfl_xor(mx, 32)); resc = true;
        } else {
            int im = imax3(__builtin_bit_cast(int, s0[0]), __builtin_bit_cast(int, s1[0]), __builtin_bit_cast(int, s0[1]));
            im = imax3(im, __builtin_bit_cast(int, s1[1]), __builtin_bit_cast(int, s0[2])); im = imax3(im, __builtin_bit_cast(int, s1[2]), __builtin_bit_cast(int, s0[3]));
            im = imax3(im, __builtin_bit_cast(int, s1[3]), __builtin_bit_cast(int, s0[4])); im = imax3(im, __builtin_bit_cast(int, s1[4]), __builtin_bit_cast(int, s0[5]));
            im = imax3(im, __builtin_bit_cast(int, s1[5]), __builtin_bit_cast(int, s0[6])); im = imax3(im, __builtin_bit_cast(int, s1[6]), __builtin_bit_cast(int, s0[7]));
            im = imax3(im, __builtin_bit_cast(int, s1[7]), __builtin_bit_cast(int, s0[8])); im = imax3(im, __builtin_bit_cast(int, s1[8]), __builtin_bit_cast(int, s0[9]));
            im = imax3(im, __builtin_bit_cast(int, s1[9]), __builtin_bit_cast(int, s0[10])); im = imax3(im, __builtin_bit_cast(int, s1[10]), __builtin_bit_cast(int, s0[11]));
            im = imax3(im, __builtin_bit_cast(int, s1[11]), __builtin_bit_cast(int, s0[12])); im = imax3(im, __builtin_bit_cast(int, s1[12]), __builtin_bit_cast(int, s0[13]));
            im = imax3(im, __builtin_bit_cast(int, s1[13]), __builtin_bit_cast(int, s0[14])); im = imax3(im, __builtin_bit_cast(int, s1[14]), __builtin_bit_cast(int, s0[15]));
            im = max(im, __builtin_bit_cast(int, s1[15]));
            im = max(im, __shfl_xor(im, 32));
            resc = __builtin_amdgcn_ballot_w64(im > 0x41000000) != 0ull; d = im > 0x41000000 ? __builtin_bit_cast(float, im) : 0.f;
        }
        if (resc) {
            if (kt != 0 || sub != 0) { const float alpha = __builtin_amdgcn_exp2f(-d); o0 = o0 * alpha; o1 = o1 * alpha; o2 = o2 * alpha; }
            negm = negm - d; s0 = s0 - d; s1 = s1 - d;
        }
#pragma unroll
        for (int i = 0; i < 16; ++i) { s0[i] = __builtin_amdgcn_exp2f(s0[i]); s1[i] = __builtin_amdgcn_exp2f(s1[i]); }
#pragma unroll
        for (int t = 0; t < 2; ++t)
#pragma unroll
            for (int ss = 0; ss < 2; ++ss) {
                u32x4 w;
                if (t == 0) { w.x = pk2(s0[8 * ss + 0], s0[8 * ss + 1]); w.y = pk2(s0[8 * ss + 2], s0[8 * ss + 3]); w.z = pk2(s0[8 * ss + 4], s0[8 * ss + 5]); w.w = pk2(s0[8 * ss + 6], s0[8 * ss + 7]); }
                else { w.x = pk2(s1[8 * ss + 0], s1[8 * ss + 1]); w.y = pk2(s1[8 * ss + 2], s1[8 * ss + 3]); w.z = pk2(s1[8 * ss + 4], s1[8 * ss + 5]); w.w = pk2(s1[8 * ss + 6], s1[8 * ss + 7]); }
                const bf16x8 pf = __builtin_bit_cast(bf16x8, w);
                const bf16x8 va = __builtin_bit_cast(bf16x8, (u32x4){vr[t][ss][0].x, vr[t][ss][0].y, vr[t][ss][1].x, vr[t][ss][1].y}), vb = __builtin_bit_cast(bf16x8, (u32x4){vr[t][ss][2].x, vr[t][ss][2].y, vr[t][ss][3].x, vr[t][ss][3].y});
                o0 = mma32(va, pf, o0); o1 = mma32(vb, pf, o1); o2 = mma32(onesf, pf, o2);
            }
        }
        if (more) ATT_ST((kt + 1) & 1);
        __syncthreads();
    }
#undef ATT_LD
#undef ATT_ST
    const float lsum = o2[0] + __shfl_xor(o2[0], 32);
    const float inv = 1.f / lsum;
    bf16_t* orow = MIX + (size_t)qrow * D + 768 + h * 64;
#pragma unroll
    for (int i = 0; i < 4; ++i) { const int dv = 8 * i + 4 * hh;
        *(u32x2*)(orow + dv) = pk4((f32x4){o0[4 * i] * inv, o0[4 * i + 1] * inv, o0[4 * i + 2] * inv, o0[4 * i + 3] * inv});
        *(u32x2*)(orow + 32 + dv) = pk4((f32x4){o1[4 * i] * inv, o1[4 * i + 1] * inv, o1[4 * i + 2] * inv, o1[4 * i + 3] * inv}); }
}

#define XB_TMO      128
#define XB_XCNT(j)  (256  + 64 * (j))
#define XB_XSUB(j)  (1280 + 64 * (j))
#define XB_XGEN(j)  (2304 + 64 * (j))
#define XB_TOP      3328
#define XB_TOPGEN   3392
#define XCD_BAR_WORDS 3456
#define XB_SPIN_CAP (1u << 18)

__device__ __forceinline__ unsigned xb_ld(unsigned* p)              { return __hip_atomic_load(p, __ATOMIC_RELAXED, __HIP_MEMORY_SCOPE_AGENT); }
__device__ __forceinline__ unsigned xb_add(unsigned* p, unsigned v) { return __hip_atomic_fetch_add(p, v, __ATOMIC_RELAXED, __HIP_MEMORY_SCOPE_AGENT); }
__device__ __forceinline__ unsigned xb_xcc_id() { return (unsigned)__builtin_amdgcn_s_getreg((3 << 11) | 20) & 0xFu; }
#define XB_SPIN(cond, bar) do { unsigned _sp = 0; while (cond) { __builtin_amdgcn_s_sleep(1); \
    if ((++_sp & 255u) == 0u) { if (xb_ld(&(bar)[XB_TMO])) break; if (_sp > XB_SPIN_CAP) { atomicAdd(&(bar)[XB_TMO], 1u); break; } } } } while (0)

struct XcdBarrier {
    unsigned* bar; unsigned x;
    volatile LAS unsigned* st;
};

__device__ __forceinline__ XcdBarrier xcd_barrier_post(unsigned* bar, volatile LAS unsigned* st) {
    XcdBarrier b; b.bar = bar; b.x = xb_xcc_id(); b.st = st;
    if (threadIdx.x == 0) (void)xb_add(&bar[XB_XCNT(b.x)], 1u);
    return b;
}
__device__ __forceinline__ void xcd_barrier_complete(unsigned* bar, unsigned x, unsigned& nloc, unsigned& nx) {
    const unsigned G = gridDim.x * gridDim.y * gridDim.z;
    unsigned sum, cnt, mine, sp = 0u;
    for (;;) {
        sum = 0u; cnt = 0u; mine = 0u;
#pragma unroll
        for (unsigned j = 0; j < 16; ++j) { const unsigned c = xb_ld(&bar[XB_XCNT(j)]); sum += c; cnt += (c > 0u) ? 1u : 0u; mine = (j == x) ? c : mine; }
        if (sum == G) break;
        __builtin_amdgcn_s_sleep(1);
        if ((++sp & 255u) == 0u) { if (xb_ld(&bar[XB_TMO])) break; if (sp > XB_SPIN_CAP) { atomicAdd(&bar[XB_TMO], 1u); break; } }
    }
    nloc = mine > 0u ? mine : 1u; nx = cnt > 0u ? cnt : 1u;
}

__device__ __forceinline__ void xcd_barrier(const XcdBarrier& b) {
    asm volatile("s_waitcnt vmcnt(0)" ::: "memory");
    __syncthreads();
    if (threadIdx.x == 0) {
        unsigned* bar = b.bar;
        __builtin_amdgcn_s_waitcnt(0);
        unsigned nloc = b.st[0], nx = b.st[1];
        if (nloc == 0u) { xcd_barrier_complete(bar, b.x, nloc, nx); b.st[0] = nloc; b.st[1] = nx; }
        const unsigned old = xb_add(&bar[XB_XSUB(b.x)], 1u);
        const unsigned gen = old / nloc;
        if (old + 1u == (gen + 1u) * nloc) {
            __builtin_amdgcn_fence(__ATOMIC_RELEASE, "agent");
            asm volatile("s_waitcnt vmcnt(0)" ::: "memory");
            const unsigned og = xb_add(&bar[XB_TOP], 1u);
            const unsigned tg = og / nx;
            if (og + 1u == (tg + 1u) * nx) xb_add(&bar[XB_TOPGEN], 1u);
            else XB_SPIN(xb_ld(&bar[XB_TOPGEN]) == tg, bar);
            __builtin_amdgcn_fence(__ATOMIC_ACQUIRE, "agent");
            xb_add(&bar[XB_XGEN(b.x)], 1u);
            asm volatile("s_waitcnt vmcnt(0)" ::: "memory");
        } else {
            XB_SPIN(xb_ld(&bar[XB_XGEN(b.x)]) == gen, bar);
            __builtin_amdgcn_fence(__ATOMIC_ACQUIRE, "agent");
            asm volatile("s_waitcnt vmcnt(0)" ::: "memory");
        }
    }
    __syncthreads();
}

__global__ void __launch_bounds__(NTHREADS, 2) mk_fwd(Params p) {
    extern __shared__ __attribute__((aligned(16))) unsigned char lds_raw[];
    cg::grid_group grid = cg::this_grid();
    Ctx C; C.p = p; C.lds = (LAS unsigned char*)lds_raw; C.tid = threadIdx.x; C.lane = C.tid & 63; C.wave = __builtin_amdgcn_readfirstlane(C.tid >> 6); C.bid = blockIdx.x; C.G = gridDim.x; C.ws = p.ws;

    volatile LAS unsigned* bst = (volatile LAS unsigned*)(C.lds + LDS_BYTES - 64);
    if (threadIdx.x < 2) bst[threadIdx.x] = 0u;
    __syncthreads();
    const XcdBarrier bar = xcd_barrier_post((unsigned*)(p.ws + WS_BAR), bst);
    C.refresh(); phase_prologue(C);
    if (p.ws == nullptr) grid.sync();
    xcd_barrier(bar);
    C.refresh(); phase_norm0(C);
    xcd_barrier(bar);
#pragma unroll 1
    for (int layer = 0; layer < DEPTH; ++layer) {
        { C.refresh(); bf16_t* R1 = (bf16_t*)(C.ws + WS_R1); bf16_t* R2 = (bf16_t*)(C.ws + WS_R2); unsigned char* wl = C.wl(layer); pg8::Gemm g{R1, (const bf16_t*)(wl + WL_IN), M, NPP, D}; pg8::StaticOrder S; S.init(M, NPP, C.G, C.bid); pg8::EpiStore E{R2, NP, NP};
          pg8::gemm_phase<pg8::EpiStore, pg8::StaticOrder, true, true>(C.lds, g, S, E); }
        xcd_barrier(bar);
        C.refresh();
        for (int u = C.bid; u < 768 + 192 + 128 + 128 + 200; u += C.G) {
            C.refresh();
            if (u < 768) unit_chunk_mlp(C, layer, u);
            else if (u < 960) unit_conv(C, layer, u - 768);
            else if (u < 1088) unit_fourier_ctx(C, u - 960);
            else if (u < 1216) unit_fourier_lat1(C, u - 1088);
            else unit_mla_prep(C, layer, u - 1216);
        }
        xcd_barrier(bar);
        C.refresh();
        for (int u = C.bid; u < 512; u += C.G) {
            C.refresh();
            if (u < 256) unit_attention(C, 128 + u);
            else if (u < 384) unit_attention(C, u - 256);
            else unit_fourier_lat2(C, u - 384);
        }
        xcd_barrier(bar);
        { C.refresh(); bf16_t* R1 = (bf16_t*)(C.ws + WS_R1); bf16_t* R2 = (bf16_t*)(C.ws + WS_R2); unsigned char* wl = C.wl(layer); pg8::Gemm g{R1, (const bf16_t*)(wl + WL_OUT), M, D, D}; pg8::SplitTailOrder S; S.init(D, C.G, C.bid); pg8::EpiStoreSplit E{R2, R2 + (size_t)M * D - (size_t)SPLIT_ROW0 * D, D};
          pg8::gemm_phase<pg8::EpiStoreSplit, pg8::SplitTailOrder, true, true>(C.lds, g, S, E); }
        xcd_barrier(bar);
        C.refresh(); phase_post<0>(C, layer);
        xcd_barrier(bar);
        { C.refresh(); bf16_t* R1 = (bf16_t*)(C.ws + WS_R1); bf16_t* R2 = (bf16_t*)(C.ws + WS_R2); unsigned char* wl = C.wl(layer); pg8::Gemm g{R1, (const bf16_t*)(wl + WL_GU), M, 2 * FF, D}; pg8::StaticOrder S; S.init(M, 2 * FF, C.G, C.bid); pg8::EpiSwiGLU E{R2, FF};
          pg8::gemm_phase<pg8::EpiSwiGLU, pg8::StaticOrder, true, true>(C.lds, g, S, E);
          if (C.G == 256 && layer + 1 < DEPTH && C.bid >= 64) { C.refresh(); transpose_items(C, (layer + 1) * TI_L + (C.bid - 64), 192, (layer + 2) * TI_L); } }
        xcd_barrier(bar);
        { C.refresh(); bf16_t* R2 = (bf16_t*)(C.ws + WS_R2); bf16_t* R3 = (bf16_t*)(C.ws + WS_MLA); unsigned char* wl = C.wl(layer); pg8::Gemm g{R2, (const bf16_t*)(wl + WL_DN), M, D, FF}; pg8::SplitTailOrder S; S.init(FF, C.G, C.bid); pg8::EpiStoreSplit E{R3, R3 + (size_t)M * D - (size_t)SPLIT_ROW0 * D, D};
          pg8::gemm_phase<pg8::EpiStoreSplit, pg8::SplitTailOrder, true, true>(C.lds, g, S, E); }
        xcd_barrier(bar);
        C.refresh(); phase_post<1>(C, layer);
        if (layer + 1 < DEPTH) xcd_barrier(bar);
    }
}

extern "C" void kernel_launch(void* const* d_in, const int* in_sizes, int n_in, void* d_out, int out_size, void* d_ws, size_t ws_size, hipStream_t stream) {
    static int grid = 0;
    if (grid == 0) {
        if (n_in != 24 || ws_size < WS_END) { fprintf(stderr, "kernel_launch: need 24 inputs and %zu bytes of workspace; got %d, %zu\n", (size_t)WS_END, n_in, ws_size); grid = -1; return; }
        int dev = 0, cus = 0, per_cu = 0;
        if (hipGetDevice(&dev) != hipSuccess || hipDeviceGetAttribute(&cus, hipDeviceAttributeMultiprocessorCount, dev) != hipSuccess) { grid = -1; return; }
        if (hipFuncSetAttribute((const void*)mk_fwd, hipFuncAttributeMaxDynamicSharedMemorySize, LDS_BYTES) != hipSuccess) { fprintf(stderr, "kernel_launch: hipFuncSetAttribute failed\n"); grid = -1; return; }
        if (hipOccupancyMaxActiveBlocksPerMultiprocessor(&per_cu, (const void*)mk_fwd, NTHREADS, LDS_BYTES) != hipSuccess || per_cu < 1) fprintf(stderr, "kernel_launch: occupancy query says %d blocks per CU\n", per_cu);
        (void)hipGetLastError();
        grid = cus;
    }
    if (grid < 0) return;
    Params p{};
    for (int i = 0; i < 24; ++i) p.in[i] = (const float*)d_in[i];
    p.out = (float*)d_out; p.ws = (unsigned char*)d_ws;
    if (hipMemsetAsync((char*)d_ws + WS_BAR, 0, WS_BAR_BYTES, stream) != hipSuccess) { fprintf(stderr, "kernel_launch: memset failed\n"); return; }
    void* args[] = {&p};
    hipError_t e = hipLaunchCooperativeKernel((const void*)mk_fwd, dim3(grid), dim3(NTHREADS), args, LDS_BYTES, stream);
    if (e != hipSuccess) fprintf(stderr, "kernel_launch: cooperative launch failed: %s (grid %d)\n", hipGetErrorString(e), grid);
}
```
